# Optimizing an MI355X kernel written in HIP

```python
import math
import numpy as np
import jax
import jax.numpy as jnp
from jax import lax

D_MODEL = 2048
BATCH = 8
SEQ = 2048
DEPTH = 1

CHUNK = 64
BLOCK_Q = 128
FOX_HEADS = 8
FOX_HEAD_DIM = 128
FOX_WIDTH = FOX_HEADS * FOX_HEAD_DIM
RET_HEADS = 8
RET_QK_DIM = 128
RET_V_DIM = 128
RET_QK_WIDTH = RET_HEADS * RET_QK_DIM
RET_V_WIDTH = RET_HEADS * RET_V_DIM
N_BRANCHES = 2
MEM_TOKENS = 256
MEM_HEADS = 4
MEM_HEAD_DIM = 128
MEM_WIDTH = MEM_HEADS * MEM_HEAD_DIM
PEER_HEADS = 8
PEER_NKEYS = 128
PEER_QUERY_DIM = 256
PEER_TOPK = 16
N_EXPERTS = PEER_NKEYS * PEER_NKEYS
PEER_TOKEN_BLOCK = 128
ROPE_BASE = 10000.0
EPS = 1e-6
IN_SPLIT_SIZES = (FOX_WIDTH, FOX_WIDTH, FOX_WIDTH, FOX_HEADS, RET_QK_WIDTH, RET_QK_WIDTH, RET_V_WIDTH, RET_V_WIDTH, N_BRANCHES * D_MODEL)
N_IN = sum(IN_SPLIT_SIZES)

kernel_name = 'hybrid_fox_retention_peer_block'


def _rms(x, g):
    xf = x.astype(jnp.float32)
    y = xf * lax.rsqrt(jnp.mean(xf * xf, axis=-1, keepdims=True) + EPS)
    return (y * g.astype(jnp.float32)).astype(x.dtype)


def _split_heads(t, n_heads):
    b, s, _ = t.shape
    return t.reshape(b, s, n_heads, -1).transpose(0, 2, 1, 3)


def _merge_heads(t):
    b, h, s, d = t.shape
    return t.transpose(0, 2, 1, 3).reshape(b, s, h * d)


def _rope(x):
    s, d = x.shape[-2], x.shape[-1]
    half = d // 2
    inv_freq = jnp.exp(-math.log(ROPE_BASE) * jnp.arange(half, dtype=jnp.float32) / half)
    ang = jnp.arange(s, dtype=jnp.float32)[:, None] * inv_freq[None, :]
    cos, sin = jnp.cos(ang), jnp.sin(ang)
    xf = x.astype(jnp.float32)
    x1, x2 = xf[..., :half], xf[..., half:]
    return jnp.concatenate([x1 * cos - x2 * sin, x1 * sin + x2 * cos], axis=-1).astype(x.dtype)


def _fox_attention(q, k, v, cum_logf):
    s_len, d = q.shape[2], q.shape[3]
    scale = d ** -0.5
    neg = jnp.finfo(jnp.float32).min
    outs = []
    for i in range(s_len // BLOCK_Q):
        lo, hi = i * BLOCK_Q, (i + 1) * BLOCK_Q
        qb = q[:, :, lo:hi]
        kb = k[:, :, :hi]
        vb = v[:, :, :hi]
        logits = jnp.einsum('bhqd,bhkd->bhqk', qb, kb).astype(jnp.float32) * scale
        logits = logits + cum_logf[:, :, lo:hi, None] - cum_logf[:, :, None, :hi]
        mask = jnp.arange(hi)[None, :] <= jnp.arange(lo, hi)[:, None]
        logits = jnp.where(mask, logits, neg)
        p = jax.nn.softmax(logits, axis=-1).astype(vb.dtype)
        outs.append(jnp.einsum('bhqk,bhkd->bhqd', p, vb))
    return jnp.concatenate(outs, axis=2)


def _retention(q, k, v):
    b, h, s_len, d = q.shape
    dv = v.shape[-1]
    nc = s_len // CHUNK
    log_g = jnp.log1p(-jnp.exp2(-5.0 - jnp.arange(h, dtype=jnp.float32)))
    idx = jnp.arange(CHUNK, dtype=jnp.float32)
    d_intra = jnp.exp(log_g[:, None, None] * jnp.abs(idx[:, None] - idx[None, :]))
    q_dec = jnp.exp(log_g[:, None] * (idx[None, :] + 1.0))
    k_dec = jnp.exp(log_g[:, None] * (CHUNK - 1.0 - idx[None, :]))
    chunk_dec = jnp.exp(log_g * CHUNK)
    qc = q.astype(jnp.float32).reshape(b, h, nc, CHUNK, d)
    kc = k.astype(jnp.float32).reshape(b, h, nc, CHUNK, d)
    vc = v.astype(jnp.float32).reshape(b, h, nc, CHUNK, dv)
    att = jnp.einsum('bhnid,bhnjd->bhnij', qc, kc) * d_intra[None, :, None]
    y_intra = jnp.einsum('bhnij,bhnje->bhnie', att, vc)
    kv = jnp.einsum('bhncd,bhnce->nbhde', kc * k_dec[None, :, None, :, None], vc)

    def step(state, kv_c):
        return state * chunk_dec[None, :, None, None] + kv_c, state

    _, states = lax.scan(step, jnp.zeros((b, h, d, dv), jnp.float32), kv)
    y_inter = jnp.einsum('bhnid,nbhde->bhnie', qc * q_dec[None, :, None, :, None], states)
    return (y_intra + y_inter).reshape(b, h, s_len, dv)


def _mixer_block(x, ln_g, w_in, b_forget, fox_q_g, fox_k_g, ret_norm_g, w_fox_up, w_ret_up, w_out):
    b, s_len, dm = x.shape
    h = _rms(x, ln_g)
    proj = h @ w_in
    split_pts = np.cumsum(IN_SPLIT_SIZES)[:-1].tolist()
    fq, fk, fv, ff, rq, rk, rv, rg, gate_logits = jnp.split(proj, split_pts, axis=-1)
    q = _rms(_split_heads(fq, FOX_HEADS), fox_q_g)
    k = _rms(_split_heads(fk, FOX_HEADS), fox_k_g)
    v = _split_heads(fv, FOX_HEADS)
    log_f = jax.nn.log_sigmoid(ff.astype(jnp.float32) + b_forget.astype(jnp.float32))
    cum_logf = jnp.cumsum(log_f.transpose(0, 2, 1), axis=-1)
    o_fox = _merge_heads(_fox_attention(q, k, v, cum_logf))
    rq_h = _rope(_split_heads(rq, RET_HEADS))
    rk_h = _rope(_split_heads(rk, RET_HEADS)) * (RET_QK_DIM ** -0.5)
    rv_h = _split_heads(rv, RET_HEADS)
    y = _retention(rq_h, rk_h, rv_h)
    mu = jnp.mean(y, axis=-1, keepdims=True)
    var = jnp.mean(jnp.square(y - mu), axis=-1, keepdims=True)
    y = _merge_heads((y - mu) * lax.rsqrt(var + EPS)) * ret_norm_g.astype(jnp.float32)
    o_ret = (jax.nn.silu(rg.astype(jnp.float32)) * y).astype(x.dtype)
    gates = jax.nn.sigmoid(gate_logits.astype(jnp.float32)).reshape(b, s_len, N_BRANCHES, dm)
    merged = gates[:, :, 0] * (o_fox @ w_fox_up) + gates[:, :, 1] * (o_ret @ w_ret_up)
    return x + merged.astype(x.dtype) @ w_out


def _memory_block(x, mem, ln_g, mem_g, w_mq, w_mkv, q_g, k_g, w_mo):
    b, s_len, _ = x.shape
    m_len = mem.shape[1]
    h = _rms(x, ln_g)
    m = _rms(mem, mem_g)
    q = _rms((h @ w_mq).reshape(b, s_len, MEM_HEADS, MEM_HEAD_DIM), q_g)
    kv = (m @ w_mkv).reshape(b, m_len, 2, MEM_HEADS, MEM_HEAD_DIM)
    k = _rms(kv[:, :, 0], k_g)
    v = kv[:, :, 1]
    logits = jnp.einsum('bshd,bmhd->bhsm', q, k).astype(jnp.float32) * (MEM_HEAD_DIM ** -0.5)
    p = jax.nn.softmax(logits, axis=-1).astype(v.dtype)
    o = jnp.einsum('bhsm,bmhd->bshd', p, v).reshape(b, s_len, MEM_WIDTH)
    return x + o @ w_mo


def _peer_block(x, ln_g, w_q, sub_keys, peer_u, peer_v):
    b, s_len, dm = x.shape
    h = _rms(x, ln_g)
    q = (h @ w_q).reshape(b, s_len, PEER_HEADS, 2, PEER_QUERY_DIM // 2)
    sc = jnp.einsum('bshpd,hpkd->bshpk', q, sub_keys).astype(jnp.float32)
    s_top, i_top = lax.top_k(sc, PEER_TOPK)
    cand = s_top[..., 0, :, None] + s_top[..., 1, None, :]
    cidx = i_top[..., 0, :, None] * PEER_NKEYS + i_top[..., 1, None, :]
    cand = cand.reshape(b, s_len, PEER_HEADS, PEER_TOPK * PEER_TOPK)
    cidx = cidx.reshape(b, s_len, PEER_HEADS, PEER_TOPK * PEER_TOPK)
    s_fin, pos = lax.top_k(cand, PEER_TOPK)
    e_idx = jnp.take_along_axis(cidx, pos, axis=-1)
    gate = jax.nn.softmax(s_fin, axis=-1)
    n_tok = b * s_len
    nb = n_tok // PEER_TOKEN_BLOCK
    hk = PEER_HEADS * PEER_TOPK
    hb = h.reshape(nb, PEER_TOKEN_BLOCK, dm)
    ib = e_idx.reshape(nb, PEER_TOKEN_BLOCK, hk)
    gb = gate.reshape(nb, PEER_TOKEN_BLOCK, hk).astype(h.dtype)

    def expert_block(args):
        hh, ii, gg = args
        act = jnp.einsum('tkd,td->tk', peer_u[ii], hh)
        w = gg * jax.nn.gelu(act)
        return jnp.einsum('tk,tkd->td', w, peer_v[ii])

    out = lax.map(expert_block, (hb, ib, gb)).reshape(b, s_len, dm)
    return x + out


def setup_inputs(seed: int = 0) -> dict:
    key = jax.random.key(seed)
    ks = jax.random.split(key, 24)
    f32 = jnp.float32
    L = DEPTH

    def nrm(k, shape, scale):
        return jax.random.normal(k, shape, f32) * scale

    def gain(k, n):
        return 1.0 + 0.02 * jax.random.normal(k, (L, n), f32)

    return {
        'x': nrm(ks[0], (BATCH, SEQ, D_MODEL), 1.0),
        'mem': nrm(ks[1], (BATCH, MEM_TOKENS, D_MODEL), 1.0),
        'ln_mix_g': gain(ks[2], D_MODEL),
        'w_in': nrm(ks[3], (L, D_MODEL, N_IN), D_MODEL ** -0.5),
        'b_forget': jax.random.uniform(ks[4], (L, FOX_HEADS), f32, 1.0, 6.0),
        'fox_q_norm_g': gain(ks[5], FOX_HEAD_DIM),
        'fox_k_norm_g': gain(ks[6], FOX_HEAD_DIM),
        'ret_norm_g': gain(ks[7], RET_V_WIDTH),
        'w_fox_up': nrm(ks[8], (L, FOX_WIDTH, D_MODEL), FOX_WIDTH ** -0.5),
        'w_ret_up': nrm(ks[9], (L, RET_V_WIDTH, D_MODEL), RET_V_WIDTH ** -0.5),
        'w_out': nrm(ks[10], (L, D_MODEL, D_MODEL), D_MODEL ** -0.5),
        'ln_mem_g': gain(ks[11], D_MODEL),
        'mem_norm_g': gain(ks[12], D_MODEL),
        'w_mq': nrm(ks[13], (L, D_MODEL, MEM_WIDTH), D_MODEL ** -0.5),
        'w_mkv': nrm(ks[14], (L, D_MODEL, 2 * MEM_WIDTH), D_MODEL ** -0.5),
        'mem_q_norm_g': gain(ks[15], MEM_HEAD_DIM),
        'mem_k_norm_g': gain(ks[16], MEM_HEAD_DIM),
        'w_mo': nrm(ks[17], (L, MEM_WIDTH, D_MODEL), MEM_WIDTH ** -0.5),
        'ln_ffn_g': gain(ks[18], D_MODEL),
        'w_peer_q': nrm(ks[19], (L, D_MODEL, PEER_HEADS * PEER_QUERY_DIM), D_MODEL ** -0.5),
        'peer_sub_keys': nrm(ks[20], (L, PEER_HEADS, 2, PEER_NKEYS, PEER_QUERY_DIM // 2), (PEER_QUERY_DIM // 2) ** -0.5),
        'peer_u': nrm(ks[21], (L, N_EXPERTS, D_MODEL), D_MODEL ** -0.5),
        'peer_v': nrm(ks[22], (L, N_EXPERTS, D_MODEL), 0.5),
    }


def reference(x, mem, ln_mix_g, w_in, b_forget, fox_q_norm_g, fox_k_norm_g, ret_norm_g, w_fox_up, w_ret_up, w_out, ln_mem_g, mem_norm_g, w_mq, w_mkv, mem_q_norm_g, mem_k_norm_g, w_mo, ln_ffn_g, w_peer_q, peer_sub_keys, peer_u, peer_v):
    for l in range(DEPTH):
        x = _mixer_block(x, ln_mix_g[l], w_in[l], b_forget[l], fox_q_norm_g[l], fox_k_norm_g[l], ret_norm_g[l], w_fox_up[l], w_ret_up[l], w_out[l])
        x = _memory_block(x, mem, ln_mem_g[l], mem_norm_g[l], w_mq[l], w_mkv[l], mem_q_norm_g[l], mem_k_norm_g[l], w_mo[l])
        x = _peer_block(x, ln_ffn_g[l], w_peer_q[l], peer_sub_keys[l], peer_u[l], peer_v[l])
    return x
```

```cpp
#include <hip/hip_runtime.h>
#include <cstdio>
#include <cstdint>
#include <cmath>
namespace pg8 {
#define PG8_LAS __attribute__((address_space(3)))
typedef unsigned short bf16_t;
typedef short bf16x8 __attribute__((ext_vector_type(8)));
typedef float f32x4 __attribute__((ext_vector_type(4)));
typedef unsigned u32x4 __attribute__((ext_vector_type(4)));
constexpr int BM = 256, BK = 64, HALF = 128, HTB = HALF * BK * 2  , STAGE_BYTES = 8 * HTB, NXCD = 8, WGM = 8;

__host__ __device__ __forceinline__ int lds_byte(int r, int c) { const int st = (r >> 4) * 2 + (c >> 5), rr = r & 15, cc = c & 31, ob = rr * 64 + cc * 2; return st * 1024 + (ob ^ (((ob >> 9) & 1) << 5)); }
__host__ __device__ __forceinline__ void stage_rc(int b, int& R, int& C) { const int st = b / 1024, sb = b % 1024, swz = sb ^ (((sb >> 9) & 1) << 5); R = (st >> 1) * 16 + swz / 64; C = (st & 1) * 32 + (swz % 64) / 2; }
__host__ __device__ __forceinline__ int perm32(int rho) { const int n = rho >> 4, i = rho & 15; return 8 * (i >> 2) + 4 * n + (i & 3); }

struct Unit { int pm, pn; };
struct Gemm { const bf16_t* A; const bf16_t* Bt; int M, N, K, lda; };

struct StaticOrder {
    int nM, nN, nwg, G, c;
    __host__ __device__ void init(int M, int N, int G_, int c_) { nM = M / BM; nN = N / BM; nwg = nM * nN; G = G_; c = c_; }
    __host__ __device__ bool next(int i, Unit& u) const {
        const long L = (long)i * G + c; if (L >= nwg) return false;
        int wgid = (int)L; { const int q = nwg / NXCD, r = nwg % NXCD, xcd = wgid % NXCD, off = wgid / NXCD; wgid = (xcd < r ? xcd * (q + 1) : r * (q + 1) + (xcd - r) * q) + off; }
        const int nig = WGM * nN, gid = wgid / nig, fm = gid * WGM, gsz = (nM - fm) < WGM ? (nM - fm) : WGM;
        u.pm = fm + ((wgid % nig) % gsz); u.pn = (wgid % nig) / gsz; return true;
    }
    __device__ __forceinline__ void a_ready(const Unit&) const {}
    __device__ __forceinline__ void done(const Unit&) const {}
};

__device__ __forceinline__ unsigned cvt_pk_bf16(float lo, float hi) { unsigned r; asm volatile("v_cvt_pk_bf16_f32 %0, %1, %2" : "=v"(r) : "v"(lo), "v"(hi)); return r; }
typedef float f32x2 __attribute__((ext_vector_type(2)));
__device__ __forceinline__ f32x2 gelu_pk(f32x2 v) {
    const f32x2 av = __builtin_elementwise_abs(v), d = av * 0.2316418882f + 1.0f;
    f32x2 t; t.x = __builtin_amdgcn_rcpf(d.x); t.y = __builtin_amdgcn_rcpf(d.y);
    f32x2 q = t * 0.5307027145f + (-0.7265760135f); q = q * t + 0.7107068705f; q = q * t + (-0.142248368f); q = q * t + 0.127414796f; q = q * t;
    const f32x2 s = (v * v) * (-0.72134752044f);
    f32x2 e; e.x = __builtin_amdgcn_exp2f(s.x); e.y = __builtin_amdgcn_exp2f(s.y);
    const f32x2 m = v * (q * e), r = v - m;
    f32x2 o; o.x = v.x < 0.f ? m.x : r.x; o.y = v.y < 0.f ? m.y : r.y; return o;
}

template <int ACT  > struct EpiBf16 {
    static constexpr bool PERM = true, AFTER_DRAIN = false; static_assert(ACT == 0 || ACT == 1, "EpiBf16: ACT is 0 (none) or 1 (gelu_pk)");
    bf16_t* O; int ldc; const float* bias; int split_cols; size_t split_stride; float scale0;
    __device__ __forceinline__ void operator()(const f32x4 (&acc)[2][2][4][2], const Unit& u, int wr, int wc, int fr, int fq) const {
        const int row0 = u.pm * BM + wr * 64 + fr; int colt = u.pn * BM; bf16_t* base = O;
        float sc = 1.f; if (split_cols) { const int t = colt / split_cols; base += (size_t)t * split_stride; colt -= t * split_cols; if (t == 0) sc = scale0; }
        const int col0 = colt + wc * 32 + 8 * fq, bcol0 = u.pn * BM + wc * 32 + 8 * fq;
        f32x4 bv[2][2];
#pragma unroll
        for (int bj = 0; bj < 2; ++bj)
#pragma unroll
            for (int n = 0; n < 2; ++n) bv[bj][n] = bias ? *(const f32x4*)(bias + bcol0 + bj * HALF + 4 * n) : (f32x4){0.f, 0.f, 0.f, 0.f};
#pragma unroll
        for (int ai = 0; ai < 2; ++ai)
#pragma unroll
            for (int m = 0; m < 4; ++m) { bf16_t* rowp = base + (size_t)(row0 + ai * HALF + m * 16) * ldc + col0;
#pragma unroll
                for (int bj = 0; bj < 2; ++bj) { f32x4 v0 = acc[ai][bj][m][0] + bv[bj][0], v1 = acc[ai][bj][m][1] + bv[bj][1];
                    if (ACT == 1) { f32x2 a = gelu_pk((f32x2){v0[0], v0[1]}), b = gelu_pk((f32x2){v0[2], v0[3]}), c = gelu_pk((f32x2){v1[0], v1[1]}), d = gelu_pk((f32x2){v1[2], v1[3]});
                        v0 = (f32x4){a.x, a.y, b.x, b.y}; v1 = (f32x4){c.x, c.y, d.x, d.y}; }
                    v0 = v0 * sc; v1 = v1 * sc; u32x4 w; w.x = cvt_pk_bf16(v0[0], v0[1]); w.y = cvt_pk_bf16(v0[2], v0[3]); w.z = cvt_pk_bf16(v1[0], v1[1]); w.w = cvt_pk_bf16(v1[2], v1[3]);
                    *(u32x4*)(rowp + bj * HALF) = w; } }
    }
};

struct PanelStats {
    unsigned* xbuf;
    unsigned* cnt;
    unsigned* tmo;
    int ntn; float eps;
    unsigned code;
    __device__ __forceinline__ bool run(const f32x4 (&v)[2][2][4][2], const Unit& u, int wr, int wc, int fr, int fq, PG8_LAS unsigned char* lds, int wid, int lane) const {
        typedef float f32x2v __attribute__((ext_vector_type(2)));
        PG8_LAS f32x2v* P = (PG8_LAS f32x2v*)lds;
        PG8_LAS f32x2v* S = (PG8_LAS f32x2v*)(lds + 8192);
        PG8_LAS unsigned* flag = (PG8_LAS unsigned*)(lds + 8192 + 2048);
#pragma unroll
        for (int ai = 0; ai < 2; ++ai)
#pragma unroll
            for (int m = 0; m < 4; ++m) {
                float s = 0.f;
#pragma unroll
                for (int bj = 0; bj < 2; ++bj)
#pragma unroll
                    for (int n = 0; n < 2; ++n) { const f32x4 x = v[ai][bj][m][n]; s += (x[0] + x[1]) + (x[2] + x[3]); }
                s += __shfl_xor(s, 16); s += __shfl_xor(s, 32);
                const float mw = s * (1.0f / 64.0f); float q = 0.f;
#pragma unroll
                for (int bj = 0; bj < 2; ++bj)
#pragma unroll
                    for (int n = 0; n < 2; ++n) { const f32x4 d = v[ai][bj][m][n] - mw; q += (d[0] * d[0] + d[1] * d[1]) + (d[2] * d[2] + d[3] * d[3]); }
                q += __shfl_xor(q, 16); q += __shfl_xor(q, 32);
                if (fq == 0) P[(ai * HALF + wr * 64 + m * 16 + fr) * 4 + wc] = (f32x2v){mw, q};
            }
        asm volatile("s_waitcnt lgkmcnt(0)" ::: "memory"); __builtin_amdgcn_s_barrier(); asm volatile("" ::: "memory");
#if defined(BROKEN_EXCHANGE_NO_WAIT)
#warning BROKEN CONTROL BUILD: the row-statistics exchange does not wait; results are wrong by design
        if (blockIdx.x >= 64) { const long long t0_ = clock64(); while (clock64() - t0_ < 60000) __builtin_amdgcn_s_sleep(8); }
#endif
        const int row = wid * 32 + (lane & 31);
        if (lane < 32) {
            const f32x2v a = P[row * 4 + 0], b = P[row * 4 + 1], c = P[row * 4 + 2], d = P[row * 4 + 3];
            const float mt = (a.x + b.x + c.x + d.x) * 0.25f;
            const float da = a.x - mt, db = b.x - mt, dc = c.x - mt, dd = d.x - mt;
            const float m2 = (a.y + b.y) + (c.y + d.y) + 64.0f * ((da * da + db * db) + (dc * dc + dd * dd));
            unsigned long long* slot = (unsigned long long*)xbuf + ((size_t)(u.pm * BM + row) * 4 + u.pn);
            __hip_atomic_store(slot, ((unsigned long long)__float_as_uint(m2) << 32) | __float_as_uint(mt), __ATOMIC_RELAXED, __HIP_MEMORY_SCOPE_AGENT);
        }
        asm volatile("s_waitcnt vmcnt(0)" ::: "memory");
        if (lane == 0) __hip_atomic_fetch_add(cnt + 64 * u.pm, 1u, __ATOMIC_RELAXED, __HIP_MEMORY_SCOPE_AGENT);
        if (wid == 0) {
            bool dead = false; const unsigned long long t0 = __builtin_amdgcn_s_memrealtime(); const unsigned want = 8u * (unsigned)ntn;
            for (;;) {
#if defined(BROKEN_EXCHANGE_NO_WAIT)
                break;
#endif
                if ((unsigned)__builtin_amdgcn_readfirstlane(__hip_atomic_load(cnt + 64 * u.pm, __ATOMIC_RELAXED, __HIP_MEMORY_SCOPE_AGENT)) >= want) break;
                if (__builtin_amdgcn_s_memrealtime() - t0 > 2000000ull) {
                    if (lane == 0) { unsigned expect = 0u; __hip_atomic_compare_exchange_strong(tmo + 1, &expect, code | (unsigned)(u.pm & 0xff), __ATOMIC_RELAXED, __ATOMIC_RELAXED, __HIP_MEMORY_SCOPE_AGENT);
                                     __hip_atomic_store(tmo, 1u, __ATOMIC_RELAXED, __HIP_MEMORY_SCOPE_AGENT); }
                    dead = true; break; }
                __builtin_amdgcn_s_sleep(2);
            }
            __builtin_amdgcn_fence(__ATOMIC_ACQUIRE, "agent");
            if (lane == 0) flag[0] = dead ? 1u : 0u;
        }
        asm volatile("s_waitcnt vmcnt(0) lgkmcnt(0)" ::: "memory"); __builtin_amdgcn_s_barrier(); asm volatile("" ::: "memory");
        const bool bad = flag[0] != 0u;
        if (lane < 32) {
            const unsigned long long* slot = (const unsigned long long*)xbuf + (size_t)(u.pm * BM + row) * 4; float mt[4], m2[4]; float ms = 0.f;
#pragma unroll
            for (int t = 0; t < 4; ++t) { if (t < ntn) { const unsigned long long w = __hip_atomic_load(slot + t, __ATOMIC_RELAXED, __HIP_MEMORY_SCOPE_AGENT); mt[t] = __uint_as_float((unsigned)w); m2[t] = __uint_as_float((unsigned)(w >> 32)); } else { mt[t] = 0.f; m2[t] = 0.f; } ms += mt[t]; }
            const float mean = ms / (float)ntn; float q = 0.f;
#pragma unroll
            for (int t = 0; t < 4; ++t) if (t < ntn) { const float dm = mt[t] - mean; q += m2[t] + 256.0f * dm * dm; }
            S[row] = (f32x2v){mean, 1.0f / sqrtf(q / (256.0f * (float)ntn) + eps)};
        }
        asm volatile("s_waitcnt lgkmcnt(0)" ::: "memory"); __builtin_amdgcn_s_barrier(); asm volatile("" ::: "memory");
        return bad;
    }
};
struct EpiLnRes {
    static constexpr bool PERM = false, AFTER_DRAIN = true;
    const float* base; float* out; int ldc; const float* bias; PanelStats st; unsigned poison;
    __device__ __forceinline__ void fused(f32x4 (&acc)[2][2][4][2], const Unit& u, int wr, int wc, int fr, int fq, PG8_LAS unsigned char* lds, int wid, int lane) const {
        typedef float f32x2v __attribute__((ext_vector_type(2)));
        const PG8_LAS f32x2v* S = (const PG8_LAS f32x2v*)(lds + 8192);
        const int col0 = u.pn * BM + wc * 32 + 4 * fq;
#pragma unroll
        for (int bj = 0; bj < 2; ++bj)
#pragma unroll
            for (int n = 0; n < 2; ++n) { const f32x4 bv = bias ? *(const f32x4*)(bias + col0 + bj * HALF + n * 16) : (f32x4){0.f, 0.f, 0.f, 0.f};
#pragma unroll
                for (int ai = 0; ai < 2; ++ai)
#pragma unroll
                    for (int m = 0; m < 4; ++m) acc[ai][bj][m][n] += bv; }
        f32x4 pre[4][2][2];
#pragma unroll
        for (int m = 0; m < 4; ++m) { const size_t off = (size_t)(u.pm * BM + wr * 64 + m * 16 + fr) * ldc + col0;
#pragma unroll
            for (int bj = 0; bj < 2; ++bj)
#pragma unroll
                for (int n = 0; n < 2; ++n) pre[m][bj][n] = *(const f32x4*)(base + off + bj * HALF + n * 16); }
        const bool bad = st.run(acc, u, wr, wc, fr, fq, lds, wid, lane) || poison != 0u;
        const float qnan = __builtin_nanf("");
#pragma unroll
        for (int ai = 0; ai < 2; ++ai)
#pragma unroll
            for (int m = 0; m < 4; ++m) { const int r = ai * HALF + wr * 64 + m * 16 + fr; const f32x2v sr = S[r]; const size_t off = (size_t)(u.pm * BM + r) * ldc + col0;
#pragma unroll
                for (int bj = 0; bj < 2; ++bj)
#pragma unroll
                    for (int n = 0; n < 2; ++n) { const f32x4 bs = ai == 0 ? pre[m][bj][n] : *(const f32x4*)(base + off + bj * HALF + n * 16); f32x4 o = bs + (acc[ai][bj][m][n] - sr.x) * sr.y;
                        if (bad) o = (f32x4){qnan, qnan, qnan, qnan}; *(f32x4*)(out + off + bj * HALF + n * 16) = o; }
                if (m & 1) asm volatile("" ::: "memory"); }
    }
};
struct EpiLnResLn {
    static constexpr bool PERM = false, AFTER_DRAIN = true;
    const float* base; float* out; bf16_t* xn; int ldc; const float* bias; PanelStats st1, st2; unsigned poison;
    __device__ __forceinline__ void fused(f32x4 (&acc)[2][2][4][2], const Unit& u, int wr, int wc, int fr, int fq, PG8_LAS unsigned char* lds, int wid, int lane) const {
        typedef float f32x2v __attribute__((ext_vector_type(2))); typedef unsigned u32x2v __attribute__((ext_vector_type(2)));
        const PG8_LAS f32x2v* S = (const PG8_LAS f32x2v*)(lds + 8192);
        const int col0 = u.pn * BM + wc * 32 + 4 * fq;
#pragma unroll
        for (int bj = 0; bj < 2; ++bj)
#pragma unroll
            for (int n = 0; n < 2; ++n) { const f32x4 bv = bias ? *(const f32x4*)(bias + col0 + bj * HALF + n * 16) : (f32x4){0.f, 0.f, 0.f, 0.f};
#pragma unroll
                for (int ai = 0; ai < 2; ++ai)
#pragma unroll
                    for (int m = 0; m < 4; ++m) acc[ai][bj][m][n] += bv; }
        bool bad = st1.run(acc, u, wr, wc, fr, fq, lds, wid, lane) || poison != 0u;
        const float qnan = __builtin_nanf("");
#pragma unroll
        for (int ai = 0; ai < 2; ++ai)
#pragma unroll
            for (int m = 0; m < 4; ++m) { const int r = ai * HALF + wr * 64 + m * 16 + fr; const f32x2v sr = S[r]; const size_t off = (size_t)(u.pm * BM + r) * ldc + col0;
#pragma unroll
                for (int bj = 0; bj < 2; ++bj)
#pragma unroll
                    for (int n = 0; n < 2; ++n) { const f32x4 bs = *(const f32x4*)(base + off + bj * HALF + n * 16); acc[ai][bj][m][n] = bs + (acc[ai][bj][m][n] - sr.x) * sr.y; }
                asm volatile("" : "+v"(acc[ai][0][m][0]), "+v"(acc[ai][0][m][1]), "+v"(acc[ai][1][m][0]), "+v"(acc[ai][1][m][1]));
                if (m & 1) asm volatile("" ::: "memory"); }
        const bool bad1 = bad;
        bad = st2.run(acc, u, wr, wc, fr, fq, lds, wid, lane) || bad;
#pragma unroll
        for (int ai = 0; ai < 2; ++ai)
#pragma unroll
            for (int m = 0; m < 4; ++m) { const int r = ai * HALF + wr * 64 + m * 16 + fr; const f32x2v sr = S[r]; const size_t off = (size_t)(u.pm * BM + r) * ldc + col0;
#pragma unroll
                for (int bj = 0; bj < 2; ++bj)
#pragma unroll
                    for (int n = 0; n < 2; ++n) { const f32x4 x1 = acc[ai][bj][m][n]; *(f32x4*)(out + off + bj * HALF + n * 16) = bad1 ? (f32x4){qnan, qnan, qnan, qnan} : x1;
                        const f32x4 o = (x1 - sr.x) * sr.y; u32x2v w; w.x = cvt_pk_bf16(o[0], o[1]); w.y = cvt_pk_bf16(o[2], o[3]);
                        if (bad) { w.x = 0x7fc07fc0u; w.y = 0x7fc07fc0u; } *(u32x2v*)(xn + off + bj * HALF + n * 16) = w; }
                asm volatile("" ::: "memory"); }
    }
};

template <class Epi, class Sched, bool ALIGN_EPI = false, bool SP2 = false>
__device__ __forceinline__ void gemm_phase(PG8_LAS unsigned char* lds, const Gemm g, const Sched& S, const Epi& E) {
    int tid_ = threadIdx.x; asm volatile("" : "+v"(tid_));
    const int tid = tid_, wid = __builtin_amdgcn_readfirstlane(tid >> 6), lane = tid & 63, wr = wid >> 2, wc = wid & 3, fr = lane & 15, fq = lane >> 4;
    const int K = g.K, nt = K / BK;
    unsigned voffA[2], voffB[2];
#pragma unroll
    for (int i = 0; i < 2; ++i) { int R, C; stage_rc(tid * 16 + i * 8192, R, C); const int Rb = Epi::PERM ? ((R & ~31) + perm32(R & 31)) : R;
        voffA[i] = (unsigned)(R * g.lda + C) * 2u; voffB[i] = (unsigned)(Rb * K + C) * 2u; }
    const size_t kstep = (size_t)(BK * 2);
    const size_t hstepB = (size_t)HALF * K * 2, hstepA = (size_t)HALF * g.lda * 2;
    const size_t tstepB = 2 * hstepB, tstepA = 2 * hstepA;
    const unsigned ldsw = (unsigned)wid * 1024u;
    const int aoff = lds_byte(wr * 64 + fr, fq * 8), boff = lds_byte(wc * 32 + fr, fq * 8);
#define PG8_SA(b, h) (((b) * 2 + (h)) * HTB)
#define PG8_SB(b, h) ((4 + (b) * 2 + (h)) * HTB)
#define PG8_STAGE(bufoff, gbase, voff) do { _Pragma("unroll") for (int _i = 0; _i < 2; ++_i) \
        __builtin_amdgcn_global_load_lds((const unsigned*)((const char*)(gbase) + (voff)[_i]), (PG8_LAS unsigned*)(lds + (bufoff) + ldsw + _i * 8192), 16, 0, 0); } while (0)
#define PG8_LDA(dst, b, h) do { _Pragma("unroll") for (int m = 0; m < 4; ++m) _Pragma("unroll") for (int k = 0; k < 2; ++k) dst[m][k] = *(const PG8_LAS bf16x8*)(lds + PG8_SA(b, h) + aoff + m * 2048 + k * 1024); } while (0)
#define PG8_LDB(dst, b, h) do { _Pragma("unroll") for (int n = 0; n < 2; ++n) _Pragma("unroll") for (int k = 0; k < 2; ++k) dst[n][k] = *(const PG8_LAS bf16x8*)(lds + PG8_SB(b, h) + boff + n * 2048 + k * 1024); } while (0)
#define PG8_MMA(ai, bj, At, Bt) do { __builtin_amdgcn_s_setprio(1); _Pragma("unroll") for (int m = 0; m < 4; ++m) _Pragma("unroll") for (int n = 0; n < 2; ++n) _Pragma("unroll") for (int k = 0; k < 2; ++k) \
        acc[ai][bj][m][n] = __builtin_amdgcn_mfma_f32_16x16x32_bf16(Bt[n][k], At[m][k], acc[ai][bj][m][n], 0, 0, 0); __builtin_amdgcn_s_setprio(0); } while (0)
#define PG8_WAIT_V(n) asm volatile("s_waitcnt vmcnt(" #n ")" ::: "memory")
#define PG8_WAIT_L(n) asm volatile("s_waitcnt lgkmcnt(" #n ")" ::: "memory")
#define PG8_BAR __builtin_amdgcn_s_barrier()
#define PG8_SCHED __builtin_amdgcn_sched_barrier(0)
    Unit cur, nxt; int ui = 0;
    if (!S.next(0, cur)) return;
    f32x4 acc[2][2][4][2];
#pragma unroll
    for (int a = 0; a < 2; ++a)
#pragma unroll
        for (int b = 0; b < 2; ++b)
#pragma unroll
            for (int m = 0; m < 4; ++m)
#pragma unroll
                for (int n = 0; n < 2; ++n) acc[a][b][m][n] = (f32x4){0.f, 0.f, 0.f, 0.f};
    bf16x8 At[4][2], B0[2][2], B1[2][2];
    const char* cA = (const char*)g.A + (size_t)cur.pm * tstepA; const char* cB = (const char*)g.Bt + (size_t)cur.pn * tstepB;
    S.a_ready(cur);
    if constexpr (SP2) {
        PG8_STAGE(PG8_SB(0, 0), cB, voffB); PG8_STAGE(PG8_SB(0, 1), cB + hstepB, voffB); PG8_STAGE(PG8_SA(0, 0), cA, voffA); PG8_STAGE(PG8_SA(0, 1), cA + hstepA, voffA);
        if (wr == 1) PG8_BAR;
        PG8_WAIT_V(2); PG8_BAR;
        PG8_STAGE(PG8_SB(1, 0), cB + kstep, voffB); PG8_STAGE(PG8_SA(1, 0), cA + kstep, voffA); PG8_STAGE(PG8_SB(1, 1), cB + hstepB + kstep, voffB);
        PG8_WAIT_V(6); PG8_BAR;
    } else {
        PG8_STAGE(PG8_SB(0, 0), cB, voffB); PG8_STAGE(PG8_SA(0, 0), cA, voffA); PG8_STAGE(PG8_SB(0, 1), cB + hstepB, voffB); PG8_STAGE(PG8_SA(0, 1), cA + hstepA, voffA);
        if (wr == 1) PG8_BAR;
        PG8_WAIT_V(4); PG8_BAR;
        PG8_STAGE(PG8_SB(1, 0), cB + kstep, voffB); PG8_STAGE(PG8_SA(1, 0), cA + kstep, voffA); PG8_STAGE(PG8_SB(1, 1), cB + hstepB + kstep, voffB);
        PG8_WAIT_V(6); PG8_BAR;
    }
    for (;;) {
        const bool has_next = S.next(ui + 1, nxt);
        const char* nA = has_next ? (const char*)g.A + (size_t)nxt.pm * tstepA : cA; const char* nB = has_next ? (const char*)g.Bt + (size_t)nxt.pn * tstepB : cB;
        for (int t = 0; t < nt; t += 2) {
            const bool last = (t == nt - 2);
            const char* a1 = cA + (size_t)(t + 1) * kstep;
            const char* a2 = last ? nA : cA + (size_t)(t + 2) * kstep; const char* b2 = last ? nB : cB + (size_t)(t + 2) * kstep;
            const char* a3 = a2 + kstep; const char* b3 = b2 + kstep;
            if (last && has_next) S.a_ready(nxt);
            if constexpr (SP2) {
            PG8_LDB(B0, 0, 0); PG8_LDB(B1, 0, 1); PG8_SCHED; PG8_LDA(At, 0, 0); PG8_STAGE(PG8_SA(1, 1), a1 + hstepA, voffA);
            PG8_WAIT_V(8); PG8_WAIT_L(0); PG8_BAR; PG8_MMA(0, 0, At, B0); PG8_MMA(0, 1, At, B1); PG8_BAR; PG8_SCHED;
            PG8_LDA(At, 0, 1); PG8_STAGE(PG8_SB(0, 0), b2, voffB); PG8_STAGE(PG8_SB(0, 1), b2 + hstepB, voffB); PG8_STAGE(PG8_SA(0, 0), a2, voffA);
            PG8_WAIT_V(8); PG8_WAIT_L(0); PG8_BAR; PG8_MMA(1, 0, At, B0); PG8_MMA(1, 1, At, B1); PG8_BAR; PG8_SCHED;
            PG8_LDB(B0, 1, 0); PG8_LDB(B1, 1, 1); PG8_SCHED; PG8_LDA(At, 1, 0); PG8_STAGE(PG8_SA(0, 1), a2 + hstepA, voffA);
            PG8_WAIT_V(8); PG8_WAIT_L(0); PG8_BAR; PG8_MMA(0, 0, At, B0); PG8_MMA(0, 1, At, B1); PG8_BAR; PG8_SCHED;
            PG8_LDA(At, 1, 1); PG8_STAGE(PG8_SB(1, 0), b3, voffB); PG8_STAGE(PG8_SB(1, 1), b3 + hstepB, voffB); PG8_STAGE(PG8_SA(1, 0), a3, voffA);
            PG8_WAIT_V(8); PG8_WAIT_L(0); PG8_BAR; PG8_MMA(1, 0, At, B0); PG8_MMA(1, 1, At, B1); PG8_BAR; PG8_SCHED;
            } else {
            PG8_LDB(B0, 0, 0); PG8_SCHED; PG8_LDA(At, 0, 0); PG8_STAGE(PG8_SA(1, 1), a1 + hstepA, voffA);
            PG8_WAIT_L(8); PG8_BAR; PG8_WAIT_L(0); PG8_MMA(0, 0, At, B0); PG8_BAR; PG8_SCHED;
            PG8_LDB(B1, 0, 1); PG8_STAGE(PG8_SB(0, 0), b2, voffB);
            PG8_BAR; PG8_WAIT_L(0); PG8_MMA(0, 1, At, B1); PG8_BAR;
            PG8_LDA(At, 0, 1); PG8_STAGE(PG8_SA(0, 0), a2, voffA);
            PG8_BAR; PG8_WAIT_L(0); PG8_MMA(1, 0, At, B0); PG8_BAR; PG8_SCHED;
            PG8_STAGE(PG8_SB(0, 1), b2 + hstepB, voffB);
            PG8_WAIT_V(6); PG8_BAR; PG8_MMA(1, 1, At, B1); PG8_BAR;
            PG8_LDB(B0, 1, 0); PG8_SCHED; PG8_LDA(At, 1, 0); PG8_STAGE(PG8_SA(0, 1), a2 + hstepA, voffA);
            PG8_WAIT_L(8); PG8_BAR; PG8_WAIT_L(0); PG8_MMA(0, 0, At, B0); PG8_BAR; PG8_SCHED;
            PG8_LDB(B1, 1, 1); PG8_STAGE(PG8_SB(1, 0), b3, voffB);
            PG8_BAR; PG8_WAIT_L(0); PG8_MMA(0, 1, At, B1); PG8_BAR;
            PG8_LDA(At, 1, 1); PG8_STAGE(PG8_SA(1, 0), a3, voffA);
            PG8_BAR; PG8_WAIT_L(0); PG8_MMA(1, 0, At, B0); PG8_BAR; PG8_SCHED;
            PG8_STAGE(PG8_SB(1, 1), b3 + hstepB, voffB);
            PG8_WAIT_V(6); PG8_BAR; PG8_MMA(1, 1, At, B1); PG8_BAR;
            }
        }
        if constexpr (ALIGN_EPI) { if (wr == 0) PG8_BAR; }
        if constexpr (!Epi::AFTER_DRAIN) { E(acc, cur, wr, wc, fr, fq); S.done(cur); }
        if (!has_next) break;
#pragma unroll
        for (int a = 0; a < 2; ++a)
#pragma unroll
            for (int b = 0; b < 2; ++b)
#pragma unroll
                for (int m = 0; m < 4; ++m)
#pragma unroll
                    for (int n = 0; n < 2; ++n) acc[a][b][m][n] = (f32x4){0.f, 0.f, 0.f, 0.f};
        cur = nxt; cA = nA; cB = nB; ++ui;
        if constexpr (ALIGN_EPI) { if (wr == 1) PG8_BAR; }
    }
    PG8_WAIT_V(0);
    if constexpr (!ALIGN_EPI) { if (wr == 0) PG8_BAR; }
    PG8_BAR;
    if constexpr (Epi::AFTER_DRAIN) { E.fused(acc, cur, wr, wc, fr, fq, lds, wid, lane); S.done(cur); }
#undef PG8_SA
#undef PG8_SB
#undef PG8_STAGE
#undef PG8_LDA
#undef PG8_LDB
#undef PG8_MMA
#undef PG8_WAIT_V
#undef PG8_WAIT_L
#undef PG8_BAR
#undef PG8_SCHED
}
}

#ifndef PG8_SP2
#define PG8_SP2 true
#endif
#ifndef PG8_ALIGN
#define PG8_ALIGN true
#endif
namespace pg8 {
typedef unsigned u32x2e __attribute__((ext_vector_type(2)));
__device__ __forceinline__ float bfbits2f(unsigned b16) { return __uint_as_float(b16 << 16); }
__device__ __forceinline__ void unpack8(const u32x4 w, float (&f)[8]) {
    f[0] = __uint_as_float(w.x << 16); f[1] = __uint_as_float(w.x & 0xffff0000u); f[2] = __uint_as_float(w.y << 16); f[3] = __uint_as_float(w.y & 0xffff0000u);
    f[4] = __uint_as_float(w.z << 16); f[5] = __uint_as_float(w.z & 0xffff0000u); f[6] = __uint_as_float(w.w << 16); f[7] = __uint_as_float(w.w & 0xffff0000u);
}
__device__ __forceinline__ u32x4 pack8f(const float (&f)[8]) { u32x4 w; w.x = cvt_pk_bf16(f[0], f[1]); w.y = cvt_pk_bf16(f[2], f[3]); w.z = cvt_pk_bf16(f[4], f[5]); w.w = cvt_pk_bf16(f[6], f[7]); return w; }
__device__ __forceinline__ float sigmoid_f(float x) { return __builtin_amdgcn_rcpf(1.f + __builtin_amdgcn_exp2f(-1.4426950408889634f * x)); }

struct EpiProj {
    static constexpr bool PERM = true, AFTER_DRAIN = false;
    bf16_t* O; int ldc;
    __device__ __forceinline__ void operator()(const f32x4 (&acc)[2][2][4][2], const Unit& u, int wr, int wc, int fr, int fq) const {
        const int row0 = u.pm * BM + wr * 64 + fr, col0 = u.pn * BM + wc * 32 + 8 * fq;
        const int act = u.pn < 24 ? 0 : (u.pn < 28 ? 1 : 2);
#pragma unroll
        for (int ai = 0; ai < 2; ++ai)
#pragma unroll
            for (int m = 0; m < 4; ++m) { bf16_t* rowp = O + (size_t)(row0 + ai * HALF + m * 16) * ldc + col0;
#pragma unroll
                for (int bj = 0; bj < 2; ++bj) { float v[8];
#pragma unroll
                    for (int i = 0; i < 4; ++i) { v[i] = acc[ai][bj][m][0][i]; v[4 + i] = acc[ai][bj][m][1][i]; }
                    if (act != 0) {
#pragma unroll
                        for (int i = 0; i < 8; ++i) { const float s = sigmoid_f(v[i]); v[i] = (act == 1) ? v[i] * s : s; } }
                    *(u32x4*)(rowp + bj * HALF) = pack8f(v); } }
    }
};
struct EpiRowScale {
    static constexpr bool PERM = true, AFTER_DRAIN = false;
    bf16_t* O; int ldc; const float* rowss; float inv_n, eps;
    __device__ __forceinline__ void operator()(const f32x4 (&acc)[2][2][4][2], const Unit& u, int wr, int wc, int fr, int fq) const {
        const int row0 = u.pm * BM + wr * 64 + fr, col0 = u.pn * BM + wc * 32 + 8 * fq;
#pragma unroll
        for (int ai = 0; ai < 2; ++ai)
#pragma unroll
            for (int m = 0; m < 4; ++m) { const int row = row0 + ai * HALF + m * 16; bf16_t* rowp = O + (size_t)row * ldc + col0;
                float sc = 1.f; if (rowss) sc = 1.f / sqrtf(__hip_atomic_load(rowss + row, __ATOMIC_RELAXED, __HIP_MEMORY_SCOPE_AGENT) * inv_n + eps);
#pragma unroll
                for (int bj = 0; bj < 2; ++bj) { float v[8];
#pragma unroll
                    for (int i = 0; i < 4; ++i) { v[i] = acc[ai][bj][m][0][i] * sc; v[4 + i] = acc[ai][bj][m][1][i] * sc; }
                    *(u32x4*)(rowp + bj * HALF) = pack8f(v); } }
    }
};
template <bool ADD> struct EpiGate {
    static constexpr bool PERM = true, AFTER_DRAIN = false;
    bf16_t* O; int ldc; const bf16_t* Gt; int ldg;
    __device__ __forceinline__ void operator()(const f32x4 (&acc)[2][2][4][2], const Unit& u, int wr, int wc, int fr, int fq) const {
        const int row0 = u.pm * BM + wr * 64 + fr, col0 = u.pn * BM + wc * 32 + 8 * fq;
#pragma unroll
        for (int ai = 0; ai < 2; ++ai)
#pragma unroll
            for (int m = 0; m < 4; ++m) { const int row = row0 + ai * HALF + m * 16; bf16_t* rowp = O + (size_t)row * ldc + col0; const bf16_t* gp = Gt + (size_t)row * ldg + col0;
#pragma unroll
                for (int bj = 0; bj < 2; ++bj) { float v[8], g[8]; unpack8(*(const u32x4*)(gp + bj * HALF), g);
#pragma unroll
                    for (int i = 0; i < 4; ++i) { v[i] = acc[ai][bj][m][0][i] * g[i]; v[4 + i] = acc[ai][bj][m][1][i] * g[4 + i]; }
                    if (ADD) { float t[8]; unpack8(*(const u32x4*)(rowp + bj * HALF), t);
#pragma unroll
                        for (int i = 0; i < 8; ++i) v[i] += t[i]; }
                    *(u32x4*)(rowp + bj * HALF) = pack8f(v); } }
    }
};
struct EpiResid {
    static constexpr bool PERM = true, AFTER_DRAIN = false;
    const float* base; float* out; bf16_t* XB; int ldc; float* rowss;
    __device__ __forceinline__ void operator()(const f32x4 (&acc)[2][2][4][2], const Unit& u, int wr, int wc, int fr, int fq) const {
        const int row0 = u.pm * BM + wr * 64 + fr, col0 = u.pn * BM + wc * 32 + 8 * fq;
#pragma unroll
        for (int ai = 0; ai < 2; ++ai)
#pragma unroll
            for (int m = 0; m < 4; ++m) { const int row = row0 + ai * HALF + m * 16; const size_t off = (size_t)row * ldc + col0; float ss = 0.f;
#pragma unroll
                for (int bj = 0; bj < 2; ++bj) { const f32x4 b0 = *(const f32x4*)(base + off + bj * HALF), b1 = *(const f32x4*)(base + off + bj * HALF + 4);
                    const f32x4 x0 = b0 + acc[ai][bj][m][0], x1 = b1 + acc[ai][bj][m][1];
                    *(f32x4*)(out + off + bj * HALF) = x0; *(f32x4*)(out + off + bj * HALF + 4) = x1;
                    ss += (x0[0] * x0[0] + x0[1] * x0[1]) + (x0[2] * x0[2] + x0[3] * x0[3]) + (x1[0] * x1[0] + x1[1] * x1[1]) + (x1[2] * x1[2] + x1[3] * x1[3]);
                    u32x4 w; w.x = cvt_pk_bf16(x0[0], x0[1]); w.y = cvt_pk_bf16(x0[2], x0[3]); w.z = cvt_pk_bf16(x1[0], x1[1]); w.w = cvt_pk_bf16(x1[2], x1[3]);
                    *(u32x4*)(XB + off + bj * HALF) = w; }
                ss += __shfl_xor(ss, 16); ss += __shfl_xor(ss, 32);
                if (fq == 0) atomicAdd(rowss + row, ss); }
    }
};
struct EpiAny {
    static constexpr bool PERM = true, AFTER_DRAIN = false;
    int kind; bf16_t* O; int ldc; const bf16_t* Gt; int ldg; const float* base; float* out; float* rowss; const float* rowss_in;
    __device__ __forceinline__ void operator()(const f32x4 (&acc)[2][2][4][2], const Unit& u, int wr, int wc, int fr, int fq) const {
        if (kind == 0) { EpiProj e{O, ldc}; e(acc, u, wr, wc, fr, fq); }
        else if (kind == 1) { EpiRowScale e{O, ldc, rowss_in, 1.f / 2048.f, 1e-6f}; e(acc, u, wr, wc, fr, fq); }
        else if (kind == 2) { EpiGate<false> e{O, ldc, Gt, ldg}; e(acc, u, wr, wc, fr, fq); }
        else if (kind == 3) { EpiGate<true> e{O, ldc, Gt, ldg}; e(acc, u, wr, wc, fr, fq); }
        else { EpiResid e{base, out, O, ldc, rowss}; e(acc, u, wr, wc, fr, fq); }
    }
};
}
namespace att {
using bf16 = unsigned short;
typedef short bf16x8 __attribute__((ext_vector_type(8)));
typedef short s16x4 __attribute__((ext_vector_type(4)));
typedef float f32x16 __attribute__((ext_vector_type(16)));
typedef float f32x4 __attribute__((ext_vector_type(4)));
typedef unsigned u32x4 __attribute__((ext_vector_type(4)));
constexpr int D = 128, NW = 8, QBLK = 32, KVBLK = 64, QB = NW * QBLK;
constexpr int SHM_V = KVBLK * D * 2, SHM_K = KVBLK * D * 2;
constexpr int LDS_WS = 2 * SHM_V + 2 * SHM_K;
constexpr int LDS_BIAS = LDS_WS + NW * 64 * 4;
constexpr int LDS_Q = LDS_BIAS + 2048 * 4;
constexpr int LDS_BYTES = LDS_Q + NW * 8192;
constexpr float THR = 8.f;

#define KSWZ(row, colB) ((row) * 256 + ((colB) ^ (((row) & 7) << 4)))
#define SBAR() __builtin_amdgcn_sched_barrier(0)
__device__ __forceinline__ int v_st(int k, int c) { const int kk = (k & ~0xC) | ((k & 4) << 1) | ((k & 8) >> 1); return ((kk >> 3) * 4 + (c >> 5)) * 512 + ((kk & 7) * 32 + (c & 31)) * 2; }
__device__ __forceinline__ int v_rd_base(int lane) { return ((lane & 3) << 3) | (((lane >> 2) & 3) << 6) | (((lane >> 4) & 1) << 5) | (((lane >> 5) & 1) << 8); }
constexpr int v_rd_off(int d0, int ks, int half) { return d0 * 512 + ks * 4096 + half * 2048; }
__device__ __forceinline__ int crow(int r, int hi) { return (r & 3) + 8 * (r >> 2) + 4 * hi; }
__device__ __forceinline__ unsigned cvtpk(float lo, float hi) { unsigned r; asm volatile("v_cvt_pk_bf16_f32 %0, %1, %2" : "=v"(r) : "v"(lo), "v"(hi)); return r; }
__device__ __forceinline__ bf16x8 load8(const bf16* p) { return *reinterpret_cast<const bf16x8*>(p); }
__device__ __forceinline__ float bf2f(unsigned short b) { return __uint_as_float((unsigned)b << 16); }

__device__ __forceinline__ void mask_tile(f32x16& p0, f32x16& p1, int dq) {
    const float NEG = -__builtin_inff();
#pragma unroll
    for (int r = 0; r < 16; ++r) {
        const int c = (r & 3) + 8 * (r >> 2);
        if (dq - c < 0) p0[r] = NEG;
        if (dq - c - 32 < 0) p1[r] = NEG;
    }
}
__device__ __forceinline__ void partialSM(f32x16& p0, f32x16& p1, float& m_reg, float& mn, float& alpha) {
    float pmax = p0[0]; for (int r = 1; r < 16; ++r) pmax = fmaxf(pmax, p0[r]); for (int r = 0; r < 16; ++r) pmax = fmaxf(pmax, p1[r]);
    { auto rr = __builtin_amdgcn_permlane32_swap(__float_as_uint(pmax), __float_as_uint(pmax), false, false);
      pmax = fmaxf(__uint_as_float(rr[0]), __uint_as_float(rr[1])); }
    if (__builtin_expect(__all((pmax - m_reg) <= THR), 1)) { mn = m_reg; alpha = 1.f; }
    else { mn = fmaxf(m_reg, pmax); alpha = __builtin_amdgcn_exp2f(m_reg - mn); m_reg = mn; }
    for (int r = 0; r < 16; ++r) p0[r] = p0[r] - mn; for (int r = 0; r < 16; ++r) p1[r] = p1[r] - mn;
    for (int r = 0; r < 16; ++r) p0[r] = __builtin_amdgcn_exp2f(p0[r]);
}
#define ATT_PK4(P, B_, OUT) do { unsigned a0 = cvtpk(P[B_+0], P[B_+1]), a1 = cvtpk(P[B_+2], P[B_+3]);                          \
        unsigned b0 = cvtpk(P[B_+4], P[B_+5]), b1 = cvtpk(P[B_+6], P[B_+7]);                                             \
        auto r0 = __builtin_amdgcn_permlane32_swap(a0, b0, false, false); auto r1 = __builtin_amdgcn_permlane32_swap(a1, b1, false, false); \
        u32x4 w = {r0[0], r1[0], r0[1], r1[1]}; OUT = *reinterpret_cast<bf16x8*>(&w); } while (0)
__device__ __forceinline__ void finishSM(f32x16& p0, f32x16& p1, float alpha, float& l_reg, bf16x8& pa0, bf16x8& pa1, bf16x8& pa2, bf16x8& pa3) {
    for (int r = 0; r < 16; ++r) p1[r] = __builtin_amdgcn_exp2f(p1[r]);
    float ps = 0; for (int r = 0; r < 16; ++r) ps += p0[r]; for (int r = 0; r < 16; ++r) ps += p1[r];
    { auto rr = __builtin_amdgcn_permlane32_swap(__float_as_uint(ps), __float_as_uint(ps), false, false);
      ps = __uint_as_float(rr[0]) + __uint_as_float(rr[1]); }
    l_reg = l_reg * alpha + ps;
    ATT_PK4(p0, 0, pa0); ATT_PK4(p0, 8, pa1); ATT_PK4(p1, 0, pa2); ATT_PK4(p1, 8, pa3);
}
__device__ __forceinline__ void ret_weight(f32x16& p0, f32x16& p1, int dq, float lg, bool act) {
    if (!act) { p0 = f32x16{}; p1 = f32x16{}; return; }
#pragma unroll
    for (int r = 0; r < 16; ++r) {
        const int c = (r & 3) + 8 * (r >> 2);
        const float e0 = lg * fabsf((float)(dq - c)), e1 = lg * fabsf((float)(dq - c - 32));
        p0[r] *= __builtin_amdgcn_exp2f(e0); p1[r] *= __builtin_amdgcn_exp2f(e1);
    }
}
__device__ __forceinline__ void ret_pack(f32x16& p0, f32x16& p1, bf16x8& pa0, bf16x8& pa1, bf16x8& pa2, bf16x8& pa3) {
    ATT_PK4(p0, 0, pa0); ATT_PK4(p0, 8, pa1); ATT_PK4(p1, 0, pa2); ATT_PK4(p1, 8, pa3);
}
template <int KB, bool BIAS>
__device__ __forceinline__ void qkt(f32x16& p0, f32x16& p1, const char* K_lds, int r32, int hi, const char* Qw  , const float* bias_tile  ) {
    if (BIAS) {
#pragma unroll
        for (int g = 0; g < 4; ++g) { const f32x4 b0 = *(const f32x4*)(bias_tile + 8 * g), b1 = *(const f32x4*)(bias_tile + 32 + 8 * g);
            p0[4 * g] = b0[0]; p0[4 * g + 1] = b0[1]; p0[4 * g + 2] = b0[2]; p0[4 * g + 3] = b0[3];
            p1[4 * g] = b1[0]; p1[4 * g + 1] = b1[1]; p1[4 * g + 2] = b1[2]; p1[4 * g + 3] = b1[3]; }
    } else { p0 = f32x16{}; p1 = f32x16{}; }
    int ko[4];
#pragma unroll
    for (int dd = 0; dd < 4; ++dd) ko[dd] = KSWZ(r32, (dd * 16 + hi * 8) * 2);
#pragma unroll
    for (int d0 = 0; d0 < 8; ++d0) { const char* a = K_lds + KB * SHM_K + ko[d0 & 3] + (d0 >> 2) * 128;
        bf16x8 b0 = *reinterpret_cast<const bf16x8*>(a);
        bf16x8 b1 = *reinterpret_cast<const bf16x8*>(a + 32 * 256);
        bf16x8 q = *reinterpret_cast<const bf16x8*>(Qw + ko[d0 & 3] + (d0 >> 2) * 128);
        p0 = __builtin_amdgcn_mfma_f32_32x32x16_bf16(b0, q, p0, 0, 0, 0);
        p1 = __builtin_amdgcn_mfma_f32_32x32x16_bf16(b1, q, p1, 0, 0, 0); }
}
template <int VB>
__device__ __forceinline__ void pv_tile(f32x16* o, int vb0, bf16x8 pa0, bf16x8 pa1, bf16x8 pa2, bf16x8 pa3) {
#define TRRD(dst, off) asm volatile("ds_read_b64_tr_b16 %0, %1 offset:%2" : "=&v"(dst) : "v"(vb0), "i"(off) : "memory")
#define PV_D0(d0) do { s16x4 l0, l1, l2, l3, h0, h1, h2, h3; constexpr int b_ = VB * SHM_V + v_rd_off(d0, 0, 0); \
        TRRD(l0, b_); TRRD(h0, b_ + 2048); TRRD(l1, b_ + 4096); TRRD(h1, b_ + 6144); TRRD(l2, b_ + 8192); TRRD(h2, b_ + 10240); TRRD(l3, b_ + 12288); TRRD(h3, b_ + 14336); \
        asm volatile("s_waitcnt lgkmcnt(0)" ::: "memory"); SBAR();   \
        o[d0] = __builtin_amdgcn_mfma_f32_32x32x16_bf16(pa0, (bf16x8){l0[0], l0[1], l0[2], l0[3], h0[0], h0[1], h0[2], h0[3]}, o[d0], 0, 0, 0);   \
        o[d0] = __builtin_amdgcn_mfma_f32_32x32x16_bf16(pa1, (bf16x8){l1[0], l1[1], l1[2], l1[3], h1[0], h1[1], h1[2], h1[3]}, o[d0], 0, 0, 0);   \
        o[d0] = __builtin_amdgcn_mfma_f32_32x32x16_bf16(pa2, (bf16x8){l2[0], l2[1], l2[2], l2[3], h2[0], h2[1], h2[2], h2[3]}, o[d0], 0, 0, 0);   \
        o[d0] = __builtin_amdgcn_mfma_f32_32x32x16_bf16(pa3, (bf16x8){l3[0], l3[1], l3[2], l3[3], h3[0], h3[1], h3[2], h3[3]}, o[d0], 0, 0, 0); } while (0)
    PV_D0(0); PV_D0(1); PV_D0(2); PV_D0(3);
#undef PV_D0
#undef TRRD
}

struct BlockRef { const bf16* Q; const bf16* K; const bf16* V; bf16* O; int P0; int skv; float lg; const bf16* RG; const float* GN; };
struct Seam { bf16x8 qr[8]; bf16x8 st_v0, st_v1, st_k0, st_k1; };
template <int MODE> struct Pitch { static constexpr int LDQ = (MODE == 2) ? 512 : 11264, LDK = (MODE == 2) ? 1024 : 11264, LDO = LDQ; };

#define ROWK(p, k0, rr) ((p) + (size_t)((k0) + (rr)) * LDK + sc)
#define VMW() asm volatile("s_waitcnt vmcnt(0)" ::: "memory")
#define VMWN(n) asm volatile("s_waitcnt vmcnt(%0)" :: "i"(n) : "memory")
#define SLOAD_H(Kp, Vp, k0) do { S.st_v0 = load8(ROWK(Vp, k0, sr)); S.st_v1 = load8(ROWK(Vp, k0, 32 + sr));              \
                         S.st_k0 = load8(ROWK(Kp, k0, sr)); S.st_k1 = load8(ROWK(Kp, k0, 32 + sr)); } while (0)
#define SWRITE_HK(bf) do { *(bf16x8*)(K_lds + (bf) * SHM_K + kws) = S.st_k0; *(bf16x8*)(K_lds + (bf) * SHM_K + kws + 32 * 256) = S.st_k1; } while (0)
#define SWRITE_HV(bf) do { *(bf16x8*)(V_lds + (bf) * SHM_V + vst0) = S.st_v0; *(bf16x8*)(V_lds + (bf) * SHM_V + vst1) = S.st_v1; } while (0)
#define SWRITE_H(bf) do { SWRITE_HV(bf); SWRITE_HK(bf); } while (0)

template <int MODE>
__device__ __forceinline__ void attn_prime(const BlockRef& cur, char* lds, Seam& S) {
    constexpr int LDQ = Pitch<MODE>::LDQ, LDK = Pitch<MODE>::LDK;
    int tid_ = threadIdx.x; asm volatile("" : "+v"(tid_));
    const int tid = tid_, wid = __builtin_amdgcn_readfirstlane(tid >> 6), lane = tid & 63, r32 = lane & 31, hi = lane >> 5;
    const int sr = tid >> 4, sc = (tid & 15) * 8, kws = KSWZ(sr, sc * 2); char* K_lds = lds + 2 * SHM_V;
    const int kb0 = 0;
    for (int d0 = 0; d0 < 8; ++d0) S.qr[d0] = load8(cur.Q + (size_t)(wid * QBLK + r32) * LDQ + d0 * 16 + hi * 8);
    SLOAD_H(cur.K, cur.V, kb0); VMW(); SWRITE_HK(0);
    __syncthreads();
}
template <int MODE>
__device__ __forceinline__ void attn_block(const BlockRef& cur, const BlockRef& nxt, char* lds, Seam& S) {
    constexpr int LDQ = Pitch<MODE>::LDQ, LDK = Pitch<MODE>::LDK, LDO = Pitch<MODE>::LDO;
    constexpr bool BIAS = (MODE == 0), SOFTMAX = (MODE != 1);
    int tid_ = threadIdx.x; asm volatile("" : "+v"(tid_));
    const int tid = tid_, wid = __builtin_amdgcn_readfirstlane(tid >> 6), lane = tid & 63, r32 = lane & 31, hi = lane >> 5;
    const int j_lo = 0;
    int j_hi = (cur.P0 + QB - 1) / KVBLK + 1; if (j_hi > cur.skv / KVBLK) j_hi = cur.skv / KVBLK;
    const int NT = j_hi - j_lo;
    const int kbn = 0;
    const int qlo = cur.P0 + wid * QBLK, qm = qlo + r32 - 4 * hi;
    char* V_lds = lds; char* K_lds = lds + 2 * SHM_V;
    float* ws = (float*)(lds + LDS_WS) + wid * 64; float* li_l = ws, * al_l = ws + 32;
    const float* bias = (const float*)(lds + LDS_BIAS) + 4 * hi;
    float m_reg = -1e30f, l_reg = 0; f32x16 o[4] = {};
    const int sr = tid >> 4, sc = (tid & 15) * 8, vst0 = v_st(sr, sc), vst1 = v_st(32 + sr, sc), kws = KSWZ(sr, sc * 2);
    const int vb0 = (int)(uintptr_t)V_lds + v_rd_base(lane);
    const bf16* Kh = cur.K; const bf16* Vh = cur.V;
    const float lg = cur.lg; const int cq = qlo >> 6;
#define RESC(a) do { if (SOFTMAX) { if (__any((a) < 1.f)) { if (hi == 0) al_l[r32] = (a); asm volatile("s_waitcnt lgkmcnt(0)" ::: "memory");              \
                     for (int d_ = 0; d_ < 4; ++d_) for (int r = 0; r < 16; ++r) o[d_][r] *= al_l[crow(r, hi)]; } } } while (0)
#define KBASE(t) ((j_lo + (t)) * KVBLK)
#define POSTQK(P0_, P1_, mnX, alX, t) do { const int kb_ = KBASE(t); \
        if (MODE == 1) { ret_weight(P0_, P1_, qm - kb_, lg, (j_lo + (t)) <= cq); } \
        else { if (MODE == 0 && (kb_ + KVBLK - 1 > qlo)) mask_tile(P0_, P1_, qm - kb_); partialSM(P0_, P1_, m_reg, mnX, alX); } } while (0)
#define FINISH(P0_, P1_, alX) do { if (MODE == 1) ret_pack(P0_, P1_, pa0, pa1, pa2, pa3); else finishSM(P0_, P1_, alX, l_reg, pa0, pa1, pa2, pa3); } while (0)
    constexpr int NQL = 8;
#define SEAM_K0() do { VMWN(NQL); SWRITE_HK(0); SBAR(); } while (0)
    f32x16 pA0, pA1, pB0, pB1; float mnA = 0.f, mnB = 0.f, alA = 1.f, alB = 1.f; bf16x8 pa0, pa1, pa2, pa3;
    char* Qw = lds + LDS_Q + wid * 8192;
#pragma unroll
    for (int d0 = 0; d0 < 8; ++d0) *(bf16x8*)(Qw + KSWZ(r32, (d0 * 16 + hi * 8) * 2)) = S.qr[d0];
    SWRITE_HV(0); SBAR();
    if (NT > 1) { SLOAD_H(Kh, Vh, KBASE(1)); }
    SBAR(); qkt<0, BIAS>(pA0, pA1, K_lds, r32, hi, Qw, bias + KBASE(0));
    POSTQK(pA0, pA1, mnA, alA, 0);
    if (NT > 1) { VMW(); SWRITE_H(1); }
    __syncthreads();
#define HALF_STEP(PX0, PX1, mnX, alX, PY0, PY1, alY, t, KB, VB, SB) do {                                                      \
        SBAR(); qkt<KB, BIAS>(PX0, PX1, K_lds, r32, hi, Qw, bias + KBASE(t));                                             \
        FINISH(PY0, PY1, alY); SBAR();                                                           \
        if ((t) + 1 < NT) { SLOAD_H(Kh, Vh, KBASE((t) + 1)); SBAR(); }                                               \
        pv_tile<VB>(o, vb0, pa0, pa1, pa2, pa3); POSTQK(PX0, PX1, mnX, alX, (t));                                        \
        __syncthreads();                                                                                                      \
        if ((t) + 1 < NT) { VMW(); SWRITE_H(SB); }                                                                          \
        RESC(alX); __syncthreads(); } while (0)
    for (int t = 1; t + 1 < NT; t += 2) {
        HALF_STEP(pB0, pB1, mnB, alB, pA0, pA1, alA, t, 1, 0, 0);
        HALF_STEP(pA0, pA1, mnA, alA, pB0, pB1, alB, t + 1, 0, 1, 1);
    }
    const bool even = (NT & 1) == 0;
    if (even) { SBAR(); qkt<1, BIAS>(pB0, pB1, K_lds, r32, hi, Qw, bias + KBASE(NT - 1)); SBAR(); }
    { constexpr int LDQn = LDQ; SLOAD_H(nxt.K, nxt.V, kbn); SBAR();
#pragma unroll
      for (int d0 = 0; d0 < 8; ++d0) S.qr[d0] = load8(nxt.Q + (size_t)(wid * QBLK + r32) * LDQn + d0 * 16 + hi * 8); }
    SBAR();
    FINISH(pA0, pA1, alA); SBAR();
    pv_tile<0>(o, vb0, pa0, pa1, pa2, pa3);
    if (even) { POSTQK(pB0, pB1, mnB, alB, NT - 1); __syncthreads(); RESC(alB);
        FINISH(pB0, pB1, alB); SBAR(); pv_tile<1>(o, vb0, pa0, pa1, pa2, pa3); }
    SBAR(); SEAM_K0();
    bf16* Ow = cur.O + (size_t)(wid * QBLK) * LDO;
    if (MODE != 1) {
        if (hi == 0) li_l[r32] = l_reg; asm volatile("s_waitcnt lgkmcnt(0)" ::: "memory");
        float rli[16];
#pragma unroll
        for (int r = 0; r < 16; ++r) rli[r] = __builtin_amdgcn_rcpf(li_l[crow(r, hi)]);
#pragma unroll
        for (int r = 0; r < 16; ++r) { const int orow = crow(r, hi);
#pragma unroll
            for (int d0 = 0; d0 < 4; ++d0) { const float v = o[d0][r] * rli[r];
                const float vn = __shfl_xor(v, 1);
                if ((r32 & 1) == 0) *(unsigned*)(Ow + (size_t)orow * LDO + d0 * 32 + r32) = cvtpk(v, vn); } }
    } else {
        float gn[4];
#pragma unroll
        for (int d0 = 0; d0 < 4; ++d0) gn[d0] = cur.GN[d0 * 32 + r32];
        const bf16* RGw = cur.RG + (size_t)(wid * QBLK) * LDO;
#pragma unroll
        for (int r = 0; r < 16; ++r) { const int orow = crow(r, hi);
            float s = (o[0][r] + o[1][r]) + (o[2][r] + o[3][r]);
#pragma unroll
            for (int x = 1; x < 32; x <<= 1) s += __shfl_xor(s, x);
            const float mean = s * (1.f / 128.f);
            float q = 0.f;
#pragma unroll
            for (int d0 = 0; d0 < 4; ++d0) { const float dlt = o[d0][r] - mean; q += dlt * dlt; }
#pragma unroll
            for (int x = 1; x < 32; x <<= 1) q += __shfl_xor(q, x);
            const float rstd = 1.f / sqrtf(q * (1.f / 128.f) + 1e-6f);
#pragma unroll
            for (int d0 = 0; d0 < 4; ++d0) { const float g = bf2f(RGw[(size_t)orow * LDO + d0 * 32 + r32]);
                const float v = (o[d0][r] - mean) * rstd * gn[d0] * g;
                const float vn = __shfl_xor(v, 1);
                if ((r32 & 1) == 0) *(unsigned*)(Ow + (size_t)orow * LDO + d0 * 32 + r32) = cvtpk(v, vn); } }
    }
    __syncthreads();
#undef RESC
#undef KBASE
#undef POSTQK
#undef FINISH
#undef SEAM_K0
#undef HALF_STEP
}
#undef ROWK
#undef VMW
#undef VMWN
#undef SLOAD_H
#undef SWRITE_HK
#undef SWRITE_HV
#undef SWRITE_H
#undef SBAR
#undef KSWZ
#undef ATT_PK4
}
#define GAS __attribute__((address_space(1)))
#define LAS __attribute__((address_space(3)))
typedef unsigned short bf16;
typedef unsigned v4u __attribute__((ext_vector_type(4)));
typedef float f32x4 __attribute__((ext_vector_type(4)));
typedef short bf16x8 __attribute__((ext_vector_type(8)));
typedef GAS unsigned gu32;
typedef GAS unsigned long long gu64;
#define RLX_AGENT __ATOMIC_RELAXED, __HIP_MEMORY_SCOPE_AGENT
#define LDS_WAIT() asm volatile("s_waitcnt lgkmcnt(0)" ::: "memory")
#define VM_WAIT() asm volatile("s_waitcnt vmcnt(0)" ::: "memory")
__device__ __forceinline__ unsigned long long rt() { return __builtin_amdgcn_s_memrealtime(); }
__device__ __forceinline__ unsigned f2bf(float f) { unsigned u = __builtin_bit_cast(unsigned, f); return (u + 0x7fffu + ((u >> 16) & 1u)) >> 16; }
__device__ __forceinline__ unsigned pk2(float lo, float hi) { return f2bf(lo) | (f2bf(hi) << 16); }

#define XB_TMO      128
#define XB_XCNT(j)  (256  + 64 * (j))
#define XB_XSUB(j)  (1280 + 64 * (j))
#define XB_XGEN(j)  (2304 + 64 * (j))
#define XB_TOP      3328
#define XB_TOPGEN   3392
#define XCD_BAR_WORDS 3456
#define XB_SPIN_CAP (1u << 18)

__device__ __forceinline__ unsigned xb_ld(unsigned* p)              { return __hip_atomic_load(p, __ATOMIC_RELAXED, __HIP_MEMORY_SCOPE_AGENT); }
__device__ __forceinline__ unsigned xb_add(unsigned* p, unsigned v) { return __hip_atomic_fetch_add(p, v, __ATOMIC_RELAXED, __HIP_MEMORY_SCOPE_AGENT); }
__device__ __forceinline__ unsigned xb_xcc_id() { return (unsigned)__builtin_amdgcn_s_getreg((3 << 11) | 20) & 0xFu; }
#define XB_SPIN(cond, bar) do { unsigned _sp = 0; while (cond) { __builtin_amdgcn_s_sleep(1); \
    if ((++_sp & 255u) == 0u) { if (xb_ld(&(bar)[XB_TMO])) break; if (_sp > XB_SPIN_CAP) { atomicAdd(&(bar)[XB_TMO], 1u); break; } } } } while (0)

struct XcdBarrier {
    unsigned* bar; unsigned x;
    volatile LAS unsigned* st;
};

__device__ __forceinline__ XcdBarrier xcd_barrier_post(unsigned* bar, volatile LAS unsigned* st) {
    XcdBarrier b; b.bar = bar; b.x = xb_xcc_id(); b.st = st;
    if (threadIdx.x == 0) (void)xb_add(&bar[XB_XCNT(b.x)], 1u);
    return b;
}
__device__ __forceinline__ void xcd_barrier_complete(unsigned* bar, unsigned x, unsigned& nloc, unsigned& nx) {
    const unsigned G = gridDim.x * gridDim.y * gridDim.z;
    unsigned sum, cnt, mine, sp = 0u;
    for (;;) {
        sum = 0u; cnt = 0u; mine = 0u;
#pragma unroll
        for (unsigned j = 0; j < 16; ++j) { const unsigned c = xb_ld(&bar[XB_XCNT(j)]); sum += c; cnt += (c > 0u) ? 1u : 0u; mine = (j == x) ? c : mine; }
        if (sum == G) break;
        __builtin_amdgcn_s_sleep(1);
        if ((++sp & 255u) == 0u) { if (xb_ld(&bar[XB_TMO])) break; if (sp > XB_SPIN_CAP) { atomicAdd(&bar[XB_TMO], 1u); break; } }
    }
    nloc = mine > 0u ? mine : 1u; nx = cnt > 0u ? cnt : 1u;
}

__device__ __forceinline__ void xcd_barrier(const XcdBarrier& b) {
    asm volatile("s_waitcnt vmcnt(0)" ::: "memory");
    __syncthreads();
    if (threadIdx.x == 0) {
        unsigned* bar = b.bar;
        __builtin_amdgcn_s_waitcnt(0);
        unsigned nloc = b.st[0], nx = b.st[1];
        if (nloc == 0u) { xcd_barrier_complete(bar, b.x, nloc, nx); b.st[0] = nloc; b.st[1] = nx; }
        const unsigned old = xb_add(&bar[XB_XSUB(b.x)], 1u);
        const unsigned gen = old / nloc;
        if (old + 1u == (gen + 1u) * nloc) {
            __builtin_amdgcn_fence(__ATOMIC_RELEASE, "agent");
            asm volatile("s_waitcnt vmcnt(0)" ::: "memory");
            const unsigned og = xb_add(&bar[XB_TOP], 1u);
            const unsigned tg = og / nx;
            if (og + 1u == (tg + 1u) * nx) xb_add(&bar[XB_TOPGEN], 1u);
            else XB_SPIN(xb_ld(&bar[XB_TOPGEN]) == tg, bar);
            __builtin_amdgcn_fence(__ATOMIC_ACQUIRE, "agent");
            xb_add(&bar[XB_XGEN(b.x)], 1u);
            asm volatile("s_waitcnt vmcnt(0)" ::: "memory");
        } else {
            XB_SPIN(xb_ld(&bar[XB_XGEN(b.x)]) == gen, bar);
            __builtin_amdgcn_fence(__ATOMIC_ACQUIRE, "agent");
            asm volatile("s_waitcnt vmcnt(0)" ::: "memory");
        }
    }
    __syncthreads();
}
constexpr int NWAVES = 8;
constexpr int M_TOK = 16384, DM = 2048, SEQ = 2048, NB = 8;
constexpr int PP = 11264;
constexpr int C_FQ = 0, C_FK = 1024, C_FV = 2048, C_RQ = 3072, C_RK = 4096, C_RV = 5120, C_RG = 6144, C_G0 = 7168, C_G1 = 9216;
constexpr int N_IN_ORIG = 11272;
constexpr float RMS_EPS = 1e-6f;
constexpr float QK_C2 = 0.08838834764831845f * 1.4426950408889634f;
constexpr size_t MiB = 1u << 20;
constexpr size_t WS_CTL = 0, CTL_ZERO_BYTES = 1 * MiB;
constexpr size_t WS_ROWSS1 = 256 * 1024, WS_ROWSS2 = 512 * 1024;
constexpr size_t WS_WIN = 1 * MiB, WS_WFOX = 45 * MiB, WS_WRET = 49 * MiB, WS_WOUT = 53 * MiB, WS_WMQ = 61 * MiB, WS_WMKV = 63 * MiB, WS_WMO = 67 * MiB, WS_WPQ = 69 * MiB, WS_SUBK = 77 * MiB;
constexpr size_t WS_LOGF = 78 * MiB, WS_CUMF = 78 * MiB + 512 * 1024;
constexpr size_t WS_XN = 80 * MiB;
constexpr size_t WS_PROJ = 144 * MiB;
constexpr size_t WS_MN = 496 * MiB, WS_KVM = 504 * MiB, WS_END = 508 * MiB;
constexpr size_t WS_XB1 = 144 * MiB, WS_QM = 208 * MiB, WS_OMEM = 224 * MiB, WS_PU = 240 * MiB, WS_PV = 304 * MiB, WS_QP = 144 * MiB, WS_IDX = 208 * MiB, WS_GATE = 216 * MiB;
constexpr int CW_BAR = 4096;
constexpr int RING_BYTES = 131072, LDS_BYTES = 147456, LDSCTL_OFF = LDS_BYTES - 1024, MISC_OFF = LDSCTL_OFF + 320;
static_assert(att::LDS_BYTES <= LDSCTL_OFF, "attention LDS");

struct Args { const float* in[23]; float* out; unsigned char* ws; int ph_lo, ph_hi; };
enum { I_X = 0, I_MEM, I_LN_MIX, I_W_IN, I_B_FORGET, I_FOXQ_G, I_FOXK_G, I_RET_G, I_W_FOXUP, I_W_RETUP, I_W_OUT, I_LN_MEM, I_MEMNORM_G, I_W_MQ, I_W_MKV, I_MEMQ_G, I_MEMK_G, I_W_MO, I_LN_FFN, I_W_PQ, I_SUBK, I_PEER_U, I_PEER_V };

__device__ __forceinline__ float wave_sum(float v) {
#pragma unroll
    for (int o = 1; o < 64; o <<= 1) v += __shfl_xor(v, o);
    return v;
}
__device__ __forceinline__ void transpose_item(const float* W, int ldw, int K, int src_col0, const float* kgain, bf16* WT, int dst_row0, LAS float* scr, int kb, int nb, int lane) {
    const int k0 = 64 * kb, n0 = 32 * nb;
#pragma unroll 8
    for (int i = 0; i < 32; ++i) { const int kk = 2 * i + (lane >> 5); float v = W[(size_t)(k0 + kk) * ldw + src_col0 + n0 + (lane & 31)]; if (kgain) v *= kgain[k0 + kk]; scr[kk * 33 + (lane & 31)] = v; }
    LDS_WAIT(); asm volatile("" ::: "memory");
    const int c = lane & 7;
#pragma unroll
    for (int j = 0; j < 4; ++j) { const int n = (lane >> 3) + 8 * j; const LAS float* s = scr + (8 * c) * 33 + n;
        v4u o; o.x = pk2(s[0 * 33], s[1 * 33]); o.y = pk2(s[2 * 33], s[3 * 33]); o.z = pk2(s[4 * 33], s[5 * 33]); o.w = pk2(s[6 * 33], s[7 * 33]);
        *(GAS v4u*)(WT + (size_t)(dst_row0 + n0 + n) * K + k0 + 8 * c) = o; }
    LDS_WAIT(); asm volatile("" ::: "memory");
}
struct TJob { const float* W; int ldw, K, N; const float* gain; bf16* WT; };

__device__ __forceinline__ void rms_row_to_bf16(const float* xrow, const float* gain, bf16* orow, int lane, f32x4 (&hv)[8]) {
    const GAS f32x4* xr = (const GAS f32x4*)xrow + lane; float s = 0.f;
#pragma unroll
    for (int j = 0; j < 8; ++j) { hv[j] = xr[64 * j]; s += (hv[j].x * hv[j].x + hv[j].y * hv[j].y) + (hv[j].z * hv[j].z + hv[j].w * hv[j].w); }
    const float r = 1.f / sqrtf(wave_sum(s) * (1.f / DM) + RMS_EPS);
    GAS unsigned long long* o8 = (GAS unsigned long long*)orow + lane;
#pragma unroll
    for (int j = 0; j < 8; ++j) { const f32x4 g = ((const GAS f32x4*)gain)[lane + 64 * j]; hv[j] = hv[j] * r * g;
        o8[64 * j] = (unsigned long long)pk2(hv[j].x, hv[j].y) | ((unsigned long long)pk2(hv[j].z, hv[j].w) << 32); }
}
__device__ __forceinline__ float log_sigmoid_f(float z) { return fminf(z, 0.f) - log1pf(expf(-fabsf(z))); }

struct Frame { LAS unsigned char* lds; unsigned char* ldsg; int tid, lane, wave, G, bx; const float* const* in; float* out; unsigned char* ws; };

__device__ __forceinline__ void p0_prologue(Frame& F) {
    const int gw = F.bx * NWAVES + F.wave, NGW = F.G * NWAVES;
    {
        LAS float* scr = (LAS float*)(F.lds + F.wave * 16384);
        const TJob jobs[8] = {
            {F.in[I_W_IN], N_IN_ORIG, 2048, PP, nullptr, (bf16*)(F.ws + WS_WIN)},
            {F.in[I_W_FOXUP], 2048, 1024, 2048, nullptr, (bf16*)(F.ws + WS_WFOX)},
            {F.in[I_W_RETUP], 2048, 1024, 2048, nullptr, (bf16*)(F.ws + WS_WRET)},
            {F.in[I_W_OUT], 2048, 2048, 2048, nullptr, (bf16*)(F.ws + WS_WOUT)},
            {F.in[I_W_MQ], 512, 2048, 512, F.in[I_LN_MEM], (bf16*)(F.ws + WS_WMQ)},
            {F.in[I_W_MKV], 1024, 2048, 1024, nullptr, (bf16*)(F.ws + WS_WMKV)},
            {F.in[I_W_MO], 2048, 512, 2048, nullptr, (bf16*)(F.ws + WS_WMO)},
            {F.in[I_W_PQ], 2048, 2048, 2048, F.in[I_LN_FFN], (bf16*)(F.ws + WS_WPQ)} };
        int base = 0;
#pragma unroll
        for (int j = 0; j < 8; ++j) {
            const TJob& J = jobs[j]; const int nblk = J.N / 32, items = (J.K / 64) * nblk;
            int first = gw - (base % NGW); if (first < 0) first += NGW;
            for (int r = first; r < items; r += NGW) { const int kb = r / nblk, nb = r % nblk;
                const int src_col0 = (j == 0 && nb * 32 >= 3072) ? 8 : 0;
                transpose_item(J.W, J.ldw, J.K, src_col0, J.gain, J.WT, 0, scr, kb, nb, F.lane); }
            base += items;
        }
    }
    {
        const float* sk = F.in[I_SUBK]; bf16* o = (bf16*)(F.ws + WS_SUBK);
        for (int i = (F.bx * 512 + F.tid) * 4; i < 16 * 128 * 128; i += F.G * 512 * 4) { const f32x4 v = *(const GAS f32x4*)(sk + i);
            *(GAS unsigned long long*)(o + i) = (unsigned long long)pk2(v.x, v.y) | ((unsigned long long)pk2(v.z, v.w) << 32); }
    }
    __syncthreads();
    {
        LAS float* wf = (LAS float*)F.lds; const float* w = F.in[I_W_IN];
        for (int k = F.tid; k < 2048; k += 512) { const f32x4 a = *(const GAS f32x4*)(w + (size_t)k * N_IN_ORIG + 3072), b = *(const GAS f32x4*)(w + (size_t)k * N_IN_ORIG + 3076);
            wf[0 * 2048 + k] = a.x; wf[1 * 2048 + k] = a.y; wf[2 * 2048 + k] = a.z; wf[3 * 2048 + k] = a.w; wf[4 * 2048 + k] = b.x; wf[5 * 2048 + k] = b.y; wf[6 * 2048 + k] = b.z; wf[7 * 2048 + k] = b.w; }
    }
    __syncthreads();
    {
        const LAS float* wf = (const LAS float*)F.lds; const float* bfg = F.in[I_B_FORGET]; float* logf_o = (float*)(F.ws + WS_LOGF);
        for (int m = gw; m < M_TOK; m += NGW) { f32x4 hv[8];
            rms_row_to_bf16(F.in[I_X] + (size_t)m * DM, F.in[I_LN_MIX], (bf16*)(F.ws + WS_XN) + (size_t)m * DM, F.lane, hv);
            float z = 0.f;
#pragma unroll
            for (int q = 0; q < 8; ++q) { float acc = 0.f;
#pragma unroll
                for (int j = 0; j < 8; ++j) { const f32x4 wv = *(const LAS f32x4*)(wf + q * 2048 + 4 * F.lane + 256 * j); acc += (hv[j].x * wv.x + hv[j].y * wv.y) + (hv[j].z * wv.z + hv[j].w * wv.w); }
                acc = wave_sum(acc); z = (F.lane == q) ? acc : z;
                __builtin_amdgcn_sched_barrier(0); }
            if (F.lane < 8) logf_o[(size_t)m * 8 + F.lane] = log_sigmoid_f(z + bfg[F.lane]);
        }
        for (int m = gw; m < NB * 256; m += NGW) { f32x4 hv[8]; rms_row_to_bf16(F.in[I_MEM] + (size_t)m * DM, F.in[I_MEMNORM_G], (bf16*)(F.ws + WS_MN) + (size_t)m * DM, F.lane, hv); }
    }
}
__device__ __forceinline__ void p1_scan(Frame& F) {
    if (F.bx < 64) {
        const int b = F.bx >> 3, h = F.bx & 7; const float* lf = (const float*)(F.ws + WS_LOGF); float* cf = (float*)(F.ws + WS_CUMF) + (size_t)F.bx * SEQ;
        float v[4]; float run = 0.f;
#pragma unroll
        for (int i = 0; i < 4; ++i) { run += lf[(size_t)(b * SEQ + F.tid * 4 + i) * 8 + h]; v[i] = run; }
        float incl = run;
#pragma unroll
        for (int o = 1; o < 64; o <<= 1) { const float t = __shfl_up(incl, o); if (F.lane >= o) incl += t; }
        LAS float* wt = (LAS float*)F.lds;
        if (F.lane == 63) wt[F.wave] = incl;
        __syncthreads();
        float off = incl - run;
        for (int w = 0; w < F.wave; ++w) off += wt[w];
#pragma unroll
        for (int i = 0; i < 4; ++i) cf[F.tid * 4 + i] = v[i] + off;
    }
    __syncthreads();
}
__device__ __forceinline__ void unpack8s(const att::bf16x8 v, float (&f)[8]) {
#pragma unroll
    for (int i = 0; i < 8; ++i) f[i] = __uint_as_float((unsigned)(unsigned short)v[i] << 16);
}
__device__ __forceinline__ att::bf16x8 pack8s(const float (&f)[8]) { v4u w; w.x = pg8::cvt_pk_bf16(f[0], f[1]); w.y = pg8::cvt_pk_bf16(f[2], f[3]); w.z = pg8::cvt_pk_bf16(f[4], f[5]); w.w = pg8::cvt_pk_bf16(f[6], f[7]); return __builtin_bit_cast(att::bf16x8, w); }
__device__ __forceinline__ void p3_fixup(Frame& F) {
    const int gw = F.bx * NWAVES + F.wave, NGW = F.G * NWAVES, lane = F.lane;
    bf16* proj = (bf16*)(F.ws + WS_PROJ);
    const int head = lane >> 3, sub = lane & 7;
    float gq[16], gk[16], fr[8];
#pragma unroll
    for (int i = 0; i < 16; ++i) { gq[i] = F.in[I_FOXQ_G][sub * 16 + i] * QK_C2; gk[i] = F.in[I_FOXK_G][sub * 16 + i]; }
#pragma unroll
    for (int i = 0; i < 8; ++i) fr[i] = expf(-9.210340371976184f * (float)(sub * 8 + i) * (1.f / 64.f)) * 0.15915494309189535f;
    for (int m = gw; m < M_TOK; m += NGW) {
        bf16* row = proj + (size_t)m * PP; const float pos = (float)(m & (SEQ - 1));
#pragma unroll
        for (int which = 0; which < 2; ++which) {
            bf16* p = row + (which ? C_FK : C_FQ) + head * 128 + sub * 16;
            float a[8], b[8]; unpack8s(*(const att::bf16x8*)p, a); unpack8s(*(const att::bf16x8*)(p + 8), b);
            float s = 0.f;
#pragma unroll
            for (int i = 0; i < 8; ++i) s += a[i] * a[i] + b[i] * b[i];
            s += __shfl_xor(s, 1); s += __shfl_xor(s, 2); s += __shfl_xor(s, 4);
            const float r = 1.f / sqrtf(s * (1.f / 128.f) + RMS_EPS);
#pragma unroll
            for (int i = 0; i < 8; ++i) { a[i] *= r * (which ? gk[i] : gq[i]); b[i] *= r * (which ? gk[8 + i] : gq[8 + i]); }
            *(att::bf16x8*)p = pack8s(a); *(att::bf16x8*)(p + 8) = pack8s(b);
        }
        float sn[8], cs[8];
#pragma unroll
        for (int i = 0; i < 8; ++i) { float rev = pos * fr[i]; rev -= rintf(rev); sn[i] = __builtin_amdgcn_sinf(rev); cs[i] = __builtin_amdgcn_cosf(rev); }
#pragma unroll
        for (int which = 0; which < 2; ++which) {
            bf16* p = row + (which ? C_RK : C_RQ) + head * 128 + sub * 8; const float sc = which ? 0.08838834764831845f : 1.f;
            float a[8], b[8]; unpack8s(*(const att::bf16x8*)p, a); unpack8s(*(const att::bf16x8*)(p + 64), b);
            float oa[8], ob[8];
#pragma unroll
            for (int i = 0; i < 8; ++i) { oa[i] = (a[i] * cs[i] - b[i] * sn[i]) * sc; ob[i] = (a[i] * sn[i] + b[i] * cs[i]) * sc; }
            *(att::bf16x8*)p = pack8s(oa); *(att::bf16x8*)(p + 64) = pack8s(ob);
        }
    }
    {
        bf16* kvm = (bf16*)(F.ws + WS_KVM); const int hd = lane >> 4, sb = lane & 15; float g[8];
#pragma unroll
        for (int i = 0; i < 8; ++i) g[i] = F.in[I_MEMK_G][sb * 8 + i];
        for (int m = gw; m < NB * 256; m += NGW) { bf16* p = kvm + (size_t)m * 1024 + hd * 128 + sb * 8;
            float a[8]; unpack8s(*(const att::bf16x8*)p, a); float s = 0.f;
#pragma unroll
            for (int i = 0; i < 8; ++i) s += a[i] * a[i];
            s += __shfl_xor(s, 1); s += __shfl_xor(s, 2); s += __shfl_xor(s, 4); s += __shfl_xor(s, 8);
            const float r = 1.f / sqrtf(s * (1.f / 128.f) + RMS_EPS);
#pragma unroll
            for (int i = 0; i < 8; ++i) a[i] *= r * g[i];
            *(att::bf16x8*)p = pack8s(a); }
    }
}
__device__ __forceinline__ void p4_attention(Frame& F) {
    char* lds = (char*)F.ldsg;
    const int xcd = F.bx & 7, kk = F.bx >> 3;
    const int bh = (kk >> 2) * 8 + xcd, x = kk & 3, b = bh >> 3, h = bh & 7;
    if (bh >= 64) return;
    const att::bf16* proj = (const att::bf16*)(F.ws + WS_PROJ);
    const size_t rowb = (size_t)b * SEQ;
#ifndef NO_FOX
    {
        float* tbl = (float*)(lds + att::LDS_BIAS); const float* cf = (const float*)(F.ws + WS_CUMF) + (size_t)bh * SEQ;
        const f32x4 v = *(const f32x4*)(cf + F.tid * 4); *(f32x4*)(tbl + F.tid * 4) = v * (-1.4426950408889634f);
        att::BlockRef r0, r1;
        r0.Q = proj + (rowb + (size_t)x * 256) * PP + C_FQ + h * 128; r0.K = proj + rowb * PP + C_FK + h * 128; r0.V = proj + rowb * PP + C_FV + h * 128; r0.O = (att::bf16*)r0.Q;
        r0.P0 = x * 256; r0.skv = SEQ; r0.lg = 0.f; r0.RG = nullptr; r0.GN = nullptr;
        r1 = r0; r1.Q = proj + (rowb + (size_t)(7 - x) * 256) * PP + C_FQ + h * 128; r1.O = (att::bf16*)r1.Q; r1.P0 = (7 - x) * 256;
        att::Seam S;
        att::attn_prime<0>(r0, lds, S);
        att::attn_block<0>(r0, r1, lds, S);
        att::attn_block<0>(r1, r1, lds, S);
    }
#endif
#ifndef NO_RET
    {
        att::BlockRef r0, r1;
        r0.Q = proj + (rowb + (size_t)x * 256) * PP + C_RQ + h * 128; r0.K = proj + rowb * PP + C_RK + h * 128; r0.V = proj + rowb * PP + C_RV + h * 128; r0.O = (att::bf16*)r0.Q;
        r0.P0 = x * 256; r0.skv = SEQ; r0.lg = log2f(1.f - exp2f(-5.f - (float)h)); r0.RG = proj + (rowb + (size_t)x * 256) * PP + C_RG + h * 128; r0.GN = F.in[I_RET_G] + h * 128;
        r1 = r0; r1.Q = proj + (rowb + (size_t)(7 - x) * 256) * PP + C_RQ + h * 128; r1.O = (att::bf16*)r1.Q; r1.P0 = (7 - x) * 256; r1.RG = proj + (rowb + (size_t)(7 - x) * 256) * PP + C_RG + h * 128;
        att::Seam S;
        att::attn_prime<1>(r0, lds, S);
        att::attn_block<1>(r0, r1, lds, S);
        att::attn_block<1>(r1, r1, lds, S);
    }
#endif
}


__device__ __forceinline__ void p8_convert_peer(Frame& F) {
    const int w = (F.bx - 128) * NWAVES + F.wave, NW_ = 128 * NWAVES, lane = F.lane;
    f32x4 g[8];
#pragma unroll
    for (int j = 0; j < 8; ++j) g[j] = ((const GAS f32x4*)F.in[I_LN_FFN])[lane + 64 * j];
    for (int r = w; r < 32768; r += NW_) {
        const bool isu = r < 16384; const float* src = (isu ? F.in[I_PEER_U] : F.in[I_PEER_V]) + (size_t)(r & 16383) * DM;
        bf16* dst = (bf16*)(F.ws + (isu ? WS_PU : WS_PV)) + (size_t)(r & 16383) * DM;
        const GAS f32x4* xr = (const GAS f32x4*)src + lane; GAS unsigned long long* o8 = (GAS unsigned long long*)dst + lane;
        f32x4 v[8];
#pragma unroll
        for (int j = 0; j < 8; ++j) v[j] = xr[64 * j];
#pragma unroll
        for (int j = 0; j < 8; ++j) { if (isu) v[j] = v[j] * g[j]; o8[64 * j] = (unsigned long long)pk2(v[j].x, v[j].y) | ((unsigned long long)pk2(v[j].z, v[j].w) << 32); }
    }
}
__device__ __forceinline__ void p9_mq_norm(Frame& F) {
    const int gw = F.bx * NWAVES + F.wave, NGW = F.G * NWAVES, lane = F.lane;
    bf16* qm = (bf16*)(F.ws + WS_QM); const int hd = lane >> 4, sb = lane & 15; float g[8];
#pragma unroll
    for (int i = 0; i < 8; ++i) g[i] = F.in[I_MEMQ_G][sb * 8 + i] * QK_C2;
    for (int m = gw; m < M_TOK; m += NGW) { bf16* p = qm + (size_t)m * 512 + hd * 128 + sb * 8;
        float a[8]; unpack8s(*(const att::bf16x8*)p, a); float s = 0.f;
#pragma unroll
        for (int i = 0; i < 8; ++i) s += a[i] * a[i];
        s += __shfl_xor(s, 1); s += __shfl_xor(s, 2); s += __shfl_xor(s, 4); s += __shfl_xor(s, 8);
        const float r = 1.f / sqrtf(s * (1.f / 128.f) + RMS_EPS);
#pragma unroll
        for (int i = 0; i < 8; ++i) a[i] *= r * g[i];
        *(att::bf16x8*)p = pack8s(a); }
}
__device__ __forceinline__ void p10_mem_attention(Frame& F) {
    char* lds = (char*)F.ldsg;
    const int b = F.bx >> 5, h = (F.bx >> 3) & 3, qb = F.bx & 7;
    att::BlockRef r0;
    const size_t qoff = ((size_t)b * SEQ + (size_t)qb * 256) * 512 + h * 128;
    r0.Q = (const att::bf16*)(F.ws + WS_QM) + qoff; r0.O = (att::bf16*)(F.ws + WS_OMEM) + qoff;
    r0.K = (const att::bf16*)(F.ws + WS_KVM) + (size_t)(b * 256) * 1024 + h * 128; r0.V = r0.K + 512;
    r0.P0 = 1 << 20; r0.skv = 256; r0.lg = 0.f; r0.RG = nullptr; r0.GN = nullptr;
    att::Seam S;
    att::attn_prime<2>(r0, lds, S);
    att::attn_block<2>(r0, r0, lds, S);
}
#define TK_INS(L, v) do { _Pragma("unroll") for (int i_ = 15; i_ >= 1; --i_) L[i_] = __builtin_amdgcn_fmed3f(L[i_ - 1], L[i_], (v)); L[0] = fmaxf(L[0], (v)); } while (0)
__device__ __forceinline__ void p13_topk(Frame& F) {
    const int lane = F.lane, r32 = lane & 31, hi = lane >> 5, wave = F.wave;
    const att::bf16* qp = (const att::bf16*)(F.ws + WS_QP); const att::bf16* subk = (const att::bf16*)(F.ws + WS_SUBK);
    int* idx_o = (int*)(F.ws + WS_IDX); float* gate_o = (float*)(F.ws + WS_GATE);
    LAS unsigned* kb = (LAS unsigned*)(F.lds + (wave * 64 + lane) * 32);
    for (int task = 0; task < 2; ++task) {
        const int g = wave & 1, h = (wave >> 1) * 2 + task, tok = F.bx * 64 + g * 32 + r32;
        float L0[16], L1[16];
#pragma unroll
        for (int p = 0; p < 2; ++p) {
            att::bf16x8 q[8];
#pragma unroll
            for (int d0 = 0; d0 < 8; ++d0) q[d0] = att::load8(qp + (size_t)tok * DM + (h * 2 + p) * 128 + d0 * 16 + hi * 8);
            att::f32x16 acc[4];
#pragma unroll
            for (int kt = 0; kt < 4; ++kt) { acc[kt] = att::f32x16{};
                const att::bf16* kr = subk + ((size_t)(h * 2 + p) * 128 + kt * 32 + r32) * 128 + hi * 8;
#pragma unroll
                for (int d0 = 0; d0 < 8; ++d0) acc[kt] = __builtin_amdgcn_mfma_f32_32x32x16_bf16(att::load8(kr + d0 * 16), q[d0], acc[kt], 0, 0, 0); }
            float L[16];
#pragma unroll
            for (int i = 0; i < 16; ++i) L[i] = -3.0e38f;
#pragma unroll
            for (int kt = 0; kt < 4; ++kt)
#pragma unroll
                for (int r = 0; r < 16; ++r) { const unsigned key = (unsigned)(kt * 32 + (r & 3) + 8 * (r >> 2)) + 4u * (unsigned)hi;
                    const float v = __uint_as_float((__float_as_uint(acc[kt][r]) & ~0x7Fu) | key); TK_INS(L, v); }
            float P[16];
#pragma unroll
            for (int i = 0; i < 16; ++i) P[i] = __shfl_xor(L[i], 32);
#pragma unroll
            for (int i = 0; i < 16; ++i) TK_INS(L, P[i]);
#pragma unroll
            for (int i = 0; i < 16; ++i) { if (p == 0) L0[i] = L[i]; else L1[i] = L[i]; }
        }
#pragma unroll
        for (int w = 0; w < 4; ++w) {
            kb[w] = (__float_as_uint(L0[4 * w]) & 0x7Fu) | ((__float_as_uint(L0[4 * w + 1]) & 0x7Fu) << 8) | ((__float_as_uint(L0[4 * w + 2]) & 0x7Fu) << 16) | ((__float_as_uint(L0[4 * w + 3]) & 0x7Fu) << 24);
            kb[4 + w] = (__float_as_uint(L1[4 * w]) & 0x7Fu) | ((__float_as_uint(L1[4 * w + 1]) & 0x7Fu) << 8) | ((__float_as_uint(L1[4 * w + 2]) & 0x7Fu) << 16) | ((__float_as_uint(L1[4 * w + 3]) & 0x7Fu) << 24); }
        float T[16];
#pragma unroll
        for (int i = 0; i < 16; ++i) T[i] = -3.0e38f;
#pragma unroll
        for (int a = 0; a < 16; ++a) { const float sa = __uint_as_float(__float_as_uint(L0[a]) & ~0x7Fu);
#pragma unroll
            for (int b2 = 0; b2 < 16; ++b2) if ((a + 1) * (b2 + 1) <= 16) { const float s = sa + __uint_as_float(__float_as_uint(L1[b2]) & ~0x7Fu);
                const float v = __uint_as_float((__float_as_uint(s) & ~0xFFu) | (unsigned)(a * 16 + b2)); TK_INS(T, v); } }
        LDS_WAIT();
        const LAS unsigned char* kbb = (const LAS unsigned char*)kb;
        float sc[16]; int ei[16]; float mx = __uint_as_float(__float_as_uint(T[0]) & ~0xFFu), sum = 0.f;
#pragma unroll
        for (int k = 0; k < 16; ++k) { const unsigned bits = __float_as_uint(T[k]); const unsigned id = bits & 0xFFu;
            const int i1 = kbb[id >> 4], i2 = kbb[16 + (id & 15u)]; ei[k] = i1 * 128 + i2;
            sc[k] = __builtin_amdgcn_exp2f((__uint_as_float(bits & ~0xFFu) - mx) * 1.4426950408889634f); sum += sc[k]; }
        const float inv = 1.f / sum;
        if (hi == 0) {
#pragma unroll
            for (int w = 0; w < 4; ++w) {
                *(GAS v4u*)(idx_o + (size_t)tok * 128 + h * 16 + 4 * w) = (v4u){(unsigned)ei[4 * w], (unsigned)ei[4 * w + 1], (unsigned)ei[4 * w + 2], (unsigned)ei[4 * w + 3]};
                *(GAS f32x4*)(gate_o + (size_t)tok * 128 + h * 16 + 4 * w) = (f32x4){sc[4 * w] * inv, sc[4 * w + 1] * inv, sc[4 * w + 2] * inv, sc[4 * w + 3] * inv}; } }
        LDS_WAIT(); asm volatile("" ::: "memory");
    }
}

__device__ __forceinline__ void wave_argmax(float v, int id, float& bv, int& bi) {
#pragma unroll
    for (int o = 1; o < 64; o <<= 1) { const float ov = __shfl_xor(v, o); const int oi = __shfl_xor(id, o); if (ov > v || (ov == v && oi > id)) { v = ov; id = oi; } }
    bv = v; bi = id;
}
__device__ __forceinline__ void p13_topk_naive(Frame& F) {
    const int gw = F.bx * NWAVES + F.wave, NGW = F.G * NWAVES, lane = F.lane;
    const bf16* qp = (const bf16*)(F.ws + WS_QP); const bf16* subk = (const bf16*)(F.ws + WS_SUBK);
    int* idx_o = (int*)(F.ws + WS_IDX); float* gate_o = (float*)(F.ws + WS_GATE);
    for (int item = gw; item < M_TOK * 8; item += NGW) {
        const int tok = item >> 3, h = item & 7;
        float ts[2][16]; int ti[2][16];
#pragma unroll
        for (int p = 0; p < 2; ++p) {
            float s[2] = {0.f, 0.f};
            for (int d = 0; d < 128; ++d) { const float q = __uint_as_float((unsigned)qp[(size_t)tok * DM + (h * 2 + p) * 128 + d] << 16);
                s[0] += q * __uint_as_float((unsigned)subk[((size_t)(h * 2 + p) * 128 + lane) * 128 + d] << 16);
                s[1] += q * __uint_as_float((unsigned)subk[((size_t)(h * 2 + p) * 128 + 64 + lane) * 128 + d] << 16); }
#pragma unroll
            for (int k = 0; k < 16; ++k) { const bool first = s[0] >= s[1]; float bv; int bi;
                wave_argmax(first ? s[0] : s[1], first ? lane : 64 + lane, bv, bi);
                ts[p][k] = bv; ti[p][k] = bi;
                if (bi == lane) s[0] = -3.0e38f; if (bi == 64 + lane) s[1] = -3.0e38f; }
        }
        float cs[4]; int ci[4];
#pragma unroll
        for (int j = 0; j < 4; ++j) { float sa = 0.f, sb = 0.f; int ia = 0, ib = 0;
#pragma unroll
            for (int k = 0; k < 16; ++k) { if ((lane >> 2) == k) { sa = ts[0][k]; ia = ti[0][k]; } if ((4 * (lane & 3) + j) == k) { sb = ts[1][k]; ib = ti[1][k]; } }
            cs[j] = sa + sb; ci[j] = ia * 128 + ib; }
        float fs[16]; int fi[16];
#pragma unroll
        for (int k = 0; k < 16; ++k) { int bj = 0; float v = cs[0];
#pragma unroll
            for (int j = 1; j < 4; ++j) if (cs[j] > v) { v = cs[j]; bj = j; }
            int id = 0;
#pragma unroll
            for (int j = 0; j < 4; ++j) if (bj == j) id = ci[j];
            float bv; int bi; wave_argmax(v, id, bv, bi); fs[k] = bv; fi[k] = bi;
#pragma unroll
            for (int j = 0; j < 4; ++j) if (ci[j] == bi && cs[j] == bv) cs[j] = -3.0e38f; }
        float sum = 0.f, e[16];
#pragma unroll
        for (int k = 0; k < 16; ++k) { e[k] = expf(fs[k] - fs[0]); sum += e[k]; }
        if (lane < 16) { float g = 0.f; int id = 0;
#pragma unroll
            for (int k = 0; k < 16; ++k) if (lane == k) { g = e[k] / sum; id = fi[k]; }
            idx_o[(size_t)tok * 128 + h * 16 + lane] = id; gate_o[(size_t)tok * 128 + h * 16 + lane] = g; }
    }
}

typedef __bf16 bf16x2_t __attribute__((ext_vector_type(2)));
__device__ __forceinline__ float dot2bf(unsigned a, unsigned b, float acc) { asm("v_dot2c_f32_bf16 %0, %1, %2" : "+v"(acc) : "v"(a), "v"(b)); return acc; }
__device__ __forceinline__ float dot8(const v4u a, const v4u b, float acc) {
    acc = dot2bf(a.x, b.x, acc); acc = dot2bf(a.y, b.y, acc); acc = dot2bf(a.z, b.z, acc); acc = dot2bf(a.w, b.w, acc);
    return acc;
}
__device__ __forceinline__ float gelu_tanh(float x) {
    const float y = 0.7978845608028654f * (x + 0.044715f * x * x * x);
    const float t = 1.f - 2.f * __builtin_amdgcn_rcpf(1.f + __builtin_amdgcn_exp2f(2.885390081777927f * y));
    return 0.5f * x * (1.f + t);
}
__device__ __forceinline__ void axpy8(float (&acc)[8], const v4u v, float w) {
    acc[0] += w * __uint_as_float(v.x << 16); acc[1] += w * __uint_as_float(v.x & 0xffff0000u); acc[2] += w * __uint_as_float(v.y << 16); acc[3] += w * __uint_as_float(v.y & 0xffff0000u);
    acc[4] += w * __uint_as_float(v.z << 16); acc[5] += w * __uint_as_float(v.z & 0xffff0000u); acc[6] += w * __uint_as_float(v.w << 16); acc[7] += w * __uint_as_float(v.w & 0xffff0000u);
}
__device__ __forceinline__ void p14_experts(Frame& F) {
    const int gw = F.bx * NWAVES + F.wave, NGW = F.G * NWAVES, lane = F.lane;
    const bf16* xb = (const bf16*)(F.ws + WS_XN); const bf16* pu = (const bf16*)(F.ws + WS_PU); const bf16* pv = (const bf16*)(F.ws + WS_PV);
    const int* idx = (const int*)(F.ws + WS_IDX); const float* gate = (const float*)(F.ws + WS_GATE); const float* rowss = (const float*)(F.ws + WS_ROWSS2);
    for (int t = gw; t < M_TOK; t += NGW) {
        const float rs = 1.f / sqrtf(rowss[t] * (1.f / DM) + RMS_EPS);
        v4u xh[4];
#pragma unroll
        for (int c = 0; c < 4; ++c) xh[c] = *(const GAS v4u*)(xb + (size_t)t * DM + lane * 8 + c * 512);
        const int id0 = idx[(size_t)t * 128 + lane], id1 = idx[(size_t)t * 128 + 64 + lane];
        const float gt0 = gate[(size_t)t * 128 + lane], gt1 = gate[(size_t)t * 128 + 64 + lane];
        float acc[4][8];
#pragma unroll
        for (int c = 0; c < 4; ++c)
#pragma unroll
            for (int e = 0; e < 8; ++e) acc[c][e] = 0.f;
#pragma unroll 1
        for (int j = 0; j < 32; ++j) {
            const int idr = j < 16 ? id0 : id1; const float gtr = j < 16 ? gt0 : gt1;
            v4u ua[4][4], va[4][4]; float gk[4];
#pragma unroll
            for (int i = 0; i < 4; ++i) { const int e = __builtin_amdgcn_readlane(idr, (j * 4 + i) & 63); gk[i] = __builtin_bit_cast(float, __builtin_amdgcn_readlane(__builtin_bit_cast(int, gtr), (j * 4 + i) & 63));
#pragma unroll
                for (int c = 0; c < 4; ++c) { ua[i][c] = *(const GAS v4u*)(pu + (size_t)e * DM + lane * 8 + c * 512); va[i][c] = *(const GAS v4u*)(pv + (size_t)e * DM + lane * 8 + c * 512); } }
            float d[4];
#pragma unroll
            for (int i = 0; i < 4; ++i) { float s = 0.f;
#pragma unroll
                for (int c = 0; c < 4; ++c) s = dot8(ua[i][c], xh[c], s);
                d[i] = wave_sum(s); }
#pragma unroll
            for (int i = 0; i < 4; ++i) { const float w = gk[i] * gelu_tanh(d[i] * rs);
#pragma unroll
                for (int c = 0; c < 4; ++c) axpy8(acc[c], va[i][c], w); }
        }
        float* orow = F.out + (size_t)t * DM + lane * 8;
#pragma unroll
        for (int c = 0; c < 4; ++c) { const f32x4 a = *(const GAS f32x4*)(orow + c * 512), b = *(const GAS f32x4*)(orow + c * 512 + 4);
            *(GAS f32x4*)(orow + c * 512) = a + (f32x4){acc[c][0], acc[c][1], acc[c][2], acc[c][3]}; *(GAS f32x4*)(orow + c * 512 + 4) = b + (f32x4){acc[c][4], acc[c][5], acc[c][6], acc[c][7]}; }
    }
}


__device__ __forceinline__ void p14_experts_naive(Frame& F) {
    const int gw = F.bx * NWAVES + F.wave, NGW = F.G * NWAVES, lane = F.lane;
    const bf16* xb = (const bf16*)(F.ws + WS_XN); const bf16* pu = (const bf16*)(F.ws + WS_PU); const bf16* pv = (const bf16*)(F.ws + WS_PV);
    const int* idx = (const int*)(F.ws + WS_IDX); const float* gate = (const float*)(F.ws + WS_GATE); const float* rowss = (const float*)(F.ws + WS_ROWSS2);
    for (int t = gw; t < M_TOK; t += NGW) {
        const float rs = 1.f / sqrtf(rowss[t] * (1.f / DM) + RMS_EPS);
        float acc[32];
#pragma unroll
        for (int i = 0; i < 32; ++i) acc[i] = 0.f;
#pragma unroll 1
        for (int k = 0; k < 128; ++k) {
            const int e = idx[(size_t)t * 128 + k]; const float g = gate[(size_t)t * 128 + k];
            float s = 0.f;
#pragma unroll
            for (int i = 0; i < 32; ++i) s += __uint_as_float((unsigned)pu[(size_t)e * DM + lane * 32 + i] << 16) * __uint_as_float((unsigned)xb[(size_t)t * DM + lane * 32 + i] << 16);
            s = wave_sum(s) * rs;
            const float w = g * 0.5f * s * (1.f + tanhf(0.7978845608028654f * (s + 0.044715f * s * s * s)));
#pragma unroll
            for (int i = 0; i < 32; ++i) acc[i] += w * __uint_as_float((unsigned)pv[(size_t)e * DM + lane * 32 + i] << 16);
        }
#pragma unroll
        for (int i = 0; i < 32; ++i) F.out[(size_t)t * DM + lane * 32 + i] += acc[i];
    }
}

#ifndef LAST_PHASE
#define LAST_PHASE 14
#endif
enum { PH_PROLOGUE = 0, PH_GEMM_IN, PH_GEMM_MKV, PH_FIXUP, PH_ATTN, PH_GEMM_FOXUP, PH_GEMM_RETUP, PH_GEMM_OUT, PH_GEMM_MQ, PH_MQ_NORM, PH_MEM_ATTN, PH_GEMM_MO, PH_GEMM_PQ, PH_TOPK, PH_EXPERTS, PH_N };
__global__ void __launch_bounds__(NWAVES * 64, 2) mega_fwd(Args args) {
    extern __shared__ __attribute__((aligned(16))) unsigned char lds[];
    Frame F;
    F.lds = (LAS unsigned char*)lds; F.ldsg = lds; F.tid = threadIdx.x; F.lane = F.tid & 63; F.wave = __builtin_amdgcn_readfirstlane(F.tid >> 6); F.G = gridDim.x; F.bx = blockIdx.x;
    F.in = args.in; F.out = args.out; F.ws = args.ws;
    volatile LAS unsigned* MISC = (volatile LAS unsigned*)(F.lds + MISC_OFF);
    for (int u = F.tid; u < (LDS_BYTES - LDSCTL_OFF) / 4; u += NWAVES * 64) ((LAS unsigned*)(F.lds + LDSCTL_OFF))[u] = 0u;
    __syncthreads();
    gu32* ctl = (gu32*)(args.ws + WS_CTL);
    XcdBarrier bar = xcd_barrier_post((unsigned*)(ctl + CW_BAR), MISC + 8);
    unsigned char* ws = args.ws;
    bf16* proj = (bf16*)(ws + WS_PROJ);
    for (int ph = args.ph_lo; ph < args.ph_hi; ++ph) {
        { int t_ = threadIdx.x; asm volatile("" : "+v"(t_)); F.tid = t_; F.lane = t_ & 63; }
        bool is_gemm = false, barrier_after = true;
        pg8::Gemm g{nullptr, nullptr, 0, 0, 0, 0}; pg8::EpiAny E{};
        switch (ph) {
#ifndef NO_P0
        case PH_PROLOGUE: p0_prologue(F); break;
#endif
        case PH_GEMM_IN: p1_scan(F); is_gemm = true; barrier_after = false;
            g = pg8::Gemm{(const bf16*)(ws + WS_XN), (const bf16*)(ws + WS_WIN), M_TOK, PP, DM, DM}; E.kind = 0; E.O = proj; E.ldc = PP; break;
        case PH_GEMM_MKV: is_gemm = true;
            g = pg8::Gemm{(const bf16*)(ws + WS_MN), (const bf16*)(ws + WS_WMKV), NB * 256, 1024, DM, DM}; E.kind = 1; E.O = (bf16*)(ws + WS_KVM); E.ldc = 1024; E.rowss_in = nullptr; break;
#ifndef NO_FIX
        case PH_FIXUP: p3_fixup(F); break;
#endif
#ifndef NO_ATTN
        case PH_ATTN: p4_attention(F); break;
#endif
        case PH_GEMM_FOXUP: is_gemm = true;
            g = pg8::Gemm{proj + C_FQ, (const bf16*)(ws + WS_WFOX), M_TOK, DM, 1024, PP}; E.kind = 2; E.O = (bf16*)(ws + WS_XN); E.ldc = DM; E.Gt = proj + C_G0; E.ldg = PP; break;
        case PH_GEMM_RETUP: is_gemm = true;
            g = pg8::Gemm{proj + C_RQ, (const bf16*)(ws + WS_WRET), M_TOK, DM, 1024, PP}; E.kind = 3; E.O = (bf16*)(ws + WS_XN); E.ldc = DM; E.Gt = proj + C_G1; E.ldg = PP; break;
        case PH_GEMM_OUT: is_gemm = true;
            g = pg8::Gemm{(const bf16*)(ws + WS_XN), (const bf16*)(ws + WS_WOUT), M_TOK, DM, DM, DM}; E.kind = 4; E.base = args.in[I_X]; E.out = args.out; E.O = (bf16*)(ws + WS_XB1); E.ldc = DM; E.rowss = (float*)(ws + WS_ROWSS1); break;
        case PH_GEMM_MQ: if (F.bx >= 128) p8_convert_peer(F); is_gemm = true;
            g = pg8::Gemm{(const bf16*)(ws + WS_XB1), (const bf16*)(ws + WS_WMQ), M_TOK, 512, DM, DM}; E.kind = 1; E.O = (bf16*)(ws + WS_QM); E.ldc = 512; E.rowss_in = (const float*)(ws + WS_ROWSS1); break;
        case PH_MQ_NORM: p9_mq_norm(F); break;
        case PH_MEM_ATTN: p10_mem_attention(F); break;
        case PH_GEMM_MO: is_gemm = true;
            g = pg8::Gemm{(const bf16*)(ws + WS_OMEM), (const bf16*)(ws + WS_WMO), M_TOK, DM, 512, 512}; E.kind = 4; E.base = args.out; E.out = args.out; E.O = (bf16*)(ws + WS_XN); E.ldc = DM; E.rowss = (float*)(ws + WS_ROWSS2); break;
        case PH_GEMM_PQ: is_gemm = true;
            g = pg8::Gemm{(const bf16*)(ws + WS_XN), (const bf16*)(ws + WS_WPQ), M_TOK, DM, DM, DM}; E.kind = 1; E.O = (bf16*)(ws + WS_QP); E.ldc = DM; E.rowss_in = (const float*)(ws + WS_ROWSS2); break;
#ifdef NAIVE_TOPK
        case PH_TOPK: p13_topk_naive(F); break;
#else
        case PH_TOPK: p13_topk(F); break;
#endif
#ifdef NAIVE_EXPERTS
        case PH_EXPERTS: p14_experts_naive(F); break;
#else
        case PH_EXPERTS: p14_experts(F); break;
#endif
        default: break;
        }
#ifndef NO_GEMM
        if (is_gemm) { pg8::StaticOrder S; S.init(g.M, g.N, F.G, F.bx); pg8::gemm_phase<pg8::EpiAny, pg8::StaticOrder, true, true>(F.lds, g, S, E); }
#endif
        if (barrier_after && ph + 1 < args.ph_hi) xcd_barrier(bar);
    }
    if (xb_ld((unsigned*)(ctl + CW_BAR) + XB_TMO) != 0u) { const float q = __builtin_nanf(""); for (size_t i = (size_t)F.bx * 512 + F.tid; i < (size_t)M_TOK * DM / 4; i += (size_t)F.G * 512) ((f32x4*)args.out)[i] = (f32x4){q, q, q, q}; }
}

extern "C" void kernel_launch(void* const* d_in, const int* in_sizes, int n_in, void* d_out, int out_size, void* d_ws, size_t ws_size, hipStream_t stream) {
    static int grid = 0;
    if (grid == 0) {
        if (n_in != 23 || out_size != M_TOK * DM || ws_size < WS_END) { fprintf(stderr, "kernel_launch: unexpected shapes (n_in %d out %d ws %zu)\n", n_in, out_size, ws_size); grid = -1; return; }
        int dev = 0, cus = 0, per_cu = 0;
        if (hipGetDevice(&dev) != hipSuccess || hipDeviceGetAttribute(&cus, hipDeviceAttributeMultiprocessorCount, dev) != hipSuccess) { grid = -1; return; }
        if (hipFuncSetAttribute((const void*)mega_fwd, hipFuncAttributeMaxDynamicSharedMemorySize, LDS_BYTES) != hipSuccess) { fprintf(stderr, "hipFuncSetAttribute failed\n"); grid = -1; return; }
        if (hipOccupancyMaxActiveBlocksPerMultiprocessor(&per_cu, (const void*)mega_fwd, NWAVES * 64, LDS_BYTES) != hipSuccess || per_cu < 1) fprintf(stderr, "occupancy query reports %d\n", per_cu);
        (void)hipGetLastError();
        grid = cus;
        if (grid != 256) { fprintf(stderr, "kernel_launch: built for 256 CUs, got %d\n", cus); grid = -1; return; }
    }
    if (grid < 0) return;
    (void)hipMemsetAsync((char*)d_ws + WS_CTL, 0, CTL_ZERO_BYTES, stream);
    Args a{};
    for (int i = 0; i < 23; ++i) a.in[i] = (const float*)d_in[i];
    a.out = (float*)d_out; a.ws = (unsigned char*)d_ws; a.ph_lo = 0; a.ph_hi = LAST_PHASE + 1;
    hipLaunchKernelGGL(mega_fwd, dim3(grid), dim3(NWAVES * 64), LDS_BYTES, stream, a);
}
```

```cpp
#include <hip/hip_runtime.h>
#include <cstdio>
#include <cstdint>
#include <cmath>
#define FP8_UP_OUT 0
namespace pg8 {
#define PG8_LAS __attribute__((address_space(3)))
typedef unsigned short bf16_t;
typedef short bf16x8 __attribute__((ext_vector_type(8)));
typedef float f32x4 __attribute__((ext_vector_type(4)));
typedef unsigned u32x4 __attribute__((ext_vector_type(4)));
constexpr int BM = 256, BK = 64, HALF = 128, HTB = HALF * BK * 2  , STAGE_BYTES = 8 * HTB, NXCD = 8, WGM = 8;

__host__ __device__ __forceinline__ int lds_byte(int r, int c) { const int st = (r >> 4) * 2 + (c >> 5), rr = r & 15, cc = c & 31, ob = rr * 64 + cc * 2; return st * 1024 + (ob ^ (((ob >> 9) & 1) << 5)); }
__host__ __device__ __forceinline__ void stage_rc(int b, int& R, int& C) { const int st = b / 1024, sb = b % 1024, swz = sb ^ (((sb >> 9) & 1) << 5); R = (st >> 1) * 16 + swz / 64; C = (st & 1) * 32 + (swz % 64) / 2; }
__host__ __device__ __forceinline__ int perm32(int rho) { const int n = rho >> 4, i = rho & 15; return 8 * (i >> 2) + 4 * n + (i & 3); }

struct Unit { int pm, pn, kp; };
typedef int pg8_v4i __attribute__((ext_vector_type(4)));
struct Gemm { const bf16_t* A; const bf16_t* Bt; int M, N, K, lda; int scale_b; int ldb; };

struct StaticOrder {
    int nM, nN, nwg, G, c, kshift = 0;
    __host__ __device__ __forceinline__ void init(int M, int N, int G_, int c_) { nM = M / BM; nN = N / BM; nwg = nM * nN; G = G_; c = c_; }
    __host__ __device__ __forceinline__ bool next(int i2, Unit& u) const {
        const int i = i2 >> kshift; u.kp = i2 & ((1 << kshift) - 1);
        const long L = (long)i * G + c; if (L >= nwg) return false;
        int wgid = (int)L; { const int q = nwg / NXCD, r = nwg % NXCD, xcd = wgid % NXCD, off = wgid / NXCD; wgid = (xcd < r ? xcd * (q + 1) : r * (q + 1) + (xcd - r) * q) + off; }
        const int nig = WGM * nN, gid = wgid / nig, fm = gid * WGM, gsz = (nM - fm) < WGM ? (nM - fm) : WGM;
        u.pm = fm + ((wgid % nig) % gsz); u.pn = (wgid % nig) / gsz; return true;
    }
    __device__ __forceinline__ void a_ready(const Unit&) const {}
    __device__ __forceinline__ void done(const Unit&) const {}
};

__device__ __forceinline__ unsigned cvt_pk_bf16(float lo, float hi) { unsigned r; asm volatile("v_cvt_pk_bf16_f32 %0, %1, %2" : "=v"(r) : "v"(lo), "v"(hi)); return r; }
typedef float f32x2 __attribute__((ext_vector_type(2)));
__device__ __forceinline__ f32x2 gelu_pk(f32x2 v) {
    const f32x2 av = __builtin_elementwise_abs(v), d = av * 0.2316418882f + 1.0f;
    f32x2 t; t.x = __builtin_amdgcn_rcpf(d.x); t.y = __builtin_amdgcn_rcpf(d.y);
    f32x2 q = t * 0.5307027145f + (-0.7265760135f); q = q * t + 0.7107068705f; q = q * t + (-0.142248368f); q = q * t + 0.127414796f; q = q * t;
    const f32x2 s = (v * v) * (-0.72134752044f);
    f32x2 e; e.x = __builtin_amdgcn_exp2f(s.x); e.y = __builtin_amdgcn_exp2f(s.y);
    const f32x2 m = v * (q * e), r = v - m;
    f32x2 o; o.x = v.x < 0.f ? m.x : r.x; o.y = v.y < 0.f ? m.y : r.y; return o;
}

template <int ACT  > struct EpiBf16 {
    static constexpr bool PERM = true, AFTER_DRAIN = false; static_assert(ACT == 0 || ACT == 1, "EpiBf16: ACT is 0 (none) or 1 (gelu_pk)");
    bf16_t* O; int ldc; const float* bias; int split_cols; size_t split_stride; float scale0;
    __device__ __forceinline__ void operator()(const f32x4 (&acc)[2][2][4][2], const Unit& u, int wr, int wc, int fr, int fq) const {
        const int row0 = u.pm * BM + wr * 64 + fr; int colt = u.pn * BM; bf16_t* base = O;
        float sc = 1.f; if (split_cols) { const int t = colt / split_cols; base += (size_t)t * split_stride; colt -= t * split_cols; if (t == 0) sc = scale0; }
        const int col0 = colt + wc * 32 + 8 * fq, bcol0 = u.pn * BM + wc * 32 + 8 * fq;
        f32x4 bv[2][2];
#pragma unroll
        for (int bj = 0; bj < 2; ++bj)
#pragma unroll
            for (int n = 0; n < 2; ++n) bv[bj][n] = bias ? *(const f32x4*)(bias + bcol0 + bj * HALF + 4 * n) : (f32x4){0.f, 0.f, 0.f, 0.f};
#pragma unroll
        for (int ai = 0; ai < 2; ++ai)
#pragma unroll
            for (int m = 0; m < 4; ++m) { bf16_t* rowp = base + (size_t)(row0 + ai * HALF + m * 16) * ldc + col0;
#pragma unroll
                for (int bj = 0; bj < 2; ++bj) { f32x4 v0 = acc[ai][bj][m][0] + bv[bj][0], v1 = acc[ai][bj][m][1] + bv[bj][1];
                    if (ACT == 1) { f32x2 a = gelu_pk((f32x2){v0[0], v0[1]}), b = gelu_pk((f32x2){v0[2], v0[3]}), c = gelu_pk((f32x2){v1[0], v1[1]}), d = gelu_pk((f32x2){v1[2], v1[3]});
                        v0 = (f32x4){a.x, a.y, b.x, b.y}; v1 = (f32x4){c.x, c.y, d.x, d.y}; }
                    v0 = v0 * sc; v1 = v1 * sc; u32x4 w; w.x = cvt_pk_bf16(v0[0], v0[1]); w.y = cvt_pk_bf16(v0[2], v0[3]); w.z = cvt_pk_bf16(v1[0], v1[1]); w.w = cvt_pk_bf16(v1[2], v1[3]);
                    *(u32x4*)(rowp + bj * HALF) = w; } }
    }
};

struct PanelStats {
    unsigned* xbuf;
    unsigned* cnt;
    unsigned* tmo;
    int ntn; float eps;
    unsigned code;
    __device__ __forceinline__ bool run(const f32x4 (&v)[2][2][4][2], const Unit& u, int wr, int wc, int fr, int fq, PG8_LAS unsigned char* lds, int wid, int lane) const {
        typedef float f32x2v __attribute__((ext_vector_type(2)));
        PG8_LAS f32x2v* P = (PG8_LAS f32x2v*)lds;
        PG8_LAS f32x2v* S = (PG8_LAS f32x2v*)(lds + 8192);
        PG8_LAS unsigned* flag = (PG8_LAS unsigned*)(lds + 8192 + 2048);
#pragma unroll
        for (int ai = 0; ai < 2; ++ai)
#pragma unroll
            for (int m = 0; m < 4; ++m) {
                float s = 0.f;
#pragma unroll
                for (int bj = 0; bj < 2; ++bj)
#pragma unroll
                    for (int n = 0; n < 2; ++n) { const f32x4 x = v[ai][bj][m][n]; s += (x[0] + x[1]) + (x[2] + x[3]); }
                s += __shfl_xor(s, 16); s += __shfl_xor(s, 32);
                const float mw = s * (1.0f / 64.0f); float q = 0.f;
#pragma unroll
                for (int bj = 0; bj < 2; ++bj)
#pragma unroll
                    for (int n = 0; n < 2; ++n) { const f32x4 d = v[ai][bj][m][n] - mw; q += (d[0] * d[0] + d[1] * d[1]) + (d[2] * d[2] + d[3] * d[3]); }
                q += __shfl_xor(q, 16); q += __shfl_xor(q, 32);
                if (fq == 0) P[(ai * HALF + wr * 64 + m * 16 + fr) * 4 + wc] = (f32x2v){mw, q};
            }
        asm volatile("s_waitcnt lgkmcnt(0)" ::: "memory"); __builtin_amdgcn_s_barrier(); asm volatile("" ::: "memory");
#if defined(BROKEN_EXCHANGE_NO_WAIT)
#warning BROKEN CONTROL BUILD: the row-statistics exchange does not wait; results are wrong by design
        if (blockIdx.x >= 64) { const long long t0_ = clock64(); while (clock64() - t0_ < 60000) __builtin_amdgcn_s_sleep(8); }
#endif
        const int row = wid * 32 + (lane & 31);
        if (lane < 32) {
            const f32x2v a = P[row * 4 + 0], b = P[row * 4 + 1], c = P[row * 4 + 2], d = P[row * 4 + 3];
            const float mt = (a.x + b.x + c.x + d.x) * 0.25f;
            const float da = a.x - mt, db = b.x - mt, dc = c.x - mt, dd = d.x - mt;
            const float m2 = (a.y + b.y) + (c.y + d.y) + 64.0f * ((da * da + db * db) + (dc * dc + dd * dd));
            unsigned long long* slot = (unsigned long long*)xbuf + ((size_t)(u.pm * BM + row) * 4 + u.pn);
            __hip_atomic_store(slot, ((unsigned long long)__float_as_uint(m2) << 32) | __float_as_uint(mt), __ATOMIC_RELAXED, __HIP_MEMORY_SCOPE_AGENT);
        }
        asm volatile("s_waitcnt vmcnt(0)" ::: "memory");
        if (lane == 0) __hip_atomic_fetch_add(cnt + 64 * u.pm, 1u, __ATOMIC_RELAXED, __HIP_MEMORY_SCOPE_AGENT);
        if (wid == 0) {
            bool dead = false; const unsigned long long t0 = __builtin_amdgcn_s_memrealtime(); const unsigned want = 8u * (unsigned)ntn;
            for (;;) {
#if defined(BROKEN_EXCHANGE_NO_WAIT)
                break;
#endif
                if ((unsigned)__builtin_amdgcn_readfirstlane(__hip_atomic_load(cnt + 64 * u.pm, __ATOMIC_RELAXED, __HIP_MEMORY_SCOPE_AGENT)) >= want) break;
                if (__builtin_amdgcn_s_memrealtime() - t0 > 2000000ull) {
                    if (lane == 0) { unsigned expect = 0u; __hip_atomic_compare_exchange_strong(tmo + 1, &expect, code | (unsigned)(u.pm & 0xff), __ATOMIC_RELAXED, __ATOMIC_RELAXED, __HIP_MEMORY_SCOPE_AGENT);
                                     __hip_atomic_store(tmo, 1u, __ATOMIC_RELAXED, __HIP_MEMORY_SCOPE_AGENT); }
                    dead = true; break; }
                __builtin_amdgcn_s_sleep(2);
            }
            __builtin_amdgcn_fence(__ATOMIC_ACQUIRE, "agent");
            if (lane == 0) flag[0] = dead ? 1u : 0u;
        }
        asm volatile("s_waitcnt vmcnt(0) lgkmcnt(0)" ::: "memory"); __builtin_amdgcn_s_barrier(); asm volatile("" ::: "memory");
        const bool bad = flag[0] != 0u;
        if (lane < 32) {
            const unsigned long long* slot = (const unsigned long long*)xbuf + (size_t)(u.pm * BM + row) * 4; float mt[4], m2[4]; float ms = 0.f;
#pragma unroll
            for (int t = 0; t < 4; ++t) { if (t < ntn) { const unsigned long long w = __hip_atomic_load(slot + t, __ATOMIC_RELAXED, __HIP_MEMORY_SCOPE_AGENT); mt[t] = __uint_as_float((unsigned)w); m2[t] = __uint_as_float((unsigned)(w >> 32)); } else { mt[t] = 0.f; m2[t] = 0.f; } ms += mt[t]; }
            const float mean = ms / (float)ntn; float q = 0.f;
#pragma unroll
            for (int t = 0; t < 4; ++t) if (t < ntn) { const float dm = mt[t] - mean; q += m2[t] + 256.0f * dm * dm; }
            S[row] = (f32x2v){mean, 1.0f / sqrtf(q / (256.0f * (float)ntn) + eps)};
        }
        asm volatile("s_waitcnt lgkmcnt(0)" ::: "memory"); __builtin_amdgcn_s_barrier(); asm volatile("" ::: "memory");
        return bad;
    }
};
struct EpiLnRes {
    static constexpr bool PERM = false, AFTER_DRAIN = true;
    const float* base; float* out; int ldc; const float* bias; PanelStats st; unsigned poison;
    __device__ __forceinline__ void fused(f32x4 (&acc)[2][2][4][2], const Unit& u, int wr, int wc, int fr, int fq, PG8_LAS unsigned char* lds, int wid, int lane) const {
        typedef float f32x2v __attribute__((ext_vector_type(2)));
        const PG8_LAS f32x2v* S = (const PG8_LAS f32x2v*)(lds + 8192);
        const int col0 = u.pn * BM + wc * 32 + 4 * fq;
#pragma unroll
        for (int bj = 0; bj < 2; ++bj)
#pragma unroll
            for (int n = 0; n < 2; ++n) { const f32x4 bv = bias ? *(const f32x4*)(bias + col0 + bj * HALF + n * 16) : (f32x4){0.f, 0.f, 0.f, 0.f};
#pragma unroll
                for (int ai = 0; ai < 2; ++ai)
#pragma unroll
                    for (int m = 0; m < 4; ++m) acc[ai][bj][m][n] += bv; }
        f32x4 pre[4][2][2];
#pragma unroll
        for (int m = 0; m < 4; ++m) { const size_t off = (size_t)(u.pm * BM + wr * 64 + m * 16 + fr) * ldc + col0;
#pragma unroll
            for (int bj = 0; bj < 2; ++bj)
#pragma unroll
                for (int n = 0; n < 2; ++n) pre[m][bj][n] = *(const f32x4*)(base + off + bj * HALF + n * 16); }
        const bool bad = st.run(acc, u, wr, wc, fr, fq, lds, wid, lane) || poison != 0u;
        const float qnan = __builtin_nanf("");
#pragma unroll
        for (int ai = 0; ai < 2; ++ai)
#pragma unroll
            for (int m = 0; m < 4; ++m) { const int r = ai * HALF + wr * 64 + m * 16 + fr; const f32x2v sr = S[r]; const size_t off = (size_t)(u.pm * BM + r) * ldc + col0;
#pragma unroll
                for (int bj = 0; bj < 2; ++bj)
#pragma unroll
                    for (int n = 0; n < 2; ++n) { const f32x4 bs = ai == 0 ? pre[m][bj][n] : *(const f32x4*)(base + off + bj * HALF + n * 16); f32x4 o = bs + (acc[ai][bj][m][n] - sr.x) * sr.y;
                        if (bad) o = (f32x4){qnan, qnan, qnan, qnan}; *(f32x4*)(out + off + bj * HALF + n * 16) = o; }
                if (m & 1) asm volatile("" ::: "memory"); }
    }
};
struct EpiLnResLn {
    static constexpr bool PERM = false, AFTER_DRAIN = true;
    const float* base; float* out; bf16_t* xn; int ldc; const float* bias; PanelStats st1, st2; unsigned poison;
    __device__ __forceinline__ void fused(f32x4 (&acc)[2][2][4][2], const Unit& u, int wr, int wc, int fr, int fq, PG8_LAS unsigned char* lds, int wid, int lane) const {
        typedef float f32x2v __attribute__((ext_vector_type(2))); typedef unsigned u32x2v __attribute__((ext_vector_type(2)));
        const PG8_LAS f32x2v* S = (const PG8_LAS f32x2v*)(lds + 8192);
        const int col0 = u.pn * BM + wc * 32 + 4 * fq;
#pragma unroll
        for (int bj = 0; bj < 2; ++bj)
#pragma unroll
            for (int n = 0; n < 2; ++n) { const f32x4 bv = bias ? *(const f32x4*)(bias + col0 + bj * HALF + n * 16) : (f32x4){0.f, 0.f, 0.f, 0.f};
#pragma unroll
                for (int ai = 0; ai < 2; ++ai)
#pragma unroll
                    for (int m = 0; m < 4; ++m) acc[ai][bj][m][n] += bv; }
        bool bad = st1.run(acc, u, wr, wc, fr, fq, lds, wid, lane) || poison != 0u;
        const float qnan = __builtin_nanf("");
#pragma unroll
        for (int ai = 0; ai < 2; ++ai)
#pragma unroll
            for (int m = 0; m < 4; ++m) { const int r = ai * HALF + wr * 64 + m * 16 + fr; const f32x2v sr = S[r]; const size_t off = (size_t)(u.pm * BM + r) * ldc + col0;
#pragma unroll
                for (int bj = 0; bj < 2; ++bj)
#pragma unroll
                    for (int n = 0; n < 2; ++n) { const f32x4 bs = *(const f32x4*)(base + off + bj * HALF + n * 16); acc[ai][bj][m][n] = bs + (acc[ai][bj][m][n] - sr.x) * sr.y; }
                asm volatile("" : "+v"(acc[ai][0][m][0]), "+v"(acc[ai][0][m][1]), "+v"(acc[ai][1][m][0]), "+v"(acc[ai][1][m][1]));
                if (m & 1) asm volatile("" ::: "memory"); }
        const bool bad1 = bad;
        bad = st2.run(acc, u, wr, wc, fr, fq, lds, wid, lane) || bad;
#pragma unroll
        for (int ai = 0; ai < 2; ++ai)
#pragma unroll
            for (int m = 0; m < 4; ++m) { const int r = ai * HALF + wr * 64 + m * 16 + fr; const f32x2v sr = S[r]; const size_t off = (size_t)(u.pm * BM + r) * ldc + col0;
#pragma unroll
                for (int bj = 0; bj < 2; ++bj)
#pragma unroll
                    for (int n = 0; n < 2; ++n) { const f32x4 x1 = acc[ai][bj][m][n]; *(f32x4*)(out + off + bj * HALF + n * 16) = bad1 ? (f32x4){qnan, qnan, qnan, qnan} : x1;
                        const f32x4 o = (x1 - sr.x) * sr.y; u32x2v w; w.x = cvt_pk_bf16(o[0], o[1]); w.y = cvt_pk_bf16(o[2], o[3]);
                        if (bad) { w.x = 0x7fc07fc0u; w.y = 0x7fc07fc0u; } *(u32x2v*)(xn + off + bj * HALF + n * 16) = w; }
                asm volatile("" ::: "memory"); }
    }
};

typedef int pg8_v8i __attribute__((ext_vector_type(8)));
template <bool FP8> struct Frag;
template <> struct Frag<false> { bf16x8 k[2]; };
template <> struct Frag<true> { pg8_v8i v; };
__device__ __forceinline__ void load_frag(Frag<false>& f, const PG8_LAS unsigned char* p) { f.k[0] = *(const PG8_LAS bf16x8*)p; f.k[1] = *(const PG8_LAS bf16x8*)(p + 1024); }
__device__ __forceinline__ void load_frag(Frag<true>& f, const PG8_LAS unsigned char* p) { const pg8_v4i a = *(const PG8_LAS pg8_v4i*)p, b = *(const PG8_LAS pg8_v4i*)(p + 1024); f.v = __builtin_shufflevector(a, b, 0, 1, 2, 3, 4, 5, 6, 7); }
__device__ __forceinline__ void mma_frag(f32x4& acc, const Frag<false>& b, const Frag<false>& a, int) { acc = __builtin_amdgcn_mfma_f32_16x16x32_bf16(b.k[0], a.k[0], acc, 0, 0, 0); acc = __builtin_amdgcn_mfma_f32_16x16x32_bf16(b.k[1], a.k[1], acc, 0, 0, 0); }
__device__ __forceinline__ void mma_frag(f32x4& acc, const Frag<true>& b, const Frag<true>& a, int scale_w) {
    asm volatile("v_mfma_scale_f32_16x16x128_f8f6f4 %0, %1, %2, %0, %3, %4 op_sel_hi:[0,0,0]" : "+v"(acc) : "v"(b.v), "v"(a.v), "v"(scale_w), "v"(0x7F7F7F7F)); }
template <class Epi, class Sched, bool ALIGN_EPI = false, bool SP2 = false, bool FP8 = false>
__device__ __forceinline__ void gemm_phase(PG8_LAS unsigned char* lds, const Gemm g, const Sched& S, const Epi& E) {
    int tid_ = threadIdx.x; asm volatile("" : "+v"(tid_));
    const int tid = tid_, wid = __builtin_amdgcn_readfirstlane(tid >> 6), lane = tid & 63, wr = wid >> 2, wc = wid & 3, fr = lane & 15, fq = lane >> 4;
    const int K = g.K, nt = K / BK;
    unsigned voffA[2], voffB[2];
#pragma unroll
    for (int i = 0; i < 2; ++i) { int R, C; stage_rc(tid * 16 + i * 8192, R, C); const int Rb = Epi::PERM ? ((R & ~31) + perm32(R & 31)) : R;
        voffA[i] = (unsigned)(R * g.lda + C) * 2u; voffB[i] = (unsigned)(Rb * g.ldb + C) * 2u; }
    const size_t kstep = (size_t)(BK * 2);
    const size_t hstepB = (size_t)HALF * g.ldb * 2, hstepA = (size_t)HALF * g.lda * 2;
    const size_t tstepB = 2 * hstepB, tstepA = 2 * hstepA;
    const unsigned ldsw = (unsigned)wid * 1024u;
    const int aoff = lds_byte(wr * 64 + fr, fq * 8), boff = lds_byte(wc * 32 + fr, fq * 8);
#define PG8_SA(b, h) (((b) * 2 + (h)) * HTB)
#define PG8_SB(b, h) ((4 + (b) * 2 + (h)) * HTB)
#define PG8_STAGE(bufoff, gbase, voff) do { _Pragma("unroll") for (int _i = 0; _i < 2; ++_i) \
        __builtin_amdgcn_global_load_lds((const unsigned*)((const char*)(gbase) + (voff)[_i]), (PG8_LAS unsigned*)(lds + (bufoff) + ldsw + _i * 8192), 16, 0, 0); } while (0)
#define PG8_LDA(dst, b, h) do { _Pragma("unroll") for (int m = 0; m < 4; ++m) load_frag(dst[m], lds + PG8_SA(b, h) + aoff + m * 2048); } while (0)
#define PG8_LDB(dst, b, h) do { _Pragma("unroll") for (int n = 0; n < 2; ++n) load_frag(dst[n], lds + PG8_SB(b, h) + boff + n * 2048); } while (0)
#define PG8_MMA(ai, bj, At, Bt) do { __builtin_amdgcn_s_setprio(1); _Pragma("unroll") for (int m = 0; m < 4; ++m) _Pragma("unroll") for (int n = 0; n < 2; ++n) mma_frag(acc[ai][bj][m][n], Bt[n], At[m], g.scale_b); \
        __builtin_amdgcn_s_setprio(0); } while (0)
#define PG8_WAIT_V(n) asm volatile("s_waitcnt vmcnt(" #n ")" ::: "memory")
#define PG8_WAIT_L(n) asm volatile("s_waitcnt lgkmcnt(" #n ")" ::: "memory")
#define PG8_BAR __builtin_amdgcn_s_barrier()
#define PG8_SCHED __builtin_amdgcn_sched_barrier(0)
    Unit cur, nxt; int ui = 0;
    if (!S.next(0, cur)) return;
    f32x4 acc[2][2][4][2];
#pragma unroll
    for (int a = 0; a < 2; ++a)
#pragma unroll
        for (int b = 0; b < 2; ++b)
#pragma unroll
            for (int m = 0; m < 4; ++m)
#pragma unroll
                for (int n = 0; n < 2; ++n) acc[a][b][m][n] = (f32x4){0.f, 0.f, 0.f, 0.f};
    Frag<FP8> At[4], B0[2], B1[2];
    const size_t kpart = (size_t)K * 2;
    const char* cA = (const char*)g.A + (size_t)cur.pm * tstepA + cur.kp * kpart; const char* cB = (const char*)g.Bt + (size_t)cur.pn * tstepB + cur.kp * kpart;
    S.a_ready(cur);
    if constexpr (SP2) {
        PG8_STAGE(PG8_SB(0, 0), cB, voffB); PG8_STAGE(PG8_SB(0, 1), cB + hstepB, voffB); PG8_STAGE(PG8_SA(0, 0), cA, voffA); PG8_STAGE(PG8_SA(0, 1), cA + hstepA, voffA);
        if (wr == 1) PG8_BAR;
        PG8_WAIT_V(2); PG8_BAR;
        PG8_STAGE(PG8_SB(1, 0), cB + kstep, voffB); PG8_STAGE(PG8_SA(1, 0), cA + kstep, voffA); PG8_STAGE(PG8_SB(1, 1), cB + hstepB + kstep, voffB);
        PG8_WAIT_V(6); PG8_BAR;
    } else {
        PG8_STAGE(PG8_SB(0, 0), cB, voffB); PG8_STAGE(PG8_SA(0, 0), cA, voffA); PG8_STAGE(PG8_SB(0, 1), cB + hstepB, voffB); PG8_STAGE(PG8_SA(0, 1), cA + hstepA, voffA);
        if (wr == 1) PG8_BAR;
        PG8_WAIT_V(4); PG8_BAR;
        PG8_STAGE(PG8_SB(1, 0), cB + kstep, voffB); PG8_STAGE(PG8_SA(1, 0), cA + kstep, voffA); PG8_STAGE(PG8_SB(1, 1), cB + hstepB + kstep, voffB);
        PG8_WAIT_V(6); PG8_BAR;
    }
    for (;;) {
        const bool has_next = S.next(ui + 1, nxt);
        const char* nA = has_next ? (const char*)g.A + (size_t)nxt.pm * tstepA + nxt.kp * kpart : cA; const char* nB = has_next ? (const char*)g.Bt + (size_t)nxt.pn * tstepB + nxt.kp * kpart : cB;
        for (int t = 0; t < nt; t += 2) {
            const bool last = (t == nt - 2);
            const char* a1 = cA + (size_t)(t + 1) * kstep;
            const char* a2 = last ? nA : cA + (size_t)(t + 2) * kstep; const char* b2 = last ? nB : cB + (size_t)(t + 2) * kstep;
            const char* a3 = a2 + kstep; const char* b3 = b2 + kstep;
            if (last && has_next) S.a_ready(nxt);
            if constexpr (SP2) {
            PG8_LDB(B0, 0, 0); PG8_LDB(B1, 0, 1); PG8_SCHED; PG8_LDA(At, 0, 0); PG8_STAGE(PG8_SA(1, 1), a1 + hstepA, voffA);
            PG8_WAIT_V(8); PG8_WAIT_L(0); PG8_BAR; PG8_MMA(0, 0, At, B0); PG8_MMA(0, 1, At, B1); PG8_BAR; PG8_SCHED;
            PG8_LDA(At, 0, 1); PG8_STAGE(PG8_SB(0, 0), b2, voffB); PG8_STAGE(PG8_SB(0, 1), b2 + hstepB, voffB); PG8_STAGE(PG8_SA(0, 0), a2, voffA);
            PG8_WAIT_V(8); PG8_WAIT_L(0); PG8_BAR; PG8_MMA(1, 0, At, B0); PG8_MMA(1, 1, At, B1); PG8_BAR; PG8_SCHED;
            PG8_LDB(B0, 1, 0); PG8_LDB(B1, 1, 1); PG8_SCHED; PG8_LDA(At, 1, 0); PG8_STAGE(PG8_SA(0, 1), a2 + hstepA, voffA);
            PG8_WAIT_V(8); PG8_WAIT_L(0); PG8_BAR; PG8_MMA(0, 0, At, B0); PG8_MMA(0, 1, At, B1); PG8_BAR; PG8_SCHED;
            PG8_LDA(At, 1, 1); PG8_STAGE(PG8_SB(1, 0), b3, voffB); PG8_STAGE(PG8_SB(1, 1), b3 + hstepB, voffB); PG8_STAGE(PG8_SA(1, 0), a3, voffA);
            PG8_WAIT_V(8); PG8_WAIT_L(0); PG8_BAR; PG8_MMA(1, 0, At, B0); PG8_MMA(1, 1, At, B1); PG8_BAR; PG8_SCHED;
            } else {
            PG8_LDB(B0, 0, 0); PG8_SCHED; PG8_LDA(At, 0, 0); PG8_STAGE(PG8_SA(1, 1), a1 + hstepA, voffA);
            PG8_WAIT_L(8); PG8_BAR; PG8_WAIT_L(0); PG8_MMA(0, 0, At, B0); PG8_BAR; PG8_SCHED;
            PG8_LDB(B1, 0, 1); PG8_STAGE(PG8_SB(0, 0), b2, voffB);
            PG8_BAR; PG8_WAIT_L(0); PG8_MMA(0, 1, At, B1); PG8_BAR;
            PG8_LDA(At, 0, 1); PG8_STAGE(PG8_SA(0, 0), a2, voffA);
            PG8_BAR; PG8_WAIT_L(0); PG8_MMA(1, 0, At, B0); PG8_BAR; PG8_SCHED;
            PG8_STAGE(PG8_SB(0, 1), b2 + hstepB, voffB);
            PG8_WAIT_V(6); PG8_BAR; PG8_MMA(1, 1, At, B1); PG8_BAR;
            PG8_LDB(B0, 1, 0); PG8_SCHED; PG8_LDA(At, 1, 0); PG8_STAGE(PG8_SA(0, 1), a2 + hstepA, voffA);
            PG8_WAIT_L(8); PG8_BAR; PG8_WAIT_L(0); PG8_MMA(0, 0, At, B0); PG8_BAR; PG8_SCHED;
            PG8_LDB(B1, 1, 1); PG8_STAGE(PG8_SB(1, 0), b3, voffB);
            PG8_BAR; PG8_WAIT_L(0); PG8_MMA(0, 1, At, B1); PG8_BAR;
            PG8_LDA(At, 1, 1); PG8_STAGE(PG8_SA(1, 0), a3, voffA);
            PG8_BAR; PG8_WAIT_L(0); PG8_MMA(1, 0, At, B0); PG8_BAR; PG8_SCHED;
            PG8_STAGE(PG8_SB(1, 1), b3 + hstepB, voffB);
            PG8_WAIT_V(6); PG8_BAR; PG8_MMA(1, 1, At, B1); PG8_BAR;
            }
        }
        if constexpr (ALIGN_EPI) { if (wr == 0) PG8_BAR; }
        if constexpr (FP8) { asm volatile("s_nop 15\n\ts_nop 15" ::: "memory"); }
        if constexpr (!Epi::AFTER_DRAIN) { E(acc, cur, wr, wc, fr, fq); S.done(cur); }
        if (!has_next) break;
        if (nxt.kp == 0)
#pragma unroll
        for (int a = 0; a < 2; ++a)
#pragma unroll
            for (int b = 0; b < 2; ++b)
#pragma unroll
                for (int m = 0; m < 4; ++m)
#pragma unroll
                    for (int n = 0; n < 2; ++n) acc[a][b][m][n] = (f32x4){0.f, 0.f, 0.f, 0.f};
        cur = nxt; cA = nA; cB = nB; ++ui;
        if constexpr (ALIGN_EPI) { if (wr == 1) PG8_BAR; }
    }
    PG8_WAIT_V(0);
    if constexpr (!ALIGN_EPI) { if (wr == 0) PG8_BAR; }
    PG8_BAR;
    if constexpr (Epi::AFTER_DRAIN) { E.fused(acc, cur, wr, wc, fr, fq, lds, wid, lane); S.done(cur); }
#undef PG8_SA
#undef PG8_SB
#undef PG8_STAGE
#undef PG8_LDA
#undef PG8_LDB
#undef PG8_MMA
#undef PG8_WAIT_V
#undef PG8_WAIT_L
#undef PG8_BAR
#undef PG8_SCHED
}
}

#ifndef PG8_SP2
#define PG8_SP2 true
#endif
#ifndef PG8_ALIGN
#define PG8_ALIGN true
#endif
namespace pg8 {
typedef unsigned u32x2e __attribute__((ext_vector_type(2)));
__device__ __forceinline__ float bfbits2f(unsigned b16) { return __uint_as_float(b16 << 16); }
__device__ __forceinline__ void unpack8(const u32x4 w, float (&f)[8]) {
    f[0] = __uint_as_float(w.x << 16); f[1] = __uint_as_float(w.x & 0xffff0000u); f[2] = __uint_as_float(w.y << 16); f[3] = __uint_as_float(w.y & 0xffff0000u);
    f[4] = __uint_as_float(w.z << 16); f[5] = __uint_as_float(w.z & 0xffff0000u); f[6] = __uint_as_float(w.w << 16); f[7] = __uint_as_float(w.w & 0xffff0000u);
}
__device__ __forceinline__ u32x4 pack8f(const float (&f)[8]) { u32x4 w; w.x = cvt_pk_bf16(f[0], f[1]); w.y = cvt_pk_bf16(f[2], f[3]); w.z = cvt_pk_bf16(f[4], f[5]); w.w = cvt_pk_bf16(f[6], f[7]); return w; }
__device__ __forceinline__ float sigmoid_f(float x) { return __builtin_amdgcn_rcpf(1.f + __builtin_amdgcn_exp2f(-1.4426950408889634f * x)); }

struct EpiProj {
    static constexpr bool PERM = true, AFTER_DRAIN = false;
    bf16_t* O; int ldc; int pn_off;
    __device__ __forceinline__ void operator()(const f32x4 (&acc)[2][2][4][2], const Unit& u, int wr, int wc, int fr, int fq) const {
        const int row0 = u.pm * BM + wr * 64 + fr, col0 = u.pn * BM + wc * 32 + 8 * fq;
        const int gpn = u.pn + pn_off; const int act = gpn < 24 ? 0 : (gpn < 28 ? 1 : 2);
#pragma unroll
        for (int ai = 0; ai < 2; ++ai)
#pragma unroll
            for (int m = 0; m < 4; ++m) { bf16_t* rowp = O + (size_t)(row0 + ai * HALF + m * 16) * ldc + col0;
#pragma unroll
                for (int bj = 0; bj < 2; ++bj) { float v[8];
#pragma unroll
                    for (int i = 0; i < 4; ++i) { v[i] = acc[ai][bj][m][0][i]; v[4 + i] = acc[ai][bj][m][1][i]; }
                    if (act != 0) {
#pragma unroll
                        for (int i = 0; i < 8; ++i) { const float s = sigmoid_f(v[i]); v[i] = (act == 1) ? v[i] * s : s; } }
                    *(u32x4*)(rowp + bj * HALF) = pack8f(v); } }
    }
};
struct EpiRowScale {
    static constexpr bool PERM = true, AFTER_DRAIN = false;
    bf16_t* O; int ldc; const float* rowss; float inv_n, eps;
    __device__ __forceinline__ void operator()(const f32x4 (&acc)[2][2][4][2], const Unit& u, int wr, int wc, int fr, int fq) const {
        const int row0 = u.pm * BM + wr * 64 + fr, col0 = u.pn * BM + wc * 32 + 8 * fq;
#pragma unroll
        for (int ai = 0; ai < 2; ++ai)
#pragma unroll
            for (int m = 0; m < 4; ++m) { const int row = row0 + ai * HALF + m * 16; bf16_t* rowp = O + (size_t)row * ldc + col0;
                float sc = 1.f; if (rowss) sc = 1.f / sqrtf(__hip_atomic_load(rowss + row, __ATOMIC_RELAXED, __HIP_MEMORY_SCOPE_AGENT) * inv_n + eps);
#pragma unroll
                for (int bj = 0; bj < 2; ++bj) { float v[8];
#pragma unroll
                    for (int i = 0; i < 4; ++i) { v[i] = acc[ai][bj][m][0][i] * sc; v[4 + i] = acc[ai][bj][m][1][i] * sc; }
                    *(u32x4*)(rowp + bj * HALF) = pack8f(v); } }
    }
};
template <bool ADD> struct EpiGate {
    static constexpr bool PERM = true, AFTER_DRAIN = false;
    bf16_t* O; int ldc; const bf16_t* Gt; int ldg; unsigned char* O8; int ld8;
    __device__ __forceinline__ void operator()(const f32x4 (&acc)[2][2][4][2], const Unit& u, int wr, int wc, int fr, int fq) const {
        const int row0 = u.pm * BM + wr * 64 + fr, col0 = u.pn * BM + wc * 32 + 8 * fq;
#pragma unroll
        for (int ai = 0; ai < 2; ++ai)
#pragma unroll
            for (int m = 0; m < 4; ++m) { const int row = row0 + ai * HALF + m * 16; bf16_t* rowp = O + (size_t)row * ldc + col0; const bf16_t* gp = Gt + (size_t)row * ldg + col0;
#pragma unroll
                for (int bj = 0; bj < 2; ++bj) { float v[8], g[8]; unpack8(*(const u32x4*)(gp + bj * HALF), g);
#pragma unroll
                    for (int i = 0; i < 4; ++i) { v[i] = acc[ai][bj][m][0][i] * g[i]; v[4 + i] = acc[ai][bj][m][1][i] * g[4 + i]; }
                    if (ADD) { float t[8]; unpack8(*(const u32x4*)(rowp + bj * HALF), t);
#pragma unroll
                        for (int i = 0; i < 8; ++i) v[i] += t[i];
                        int p0 = 0, p1 = 0; p0 = __builtin_amdgcn_cvt_pk_fp8_f32(v[0], v[1], p0, false); p0 = __builtin_amdgcn_cvt_pk_fp8_f32(v[2], v[3], p0, true);
                        p1 = __builtin_amdgcn_cvt_pk_fp8_f32(v[4], v[5], p1, false); p1 = __builtin_amdgcn_cvt_pk_fp8_f32(v[6], v[7], p1, true);
                        if (O8) *(u32x2e*)(O8 + (size_t)row * ld8 + col0 + bj * HALF) = (u32x2e){(unsigned)p0, (unsigned)p1}; else *(u32x4*)(rowp + bj * HALF) = pack8f(v); }
                    else *(u32x4*)(rowp + bj * HALF) = pack8f(v); } }
    }
};
struct EpiGate8 {
    static constexpr bool PERM = true, AFTER_DRAIN = false;
    const bf16_t* G1; int ldg; unsigned char* O8; int ld8;
    __device__ __forceinline__ void operator()(const f32x4 (&acc)[2][2][4][2], const Unit& u, int wr, int wc, int fr, int fq) const {
        const int row0 = u.pm * BM + wr * 64 + fr, col0 = u.pn * BM + wc * 32 + 8 * fq;
#pragma unroll
        for (int ai = 0; ai < 2; ++ai)
#pragma unroll
            for (int m = 0; m < 4; ++m) { const int row = row0 + ai * HALF + m * 16; const bf16_t* gp = G1 + (size_t)row * ldg + col0;
#pragma unroll
                for (int bj = 0; bj < 2; ++bj) { float v[8], g[8]; unpack8(*(const u32x4*)(gp + bj * HALF), g);
#pragma unroll
                    for (int i = 0; i < 4; ++i) { v[i] = acc[ai][bj][m][0][i] * g[i]; v[4 + i] = acc[ai][bj][m][1][i] * g[4 + i]; }
                    int p0 = 0, p1 = 0; p0 = __builtin_amdgcn_cvt_pk_fp8_f32(v[0], v[1], p0, false); p0 = __builtin_amdgcn_cvt_pk_fp8_f32(v[2], v[3], p0, true);
                    p1 = __builtin_amdgcn_cvt_pk_fp8_f32(v[4], v[5], p1, false); p1 = __builtin_amdgcn_cvt_pk_fp8_f32(v[6], v[7], p1, true);
                    *(u32x2e*)(O8 + (size_t)row * ld8 + col0 + bj * HALF) = (u32x2e){(unsigned)p0, (unsigned)p1}; } }
    }
};
struct EpiResid {
    static constexpr bool PERM = true, AFTER_DRAIN = false;
    const float* base32; const bf16_t* base16; bf16_t* XB; int ldc; float* rowss;
    __device__ __forceinline__ void operator()(const f32x4 (&acc)[2][2][4][2], const Unit& u, int wr, int wc, int fr, int fq) const {
        const int row0 = u.pm * BM + wr * 64 + fr, col0 = u.pn * BM + wc * 32 + 8 * fq;
#pragma unroll
        for (int ai = 0; ai < 2; ++ai)
#pragma unroll
            for (int m = 0; m < 4; ++m) { const int row = row0 + ai * HALF + m * 16; const size_t off = (size_t)row * ldc + col0; float ss = 0.f;
#pragma unroll
                for (int bj = 0; bj < 2; ++bj) { float b[8];
                    if (base32) { const f32x4 b0 = *(const f32x4*)(base32 + off + bj * HALF), b1 = *(const f32x4*)(base32 + off + bj * HALF + 4);
                        b[0] = b0[0]; b[1] = b0[1]; b[2] = b0[2]; b[3] = b0[3]; b[4] = b1[0]; b[5] = b1[1]; b[6] = b1[2]; b[7] = b1[3]; }
                    else unpack8(*(const u32x4*)(base16 + off + bj * HALF), b);
#pragma unroll
                    for (int i = 0; i < 4; ++i) { b[i] += acc[ai][bj][m][0][i]; b[4 + i] += acc[ai][bj][m][1][i]; }
#pragma unroll
                    for (int i = 0; i < 8; ++i) ss += b[i] * b[i];
                    *(u32x4*)(XB + off + bj * HALF) = pack8f(b); }
                ss += __shfl_xor(ss, 16); ss += __shfl_xor(ss, 32);
                if (fq == 0) atomicAdd(rowss + row, ss); }
    }
};
struct EpiAny {
    static constexpr bool PERM = true, AFTER_DRAIN = false;
    int kind; bf16_t* O; int ldc; const bf16_t* Gt; int ldg; const float* base; const bf16_t* base16; float* rowss; const float* rowss_in; int pn_off; unsigned char* O8; int ld8; const bf16_t* Gt2;
    __device__ __forceinline__ void mid(f32x4 (&acc)[2][2][4][2], const Unit& u, int wr, int wc, int fr, int fq) const {
        const int row0 = u.pm * BM + wr * 64 + fr, col0 = u.pn * BM + wc * 32 + 8 * fq;
#pragma unroll
        for (int ai = 0; ai < 2; ++ai)
#pragma unroll
            for (int m = 0; m < 4; ++m) { const int row = row0 + ai * HALF + m * 16; const bf16_t* g0p = Gt + (size_t)row * ldg + col0; const bf16_t* g1p = Gt2 + (size_t)row * ldg + col0;
#pragma unroll
                for (int bj = 0; bj < 2; ++bj) { float a[8], b[8]; unpack8(*(const u32x4*)(g0p + bj * HALF), a); unpack8(*(const u32x4*)(g1p + bj * HALF), b);
#pragma unroll
                    for (int i = 0; i < 4; ++i) { acc[ai][bj][m][0][i] *= a[i] * __builtin_amdgcn_rcpf(b[i]); acc[ai][bj][m][1][i] *= a[4 + i] * __builtin_amdgcn_rcpf(b[4 + i]); } }
                if (m & 1) asm volatile("" ::: "memory"); }
    }
    __device__ __forceinline__ void operator()(f32x4 (&acc)[2][2][4][2], const Unit& u, int wr, int wc, int fr, int fq) const {
        if (kind == 7 && u.kp == 0) { mid(acc, u, wr, wc, fr, fq); return; }
        if (kind == 0) { EpiProj e{O, ldc, pn_off}; e(acc, u, wr, wc, fr, fq); }
        else if (kind == 1) { EpiRowScale e{O, ldc, rowss_in, 1.f / 2048.f, 1e-6f}; e(acc, u, wr, wc, fr, fq); }
        else if (kind == 2) { EpiGate<false> e{O, ldc, Gt, ldg, nullptr, 0}; e(acc, u, wr, wc, fr, fq); }
        else if (kind == 3) { EpiGate<true> e{O, ldc, Gt, ldg, O8, ld8}; e(acc, u, wr, wc, fr, fq); }
        else if (kind == 6) { EpiGate<true> e{O, ldc, Gt, ldg, nullptr, 0}; e(acc, u, wr, wc, fr, fq); }
        else if (kind == 7) { EpiGate8 e{Gt2, ldg, O8, ld8}; e(acc, u, wr, wc, fr, fq); }
        else { EpiResid e{base, base16, O, ldc, rowss}; e(acc, u, wr, wc, fr, fq); }
    }
};
}
#ifndef ATT_QREG
#define ATT_QREG 1
#endif
namespace att {
using bf16 = unsigned short;
typedef short bf16x8 __attribute__((ext_vector_type(8)));
typedef short s16x4 __attribute__((ext_vector_type(4)));
typedef float f32x16 __attribute__((ext_vector_type(16)));
typedef float f32x4 __attribute__((ext_vector_type(4)));
typedef unsigned u32x4 __attribute__((ext_vector_type(4)));
constexpr int D = 128, NW = 8, QBLK = 32, KVBLK = 64, QB = NW * QBLK;
constexpr int SHM_V = KVBLK * D * 2, SHM_K = KVBLK * D * 2;
constexpr int LDS_WS = 2 * SHM_V + 2 * SHM_K;
constexpr int LDS_BIAS = LDS_WS + NW * 64 * 4;
constexpr int LDS_Q = LDS_BIAS + 2048 * 4;
constexpr int LDS_BYTES = LDS_Q + NW * 8192;
constexpr float THR = 8.f;

#define KSWZ(row, colB) ((row) * 256 + ((colB) ^ (((row) & 7) << 4)))
#define SBAR() __builtin_amdgcn_sched_barrier(0)
__device__ __forceinline__ int v_st(int k, int c) { const int kk = (k & ~0xC) | ((k & 4) << 1) | ((k & 8) >> 1); return ((kk >> 3) * 4 + (c >> 5)) * 512 + ((kk & 7) * 32 + (c & 31)) * 2; }
__device__ __forceinline__ int v_rd_base(int lane) { return ((lane & 3) << 3) | (((lane >> 2) & 3) << 6) | (((lane >> 4) & 1) << 5) | (((lane >> 5) & 1) << 8); }
constexpr int v_rd_off(int d0, int ks, int half) { return d0 * 512 + ks * 4096 + half * 2048; }
__device__ __forceinline__ int crow(int r, int hi) { return (r & 3) + 8 * (r >> 2) + 4 * hi; }
__device__ __forceinline__ unsigned cvtpk(float lo, float hi) { unsigned r; asm volatile("v_cvt_pk_bf16_f32 %0, %1, %2" : "=v"(r) : "v"(lo), "v"(hi)); return r; }
__device__ __forceinline__ bf16x8 load8(const bf16* p) { return *reinterpret_cast<const bf16x8*>(p); }
__device__ __forceinline__ float bf2f(unsigned short b) { return __uint_as_float((unsigned)b << 16); }

__device__ __forceinline__ void mask_tile(f32x16& p0, f32x16& p1, int dq) {
    const float NEG = -__builtin_inff();
#pragma unroll
    for (int r = 0; r < 16; ++r) {
        const int c = (r & 3) + 8 * (r >> 2);
        if (dq - c < 0) p0[r] = NEG;
        if (dq - c - 32 < 0) p1[r] = NEG;
    }
}
__device__ __forceinline__ void partialSM(f32x16& p0, f32x16& p1, float& m_reg, float& mn, float& alpha) {
    float pmax = p0[0]; for (int r = 1; r < 16; ++r) pmax = fmaxf(pmax, p0[r]); for (int r = 0; r < 16; ++r) pmax = fmaxf(pmax, p1[r]);
    { auto rr = __builtin_amdgcn_permlane32_swap(__float_as_uint(pmax), __float_as_uint(pmax), false, false);
      pmax = fmaxf(__uint_as_float(rr[0]), __uint_as_float(rr[1])); }
    if (__builtin_expect(__all((pmax - m_reg) <= THR), 1)) { mn = m_reg; alpha = 1.f; }
    else { mn = fmaxf(m_reg, pmax); alpha = __builtin_amdgcn_exp2f(m_reg - mn); m_reg = mn; }
    for (int r = 0; r < 16; ++r) p0[r] = p0[r] - mn; for (int r = 0; r < 16; ++r) p1[r] = p1[r] - mn;
    for (int r = 0; r < 16; ++r) p0[r] = __builtin_amdgcn_exp2f(p0[r]);
}
#define ATT_PK4(P, B_, OUT) do { unsigned a0 = cvtpk(P[B_+0], P[B_+1]), a1 = cvtpk(P[B_+2], P[B_+3]);                          \
        unsigned b0 = cvtpk(P[B_+4], P[B_+5]), b1 = cvtpk(P[B_+6], P[B_+7]);                                             \
        auto r0 = __builtin_amdgcn_permlane32_swap(a0, b0, false, false); auto r1 = __builtin_amdgcn_permlane32_swap(a1, b1, false, false); \
        u32x4 w = {r0[0], r1[0], r0[1], r1[1]}; OUT = *reinterpret_cast<bf16x8*>(&w); } while (0)
__device__ __forceinline__ void finishSM(f32x16& p0, f32x16& p1, float alpha, float& l_reg, bf16x8& pa0, bf16x8& pa1, bf16x8& pa2, bf16x8& pa3) {
    for (int r = 0; r < 16; ++r) p1[r] = __builtin_amdgcn_exp2f(p1[r]);
    float ps = 0; for (int r = 0; r < 16; ++r) ps += p0[r]; for (int r = 0; r < 16; ++r) ps += p1[r];
    { auto rr = __builtin_amdgcn_permlane32_swap(__float_as_uint(ps), __float_as_uint(ps), false, false);
      ps = __uint_as_float(rr[0]) + __uint_as_float(rr[1]); }
    l_reg = l_reg * alpha + ps;
    ATT_PK4(p0, 0, pa0); ATT_PK4(p0, 8, pa1); ATT_PK4(p1, 0, pa2); ATT_PK4(p1, 8, pa3);
}
__device__ __forceinline__ void ret_weight(f32x16& p0, f32x16& p1, int dq, float lg, bool act) {
    if (!act) { p0 = f32x16{}; p1 = f32x16{}; return; }
#pragma unroll
    for (int r = 0; r < 16; ++r) {
        const int c = (r & 3) + 8 * (r >> 2);
        const float e0 = lg * fabsf((float)(dq - c)), e1 = lg * fabsf((float)(dq - c - 32));
        p0[r] *= __builtin_amdgcn_exp2f(e0); p1[r] *= __builtin_amdgcn_exp2f(e1);
    }
}
__device__ __forceinline__ void ret_pack(f32x16& p0, f32x16& p1, bf16x8& pa0, bf16x8& pa1, bf16x8& pa2, bf16x8& pa3) {
    ATT_PK4(p0, 0, pa0); ATT_PK4(p0, 8, pa1); ATT_PK4(p1, 0, pa2); ATT_PK4(p1, 8, pa3);
}
template <int KB, bool BIAS>
__device__ __forceinline__ void qkt(f32x16& p0, f32x16& p1, const char* K_lds, int r32, int hi, const char* Qw  , const float* bias_tile  , const bf16x8* qr = nullptr) {
    if (BIAS) {
#pragma unroll
        for (int g = 0; g < 4; ++g) { const f32x4 b0 = *(const f32x4*)(bias_tile + 8 * g), b1 = *(const f32x4*)(bias_tile + 32 + 8 * g);
            p0[4 * g] = b0[0]; p0[4 * g + 1] = b0[1]; p0[4 * g + 2] = b0[2]; p0[4 * g + 3] = b0[3];
            p1[4 * g] = b1[0]; p1[4 * g + 1] = b1[1]; p1[4 * g + 2] = b1[2]; p1[4 * g + 3] = b1[3]; }
    } else { p0 = f32x16{}; p1 = f32x16{}; }
    int ko[4];
#pragma unroll
    for (int dd = 0; dd < 4; ++dd) ko[dd] = KSWZ(r32, (dd * 16 + hi * 8) * 2);
#pragma unroll
    for (int d0 = 0; d0 < 8; ++d0) { const char* a = K_lds + KB * SHM_K + ko[d0 & 3] + (d0 >> 2) * 128;
        bf16x8 b0 = *reinterpret_cast<const bf16x8*>(a);
        bf16x8 b1 = *reinterpret_cast<const bf16x8*>(a + 32 * 256);
#if ATT_QREG
        bf16x8 q = qr[d0];
#else
        bf16x8 q = *reinterpret_cast<const bf16x8*>(Qw + ko[d0 & 3] + (d0 >> 2) * 128);
#endif
        p0 = __builtin_amdgcn_mfma_f32_32x32x16_bf16(b0, q, p0, 0, 0, 0);
        p1 = __builtin_amdgcn_mfma_f32_32x32x16_bf16(b1, q, p1, 0, 0, 0); }
}
template <int VB>
__device__ __forceinline__ void pv_tile(f32x16* o, int vb0, bf16x8 pa0, bf16x8 pa1, bf16x8 pa2, bf16x8 pa3) {
#define TRRD(dst, off) asm volatile("ds_read_b64_tr_b16 %0, %1 offset:%2" : "=&v"(dst) : "v"(vb0), "i"(off) : "memory")
#define PV_D0(d0) do { s16x4 l0, l1, l2, l3, h0, h1, h2, h3; constexpr int b_ = VB * SHM_V + v_rd_off(d0, 0, 0); \
        TRRD(l0, b_); TRRD(h0, b_ + 2048); TRRD(l1, b_ + 4096); TRRD(h1, b_ + 6144); TRRD(l2, b_ + 8192); TRRD(h2, b_ + 10240); TRRD(l3, b_ + 12288); TRRD(h3, b_ + 14336); \
        asm volatile("s_waitcnt lgkmcnt(0)" ::: "memory"); SBAR();   \
        o[d0] = __builtin_amdgcn_mfma_f32_32x32x16_bf16(pa0, (bf16x8){l0[0], l0[1], l0[2], l0[3], h0[0], h0[1], h0[2], h0[3]}, o[d0], 0, 0, 0);   \
        o[d0] = __builtin_amdgcn_mfma_f32_32x32x16_bf16(pa1, (bf16x8){l1[0], l1[1], l1[2], l1[3], h1[0], h1[1], h1[2], h1[3]}, o[d0], 0, 0, 0);   \
        o[d0] = __builtin_amdgcn_mfma_f32_32x32x16_bf16(pa2, (bf16x8){l2[0], l2[1], l2[2], l2[3], h2[0], h2[1], h2[2], h2[3]}, o[d0], 0, 0, 0);   \
        o[d0] = __builtin_amdgcn_mfma_f32_32x32x16_bf16(pa3, (bf16x8){l3[0], l3[1], l3[2], l3[3], h3[0], h3[1], h3[2], h3[3]}, o[d0], 0, 0, 0); } while (0)
    PV_D0(0); PV_D0(1); PV_D0(2); PV_D0(3);
#undef PV_D0
#undef TRRD
}

struct BlockRef { const bf16* Q; const bf16* K; const bf16* V; bf16* O; int P0; int skv; float lg; const bf16* RG; const float* GN; unsigned char* O8;   };
struct Seam { bf16x8 qr[8]; bf16x8 st_v0, st_v1, st_k0, st_k1; };
template <int MODE> struct Pitch { static constexpr int LDQ = (MODE == 2) ? 512 : 11264, LDK = (MODE == 2) ? 1024 : 11264, LDO = LDQ; };

#define ROWK(p, k0, rr) ((p) + (size_t)((k0) + (rr)) * LDK + sc)
#define VMW() asm volatile("s_waitcnt vmcnt(0)" ::: "memory")
#define VMWN(n) asm volatile("s_waitcnt vmcnt(%0)" :: "i"(n) : "memory")
#define SLOAD_H(Kp, Vp, k0) do { S.st_v0 = load8(ROWK(Vp, k0, sr)); S.st_v1 = load8(ROWK(Vp, k0, 32 + sr));              \
                         S.st_k0 = load8(ROWK(Kp, k0, sr)); S.st_k1 = load8(ROWK(Kp, k0, 32 + sr)); } while (0)
#define SWRITE_HK(bf) do { *(bf16x8*)(K_lds + (bf) * SHM_K + kws) = S.st_k0; *(bf16x8*)(K_lds + (bf) * SHM_K + kws + 32 * 256) = S.st_k1; } while (0)
#define SWRITE_HV(bf) do { *(bf16x8*)(V_lds + (bf) * SHM_V + vst0) = S.st_v0; *(bf16x8*)(V_lds + (bf) * SHM_V + vst1) = S.st_v1; } while (0)
#define SWRITE_H(bf) do { SWRITE_HV(bf); SWRITE_HK(bf); } while (0)

template <int MODE>
__device__ __forceinline__ void attn_prime(const BlockRef& cur, char* lds, Seam& S) {
    constexpr int LDQ = Pitch<MODE>::LDQ, LDK = Pitch<MODE>::LDK;
    int tid_ = threadIdx.x; asm volatile("" : "+v"(tid_));
    const int tid = tid_, wid = __builtin_amdgcn_readfirstlane(tid >> 6), lane = tid & 63, r32 = lane & 31, hi = lane >> 5;
    const int sr = tid >> 4, sc = (tid & 15) * 8, kws = KSWZ(sr, sc * 2); char* K_lds = lds + 2 * SHM_V;
    const int kb0 = 0;
    for (int d0 = 0; d0 < 8; ++d0) S.qr[d0] = load8(cur.Q + (size_t)(wid * QBLK + r32) * LDQ + d0 * 16 + hi * 8);
    SLOAD_H(cur.K, cur.V, kb0); VMW(); SWRITE_HK(0);
    __syncthreads();
}
template <int MODE>
__device__ __forceinline__ void attn_block(const BlockRef& cur, const BlockRef& nxt, char* lds, Seam& S) {
    constexpr int LDQ = Pitch<MODE>::LDQ, LDK = Pitch<MODE>::LDK, LDO = Pitch<MODE>::LDO;
    constexpr bool BIAS = (MODE == 0), SOFTMAX = (MODE != 1);
    int tid_ = threadIdx.x; asm volatile("" : "+v"(tid_));
    const int tid = tid_, wid = __builtin_amdgcn_readfirstlane(tid >> 6), lane = tid & 63, r32 = lane & 31, hi = lane >> 5;
    const int j_lo = 0;
    int j_hi = (cur.P0 + QB - 1) / KVBLK + 1; if (j_hi > cur.skv / KVBLK) j_hi = cur.skv / KVBLK;
    const int NT = j_hi - j_lo;
    const int kbn = 0;
    const int qlo = cur.P0 + wid * QBLK, qm = qlo + r32 - 4 * hi;
    char* V_lds = lds; char* K_lds = lds + 2 * SHM_V;
    float* ws = (float*)(lds + LDS_WS) + wid * 64; float* li_l = ws, * al_l = ws + 32;
    const float* bias = (const float*)(lds + LDS_BIAS) + 4 * hi;
    float m_reg = -1e30f, l_reg = 0; f32x16 o[4] = {};
    const int sr = tid >> 4, sc = (tid & 15) * 8, vst0 = v_st(sr, sc), vst1 = v_st(32 + sr, sc), kws = KSWZ(sr, sc * 2);
    const int vb0 = (int)(uintptr_t)V_lds + v_rd_base(lane);
    const bf16* Kh = cur.K; const bf16* Vh = cur.V;
    const float lg = cur.lg; const int cq = qlo >> 6;
#define RESC(a) do { if (SOFTMAX) { if (__any((a) < 1.f)) { if (hi == 0) al_l[r32] = (a); asm volatile("s_waitcnt lgkmcnt(0)" ::: "memory");              \
                     for (int d_ = 0; d_ < 4; ++d_) for (int r = 0; r < 16; ++r) o[d_][r] *= al_l[crow(r, hi)]; } } } while (0)
#define KBASE(t) ((j_lo + (t)) * KVBLK)
#define POSTQK(P0_, P1_, mnX, alX, t) do { const int kb_ = KBASE(t); \
        if (MODE == 1) { ret_weight(P0_, P1_, qm - kb_, lg, (j_lo + (t)) <= cq); } \
        else { if (MODE == 0 && (kb_ + KVBLK - 1 > qlo)) mask_tile(P0_, P1_, qm - kb_); partialSM(P0_, P1_, m_reg, mnX, alX); } } while (0)
#define FINISH(P0_, P1_, alX) do { if (MODE == 1) ret_pack(P0_, P1_, pa0, pa1, pa2, pa3); else finishSM(P0_, P1_, alX, l_reg, pa0, pa1, pa2, pa3); } while (0)
    constexpr int NQL = 8;
#define SEAM_K0() do { VMWN(NQL); SWRITE_HK(0); SBAR(); } while (0)
    f32x16 pA0, pA1, pB0, pB1; float mnA = 0.f, mnB = 0.f, alA = 1.f, alB = 1.f; bf16x8 pa0, pa1, pa2, pa3;
    char* Qw = lds + LDS_Q + wid * 8192;
#if ATT_QREG
    const bf16x8* QR = S.qr;
#else
    const bf16x8* QR = nullptr;
#pragma unroll
    for (int d0 = 0; d0 < 8; ++d0) *(bf16x8*)(Qw + KSWZ(r32, (d0 * 16 + hi * 8) * 2)) = S.qr[d0];
#endif
    SWRITE_HV(0); SBAR();
    if (NT > 1) { SLOAD_H(Kh, Vh, KBASE(1)); }
    SBAR(); qkt<0, BIAS>(pA0, pA1, K_lds, r32, hi, Qw, bias + KBASE(0), QR);
    POSTQK(pA0, pA1, mnA, alA, 0);
    if (NT > 1) { VMW(); SWRITE_H(1); }
    __syncthreads();
#define HALF_STEP(PX0, PX1, mnX, alX, PY0, PY1, alY, t, KB, VB, SB) do {                                                      \
        SBAR(); qkt<KB, BIAS>(PX0, PX1, K_lds, r32, hi, Qw, bias + KBASE(t), QR);                                             \
        FINISH(PY0, PY1, alY); SBAR();                                                           \
        if ((t) + 1 < NT) { SLOAD_H(Kh, Vh, KBASE((t) + 1)); SBAR(); }                                               \
        pv_tile<VB>(o, vb0, pa0, pa1, pa2, pa3); POSTQK(PX0, PX1, mnX, alX, (t));                                        \
        __syncthreads();                                                                                                      \
        if ((t) + 1 < NT) { VMW(); SWRITE_H(SB); }                                                                          \
        RESC(alX); __syncthreads(); } while (0)
    for (int t = 1; t + 1 < NT; t += 2) {
        HALF_STEP(pB0, pB1, mnB, alB, pA0, pA1, alA, t, 1, 0, 0);
        HALF_STEP(pA0, pA1, mnA, alA, pB0, pB1, alB, t + 1, 0, 1, 1);
    }
    const bool even = (NT & 1) == 0;
    if (even) { SBAR(); qkt<1, BIAS>(pB0, pB1, K_lds, r32, hi, Qw, bias + KBASE(NT - 1), QR); SBAR(); }
    { constexpr int LDQn = LDQ; SLOAD_H(nxt.K, nxt.V, kbn); SBAR();
#pragma unroll
      for (int d0 = 0; d0 < 8; ++d0) S.qr[d0] = load8(nxt.Q + (size_t)(wid * QBLK + r32) * LDQn + d0 * 16 + hi * 8); }
    SBAR();
    FINISH(pA0, pA1, alA); SBAR();
    pv_tile<0>(o, vb0, pa0, pa1, pa2, pa3);
    if (even) { POSTQK(pB0, pB1, mnB, alB, NT - 1); __syncthreads(); RESC(alB);
        FINISH(pB0, pB1, alB); SBAR(); pv_tile<1>(o, vb0, pa0, pa1, pa2, pa3); }
    SBAR(); SEAM_K0();
    bf16* Ow = cur.O + (size_t)(wid * QBLK) * LDO;
    if (MODE != 1) {
        if (hi == 0) li_l[r32] = l_reg; asm volatile("s_waitcnt lgkmcnt(0)" ::: "memory");
        float rli[16];
#pragma unroll
        for (int r = 0; r < 16; ++r) rli[r] = __builtin_amdgcn_rcpf(li_l[crow(r, hi)]);
#pragma unroll
        for (int r = 0; r < 16; ++r) { const int orow = crow(r, hi);
#pragma unroll
            for (int d0 = 0; d0 < 4; ++d0) { const float v = o[d0][r] * rli[r];
                const float vn = __shfl_xor(v, 1);
                if (cur.O8) { const int pk = __builtin_amdgcn_cvt_pk_fp8_f32(v, vn, 0, false); const int pk2 = __shfl_xor(pk, 2);
                    if ((r32 & 3) == 0) *(unsigned*)(cur.O8 + (size_t)(wid * QBLK + orow) * (MODE == 2 ? 512 : 2048) + d0 * 32 + r32) = ((unsigned)pk & 0xFFFFu) | ((unsigned)pk2 << 16); }
                else if ((r32 & 1) == 0) *(unsigned*)(Ow + (size_t)orow * LDO + d0 * 32 + r32) = cvtpk(v, vn); } }
    } else {
        float gn[4];
#pragma unroll
        for (int d0 = 0; d0 < 4; ++d0) gn[d0] = cur.GN[d0 * 32 + r32];
        const bf16* RGw = cur.RG + (size_t)(wid * QBLK) * LDO;
#pragma unroll
        for (int r = 0; r < 16; ++r) { const int orow = crow(r, hi);
            float s = (o[0][r] + o[1][r]) + (o[2][r] + o[3][r]);
#pragma unroll
            for (int x = 1; x < 32; x <<= 1) s += __shfl_xor(s, x);
            const float mean = s * (1.f / 128.f);
            float q = 0.f;
#pragma unroll
            for (int d0 = 0; d0 < 4; ++d0) { const float dlt = o[d0][r] - mean; q += dlt * dlt; }
#pragma unroll
            for (int x = 1; x < 32; x <<= 1) q += __shfl_xor(q, x);
            const float rstd = 1.f / sqrtf(q * (1.f / 128.f) + 1e-6f);
#pragma unroll
            for (int d0 = 0; d0 < 4; ++d0) { const float g = bf2f(RGw[(size_t)orow * LDO + d0 * 32 + r32]);
                const float v = (o[d0][r] - mean) * rstd * gn[d0] * g;
                const float vn = __shfl_xor(v, 1);
                if (cur.O8) { const int pk = __builtin_amdgcn_cvt_pk_fp8_f32(v, vn, 0, false); const int pk2 = __shfl_xor(pk, 2);
                    if ((r32 & 3) == 0) *(unsigned*)(cur.O8 + (size_t)(wid * QBLK + orow) * 2048 + d0 * 32 + r32) = ((unsigned)pk & 0xFFFFu) | ((unsigned)pk2 << 16); }
                else if ((r32 & 1) == 0) *(unsigned*)(Ow + (size_t)orow * LDO + d0 * 32 + r32) = cvtpk(v, vn); } }
    }
    __syncthreads();
#undef RESC
#undef KBASE
#undef POSTQK
#undef FINISH
#undef SEAM_K0
#undef HALF_STEP
}
#undef ROWK
#undef VMW
#undef VMWN
#undef SLOAD_H
#undef SWRITE_HK
#undef SWRITE_HV
#undef SWRITE_H
#undef SBAR
#undef KSWZ
#undef ATT_PK4
}
#define GAS __attribute__((address_space(1)))
#define LAS __attribute__((address_space(3)))
typedef unsigned short bf16;
typedef unsigned v4u __attribute__((ext_vector_type(4)));
typedef float f32x4 __attribute__((ext_vector_type(4)));
typedef short bf16x8 __attribute__((ext_vector_type(8)));
typedef GAS unsigned gu32;
typedef GAS unsigned long long gu64;
#define RLX_AGENT __ATOMIC_RELAXED, __HIP_MEMORY_SCOPE_AGENT
#define LDS_WAIT() asm volatile("s_waitcnt lgkmcnt(0)" ::: "memory")
#define VM_WAIT() asm volatile("s_waitcnt vmcnt(0)" ::: "memory")
__device__ __forceinline__ unsigned long long rt() { return __builtin_amdgcn_s_memrealtime(); }
__device__ __forceinline__ unsigned f2bf(float f) { unsigned u = __builtin_bit_cast(unsigned, f); return (u + 0x7fffu + ((u >> 16) & 1u)) >> 16; }
__device__ __forceinline__ unsigned pk2(float lo, float hi) { return f2bf(lo) | (f2bf(hi) << 16); }

#define XB_TMO      128
#define XB_XCNT(j)  (256  + 64 * (j))
#define XB_XSUB(j)  (1280 + 64 * (j))
#define XB_XGEN(j)  (2304 + 64 * (j))
#define XB_TOP      3328
#define XB_TOPGEN   3392
#define XCD_BAR_WORDS 3456
#define XB_SPIN_CAP (1u << 18)

__device__ __forceinline__ unsigned xb_ld(unsigned* p)              { return __hip_atomic_load(p, __ATOMIC_RELAXED, __HIP_MEMORY_SCOPE_AGENT); }
__device__ __forceinline__ unsigned xb_add(unsigned* p, unsigned v) { return __hip_atomic_fetch_add(p, v, __ATOMIC_RELAXED, __HIP_MEMORY_SCOPE_AGENT); }
__device__ __forceinline__ unsigned xb_xcc_id() { return (unsigned)__builtin_amdgcn_s_getreg((3 << 11) | 20) & 0xFu; }
#define XB_SPIN(cond, bar) do { unsigned _sp = 0; while (cond) { __builtin_amdgcn_s_sleep(1); \
    if ((++_sp & 255u) == 0u) { if (xb_ld(&(bar)[XB_TMO])) break; if (_sp > XB_SPIN_CAP) { atomicAdd(&(bar)[XB_TMO], 1u); break; } } } } while (0)

struct XcdBarrier {
    unsigned* bar; unsigned x;
    volatile LAS unsigned* st;
};

__device__ __forceinline__ XcdBarrier xcd_barrier_post(unsigned* bar, volatile LAS unsigned* st) {
    XcdBarrier b; b.bar = bar; b.x = xb_xcc_id(); b.st = st;
    if (threadIdx.x == 0) (void)xb_add(&bar[XB_XCNT(b.x)], 1u);
    return b;
}
__device__ __forceinline__ void xcd_barrier_complete(unsigned* bar, unsigned x, unsigned& nloc, unsigned& nx) {
    const unsigned G = gridDim.x * gridDim.y * gridDim.z;
    unsigned sum, cnt, mine, sp = 0u;
    for (;;) {
        sum = 0u; cnt = 0u; mine = 0u;
#pragma unroll
        for (unsigned j = 0; j < 16; ++j) { const unsigned c = xb_ld(&bar[XB_XCNT(j)]); sum += c; cnt += (c > 0u) ? 1u : 0u; mine = (j == x) ? c : mine; }
        if (sum == G) break;
        __builtin_amdgcn_s_sleep(1);
        if ((++sp & 255u) == 0u) { if (xb_ld(&bar[XB_TMO])) break; if (sp > XB_SPIN_CAP) { atomicAdd(&bar[XB_TMO], 1u); break; } }
    }
    nloc = mine > 0u ? mine : 1u; nx = cnt > 0u ? cnt : 1u;
}

__device__ __forceinline__ void xcd_barrier(const XcdBarrier& b) {
    asm volatile("s_waitcnt vmcnt(0)" ::: "memory");
    __syncthreads();
    if (threadIdx.x == 0) {
        unsigned* bar = b.bar;
        __builtin_amdgcn_s_waitcnt(0);
        unsigned nloc = b.st[0], nx = b.st[1];
        if (nloc == 0u) { xcd_barrier_complete(bar, b.x, nloc, nx); b.st[0] = nloc; b.st[1] = nx; }
        const unsigned old = xb_add(&bar[XB_XSUB(b.x)], 1u);
        const unsigned gen = old / nloc;
        if (old + 1u == (gen + 1u) * nloc) {
            __builtin_amdgcn_fence(__ATOMIC_RELEASE, "agent");
            asm volatile("s_waitcnt vmcnt(0)" ::: "memory");
            const unsigned og = xb_add(&bar[XB_TOP], 1u);
            const unsigned tg = og / nx;
            if (og + 1u == (tg + 1u) * nx) xb_add(&bar[XB_TOPGEN], 1u);
            else XB_SPIN(xb_ld(&bar[XB_TOPGEN]) == tg, bar);
            __builtin_amdgcn_fence(__ATOMIC_ACQUIRE, "agent");
            xb_add(&bar[XB_XGEN(b.x)], 1u);
            asm volatile("s_waitcnt vmcnt(0)" ::: "memory");
        } else {
            XB_SPIN(xb_ld(&bar[XB_XGEN(b.x)]) == gen, bar);
            __builtin_amdgcn_fence(__ATOMIC_ACQUIRE, "agent");
            asm volatile("s_waitcnt vmcnt(0)" ::: "memory");
        }
    }
    __syncthreads();
}
constexpr int NWAVES = 8;
constexpr int M_TOK = 16384, DM = 2048, SEQ = 2048, NB = 8;
constexpr int PP = 11264;
constexpr int C_FQ = 0, C_FK = 1024, C_RQ = 2048, C_RK = 3072, C_FV = 4096, C_RV = 5120, C_RG = 6144, C_G0 = 7168, C_G1 = 9216;
constexpr int N_QK = 4096, N_REST = 7168;
#ifndef FP8_UP_OUT
#define FP8_UP_OUT 1
#endif
constexpr int W8_SCALE_B = 0x79797979;
constexpr int N_IN_ORIG = 11272;
constexpr float RMS_EPS = 1e-6f;
constexpr float QK_C2 = 0.08838834764831845f * 1.4426950408889634f;
constexpr size_t MiB = 1u << 20;
constexpr size_t DO_XN8 = 0, DO_OCAT8 = 32 * MiB;
constexpr size_t DO_OFOX8 = DO_OCAT8, DO_ORET8 = DO_OCAT8 + 1024;
constexpr size_t WS_CTL = 0, CTL_ZERO_BYTES = 1 * MiB;
constexpr size_t WS_ROWSS1 = 256 * 1024, WS_ROWSS2 = 512 * 1024;
constexpr size_t WS_WIN = 1 * MiB, WS_WFOX = 45 * MiB, WS_WRET = 49 * MiB, WS_WOUT = 53 * MiB, WS_WMQ = 61 * MiB, WS_WMKV = 63 * MiB, WS_WMO = 67 * MiB, WS_WPQ = 69 * MiB, WS_SUBK = 77 * MiB;
constexpr size_t WS_PSCALE = 79 * MiB;
constexpr size_t WS_LOGF = 78 * MiB, WS_CUMF = 78 * MiB + 512 * 1024;
constexpr size_t WS_XN = 80 * MiB;
constexpr size_t WS_PROJ = 144 * MiB;
constexpr size_t WS_MN = 496 * MiB, WS_KVM = 504 * MiB, WS_END = 508 * MiB;
constexpr size_t WS_XB1B = 144 * MiB;
constexpr size_t WS_XB2 = FP8_UP_OUT ? WS_XB1B : WS_XN;
constexpr size_t WS_XB1 = FP8_UP_OUT ? WS_XN   : WS_XB1B, WS_QM = 208 * MiB, WS_OMEM = 224 * MiB, WS_PU = 240 * MiB, WS_PV = 304 * MiB, WS_QP = (FP8_UP_OUT ? 368 : 144) * MiB  , WS_IDX = 208 * MiB, WS_GATE = 216 * MiB;
constexpr int CW_BAR = 4096, CW_CONV = 64;
constexpr int RING_BYTES = 131072, LDS_BYTES = 147456, LDSCTL_OFF = LDS_BYTES - 1024, MISC_OFF = LDSCTL_OFF + 320;
static_assert(att::LDS_BYTES <= LDSCTL_OFF, "attention LDS");

struct Args { const float* in[23]; float* out; unsigned char* ws; int ph_lo, ph_hi; int p0_mask, pad; };
enum { I_X = 0, I_MEM, I_LN_MIX, I_W_IN, I_B_FORGET, I_FOXQ_G, I_FOXK_G, I_RET_G, I_W_FOXUP, I_W_RETUP, I_W_OUT, I_LN_MEM, I_MEMNORM_G, I_W_MQ, I_W_MKV, I_MEMQ_G, I_MEMK_G, I_W_MO, I_LN_FFN, I_W_PQ, I_SUBK, I_PEER_U, I_PEER_V };

__device__ __forceinline__ float wave_sum(float v) {
#pragma unroll
    for (int o = 1; o < 64; o <<= 1) v += __shfl_xor(v, o);
    return v;
}
__device__ __forceinline__ void transpose_item(const float* W, int ldw, int K, int src_col0, const float* kgain, bf16* WT, int dst_row0, LAS float* scr, int kb, int nb, int lane) {
    const int k0 = 64 * kb, n0 = 32 * nb;
    f32x4 ld[8];
#pragma unroll
    for (int i = 0; i < 8; ++i) ld[i] = *(const GAS f32x4*)(W + (size_t)(k0 + 8 * i + (lane >> 3)) * ldw + src_col0 + n0 + 4 * (lane & 7));
#pragma unroll
    for (int i = 0; i < 8; ++i) { const int kk = 8 * i + (lane >> 3); f32x4 v = ld[i]; if (kgain) v = v * kgain[k0 + kk]; LAS float* d = scr + kk * 33 + 4 * (lane & 7); d[0] = v.x; d[1] = v.y; d[2] = v.z; d[3] = v.w; }
    LDS_WAIT(); asm volatile("" ::: "memory");
    const int c = lane & 7;
#pragma unroll
    for (int j = 0; j < 4; ++j) { const int n = (lane >> 3) + 8 * j; const LAS float* s = scr + (8 * c) * 33 + n;
        v4u o; o.x = pk2(s[0 * 33], s[1 * 33]); o.y = pk2(s[2 * 33], s[3 * 33]); o.z = pk2(s[4 * 33], s[5 * 33]); o.w = pk2(s[6 * 33], s[7 * 33]);
        *(GAS v4u*)(WT + (size_t)(dst_row0 + n0 + n) * K + k0 + 8 * c) = o; }
    LDS_WAIT(); asm volatile("" ::: "memory");
}
__device__ __forceinline__ void transpose_item8(const float* W, int ldw, int K  , int src_col0, unsigned char* WT8  , int kb, int nb, LAS float* scr, int lane) {
    const int k0 = 64 * kb, n0 = 32 * nb;
    f32x4 ld[8];
#pragma unroll
    for (int i = 0; i < 8; ++i) ld[i] = *(const GAS f32x4*)(W + (size_t)(k0 + 8 * i + (lane >> 3)) * ldw + src_col0 + n0 + 4 * (lane & 7));
#pragma unroll
    for (int i = 0; i < 8; ++i) { const int kk = 8 * i + (lane >> 3); const f32x4 v = ld[i] * 64.f; LAS float* d = scr + kk * 33 + 4 * (lane & 7); d[0] = v.x; d[1] = v.y; d[2] = v.z; d[3] = v.w; }
    LDS_WAIT(); asm volatile("" ::: "memory");
    const int c = lane & 7;
#pragma unroll
    for (int j = 0; j < 4; ++j) { const int n = (lane >> 3) + 8 * j; const LAS float* s = scr + (8 * c) * 33 + n;
        int p0 = 0, p1 = 0; p0 = __builtin_amdgcn_cvt_pk_fp8_f32(s[0 * 33], s[1 * 33], p0, false); p0 = __builtin_amdgcn_cvt_pk_fp8_f32(s[2 * 33], s[3 * 33], p0, true);
        p1 = __builtin_amdgcn_cvt_pk_fp8_f32(s[4 * 33], s[5 * 33], p1, false); p1 = __builtin_amdgcn_cvt_pk_fp8_f32(s[6 * 33], s[7 * 33], p1, true);
        *(GAS unsigned long long*)(WT8 + (size_t)(n0 + n) * K + k0 + 8 * c) = (unsigned long long)(unsigned)p0 | ((unsigned long long)(unsigned)p1 << 32); }
    LDS_WAIT(); asm volatile("" ::: "memory");
}
struct TJob { const float* W; int ldw, K, N; const float* gain; bf16* WT; int fp8; };

__device__ __forceinline__ void rms_row_to_bf16(const float* xrow, const float* gain, bf16* orow, int lane, f32x4 (&hv)[8], unsigned char* orow8 = nullptr) {
    const GAS f32x4* xr = (const GAS f32x4*)xrow + lane; float s = 0.f;
#pragma unroll
    for (int j = 0; j < 8; ++j) { hv[j] = xr[64 * j]; s += (hv[j].x * hv[j].x + hv[j].y * hv[j].y) + (hv[j].z * hv[j].z + hv[j].w * hv[j].w); }
    const float r = 1.f / sqrtf(wave_sum(s) * (1.f / DM) + RMS_EPS);
    GAS unsigned long long* o8 = (GAS unsigned long long*)orow + lane;
#pragma unroll
    for (int j = 0; j < 8; ++j) { const f32x4 g = ((const GAS f32x4*)gain)[lane + 64 * j]; hv[j] = hv[j] * r * g;
        o8[64 * j] = (unsigned long long)pk2(hv[j].x, hv[j].y) | ((unsigned long long)pk2(hv[j].z, hv[j].w) << 32);
        if (orow8) { int p = 0; p = __builtin_amdgcn_cvt_pk_fp8_f32(hv[j].x, hv[j].y, p, false); p = __builtin_amdgcn_cvt_pk_fp8_f32(hv[j].z, hv[j].w, p, true); ((GAS unsigned*)orow8)[lane + 64 * j] = (unsigned)p; } }
}
__device__ __forceinline__ float log_sigmoid_f(float z) { return fminf(z, 0.f) - log1pf(expf(-fabsf(z))); }

struct Frame { LAS unsigned char* lds; unsigned char* ldsg; int tid, lane, wave, G, bx, p0_mask; const float* const* in; float* out; unsigned char* ws; };

__device__ __forceinline__ void p0_prologue(Frame& F) {
    const int gw = F.bx * NWAVES + F.wave, NGW = F.G * NWAVES;
    if (F.p0_mask & 1) {
        LAS float* scr = (LAS float*)(F.lds + F.wave * 16384);
        const TJob jobs[9] = {
            {F.in[I_W_IN], N_IN_ORIG, 2048, N_QK, nullptr, (bf16*)(F.ws + WS_WIN), 0},
            {F.in[I_W_IN], N_IN_ORIG, 2048, N_REST, nullptr, (bf16*)(F.ws + WS_WIN + 16 * MiB), 1},
            {F.in[I_W_FOXUP], 2048, 1024, 2048, nullptr, (bf16*)(F.ws + WS_WFOX), FP8_UP_OUT},
            {F.in[I_W_RETUP], 2048, 1024, 2048, nullptr, (bf16*)(F.ws + (FP8_UP_OUT ? WS_WFOX + 1024 : WS_WRET)), FP8_UP_OUT},
            {F.in[I_W_OUT], 2048, 2048, 2048, nullptr, (bf16*)(F.ws + WS_WOUT), FP8_UP_OUT},
            {F.in[I_W_MQ], 512, 2048, 512, F.in[I_LN_MEM], (bf16*)(F.ws + WS_WMQ), 0},
            {F.in[I_W_MKV], 1024, 2048, 1024, nullptr, (bf16*)(F.ws + WS_WMKV), 0},
            {F.in[I_W_MO], 2048, 512, 2048, nullptr, (bf16*)(F.ws + WS_WMO), 1},
            {F.in[I_W_PQ], 2048, 2048, 2048, F.in[I_LN_FFN], (bf16*)(F.ws + WS_WPQ), 0} };
        int base = 0;
#pragma unroll
        for (int j = 0; j < 9; ++j) {
            const TJob& J = jobs[j]; const int nblk = J.N / 32, items = (J.K / 64) * nblk;
            int first = gw - (base % NGW); if (first < 0) first += NGW;
            for (int r = first; r < items; r += NGW) { const int kb = r / nblk, nb = r % nblk;
                int src_col0 = 0;
                if (j == 0) src_col0 = (nb * 32 >= 2048) ? 1032 : 0;
                if (j == 1) src_col0 = (nb * 32 < 1024) ? 2048 : 4104;
                if (J.fp8) transpose_item8(J.W, J.ldw, (FP8_UP_OUT && (j == 2 || j == 3)) ? 2048 : J.K, src_col0, (unsigned char*)J.WT, kb, nb, scr, F.lane);
                else transpose_item(J.W, J.ldw, J.K, src_col0, J.gain, J.WT, 0, scr, kb, nb, F.lane); }
            base += items;
        }
    }
    if (F.p0_mask & 1) {
        const float* sk = F.in[I_SUBK]; bf16* o = (bf16*)(F.ws + WS_SUBK);
        for (int i = (F.bx * 512 + F.tid) * 4; i < 16 * 128 * 128; i += F.G * 512 * 4) { const f32x4 v = *(const GAS f32x4*)(sk + i);
            *(GAS unsigned long long*)(o + i) = (unsigned long long)pk2(v.x, v.y) | ((unsigned long long)pk2(v.z, v.w) << 32); }
    }
    __syncthreads();
    if (F.p0_mask & 2) {
        LAS float* wf = (LAS float*)F.lds; const float* w = F.in[I_W_IN];
        for (int k = F.tid; k < 2048; k += 512) { const f32x4 a = *(const GAS f32x4*)(w + (size_t)k * N_IN_ORIG + 3072), b = *(const GAS f32x4*)(w + (size_t)k * N_IN_ORIG + 3076);
            wf[0 * 2048 + k] = a.x; wf[1 * 2048 + k] = a.y; wf[2 * 2048 + k] = a.z; wf[3 * 2048 + k] = a.w; wf[4 * 2048 + k] = b.x; wf[5 * 2048 + k] = b.y; wf[6 * 2048 + k] = b.z; wf[7 * 2048 + k] = b.w; }
    }
    __syncthreads();
    if (F.p0_mask & 2) {
        const LAS float* wf = (const LAS float*)F.lds; const float* bfg = F.in[I_B_FORGET]; float* logf_o = (float*)(F.ws + WS_LOGF);
        for (int m = gw; m < M_TOK; m += NGW) { f32x4 hv[8];
            rms_row_to_bf16(F.in[I_X] + (size_t)m * DM, F.in[I_LN_MIX], (bf16*)(F.ws + WS_XN) + (size_t)m * DM, F.lane, hv, (unsigned char*)F.out + DO_XN8 + (size_t)m * DM);
            float z = 0.f;
#pragma unroll
            for (int q = 0; q < 8; ++q) { float acc = 0.f;
#pragma unroll
                for (int j = 0; j < 8; ++j) { const f32x4 wv = *(const LAS f32x4*)(wf + q * 2048 + 4 * F.lane + 256 * j); acc += (hv[j].x * wv.x + hv[j].y * wv.y) + (hv[j].z * wv.z + hv[j].w * wv.w); }
                acc = wave_sum(acc); z = (F.lane == q) ? acc : z;
                __builtin_amdgcn_sched_barrier(0); }
            if (F.lane < 8) logf_o[(size_t)m * 8 + F.lane] = log_sigmoid_f(z + bfg[F.lane]);
        }
        for (int m = gw; m < NB * 256; m += NGW) { f32x4 hv[8]; rms_row_to_bf16(F.in[I_MEM] + (size_t)m * DM, F.in[I_MEMNORM_G], (bf16*)(F.ws + WS_MN) + (size_t)m * DM, F.lane, hv); }
    }
}
__device__ __forceinline__ void p1_scan(Frame& F) {
    if (F.bx < 64) {
        const int b = F.bx >> 3, h = F.bx & 7; const float* lf = (const float*)(F.ws + WS_LOGF); float* cf = (float*)(F.ws + WS_CUMF) + (size_t)F.bx * SEQ;
        float v[4]; float run = 0.f;
#pragma unroll
        for (int i = 0; i < 4; ++i) { run += lf[(size_t)(b * SEQ + F.tid * 4 + i) * 8 + h]; v[i] = run; }
        float incl = run;
#pragma unroll
        for (int o = 1; o < 64; o <<= 1) { const float t = __shfl_up(incl, o); if (F.lane >= o) incl += t; }
        LAS float* wt = (LAS float*)F.lds;
        if (F.lane == 63) wt[F.wave] = incl;
        __syncthreads();
        float off = incl - run;
        for (int w = 0; w < F.wave; ++w) off += wt[w];
#pragma unroll
        for (int i = 0; i < 4; ++i) cf[F.tid * 4 + i] = v[i] + off;
    }
    __syncthreads();
}
__device__ __forceinline__ void unpack8s(const att::bf16x8 v, float (&f)[8]) {
#pragma unroll
    for (int i = 0; i < 8; ++i) f[i] = __uint_as_float((unsigned)(unsigned short)v[i] << 16);
}
__device__ __forceinline__ att::bf16x8 pack8s(const float (&f)[8]) { v4u w; w.x = pg8::cvt_pk_bf16(f[0], f[1]); w.y = pg8::cvt_pk_bf16(f[2], f[3]); w.z = pg8::cvt_pk_bf16(f[4], f[5]); w.w = pg8::cvt_pk_bf16(f[6], f[7]); return __builtin_bit_cast(att::bf16x8, w); }
__device__ __forceinline__ void p4_attention(Frame& F) {
    char* lds = (char*)F.ldsg;
    const int xcd = F.bx & 7, kk = F.bx >> 3;
    const int bh = (kk >> 2) * 8 + xcd, x = kk & 3, b = bh >> 3, h = bh & 7;
    if (bh >= 64) return;
    const att::bf16* proj = (const att::bf16*)(F.ws + WS_PROJ);
    const size_t rowb = (size_t)b * SEQ;
    if (F.p0_mask & 1) {
        float* tbl = (float*)(lds + att::LDS_BIAS); const float* cf = (const float*)(F.ws + WS_CUMF) + (size_t)bh * SEQ;
        const f32x4 v = *(const f32x4*)(cf + F.tid * 4); *(f32x4*)(tbl + F.tid * 4) = v * (-1.4426950408889634f);
        att::BlockRef r0, r1;
        r0.Q = proj + (rowb + (size_t)x * 256) * PP + C_FQ + h * 128; r0.K = proj + rowb * PP + C_FK + h * 128; r0.V = proj + rowb * PP + C_FV + h * 128; r0.O = (att::bf16*)r0.Q;
        r0.P0 = x * 256; r0.skv = SEQ; r0.lg = 0.f; r0.RG = nullptr; r0.GN = nullptr; r0.O8 = FP8_UP_OUT ? (unsigned char*)F.out + DO_OFOX8 + (rowb + (size_t)x * 256) * 2048 + h * 128 : nullptr;
        r1 = r0; r1.Q = proj + (rowb + (size_t)(7 - x) * 256) * PP + C_FQ + h * 128; r1.O = (att::bf16*)r1.Q; r1.P0 = (7 - x) * 256; r1.O8 = FP8_UP_OUT ? (unsigned char*)F.out + DO_OFOX8 + (rowb + (size_t)(7 - x) * 256) * 2048 + h * 128 : nullptr;
        att::Seam S;
        att::attn_prime<0>(r0, lds, S);
        att::attn_block<0>(r0, r1, lds, S);
        att::attn_block<0>(r1, r1, lds, S);
    }
    if (F.p0_mask & 2) {
        att::BlockRef r0, r1;
        r0.Q = proj + (rowb + (size_t)x * 256) * PP + C_RQ + h * 128; r0.K = proj + rowb * PP + C_RK + h * 128; r0.V = proj + rowb * PP + C_RV + h * 128; r0.O = (att::bf16*)r0.Q;
        r0.P0 = x * 256; r0.skv = SEQ; r0.lg = log2f(1.f - exp2f(-5.f - (float)h)); r0.RG = proj + (rowb + (size_t)x * 256) * PP + C_RG + h * 128; r0.GN = F.in[I_RET_G] + h * 128; r0.O8 = FP8_UP_OUT ? (unsigned char*)F.out + DO_ORET8 + (rowb + (size_t)x * 256) * 2048 + h * 128 : nullptr;
        r1 = r0; r1.O8 = FP8_UP_OUT ? (unsigned char*)F.out + DO_ORET8 + (rowb + (size_t)(7 - x) * 256) * 2048 + h * 128 : nullptr; r1.Q = proj + (rowb + (size_t)(7 - x) * 256) * PP + C_RQ + h * 128; r1.O = (att::bf16*)r1.Q; r1.P0 = (7 - x) * 256; r1.RG = proj + (rowb + (size_t)(7 - x) * 256) * PP + C_RG + h * 128;
        att::Seam S;
        att::attn_prime<1>(r0, lds, S);
        att::attn_block<1>(r0, r1, lds, S);
        att::attn_block<1>(r1, r1, lds, S);
    }
}


__device__ __forceinline__ void p8_convert_peer(Frame& F) {
    const int lane = F.lane;
    f32x4 g[8];
#pragma unroll
    for (int j = 0; j < 8; ++j) g[j] = ((const GAS f32x4*)F.in[I_LN_FFN])[lane + 64 * j];
    float* scl = (float*)(F.ws + WS_PSCALE);
    int r0, rend, rstride;
    if (F.bx >= 160) { r0 = (F.bx - 160) * NWAVES + F.wave; rend = 22272; rstride = 768; } else { r0 = 22272 + F.bx * NWAVES + F.wave; rend = 32768; rstride = 1280; }
#pragma unroll 1
    for (int rr = r0; rr < rend; rr += 2 * rstride) {
        f32x4 v[2][8]; float amax[2] = {0.f, 0.f}; bool ok[2], isu[2]; int ri[2];
#pragma unroll
        for (int q = 0; q < 2; ++q) { const int r = rr + q * rstride; ok[q] = r < rend; const int rc = ok[q] ? r : rr; isu[q] = rc < 16384; ri[q] = rc;
            const float* src = (isu[q] ? F.in[I_PEER_U] : F.in[I_PEER_V]) + (size_t)(rc & 16383) * DM;
#pragma unroll
            for (int j = 0; j < 8; ++j) v[q][j] = ((const GAS f32x4*)src)[lane + 64 * j]; }
#pragma unroll
        for (int q = 0; q < 2; ++q) {
#pragma unroll
            for (int j = 0; j < 8; ++j) { if (isu[q]) v[q][j] = v[q][j] * g[j]; amax[q] = fmaxf(amax[q], fmaxf(fmaxf(fabsf(v[q][j].x), fabsf(v[q][j].y)), fmaxf(fabsf(v[q][j].z), fabsf(v[q][j].w)))); }
#pragma unroll
            for (int o = 1; o < 64; o <<= 1) amax[q] = fmaxf(amax[q], __shfl_xor(amax[q], o));
            const float sc = amax[q] > 0.f ? amax[q] * (1.f / 448.f) : 1.f, inv = 1.f / sc;
            if (ok[q]) { if (lane == 0) scl[ri[q]] = sc;
                GAS unsigned* o4 = (GAS unsigned*)(F.ws + (isu[q] ? WS_PU : WS_PV) + (size_t)(ri[q] & 16383) * DM) + lane;
#pragma unroll
                for (int j = 0; j < 8; ++j) { int p = 0; p = __builtin_amdgcn_cvt_pk_fp8_f32(v[q][j].x * inv, v[q][j].y * inv, p, false); p = __builtin_amdgcn_cvt_pk_fp8_f32(v[q][j].z * inv, v[q][j].w * inv, p, true); o4[64 * j] = (unsigned)p; } } }
    }
}
__device__ __forceinline__ void norm_own_tile(Frame& F, bf16* base, int ld, int row0, int col0, const float* gain, float mul) {
    asm volatile("s_waitcnt vmcnt(0)" ::: "memory"); __syncthreads();
    const int lane = F.lane, rsel = lane >> 5, head = (lane >> 4) & 1, sub = lane & 15;
    float gv[8];
#pragma unroll
    for (int i = 0; i < 8; ++i) gv[i] = gain[sub * 8 + i] * mul;
#pragma unroll 1
    for (int r4 = 0; r4 < 16; r4 += 4) {
        att::bf16x8 v[4]; bf16* p[4];
#pragma unroll
        for (int q = 0; q < 4; ++q) { p[q] = base + (size_t)(row0 + F.wave * 32 + (r4 + q) * 2 + rsel) * ld + col0 + head * 128 + sub * 8; v[q] = *(const att::bf16x8*)p[q]; }
#pragma unroll
        for (int q = 0; q < 4; ++q) { float a[8]; unpack8s(v[q], a); float s = 0.f;
#pragma unroll
            for (int i = 0; i < 8; ++i) s += a[i] * a[i];
            s += __shfl_xor(s, 1); s += __shfl_xor(s, 2); s += __shfl_xor(s, 4); s += __shfl_xor(s, 8);
            const float rr = 1.f / sqrtf(s * (1.f / 128.f) + RMS_EPS);
#pragma unroll
            for (int i = 0; i < 8; ++i) a[i] *= rr * gv[i];
            *(att::bf16x8*)p[q] = pack8s(a); }
    }
}
__device__ __forceinline__ void fix_own_tile(Frame& F, bf16* proj, int pm, int pn) {
    const int lane = F.lane, kind = pn >> 2;
    if (kind < 2) {
        const int rsel = lane >> 5, head = (lane >> 4) & 1, sub = lane & 15; float gv[8];
#pragma unroll
        for (int i = 0; i < 8; ++i) gv[i] = kind == 0 ? F.in[I_FOXQ_G][sub * 8 + i] * QK_C2 : F.in[I_FOXK_G][sub * 8 + i];
#pragma unroll 1
        for (int r4 = 0; r4 < 16; r4 += 4) { att::bf16x8 v[4]; bf16* p[4];
#pragma unroll
            for (int q = 0; q < 4; ++q) { p[q] = proj + (size_t)(pm * 256 + F.wave * 32 + (r4 + q) * 2 + rsel) * PP + pn * 256 + head * 128 + sub * 8; v[q] = *(const att::bf16x8*)p[q]; }
#pragma unroll
            for (int q = 0; q < 4; ++q) { float a[8]; unpack8s(v[q], a); float s = 0.f;
#pragma unroll
                for (int i = 0; i < 8; ++i) s += a[i] * a[i];
                s += __shfl_xor(s, 1); s += __shfl_xor(s, 2); s += __shfl_xor(s, 4); s += __shfl_xor(s, 8);
                const float rr = 1.f / sqrtf(s * (1.f / 128.f) + RMS_EPS);
#pragma unroll
                for (int i = 0; i < 8; ++i) a[i] *= rr * gv[i];
                *(att::bf16x8*)p[q] = pack8s(a); } }
    } else {
        const int rsel = lane >> 4, head = (lane >> 3) & 1, sub = lane & 7; const float sc = kind == 3 ? 0.08838834764831845f : 1.f; float fr[8];
#pragma unroll
        for (int i = 0; i < 8; ++i) fr[i] = expf(-9.210340371976184f * (float)(sub * 8 + i) * (1.f / 64.f)) * 0.15915494309189535f;
#pragma unroll 1
        for (int r4 = 0; r4 < 8; r4 += 4) { att::bf16x8 va[4], vb[4]; bf16* p[4];
#pragma unroll
            for (int q = 0; q < 4; ++q) { p[q] = proj + (size_t)(pm * 256 + F.wave * 32 + (r4 + q) * 4 + rsel) * PP + pn * 256 + head * 128 + sub * 8; va[q] = *(const att::bf16x8*)p[q]; vb[q] = *(const att::bf16x8*)(p[q] + 64); }
#pragma unroll
            for (int q = 0; q < 4; ++q) { const float pos = (float)((pm * 256 + F.wave * 32 + (r4 + q) * 4 + rsel) & (SEQ - 1)); float a[8], b[8], oa[8], ob[8]; unpack8s(va[q], a); unpack8s(vb[q], b);
#pragma unroll
                for (int i = 0; i < 8; ++i) { float rev = pos * fr[i]; rev -= rintf(rev); const float sn = __builtin_amdgcn_sinf(rev), cs = __builtin_amdgcn_cosf(rev);
                    oa[i] = (a[i] * cs - b[i] * sn) * sc; ob[i] = (a[i] * sn + b[i] * cs) * sc; }
                *(att::bf16x8*)p[q] = pack8s(oa); *(att::bf16x8*)(p[q] + 64) = pack8s(ob); } }
    }
}
__device__ __forceinline__ void p10_mem_attention(Frame& F) {
    char* lds = (char*)F.ldsg;
    const int b = F.bx >> 5, h = (F.bx >> 3) & 3, qb = F.bx & 7;
    att::BlockRef r0;
    const size_t qoff = ((size_t)b * SEQ + (size_t)qb * 256) * 512 + h * 128;
    r0.Q = (const att::bf16*)(F.ws + WS_QM) + qoff; r0.O = (att::bf16*)(F.ws + WS_OMEM) + qoff;
    r0.K = (const att::bf16*)(F.ws + WS_KVM) + (size_t)(b * 256) * 1024 + h * 128; r0.V = r0.K + 512;
    r0.P0 = 1 << 20; r0.skv = 256; r0.lg = 0.f; r0.RG = nullptr; r0.GN = nullptr; r0.O8 = F.ws + WS_OMEM + ((size_t)b * SEQ + (size_t)qb * 256) * 512 + h * 128;
    att::Seam S;
    att::attn_prime<2>(r0, lds, S);
    att::attn_block<2>(r0, r0, lds, S);
}
#define TK_INS(L, v) do { _Pragma("unroll") for (int i_ = 15; i_ >= 1; --i_) L[i_] = __builtin_amdgcn_fmed3f(L[i_ - 1], L[i_], (v)); L[0] = fmaxf(L[0], (v)); } while (0)
__device__ __forceinline__ void p13_topk_unit(Frame& F, int pm, int h) {
    const int lane = F.lane, r32 = lane & 31, hi = lane >> 5, wave = F.wave;
    const att::bf16* qp = (const att::bf16*)(F.ws + WS_QP); const att::bf16* subk = (const att::bf16*)(F.ws + WS_SUBK);
    int* idx_o = (int*)(F.ws + WS_IDX); float* gate_o = (float*)(F.ws + WS_GATE);
    LAS unsigned* kb = (LAS unsigned*)(F.lds + 65536 + (wave * 32 + (lane & 31)) * 32);
    const int tok = pm * 256 + wave * 32 + r32;
    const unsigned q_lane = (unsigned)((tok * DM + hi * 8) * 2), k_lane = (unsigned)((r32 * 128 + hi * 8) * 2);
    att::bf16x8 qf[8];
#define TK_STAGE(p_) do { const int hp_ = h * 2 + (p_); const unsigned char* qb_ = (const unsigned char*)qp + (size_t)hp_ * 256; \
        const unsigned char* kb_ = (const unsigned char*)subk + (size_t)hp_ * 32768 + (size_t)(wave >> 1) * 8192 + (size_t)(wave & 1) * 128; \
        _Pragma("unroll") for (int d0 = 0; d0 < 8; ++d0) qf[d0] = *(const GAS att::bf16x8*)(qb_ + d0 * 32 + q_lane); \
        _Pragma("unroll") for (int f_ = 0; f_ < 4; ++f_) \
            __builtin_amdgcn_global_load_lds((const GAS unsigned*)(kb_ + f_ * 32 + k_lane), (LAS unsigned*)(F.lds + (p_) * 32768 + (wave * 4 + f_) * 1024), 16, 0, 0); } while (0)
    float L0[16], L1[16];
#pragma unroll
    for (int i = 0; i < 16; ++i) { L0[i] = 0.f; L1[i] = 0.f; }
    TK_STAGE(0);
#pragma unroll 1
    for (int p = 0; p < 2; ++p) {
        asm volatile("s_waitcnt vmcnt(0)" ::: "memory"); __syncthreads();
        att::f32x16 acc[4];
        const LAS unsigned char* img = F.lds + p * 32768;
#pragma unroll
        for (int kt = 0; kt < 4; ++kt) { acc[kt] = att::f32x16{};
#pragma unroll
            for (int d0 = 0; d0 < 8; ++d0) acc[kt] = __builtin_amdgcn_mfma_f32_32x32x16_bf16(*(const LAS att::bf16x8*)(img + (kt * 8 + d0) * 1024 + lane * 16), qf[d0], acc[kt], 0, 0, 0); }
        if (p == 0) TK_STAGE(1);
        float L[16];
#pragma unroll
        for (int i = 0; i < 16; ++i) L[i] = -3.0e38f;
#pragma unroll
        for (int kt = 0; kt < 4; ++kt)
#pragma unroll
            for (int r = 0; r < 16; ++r) { const unsigned key = (unsigned)(kt * 32 + (r & 3) + 8 * (r >> 2)) + 4u * (unsigned)hi;
                const float v = __uint_as_float((__float_as_uint(acc[kt][r]) & ~0x7Fu) | key); TK_INS(L, v); }
        float P[16];
#pragma unroll
        for (int i = 0; i < 16; ++i) P[i] = __shfl_xor(L[i], 32);
#pragma unroll
        for (int i = 0; i < 16; ++i) TK_INS(L, P[i]);
#pragma unroll
        for (int i = 0; i < 16; ++i) { L0[i] = p == 0 ? L[i] : L0[i]; L1[i] = p == 0 ? L1[i] : L[i]; }
    }
#undef TK_STAGE
#pragma unroll
        for (int w = 0; w < 4; ++w) {
            kb[w] = (__float_as_uint(L0[4 * w]) & 0x7Fu) | ((__float_as_uint(L0[4 * w + 1]) & 0x7Fu) << 8) | ((__float_as_uint(L0[4 * w + 2]) & 0x7Fu) << 16) | ((__float_as_uint(L0[4 * w + 3]) & 0x7Fu) << 24);
            kb[4 + w] = (__float_as_uint(L1[4 * w]) & 0x7Fu) | ((__float_as_uint(L1[4 * w + 1]) & 0x7Fu) << 8) | ((__float_as_uint(L1[4 * w + 2]) & 0x7Fu) << 16) | ((__float_as_uint(L1[4 * w + 3]) & 0x7Fu) << 24); }
        float T[16];
#pragma unroll
        for (int i = 0; i < 16; ++i) T[i] = -3.0e38f;
#pragma unroll
        for (int a = 0; a < 16; ++a) { const float sa = __uint_as_float(__float_as_uint(L0[a]) & ~0x7Fu);
#pragma unroll
            for (int b2 = 0; b2 < 16; ++b2) if ((a + 1) * (b2 + 1) <= 16) { const float s = sa + __uint_as_float(__float_as_uint(L1[b2]) & ~0x7Fu);
                const float v = __uint_as_float((__float_as_uint(s) & ~0xFFu) | (unsigned)(a * 16 + b2)); TK_INS(T, v); } }
        LDS_WAIT();
        const LAS unsigned char* kbb = (const LAS unsigned char*)kb;
        float sc[16]; int ei[16]; float mx = __uint_as_float(__float_as_uint(T[0]) & ~0xFFu), sum = 0.f;
#pragma unroll
        for (int k = 0; k < 16; ++k) { const unsigned bits = __float_as_uint(T[k]); const unsigned id = bits & 0xFFu;
            const int i1 = kbb[id >> 4], i2 = kbb[16 + (id & 15u)]; ei[k] = i1 * 128 + i2;
            sc[k] = __builtin_amdgcn_exp2f((__uint_as_float(bits & ~0xFFu) - mx) * 1.4426950408889634f); sum += sc[k]; }
        const float inv = 1.f / sum;
        if (hi == 0) {
#pragma unroll
            for (int w = 0; w < 4; ++w) {
                *(GAS v4u*)(idx_o + (size_t)tok * 128 + h * 16 + 4 * w) = (v4u){(unsigned)ei[4 * w], (unsigned)ei[4 * w + 1], (unsigned)ei[4 * w + 2], (unsigned)ei[4 * w + 3]};
                *(GAS f32x4*)(gate_o + (size_t)tok * 128 + h * 16 + 4 * w) = (f32x4){sc[4 * w] * inv, sc[4 * w + 1] * inv, sc[4 * w + 2] * inv, sc[4 * w + 3] * inv}; } }
        LDS_WAIT(); asm volatile("" ::: "memory");
}


typedef float f32x2 __attribute__((ext_vector_type(2)));
__device__ __forceinline__ float gelu_tanh(float x) {
    const float y = 0.7978845608028654f * (x + 0.044715f * x * x * x);
    const float t = 1.f - 2.f * __builtin_amdgcn_rcpf(1.f + __builtin_amdgcn_exp2f(2.885390081777927f * y));
    return 0.5f * x * (1.f + t);
}
__device__ __forceinline__ float dot2bf(unsigned a, unsigned b, float acc) { asm("v_dot2c_f32_bf16 %0, %1, %2" : "+v"(acc) : "v"(a), "v"(b)); return acc; }
#ifndef EX_QCH
#define EX_QCH 2
#endif
struct RowBuf { v4u r[8]; float su, sv; };
#define DPP_MOV(v, ctrl) __builtin_bit_cast(float, __builtin_amdgcn_update_dpp(0, __builtin_bit_cast(int, (v)), (ctrl), 0xF, 0xF, false))
#define ROW_ROR(v, n) __builtin_bit_cast(float, __builtin_amdgcn_update_dpp(0, __builtin_bit_cast(int, (v)), 0x120 + (n), 0xF, 0xF, false))
__device__ __forceinline__ void p14_experts_sorted(Frame& F) {
    const int lane = F.lane, wave = F.wave, q = lane >> 4, l16 = lane & 15;
    const bf16* xb = (const bf16*)(F.ws + WS_XB2); const unsigned char* pu = F.ws + WS_PU; const unsigned char* pv = F.ws + WS_PV;
    const int* idx = (const int*)(F.ws + WS_IDX); const float* gate = (const float*)(F.ws + WS_GATE); const float* rowss = (const float*)(F.ws + WS_ROWSS2);
    const float* su = (const float*)(F.ws + WS_PSCALE); const float* sv = su + 16384;
    LAS unsigned* list = (LAS unsigned*)(F.lds + wave * 8192) + q * 128;
    LAS float* wl = (LAS float*)(F.lds + wave * 8192 + 2048) + q * 128;
    LAS float* gt = (LAS float*)(F.lds + wave * 8192 + 4096) + q * 128;
    LAS unsigned* cnt = (LAS unsigned*)(F.lds + wave * 8192 + 6144) + q * 32;
    constexpr int NSTEP = 128;
    for (int grp = 0; grp < 2; ++grp) {
        const int tok = (F.bx * NWAVES + wave) * 8 + grp * 4 + q;
        const float rs = 1.f / sqrtf(rowss[tok] * (1.f / DM) + RMS_EPS);
        cnt[l16] = 0u; cnt[16 + l16] = 0u;
        unsigned ent[8], pos[8];
#pragma unroll
        for (int j = 0; j < 8; ++j) { const int k = l16 + 16 * j; const unsigned e = (unsigned)idx[(size_t)tok * 128 + k]; gt[k] = gate[(size_t)tok * 128 + k]; ent[j] = e | ((unsigned)k << 16); }
        LDS_WAIT(); asm volatile("" ::: "memory");
#pragma unroll
        for (int j = 0; j < 8; ++j) pos[j] = __hip_atomic_fetch_add(cnt + ((ent[j] & 0x3FFFu) >> 9), 1u, __ATOMIC_RELAXED, __HIP_MEMORY_SCOPE_WORKGROUP);
        LDS_WAIT(); asm volatile("" ::: "memory");
        { const unsigned c0 = cnt[l16], c1 = cnt[16 + l16]; unsigned i0 = c0;
#pragma unroll
          for (int o = 1; o < 16; o <<= 1) { const unsigned tt = __shfl_up(i0, o, 16); if (l16 >= o) i0 += tt; }
          const unsigned tot0 = __shfl(i0, 15, 16); unsigned i1 = c1;
#pragma unroll
          for (int o = 1; o < 16; o <<= 1) { const unsigned tt = __shfl_up(i1, o, 16); if (l16 >= o) i1 += tt; }
          LDS_WAIT(); asm volatile("" ::: "memory");
          cnt[l16] = i0 - c0; cnt[16 + l16] = tot0 + i1 - c1; }
        LDS_WAIT(); asm volatile("" ::: "memory");
#pragma unroll
        for (int j = 0; j < 8; ++j) list[cnt[(ent[j] & 0x3FFFu) >> 9] + pos[j]] = ent[j];
        LDS_WAIT(); asm volatile("" ::: "memory");
        const unsigned lane_off = (unsigned)l16 * 16u;
        constexpr int QCH = EX_QCH, NSW = 8 / QCH;
#define EX_LD(B, s_, TABQ) do { const int ss_ = (s_) < NSTEP ? (s_) : NSTEP - 1; const unsigned off_ = ((list[ss_] & 0x3FFFu) << 11) + lane_off;     \
            _Pragma("unroll") for (int c_ = 0; c_ < QCH; ++c_) B[c_] = *(const GAS v4u*)((TABQ) + off_ + c_ * 256); } while (0)
#define EX_RING(TABQ, STEPFN, ENDFN) do { v4u H0[QCH], H1[QCH], H2[QCH], H3[QCH], H4[QCH], H5[QCH], H6[QCH], H7[QCH]; \
            EX_LD(H0, 0, TABQ); EX_LD(H1, 1, TABQ); EX_LD(H2, 2, TABQ); EX_LD(H3, 3, TABQ); EX_LD(H4, 4, TABQ); EX_LD(H5, 5, TABQ); EX_LD(H6, 6, TABQ); \
            _Pragma("unroll 1") for (int s = 0; s < NSTEP; s += 8) { \
                EX_LD(H7, s + 7, TABQ); STEPFN(H0, s, 0); \
                EX_LD(H0, s + 8, TABQ); STEPFN(H1, s + 1, 1); \
                EX_LD(H1, s + 9, TABQ); STEPFN(H2, s + 2, 2); \
                EX_LD(H2, s + 10, TABQ); STEPFN(H3, s + 3, 3); \
                EX_LD(H3, s + 11, TABQ); STEPFN(H4, s + 4, 4); \
                EX_LD(H4, s + 12, TABQ); STEPFN(H5, s + 5, 5); \
                EX_LD(H5, s + 13, TABQ); STEPFN(H6, s + 6, 6); \
                EX_LD(H6, s + 14, TABQ); STEPFN(H7, s + 7, 7); \
                ENDFN(s); } } while (0)
#pragma unroll 1
        for (int j = 0; j < NSW; ++j) {
            f32x2 xf[QCH][8];
#pragma unroll
            for (int c = 0; c < QCH; ++c) { const v4u a = *(const GAS v4u*)(xb + (size_t)tok * DM + j * (QCH * 256) + c * 256 + l16 * 16), b = *(const GAS v4u*)(xb + (size_t)tok * DM + j * (QCH * 256) + c * 256 + l16 * 16 + 8);
                const unsigned xd[8] = {a.x, a.y, a.z, a.w, b.x, b.y, b.z, b.w};
#pragma unroll
                for (int i = 0; i < 8; ++i) xf[c][i] = (f32x2){__uint_as_float(xd[i] << 16), __uint_as_float(xd[i] & 0xffff0000u)}; }
            const unsigned char* tabq = pu + j * (QCH * 256);
#define EX_U(B, s_, k_) do { f32x2 d2_ = {0.f, 0.f}; \
            _Pragma("unroll") for (int c_ = 0; c_ < QCH; ++c_) { const unsigned ud[4] = {B[c_].x, B[c_].y, B[c_].z, B[c_].w}; \
                _Pragma("unroll") for (int w_ = 0; w_ < 4; ++w_) { d2_ = __builtin_amdgcn_cvt_pk_f32_fp8((int)ud[w_], false) * xf[c_][2 * w_] + d2_; d2_ = __builtin_amdgcn_cvt_pk_f32_fp8((int)ud[w_], true) * xf[c_][2 * w_ + 1] + d2_; } } \
            dd[k_] = d2_.x + d2_.y; } while (0)
#define EX_UEND(s_) do { float r4_[4], r2_[2], r1_; \
            { const bool up = (l16 & 8) != 0; _Pragma("unroll") for (int i_ = 0; i_ < 4; ++i_) { const float mine = up ? dd[i_ + 4] : dd[i_], theirs = up ? dd[i_] : dd[i_ + 4]; r4_[i_] = mine + ROW_ROR(theirs, 8); } } \
            { const bool up = (l16 & 4) != 0; _Pragma("unroll") for (int i_ = 0; i_ < 2; ++i_) { const float mine = up ? r4_[i_ + 2] : r4_[i_], theirs = up ? r4_[i_] : r4_[i_ + 2]; \
                const float fromhi = DPP_MOV(theirs, 0x104), fromlo = DPP_MOV(theirs, 0x114); r2_[i_] = mine + (up ? fromlo : fromhi); } }     \
            { const bool up = (l16 & 2) != 0; const float mine = up ? r2_[1] : r2_[0], theirs = up ? r2_[0] : r2_[1]; r1_ = mine + DPP_MOV(theirs, 0x4E); }     \
            r1_ += DPP_MOV(r1_, 0xB1);                                                                                                                  \
            if ((l16 & 1) == 0) { const int si_ = (s_) + (l16 >> 1); wl[si_] = (j == 0 ? 0.f : wl[si_]) + r1_; } } while (0)
            float dd[8];
            EX_RING(tabq, EX_U, EX_UEND);
#undef EX_U
#undef EX_UEND
            LDS_WAIT(); asm volatile("" ::: "memory");
        }
#pragma unroll
        for (int i = 0; i < 8; ++i) { const int s = l16 + 16 * i; const unsigned me = list[s]; const unsigned e = me & 0x3FFFu;
            wl[s] = gt[(me >> 16) & 127u] * gelu_tanh(wl[s] * su[e] * rs) * sv[e]; }
        LDS_WAIT(); asm volatile("" ::: "memory");
#pragma unroll 1
        for (int j = 0; j < NSW; ++j) {
            f32x2 acc[QCH][8];
#pragma unroll
            for (int c = 0; c < QCH; ++c)
#pragma unroll
                for (int e = 0; e < 8; ++e) acc[c][e] = (f32x2){0.f, 0.f};
            const unsigned char* tabq = pv + j * (QCH * 256);
#define EX_NOEND(s_) do { } while (0)
#define EX_V(B, s_, k_) do { const float w_ = wl[s_]; const f32x2 w2 = {w_, w_}; \
            _Pragma("unroll") for (int c_ = 0; c_ < QCH; ++c_) { const unsigned ud[4] = {B[c_].x, B[c_].y, B[c_].z, B[c_].w}; \
                _Pragma("unroll") for (int w4_ = 0; w4_ < 4; ++w4_) { acc[c_][2 * w4_] = __builtin_amdgcn_cvt_pk_f32_fp8((int)ud[w4_], false) * w2 + acc[c_][2 * w4_]; acc[c_][2 * w4_ + 1] = __builtin_amdgcn_cvt_pk_f32_fp8((int)ud[w4_], true) * w2 + acc[c_][2 * w4_ + 1]; } } } while (0)
            EX_RING(tabq, EX_V, EX_NOEND);
#undef EX_V
#undef EX_NOEND
            float* orow = F.out + (size_t)tok * DM + j * (QCH * 256) + l16 * 16; const bf16* xrow = xb + (size_t)tok * DM + j * (QCH * 256) + l16 * 16;
#pragma unroll
            for (int c = 0; c < QCH; ++c) { const v4u x0 = *(const GAS v4u*)(xrow + c * 256), x1 = *(const GAS v4u*)(xrow + c * 256 + 8); const unsigned xd[8] = {x0.x, x0.y, x0.z, x0.w, x1.x, x1.y, x1.z, x1.w};
#pragma unroll
                for (int qq = 0; qq < 4; ++qq)
                    *(GAS f32x4*)(orow + c * 256 + 4 * qq) = (f32x4){__uint_as_float(xd[2 * qq] << 16) + acc[c][2 * qq].x, __uint_as_float(xd[2 * qq] & 0xffff0000u) + acc[c][2 * qq].y,
                                                                    __uint_as_float(xd[2 * qq + 1] << 16) + acc[c][2 * qq + 1].x, __uint_as_float(xd[2 * qq + 1] & 0xffff0000u) + acc[c][2 * qq + 1].y}; }
        }
#undef EX_LD
#undef EX_RING
        LDS_WAIT(); asm volatile("" ::: "memory");
    }
}

#ifdef ONLY_PHASE
#define ISO(n) ((n) == ONLY_PHASE)
#else
#define ISO(n) true
#endif
#ifndef LAST_PHASE
#define LAST_PHASE 11
#endif
enum { PH_PROLOGUE = 0, PH_GEMM_IN, PH_GEMM_IN8, PH_ATTN, PH_GEMM_FOXUP, PH_GEMM_RETUP, PH_GEMM_OUT, PH_GEMM_MQ, PH_MEM_ATTN, PH_GEMM_MO, PH_GEMM_PQ, PH_EXPERTS, PH_N };
__global__ void __launch_bounds__(NWAVES * 64, 2) mega_fwd(Args args) {
    extern __shared__ __attribute__((aligned(16))) unsigned char lds[];
    Frame F;
    F.lds = (LAS unsigned char*)lds; F.ldsg = lds; F.tid = threadIdx.x; F.lane = F.tid & 63; F.wave = __builtin_amdgcn_readfirstlane(F.tid >> 6); F.G = gridDim.x; F.bx = blockIdx.x;
    F.in = args.in; F.out = args.out; F.ws = args.ws; F.p0_mask = args.p0_mask;
    volatile LAS unsigned* MISC = (volatile LAS unsigned*)(F.lds + MISC_OFF);
    for (int u = F.tid; u < (LDS_BYTES - LDSCTL_OFF) / 4; u += NWAVES * 64) ((LAS unsigned*)(F.lds + LDSCTL_OFF))[u] = 0u;
    __syncthreads();
    gu32* ctl = (gu32*)(args.ws + WS_CTL);
    XcdBarrier bar = xcd_barrier_post((unsigned*)(ctl + CW_BAR), MISC + 8);
    unsigned char* ws = args.ws;
    bf16* proj = (bf16*)(ws + WS_PROJ);
    for (int ph = args.ph_lo; ph < args.ph_hi; ++ph) {
        { int t_ = threadIdx.x; asm volatile("" : "+v"(t_)); F.tid = t_; F.lane = t_ & 63; }
        { int g_ = gridDim.x, b_ = blockIdx.x; asm volatile("" : "+s"(g_), "+s"(b_)); F.G = g_; F.bx = b_; }
        bool is_gemm = false, barrier_after = true, fp8 = false, mq_phase = false, qk_phase = false, pq_phase = false, ksplit = false;
        pg8::Gemm g{nullptr, nullptr, 0, 0, 0, 0, 0x7F7F7F7F}; pg8::EpiAny E{};
        switch (ph) {
#ifndef NO_P0
        case PH_PROLOGUE: if constexpr (ISO(0)) p0_prologue(F); break;
#endif
        case PH_GEMM_IN: if constexpr (ISO(1)) p1_scan(F); is_gemm = true; barrier_after = false; qk_phase = true;
            g = pg8::Gemm{(const bf16*)(ws + WS_XN), (const bf16*)(ws + WS_WIN), M_TOK, N_QK, DM, DM, 0x7F7F7F7F, DM}; E.kind = 0; E.O = proj; E.ldc = PP; E.pn_off = 0; break;
        case PH_GEMM_IN8: is_gemm = true; fp8 = true;
            g = pg8::Gemm{(const bf16*)((unsigned char*)args.out + DO_XN8), (const bf16*)(ws + WS_WIN + 16 * MiB), M_TOK, N_REST, DM / 2, DM / 2, W8_SCALE_B, DM / 2}; E.kind = 0; E.O = proj + N_QK; E.ldc = PP; E.pn_off = N_QK / 256; break;
#ifndef NO_ATTN
        case PH_ATTN: if constexpr (ISO(3)) p4_attention(F); break;
#endif
#if FP8_UP_OUT
        case PH_GEMM_FOXUP: is_gemm = true; fp8 = true;
            g = pg8::Gemm{(const bf16*)((unsigned char*)args.out + DO_OCAT8), (const bf16*)(ws + WS_WFOX), M_TOK, DM, 512, 1024, W8_SCALE_B, 1024}; ksplit = true; E.kind = 7; E.Gt = proj + C_G0; E.Gt2 = proj + C_G1; E.ldg = PP; E.O8 = (unsigned char*)(proj + C_FK); E.ld8 = PP * 2; break;
        case PH_GEMM_RETUP: barrier_after = false; break;
        case PH_GEMM_OUT: is_gemm = true; fp8 = true;
            g = pg8::Gemm{proj + C_FK, (const bf16*)(ws + WS_WOUT), M_TOK, DM, DM / 2, PP, W8_SCALE_B, DM / 2}; E.kind = 4; E.base = args.in[I_X]; E.base16 = nullptr; E.O = (bf16*)(ws + WS_XB1); E.ldc = DM; E.rowss = (float*)(ws + WS_ROWSS1); break;
#else
        case PH_GEMM_FOXUP: is_gemm = true;
            g = pg8::Gemm{proj + C_FQ, (const bf16*)(ws + WS_WFOX), M_TOK, DM, 1024, PP, 0x7F7F7F7F, 1024}; E.kind = 2; E.O = (bf16*)(ws + WS_XN); E.ldc = DM; E.Gt = proj + C_G0; E.ldg = PP; break;
        case PH_GEMM_RETUP: is_gemm = true;
            g = pg8::Gemm{proj + C_RQ, (const bf16*)(ws + WS_WRET), M_TOK, DM, 1024, PP, 0x7F7F7F7F, 1024}; E.kind = 6; E.O = (bf16*)(ws + WS_XN); E.ldc = DM; E.Gt = proj + C_G1; E.ldg = PP; break;
        case PH_GEMM_OUT: is_gemm = true;
            g = pg8::Gemm{(const bf16*)(ws + WS_XN), (const bf16*)(ws + WS_WOUT), M_TOK, DM, DM, DM, 0x7F7F7F7F, DM}; E.kind = 4; E.base = args.in[I_X]; E.base16 = nullptr; E.O = (bf16*)(ws + WS_XB1B); E.ldc = DM; E.rowss = (float*)(ws + WS_ROWSS1); break;
#endif
        case PH_GEMM_MQ: is_gemm = true; mq_phase = true;
            if (F.bx < 128) { g = pg8::Gemm{(const bf16*)(ws + WS_XB1), (const bf16*)(ws + WS_WMQ), M_TOK, 512, DM, DM, 0x7F7F7F7F, DM}; E.kind = 1; E.O = (bf16*)(ws + WS_QM); E.ldc = 512; E.rowss_in = (const float*)(ws + WS_ROWSS1); }
            else { g = pg8::Gemm{(const bf16*)(ws + WS_MN), (const bf16*)(ws + WS_WMKV), NB * 256, 1024, DM, DM, 0x7F7F7F7F, DM}; E.kind = 1; E.O = (bf16*)(ws + WS_KVM); E.ldc = 1024; E.rowss_in = nullptr; }
            break;
        case PH_MEM_ATTN: if constexpr (ISO(8)) p10_mem_attention(F); break;
        case PH_GEMM_MO: is_gemm = true;
            fp8 = true; g = pg8::Gemm{(const bf16*)(ws + WS_OMEM), (const bf16*)(ws + WS_WMO), M_TOK, DM, 256, 256, W8_SCALE_B, 256}; E.kind = 4; E.base = nullptr; E.base16 = (const bf16*)(ws + WS_XB1); E.O = (bf16*)(ws + WS_XB2); E.ldc = DM; E.rowss = (float*)(ws + WS_ROWSS2); break;
        case PH_GEMM_PQ: is_gemm = true; pq_phase = true;
            g = pg8::Gemm{(const bf16*)(ws + WS_XB2), (const bf16*)(ws + WS_WPQ), M_TOK, DM, DM, DM, 0x7F7F7F7F, DM}; E.kind = 1; E.O = (bf16*)(ws + WS_QP); E.ldc = DM; E.rowss_in = (const float*)(ws + WS_ROWSS2); break;
        case PH_EXPERTS: if constexpr (ISO(11)) p14_experts_sorted(F); break;
        default: break;
        }
#ifndef NO_GEMM
        if constexpr (ISO(100)) if (is_gemm) { pg8::StaticOrder S; S.init(g.M, g.N, F.G, (mq_phase && F.bx >= 128) ? F.bx - 128 : F.bx); S.kshift = ksplit ? 1 : 0;
            if (fp8) pg8::gemm_phase<pg8::EpiAny, pg8::StaticOrder, true, true, true>(F.lds, g, S, E); else pg8::gemm_phase<pg8::EpiAny, pg8::StaticOrder, true, true, false>(F.lds, g, S, E); }
        if constexpr (ISO(1)) if (qk_phase) {
            asm volatile("s_waitcnt vmcnt(0)" ::: "memory"); __syncthreads();
            pg8::StaticOrder S; pg8::Unit u; S.init(M_TOK, N_QK, F.G, F.bx);
            for (int i = 0; S.next(i, u); ++i) fix_own_tile(F, proj, u.pm, u.pn); }
        if constexpr (ISO(10)) if (pq_phase) {
            asm volatile("s_waitcnt vmcnt(0)" ::: "memory"); __syncthreads();
            pg8::StaticOrder S; pg8::Unit u; S.init(M_TOK, DM, F.G, F.bx);
            for (int i = 0; S.next(i, u); ++i) p13_topk_unit(F, u.pm, u.pn); }
        if constexpr (ISO(7)) if (mq_phase) {
            pg8::StaticOrder S; pg8::Unit u;
            if (F.bx < 128) { S.init(M_TOK, 512, F.G, F.bx); if (S.next(0, u)) norm_own_tile(F, (bf16*)(ws + WS_QM), 512, u.pm * 256, u.pn * 256, args.in[I_MEMQ_G], QK_C2); }
            else { S.init(NB * 256, 1024, F.G, F.bx - 128); if (S.next(0, u) && u.pn < 2) norm_own_tile(F, (bf16*)(ws + WS_KVM), 1024, u.pm * 256, u.pn * 256, args.in[I_MEMK_G], 1.f); }
            if (!(F.p0_mask & 8)) p8_convert_peer(F); }
#endif
        if (barrier_after && ph + 1 < args.ph_hi) xcd_barrier(bar);
    }
    if (xb_ld((unsigned*)(ctl + CW_BAR) + XB_TMO) != 0u) { const float q = __builtin_nanf(""); for (size_t i = (size_t)F.bx * 512 + F.tid; i < (size_t)M_TOK * DM / 4; i += (size_t)F.G * 512) ((f32x4*)args.out)[i] = (f32x4){q, q, q, q}; }
}

extern "C" void kernel_launch(void* const* d_in, const int* in_sizes, int n_in, void* d_out, int out_size, void* d_ws, size_t ws_size, hipStream_t stream) {
    static int grid = 0;
    if (grid == 0) {
        if (n_in != 23 || out_size != M_TOK * DM || ws_size < WS_END) { fprintf(stderr, "kernel_launch: unexpected shapes (n_in %d out %d ws %zu)\n", n_in, out_size, ws_size); grid = -1; return; }
        int dev = 0, cus = 0, per_cu = 0;
        if (hipGetDevice(&dev) != hipSuccess || hipDeviceGetAttribute(&cus, hipDeviceAttributeMultiprocessorCount, dev) != hipSuccess) { grid = -1; return; }
        if (hipFuncSetAttribute((const void*)mega_fwd, hipFuncAttributeMaxDynamicSharedMemorySize, LDS_BYTES) != hipSuccess) { fprintf(stderr, "hipFuncSetAttribute failed\n"); grid = -1; return; }
        if (hipOccupancyMaxActiveBlocksPerMultiprocessor(&per_cu, (const void*)mega_fwd, NWAVES * 64, LDS_BYTES) != hipSuccess || per_cu < 1) fprintf(stderr, "occupancy query reports %d\n", per_cu);
        (void)hipGetLastError();
        grid = cus;
        if (grid != 256) { fprintf(stderr, "kernel_launch: built for 256 CUs, got %d\n", cus); grid = -1; return; }
    }
    if (grid < 0) return;
    (void)hipMemsetAsync((char*)d_ws + WS_CTL, 0, CTL_ZERO_BYTES, stream);
    Args a{};
    for (int i = 0; i < 23; ++i) a.in[i] = (const float*)d_in[i];
    a.out = (float*)d_out; a.ws = (unsigned char*)d_ws;
#ifdef PROBE_PREFIX
    a.ph_lo = 0; a.ph_hi = PROBE_PREFIX;
#ifdef PROBE_P0_MASK
    a.p0_mask = PROBE_P0_MASK;
#else
    a.p0_mask = 3;
#endif
    hipLaunchKernelGGL(mega_fwd, dim3(grid), dim3(NWAVES * 64), LDS_BYTES, stream, a);
    (void)hipMemsetAsync((char*)d_ws + WS_CTL, 0, CTL_ZERO_BYTES, stream);
#endif
    a.ph_lo = 0; a.ph_hi = LAST_PHASE + 1; a.p0_mask = 3;
    hipLaunchKernelGGL(mega_fwd, dim3(grid), dim3(NWAVES * 64), LDS_BYTES, stream, a);
}
```

```cpp
#include <hip/hip_runtime.h>
#include <cstdio>
#include <cstdint>
#include <cmath>
namespace pg8 {
#define PG8_LAS __attribute__((address_space(3)))
typedef unsigned short bf16_t;
typedef short bf16x8 __attribute__((ext_vector_type(8)));
typedef float f32x4 __attribute__((ext_vector_type(4)));
typedef unsigned u32x4 __attribute__((ext_vector_type(4)));
constexpr int BM = 256, BK = 64, HALF = 128, HTB = HALF * BK * 2  , STAGE_BYTES = 8 * HTB, NXCD = 8, WGM = 8;

__host__ __device__ __forceinline__ int lds_byte(int r, int c) { const int st = (r >> 4) * 2 + (c >> 5), rr = r & 15, cc = c & 31, ob = rr * 64 + cc * 2; return st * 1024 + (ob ^ (((ob >> 9) & 1) << 5)); }
__host__ __device__ __forceinline__ void stage_rc(int b, int& R, int& C) { const int st = b / 1024, sb = b % 1024, swz = sb ^ (((sb >> 9) & 1) << 5); R = (st >> 1) * 16 + swz / 64; C = (st & 1) * 32 + (swz % 64) / 2; }
__host__ __device__ __forceinline__ int perm32(int rho) { const int n = rho >> 4, i = rho & 15; return 8 * (i >> 2) + 4 * n + (i & 3); }

struct Unit { int pm, pn, kp; };
typedef int pg8_v4i __attribute__((ext_vector_type(4)));
struct Gemm { const bf16_t* A; const bf16_t* Bt; int M, N, K, lda; int scale_b; int ldb; };

struct StaticOrder {
    int nM, nN, nwg, G, c, kshift = 0;
    __host__ __device__ __forceinline__ void init(int M, int N, int G_, int c_) { nM = M / BM; nN = N / BM; nwg = nM * nN; G = G_; c = c_; }
    __host__ __device__ __forceinline__ bool next(int i2, Unit& u) const {
        const int i = i2 >> kshift; u.kp = i2 & ((1 << kshift) - 1);
        const long L = (long)i * G + c; if (L >= nwg) return false;
        int wgid = (int)L; { const int q = nwg / NXCD, r = nwg % NXCD, xcd = wgid % NXCD, off = wgid / NXCD; wgid = (xcd < r ? xcd * (q + 1) : r * (q + 1) + (xcd - r) * q) + off; }
        const int nig = WGM * nN, gid = wgid / nig, fm = gid * WGM, gsz = (nM - fm) < WGM ? (nM - fm) : WGM;
        u.pm = fm + ((wgid % nig) % gsz); u.pn = (wgid % nig) / gsz; return true;
    }
    __device__ __forceinline__ void a_ready(const Unit&) const {}
    __device__ __forceinline__ void done(const Unit&) const {}
};

__device__ __forceinline__ unsigned cvt_pk_bf16(float lo, float hi) { unsigned r; asm volatile("v_cvt_pk_bf16_f32 %0, %1, %2" : "=v"(r) : "v"(lo), "v"(hi)); return r; }
typedef float f32x2 __attribute__((ext_vector_type(2)));
__device__ __forceinline__ f32x2 gelu_pk(f32x2 v) {
    const f32x2 av = __builtin_elementwise_abs(v), d = av * 0.2316418882f + 1.0f;
    f32x2 t; t.x = __builtin_amdgcn_rcpf(d.x); t.y = __builtin_amdgcn_rcpf(d.y);
    f32x2 q = t * 0.5307027145f + (-0.7265760135f); q = q * t + 0.7107068705f; q = q * t + (-0.142248368f); q = q * t + 0.127414796f; q = q * t;
    const f32x2 s = (v * v) * (-0.72134752044f);
    f32x2 e; e.x = __builtin_amdgcn_exp2f(s.x); e.y = __builtin_amdgcn_exp2f(s.y);
    const f32x2 m = v * (q * e), r = v - m;
    f32x2 o; o.x = v.x < 0.f ? m.x : r.x; o.y = v.y < 0.f ? m.y : r.y; return o;
}

template <int ACT  > struct EpiBf16 {
    static constexpr bool PERM = true, AFTER_DRAIN = false; static_assert(ACT == 0 || ACT == 1, "EpiBf16: ACT is 0 (none) or 1 (gelu_pk)");
    bf16_t* O; int ldc; const float* bias; int split_cols; size_t split_stride; float scale0;
    __device__ __forceinline__ void operator()(const f32x4 (&acc)[2][2][4][2], const Unit& u, int wr, int wc, int fr, int fq) const {
        const int row0 = u.pm * BM + wr * 64 + fr; int colt = u.pn * BM; bf16_t* base = O;
        float sc = 1.f; if (split_cols) { const int t = colt / split_cols; base += (size_t)t * split_stride; colt -= t * split_cols; if (t == 0) sc = scale0; }
        const int col0 = colt + wc * 32 + 8 * fq, bcol0 = u.pn * BM + wc * 32 + 8 * fq;
        f32x4 bv[2][2];
#pragma unroll
        for (int bj = 0; bj < 2; ++bj)
#pragma unroll
            for (int n = 0; n < 2; ++n) bv[bj][n] = bias ? *(const f32x4*)(bias + bcol0 + bj * HALF + 4 * n) : (f32x4){0.f, 0.f, 0.f, 0.f};
#pragma unroll
        for (int ai = 0; ai < 2; ++ai)
#pragma unroll
            for (int m = 0; m < 4; ++m) { bf16_t* rowp = base + (size_t)(row0 + ai * HALF + m * 16) * ldc + col0;
#pragma unroll
                for (int bj = 0; bj < 2; ++bj) { f32x4 v0 = acc[ai][bj][m][0] + bv[bj][0], v1 = acc[ai][bj][m][1] + bv[bj][1];
                    if (ACT == 1) { f32x2 a = gelu_pk((f32x2){v0[0], v0[1]}), b = gelu_pk((f32x2){v0[2], v0[3]}), c = gelu_pk((f32x2){v1[0], v1[1]}), d = gelu_pk((f32x2){v1[2], v1[3]});
                        v0 = (f32x4){a.x, a.y, b.x, b.y}; v1 = (f32x4){c.x, c.y, d.x, d.y}; }
                    v0 = v0 * sc; v1 = v1 * sc; u32x4 w; w.x = cvt_pk_bf16(v0[0], v0[1]); w.y = cvt_pk_bf16(v0[2], v0[3]); w.z = cvt_pk_bf16(v1[0], v1[1]); w.w = cvt_pk_bf16(v1[2], v1[3]);
                    *(u32x4*)(rowp + bj * HALF) = w; } }
    }
};

struct PanelStats {
    unsigned* xbuf;
    unsigned* cnt;
    unsigned* tmo;
    int ntn; float eps;
    unsigned code;
    __device__ __forceinline__ bool run(const f32x4 (&v)[2][2][4][2], const Unit& u, int wr, int wc, int fr, int fq, PG8_LAS unsigned char* lds, int wid, int lane) const {
        typedef float f32x2v __attribute__((ext_vector_type(2)));
        PG8_LAS f32x2v* P = (PG8_LAS f32x2v*)lds;
        PG8_LAS f32x2v* S = (PG8_LAS f32x2v*)(lds + 8192);
        PG8_LAS unsigned* flag = (PG8_LAS unsigned*)(lds + 8192 + 2048);
#pragma unroll
        for (int ai = 0; ai < 2; ++ai)
#pragma unroll
            for (int m = 0; m < 4; ++m) {
                float s = 0.f;
#pragma unroll
                for (int bj = 0; bj < 2; ++bj)
#pragma unroll
                    for (int n = 0; n < 2; ++n) { const f32x4 x = v[ai][bj][m][n]; s += (x[0] + x[1]) + (x[2] + x[3]); }
                s += __shfl_xor(s, 16); s += __shfl_xor(s, 32);
                const float mw = s * (1.0f / 64.0f); float q = 0.f;
#pragma unroll
                for (int bj = 0; bj < 2; ++bj)
#pragma unroll
                    for (int n = 0; n < 2; ++n) { const f32x4 d = v[ai][bj][m][n] - mw; q += (d[0] * d[0] + d[1] * d[1]) + (d[2] * d[2] + d[3] * d[3]); }
                q += __shfl_xor(q, 16); q += __shfl_xor(q, 32);
                if (fq == 0) P[(ai * HALF + wr * 64 + m * 16 + fr) * 4 + wc] = (f32x2v){mw, q};
            }
        asm volatile("s_waitcnt lgkmcnt(0)" ::: "memory"); __builtin_amdgcn_s_barrier(); asm volatile("" ::: "memory");
#if defined(BROKEN_EXCHANGE_NO_WAIT)
#warning BROKEN CONTROL BUILD: the row-statistics exchange does not wait; results are wrong by design
        if (blockIdx.x >= 64) { const long long t0_ = clock64(); while (clock64() - t0_ < 60000) __builtin_amdgcn_s_sleep(8); }
#endif
        const int row = wid * 32 + (lane & 31);
        if (lane < 32) {
            const f32x2v a = P[row * 4 + 0], b = P[row * 4 + 1], c = P[row * 4 + 2], d = P[row * 4 + 3];
            const float mt = (a.x + b.x + c.x + d.x) * 0.25f;
            const float da = a.x - mt, db = b.x - mt, dc = c.x - mt, dd = d.x - mt;
            const float m2 = (a.y + b.y) + (c.y + d.y) + 64.0f * ((da * da + db * db) + (dc * dc + dd * dd));
            unsigned long long* slot = (unsigned long long*)xbuf + ((size_t)(u.pm * BM + row) * 4 + u.pn);
            __hip_atomic_store(slot, ((unsigned long long)__float_as_uint(m2) << 32) | __float_as_uint(mt), __ATOMIC_RELAXED, __HIP_MEMORY_SCOPE_AGENT);
        }
        asm volatile("s_waitcnt vmcnt(0)" ::: "memory");
        if (lane == 0) __hip_atomic_fetch_add(cnt + 64 * u.pm, 1u, __ATOMIC_RELAXED, __HIP_MEMORY_SCOPE_AGENT);
        if (wid == 0) {
            bool dead = false; const unsigned long long t0 = __builtin_amdgcn_s_memrealtime(); const unsigned want = 8u * (unsigned)ntn;
            for (;;) {
#if defined(BROKEN_EXCHANGE_NO_WAIT)
                break;
#endif
                if ((unsigned)__builtin_amdgcn_readfirstlane(__hip_atomic_load(cnt + 64 * u.pm, __ATOMIC_RELAXED, __HIP_MEMORY_SCOPE_AGENT)) >= want) break;
                if (__builtin_amdgcn_s_memrealtime() - t0 > 2000000ull) {
                    if (lane == 0) { unsigned expect = 0u; __hip_atomic_compare_exchange_strong(tmo + 1, &expect, code | (unsigned)(u.pm & 0xff), __ATOMIC_RELAXED, __ATOMIC_RELAXED, __HIP_MEMORY_SCOPE_AGENT);
                                     __hip_atomic_store(tmo, 1u, __ATOMIC_RELAXED, __HIP_MEMORY_SCOPE_AGENT); }
                    dead = true; break; }
                __builtin_amdgcn_s_sleep(2);
            }
            __builtin_amdgcn_fence(__ATOMIC_ACQUIRE, "agent");
            if (lane == 0) flag[0] = dead ? 1u : 0u;
        }
        asm volatile("s_waitcnt vmcnt(0) lgkmcnt(0)" ::: "memory"); __builtin_amdgcn_s_barrier(); asm volatile("" ::: "memory");
        const bool bad = flag[0] != 0u;
        if (lane < 32) {
            const unsigned long long* slot = (const unsigned long long*)xbuf + (size_t)(u.pm * BM + row) * 4; float mt[4], m2[4]; float ms = 0.f;
#pragma unroll
            for (int t = 0; t < 4; ++t) { if (t < ntn) { const unsigned long long w = __hip_atomic_load(slot + t, __ATOMIC_RELAXED, __HIP_MEMORY_SCOPE_AGENT); mt[t] = __uint_as_float((unsigned)w); m2[t] = __uint_as_float((unsigned)(w >> 32)); } else { mt[t] = 0.f; m2[t] = 0.f; } ms += mt[t]; }
            const float mean = ms / (float)ntn; float q = 0.f;
#pragma unroll
            for (int t = 0; t < 4; ++t) if (t < ntn) { const float dm = mt[t] - mean; q += m2[t] + 256.0f * dm * dm; }
            S[row] = (f32x2v){mean, 1.0f / sqrtf(q / (256.0f * (float)ntn) + eps)};
        }
        asm volatile("s_waitcnt lgkmcnt(0)" ::: "memory"); __builtin_amdgcn_s_barrier(); asm volatile("" ::: "memory");
        return bad;
    }
};
struct EpiLnRes {
    static constexpr bool PERM = false, AFTER_DRAIN = true;
    const float* base; float* out; int ldc; const float* bias; PanelStats st; unsigned poison;
    __device__ __forceinline__ void fused(f32x4 (&acc)[2][2][4][2], const Unit& u, int wr, int wc, int fr, int fq, PG8_LAS unsigned char* lds, int wid, int lane) const {
        typedef float f32x2v __attribute__((ext_vector_type(2)));
        const PG8_LAS f32x2v* S = (const PG8_LAS f32x2v*)(lds + 8192);
        const int col0 = u.pn * BM + wc * 32 + 4 * fq;
#pragma unroll
        for (int bj = 0; bj < 2; ++bj)
#pragma unroll
            for (int n = 0; n < 2; ++n) { const f32x4 bv = bias ? *(const f32x4*)(bias + col0 + bj * HALF + n * 16) : (f32x4){0.f, 0.f, 0.f, 0.f};
#pragma unroll
                for (int ai = 0; ai < 2; ++ai)
#pragma unroll
                    for (int m = 0; m < 4; ++m) acc[ai][bj][m][n] += bv; }
        f32x4 pre[4][2][2];
#pragma unroll
        for (int m = 0; m < 4; ++m) { const size_t off = (size_t)(u.pm * BM + wr * 64 + m * 16 + fr) * ldc + col0;
#pragma unroll
            for (int bj = 0; bj < 2; ++bj)
#pragma unroll
                for (int n = 0; n < 2; ++n) pre[m][bj][n] = *(const f32x4*)(base + off + bj * HALF + n * 16); }
        const bool bad = st.run(acc, u, wr, wc, fr, fq, lds, wid, lane) || poison != 0u;
        const float qnan = __builtin_nanf("");
#pragma unroll
        for (int ai = 0; ai < 2; ++ai)
#pragma unroll
            for (int m = 0; m < 4; ++m) { const int r = ai * HALF + wr * 64 + m * 16 + fr; const f32x2v sr = S[r]; const size_t off = (size_t)(u.pm * BM + r) * ldc + col0;
#pragma unroll
                for (int bj = 0; bj < 2; ++bj)
#pragma unroll
                    for (int n = 0; n < 2; ++n) { const f32x4 bs = ai == 0 ? pre[m][bj][n] : *(const f32x4*)(base + off + bj * HALF + n * 16); f32x4 o = bs + (acc[ai][bj][m][n] - sr.x) * sr.y;
                        if (bad) o = (f32x4){qnan, qnan, qnan, qnan}; *(f32x4*)(out + off + bj * HALF + n * 16) = o; }
                if (m & 1) asm volatile("" ::: "memory"); }
    }
};
struct EpiLnResLn {
    static constexpr bool PERM = false, AFTER_DRAIN = true;
    const float* base; float* out; bf16_t* xn; int ldc; const float* bias; PanelStats st1, st2; unsigned poison;
    __device__ __forceinline__ void fused(f32x4 (&acc)[2][2][4][2], const Unit& u, int wr, int wc, int fr, int fq, PG8_LAS unsigned char* lds, int wid, int lane) const {
        typedef float f32x2v __attribute__((ext_vector_type(2))); typedef unsigned u32x2v __attribute__((ext_vector_type(2)));
        const PG8_LAS f32x2v* S = (const PG8_LAS f32x2v*)(lds + 8192);
        const int col0 = u.pn * BM + wc * 32 + 4 * fq;
#pragma unroll
        for (int bj = 0; bj < 2; ++bj)
#pragma unroll
            for (int n = 0; n < 2; ++n) { const f32x4 bv = bias ? *(const f32x4*)(bias + col0 + bj * HALF + n * 16) : (f32x4){0.f, 0.f, 0.f, 0.f};
#pragma unroll
                for (int ai = 0; ai < 2; ++ai)
#pragma unroll
                    for (int m = 0; m < 4; ++m) acc[ai][bj][m][n] += bv; }
        bool bad = st1.run(acc, u, wr, wc, fr, fq, lds, wid, lane) || poison != 0u;
        const float qnan = __builtin_nanf("");
#pragma unroll
        for (int ai = 0; ai < 2; ++ai)
#pragma unroll
            for (int m = 0; m < 4; ++m) { const int r = ai * HALF + wr * 64 + m * 16 + fr; const f32x2v sr = S[r]; const size_t off = (size_t)(u.pm * BM + r) * ldc + col0;
#pragma unroll
                for (int bj = 0; bj < 2; ++bj)
#pragma unroll
                    for (int n = 0; n < 2; ++n) { const f32x4 bs = *(const f32x4*)(base + off + bj * HALF + n * 16); acc[ai][bj][m][n] = bs + (acc[ai][bj][m][n] - sr.x) * sr.y; }
                asm volatile("" : "+v"(acc[ai][0][m][0]), "+v"(acc[ai][0][m][1]), "+v"(acc[ai][1][m][0]), "+v"(acc[ai][1][m][1]));
                if (m & 1) asm volatile("" ::: "memory"); }
        const bool bad1 = bad;
        bad = st2.run(acc, u, wr, wc, fr, fq, lds, wid, lane) || bad;
#pragma unroll
        for (int ai = 0; ai < 2; ++ai)
#pragma unroll
            for (int m = 0; m < 4; ++m) { const int r = ai * HALF + wr * 64 + m * 16 + fr; const f32x2v sr = S[r]; const size_t off = (size_t)(u.pm * BM + r) * ldc + col0;
#pragma unroll
                for (int bj = 0; bj < 2; ++bj)
#pragma unroll
                    for (int n = 0; n < 2; ++n) { const f32x4 x1 = acc[ai][bj][m][n]; *(f32x4*)(out + off + bj * HALF + n * 16) = bad1 ? (f32x4){qnan, qnan, qnan, qnan} : x1;
                        const f32x4 o = (x1 - sr.x) * sr.y; u32x2v w; w.x = cvt_pk_bf16(o[0], o[1]); w.y = cvt_pk_bf16(o[2], o[3]);
                        if (bad) { w.x = 0x7fc07fc0u; w.y = 0x7fc07fc0u; } *(u32x2v*)(xn + off + bj * HALF + n * 16) = w; }
                asm volatile("" ::: "memory"); }
    }
};

typedef int pg8_v8i __attribute__((ext_vector_type(8)));
template <bool FP8> struct Frag;
template <> struct Frag<false> { bf16x8 k[2]; };
template <> struct Frag<true> { pg8_v8i v; };
__device__ __forceinline__ void load_frag(Frag<false>& f, const PG8_LAS unsigned char* p) { f.k[0] = *(const PG8_LAS bf16x8*)p; f.k[1] = *(const PG8_LAS bf16x8*)(p + 1024); }
__device__ __forceinline__ void load_frag(Frag<true>& f, const PG8_LAS unsigned char* p) { const pg8_v4i a = *(const PG8_LAS pg8_v4i*)p, b = *(const PG8_LAS pg8_v4i*)(p + 1024); f.v = __builtin_shufflevector(a, b, 0, 1, 2, 3, 4, 5, 6, 7); }
__device__ __forceinline__ void mma_frag(f32x4& acc, const Frag<false>& b, const Frag<false>& a, int) { acc = __builtin_amdgcn_mfma_f32_16x16x32_bf16(b.k[0], a.k[0], acc, 0, 0, 0); acc = __builtin_amdgcn_mfma_f32_16x16x32_bf16(b.k[1], a.k[1], acc, 0, 0, 0); }
__device__ __forceinline__ void mma_frag(f32x4& acc, const Frag<true>& b, const Frag<true>& a, int scale_w) {
    asm volatile("v_mfma_scale_f32_16x16x128_f8f6f4 %0, %1, %2, %0, %3, %4 op_sel_hi:[0,0,0]" : "+v"(acc) : "v"(b.v), "v"(a.v), "v"(scale_w), "v"(0x7F7F7F7F)); }
template <class Epi, class Sched, bool ALIGN_EPI = false, bool SP2 = false, bool FP8 = false>
__device__ __forceinline__ void gemm_phase(PG8_LAS unsigned char* lds, const Gemm g, const Sched& S, const Epi& E) {
    int tid_ = threadIdx.x; asm volatile("" : "+v"(tid_));
    const int tid = tid_, wid = __builtin_amdgcn_readfirstlane(tid >> 6), lane = tid & 63, wr = wid >> 2, wc = wid & 3, fr = lane & 15, fq = lane >> 4;
    const int K = g.K, nt = K / BK;
    unsigned voffA[2], voffB[2];
#pragma unroll
    for (int i = 0; i < 2; ++i) { int R, C; stage_rc(tid * 16 + i * 8192, R, C); const int Rb = Epi::PERM ? ((R & ~31) + perm32(R & 31)) : R;
        voffA[i] = (unsigned)(R * g.lda + C) * 2u; voffB[i] = (unsigned)(Rb * g.ldb + C) * 2u; }
    const size_t kstep = (size_t)(BK * 2);
    const size_t hstepB = (size_t)HALF * g.ldb * 2, hstepA = (size_t)HALF * g.lda * 2;
    const size_t tstepB = 2 * hstepB, tstepA = 2 * hstepA;
    const unsigned ldsw = (unsigned)wid * 1024u;
    const int aoff = lds_byte(wr * 64 + fr, fq * 8), boff = lds_byte(wc * 32 + fr, fq * 8);
#define PG8_SA(b, h) (((b) * 2 + (h)) * HTB)
#define PG8_SB(b, h) ((4 + (b) * 2 + (h)) * HTB)
#define PG8_STAGE(bufoff, gbase, voff) do { _Pragma("unroll") for (int _i = 0; _i < 2; ++_i) \
        __builtin_amdgcn_global_load_lds((const unsigned*)((const char*)(gbase) + (voff)[_i]), (PG8_LAS unsigned*)(lds + (bufoff) + ldsw + _i * 8192), 16, 0, 0); } while (0)
#define PG8_LDA(dst, b, h) do { _Pragma("unroll") for (int m = 0; m < 4; ++m) load_frag(dst[m], lds + PG8_SA(b, h) + aoff + m * 2048); } while (0)
#define PG8_LDB(dst, b, h) do { _Pragma("unroll") for (int n = 0; n < 2; ++n) load_frag(dst[n], lds + PG8_SB(b, h) + boff + n * 2048); } while (0)
#define PG8_MMA(ai, bj, At, Bt) do { __builtin_amdgcn_s_setprio(1); _Pragma("unroll") for (int m = 0; m < 4; ++m) _Pragma("unroll") for (int n = 0; n < 2; ++n) mma_frag(acc[ai][bj][m][n], Bt[n], At[m], g.scale_b); \
        __builtin_amdgcn_s_setprio(0); } while (0)
#define PG8_WAIT_V(n) asm volatile("s_waitcnt vmcnt(" #n ")" ::: "memory")
#define PG8_WAIT_L(n) asm volatile("s_waitcnt lgkmcnt(" #n ")" ::: "memory")
#define PG8_BAR __builtin_amdgcn_s_barrier()
#define PG8_SCHED __builtin_amdgcn_sched_barrier(0)
    Unit cur, nxt; int ui = 0;
    if (!S.next(0, cur)) return;
    f32x4 acc[2][2][4][2];
#pragma unroll
    for (int a = 0; a < 2; ++a)
#pragma unroll
        for (int b = 0; b < 2; ++b)
#pragma unroll
            for (int m = 0; m < 4; ++m)
#pragma unroll
                for (int n = 0; n < 2; ++n) acc[a][b][m][n] = (f32x4){0.f, 0.f, 0.f, 0.f};
    Frag<FP8> At[4], B0[2], B1[2];
    const size_t kpart = (size_t)K * 2;
    const char* cA = (const char*)g.A + (size_t)cur.pm * tstepA + cur.kp * kpart; const char* cB = (const char*)g.Bt + (size_t)cur.pn * tstepB + cur.kp * kpart;
    S.a_ready(cur);
    if constexpr (SP2) {
        PG8_STAGE(PG8_SB(0, 0), cB, voffB); PG8_STAGE(PG8_SB(0, 1), cB + hstepB, voffB); PG8_STAGE(PG8_SA(0, 0), cA, voffA); PG8_STAGE(PG8_SA(0, 1), cA + hstepA, voffA);
        if (wr == 1) PG8_BAR;
        PG8_WAIT_V(2); PG8_BAR;
        PG8_STAGE(PG8_SB(1, 0), cB + kstep, voffB); PG8_STAGE(PG8_SA(1, 0), cA + kstep, voffA); PG8_STAGE(PG8_SB(1, 1), cB + hstepB + kstep, voffB);
        PG8_WAIT_V(6); PG8_BAR;
    } else {
        PG8_STAGE(PG8_SB(0, 0), cB, voffB); PG8_STAGE(PG8_SA(0, 0), cA, voffA); PG8_STAGE(PG8_SB(0, 1), cB + hstepB, voffB); PG8_STAGE(PG8_SA(0, 1), cA + hstepA, voffA);
        if (wr == 1) PG8_BAR;
        PG8_WAIT_V(4); PG8_BAR;
        PG8_STAGE(PG8_SB(1, 0), cB + kstep, voffB); PG8_STAGE(PG8_SA(1, 0), cA + kstep, voffA); PG8_STAGE(PG8_SB(1, 1), cB + hstepB + kstep, voffB);
        PG8_WAIT_V(6); PG8_BAR;
    }
    for (;;) {
        const bool has_next = S.next(ui + 1, nxt);
        const char* nA = has_next ? (const char*)g.A + (size_t)nxt.pm * tstepA + nxt.kp * kpart : cA; const char* nB = has_next ? (const char*)g.Bt + (size_t)nxt.pn * tstepB + nxt.kp * kpart : cB;
        for (int t = 0; t < nt; t += 2) {
            const bool last = (t == nt - 2);
            const char* a1 = cA + (size_t)(t + 1) * kstep;
            const char* a2 = last ? nA : cA + (size_t)(t + 2) * kstep; const char* b2 = last ? nB : cB + (size_t)(t + 2) * kstep;
            const char* a3 = a2 + kstep; const char* b3 = b2 + kstep;
            if (last && has_next) S.a_ready(nxt);
            if constexpr (SP2) {
            PG8_LDB(B0, 0, 0); PG8_LDB(B1, 0, 1); PG8_SCHED; PG8_LDA(At, 0, 0); PG8_STAGE(PG8_SA(1, 1), a1 + hstepA, voffA);
            PG8_WAIT_V(8); PG8_WAIT_L(0); PG8_BAR; PG8_MMA(0, 0, At, B0); PG8_MMA(0, 1, At, B1); PG8_BAR; PG8_SCHED;
            PG8_LDA(At, 0, 1); PG8_STAGE(PG8_SB(0, 0), b2, voffB); PG8_STAGE(PG8_SB(0, 1), b2 + hstepB, voffB); PG8_STAGE(PG8_SA(0, 0), a2, voffA);
            PG8_WAIT_V(8); PG8_WAIT_L(0); PG8_BAR; PG8_MMA(1, 0, At, B0); PG8_MMA(1, 1, At, B1); PG8_BAR; PG8_SCHED;
            PG8_LDB(B0, 1, 0); PG8_LDB(B1, 1, 1); PG8_SCHED; PG8_LDA(At, 1, 0); PG8_STAGE(PG8_SA(0, 1), a2 + hstepA, voffA);
            PG8_WAIT_V(8); PG8_WAIT_L(0); PG8_BAR; PG8_MMA(0, 0, At, B0); PG8_MMA(0, 1, At, B1); PG8_BAR; PG8_SCHED;
            PG8_LDA(At, 1, 1); PG8_STAGE(PG8_SB(1, 0), b3, voffB); PG8_STAGE(PG8_SB(1, 1), b3 + hstepB, voffB); PG8_STAGE(PG8_SA(1, 0), a3, voffA);
            PG8_WAIT_V(8); PG8_WAIT_L(0); PG8_BAR; PG8_MMA(1, 0, At, B0); PG8_MMA(1, 1, At, B1); PG8_BAR; PG8_SCHED;
            } else {
            PG8_LDB(B0, 0, 0); PG8_SCHED; PG8_LDA(At, 0, 0); PG8_STAGE(PG8_SA(1, 1), a1 + hstepA, voffA);
            PG8_WAIT_L(8); PG8_BAR; PG8_WAIT_L(0); PG8_MMA(0, 0, At, B0); PG8_BAR; PG8_SCHED;
            PG8_LDB(B1, 0, 1); PG8_STAGE(PG8_SB(0, 0), b2, voffB);
            PG8_BAR; PG8_WAIT_L(0); PG8_MMA(0, 1, At, B1); PG8_BAR;
            PG8_LDA(At, 0, 1); PG8_STAGE(PG8_SA(0, 0), a2, voffA);
            PG8_BAR; PG8_WAIT_L(0); PG8_MMA(1, 0, At, B0); PG8_BAR; PG8_SCHED;
            PG8_STAGE(PG8_SB(0, 1), b2 + hstepB, voffB);
            PG8_WAIT_V(6); PG8_BAR; PG8_MMA(1, 1, At, B1); PG8_BAR;
            PG8_LDB(B0, 1, 0); PG8_SCHED; PG8_LDA(At, 1, 0); PG8_STAGE(PG8_SA(0, 1), a2 + hstepA, voffA);
            PG8_WAIT_L(8); PG8_BAR; PG8_WAIT_L(0); PG8_MMA(0, 0, At, B0); PG8_BAR; PG8_SCHED;
            PG8_LDB(B1, 1, 1); PG8_STAGE(PG8_SB(1, 0), b3, voffB);
            PG8_BAR; PG8_WAIT_L(0); PG8_MMA(0, 1, At, B1); PG8_BAR;
            PG8_LDA(At, 1, 1); PG8_STAGE(PG8_SA(1, 0), a3, voffA);
            PG8_BAR; PG8_WAIT_L(0); PG8_MMA(1, 0, At, B0); PG8_BAR; PG8_SCHED;
            PG8_STAGE(PG8_SB(1, 1), b3 + hstepB, voffB);
            PG8_WAIT_V(6); PG8_BAR; PG8_MMA(1, 1, At, B1); PG8_BAR;
            }
        }
        if constexpr (ALIGN_EPI) { if (wr == 0) PG8_BAR; }
        if constexpr (FP8) { asm volatile("s_nop 15\n\ts_nop 15" ::: "memory"); }
        if constexpr (!Epi::AFTER_DRAIN) { E(acc, cur, wr, wc, fr, fq); S.done(cur); }
        if (!has_next) break;
        if (nxt.kp == 0)
#pragma unroll
        for (int a = 0; a < 2; ++a)
#pragma unroll
            for (int b = 0; b < 2; ++b)
#pragma unroll
                for (int m = 0; m < 4; ++m)
#pragma unroll
                    for (int n = 0; n < 2; ++n) acc[a][b][m][n] = (f32x4){0.f, 0.f, 0.f, 0.f};
        cur = nxt; cA = nA; cB = nB; ++ui;
        if constexpr (ALIGN_EPI) { if (wr == 1) PG8_BAR; }
    }
    PG8_WAIT_V(0);
    if constexpr (!ALIGN_EPI) { if (wr == 0) PG8_BAR; }
    PG8_BAR;
    if constexpr (Epi::AFTER_DRAIN) { E.fused(acc, cur, wr, wc, fr, fq, lds, wid, lane); S.done(cur); }
#undef PG8_SA
#undef PG8_SB
#undef PG8_STAGE
#undef PG8_LDA
#undef PG8_LDB
#undef PG8_MMA
#undef PG8_WAIT_V
#undef PG8_WAIT_L
#undef PG8_BAR
#undef PG8_SCHED
}
}

#ifndef PG8_SP2
#define PG8_SP2 true
#endif
#ifndef PG8_ALIGN
#define PG8_ALIGN true
#endif
namespace pg8 {
typedef unsigned u32x2e __attribute__((ext_vector_type(2)));
__device__ __forceinline__ float bfbits2f(unsigned b16) { return __uint_as_float(b16 << 16); }
__device__ __forceinline__ void unpack8(const u32x4 w, float (&f)[8]) {
    f[0] = __uint_as_float(w.x << 16); f[1] = __uint_as_float(w.x & 0xffff0000u); f[2] = __uint_as_float(w.y << 16); f[3] = __uint_as_float(w.y & 0xffff0000u);
    f[4] = __uint_as_float(w.z << 16); f[5] = __uint_as_float(w.z & 0xffff0000u); f[6] = __uint_as_float(w.w << 16); f[7] = __uint_as_float(w.w & 0xffff0000u);
}
__device__ __forceinline__ u32x4 pack8f(const float (&f)[8]) { u32x4 w; w.x = cvt_pk_bf16(f[0], f[1]); w.y = cvt_pk_bf16(f[2], f[3]); w.z = cvt_pk_bf16(f[4], f[5]); w.w = cvt_pk_bf16(f[6], f[7]); return w; }
__device__ __forceinline__ float sigmoid_f(float x) { return __builtin_amdgcn_rcpf(1.f + __builtin_amdgcn_exp2f(-1.4426950408889634f * x)); }

struct EpiProj {
    static constexpr bool PERM = true, AFTER_DRAIN = false;
    bf16_t* O; int ldc; int pn_off;
    __device__ __forceinline__ void operator()(const f32x4 (&acc)[2][2][4][2], const Unit& u, int wr, int wc, int fr, int fq) const {
        const int row0 = u.pm * BM + wr * 64 + fr, col0 = u.pn * BM + wc * 32 + 8 * fq;
        const int gpn = u.pn + pn_off; const int act = gpn < 24 ? 0 : (gpn < 28 ? 1 : 2);
#pragma unroll
        for (int ai = 0; ai < 2; ++ai)
#pragma unroll
            for (int m = 0; m < 4; ++m) { bf16_t* rowp = O + (size_t)(row0 + ai * HALF + m * 16) * ldc + col0;
#pragma unroll
                for (int bj = 0; bj < 2; ++bj) { float v[8];
#pragma unroll
                    for (int i = 0; i < 4; ++i) { v[i] = acc[ai][bj][m][0][i]; v[4 + i] = acc[ai][bj][m][1][i]; }
                    if (act != 0) {
#pragma unroll
                        for (int i = 0; i < 8; ++i) { const float s = sigmoid_f(v[i]); v[i] = (act == 1) ? v[i] * s : s; } }
                    *(u32x4*)(rowp + bj * HALF) = pack8f(v); } }
    }
};
struct EpiRowScale {
    static constexpr bool PERM = true, AFTER_DRAIN = false;
    bf16_t* O; int ldc; const float* rowss; float inv_n, eps;
    __device__ __forceinline__ void operator()(const f32x4 (&acc)[2][2][4][2], const Unit& u, int wr, int wc, int fr, int fq) const {
        const int row0 = u.pm * BM + wr * 64 + fr, col0 = u.pn * BM + wc * 32 + 8 * fq;
        float sc[2][4];
#pragma unroll
        for (int ai = 0; ai < 2; ++ai)
#pragma unroll
            for (int m = 0; m < 4; ++m) sc[ai][m] = rowss ? rowss[row0 + ai * HALF + m * 16] : 0.f;
#pragma unroll
        for (int ai = 0; ai < 2; ++ai)
#pragma unroll
            for (int m = 0; m < 4; ++m) { const int row = row0 + ai * HALF + m * 16; bf16_t* rowp = O + (size_t)row * ldc + col0;
                const float s = rowss ? 1.f / sqrtf(sc[ai][m] * inv_n + eps) : 1.f;
#pragma unroll
                for (int bj = 0; bj < 2; ++bj) { float v[8];
#pragma unroll
                    for (int i = 0; i < 4; ++i) { v[i] = acc[ai][bj][m][0][i] * s; v[4 + i] = acc[ai][bj][m][1][i] * s; }
                    *(u32x4*)(rowp + bj * HALF) = pack8f(v); } }
    }
};
template <bool ADD> struct EpiGate {
    static constexpr bool PERM = true, AFTER_DRAIN = false;
    bf16_t* O; int ldc; const bf16_t* Gt; int ldg; unsigned char* O8; int ld8;
    __device__ __forceinline__ void operator()(const f32x4 (&acc)[2][2][4][2], const Unit& u, int wr, int wc, int fr, int fq) const {
        const int row0 = u.pm * BM + wr * 64 + fr, col0 = u.pn * BM + wc * 32 + 8 * fq;
#pragma unroll
        for (int ai = 0; ai < 2; ++ai)
#pragma unroll
            for (int m = 0; m < 4; ++m) { const int row = row0 + ai * HALF + m * 16; bf16_t* rowp = O + (size_t)row * ldc + col0; const bf16_t* gp = Gt + (size_t)row * ldg + col0;
#pragma unroll
                for (int bj = 0; bj < 2; ++bj) { float v[8], g[8]; unpack8(*(const u32x4*)(gp + bj * HALF), g);
#pragma unroll
                    for (int i = 0; i < 4; ++i) { v[i] = acc[ai][bj][m][0][i] * g[i]; v[4 + i] = acc[ai][bj][m][1][i] * g[4 + i]; }
                    if (ADD) { float t[8]; unpack8(*(const u32x4*)(rowp + bj * HALF), t);
#pragma unroll
                        for (int i = 0; i < 8; ++i) v[i] += t[i];
                        int p0 = 0, p1 = 0; p0 = __builtin_amdgcn_cvt_pk_fp8_f32(v[0], v[1], p0, false); p0 = __builtin_amdgcn_cvt_pk_fp8_f32(v[2], v[3], p0, true);
                        p1 = __builtin_amdgcn_cvt_pk_fp8_f32(v[4], v[5], p1, false); p1 = __builtin_amdgcn_cvt_pk_fp8_f32(v[6], v[7], p1, true);
                        if (O8) *(u32x2e*)(O8 + (size_t)row * ld8 + col0 + bj * HALF) = (u32x2e){(unsigned)p0, (unsigned)p1}; else *(u32x4*)(rowp + bj * HALF) = pack8f(v); }
                    else *(u32x4*)(rowp + bj * HALF) = pack8f(v); } }
    }
};
struct EpiGate8 {
    static constexpr bool PERM = true, AFTER_DRAIN = false;
    const bf16_t* G1; int ldg; unsigned char* O8; int ld8;
    __device__ __forceinline__ void operator()(const f32x4 (&acc)[2][2][4][2], const Unit& u, int wr, int wc, int fr, int fq) const {
        const int row0 = u.pm * BM + wr * 64 + fr, col0 = u.pn * BM + wc * 32 + 8 * fq;
#pragma unroll
        for (int ai = 0; ai < 2; ++ai)
#pragma unroll
            for (int m = 0; m < 4; ++m) { const int row = row0 + ai * HALF + m * 16; const bf16_t* gp = G1 + (size_t)row * ldg + col0;
#pragma unroll
                for (int bj = 0; bj < 2; ++bj) { float v[8], g[8]; unpack8(*(const u32x4*)(gp + bj * HALF), g);
#pragma unroll
                    for (int i = 0; i < 4; ++i) { v[i] = acc[ai][bj][m][0][i] * g[i]; v[4 + i] = acc[ai][bj][m][1][i] * g[4 + i]; }
                    int p0 = 0, p1 = 0; p0 = __builtin_amdgcn_cvt_pk_fp8_f32(v[0], v[1], p0, false); p0 = __builtin_amdgcn_cvt_pk_fp8_f32(v[2], v[3], p0, true);
                    p1 = __builtin_amdgcn_cvt_pk_fp8_f32(v[4], v[5], p1, false); p1 = __builtin_amdgcn_cvt_pk_fp8_f32(v[6], v[7], p1, true);
                    *(u32x2e*)(O8 + (size_t)row * ld8 + col0 + bj * HALF) = (u32x2e){(unsigned)p0, (unsigned)p1}; } }
    }
};
struct EpiResid {
    static constexpr bool PERM = true, AFTER_DRAIN = false;
    const float* base32; const bf16_t* base16; bf16_t* XB; int ldc; float* rowss;
    __device__ __forceinline__ void operator()(const f32x4 (&acc)[2][2][4][2], const Unit& u, int wr, int wc, int fr, int fq) const {
        const int row0 = u.pm * BM + wr * 64 + fr, col0 = u.pn * BM + wc * 32 + 8 * fq;
#pragma unroll
        for (int ai = 0; ai < 2; ++ai)
#pragma unroll
            for (int m = 0; m < 4; ++m) { const int row = row0 + ai * HALF + m * 16; const size_t off = (size_t)row * ldc + col0; float ss = 0.f;
#pragma unroll
                for (int bj = 0; bj < 2; ++bj) { float b[8];
                    if (base32) { const f32x4 b0 = *(const f32x4*)(base32 + off + bj * HALF), b1 = *(const f32x4*)(base32 + off + bj * HALF + 4);
                        b[0] = b0[0]; b[1] = b0[1]; b[2] = b0[2]; b[3] = b0[3]; b[4] = b1[0]; b[5] = b1[1]; b[6] = b1[2]; b[7] = b1[3]; }
                    else unpack8(*(const u32x4*)(base16 + off + bj * HALF), b);
#pragma unroll
                    for (int i = 0; i < 4; ++i) { b[i] += acc[ai][bj][m][0][i]; b[4 + i] += acc[ai][bj][m][1][i]; }
#pragma unroll
                    for (int i = 0; i < 8; ++i) ss += b[i] * b[i];
                    *(u32x4*)(XB + off + bj * HALF) = pack8f(b); }
                ss += __shfl_xor(ss, 16); ss += __shfl_xor(ss, 32);
                if (fq == 0) atomicAdd(rowss + row, ss); }
    }
};
struct EpiAny {
    static constexpr bool PERM = true, AFTER_DRAIN = false;
    int kind; bf16_t* O; int ldc; const bf16_t* Gt; int ldg; const float* base; const bf16_t* base16; float* rowss; const float* rowss_in; int pn_off; unsigned char* O8; int ld8; const bf16_t* Gt2;
    __device__ __forceinline__ void mid(f32x4 (&acc)[2][2][4][2], const Unit& u, int wr, int wc, int fr, int fq) const {
        const int row0 = u.pm * BM + wr * 64 + fr, col0 = u.pn * BM + wc * 32 + 8 * fq;
#pragma unroll
        for (int ai = 0; ai < 2; ++ai)
#pragma unroll
            for (int m = 0; m < 4; ++m) { const int row = row0 + ai * HALF + m * 16; const bf16_t* g0p = Gt + (size_t)row * ldg + col0; const bf16_t* g1p = Gt2 + (size_t)row * ldg + col0;
#pragma unroll
                for (int bj = 0; bj < 2; ++bj) { float a[8], b[8]; unpack8(*(const u32x4*)(g0p + bj * HALF), a); unpack8(*(const u32x4*)(g1p + bj * HALF), b);
#pragma unroll
                    for (int i = 0; i < 4; ++i) { acc[ai][bj][m][0][i] *= a[i] * __builtin_amdgcn_rcpf(b[i]); acc[ai][bj][m][1][i] *= a[4 + i] * __builtin_amdgcn_rcpf(b[4 + i]); } }
                if (m & 1) asm volatile("" ::: "memory"); }
    }
    __device__ __forceinline__ void operator()(f32x4 (&acc)[2][2][4][2], const Unit& u, int wr, int wc, int fr, int fq) const {
        if (kind == 7 && u.kp == 0) { mid(acc, u, wr, wc, fr, fq); return; }
        if (kind == 0) { EpiProj e{O, ldc, pn_off}; e(acc, u, wr, wc, fr, fq); }
        else if (kind == 1) { EpiRowScale e{O, ldc, rowss_in, 1.f / 2048.f, 1e-6f}; e(acc, u, wr, wc, fr, fq); }
        else if (kind == 2) { EpiGate<false> e{O, ldc, Gt, ldg, nullptr, 0}; e(acc, u, wr, wc, fr, fq); }
        else if (kind == 3) { EpiGate<true> e{O, ldc, Gt, ldg, O8, ld8}; e(acc, u, wr, wc, fr, fq); }
        else if (kind == 6) { EpiGate<true> e{O, ldc, Gt, ldg, nullptr, 0}; e(acc, u, wr, wc, fr, fq); }
        else if (kind == 7) { EpiGate8 e{Gt2, ldg, O8, ld8}; e(acc, u, wr, wc, fr, fq); }
        else { EpiResid e{base, base16, O, ldc, rowss}; e(acc, u, wr, wc, fr, fq); }
    }
};
}
#ifndef ATT_QREG
#define ATT_QREG 1
#endif
namespace att {
using bf16 = unsigned short;
typedef short bf16x8 __attribute__((ext_vector_type(8)));
typedef short s16x4 __attribute__((ext_vector_type(4)));
typedef float f32x16 __attribute__((ext_vector_type(16)));
typedef float f32x4 __attribute__((ext_vector_type(4)));
typedef unsigned u32x4 __attribute__((ext_vector_type(4)));
constexpr int D = 128, NW = 8, QBLK = 32, KVBLK = 64, QB = NW * QBLK;
constexpr int SHM_V = KVBLK * D * 2, SHM_K = KVBLK * D * 2;
constexpr int LDS_WS = 2 * SHM_V + 2 * SHM_K;
constexpr int LDS_BIAS = LDS_WS + NW * 64 * 4;
constexpr int LDS_Q = LDS_BIAS + 2048 * 4;
constexpr int LDS_BYTES = LDS_Q + NW * 8192;
constexpr float THR = 8.f;

#define KSWZ(row, colB) ((row) * 256 + ((colB) ^ (((row) & 7) << 4)))
#define SBAR() __builtin_amdgcn_sched_barrier(0)
__device__ __forceinline__ int v_st(int k, int c) { const int kk = (k & ~0xC) | ((k & 4) << 1) | ((k & 8) >> 1); return ((kk >> 3) * 4 + (c >> 5)) * 512 + ((kk & 7) * 32 + (c & 31)) * 2; }
__device__ __forceinline__ int v_rd_base(int lane) { return ((lane & 3) << 3) | (((lane >> 2) & 3) << 6) | (((lane >> 4) & 1) << 5) | (((lane >> 5) & 1) << 8); }
constexpr int v_rd_off(int d0, int ks, int half) { return d0 * 512 + ks * 4096 + half * 2048; }
__device__ __forceinline__ int crow(int r, int hi) { return (r & 3) + 8 * (r >> 2) + 4 * hi; }
__device__ __forceinline__ unsigned cvtpk(float lo, float hi) { unsigned r; asm volatile("v_cvt_pk_bf16_f32 %0, %1, %2" : "=v"(r) : "v"(lo), "v"(hi)); return r; }
__device__ __forceinline__ bf16x8 load8(const bf16* p) { return *reinterpret_cast<const bf16x8*>(p); }
__device__ __forceinline__ float bf2f(unsigned short b) { return __uint_as_float((unsigned)b << 16); }

__device__ __forceinline__ void mask_tile(f32x16& p0, f32x16& p1, int dq) {
    const float NEG = -__builtin_inff();
#pragma unroll
    for (int r = 0; r < 16; ++r) {
        const int c = (r & 3) + 8 * (r >> 2);
        if (dq - c < 0) p0[r] = NEG;
        if (dq - c - 32 < 0) p1[r] = NEG;
    }
}
__device__ __forceinline__ void partialSM(f32x16& p0, f32x16& p1, float& m_reg, float& mn, float& alpha) {
    float pmax = p0[0]; for (int r = 1; r < 16; ++r) pmax = fmaxf(pmax, p0[r]); for (int r = 0; r < 16; ++r) pmax = fmaxf(pmax, p1[r]);
    { auto rr = __builtin_amdgcn_permlane32_swap(__float_as_uint(pmax), __float_as_uint(pmax), false, false);
      pmax = fmaxf(__uint_as_float(rr[0]), __uint_as_float(rr[1])); }
    if (__builtin_expect(__all((pmax - m_reg) <= THR), 1)) { mn = m_reg; alpha = 1.f; }
    else { mn = fmaxf(m_reg, pmax); alpha = __builtin_amdgcn_exp2f(m_reg - mn); m_reg = mn; }
    for (int r = 0; r < 16; ++r) p0[r] = p0[r] - mn; for (int r = 0; r < 16; ++r) p1[r] = p1[r] - mn;
    for (int r = 0; r < 16; ++r) p0[r] = __builtin_amdgcn_exp2f(p0[r]);
}
#define ATT_PK4(P, B_, OUT) do { unsigned a0 = cvtpk(P[B_+0], P[B_+1]), a1 = cvtpk(P[B_+2], P[B_+3]);                          \
        unsigned b0 = cvtpk(P[B_+4], P[B_+5]), b1 = cvtpk(P[B_+6], P[B_+7]);                                             \
        auto r0 = __builtin_amdgcn_permlane32_swap(a0, b0, false, false); auto r1 = __builtin_amdgcn_permlane32_swap(a1, b1, false, false); \
        u32x4 w = {r0[0], r1[0], r0[1], r1[1]}; OUT = *reinterpret_cast<bf16x8*>(&w); } while (0)
__device__ __forceinline__ void finishSM(f32x16& p0, f32x16& p1, float alpha, float& l_reg, bf16x8& pa0, bf16x8& pa1, bf16x8& pa2, bf16x8& pa3) {
    for (int r = 0; r < 16; ++r) p1[r] = __builtin_amdgcn_exp2f(p1[r]);
    float ps = 0; for (int r = 0; r < 16; ++r) ps += p0[r]; for (int r = 0; r < 16; ++r) ps += p1[r];
    { auto rr = __builtin_amdgcn_permlane32_swap(__float_as_uint(ps), __float_as_uint(ps), false, false);
      ps = __uint_as_float(rr[0]) + __uint_as_float(rr[1]); }
    l_reg = l_reg * alpha + ps;
    ATT_PK4(p0, 0, pa0); ATT_PK4(p0, 8, pa1); ATT_PK4(p1, 0, pa2); ATT_PK4(p1, 8, pa3);
}
__device__ __forceinline__ void ret_weight(f32x16& p0, f32x16& p1, int dq, float lg, int dist) {
    if (dist < 0) { p0 = f32x16{}; p1 = f32x16{}; return; }
    if (dist > 0) { const float f = __builtin_amdgcn_exp2f(lg * 64.f * (float)dist);
#pragma unroll
        for (int r = 0; r < 16; ++r) { p0[r] *= f; p1[r] *= f; }
        return; }
#pragma unroll
    for (int r = 0; r < 16; ++r) {
        const int c = (r & 3) + 8 * (r >> 2);
        const float e0 = 2.f * lg * fmaxf((float)(c - dq), 0.f), e1 = 2.f * lg * fmaxf((float)(c + 32 - dq), 0.f);
        p0[r] *= __builtin_amdgcn_exp2f(e0); p1[r] *= __builtin_amdgcn_exp2f(e1);
    }
}
__device__ __forceinline__ void ret_pack(f32x16& p0, f32x16& p1, bf16x8& pa0, bf16x8& pa1, bf16x8& pa2, bf16x8& pa3) {
    ATT_PK4(p0, 0, pa0); ATT_PK4(p0, 8, pa1); ATT_PK4(p1, 0, pa2); ATT_PK4(p1, 8, pa3);
}
template <int KB, bool BIAS>
__device__ __forceinline__ void qkt(f32x16& p0, f32x16& p1, const char* K_lds, int r32, int hi, const char* Qw  , const float* bias_tile  , const bf16x8* qr = nullptr) {
    if (BIAS) {
#pragma unroll
        for (int g = 0; g < 4; ++g) { const f32x4 b0 = *(const f32x4*)(bias_tile + 8 * g), b1 = *(const f32x4*)(bias_tile + 32 + 8 * g);
            p0[4 * g] = b0[0]; p0[4 * g + 1] = b0[1]; p0[4 * g + 2] = b0[2]; p0[4 * g + 3] = b0[3];
            p1[4 * g] = b1[0]; p1[4 * g + 1] = b1[1]; p1[4 * g + 2] = b1[2]; p1[4 * g + 3] = b1[3]; }
    } else { p0 = f32x16{}; p1 = f32x16{}; }
    int ko[4];
#pragma unroll
    for (int dd = 0; dd < 4; ++dd) ko[dd] = KSWZ(r32, (dd * 16 + hi * 8) * 2);
#pragma unroll
    for (int d0 = 0; d0 < 8; ++d0) { const char* a = K_lds + KB * SHM_K + ko[d0 & 3] + (d0 >> 2) * 128;
        bf16x8 b0 = *reinterpret_cast<const bf16x8*>(a);
        bf16x8 b1 = *reinterpret_cast<const bf16x8*>(a + 32 * 256);
#if ATT_QREG
        bf16x8 q = qr[d0];
#else
        bf16x8 q = *reinterpret_cast<const bf16x8*>(Qw + ko[d0 & 3] + (d0 >> 2) * 128);
#endif
        p0 = __builtin_amdgcn_mfma_f32_32x32x16_bf16(b0, q, p0, 0, 0, 0);
        p1 = __builtin_amdgcn_mfma_f32_32x32x16_bf16(b1, q, p1, 0, 0, 0); }
}
template <int VB>
__device__ __forceinline__ void pv_tile(f32x16* o, int vb0, bf16x8 pa0, bf16x8 pa1, bf16x8 pa2, bf16x8 pa3) {
#define TRRD(dst, off) asm volatile("ds_read_b64_tr_b16 %0, %1 offset:%2" : "=&v"(dst) : "v"(vb0), "i"(off) : "memory")
#define PV_D0(d0) do { s16x4 l0, l1, l2, l3, h0, h1, h2, h3; constexpr int b_ = VB * SHM_V + v_rd_off(d0, 0, 0); \
        TRRD(l0, b_); TRRD(h0, b_ + 2048); TRRD(l1, b_ + 4096); TRRD(h1, b_ + 6144); TRRD(l2, b_ + 8192); TRRD(h2, b_ + 10240); TRRD(l3, b_ + 12288); TRRD(h3, b_ + 14336); \
        asm volatile("s_waitcnt lgkmcnt(0)" ::: "memory"); SBAR();   \
        o[d0] = __builtin_amdgcn_mfma_f32_32x32x16_bf16(pa0, (bf16x8){l0[0], l0[1], l0[2], l0[3], h0[0], h0[1], h0[2], h0[3]}, o[d0], 0, 0, 0);   \
        o[d0] = __builtin_amdgcn_mfma_f32_32x32x16_bf16(pa1, (bf16x8){l1[0], l1[1], l1[2], l1[3], h1[0], h1[1], h1[2], h1[3]}, o[d0], 0, 0, 0);   \
        o[d0] = __builtin_amdgcn_mfma_f32_32x32x16_bf16(pa2, (bf16x8){l2[0], l2[1], l2[2], l2[3], h2[0], h2[1], h2[2], h2[3]}, o[d0], 0, 0, 0);   \
        o[d0] = __builtin_amdgcn_mfma_f32_32x32x16_bf16(pa3, (bf16x8){l3[0], l3[1], l3[2], l3[3], h3[0], h3[1], h3[2], h3[3]}, o[d0], 0, 0, 0); } while (0)
    PV_D0(0); PV_D0(1); PV_D0(2); PV_D0(3);
#undef PV_D0
#undef TRRD
}

struct BlockRef { const bf16* Q; const bf16* K; const bf16* V; bf16* O; int P0; int skv; float lg; const bf16* RG; const float* GN; unsigned char* O8;   };
struct Seam { bf16x8 qr[8]; bf16x8 st_v0, st_v1, st_k0, st_k1; };
template <int MODE> struct Pitch { static constexpr int LDQ = (MODE == 2) ? 512 : 11264, LDK = (MODE == 2) ? 1024 : 11264, LDO = LDQ; };

#define ROWK(p, k0, rr) ((p) + (size_t)((k0) + (rr)) * LDK + sc)
#define VMW() asm volatile("s_waitcnt vmcnt(0)" ::: "memory")
#define VMWN(n) asm volatile("s_waitcnt vmcnt(%0)" :: "i"(n) : "memory")
#define SLOAD_H(Kp, Vp, k0) do { S.st_v0 = load8(ROWK(Vp, k0, sr)); S.st_v1 = load8(ROWK(Vp, k0, 32 + sr));              \
                         S.st_k0 = load8(ROWK(Kp, k0, sr)); S.st_k1 = load8(ROWK(Kp, k0, 32 + sr)); } while (0)
#define SWRITE_HK(bf) do { *(bf16x8*)(K_lds + (bf) * SHM_K + kws) = S.st_k0; *(bf16x8*)(K_lds + (bf) * SHM_K + kws + 32 * 256) = S.st_k1; } while (0)
#define SWRITE_HV(bf) do { *(bf16x8*)(V_lds + (bf) * SHM_V + vst0) = S.st_v0; *(bf16x8*)(V_lds + (bf) * SHM_V + vst1) = S.st_v1; } while (0)
#define SWRITE_H(bf) do { SWRITE_HV(bf); SWRITE_HK(bf); } while (0)

template <int MODE>
__device__ __forceinline__ void attn_prime(const BlockRef& cur, char* lds, Seam& S) {
    constexpr int LDQ = Pitch<MODE>::LDQ, LDK = Pitch<MODE>::LDK;
    int tid_ = threadIdx.x; asm volatile("" : "+v"(tid_));
    const int tid = tid_, wid = __builtin_amdgcn_readfirstlane(tid >> 6), lane = tid & 63, r32 = lane & 31, hi = lane >> 5;
    const int sr = tid >> 4, sc = (tid & 15) * 8, kws = KSWZ(sr, sc * 2); char* K_lds = lds + 2 * SHM_V;
    const int kb0 = 0;
    for (int d0 = 0; d0 < 8; ++d0) S.qr[d0] = load8(cur.Q + (size_t)(wid * QBLK + r32) * LDQ + d0 * 16 + hi * 8);
    SLOAD_H(cur.K, cur.V, kb0); VMW(); SWRITE_HK(0);
    __syncthreads();
}
template <int MODE>
__device__ __forceinline__ void attn_block(const BlockRef& cur, const BlockRef& nxt, char* lds, Seam& S) {
    constexpr int LDQ = Pitch<MODE>::LDQ, LDK = Pitch<MODE>::LDK, LDO = Pitch<MODE>::LDO;
    constexpr bool BIAS = (MODE == 0), SOFTMAX = (MODE != 1);
    int tid_ = threadIdx.x; asm volatile("" : "+v"(tid_));
    const int tid = tid_, wid = __builtin_amdgcn_readfirstlane(tid >> 6), lane = tid & 63, r32 = lane & 31, hi = lane >> 5;
    const int j_lo = 0;
    int j_hi = (cur.P0 + QB - 1) / KVBLK + 1; if (j_hi > cur.skv / KVBLK) j_hi = cur.skv / KVBLK;
    const int NT = j_hi - j_lo;
    const int kbn = 0;
    const int qlo = cur.P0 + wid * QBLK, qm = qlo + r32 - 4 * hi;
    char* V_lds = lds; char* K_lds = lds + 2 * SHM_V;
    float* ws = (float*)(lds + LDS_WS) + wid * 64; float* li_l = ws, * al_l = ws + 32;
    const float* bias = (const float*)(lds + LDS_BIAS) + 4 * hi;
    float m_reg = -1e30f, l_reg = 0; f32x16 o[4] = {};
    const int sr = tid >> 4, sc = (tid & 15) * 8, vst0 = v_st(sr, sc), vst1 = v_st(32 + sr, sc), kws = KSWZ(sr, sc * 2);
    const int vb0 = (int)(uintptr_t)V_lds + v_rd_base(lane);
    const bf16* Kh = cur.K; const bf16* Vh = cur.V;
    const float lg = cur.lg; const int cq = qlo >> 6;
#define RESC(a) do { if (SOFTMAX) { if (__any((a) < 1.f)) { if (hi == 0) al_l[r32] = (a); asm volatile("s_waitcnt lgkmcnt(0)" ::: "memory");              \
                     for (int d_ = 0; d_ < 4; ++d_) for (int r = 0; r < 16; ++r) o[d_][r] *= al_l[crow(r, hi)]; } } } while (0)
#define KBASE(t) ((j_lo + (t)) * KVBLK)
#define POSTQK(P0_, P1_, mnX, alX, t) do { const int kb_ = KBASE(t); \
        if (MODE == 1) { ret_weight(P0_, P1_, qm - kb_, lg, cq - (j_lo + (t))); } \
        else { if (MODE == 0 && (kb_ + KVBLK - 1 > qlo)) mask_tile(P0_, P1_, qm - kb_); partialSM(P0_, P1_, m_reg, mnX, alX); } } while (0)
#define FINISH(P0_, P1_, alX) do { if (MODE == 1) ret_pack(P0_, P1_, pa0, pa1, pa2, pa3); else finishSM(P0_, P1_, alX, l_reg, pa0, pa1, pa2, pa3); } while (0)
    constexpr int NQL = 8;
#define SEAM_K0() do { VMWN(NQL); SWRITE_HK(0); SBAR(); } while (0)
    f32x16 pA0, pA1, pB0, pB1; float mnA = 0.f, mnB = 0.f, alA = 1.f, alB = 1.f; bf16x8 pa0, pa1, pa2, pa3;
    char* Qw = lds + LDS_Q + wid * 8192;
#if ATT_QREG
    const bf16x8* QR = S.qr;
#else
    const bf16x8* QR = nullptr;
#pragma unroll
    for (int d0 = 0; d0 < 8; ++d0) *(bf16x8*)(Qw + KSWZ(r32, (d0 * 16 + hi * 8) * 2)) = S.qr[d0];
#endif
    SWRITE_HV(0); SBAR();
    if (NT > 1) { SLOAD_H(Kh, Vh, KBASE(1)); }
    SBAR(); qkt<0, BIAS>(pA0, pA1, K_lds, r32, hi, Qw, bias + KBASE(0), QR);
    POSTQK(pA0, pA1, mnA, alA, 0);
    if (NT > 1) { VMW(); SWRITE_H(1); }
    __syncthreads();
#define HALF_STEP(PX0, PX1, mnX, alX, PY0, PY1, alY, t, KB, VB, SB) do {                                                      \
        SBAR(); qkt<KB, BIAS>(PX0, PX1, K_lds, r32, hi, Qw, bias + KBASE(t), QR);                                             \
        FINISH(PY0, PY1, alY); SBAR();                                                           \
        if ((t) + 1 < NT) { SLOAD_H(Kh, Vh, KBASE((t) + 1)); SBAR(); }                                               \
        pv_tile<VB>(o, vb0, pa0, pa1, pa2, pa3); POSTQK(PX0, PX1, mnX, alX, (t));                                        \
        __syncthreads();                                                                                                      \
        if ((t) + 1 < NT) { VMW(); SWRITE_H(SB); }                                                                          \
        RESC(alX); __syncthreads(); } while (0)
    for (int t = 1; t + 1 < NT; t += 2) {
        HALF_STEP(pB0, pB1, mnB, alB, pA0, pA1, alA, t, 1, 0, 0);
        HALF_STEP(pA0, pA1, mnA, alA, pB0, pB1, alB, t + 1, 0, 1, 1);
    }
    const bool even = (NT & 1) == 0;
    if (even) { SBAR(); qkt<1, BIAS>(pB0, pB1, K_lds, r32, hi, Qw, bias + KBASE(NT - 1), QR); SBAR(); }
    { constexpr int LDQn = LDQ; SLOAD_H(nxt.K, nxt.V, kbn); SBAR();
#pragma unroll
      for (int d0 = 0; d0 < 8; ++d0) S.qr[d0] = load8(nxt.Q + (size_t)(wid * QBLK + r32) * LDQn + d0 * 16 + hi * 8); }
    SBAR();
    FINISH(pA0, pA1, alA); SBAR();
    pv_tile<0>(o, vb0, pa0, pa1, pa2, pa3);
    if (even) { POSTQK(pB0, pB1, mnB, alB, NT - 1); __syncthreads(); RESC(alB);
        FINISH(pB0, pB1, alB); SBAR(); pv_tile<1>(o, vb0, pa0, pa1, pa2, pa3); }
    SBAR(); SEAM_K0();
    bf16* Ow = cur.O + (size_t)(wid * QBLK) * LDO;
    if (MODE != 1) {
        if (hi == 0) li_l[r32] = l_reg; asm volatile("s_waitcnt lgkmcnt(0)" ::: "memory");
        float rli[16];
#pragma unroll
        for (int r = 0; r < 16; ++r) rli[r] = __builtin_amdgcn_rcpf(li_l[crow(r, hi)]);
#pragma unroll
        for (int r = 0; r < 16; ++r) { const int orow = crow(r, hi);
#pragma unroll
            for (int d0 = 0; d0 < 4; ++d0) { const float v = o[d0][r] * rli[r];
                const float vn = __shfl_xor(v, 1);
                if (cur.O8) { const int pk = __builtin_amdgcn_cvt_pk_fp8_f32(v, vn, 0, false); const int pk2 = __shfl_xor(pk, 2);
                    if ((r32 & 3) == 0) *(unsigned*)(cur.O8 + (size_t)(wid * QBLK + orow) * (MODE == 2 ? 512 : 2048) + d0 * 32 + r32) = ((unsigned)pk & 0xFFFFu) | ((unsigned)pk2 << 16); }
                else if ((r32 & 1) == 0) *(unsigned*)(Ow + (size_t)orow * LDO + d0 * 32 + r32) = cvtpk(v, vn); } }
    } else {
        float gn[4];
#pragma unroll
        for (int d0 = 0; d0 < 4; ++d0) gn[d0] = cur.GN[d0 * 32 + r32];
        const bf16* RGw = cur.RG + (size_t)(wid * QBLK) * LDO;
#pragma unroll
        for (int r = 0; r < 16; ++r) { const int orow = crow(r, hi);
            float s = (o[0][r] + o[1][r]) + (o[2][r] + o[3][r]);
#pragma unroll
            for (int x = 1; x < 32; x <<= 1) s += __shfl_xor(s, x);
            const float mean = s * (1.f / 128.f);
            float q = 0.f;
#pragma unroll
            for (int d0 = 0; d0 < 4; ++d0) { const float dlt = o[d0][r] - mean; q += dlt * dlt; }
#pragma unroll
            for (int x = 1; x < 32; x <<= 1) q += __shfl_xor(q, x);
            const float rstd = 1.f / sqrtf(q * (1.f / 128.f) + 1e-6f);
#pragma unroll
            for (int d0 = 0; d0 < 4; ++d0) { const float g = bf2f(RGw[(size_t)orow * LDO + d0 * 32 + r32]);
                const float v = (o[d0][r] - mean) * rstd * gn[d0] * g;
                const float vn = __shfl_xor(v, 1);
                if (cur.O8) { const int pk = __builtin_amdgcn_cvt_pk_fp8_f32(v, vn, 0, false); const int pk2 = __shfl_xor(pk, 2);
                    if ((r32 & 3) == 0) *(unsigned*)(cur.O8 + (size_t)(wid * QBLK + orow) * 2048 + d0 * 32 + r32) = ((unsigned)pk & 0xFFFFu) | ((unsigned)pk2 << 16); }
                else if ((r32 & 1) == 0) *(unsigned*)(Ow + (size_t)orow * LDO + d0 * 32 + r32) = cvtpk(v, vn); } }
    }
    __syncthreads();
#undef RESC
#undef KBASE
#undef POSTQK
#undef FINISH
#undef SEAM_K0
#undef HALF_STEP
}
#undef ROWK
#undef VMW
#undef VMWN
#undef SLOAD_H
#undef SWRITE_HK
#undef SWRITE_HV
#undef SWRITE_H
#undef SBAR
#undef KSWZ
#undef ATT_PK4
}
#define GAS __attribute__((address_space(1)))
#define LAS __attribute__((address_space(3)))
typedef unsigned short bf16;
typedef unsigned v4u __attribute__((ext_vector_type(4)));
typedef float f32x4 __attribute__((ext_vector_type(4)));
typedef short bf16x8 __attribute__((ext_vector_type(8)));
typedef GAS unsigned gu32;
typedef GAS unsigned long long gu64;
#define RLX_AGENT __ATOMIC_RELAXED, __HIP_MEMORY_SCOPE_AGENT
#define LDS_WAIT() asm volatile("s_waitcnt lgkmcnt(0)" ::: "memory")
#define VM_WAIT() asm volatile("s_waitcnt vmcnt(0)" ::: "memory")
__device__ __forceinline__ unsigned long long rt() { return __builtin_amdgcn_s_memrealtime(); }
__device__ __forceinline__ unsigned f2bf(float f) { unsigned u = __builtin_bit_cast(unsigned, f); return (u + 0x7fffu + ((u >> 16) & 1u)) >> 16; }
__device__ __forceinline__ unsigned pk2(float lo, float hi) { return f2bf(lo) | (f2bf(hi) << 16); }

#define XB_TMO      128
#define XB_XCNT(j)  (256  + 64 * (j))
#define XB_XSUB(j)  (1280 + 64 * (j))
#define XB_XGEN(j)  (2304 + 64 * (j))
#define XB_TOP      3328
#define XB_TOPGEN   3392
#define XCD_BAR_WORDS 3456
#define XB_SPIN_CAP (1u << 18)

__device__ __forceinline__ unsigned xb_ld(unsigned* p)              { return __hip_atomic_load(p, __ATOMIC_RELAXED, __HIP_MEMORY_SCOPE_AGENT); }
__device__ __forceinline__ unsigned xb_add(unsigned* p, unsigned v) { return __hip_atomic_fetch_add(p, v, __ATOMIC_RELAXED, __HIP_MEMORY_SCOPE_AGENT); }
__device__ __forceinline__ unsigned xb_xcc_id() { return (unsigned)__builtin_amdgcn_s_getreg((3 << 11) | 20) & 0xFu; }
#define XB_SPIN(cond, bar) do { unsigned _sp = 0; while (cond) { __builtin_amdgcn_s_sleep(1); \
    if ((++_sp & 255u) == 0u) { if (xb_ld(&(bar)[XB_TMO])) break; if (_sp > XB_SPIN_CAP) { atomicAdd(&(bar)[XB_TMO], 1u); break; } } } } while (0)

struct XcdBarrier {
    unsigned* bar; unsigned x;
    volatile LAS unsigned* st;
};

__device__ __forceinline__ XcdBarrier xcd_barrier_post(unsigned* bar, volatile LAS unsigned* st) {
    XcdBarrier b; b.bar = bar; b.x = xb_xcc_id(); b.st = st;
    if (threadIdx.x == 0) (void)xb_add(&bar[XB_XCNT(b.x)], 1u);
    return b;
}
__device__ __forceinline__ void xcd_barrier_complete(unsigned* bar, unsigned x, unsigned& nloc, unsigned& nx) {
    const unsigned G = gridDim.x * gridDim.y * gridDim.z;
    unsigned sum, cnt, mine, sp = 0u;
    for (;;) {
        sum = 0u; cnt = 0u; mine = 0u;
#pragma unroll
        for (unsigned j = 0; j < 16; ++j) { const unsigned c = xb_ld(&bar[XB_XCNT(j)]); sum += c; cnt += (c > 0u) ? 1u : 0u; mine = (j == x) ? c : mine; }
        if (sum == G) break;
        __builtin_amdgcn_s_sleep(1);
        if ((++sp & 255u) == 0u) { if (xb_ld(&bar[XB_TMO])) break; if (sp > XB_SPIN_CAP) { atomicAdd(&bar[XB_TMO], 1u); break; } }
    }
    nloc = mine > 0u ? mine : 1u; nx = cnt > 0u ? cnt : 1u;
}

__device__ __forceinline__ void xcd_barrier(const XcdBarrier& b) {
    asm volatile("s_waitcnt vmcnt(0)" ::: "memory");
    __syncthreads();
    if (threadIdx.x == 0) {
        unsigned* bar = b.bar;
        __builtin_amdgcn_s_waitcnt(0);
        unsigned nloc = b.st[0], nx = b.st[1];
        if (nloc == 0u) { xcd_barrier_complete(bar, b.x, nloc, nx); b.st[0] = nloc; b.st[1] = nx; }
        const unsigned old = xb_add(&bar[XB_XSUB(b.x)], 1u);
        const unsigned gen = old / nloc;
        if (old + 1u == (gen + 1u) * nloc) {
            __builtin_amdgcn_fence(__ATOMIC_RELEASE, "agent");
            asm volatile("s_waitcnt vmcnt(0)" ::: "memory");
            const unsigned og = xb_add(&bar[XB_TOP], 1u);
            const unsigned tg = og / nx;
            if (og + 1u == (tg + 1u) * nx) xb_add(&bar[XB_TOPGEN], 1u);
            else XB_SPIN(xb_ld(&bar[XB_TOPGEN]) == tg, bar);
            __builtin_amdgcn_fence(__ATOMIC_ACQUIRE, "agent");
            xb_add(&bar[XB_XGEN(b.x)], 1u);
            asm volatile("s_waitcnt vmcnt(0)" ::: "memory");
        } else {
            XB_SPIN(xb_ld(&bar[XB_XGEN(b.x)]) == gen, bar);
            __builtin_amdgcn_fence(__ATOMIC_ACQUIRE, "agent");
            asm volatile("s_waitcnt vmcnt(0)" ::: "memory");
        }
    }
    __syncthreads();
}
constexpr int NWAVES = 8;
constexpr int M_TOK = 16384, DM = 2048, SEQ = 2048, NB = 8;
constexpr int PP = 11264;
constexpr int C_RQ = 0, C_RK = 1024, C_FQ = 2048, C_FK = 3072, C_FV = 4096, C_RV = 5120, C_RG = 6144, C_G0 = 7168, C_G1 = 9216;
constexpr int N_QK = 2048, N_REST = 9216;
#ifndef FP8_UP_OUT
#define FP8_UP_OUT 1
#endif
constexpr int W8_SCALE_B = 0x79797979;
constexpr int N_IN_ORIG = 11272;
constexpr float RMS_EPS = 1e-6f;
constexpr float QK_C2 = 0.08838834764831845f * 1.4426950408889634f;
constexpr size_t MiB = 1u << 20;
constexpr size_t DO_XN8 = 0, DO_OCAT8 = 32 * MiB;
constexpr size_t DO_OFOX8 = DO_OCAT8, DO_ORET8 = DO_OCAT8 + 1024;
constexpr size_t WS_CTL = 0, CTL_ZERO_BYTES = 1 * MiB;
constexpr size_t WS_ROWSS1 = 256 * 1024, WS_ROWSS2 = 512 * 1024;
constexpr size_t WS_WIN = 1 * MiB, WS_WFOX = 45 * MiB, WS_WRET = 49 * MiB, WS_WOUT = 53 * MiB, WS_WMQ = 61 * MiB, WS_WMKV = 63 * MiB, WS_WMO = 67 * MiB, WS_WPQ = 69 * MiB, WS_SUBK = 77 * MiB;
constexpr size_t WS_PSCALE = 79 * MiB;
constexpr size_t WS_LOGF = 78 * MiB, WS_CUMF = 78 * MiB + 512 * 1024;
constexpr size_t WS_XN = 80 * MiB;
constexpr size_t WS_PROJ = 144 * MiB;
constexpr size_t WS_MN = 496 * MiB, WS_KVM = 504 * MiB, WS_END = 508 * MiB;
constexpr size_t WS_XB1B = 144 * MiB;
constexpr size_t WS_XB2 = FP8_UP_OUT ? WS_XB1B : WS_XN;
constexpr size_t WS_XB1 = FP8_UP_OUT ? WS_XN   : WS_XB1B, WS_QM = 208 * MiB, WS_OMEM = 224 * MiB, WS_PU = 240 * MiB, WS_PV = 304 * MiB, WS_QP = (FP8_UP_OUT ? 368 : 144) * MiB  , WS_IDX = 208 * MiB, WS_GATE = 216 * MiB;
constexpr int CW_BAR = 4096, CW_CONV = 64;
constexpr int RING_BYTES = 131072, LDS_BYTES = 147456, LDSCTL_OFF = LDS_BYTES - 1024, MISC_OFF = LDSCTL_OFF + 320;
static_assert(att::LDS_BYTES <= LDSCTL_OFF, "attention LDS");

struct Args { const float* in[23]; float* out; unsigned char* ws; int ph_lo, ph_hi; int p0_mask, pad; };
enum { I_X = 0, I_MEM, I_LN_MIX, I_W_IN, I_B_FORGET, I_FOXQ_G, I_FOXK_G, I_RET_G, I_W_FOXUP, I_W_RETUP, I_W_OUT, I_LN_MEM, I_MEMNORM_G, I_W_MQ, I_W_MKV, I_MEMQ_G, I_MEMK_G, I_W_MO, I_LN_FFN, I_W_PQ, I_SUBK, I_PEER_U, I_PEER_V };

__device__ __forceinline__ float wave_sum(float v) {
#pragma unroll
    for (int o = 1; o < 64; o <<= 1) v += __shfl_xor(v, o);
    return v;
}
__device__ __forceinline__ void transpose_item(const float* W, int ldw, int K, int src_col0, const float* kgain, bf16* WT, int dst_row0, LAS float* scr, int kb, int nb, int lane) {
    const int k0 = 64 * kb, n0 = 32 * nb;
    f32x4 ld[8];
#pragma unroll
    for (int i = 0; i < 8; ++i) ld[i] = *(const GAS f32x4*)(W + (size_t)(k0 + 8 * i + (lane >> 3)) * ldw + src_col0 + n0 + 4 * (lane & 7));
#pragma unroll
    for (int i = 0; i < 8; ++i) { const int kk = 8 * i + (lane >> 3); f32x4 v = ld[i]; if (kgain) v = v * kgain[k0 + kk]; LAS float* d = scr + kk * 33 + 4 * (lane & 7); d[0] = v.x; d[1] = v.y; d[2] = v.z; d[3] = v.w; }
    LDS_WAIT(); asm volatile("" ::: "memory");
    const int c = lane & 7;
#pragma unroll
    for (int j = 0; j < 4; ++j) { const int n = (lane >> 3) + 8 * j; const LAS float* s = scr + (8 * c) * 33 + n;
        v4u o; o.x = pk2(s[0 * 33], s[1 * 33]); o.y = pk2(s[2 * 33], s[3 * 33]); o.z = pk2(s[4 * 33], s[5 * 33]); o.w = pk2(s[6 * 33], s[7 * 33]);
        *(GAS v4u*)(WT + (size_t)(dst_row0 + n0 + n) * K + k0 + 8 * c) = o; }
    LDS_WAIT(); asm volatile("" ::: "memory");
}
__device__ __forceinline__ void transpose_item8(const float* W, int ldw, int K  , int src_col0, unsigned char* WT8  , int kb, int nb, LAS float* scr, int lane) {
    const int k0 = 64 * kb, n0 = 32 * nb;
    f32x4 ld[8];
#pragma unroll
    for (int i = 0; i < 8; ++i) ld[i] = *(const GAS f32x4*)(W + (size_t)(k0 + 8 * i + (lane >> 3)) * ldw + src_col0 + n0 + 4 * (lane & 7));
#pragma unroll
    for (int i = 0; i < 8; ++i) { const int kk = 8 * i + (lane >> 3); const f32x4 v = ld[i] * 64.f; LAS float* d = scr + kk * 33 + 4 * (lane & 7); d[0] = v.x; d[1] = v.y; d[2] = v.z; d[3] = v.w; }
    LDS_WAIT(); asm volatile("" ::: "memory");
    const int c = lane & 7;
#pragma unroll
    for (int j = 0; j < 4; ++j) { const int n = (lane >> 3) + 8 * j; const LAS float* s = scr + (8 * c) * 33 + n;
        int p0 = 0, p1 = 0; p0 = __builtin_amdgcn_cvt_pk_fp8_f32(s[0 * 33], s[1 * 33], p0, false); p0 = __builtin_amdgcn_cvt_pk_fp8_f32(s[2 * 33], s[3 * 33], p0, true);
        p1 = __builtin_amdgcn_cvt_pk_fp8_f32(s[4 * 33], s[5 * 33], p1, false); p1 = __builtin_amdgcn_cvt_pk_fp8_f32(s[6 * 33], s[7 * 33], p1, true);
        *(GAS unsigned long long*)(WT8 + (size_t)(n0 + n) * K + k0 + 8 * c) = (unsigned long long)(unsigned)p0 | ((unsigned long long)(unsigned)p1 << 32); }
    LDS_WAIT(); asm volatile("" ::: "memory");
}
struct TJob { const float* W; int ldw, K, N; const float* gain; bf16* WT; int fp8; };

__device__ __forceinline__ void rms_row_to_bf16(const float* xrow, const float* gain, bf16* orow, int lane, f32x4 (&hv)[8], unsigned char* orow8 = nullptr) {
    const GAS f32x4* xr = (const GAS f32x4*)xrow + lane; float s = 0.f;
#pragma unroll
    for (int j = 0; j < 8; ++j) { hv[j] = xr[64 * j]; s += (hv[j].x * hv[j].x + hv[j].y * hv[j].y) + (hv[j].z * hv[j].z + hv[j].w * hv[j].w); }
    const float r = 1.f / sqrtf(wave_sum(s) * (1.f / DM) + RMS_EPS);
    GAS unsigned long long* o8 = (GAS unsigned long long*)orow + lane;
#pragma unroll
    for (int j = 0; j < 8; ++j) { const f32x4 g = ((const GAS f32x4*)gain)[lane + 64 * j]; hv[j] = hv[j] * r * g;
        o8[64 * j] = (unsigned long long)pk2(hv[j].x, hv[j].y) | ((unsigned long long)pk2(hv[j].z, hv[j].w) << 32);
        if (orow8) { int p = 0; p = __builtin_amdgcn_cvt_pk_fp8_f32(hv[j].x, hv[j].y, p, false); p = __builtin_amdgcn_cvt_pk_fp8_f32(hv[j].z, hv[j].w, p, true); ((GAS unsigned*)orow8)[lane + 64 * j] = (unsigned)p; } }
}
__device__ __forceinline__ float log_sigmoid_f(float z) { return fminf(z, 0.f) - log1pf(expf(-fabsf(z))); }

struct Frame { LAS unsigned char* lds; unsigned char* ldsg; int tid, lane, wave, G, bx, p0_mask; const float* const* in; float* out; unsigned char* ws; };

__device__ __forceinline__ void p0_prologue(Frame& F) {
    const int gw = F.bx * NWAVES + F.wave, NGW = F.G * NWAVES;
    if (F.p0_mask & 1) {
        LAS float* scr = (LAS float*)(F.lds + F.wave * 16384);
        const TJob jobs[9] = {
            {F.in[I_W_IN], N_IN_ORIG, 2048, N_QK, nullptr, (bf16*)(F.ws + WS_WIN), 0},
            {F.in[I_W_IN], N_IN_ORIG, 2048, N_REST, nullptr, (bf16*)(F.ws + WS_WIN + 16 * MiB), 1},
            {F.in[I_W_FOXUP], 2048, 1024, 2048, nullptr, (bf16*)(F.ws + WS_WFOX), FP8_UP_OUT},
            {F.in[I_W_RETUP], 2048, 1024, 2048, nullptr, (bf16*)(F.ws + (FP8_UP_OUT ? WS_WFOX + 1024 : WS_WRET)), FP8_UP_OUT},
            {F.in[I_W_OUT], 2048, 2048, 2048, nullptr, (bf16*)(F.ws + WS_WOUT), FP8_UP_OUT},
            {F.in[I_W_MQ], 512, 2048, 512, F.in[I_LN_MEM], (bf16*)(F.ws + WS_WMQ), 0},
            {F.in[I_W_MKV], 1024, 2048, 1024, nullptr, (bf16*)(F.ws + WS_WMKV), 0},
            {F.in[I_W_MO], 2048, 512, 2048, nullptr, (bf16*)(F.ws + WS_WMO), 1},
            {F.in[I_W_PQ], 2048, 2048, 2048, F.in[I_LN_FFN], (bf16*)(F.ws + WS_WPQ), 0} };
        int base = 0;
#pragma unroll
        for (int j = 0; j < 9; ++j) {
            const TJob& J = jobs[j]; const int nblk = J.N / 32, items = (J.K / 64) * nblk;
            int first = gw - (base % NGW); if (first < 0) first += NGW;
            for (int r = first; r < items; r += NGW) { const int kb = r / nblk, nb = r % nblk;
                int src_col0 = 0;
                if (j == 0) src_col0 = 3080;
                if (j == 1) src_col0 = (nb * 32 < 3072) ? 0 : 2056;
                if (J.fp8) transpose_item8(J.W, J.ldw, (FP8_UP_OUT && (j == 2 || j == 3)) ? 2048 : J.K, src_col0, (unsigned char*)J.WT, kb, nb, scr, F.lane);
                else transpose_item(J.W, J.ldw, J.K, src_col0, J.gain, J.WT, 0, scr, kb, nb, F.lane); }
            base += items;
        }
    }
    if (F.p0_mask & 1) {
        const float* sk = F.in[I_SUBK]; bf16* o = (bf16*)(F.ws + WS_SUBK);
        for (int i = (F.bx * 512 + F.tid) * 4; i < 16 * 128 * 128; i += F.G * 512 * 4) { const f32x4 v = *(const GAS f32x4*)(sk + i);
            *(GAS unsigned long long*)(o + i) = (unsigned long long)pk2(v.x, v.y) | ((unsigned long long)pk2(v.z, v.w) << 32); }
    }
    __syncthreads();
    if (F.p0_mask & 2) {
        LAS float* wf = (LAS float*)F.lds; const float* w = F.in[I_W_IN];
        for (int k = F.tid; k < 2048; k += 512) { const f32x4 a = *(const GAS f32x4*)(w + (size_t)k * N_IN_ORIG + 3072), b = *(const GAS f32x4*)(w + (size_t)k * N_IN_ORIG + 3076);
            wf[0 * 2048 + k] = a.x; wf[1 * 2048 + k] = a.y; wf[2 * 2048 + k] = a.z; wf[3 * 2048 + k] = a.w; wf[4 * 2048 + k] = b.x; wf[5 * 2048 + k] = b.y; wf[6 * 2048 + k] = b.z; wf[7 * 2048 + k] = b.w; }
    }
    __syncthreads();
    if (F.p0_mask & 2) {
        const LAS float* wf = (const LAS float*)F.lds; const float* bfg = F.in[I_B_FORGET]; float* logf_o = (float*)(F.ws + WS_LOGF);
        for (int m = gw; m < M_TOK; m += NGW) { f32x4 hv[8];
            rms_row_to_bf16(F.in[I_X] + (size_t)m * DM, F.in[I_LN_MIX], (bf16*)(F.ws + WS_XN) + (size_t)m * DM, F.lane, hv, (unsigned char*)F.out + DO_XN8 + (size_t)m * DM);
            float z = 0.f;
#pragma unroll
            for (int q = 0; q < 8; ++q) { float acc = 0.f;
#pragma unroll
                for (int j = 0; j < 8; ++j) { const f32x4 wv = *(const LAS f32x4*)(wf + q * 2048 + 4 * F.lane + 256 * j); acc += (hv[j].x * wv.x + hv[j].y * wv.y) + (hv[j].z * wv.z + hv[j].w * wv.w); }
                acc = wave_sum(acc); z = (F.lane == q) ? acc : z;
                __builtin_amdgcn_sched_barrier(0); }
            if (F.lane < 8) logf_o[(size_t)m * 8 + F.lane] = log_sigmoid_f(z + bfg[F.lane]);
        }
        for (int m = gw; m < NB * 256; m += NGW) { f32x4 hv[8]; rms_row_to_bf16(F.in[I_MEM] + (size_t)m * DM, F.in[I_MEMNORM_G], (bf16*)(F.ws + WS_MN) + (size_t)m * DM, F.lane, hv); }
    }
}
__device__ __forceinline__ void p1_scan(Frame& F) {
    if (F.bx < 64) {
        const int b = F.bx >> 3, h = F.bx & 7; const float* lf = (const float*)(F.ws + WS_LOGF); float* cf = (float*)(F.ws + WS_CUMF) + (size_t)F.bx * SEQ;
        float v[4]; float run = 0.f;
#pragma unroll
        for (int i = 0; i < 4; ++i) { run += lf[(size_t)(b * SEQ + F.tid * 4 + i) * 8 + h]; v[i] = run; }
        float incl = run;
#pragma unroll
        for (int o = 1; o < 64; o <<= 1) { const float t = __shfl_up(incl, o); if (F.lane >= o) incl += t; }
        LAS float* wt = (LAS float*)F.lds;
        if (F.lane == 63) wt[F.wave] = incl;
        __syncthreads();
        float off = incl - run;
        for (int w = 0; w < F.wave; ++w) off += wt[w];
#pragma unroll
        for (int i = 0; i < 4; ++i) cf[F.tid * 4 + i] = v[i] + off;
    }
    __syncthreads();
}
__device__ __forceinline__ void unpack8s(const att::bf16x8 v, float (&f)[8]) {
#pragma unroll
    for (int i = 0; i < 8; ++i) f[i] = __uint_as_float((unsigned)(unsigned short)v[i] << 16);
}
__device__ __forceinline__ att::bf16x8 pack8s(const float (&f)[8]) { v4u w; w.x = pg8::cvt_pk_bf16(f[0], f[1]); w.y = pg8::cvt_pk_bf16(f[2], f[3]); w.z = pg8::cvt_pk_bf16(f[4], f[5]); w.w = pg8::cvt_pk_bf16(f[6], f[7]); return __builtin_bit_cast(att::bf16x8, w); }
__device__ __forceinline__ void p4_attention(Frame& F) {
    char* lds = (char*)F.ldsg;
    const int xcd = F.bx & 7, kk = F.bx >> 3;
    const int bh = (kk >> 2) * 8 + xcd, x = kk & 3, b = bh >> 3, h = bh & 7;
    if (bh >= 64) return;
    const att::bf16* proj = (const att::bf16*)(F.ws + WS_PROJ);
    const size_t rowb = (size_t)b * SEQ;
    if (F.p0_mask & 1) {
        float* tbl = (float*)(lds + att::LDS_BIAS); const float* cf = (const float*)(F.ws + WS_CUMF) + (size_t)bh * SEQ;
        const f32x4 v = *(const f32x4*)(cf + F.tid * 4); *(f32x4*)(tbl + F.tid * 4) = v * (-1.4426950408889634f);
        att::BlockRef r0, r1;
        r0.Q = proj + (rowb + (size_t)x * 256) * PP + C_FQ + h * 128; r0.K = proj + rowb * PP + C_FK + h * 128; r0.V = proj + rowb * PP + C_FV + h * 128; r0.O = (att::bf16*)r0.Q;
        r0.P0 = x * 256; r0.skv = SEQ; r0.lg = 0.f; r0.RG = nullptr; r0.GN = nullptr; r0.O8 = FP8_UP_OUT ? (unsigned char*)F.out + DO_OFOX8 + (rowb + (size_t)x * 256) * 2048 + h * 128 : nullptr;
        r1 = r0; r1.Q = proj + (rowb + (size_t)(7 - x) * 256) * PP + C_FQ + h * 128; r1.O = (att::bf16*)r1.Q; r1.P0 = (7 - x) * 256; r1.O8 = FP8_UP_OUT ? (unsigned char*)F.out + DO_OFOX8 + (rowb + (size_t)(7 - x) * 256) * 2048 + h * 128 : nullptr;
        att::Seam S;
        att::attn_prime<0>(r0, lds, S);
        att::attn_block<0>(r0, r1, lds, S);
        att::attn_block<0>(r1, r1, lds, S);
    }
    if (F.p0_mask & 2) {
        att::BlockRef r0, r1;
        r0.Q = proj + (rowb + (size_t)x * 256) * PP + C_RQ + h * 128; r0.K = proj + rowb * PP + C_RK + h * 128; r0.V = proj + rowb * PP + C_RV + h * 128; r0.O = (att::bf16*)r0.Q;
        r0.P0 = x * 256; r0.skv = SEQ; r0.lg = __builtin_amdgcn_logf(1.f - __builtin_amdgcn_exp2f(-5.f - (float)h))    ; r0.RG = proj + (rowb + (size_t)x * 256) * PP + C_RG + h * 128; r0.GN = F.in[I_RET_G] + h * 128; r0.O8 = FP8_UP_OUT ? (unsigned char*)F.out + DO_ORET8 + (rowb + (size_t)x * 256) * 2048 + h * 128 : nullptr;
        r1 = r0; r1.O8 = FP8_UP_OUT ? (unsigned char*)F.out + DO_ORET8 + (rowb + (size_t)(7 - x) * 256) * 2048 + h * 128 : nullptr; r1.Q = proj + (rowb + (size_t)(7 - x) * 256) * PP + C_RQ + h * 128; r1.O = (att::bf16*)r1.Q; r1.P0 = (7 - x) * 256; r1.RG = proj + (rowb + (size_t)(7 - x) * 256) * PP + C_RG + h * 128;
        att::Seam S;
        att::attn_prime<1>(r0, lds, S);
        att::attn_block<1>(r0, r1, lds, S);
        att::attn_block<1>(r1, r1, lds, S);
    }
}


__device__ __forceinline__ void p8_convert_peer(Frame& F) {
    const int lane = F.lane;
    f32x4 g[8];
#pragma unroll
    for (int j = 0; j < 8; ++j) g[j] = ((const GAS f32x4*)F.in[I_LN_FFN])[lane + 64 * j];
    float* scl = (float*)(F.ws + WS_PSCALE);
    int r0, rend, rstride;
    if (F.bx >= 160) { r0 = (F.bx - 160) * NWAVES + F.wave; rend = 22272; rstride = 768; } else { r0 = 22272 + F.bx * NWAVES + F.wave; rend = 32768; rstride = 1280; }
#pragma unroll 1
    for (int rr = r0; rr < rend; rr += 2 * rstride) {
        f32x4 v[2][8]; float amax[2] = {0.f, 0.f}; bool ok[2], isu[2]; int ri[2];
#pragma unroll
        for (int q = 0; q < 2; ++q) { const int r = rr + q * rstride; ok[q] = r < rend; const int rc = ok[q] ? r : rr; isu[q] = rc < 16384; ri[q] = rc;
            const float* src = (isu[q] ? F.in[I_PEER_U] : F.in[I_PEER_V]) + (size_t)(rc & 16383) * DM;
#pragma unroll
            for (int j = 0; j < 8; ++j) v[q][j] = ((const GAS f32x4*)src)[lane + 64 * j]; }
#pragma unroll
        for (int q = 0; q < 2; ++q) {
#pragma unroll
            for (int j = 0; j < 8; ++j) { if (isu[q]) v[q][j] = v[q][j] * g[j]; amax[q] = fmaxf(amax[q], fmaxf(fmaxf(fabsf(v[q][j].x), fabsf(v[q][j].y)), fmaxf(fabsf(v[q][j].z), fabsf(v[q][j].w)))); }
#pragma unroll
            for (int o = 1; o < 64; o <<= 1) amax[q] = fmaxf(amax[q], __shfl_xor(amax[q], o));
            const float sc = amax[q] > 0.f ? amax[q] * (1.f / 448.f) : 1.f, inv = 1.f / sc;
            if (ok[q]) { if (lane == 0) scl[ri[q]] = sc;
                GAS unsigned* o4 = (GAS unsigned*)(F.ws + (isu[q] ? WS_PU : WS_PV) + (size_t)(ri[q] & 16383) * DM) + lane;
#pragma unroll
                for (int j = 0; j < 8; ++j) { int p = 0; p = __builtin_amdgcn_cvt_pk_fp8_f32(v[q][j].x * inv, v[q][j].y * inv, p, false); p = __builtin_amdgcn_cvt_pk_fp8_f32(v[q][j].z * inv, v[q][j].w * inv, p, true); o4[64 * j] = (unsigned)p; } } }
    }
}
__device__ __forceinline__ void norm_own_tile(Frame& F, bf16* base, int ld, int row0, int col0, const float* gain, float mul) {
    asm volatile("s_waitcnt vmcnt(0)" ::: "memory"); __syncthreads();
    const int lane = F.lane, rsel = lane >> 5, head = (lane >> 4) & 1, sub = lane & 15;
    float gv[8];
#pragma unroll
    for (int i = 0; i < 8; ++i) gv[i] = gain[sub * 8 + i] * mul;
#pragma unroll 1
    for (int r4 = 0; r4 < 16; r4 += 4) {
        att::bf16x8 v[4]; bf16* p[4];
#pragma unroll
        for (int q = 0; q < 4; ++q) { p[q] = base + (size_t)(row0 + F.wave * 32 + (r4 + q) * 2 + rsel) * ld + col0 + head * 128 + sub * 8; v[q] = *(const att::bf16x8*)p[q]; }
#pragma unroll
        for (int q = 0; q < 4; ++q) { float a[8]; unpack8s(v[q], a); float s = 0.f;
#pragma unroll
            for (int i = 0; i < 8; ++i) s += a[i] * a[i];
            s += __shfl_xor(s, 1); s += __shfl_xor(s, 2); s += __shfl_xor(s, 4); s += __shfl_xor(s, 8);
            const float rr = 1.f / sqrtf(s * (1.f / 128.f) + RMS_EPS);
#pragma unroll
            for (int i = 0; i < 8; ++i) a[i] *= rr * gv[i];
            *(att::bf16x8*)p[q] = pack8s(a); }
    }
}
__device__ __forceinline__ void fix_own_tile(Frame& F, bf16* proj, int pm, int pn, int kind) {
    const int lane = F.lane;
    if (kind < 2) {
        const int rsel = lane >> 5, head = (lane >> 4) & 1, sub = lane & 15; float gv[8];
#pragma unroll
        for (int i = 0; i < 8; ++i) gv[i] = kind == 0 ? F.in[I_FOXQ_G][sub * 8 + i] * QK_C2 : F.in[I_FOXK_G][sub * 8 + i];
#pragma unroll 1
        for (int r4 = 0; r4 < 16; r4 += 4) { att::bf16x8 v[4]; bf16* p[4];
#pragma unroll
            for (int q = 0; q < 4; ++q) { p[q] = proj + (size_t)(pm * 256 + F.wave * 32 + (r4 + q) * 2 + rsel) * PP + pn * 256 + head * 128 + sub * 8; v[q] = *(const att::bf16x8*)p[q]; }
#pragma unroll
            for (int q = 0; q < 4; ++q) { float a[8]; unpack8s(v[q], a); float s = 0.f;
#pragma unroll
                for (int i = 0; i < 8; ++i) s += a[i] * a[i];
                s += __shfl_xor(s, 1); s += __shfl_xor(s, 2); s += __shfl_xor(s, 4); s += __shfl_xor(s, 8);
                const float rr = 1.f / sqrtf(s * (1.f / 128.f) + RMS_EPS);
#pragma unroll
                for (int i = 0; i < 8; ++i) a[i] *= rr * gv[i];
                *(att::bf16x8*)p[q] = pack8s(a); } }
    } else {
        const int rsel = lane >> 4, head = (lane >> 3) & 1, sub = lane & 7; const float sc = kind == 3 ? 0.08838834764831845f : 1.f; float fr[8];
        const float lgh = __builtin_amdgcn_logf(1.f - __builtin_amdgcn_exp2f(-5.f - (float)((pn & 3) * 2 + head)));
#pragma unroll
        for (int i = 0; i < 8; ++i) fr[i] = expf(-9.210340371976184f * (float)(sub * 8 + i) * (1.f / 64.f)) * 0.15915494309189535f;
#pragma unroll 1
        for (int r4 = 0; r4 < 8; r4 += 4) { att::bf16x8 va[4], vb[4]; bf16* p[4];
#pragma unroll
            for (int q = 0; q < 4; ++q) { p[q] = proj + (size_t)(pm * 256 + F.wave * 32 + (r4 + q) * 4 + rsel) * PP + pn * 256 + head * 128 + sub * 8; va[q] = *(const att::bf16x8*)p[q]; vb[q] = *(const att::bf16x8*)(p[q] + 64); }
#pragma unroll
            for (int q = 0; q < 4; ++q) { const int rowi = pm * 256 + F.wave * 32 + (r4 + q) * 4 + rsel; const float pos = (float)(rowi & (SEQ - 1)); float a[8], b[8], oa[8], ob[8]; unpack8s(va[q], a); unpack8s(vb[q], b);
                const float dsc = sc * __builtin_amdgcn_exp2f((kind == 2 ? lgh : -lgh) * (float)(rowi & 63));
#pragma unroll
                for (int i = 0; i < 8; ++i) { float rev = pos * fr[i]; rev -= rintf(rev); const float sn = __builtin_amdgcn_sinf(rev), cs = __builtin_amdgcn_cosf(rev);
                    oa[i] = (a[i] * cs - b[i] * sn) * dsc; ob[i] = (a[i] * sn + b[i] * cs) * dsc; }
                *(att::bf16x8*)p[q] = pack8s(oa); *(att::bf16x8*)(p[q] + 64) = pack8s(ob); } }
    }
}
__device__ __forceinline__ void p10_mem_attention(Frame& F) {
    char* lds = (char*)F.ldsg;
    const int b = F.bx >> 5, h = (F.bx >> 3) & 3, qb = F.bx & 7;
    att::BlockRef r0;
    const size_t qoff = ((size_t)b * SEQ + (size_t)qb * 256) * 512 + h * 128;
    r0.Q = (const att::bf16*)(F.ws + WS_QM) + qoff; r0.O = (att::bf16*)(F.ws + WS_OMEM) + qoff;
    r0.K = (const att::bf16*)(F.ws + WS_KVM) + (size_t)(b * 256) * 1024 + h * 128; r0.V = r0.K + 512;
    r0.P0 = 1 << 20; r0.skv = 256; r0.lg = 0.f; r0.RG = nullptr; r0.GN = nullptr; r0.O8 = F.ws + WS_OMEM + ((size_t)b * SEQ + (size_t)qb * 256) * 512 + h * 128;
    att::Seam S;
    att::attn_prime<2>(r0, lds, S);
    att::attn_block<2>(r0, r0, lds, S);
}
#define TK_INS(L, v) do { _Pragma("unroll") for (int i_ = 15; i_ >= 1; --i_) L[i_] = __builtin_amdgcn_fmed3f(L[i_ - 1], L[i_], (v)); L[0] = fmaxf(L[0], (v)); } while (0)
__device__ __forceinline__ void p13_topk_unit(Frame& F, int pm, int h) {
    const int lane = F.lane, r32 = lane & 31, hi = lane >> 5, wave = F.wave;
    const att::bf16* qp = (const att::bf16*)(F.ws + WS_QP); const att::bf16* subk = (const att::bf16*)(F.ws + WS_SUBK);
    int* idx_o = (int*)(F.ws + WS_IDX); float* gate_o = (float*)(F.ws + WS_GATE);
    LAS unsigned* kb = (LAS unsigned*)(F.lds + 65536 + (wave * 32 + (lane & 31)) * 32);
    const int tok = pm * 256 + wave * 32 + r32;
    const unsigned q_lane = (unsigned)((tok * DM + hi * 8) * 2), k_lane = (unsigned)((r32 * 128 + hi * 8) * 2);
    att::bf16x8 qf[8];
#define TK_STAGE(p_) do { const int hp_ = h * 2 + (p_); const unsigned char* qb_ = (const unsigned char*)qp + (size_t)hp_ * 256; \
        const unsigned char* kb_ = (const unsigned char*)subk + (size_t)hp_ * 32768 + (size_t)(wave >> 1) * 8192 + (size_t)(wave & 1) * 128; \
        _Pragma("unroll") for (int d0 = 0; d0 < 8; ++d0) qf[d0] = *(const GAS att::bf16x8*)(qb_ + d0 * 32 + q_lane); \
        _Pragma("unroll") for (int f_ = 0; f_ < 4; ++f_) \
            __builtin_amdgcn_global_load_lds((const GAS unsigned*)(kb_ + f_ * 32 + k_lane), (LAS unsigned*)(F.lds + (p_) * 32768 + (wave * 4 + f_) * 1024), 16, 0, 0); } while (0)
    float L0[16], L1[16];
#pragma unroll
    for (int i = 0; i < 16; ++i) { L0[i] = 0.f; L1[i] = 0.f; }
    TK_STAGE(0);
#pragma unroll 1
    for (int p = 0; p < 2; ++p) {
        asm volatile("s_waitcnt vmcnt(0)" ::: "memory"); __syncthreads();
        att::f32x16 acc[4];
        const LAS unsigned char* img = F.lds + p * 32768;
#pragma unroll
        for (int kt = 0; kt < 4; ++kt) { acc[kt] = att::f32x16{};
#pragma unroll
            for (int d0 = 0; d0 < 8; ++d0) acc[kt] = __builtin_amdgcn_mfma_f32_32x32x16_bf16(*(const LAS att::bf16x8*)(img + (kt * 8 + d0) * 1024 + lane * 16), qf[d0], acc[kt], 0, 0, 0); }
        if (p == 0) TK_STAGE(1);
        float L[16];
#pragma unroll
        for (int i = 0; i < 16; ++i) L[i] = -3.0e38f;
#pragma unroll
        for (int kt = 0; kt < 4; ++kt)
#pragma unroll
            for (int r = 0; r < 16; ++r) { const unsigned key = (unsigned)(kt * 32 + (r & 3) + 8 * (r >> 2)) + 4u * (unsigned)hi;
                const float v = __uint_as_float((__float_as_uint(acc[kt][r]) & ~0x7Fu) | key); TK_INS(L, v); }
        float P[16];
#pragma unroll
        for (int i = 0; i < 16; ++i) P[i] = __shfl_xor(L[i], 32);
#pragma unroll
        for (int i = 0; i < 16; ++i) TK_INS(L, P[i]);
#pragma unroll
        for (int i = 0; i < 16; ++i) { L0[i] = p == 0 ? L[i] : L0[i]; L1[i] = p == 0 ? L1[i] : L[i]; }
    }
#undef TK_STAGE
#pragma unroll
        for (int w = 0; w < 4; ++w) {
            kb[w] = (__float_as_uint(L0[4 * w]) & 0x7Fu) | ((__float_as_uint(L0[4 * w + 1]) & 0x7Fu) << 8) | ((__float_as_uint(L0[4 * w + 2]) & 0x7Fu) << 16) | ((__float_as_uint(L0[4 * w + 3]) & 0x7Fu) << 24);
            kb[4 + w] = (__float_as_uint(L1[4 * w]) & 0x7Fu) | ((__float_as_uint(L1[4 * w + 1]) & 0x7Fu) << 8) | ((__float_as_uint(L1[4 * w + 2]) & 0x7Fu) << 16) | ((__float_as_uint(L1[4 * w + 3]) & 0x7Fu) << 24); }
        float T[16];
#pragma unroll
        for (int i = 0; i < 16; ++i) T[i] = -3.0e38f;
#pragma unroll
        for (int a = 0; a < 16; ++a) { const float sa = __uint_as_float(__float_as_uint(L0[a]) & ~0x7Fu);
#pragma unroll
            for (int b2 = 0; b2 < 16; ++b2) if ((a + 1) * (b2 + 1) <= 16) { const float s = sa + __uint_as_float(__float_as_uint(L1[b2]) & ~0x7Fu);
                const float v = __uint_as_float((__float_as_uint(s) & ~0xFFu) | (unsigned)(a * 16 + b2)); TK_INS(T, v); } }
        LDS_WAIT();
        const LAS unsigned char* kbb = (const LAS unsigned char*)kb;
        float sc[16]; int ei[16]; float mx = __uint_as_float(__float_as_uint(T[0]) & ~0xFFu), sum = 0.f;
#pragma unroll
        for (int k = 0; k < 16; ++k) { const unsigned bits = __float_as_uint(T[k]); const unsigned id = bits & 0xFFu;
            const int i1 = kbb[id >> 4], i2 = kbb[16 + (id & 15u)]; ei[k] = i1 * 128 + i2;
            sc[k] = __builtin_amdgcn_exp2f((__uint_as_float(bits & ~0xFFu) - mx) * 1.4426950408889634f); sum += sc[k]; }
        const float inv = 1.f / sum;
        if (hi == 0) {
#pragma unroll
            for (int w = 0; w < 4; ++w) {
                *(GAS v4u*)(idx_o + (size_t)tok * 128 + h * 16 + 4 * w) = (v4u){(unsigned)ei[4 * w], (unsigned)ei[4 * w + 1], (unsigned)ei[4 * w + 2], (unsigned)ei[4 * w + 3]};
                *(GAS f32x4*)(gate_o + (size_t)tok * 128 + h * 16 + 4 * w) = (f32x4){sc[4 * w] * inv, sc[4 * w + 1] * inv, sc[4 * w + 2] * inv, sc[4 * w + 3] * inv}; } }
        LDS_WAIT(); asm volatile("" ::: "memory");
}


typedef float f32x2 __attribute__((ext_vector_type(2)));
__device__ __forceinline__ float gelu_tanh(float x) {
    const float y = 0.7978845608028654f * (x + 0.044715f * x * x * x);
    const float t = 1.f - 2.f * __builtin_amdgcn_rcpf(1.f + __builtin_amdgcn_exp2f(2.885390081777927f * y));
    return 0.5f * x * (1.f + t);
}
__device__ __forceinline__ float dot2bf(unsigned a, unsigned b, float acc) { asm("v_dot2c_f32_bf16 %0, %1, %2" : "+v"(acc) : "v"(a), "v"(b)); return acc; }
#ifndef EX_QCH
#define EX_QCH 2
#endif
struct RowBuf { v4u r[8]; float su, sv; };
#define DPP_MOV(v, ctrl) __builtin_bit_cast(float, __builtin_amdgcn_update_dpp(0, __builtin_bit_cast(int, (v)), (ctrl), 0xF, 0xF, false))
#define ROW_ROR(v, n) __builtin_bit_cast(float, __builtin_amdgcn_update_dpp(0, __builtin_bit_cast(int, (v)), 0x120 + (n), 0xF, 0xF, false))
__device__ __forceinline__ void p14_experts_sorted(Frame& F) {
    const int lane = F.lane, wave = F.wave, q = lane >> 4, l16 = lane & 15;
    const bf16* xb = (const bf16*)(F.ws + WS_XB2); const unsigned char* pu = F.ws + WS_PU; const unsigned char* pv = F.ws + WS_PV;
    const int* idx = (const int*)(F.ws + WS_IDX); const float* gate = (const float*)(F.ws + WS_GATE); const float* rowss = (const float*)(F.ws + WS_ROWSS2);
    const float* su = (const float*)(F.ws + WS_PSCALE); const float* sv = su + 16384;
    LAS unsigned* list = (LAS unsigned*)(F.lds + wave * 8192) + q * 128;
    LAS float* wl = (LAS float*)(F.lds + wave * 8192 + 2048) + q * 128;
    LAS float* gt = (LAS float*)(F.lds + wave * 8192 + 4096) + q * 128;
    LAS unsigned* cnt = (LAS unsigned*)(F.lds + wave * 8192 + 6144) + q * 32;
    constexpr int NSTEP = 128;
    for (int grp = 0; grp < 2; ++grp) {
        const int tok = (F.bx * NWAVES + wave) * 8 + grp * 4 + q;
        const float rs = 1.f / sqrtf(rowss[tok] * (1.f / DM) + RMS_EPS);
        cnt[l16] = 0u; cnt[16 + l16] = 0u;
        unsigned ent[8], pos[8];
#pragma unroll
        for (int j = 0; j < 8; ++j) { const int k = l16 + 16 * j; const unsigned e = (unsigned)idx[(size_t)tok * 128 + k]; gt[k] = gate[(size_t)tok * 128 + k]; ent[j] = e | ((unsigned)k << 16); }
        LDS_WAIT(); asm volatile("" ::: "memory");
#pragma unroll
        for (int j = 0; j < 8; ++j) pos[j] = __hip_atomic_fetch_add(cnt + ((ent[j] & 0x3FFFu) >> 9), 1u, __ATOMIC_RELAXED, __HIP_MEMORY_SCOPE_WORKGROUP);
        LDS_WAIT(); asm volatile("" ::: "memory");
        { const unsigned c0 = cnt[l16], c1 = cnt[16 + l16]; unsigned i0 = c0;
#pragma unroll
          for (int o = 1; o < 16; o <<= 1) { const unsigned tt = __shfl_up(i0, o, 16); if (l16 >= o) i0 += tt; }
          const unsigned tot0 = __shfl(i0, 15, 16); unsigned i1 = c1;
#pragma unroll
          for (int o = 1; o < 16; o <<= 1) { const unsigned tt = __shfl_up(i1, o, 16); if (l16 >= o) i1 += tt; }
          LDS_WAIT(); asm volatile("" ::: "memory");
          cnt[l16] = i0 - c0; cnt[16 + l16] = tot0 + i1 - c1; }
        LDS_WAIT(); asm volatile("" ::: "memory");
#pragma unroll
        for (int j = 0; j < 8; ++j) list[cnt[(ent[j] & 0x3FFFu) >> 9] + pos[j]] = ent[j];
        LDS_WAIT(); asm volatile("" ::: "memory");
        const unsigned lane_off = (unsigned)l16 * 16u;
        constexpr int QCH = EX_QCH, NSW = 8 / QCH;
#define EX_LD(B, s_, TABQ) do { const int ss_ = (s_) < NSTEP ? (s_) : NSTEP - 1; const unsigned off_ = ((list[ss_] & 0x3FFFu) << 11) + lane_off;     \
            _Pragma("unroll") for (int c_ = 0; c_ < QCH; ++c_) B[c_] = *(const GAS v4u*)((TABQ) + off_ + c_ * 256); } while (0)
#define EX_RING(TABQ, STEPFN, ENDFN) do { v4u H0[QCH], H1[QCH], H2[QCH], H3[QCH], H4[QCH], H5[QCH], H6[QCH], H7[QCH]; \
            EX_LD(H0, 0, TABQ); EX_LD(H1, 1, TABQ); EX_LD(H2, 2, TABQ); EX_LD(H3, 3, TABQ); EX_LD(H4, 4, TABQ); EX_LD(H5, 5, TABQ); EX_LD(H6, 6, TABQ); \
            _Pragma("unroll 1") for (int s = 0; s < NSTEP; s += 8) { \
                EX_LD(H7, s + 7, TABQ); STEPFN(H0, s, 0); \
                EX_LD(H0, s + 8, TABQ); STEPFN(H1, s + 1, 1); \
                EX_LD(H1, s + 9, TABQ); STEPFN(H2, s + 2, 2); \
                EX_LD(H2, s + 10, TABQ); STEPFN(H3, s + 3, 3); \
                EX_LD(H3, s + 11, TABQ); STEPFN(H4, s + 4, 4); \
                EX_LD(H4, s + 12, TABQ); STEPFN(H5, s + 5, 5); \
                EX_LD(H5, s + 13, TABQ); STEPFN(H6, s + 6, 6); \
                EX_LD(H6, s + 14, TABQ); STEPFN(H7, s + 7, 7); \
                ENDFN(s); } } while (0)
#pragma unroll 1
        for (int j = 0; j < NSW; ++j) {
            f32x2 xf[QCH][8];
#pragma unroll
            for (int c = 0; c < QCH; ++c) { const v4u a = *(const GAS v4u*)(xb + (size_t)tok * DM + j * (QCH * 256) + c * 256 + l16 * 16), b = *(const GAS v4u*)(xb + (size_t)tok * DM + j * (QCH * 256) + c * 256 + l16 * 16 + 8);
                const unsigned xd[8] = {a.x, a.y, a.z, a.w, b.x, b.y, b.z, b.w};
#pragma unroll
                for (int i = 0; i < 8; ++i) xf[c][i] = (f32x2){__uint_as_float(xd[i] << 16), __uint_as_float(xd[i] & 0xffff0000u)}; }
            const unsigned char* tabq = pu + j * (QCH * 256);
#define EX_U(B, s_, k_) do { f32x2 d2_ = {0.f, 0.f}; \
            _Pragma("unroll") for (int c_ = 0; c_ < QCH; ++c_) { const unsigned ud[4] = {B[c_].x, B[c_].y, B[c_].z, B[c_].w}; \
                _Pragma("unroll") for (int w_ = 0; w_ < 4; ++w_) { d2_ = __builtin_amdgcn_cvt_pk_f32_fp8((int)ud[w_], false) * xf[c_][2 * w_] + d2_; d2_ = __builtin_amdgcn_cvt_pk_f32_fp8((int)ud[w_], true) * xf[c_][2 * w_ + 1] + d2_; } } \
            dd[k_] = d2_.x + d2_.y; } while (0)
#define EX_UEND(s_) do { float r4_[4], r2_[2], r1_; \
            { const bool up = (l16 & 8) != 0; _Pragma("unroll") for (int i_ = 0; i_ < 4; ++i_) { const float mine = up ? dd[i_ + 4] : dd[i_], theirs = up ? dd[i_] : dd[i_ + 4]; r4_[i_] = mine + ROW_ROR(theirs, 8); } } \
            { const bool up = (l16 & 4) != 0; _Pragma("unroll") for (int i_ = 0; i_ < 2; ++i_) { const float mine = up ? r4_[i_ + 2] : r4_[i_], theirs = up ? r4_[i_] : r4_[i_ + 2]; \
                const float fromhi = DPP_MOV(theirs, 0x104), fromlo = DPP_MOV(theirs, 0x114); r2_[i_] = mine + (up ? fromlo : fromhi); } }     \
            { const bool up = (l16 & 2) != 0; const float mine = up ? r2_[1] : r2_[0], theirs = up ? r2_[0] : r2_[1]; r1_ = mine + DPP_MOV(theirs, 0x4E); }     \
            r1_ += DPP_MOV(r1_, 0xB1);                                                                                                                  \
            if ((l16 & 1) == 0) { const int si_ = (s_) + (l16 >> 1); wl[si_] = (j == 0 ? 0.f : wl[si_]) + r1_; } } while (0)
            float dd[8];
            EX_RING(tabq, EX_U, EX_UEND);
#undef EX_U
#undef EX_UEND
            LDS_WAIT(); asm volatile("" ::: "memory");
        }
#pragma unroll
        for (int i = 0; i < 8; ++i) { const int s = l16 + 16 * i; const unsigned me = list[s]; const unsigned e = me & 0x3FFFu;
            wl[s] = gt[(me >> 16) & 127u] * gelu_tanh(wl[s] * su[e] * rs) * sv[e]; }
        LDS_WAIT(); asm volatile("" ::: "memory");
#pragma unroll 1
        for (int j = 0; j < NSW; ++j) {
            f32x2 acc[QCH][8];
#pragma unroll
            for (int c = 0; c < QCH; ++c)
#pragma unroll
                for (int e = 0; e < 8; ++e) acc[c][e] = (f32x2){0.f, 0.f};
            const unsigned char* tabq = pv + j * (QCH * 256);
#define EX_NOEND(s_) do { } while (0)
#define EX_V(B, s_, k_) do { const float w_ = wl[s_]; const f32x2 w2 = {w_, w_}; \
            _Pragma("unroll") for (int c_ = 0; c_ < QCH; ++c_) { const unsigned ud[4] = {B[c_].x, B[c_].y, B[c_].z, B[c_].w}; \
                _Pragma("unroll") for (int w4_ = 0; w4_ < 4; ++w4_) { acc[c_][2 * w4_] = __builtin_amdgcn_cvt_pk_f32_fp8((int)ud[w4_], false) * w2 + acc[c_][2 * w4_]; acc[c_][2 * w4_ + 1] = __builtin_amdgcn_cvt_pk_f32_fp8((int)ud[w4_], true) * w2 + acc[c_][2 * w4_ + 1]; } } } while (0)
            EX_RING(tabq, EX_V, EX_NOEND);
#undef EX_V
#undef EX_NOEND
            float* orow = F.out + (size_t)tok * DM + j * (QCH * 256) + l16 * 16; const bf16* xrow = xb + (size_t)tok * DM + j * (QCH * 256) + l16 * 16;
#pragma unroll
            for (int c = 0; c < QCH; ++c) { const v4u x0 = *(const GAS v4u*)(xrow + c * 256), x1 = *(const GAS v4u*)(xrow + c * 256 + 8); const unsigned xd[8] = {x0.x, x0.y, x0.z, x0.w, x1.x, x1.y, x1.z, x1.w};
#pragma unroll
                for (int qq = 0; qq < 4; ++qq)
                    *(GAS f32x4*)(orow + c * 256 + 4 * qq) = (f32x4){__uint_as_float(xd[2 * qq] << 16) + acc[c][2 * qq].x, __uint_as_float(xd[2 * qq] & 0xffff0000u) + acc[c][2 * qq].y,
                                                                    __uint_as_float(xd[2 * qq + 1] << 16) + acc[c][2 * qq + 1].x, __uint_as_float(xd[2 * qq + 1] & 0xffff0000u) + acc[c][2 * qq + 1].y}; }
        }
#undef EX_LD
#undef EX_RING
        LDS_WAIT(); asm volatile("" ::: "memory");
    }
}

#ifdef ONLY_PHASE
#define ISO(n) ((n) == ONLY_PHASE)
#else
#define ISO(n) true
#endif
#ifndef LAST_PHASE
#define LAST_PHASE 11
#endif
enum { PH_PROLOGUE = 0, PH_GEMM_IN, PH_GEMM_IN8, PH_ATTN, PH_GEMM_FOXUP, PH_GEMM_RETUP, PH_GEMM_OUT, PH_GEMM_MQ, PH_MEM_ATTN, PH_GEMM_MO, PH_GEMM_PQ, PH_EXPERTS, PH_N };
__global__ void __launch_bounds__(NWAVES * 64, 2) mega_fwd(Args args) {
    extern __shared__ __attribute__((aligned(16))) unsigned char lds[];
    Frame F;
    F.lds = (LAS unsigned char*)lds; F.ldsg = lds; F.tid = threadIdx.x; F.lane = F.tid & 63; F.wave = __builtin_amdgcn_readfirstlane(F.tid >> 6); F.G = gridDim.x; F.bx = blockIdx.x;
    F.in = args.in; F.out = args.out; F.ws = args.ws; F.p0_mask = args.p0_mask;
    volatile LAS unsigned* MISC = (volatile LAS unsigned*)(F.lds + MISC_OFF);
    for (int u = F.tid; u < (LDS_BYTES - LDSCTL_OFF) / 4; u += NWAVES * 64) ((LAS unsigned*)(F.lds + LDSCTL_OFF))[u] = 0u;
    __syncthreads();
    gu32* ctl = (gu32*)(args.ws + WS_CTL);
    XcdBarrier bar = xcd_barrier_post((unsigned*)(ctl + CW_BAR), MISC + 8);
    unsigned char* ws = args.ws;
    bf16* proj = (bf16*)(ws + WS_PROJ);
    for (int ph = args.ph_lo; ph < args.ph_hi; ++ph) {
        { int t_ = threadIdx.x; asm volatile("" : "+v"(t_)); F.tid = t_; F.lane = t_ & 63; }
        { int g_ = gridDim.x, b_ = blockIdx.x; asm volatile("" : "+s"(g_), "+s"(b_)); F.G = g_; F.bx = b_; }
        bool is_gemm = false, barrier_after = true, fp8 = false, mq_phase = false, qk_phase = false, pq_phase = false, ksplit = false, qk8_phase = false;
        pg8::Gemm g{nullptr, nullptr, 0, 0, 0, 0, 0x7F7F7F7F}; pg8::EpiAny E{};
        switch (ph) {
#ifndef NO_P0
        case PH_PROLOGUE: if constexpr (ISO(0)) p0_prologue(F); break;
#endif
        case PH_GEMM_IN: if constexpr (ISO(1)) p1_scan(F); is_gemm = true; barrier_after = false; qk_phase = true;
            g = pg8::Gemm{(const bf16*)(ws + WS_XN), (const bf16*)(ws + WS_WIN), M_TOK, N_QK, DM, DM, 0x7F7F7F7F, DM}; E.kind = 0; E.O = proj; E.ldc = PP; E.pn_off = 0; break;
        case PH_GEMM_IN8: is_gemm = true; fp8 = true; qk8_phase = true;
            g = pg8::Gemm{(const bf16*)((unsigned char*)args.out + DO_XN8), (const bf16*)(ws + WS_WIN + 16 * MiB), M_TOK, N_REST, DM / 2, DM / 2, W8_SCALE_B, DM / 2}; E.kind = 0; E.O = proj + N_QK; E.ldc = PP; E.pn_off = N_QK / 256; break;
#ifndef NO_ATTN
        case PH_ATTN: if constexpr (ISO(3)) p4_attention(F); break;
#endif
#if FP8_UP_OUT
        case PH_GEMM_FOXUP: is_gemm = true; fp8 = true;
            g = pg8::Gemm{(const bf16*)((unsigned char*)args.out + DO_OCAT8), (const bf16*)(ws + WS_WFOX), M_TOK, DM, 512, 1024, W8_SCALE_B, 1024}; ksplit = true; E.kind = 7; E.Gt = proj + C_G0; E.Gt2 = proj + C_G1; E.ldg = PP; E.O8 = (unsigned char*)(proj + C_FK); E.ld8 = PP * 2; break;
        case PH_GEMM_RETUP: barrier_after = false; break;
        case PH_GEMM_OUT: is_gemm = true; fp8 = true;
            g = pg8::Gemm{proj + C_FK, (const bf16*)(ws + WS_WOUT), M_TOK, DM, DM / 2, PP, W8_SCALE_B, DM / 2}; E.kind = 4; E.base = args.in[I_X]; E.base16 = nullptr; E.O = (bf16*)(ws + WS_XB1); E.ldc = DM; E.rowss = (float*)(ws + WS_ROWSS1); break;
#else
        case PH_GEMM_FOXUP: is_gemm = true;
            g = pg8::Gemm{proj + C_FQ, (const bf16*)(ws + WS_WFOX), M_TOK, DM, 1024, PP, 0x7F7F7F7F, 1024}; E.kind = 2; E.O = (bf16*)(ws + WS_XN); E.ldc = DM; E.Gt = proj + C_G0; E.ldg = PP; break;
        case PH_GEMM_RETUP: is_gemm = true;
            g = pg8::Gemm{proj + C_RQ, (const bf16*)(ws + WS_WRET), M_TOK, DM, 1024, PP, 0x7F7F7F7F, 1024}; E.kind = 6; E.O = (bf16*)(ws + WS_XN); E.ldc = DM; E.Gt = proj + C_G1; E.ldg = PP; break;
        case PH_GEMM_OUT: is_gemm = true;
            g = pg8::Gemm{(const bf16*)(ws + WS_XN), (const bf16*)(ws + WS_WOUT), M_TOK, DM, DM, DM, 0x7F7F7F7F, DM}; E.kind = 4; E.base = args.in[I_X]; E.base16 = nullptr; E.O = (bf16*)(ws + WS_XB1B); E.ldc = DM; E.rowss = (float*)(ws + WS_ROWSS1); break;
#endif
        case PH_GEMM_MQ: is_gemm = true; mq_phase = true;
            if (F.bx < 128) { g = pg8::Gemm{(const bf16*)(ws + WS_XB1), (const bf16*)(ws + WS_WMQ), M_TOK, 512, DM, DM, 0x7F7F7F7F, DM}; E.kind = 1; E.O = (bf16*)(ws + WS_QM); E.ldc = 512; E.rowss_in = (const float*)(ws + WS_ROWSS1); }
            else { g = pg8::Gemm{(const bf16*)(ws + WS_MN), (const bf16*)(ws + WS_WMKV), NB * 256, 1024, DM, DM, 0x7F7F7F7F, DM}; E.kind = 1; E.O = (bf16*)(ws + WS_KVM); E.ldc = 1024; E.rowss_in = nullptr; }
            break;
        case PH_MEM_ATTN: if constexpr (ISO(8)) p10_mem_attention(F); break;
        case PH_GEMM_MO: is_gemm = true;
            fp8 = true; g = pg8::Gemm{(const bf16*)(ws + WS_OMEM), (const bf16*)(ws + WS_WMO), M_TOK, DM, 256, 256, W8_SCALE_B, 256}; E.kind = 4; E.base = nullptr; E.base16 = (const bf16*)(ws + WS_XB1); E.O = (bf16*)(ws + WS_XB2); E.ldc = DM; E.rowss = (float*)(ws + WS_ROWSS2); break;
        case PH_GEMM_PQ: is_gemm = true; pq_phase = true;
            g = pg8::Gemm{(const bf16*)(ws + WS_XB2), (const bf16*)(ws + WS_WPQ), M_TOK, DM, DM, DM, 0x7F7F7F7F, DM}; E.kind = 1; E.O = (bf16*)(ws + WS_QP); E.ldc = DM; E.rowss_in = (const float*)(ws + WS_ROWSS2); break;
        case PH_EXPERTS: if constexpr (ISO(11)) p14_experts_sorted(F); break;
        default: break;
        }
#ifndef NO_GEMM
        if constexpr (ISO(100)) if (is_gemm) { pg8::StaticOrder S; S.init(g.M, g.N, F.G, (mq_phase && F.bx >= 128) ? F.bx - 128 : F.bx); S.kshift = ksplit ? 1 : 0;
            if (fp8) pg8::gemm_phase<pg8::EpiAny, pg8::StaticOrder, true, true, true>(F.lds, g, S, E); else pg8::gemm_phase<pg8::EpiAny, pg8::StaticOrder, true, true, false>(F.lds, g, S, E); }
        if constexpr (ISO(1)) if (qk_phase) {
            asm volatile("s_waitcnt vmcnt(0)" ::: "memory"); __syncthreads();
            pg8::StaticOrder S; pg8::Unit u; S.init(M_TOK, N_QK, F.G, F.bx);
            for (int i = 0; S.next(i, u); ++i) fix_own_tile(F, proj, u.pm, u.pn, 2 + (u.pn >> 2)); }
        if constexpr (ISO(2)) if (qk8_phase) {
            asm volatile("s_waitcnt vmcnt(0)" ::: "memory"); __syncthreads();
            pg8::StaticOrder S; pg8::Unit u; S.init(M_TOK, N_REST, F.G, F.bx);
            for (int i = 0; S.next(i, u); ++i) if (u.pn < 8) fix_own_tile(F, proj, u.pm, u.pn + 8, u.pn >> 2); }
        if constexpr (ISO(10)) if (pq_phase) {
            asm volatile("s_waitcnt vmcnt(0)" ::: "memory"); __syncthreads();
            pg8::StaticOrder S; pg8::Unit u; S.init(M_TOK, DM, F.G, F.bx);
            for (int i = 0; S.next(i, u); ++i) p13_topk_unit(F, u.pm, u.pn); }
        if constexpr (ISO(7)) if (mq_phase) {
            pg8::StaticOrder S; pg8::Unit u;
            if (F.bx < 128) { S.init(M_TOK, 512, F.G, F.bx); if (S.next(0, u)) norm_own_tile(F, (bf16*)(ws + WS_QM), 512, u.pm * 256, u.pn * 256, args.in[I_MEMQ_G], QK_C2); }
            else { S.init(NB * 256, 1024, F.G, F.bx - 128); if (S.next(0, u) && u.pn < 2) norm_own_tile(F, (bf16*)(ws + WS_KVM), 1024, u.pm * 256, u.pn * 256, args.in[I_MEMK_G], 1.f); }
            if (!(F.p0_mask & 8)) p8_convert_peer(F); }
#endif
        if (barrier_after && ph + 1 < args.ph_hi) xcd_barrier(bar);
    }
    if (xb_ld((unsigned*)(ctl + CW_BAR) + XB_TMO) != 0u) { const float q = __builtin_nanf(""); for (size_t i = (size_t)F.bx * 512 + F.tid; i < (size_t)M_TOK * DM / 4; i += (size_t)F.G * 512) ((f32x4*)args.out)[i] = (f32x4){q, q, q, q}; }
}

extern "C" void kernel_launch(void* const* d_in, const int* in_sizes, int n_in, void* d_out, int out_size, void* d_ws, size_t ws_size, hipStream_t stream) {
    static int grid = 0;
    if (grid == 0) {
        if (n_in != 23 || out_size != M_TOK * DM || ws_size < WS_END) { fprintf(stderr, "kernel_launch: unexpected shapes (n_in %d out %d ws %zu)\n", n_in, out_size, ws_size); grid = -1; return; }
        int dev = 0, cus = 0, per_cu = 0;
        if (hipGetDevice(&dev) != hipSuccess || hipDeviceGetAttribute(&cus, hipDeviceAttributeMultiprocessorCount, dev) != hipSuccess) { grid = -1; return; }
        if (hipFuncSetAttribute((const void*)mega_fwd, hipFuncAttributeMaxDynamicSharedMemorySize, LDS_BYTES) != hipSuccess) { fprintf(stderr, "hipFuncSetAttribute failed\n"); grid = -1; return; }
        if (hipOccupancyMaxActiveBlocksPerMultiprocessor(&per_cu, (const void*)mega_fwd, NWAVES * 64, LDS_BYTES) != hipSuccess || per_cu < 1) fprintf(stderr, "occupancy query reports %d\n", per_cu);
        (void)hipGetLastError();
        grid = cus;
        if (grid != 256) { fprintf(stderr, "kernel_launch: built for 256 CUs, got %d\n", cus); grid = -1; return; }
    }
    if (grid < 0) return;
    (void)hipMemsetAsync((char*)d_ws + WS_CTL, 0, CTL_ZERO_BYTES, stream);
    Args a{};
    for (int i = 0; i < 23; ++i) a.in[i] = (const float*)d_in[i];
    a.out = (float*)d_out; a.ws = (unsigned char*)d_ws;
#ifdef PROBE_PREFIX
    a.ph_lo = 0; a.ph_hi = PROBE_PREFIX;
#ifdef PROBE_P0_MASK
    a.p0_mask = PROBE_P0_MASK;
#else
    a.p0_mask = 3;
#endif
    hipLaunchKernelGGL(mega_fwd, dim3(grid), dim3(NWAVES * 64), LDS_BYTES, stream, a);
    (void)hipMemsetAsync((char*)d_ws + WS_CTL, 0, CTL_ZERO_BYTES, stream);
#endif
    a.ph_lo = 0; a.ph_hi = LAST_PHASE + 1; a.p0_mask = 3;
    hipLaunchKernelGGL(mega_fwd, dim3(grid), dim3(NWAVES * 64), LDS_BYTES, stream, a);
}
```

```cpp
#include <hip/hip_runtime.h>
#include <cstdio>
#include <cstdint>
#include <cmath>
namespace pg8 {
#define PG8_LAS __attribute__((address_space(3)))
typedef unsigned short bf16_t;
typedef short bf16x8 __attribute__((ext_vector_type(8)));
typedef float f32x4 __attribute__((ext_vector_type(4)));
typedef unsigned u32x4 __attribute__((ext_vector_type(4)));
constexpr int BM = 256, BK = 64, HALF = 128, HTB = HALF * BK * 2  , STAGE_BYTES = 8 * HTB, NXCD = 8, WGM = 8;

__host__ __device__ __forceinline__ int lds_byte(int r, int c) { const int st = (r >> 4) * 2 + (c >> 5), rr = r & 15, cc = c & 31, ob = rr * 64 + cc * 2; return st * 1024 + (ob ^ (((ob >> 9) & 1) << 5)); }
__host__ __device__ __forceinline__ void stage_rc(int b, int& R, int& C) { const int st = b / 1024, sb = b % 1024, swz = sb ^ (((sb >> 9) & 1) << 5); R = (st >> 1) * 16 + swz / 64; C = (st & 1) * 32 + (swz % 64) / 2; }
__host__ __device__ __forceinline__ int perm32(int rho) { const int n = rho >> 4, i = rho & 15; return 8 * (i >> 2) + 4 * n + (i & 3); }

struct Unit { int pm, pn, kp; };
typedef int pg8_v4i __attribute__((ext_vector_type(4)));
struct Gemm { const bf16_t* A; const bf16_t* Bt; int M, N, K, lda; int scale_b; int ldb; };

struct StaticOrder {
    int nM, nN, nwg, G, c, kshift = 0;
    __host__ __device__ __forceinline__ void init(int M, int N, int G_, int c_) { nM = M / BM; nN = N / BM; nwg = nM * nN; G = G_; c = c_; }
    __host__ __device__ __forceinline__ bool next(int i2, Unit& u) const {
        const int i = i2 >> kshift; u.kp = i2 & ((1 << kshift) - 1);
        const long L = (long)i * G + c; if (L >= nwg) return false;
        int wgid = (int)L; { const int q = nwg / NXCD, r = nwg % NXCD, xcd = wgid % NXCD, off = wgid / NXCD; wgid = (xcd < r ? xcd * (q + 1) : r * (q + 1) + (xcd - r) * q) + off; }
        const int nig = WGM * nN, gid = wgid / nig, fm = gid * WGM, gsz = (nM - fm) < WGM ? (nM - fm) : WGM;
        u.pm = fm + ((wgid % nig) % gsz); u.pn = (wgid % nig) / gsz; return true;
    }
    __device__ __forceinline__ void a_ready(const Unit&) const {}
    __device__ __forceinline__ void done(const Unit&) const {}
};

__device__ __forceinline__ unsigned cvt_pk_bf16(float lo, float hi) { unsigned r; asm volatile("v_cvt_pk_bf16_f32 %0, %1, %2" : "=v"(r) : "v"(lo), "v"(hi)); return r; }
typedef float f32x2 __attribute__((ext_vector_type(2)));
__device__ __forceinline__ f32x2 gelu_pk(f32x2 v) {
    const f32x2 av = __builtin_elementwise_abs(v), d = av * 0.2316418882f + 1.0f;
    f32x2 t; t.x = __builtin_amdgcn_rcpf(d.x); t.y = __builtin_amdgcn_rcpf(d.y);
    f32x2 q = t * 0.5307027145f + (-0.7265760135f); q = q * t + 0.7107068705f; q = q * t + (-0.142248368f); q = q * t + 0.127414796f; q = q * t;
    const f32x2 s = (v * v) * (-0.72134752044f);
    f32x2 e; e.x = __builtin_amdgcn_exp2f(s.x); e.y = __builtin_amdgcn_exp2f(s.y);
    const f32x2 m = v * (q * e), r = v - m;
    f32x2 o; o.x = v.x < 0.f ? m.x : r.x; o.y = v.y < 0.f ? m.y : r.y; return o;
}

template <int ACT  > struct EpiBf16 {
    static constexpr bool PERM = true, AFTER_DRAIN = false; static_assert(ACT == 0 || ACT == 1, "EpiBf16: ACT is 0 (none) or 1 (gelu_pk)");
    bf16_t* O; int ldc; const float* bias; int split_cols; size_t split_stride; float scale0;
    __device__ __forceinline__ void operator()(const f32x4 (&acc)[2][2][4][2], const Unit& u, int wr, int wc, int fr, int fq) const {
        const int row0 = u.pm * BM + wr * 64 + fr; int colt = u.pn * BM; bf16_t* base = O;
        float sc = 1.f; if (split_cols) { const int t = colt / split_cols; base += (size_t)t * split_stride; colt -= t * split_cols; if (t == 0) sc = scale0; }
        const int col0 = colt + wc * 32 + 8 * fq, bcol0 = u.pn * BM + wc * 32 + 8 * fq;
        f32x4 bv[2][2];
#pragma unroll
        for (int bj = 0; bj < 2; ++bj)
#pragma unroll
            for (int n = 0; n < 2; ++n) bv[bj][n] = bias ? *(const f32x4*)(bias + bcol0 + bj * HALF + 4 * n) : (f32x4){0.f, 0.f, 0.f, 0.f};
#pragma unroll
        for (int ai = 0; ai < 2; ++ai)
#pragma unroll
            for (int m = 0; m < 4; ++m) { bf16_t* rowp = base + (size_t)(row0 + ai * HALF + m * 16) * ldc + col0;
#pragma unroll
                for (int bj = 0; bj < 2; ++bj) { f32x4 v0 = acc[ai][bj][m][0] + bv[bj][0], v1 = acc[ai][bj][m][1] + bv[bj][1];
                    if (ACT == 1) { f32x2 a = gelu_pk((f32x2){v0[0], v0[1]}), b = gelu_pk((f32x2){v0[2], v0[3]}), c = gelu_pk((f32x2){v1[0], v1[1]}), d = gelu_pk((f32x2){v1[2], v1[3]});
                        v0 = (f32x4){a.x, a.y, b.x, b.y}; v1 = (f32x4){c.x, c.y, d.x, d.y}; }
                    v0 = v0 * sc; v1 = v1 * sc; u32x4 w; w.x = cvt_pk_bf16(v0[0], v0[1]); w.y = cvt_pk_bf16(v0[2], v0[3]); w.z = cvt_pk_bf16(v1[0], v1[1]); w.w = cvt_pk_bf16(v1[2], v1[3]);
                    *(u32x4*)(rowp + bj * HALF) = w; } }
    }
};

struct PanelStats {
    unsigned* xbuf;
    unsigned* cnt;
    unsigned* tmo;
    int ntn; float eps;
    unsigned code;
    __device__ __forceinline__ bool run(const f32x4 (&v)[2][2][4][2], const Unit& u, int wr, int wc, int fr, int fq, PG8_LAS unsigned char* lds, int wid, int lane) const {
        typedef float f32x2v __attribute__((ext_vector_type(2)));
        PG8_LAS f32x2v* P = (PG8_LAS f32x2v*)lds;
        PG8_LAS f32x2v* S = (PG8_LAS f32x2v*)(lds + 8192);
        PG8_LAS unsigned* flag = (PG8_LAS unsigned*)(lds + 8192 + 2048);
#pragma unroll
        for (int ai = 0; ai < 2; ++ai)
#pragma unroll
            for (int m = 0; m < 4; ++m) {
                float s = 0.f;
#pragma unroll
                for (int bj = 0; bj < 2; ++bj)
#pragma unroll
                    for (int n = 0; n < 2; ++n) { const f32x4 x = v[ai][bj][m][n]; s += (x[0] + x[1]) + (x[2] + x[3]); }
                s += __shfl_xor(s, 16); s += __shfl_xor(s, 32);
                const float mw = s * (1.0f / 64.0f); float q = 0.f;
#pragma unroll
                for (int bj = 0; bj < 2; ++bj)
#pragma unroll
                    for (int n = 0; n < 2; ++n) { const f32x4 d = v[ai][bj][m][n] - mw; q += (d[0] * d[0] + d[1] * d[1]) + (d[2] * d[2] + d[3] * d[3]); }
                q += __shfl_xor(q, 16); q += __shfl_xor(q, 32);
                if (fq == 0) P[(ai * HALF + wr * 64 + m * 16 + fr) * 4 + wc] = (f32x2v){mw, q};
            }
        asm volatile("s_waitcnt lgkmcnt(0)" ::: "memory"); __builtin_amdgcn_s_barrier(); asm volatile("" ::: "memory");
#if defined(BROKEN_EXCHANGE_NO_WAIT)
#warning BROKEN CONTROL BUILD: the row-statistics exchange does not wait; results are wrong by design
        if (blockIdx.x >= 64) { const long long t0_ = clock64(); while (clock64() - t0_ < 60000) __builtin_amdgcn_s_sleep(8); }
#endif
        const int row = wid * 32 + (lane & 31);
        if (lane < 32) {
            const f32x2v a = P[row * 4 + 0], b = P[row * 4 + 1], c = P[row * 4 + 2], d = P[row * 4 + 3];
            const float mt = (a.x + b.x + c.x + d.x) * 0.25f;
            const float da = a.x - mt, db = b.x - mt, dc = c.x - mt, dd = d.x - mt;
            const float m2 = (a.y + b.y) + (c.y + d.y) + 64.0f * ((da * da + db * db) + (dc * dc + dd * dd));
            unsigned long long* slot = (unsigned long long*)xbuf + ((size_t)(u.pm * BM + row) * 4 + u.pn);
            __hip_atomic_store(slot, ((unsigned long long)__float_as_uint(m2) << 32) | __float_as_uint(mt), __ATOMIC_RELAXED, __HIP_MEMORY_SCOPE_AGENT);
        }
        asm volatile("s_waitcnt vmcnt(0)" ::: "memory");
        if (lane == 0) __hip_atomic_fetch_add(cnt + 64 * u.pm, 1u, __ATOMIC_RELAXED, __HIP_MEMORY_SCOPE_AGENT);
        if (wid == 0) {
            bool dead = false; const unsigned long long t0 = __builtin_amdgcn_s_memrealtime(); const unsigned want = 8u * (unsigned)ntn;
            for (;;) {
#if defined(BROKEN_EXCHANGE_NO_WAIT)
                break;
#endif
                if ((unsigned)__builtin_amdgcn_readfirstlane(__hip_atomic_load(cnt + 64 * u.pm, __ATOMIC_RELAXED, __HIP_MEMORY_SCOPE_AGENT)) >= want) break;
                if (__builtin_amdgcn_s_memrealtime() - t0 > 2000000ull) {
                    if (lane == 0) { unsigned expect = 0u; __hip_atomic_compare_exchange_strong(tmo + 1, &expect, code | (unsigned)(u.pm & 0xff), __ATOMIC_RELAXED, __ATOMIC_RELAXED, __HIP_MEMORY_SCOPE_AGENT);
                                     __hip_atomic_store(tmo, 1u, __ATOMIC_RELAXED, __HIP_MEMORY_SCOPE_AGENT); }
                    dead = true; break; }
                __builtin_amdgcn_s_sleep(2);
            }
            __builtin_amdgcn_fence(__ATOMIC_ACQUIRE, "agent");
            if (lane == 0) flag[0] = dead ? 1u : 0u;
        }
        asm volatile("s_waitcnt vmcnt(0) lgkmcnt(0)" ::: "memory"); __builtin_amdgcn_s_barrier(); asm volatile("" ::: "memory");
        const bool bad = flag[0] != 0u;
        if (lane < 32) {
            const unsigned long long* slot = (const unsigned long long*)xbuf + (size_t)(u.pm * BM + row) * 4; float mt[4], m2[4]; float ms = 0.f;
#pragma unroll
            for (int t = 0; t < 4; ++t) { if (t < ntn) { const unsigned long long w = __hip_atomic_load(slot + t, __ATOMIC_RELAXED, __HIP_MEMORY_SCOPE_AGENT); mt[t] = __uint_as_float((unsigned)w); m2[t] = __uint_as_float((unsigned)(w >> 32)); } else { mt[t] = 0.f; m2[t] = 0.f; } ms += mt[t]; }
            const float mean = ms / (float)ntn; float q = 0.f;
#pragma unroll
            for (int t = 0; t < 4; ++t) if (t < ntn) { const float dm = mt[t] - mean; q += m2[t] + 256.0f * dm * dm; }
            S[row] = (f32x2v){mean, 1.0f / sqrtf(q / (256.0f * (float)ntn) + eps)};
        }
        asm volatile("s_waitcnt lgkmcnt(0)" ::: "memory"); __builtin_amdgcn_s_barrier(); asm volatile("" ::: "memory");
        return bad;
    }
};
struct EpiLnRes {
    static constexpr bool PERM = false, AFTER_DRAIN = true;
    const float* base; float* out; int ldc; const float* bias; PanelStats st; unsigned poison;
    __device__ __forceinline__ void fused(f32x4 (&acc)[2][2][4][2], const Unit& u, int wr, int wc, int fr, int fq, PG8_LAS unsigned char* lds, int wid, int lane) const {
        typedef float f32x2v __attribute__((ext_vector_type(2)));
        const PG8_LAS f32x2v* S = (const PG8_LAS f32x2v*)(lds + 8192);
        const int col0 = u.pn * BM + wc * 32 + 4 * fq;
#pragma unroll
        for (int bj = 0; bj < 2; ++bj)
#pragma unroll
            for (int n = 0; n < 2; ++n) { const f32x4 bv = bias ? *(const f32x4*)(bias + col0 + bj * HALF + n * 16) : (f32x4){0.f, 0.f, 0.f, 0.f};
#pragma unroll
                for (int ai = 0; ai < 2; ++ai)
#pragma unroll
                    for (int m = 0; m < 4; ++m) acc[ai][bj][m][n] += bv; }
        f32x4 pre[4][2][2];
#pragma unroll
        for (int m = 0; m < 4; ++m) { const size_t off = (size_t)(u.pm * BM + wr * 64 + m * 16 + fr) * ldc + col0;
#pragma unroll
            for (int bj = 0; bj < 2; ++bj)
#pragma unroll
                for (int n = 0; n < 2; ++n) pre[m][bj][n] = *(const f32x4*)(base + off + bj * HALF + n * 16); }
        const bool bad = st.run(acc, u, wr, wc, fr, fq, lds, wid, lane) || poison != 0u;
        const float qnan = __builtin_nanf("");
#pragma unroll
        for (int ai = 0; ai < 2; ++ai)
#pragma unroll
            for (int m = 0; m < 4; ++m) { const int r = ai * HALF + wr * 64 + m * 16 + fr; const f32x2v sr = S[r]; const size_t off = (size_t)(u.pm * BM + r) * ldc + col0;
#pragma unroll
                for (int bj = 0; bj < 2; ++bj)
#pragma unroll
                    for (int n = 0; n < 2; ++n) { const f32x4 bs = ai == 0 ? pre[m][bj][n] : *(const f32x4*)(base + off + bj * HALF + n * 16); f32x4 o = bs + (acc[ai][bj][m][n] - sr.x) * sr.y;
                        if (bad) o = (f32x4){qnan, qnan, qnan, qnan}; *(f32x4*)(out + off + bj * HALF + n * 16) = o; }
                if (m & 1) asm volatile("" ::: "memory"); }
    }
};
struct EpiLnResLn {
    static constexpr bool PERM = false, AFTER_DRAIN = true;
    const float* base; float* out; bf16_t* xn; int ldc; const float* bias; PanelStats st1, st2; unsigned poison;
    __device__ __forceinline__ void fused(f32x4 (&acc)[2][2][4][2], const Unit& u, int wr, int wc, int fr, int fq, PG8_LAS unsigned char* lds, int wid, int lane) const {
        typedef float f32x2v __attribute__((ext_vector_type(2))); typedef unsigned u32x2v __attribute__((ext_vector_type(2)));
        const PG8_LAS f32x2v* S = (const PG8_LAS f32x2v*)(lds + 8192);
        const int col0 = u.pn * BM + wc * 32 + 4 * fq;
#pragma unroll
        for (int bj = 0; bj < 2; ++bj)
#pragma unroll
            for (int n = 0; n < 2; ++n) { const f32x4 bv = bias ? *(const f32x4*)(bias + col0 + bj * HALF + n * 16) : (f32x4){0.f, 0.f, 0.f, 0.f};
#pragma unroll
                for (int ai = 0; ai < 2; ++ai)
#pragma unroll
                    for (int m = 0; m < 4; ++m) acc[ai][bj][m][n] += bv; }
        bool bad = st1.run(acc, u, wr, wc, fr, fq, lds, wid, lane) || poison != 0u;
        const float qnan = __builtin_nanf("");
#pragma unroll
        for (int ai = 0; ai < 2; ++ai)
#pragma unroll
            for (int m = 0; m < 4; ++m) { const int r = ai * HALF + wr * 64 + m * 16 + fr; const f32x2v sr = S[r]; const size_t off = (size_t)(u.pm * BM + r) * ldc + col0;
#pragma unroll
                for (int bj = 0; bj < 2; ++bj)
#pragma unroll
                    for (int n = 0; n < 2; ++n) { const f32x4 bs = *(const f32x4*)(base + off + bj * HALF + n * 16); acc[ai][bj][m][n] = bs + (acc[ai][bj][m][n] - sr.x) * sr.y; }
                asm volatile("" : "+v"(acc[ai][0][m][0]), "+v"(acc[ai][0][m][1]), "+v"(acc[ai][1][m][0]), "+v"(acc[ai][1][m][1]));
                if (m & 1) asm volatile("" ::: "memory"); }
        const bool bad1 = bad;
        bad = st2.run(acc, u, wr, wc, fr, fq, lds, wid, lane) || bad;
#pragma unroll
        for (int ai = 0; ai < 2; ++ai)
#pragma unroll
            for (int m = 0; m < 4; ++m) { const int r = ai * HALF + wr * 64 + m * 16 + fr; const f32x2v sr = S[r]; const size_t off = (size_t)(u.pm * BM + r) * ldc + col0;
#pragma unroll
                for (int bj = 0; bj < 2; ++bj)
#pragma unroll
                    for (int n = 0; n < 2; ++n) { const f32x4 x1 = acc[ai][bj][m][n]; *(f32x4*)(out + off + bj * HALF + n * 16) = bad1 ? (f32x4){qnan, qnan, qnan, qnan} : x1;
                        const f32x4 o = (x1 - sr.x) * sr.y; u32x2v w; w.x = cvt_pk_bf16(o[0], o[1]); w.y = cvt_pk_bf16(o[2], o[3]);
                        if (bad) { w.x = 0x7fc07fc0u; w.y = 0x7fc07fc0u; } *(u32x2v*)(xn + off + bj * HALF + n * 16) = w; }
                asm volatile("" ::: "memory"); }
    }
};

typedef int pg8_v8i __attribute__((ext_vector_type(8)));
template <bool FP8> struct Frag;
template <> struct Frag<false> { bf16x8 k[2]; };
template <> struct Frag<true> { pg8_v8i v; };
__device__ __forceinline__ void load_frag(Frag<false>& f, const PG8_LAS unsigned char* p) { f.k[0] = *(const PG8_LAS bf16x8*)p; f.k[1] = *(const PG8_LAS bf16x8*)(p + 1024); }
__device__ __forceinline__ void load_frag(Frag<true>& f, const PG8_LAS unsigned char* p) { const pg8_v4i a = *(const PG8_LAS pg8_v4i*)p, b = *(const PG8_LAS pg8_v4i*)(p + 1024); f.v = __builtin_shufflevector(a, b, 0, 1, 2, 3, 4, 5, 6, 7); }
__device__ __forceinline__ void mma_frag(f32x4& acc, const Frag<false>& b, const Frag<false>& a, int) { acc = __builtin_amdgcn_mfma_f32_16x16x32_bf16(b.k[0], a.k[0], acc, 0, 0, 0); acc = __builtin_amdgcn_mfma_f32_16x16x32_bf16(b.k[1], a.k[1], acc, 0, 0, 0); }
__device__ __forceinline__ void mma_frag(f32x4& acc, const Frag<true>& b, const Frag<true>& a, int scale_w) {
    asm volatile("v_mfma_scale_f32_16x16x128_f8f6f4 %0, %1, %2, %0, %3, %4 op_sel_hi:[0,0,0]" : "+v"(acc) : "v"(b.v), "v"(a.v), "v"(scale_w), "v"(0x7F7F7F7F)); }
template <class Epi, class Sched, bool ALIGN_EPI = false, bool SP2 = false, bool FP8 = false>
__device__ __forceinline__ void gemm_phase(PG8_LAS unsigned char* lds, const Gemm g, const Sched& S, const Epi& E) {
    int tid_ = threadIdx.x; asm volatile("" : "+v"(tid_));
    const int tid = tid_, wid = __builtin_amdgcn_readfirstlane(tid >> 6), lane = tid & 63, wr = wid >> 2, wc = wid & 3, fr = lane & 15, fq = lane >> 4;
    const int K = g.K, nt = K / BK;
    unsigned voffA[2], voffB[2];
#pragma unroll
    for (int i = 0; i < 2; ++i) { int R, C; stage_rc(tid * 16 + i * 8192, R, C); const int Rb = Epi::PERM ? ((R & ~31) + perm32(R & 31)) : R;
        voffA[i] = (unsigned)(R * g.lda + C) * 2u; voffB[i] = (unsigned)(Rb * g.ldb + C) * 2u; }
    const size_t kstep = (size_t)(BK * 2);
    const size_t hstepB = (size_t)HALF * g.ldb * 2, hstepA = (size_t)HALF * g.lda * 2;
    const size_t tstepB = 2 * hstepB, tstepA = 2 * hstepA;
    const unsigned ldsw = (unsigned)wid * 1024u;
    const int aoff = lds_byte(wr * 64 + fr, fq * 8), boff = lds_byte(wc * 32 + fr, fq * 8);
#define PG8_SA(b, h) (((b) * 2 + (h)) * HTB)
#define PG8_SB(b, h) ((4 + (b) * 2 + (h)) * HTB)
#define PG8_STAGE(bufoff, gbase, voff) do { _Pragma("unroll") for (int _i = 0; _i < 2; ++_i) \
        __builtin_amdgcn_global_load_lds((const unsigned*)((const char*)(gbase) + (voff)[_i]), (PG8_LAS unsigned*)(lds + (bufoff) + ldsw + _i * 8192), 16, 0, 0); } while (0)
#define PG8_LDA(dst, b, h) do { _Pragma("unroll") for (int m = 0; m < 4; ++m) load_frag(dst[m], lds + PG8_SA(b, h) + aoff + m * 2048); } while (0)
#define PG8_LDB(dst, b, h) do { _Pragma("unroll") for (int n = 0; n < 2; ++n) load_frag(dst[n], lds + PG8_SB(b, h) + boff + n * 2048); } while (0)
#define PG8_MMA(ai, bj, At, Bt) do { __builtin_amdgcn_s_setprio(1); _Pragma("unroll") for (int m = 0; m < 4; ++m) _Pragma("unroll") for (int n = 0; n < 2; ++n) mma_frag(acc[ai][bj][m][n], Bt[n], At[m], g.scale_b); \
        __builtin_amdgcn_s_setprio(0); } while (0)
#define PG8_WAIT_V(n) asm volatile("s_waitcnt vmcnt(" #n ")" ::: "memory")
#define PG8_WAIT_L(n) asm volatile("s_waitcnt lgkmcnt(" #n ")" ::: "memory")
#define PG8_BAR __builtin_amdgcn_s_barrier()
#define PG8_SCHED __builtin_amdgcn_sched_barrier(0)
    Unit cur, nxt; int ui = 0;
    if (!S.next(0, cur)) return;
    f32x4 acc[2][2][4][2];
#pragma unroll
    for (int a = 0; a < 2; ++a)
#pragma unroll
        for (int b = 0; b < 2; ++b)
#pragma unroll
            for (int m = 0; m < 4; ++m)
#pragma unroll
                for (int n = 0; n < 2; ++n) acc[a][b][m][n] = (f32x4){0.f, 0.f, 0.f, 0.f};
    Frag<FP8> At[4], B0[2], B1[2];
    const size_t kpart = (size_t)K * 2;
    const char* cA = (const char*)g.A + (size_t)cur.pm * tstepA + cur.kp * kpart; const char* cB = (const char*)g.Bt + (size_t)cur.pn * tstepB + cur.kp * kpart;
    S.a_ready(cur);
    if constexpr (SP2) {
        PG8_STAGE(PG8_SB(0, 0), cB, voffB); PG8_STAGE(PG8_SB(0, 1), cB + hstepB, voffB); PG8_STAGE(PG8_SA(0, 0), cA, voffA); PG8_STAGE(PG8_SA(0, 1), cA + hstepA, voffA);
        if (wr == 1) PG8_BAR;
        PG8_WAIT_V(2); PG8_BAR;
        PG8_STAGE(PG8_SB(1, 0), cB + kstep, voffB); PG8_STAGE(PG8_SA(1, 0), cA + kstep, voffA); PG8_STAGE(PG8_SB(1, 1), cB + hstepB + kstep, voffB);
        PG8_WAIT_V(6); PG8_BAR;
    } else {
        PG8_STAGE(PG8_SB(0, 0), cB, voffB); PG8_STAGE(PG8_SA(0, 0), cA, voffA); PG8_STAGE(PG8_SB(0, 1), cB + hstepB, voffB); PG8_STAGE(PG8_SA(0, 1), cA + hstepA, voffA);
        if (wr == 1) PG8_BAR;
        PG8_WAIT_V(4); PG8_BAR;
        PG8_STAGE(PG8_SB(1, 0), cB + kstep, voffB); PG8_STAGE(PG8_SA(1, 0), cA + kstep, voffA); PG8_STAGE(PG8_SB(1, 1), cB + hstepB + kstep, voffB);
        PG8_WAIT_V(6); PG8_BAR;
    }
    for (;;) {
        const bool has_next = S.next(ui + 1, nxt);
        const char* nA = has_next ? (const char*)g.A + (size_t)nxt.pm * tstepA + nxt.kp * kpart : cA; const char* nB = has_next ? (const char*)g.Bt + (size_t)nxt.pn * tstepB + nxt.kp * kpart : cB;
        for (int t = 0; t < nt; t += 2) {
            const bool last = (t == nt - 2);
            const char* a1 = cA + (size_t)(t + 1) * kstep;
            const char* a2 = last ? nA : cA + (size_t)(t + 2) * kstep; const char* b2 = last ? nB : cB + (size_t)(t + 2) * kstep;
            const char* a3 = a2 + kstep; const char* b3 = b2 + kstep;
            if (last && has_next) S.a_ready(nxt);
            if constexpr (SP2) {
            PG8_LDB(B0, 0, 0); PG8_LDB(B1, 0, 1); PG8_SCHED; PG8_LDA(At, 0, 0); PG8_STAGE(PG8_SA(1, 1), a1 + hstepA, voffA);
            PG8_WAIT_V(8); PG8_WAIT_L(0); PG8_BAR; PG8_MMA(0, 0, At, B0); PG8_MMA(0, 1, At, B1); PG8_BAR; PG8_SCHED;
            PG8_LDA(At, 0, 1); PG8_STAGE(PG8_SB(0, 0), b2, voffB); PG8_STAGE(PG8_SB(0, 1), b2 + hstepB, voffB); PG8_STAGE(PG8_SA(0, 0), a2, voffA);
            PG8_WAIT_V(8); PG8_WAIT_L(0); PG8_BAR; PG8_MMA(1, 0, At, B0); PG8_MMA(1, 1, At, B1); PG8_BAR; PG8_SCHED;
            PG8_LDB(B0, 1, 0); PG8_LDB(B1, 1, 1); PG8_SCHED; PG8_LDA(At, 1, 0); PG8_STAGE(PG8_SA(0, 1), a2 + hstepA, voffA);
            PG8_WAIT_V(8); PG8_WAIT_L(0); PG8_BAR; PG8_MMA(0, 0, At, B0); PG8_MMA(0, 1, At, B1); PG8_BAR; PG8_SCHED;
            PG8_LDA(At, 1, 1); PG8_STAGE(PG8_SB(1, 0), b3, voffB); PG8_STAGE(PG8_SB(1, 1), b3 + hstepB, voffB); PG8_STAGE(PG8_SA(1, 0), a3, voffA);
            PG8_WAIT_V(8); PG8_WAIT_L(0); PG8_BAR; PG8_MMA(1, 0, At, B0); PG8_MMA(1, 1, At, B1); PG8_BAR; PG8_SCHED;
            } else {
            PG8_LDB(B0, 0, 0); PG8_SCHED; PG8_LDA(At, 0, 0); PG8_STAGE(PG8_SA(1, 1), a1 + hstepA, voffA);
            PG8_WAIT_L(8); PG8_BAR; PG8_WAIT_L(0); PG8_MMA(0, 0, At, B0); PG8_BAR; PG8_SCHED;
            PG8_LDB(B1, 0, 1); PG8_STAGE(PG8_SB(0, 0), b2, voffB);
            PG8_BAR; PG8_WAIT_L(0); PG8_MMA(0, 1, At, B1); PG8_BAR;
            PG8_LDA(At, 0, 1); PG8_STAGE(PG8_SA(0, 0), a2, voffA);
            PG8_BAR; PG8_WAIT_L(0); PG8_MMA(1, 0, At, B0); PG8_BAR; PG8_SCHED;
            PG8_STAGE(PG8_SB(0, 1), b2 + hstepB, voffB);
            PG8_WAIT_V(6); PG8_BAR; PG8_MMA(1, 1, At, B1); PG8_BAR;
            PG8_LDB(B0, 1, 0); PG8_SCHED; PG8_LDA(At, 1, 0); PG8_STAGE(PG8_SA(0, 1), a2 + hstepA, voffA);
            PG8_WAIT_L(8); PG8_BAR; PG8_WAIT_L(0); PG8_MMA(0, 0, At, B0); PG8_BAR; PG8_SCHED;
            PG8_LDB(B1, 1, 1); PG8_STAGE(PG8_SB(1, 0), b3, voffB);
            PG8_BAR; PG8_WAIT_L(0); PG8_MMA(0, 1, At, B1); PG8_BAR;
            PG8_LDA(At, 1, 1); PG8_STAGE(PG8_SA(1, 0), a3, voffA);
            PG8_BAR; PG8_WAIT_L(0); PG8_MMA(1, 0, At, B0); PG8_BAR; PG8_SCHED;
            PG8_STAGE(PG8_SB(1, 1), b3 + hstepB, voffB);
            PG8_WAIT_V(6); PG8_BAR; PG8_MMA(1, 1, At, B1); PG8_BAR;
            }
        }
        if constexpr (ALIGN_EPI) { if (wr == 0) PG8_BAR; }
        if constexpr (FP8) { asm volatile("s_nop 15\n\ts_nop 15" ::: "memory"); }
        if constexpr (!Epi::AFTER_DRAIN) { E(acc, cur, wr, wc, fr, fq); S.done(cur); }
        if (!has_next) break;
        if (nxt.kp == 0)
#pragma unroll
        for (int a = 0; a < 2; ++a)
#pragma unroll
            for (int b = 0; b < 2; ++b)
#pragma unroll
                for (int m = 0; m < 4; ++m)
#pragma unroll
                    for (int n = 0; n < 2; ++n) acc[a][b][m][n] = (f32x4){0.f, 0.f, 0.f, 0.f};
        cur = nxt; cA = nA; cB = nB; ++ui;
        if constexpr (ALIGN_EPI) { if (wr == 1) PG8_BAR; }
    }
    PG8_WAIT_V(0);
    if constexpr (!ALIGN_EPI) { if (wr == 0) PG8_BAR; }
    PG8_BAR;
    if constexpr (Epi::AFTER_DRAIN) { E.fused(acc, cur, wr, wc, fr, fq, lds, wid, lane); S.done(cur); }
#undef PG8_SA
#undef PG8_SB
#undef PG8_STAGE
#undef PG8_LDA
#undef PG8_LDB
#undef PG8_MMA
#undef PG8_WAIT_V
#undef PG8_WAIT_L
#undef PG8_BAR
#undef PG8_SCHED
}
}

#ifndef PG8_SP2
#define PG8_SP2 true
#endif
#ifndef PG8_ALIGN
#define PG8_ALIGN true
#endif
namespace pg8 {
typedef unsigned u32x2e __attribute__((ext_vector_type(2)));
__device__ __forceinline__ float bfbits2f(unsigned b16) { return __uint_as_float(b16 << 16); }
__device__ __forceinline__ void unpack8(const u32x4 w, float (&f)[8]) {
    f[0] = __uint_as_float(w.x << 16); f[1] = __uint_as_float(w.x & 0xffff0000u); f[2] = __uint_as_float(w.y << 16); f[3] = __uint_as_float(w.y & 0xffff0000u);
    f[4] = __uint_as_float(w.z << 16); f[5] = __uint_as_float(w.z & 0xffff0000u); f[6] = __uint_as_float(w.w << 16); f[7] = __uint_as_float(w.w & 0xffff0000u);
}
__device__ __forceinline__ u32x4 pack8f(const float (&f)[8]) { u32x4 w; w.x = cvt_pk_bf16(f[0], f[1]); w.y = cvt_pk_bf16(f[2], f[3]); w.z = cvt_pk_bf16(f[4], f[5]); w.w = cvt_pk_bf16(f[6], f[7]); return w; }
__device__ __forceinline__ float sigmoid_f(float x) { return __builtin_amdgcn_rcpf(1.f + __builtin_amdgcn_exp2f(-1.4426950408889634f * x)); }

struct EpiProj {
    static constexpr bool PERM = true, AFTER_DRAIN = false;
    bf16_t* O; int ldc; int pn_off;
    __device__ __forceinline__ void operator()(const f32x4 (&acc)[2][2][4][2], const Unit& u, int wr, int wc, int fr, int fq) const {
        const int row0 = u.pm * BM + wr * 64 + fr, col0 = u.pn * BM + wc * 32 + 8 * fq;
        const int gpn = u.pn + pn_off; const int act = gpn < 24 ? 0 : (gpn < 28 ? 1 : 2);
#pragma unroll
        for (int ai = 0; ai < 2; ++ai)
#pragma unroll
            for (int m = 0; m < 4; ++m) { bf16_t* rowp = O + (size_t)(row0 + ai * HALF + m * 16) * ldc + col0;
#pragma unroll
                for (int bj = 0; bj < 2; ++bj) { float v[8];
#pragma unroll
                    for (int i = 0; i < 4; ++i) { v[i] = acc[ai][bj][m][0][i]; v[4 + i] = acc[ai][bj][m][1][i]; }
                    if (act != 0) {
#pragma unroll
                        for (int i = 0; i < 8; ++i) { const float s = sigmoid_f(v[i]); v[i] = (act == 1) ? v[i] * s : s; } }
                    *(u32x4*)(rowp + bj * HALF) = pack8f(v); } }
    }
};
struct EpiRowScale {
    static constexpr bool PERM = true, AFTER_DRAIN = false;
    bf16_t* O; int ldc; const float* rowss; float inv_n, eps;
    __device__ __forceinline__ void operator()(const f32x4 (&acc)[2][2][4][2], const Unit& u, int wr, int wc, int fr, int fq) const {
        const int row0 = u.pm * BM + wr * 64 + fr, col0 = u.pn * BM + wc * 32 + 8 * fq;
        float sc[2][4];
#pragma unroll
        for (int ai = 0; ai < 2; ++ai)
#pragma unroll
            for (int m = 0; m < 4; ++m) sc[ai][m] = rowss ? rowss[row0 + ai * HALF + m * 16] : 0.f;
#pragma unroll
        for (int ai = 0; ai < 2; ++ai)
#pragma unroll
            for (int m = 0; m < 4; ++m) { const int row = row0 + ai * HALF + m * 16; bf16_t* rowp = O + (size_t)row * ldc + col0;
                const float s = rowss ? 1.f / sqrtf(sc[ai][m] * inv_n + eps) : 1.f;
#pragma unroll
                for (int bj = 0; bj < 2; ++bj) { float v[8];
#pragma unroll
                    for (int i = 0; i < 4; ++i) { v[i] = acc[ai][bj][m][0][i] * s; v[4 + i] = acc[ai][bj][m][1][i] * s; }
                    *(u32x4*)(rowp + bj * HALF) = pack8f(v); } }
    }
};
template <bool ADD> struct EpiGate {
    static constexpr bool PERM = true, AFTER_DRAIN = false;
    bf16_t* O; int ldc; const bf16_t* Gt; int ldg; unsigned char* O8; int ld8;
    __device__ __forceinline__ void operator()(const f32x4 (&acc)[2][2][4][2], const Unit& u, int wr, int wc, int fr, int fq) const {
        const int row0 = u.pm * BM + wr * 64 + fr, col0 = u.pn * BM + wc * 32 + 8 * fq;
#pragma unroll
        for (int ai = 0; ai < 2; ++ai)
#pragma unroll
            for (int m = 0; m < 4; ++m) { const int row = row0 + ai * HALF + m * 16; bf16_t* rowp = O + (size_t)row * ldc + col0; const bf16_t* gp = Gt + (size_t)row * ldg + col0;
#pragma unroll
                for (int bj = 0; bj < 2; ++bj) { float v[8], g[8]; unpack8(*(const u32x4*)(gp + bj * HALF), g);
#pragma unroll
                    for (int i = 0; i < 4; ++i) { v[i] = acc[ai][bj][m][0][i] * g[i]; v[4 + i] = acc[ai][bj][m][1][i] * g[4 + i]; }
                    if (ADD) { float t[8]; unpack8(*(const u32x4*)(rowp + bj * HALF), t);
#pragma unroll
                        for (int i = 0; i < 8; ++i) v[i] += t[i];
                        int p0 = 0, p1 = 0; p0 = __builtin_amdgcn_cvt_pk_fp8_f32(v[0], v[1], p0, false); p0 = __builtin_amdgcn_cvt_pk_fp8_f32(v[2], v[3], p0, true);
                        p1 = __builtin_amdgcn_cvt_pk_fp8_f32(v[4], v[5], p1, false); p1 = __builtin_amdgcn_cvt_pk_fp8_f32(v[6], v[7], p1, true);
                        if (O8) *(u32x2e*)(O8 + (size_t)row * ld8 + col0 + bj * HALF) = (u32x2e){(unsigned)p0, (unsigned)p1}; else *(u32x4*)(rowp + bj * HALF) = pack8f(v); }
                    else *(u32x4*)(rowp + bj * HALF) = pack8f(v); } }
    }
};
struct EpiGate8 {
    static constexpr bool PERM = true, AFTER_DRAIN = false;
    const bf16_t* G1; int ldg; unsigned char* O8; int ld8;
    __device__ __forceinline__ void operator()(const f32x4 (&acc)[2][2][4][2], const Unit& u, int wr, int wc, int fr, int fq) const {
        const int row0 = u.pm * BM + wr * 64 + fr, col0 = u.pn * BM + wc * 32 + 8 * fq;
#pragma unroll
        for (int ai = 0; ai < 2; ++ai)
#pragma unroll
            for (int m = 0; m < 4; ++m) { const int row = row0 + ai * HALF + m * 16; const bf16_t* gp = G1 + (size_t)row * ldg + col0;
#pragma unroll
                for (int bj = 0; bj < 2; ++bj) { float v[8], g[8]; unpack8(*(const u32x4*)(gp + bj * HALF), g);
#pragma unroll
                    for (int i = 0; i < 4; ++i) { v[i] = acc[ai][bj][m][0][i] * g[i]; v[4 + i] = acc[ai][bj][m][1][i] * g[4 + i]; }
                    int p0 = 0, p1 = 0; p0 = __builtin_amdgcn_cvt_pk_fp8_f32(v[0], v[1], p0, false); p0 = __builtin_amdgcn_cvt_pk_fp8_f32(v[2], v[3], p0, true);
                    p1 = __builtin_amdgcn_cvt_pk_fp8_f32(v[4], v[5], p1, false); p1 = __builtin_amdgcn_cvt_pk_fp8_f32(v[6], v[7], p1, true);
                    *(u32x2e*)(O8 + (size_t)row * ld8 + col0 + bj * HALF) = (u32x2e){(unsigned)p0, (unsigned)p1}; } }
    }
};
struct EpiResid {
    static constexpr bool PERM = true, AFTER_DRAIN = false;
    const float* base32; const bf16_t* base16; bf16_t* XB; int ldc; float* rowss;
    __device__ __forceinline__ void operator()(const f32x4 (&acc)[2][2][4][2], const Unit& u, int wr, int wc, int fr, int fq) const {
        const int row0 = u.pm * BM + wr * 64 + fr, col0 = u.pn * BM + wc * 32 + 8 * fq;
#pragma unroll
        for (int ai = 0; ai < 2; ++ai)
#pragma unroll
            for (int m = 0; m < 4; ++m) { const int row = row0 + ai * HALF + m * 16; const size_t off = (size_t)row * ldc + col0; float ss = 0.f;
#pragma unroll
                for (int bj = 0; bj < 2; ++bj) { float b[8];
                    if (base32) { const f32x4 b0 = *(const f32x4*)(base32 + off + bj * HALF), b1 = *(const f32x4*)(base32 + off + bj * HALF + 4);
                        b[0] = b0[0]; b[1] = b0[1]; b[2] = b0[2]; b[3] = b0[3]; b[4] = b1[0]; b[5] = b1[1]; b[6] = b1[2]; b[7] = b1[3]; }
                    else unpack8(*(const u32x4*)(base16 + off + bj * HALF), b);
#pragma unroll
                    for (int i = 0; i < 4; ++i) { b[i] += acc[ai][bj][m][0][i]; b[4 + i] += acc[ai][bj][m][1][i]; }
#pragma unroll
                    for (int i = 0; i < 8; ++i) ss += b[i] * b[i];
                    *(u32x4*)(XB + off + bj * HALF) = pack8f(b); }
                ss += __shfl_xor(ss, 16); ss += __shfl_xor(ss, 32);
                if (fq == 0) atomicAdd(rowss + row, ss); }
    }
};
struct EpiAny {
    static constexpr bool PERM = true, AFTER_DRAIN = false;
    int kind; bf16_t* O; int ldc; const bf16_t* Gt; int ldg; const float* base; const bf16_t* base16; float* rowss; const float* rowss_in; int pn_off; unsigned char* O8; int ld8; const bf16_t* Gt2;
    __device__ __forceinline__ void mid(f32x4 (&acc)[2][2][4][2], const Unit& u, int wr, int wc, int fr, int fq) const {
        const int row0 = u.pm * BM + wr * 64 + fr, col0 = u.pn * BM + wc * 32 + 8 * fq;
#pragma unroll
        for (int ai = 0; ai < 2; ++ai)
#pragma unroll
            for (int m = 0; m < 4; ++m) { const int row = row0 + ai * HALF + m * 16; const bf16_t* g0p = Gt + (size_t)row * ldg + col0; const bf16_t* g1p = Gt2 + (size_t)row * ldg + col0;
#pragma unroll
                for (int bj = 0; bj < 2; ++bj) { float a[8], b[8]; unpack8(*(const u32x4*)(g0p + bj * HALF), a); unpack8(*(const u32x4*)(g1p + bj * HALF), b);
#pragma unroll
                    for (int i = 0; i < 4; ++i) { acc[ai][bj][m][0][i] *= a[i] * __builtin_amdgcn_rcpf(b[i]); acc[ai][bj][m][1][i] *= a[4 + i] * __builtin_amdgcn_rcpf(b[4 + i]); } }
                if (m & 1) asm volatile("" ::: "memory"); }
    }
    __device__ __forceinline__ void operator()(f32x4 (&acc)[2][2][4][2], const Unit& u, int wr, int wc, int fr, int fq) const {
        if (kind == 7 && u.kp == 0) { mid(acc, u, wr, wc, fr, fq); return; }
        if (kind == 0) { EpiProj e{O, ldc, pn_off}; e(acc, u, wr, wc, fr, fq); }
        else if (kind == 1) { EpiRowScale e{O, ldc, rowss_in, 1.f / 2048.f, 1e-6f}; e(acc, u, wr, wc, fr, fq); }
        else if (kind == 2) { EpiGate<false> e{O, ldc, Gt, ldg, nullptr, 0}; e(acc, u, wr, wc, fr, fq); }
        else if (kind == 3) { EpiGate<true> e{O, ldc, Gt, ldg, O8, ld8}; e(acc, u, wr, wc, fr, fq); }
        else if (kind == 6) { EpiGate<true> e{O, ldc, Gt, ldg, nullptr, 0}; e(acc, u, wr, wc, fr, fq); }
        else if (kind == 7) { EpiGate8 e{Gt2, ldg, O8, ld8}; e(acc, u, wr, wc, fr, fq); }
        else { EpiResid e{base, base16, O, ldc, rowss}; e(acc, u, wr, wc, fr, fq); }
    }
};
}
#ifndef ATT_QREG
#define ATT_QREG 1
#endif
namespace att {
using bf16 = unsigned short;
typedef short bf16x8 __attribute__((ext_vector_type(8)));
typedef short s16x4 __attribute__((ext_vector_type(4)));
typedef float f32x16 __attribute__((ext_vector_type(16)));
typedef float f32x4 __attribute__((ext_vector_type(4)));
typedef unsigned u32x4 __attribute__((ext_vector_type(4)));
constexpr int D = 128, NW = 8, QBLK = 32, KVBLK = 64, QB = NW * QBLK;
constexpr int SHM_V = KVBLK * D * 2, SHM_K = KVBLK * D * 2;
constexpr int LDS_WS = 2 * SHM_V + 2 * SHM_K;
constexpr int LDS_BIAS = LDS_WS + NW * 64 * 4;
constexpr int LDS_Q = LDS_BIAS + 2048 * 4;
constexpr int LDS_BYTES = LDS_Q + NW * 8192;
constexpr float THR = 8.f;

#define KSWZ(row, colB) ((row) * 256 + ((colB) ^ (((row) & 7) << 4)))
#define SBAR() __builtin_amdgcn_sched_barrier(0)
__device__ __forceinline__ int v_st(int k, int c) { const int kk = (k & ~0xC) | ((k & 4) << 1) | ((k & 8) >> 1); return ((kk >> 3) * 4 + (c >> 5)) * 512 + ((kk & 7) * 32 + (c & 31)) * 2; }
__device__ __forceinline__ int v_rd_base(int lane) { return ((lane & 3) << 3) | (((lane >> 2) & 3) << 6) | (((lane >> 4) & 1) << 5) | (((lane >> 5) & 1) << 8); }
constexpr int v_rd_off(int d0, int ks, int half) { return d0 * 512 + ks * 4096 + half * 2048; }
__device__ __forceinline__ int crow(int r, int hi) { return (r & 3) + 8 * (r >> 2) + 4 * hi; }
__device__ __forceinline__ unsigned cvtpk(float lo, float hi) { unsigned r; asm volatile("v_cvt_pk_bf16_f32 %0, %1, %2" : "=v"(r) : "v"(lo), "v"(hi)); return r; }
__device__ __forceinline__ bf16x8 load8(const bf16* p) { return *reinterpret_cast<const bf16x8*>(p); }
__device__ __forceinline__ float bf2f(unsigned short b) { return __uint_as_float((unsigned)b << 16); }

__device__ __forceinline__ void mask_tile(f32x16& p0, f32x16& p1, int dq) {
    const float NEG = -__builtin_inff();
#pragma unroll
    for (int r = 0; r < 16; ++r) {
        const int c = (r & 3) + 8 * (r >> 2);
        if (dq - c < 0) p0[r] = NEG;
        if (dq - c - 32 < 0) p1[r] = NEG;
    }
}
__device__ __forceinline__ void partialSM(f32x16& p0, f32x16& p1, float& m_reg, float& mn, float& alpha) {
    float pmax = p0[0]; for (int r = 1; r < 16; ++r) pmax = fmaxf(pmax, p0[r]); for (int r = 0; r < 16; ++r) pmax = fmaxf(pmax, p1[r]);
    { auto rr = __builtin_amdgcn_permlane32_swap(__float_as_uint(pmax), __float_as_uint(pmax), false, false);
      pmax = fmaxf(__uint_as_float(rr[0]), __uint_as_float(rr[1])); }
    if (__builtin_expect(__all((pmax - m_reg) <= THR), 1)) { mn = m_reg; alpha = 1.f; }
    else { mn = fmaxf(m_reg, pmax); alpha = __builtin_amdgcn_exp2f(m_reg - mn); m_reg = mn; }
    for (int r = 0; r < 16; ++r) p0[r] = p0[r] - mn; for (int r = 0; r < 16; ++r) p1[r] = p1[r] - mn;
    for (int r = 0; r < 16; ++r) p0[r] = __builtin_amdgcn_exp2f(p0[r]);
}
#define ATT_PK4(P, B_, OUT) do { unsigned a0 = cvtpk(P[B_+0], P[B_+1]), a1 = cvtpk(P[B_+2], P[B_+3]);                          \
        unsigned b0 = cvtpk(P[B_+4], P[B_+5]), b1 = cvtpk(P[B_+6], P[B_+7]);                                             \
        auto r0 = __builtin_amdgcn_permlane32_swap(a0, b0, false, false); auto r1 = __builtin_amdgcn_permlane32_swap(a1, b1, false, false); \
        u32x4 w = {r0[0], r1[0], r0[1], r1[1]}; OUT = *reinterpret_cast<bf16x8*>(&w); } while (0)
__device__ __forceinline__ void finishSM(f32x16& p0, f32x16& p1, float alpha, float& l_reg, bf16x8& pa0, bf16x8& pa1, bf16x8& pa2, bf16x8& pa3) {
    for (int r = 0; r < 16; ++r) p1[r] = __builtin_amdgcn_exp2f(p1[r]);
    float ps = 0; for (int r = 0; r < 16; ++r) ps += p0[r]; for (int r = 0; r < 16; ++r) ps += p1[r];
    { auto rr = __builtin_amdgcn_permlane32_swap(__float_as_uint(ps), __float_as_uint(ps), false, false);
      ps = __uint_as_float(rr[0]) + __uint_as_float(rr[1]); }
    l_reg = l_reg * alpha + ps;
    ATT_PK4(p0, 0, pa0); ATT_PK4(p0, 8, pa1); ATT_PK4(p1, 0, pa2); ATT_PK4(p1, 8, pa3);
}
__device__ __forceinline__ void ret_weight(f32x16& p0, f32x16& p1, int dq, float lg, int dist) {
    if (dist < 0) { p0 = f32x16{}; p1 = f32x16{}; return; }
    if (dist > 0) { const float f = __builtin_amdgcn_exp2f(lg * 64.f * (float)dist);
#pragma unroll
        for (int r = 0; r < 16; ++r) { p0[r] *= f; p1[r] *= f; }
        return; }
#pragma unroll
    for (int r = 0; r < 16; ++r) {
        const int c = (r & 3) + 8 * (r >> 2);
        const float e0 = 2.f * lg * fmaxf((float)(c - dq), 0.f), e1 = 2.f * lg * fmaxf((float)(c + 32 - dq), 0.f);
        p0[r] *= __builtin_amdgcn_exp2f(e0); p1[r] *= __builtin_amdgcn_exp2f(e1);
    }
}
__device__ __forceinline__ void ret_pack(f32x16& p0, f32x16& p1, bf16x8& pa0, bf16x8& pa1, bf16x8& pa2, bf16x8& pa3) {
    ATT_PK4(p0, 0, pa0); ATT_PK4(p0, 8, pa1); ATT_PK4(p1, 0, pa2); ATT_PK4(p1, 8, pa3);
}
template <int KB, bool BIAS>
__device__ __forceinline__ void qkt(f32x16& p0, f32x16& p1, const char* K_lds, int r32, int hi, const char* Qw  , const float* bias_tile  , const bf16x8* qr = nullptr) {
    if (BIAS) {
#pragma unroll
        for (int g = 0; g < 4; ++g) { const f32x4 b0 = *(const f32x4*)(bias_tile + 8 * g), b1 = *(const f32x4*)(bias_tile + 32 + 8 * g);
            p0[4 * g] = b0[0]; p0[4 * g + 1] = b0[1]; p0[4 * g + 2] = b0[2]; p0[4 * g + 3] = b0[3];
            p1[4 * g] = b1[0]; p1[4 * g + 1] = b1[1]; p1[4 * g + 2] = b1[2]; p1[4 * g + 3] = b1[3]; }
    } else { p0 = f32x16{}; p1 = f32x16{}; }
    int ko[4];
#pragma unroll
    for (int dd = 0; dd < 4; ++dd) ko[dd] = KSWZ(r32, (dd * 16 + hi * 8) * 2);
#pragma unroll
    for (int d0 = 0; d0 < 8; ++d0) { const char* a = K_lds + KB * SHM_K + ko[d0 & 3] + (d0 >> 2) * 128;
        bf16x8 b0 = *reinterpret_cast<const bf16x8*>(a);
        bf16x8 b1 = *reinterpret_cast<const bf16x8*>(a + 32 * 256);
#if ATT_QREG
        bf16x8 q = qr[d0];
#else
        bf16x8 q = *reinterpret_cast<const bf16x8*>(Qw + ko[d0 & 3] + (d0 >> 2) * 128);
#endif
        p0 = __builtin_amdgcn_mfma_f32_32x32x16_bf16(b0, q, p0, 0, 0, 0);
        p1 = __builtin_amdgcn_mfma_f32_32x32x16_bf16(b1, q, p1, 0, 0, 0); }
}
template <int VB>
__device__ __forceinline__ void pv_tile(f32x16* o, int vb0, bf16x8 pa0, bf16x8 pa1, bf16x8 pa2, bf16x8 pa3) {
#define TRRD(dst, off) asm volatile("ds_read_b64_tr_b16 %0, %1 offset:%2" : "=&v"(dst) : "v"(vb0), "i"(off) : "memory")
#define PV_D0(d0) do { s16x4 l0, l1, l2, l3, h0, h1, h2, h3; constexpr int b_ = VB * SHM_V + v_rd_off(d0, 0, 0); \
        TRRD(l0, b_); TRRD(h0, b_ + 2048); TRRD(l1, b_ + 4096); TRRD(h1, b_ + 6144); TRRD(l2, b_ + 8192); TRRD(h2, b_ + 10240); TRRD(l3, b_ + 12288); TRRD(h3, b_ + 14336); \
        asm volatile("s_waitcnt lgkmcnt(0)" ::: "memory"); SBAR();   \
        o[d0] = __builtin_amdgcn_mfma_f32_32x32x16_bf16(pa0, (bf16x8){l0[0], l0[1], l0[2], l0[3], h0[0], h0[1], h0[2], h0[3]}, o[d0], 0, 0, 0);   \
        o[d0] = __builtin_amdgcn_mfma_f32_32x32x16_bf16(pa1, (bf16x8){l1[0], l1[1], l1[2], l1[3], h1[0], h1[1], h1[2], h1[3]}, o[d0], 0, 0, 0);   \
        o[d0] = __builtin_amdgcn_mfma_f32_32x32x16_bf16(pa2, (bf16x8){l2[0], l2[1], l2[2], l2[3], h2[0], h2[1], h2[2], h2[3]}, o[d0], 0, 0, 0);   \
        o[d0] = __builtin_amdgcn_mfma_f32_32x32x16_bf16(pa3, (bf16x8){l3[0], l3[1], l3[2], l3[3], h3[0], h3[1], h3[2], h3[3]}, o[d0], 0, 0, 0); } while (0)
    PV_D0(0); PV_D0(1); PV_D0(2); PV_D0(3);
#undef PV_D0
#undef TRRD
}

struct BlockRef { const bf16* Q; const bf16* K; const bf16* V; bf16* O; int P0; int skv; float lg; const bf16* RG; const float* GN; unsigned char* O8;   };
struct Seam { bf16x8 qr[8]; bf16x8 st_v0, st_v1, st_k0, st_k1; };
template <int MODE> struct Pitch { static constexpr int LDQ = (MODE == 2) ? 512 : 11264, LDK = (MODE == 2) ? 1024 : 11264, LDO = LDQ; };

#define ROWK(p, k0, rr) ((p) + (size_t)((k0) + (rr)) * LDK + sc)
#define VMW() asm volatile("s_waitcnt vmcnt(0)" ::: "memory")
#define VMWN(n) asm volatile("s_waitcnt vmcnt(%0)" :: "i"(n) : "memory")
#define SLOAD_H(Kp, Vp, k0) do { S.st_v0 = load8(ROWK(Vp, k0, sr)); S.st_v1 = load8(ROWK(Vp, k0, 32 + sr));              \
                         S.st_k0 = load8(ROWK(Kp, k0, sr)); S.st_k1 = load8(ROWK(Kp, k0, 32 + sr)); } while (0)
#define SWRITE_HK(bf) do { *(bf16x8*)(K_lds + (bf) * SHM_K + kws) = S.st_k0; *(bf16x8*)(K_lds + (bf) * SHM_K + kws + 32 * 256) = S.st_k1; } while (0)
#define SWRITE_HV(bf) do { *(bf16x8*)(V_lds + (bf) * SHM_V + vst0) = S.st_v0; *(bf16x8*)(V_lds + (bf) * SHM_V + vst1) = S.st_v1; } while (0)
#define SWRITE_H(bf) do { SWRITE_HV(bf); SWRITE_HK(bf); } while (0)

template <int MODE>
__device__ __forceinline__ void attn_prime(const BlockRef& cur, char* lds, Seam& S) {
    constexpr int LDQ = Pitch<MODE>::LDQ, LDK = Pitch<MODE>::LDK;
    int tid_ = threadIdx.x; asm volatile("" : "+v"(tid_));
    const int tid = tid_, wid = __builtin_amdgcn_readfirstlane(tid >> 6), lane = tid & 63, r32 = lane & 31, hi = lane >> 5;
    const int sr = tid >> 4, sc = (tid & 15) * 8, kws = KSWZ(sr, sc * 2); char* K_lds = lds + 2 * SHM_V;
    const int kb0 = 0;
    for (int d0 = 0; d0 < 8; ++d0) S.qr[d0] = load8(cur.Q + (size_t)(wid * QBLK + r32) * LDQ + d0 * 16 + hi * 8);
    SLOAD_H(cur.K, cur.V, kb0); VMW(); SWRITE_HK(0);
    __syncthreads();
}
template <int MODE>
__device__ __forceinline__ void attn_block(const BlockRef& cur, const BlockRef& nxt, char* lds, Seam& S) {
    constexpr int LDQ = Pitch<MODE>::LDQ, LDK = Pitch<MODE>::LDK, LDO = Pitch<MODE>::LDO;
    constexpr bool BIAS = (MODE == 0), SOFTMAX = (MODE != 1);
    int tid_ = threadIdx.x; asm volatile("" : "+v"(tid_));
    const int tid = tid_, wid = __builtin_amdgcn_readfirstlane(tid >> 6), lane = tid & 63, r32 = lane & 31, hi = lane >> 5;
    const int j_lo = 0;
    int j_hi = (cur.P0 + QB - 1) / KVBLK + 1; if (j_hi > cur.skv / KVBLK) j_hi = cur.skv / KVBLK;
    const int NT = j_hi - j_lo;
    const int kbn = 0;
    const int qlo = cur.P0 + wid * QBLK, qm = qlo + r32 - 4 * hi;
    char* V_lds = lds; char* K_lds = lds + 2 * SHM_V;
    float* ws = (float*)(lds + LDS_WS) + wid * 64; float* li_l = ws, * al_l = ws + 32;
    const float* bias = (const float*)(lds + LDS_BIAS) + 4 * hi;
    float m_reg = -1e30f, l_reg = 0; f32x16 o[4] = {};
    const int sr = tid >> 4, sc = (tid & 15) * 8, vst0 = v_st(sr, sc), vst1 = v_st(32 + sr, sc), kws = KSWZ(sr, sc * 2);
    const int vb0 = (int)(uintptr_t)V_lds + v_rd_base(lane);
    const bf16* Kh = cur.K; const bf16* Vh = cur.V;
    const float lg = cur.lg; const int cq = qlo >> 6;
#define RESC(a) do { if (SOFTMAX) { if (__any((a) < 1.f)) { if (hi == 0) al_l[r32] = (a); asm volatile("s_waitcnt lgkmcnt(0)" ::: "memory");              \
                     for (int d_ = 0; d_ < 4; ++d_) for (int r = 0; r < 16; ++r) o[d_][r] *= al_l[crow(r, hi)]; } } } while (0)
#define KBASE(t) ((j_lo + (t)) * KVBLK)
#define POSTQK(P0_, P1_, mnX, alX, t) do { const int kb_ = KBASE(t); \
        if (MODE == 1) { ret_weight(P0_, P1_, qm - kb_, lg, cq - (j_lo + (t))); } \
        else { if (MODE == 0 && (kb_ + KVBLK - 1 > qlo)) mask_tile(P0_, P1_, qm - kb_); partialSM(P0_, P1_, m_reg, mnX, alX); } } while (0)
#define FINISH(P0_, P1_, alX) do { if (MODE == 1) ret_pack(P0_, P1_, pa0, pa1, pa2, pa3); else finishSM(P0_, P1_, alX, l_reg, pa0, pa1, pa2, pa3); } while (0)
    constexpr int NQL = 8;
#define SEAM_K0() do { VMWN(NQL); SWRITE_HK(0); SBAR(); } while (0)
    f32x16 pA0, pA1, pB0, pB1; float mnA = 0.f, mnB = 0.f, alA = 1.f, alB = 1.f; bf16x8 pa0, pa1, pa2, pa3;
    char* Qw = lds + LDS_Q + wid * 8192;
#if ATT_QREG
    const bf16x8* QR = S.qr;
#else
    const bf16x8* QR = nullptr;
#pragma unroll
    for (int d0 = 0; d0 < 8; ++d0) *(bf16x8*)(Qw + KSWZ(r32, (d0 * 16 + hi * 8) * 2)) = S.qr[d0];
#endif
    SWRITE_HV(0); SBAR();
    if (NT > 1) { SLOAD_H(Kh, Vh, KBASE(1)); }
    SBAR(); qkt<0, BIAS>(pA0, pA1, K_lds, r32, hi, Qw, bias + KBASE(0), QR);
    POSTQK(pA0, pA1, mnA, alA, 0);
    if (NT > 1) { VMW(); SWRITE_H(1); }
    __syncthreads();
#define HALF_STEP(PX0, PX1, mnX, alX, PY0, PY1, alY, t, KB, VB, SB) do {                                                      \
        SBAR(); qkt<KB, BIAS>(PX0, PX1, K_lds, r32, hi, Qw, bias + KBASE(t), QR);                                             \
        FINISH(PY0, PY1, alY); SBAR();                                                           \
        if ((t) + 1 < NT) { SLOAD_H(Kh, Vh, KBASE((t) + 1)); SBAR(); }                                               \
        pv_tile<VB>(o, vb0, pa0, pa1, pa2, pa3); POSTQK(PX0, PX1, mnX, alX, (t));                                        \
        __syncthreads();                                                                                                      \
        if ((t) + 1 < NT) { VMW(); SWRITE_H(SB); }                                                                          \
        RESC(alX); __syncthreads(); } while (0)
    for (int t = 1; t + 1 < NT; t += 2) {
        HALF_STEP(pB0, pB1, mnB, alB, pA0, pA1, alA, t, 1, 0, 0);
        HALF_STEP(pA0, pA1, mnA, alA, pB0, pB1, alB, t + 1, 0, 1, 1);
    }
    const bool even = (NT & 1) == 0;
    if (even) { SBAR(); qkt<1, BIAS>(pB0, pB1, K_lds, r32, hi, Qw, bias + KBASE(NT - 1), QR); SBAR(); }
    { constexpr int LDQn = LDQ; SLOAD_H(nxt.K, nxt.V, kbn); SBAR();
#pragma unroll
      for (int d0 = 0; d0 < 8; ++d0) S.qr[d0] = load8(nxt.Q + (size_t)(wid * QBLK + r32) * LDQn + d0 * 16 + hi * 8); }
    SBAR();
    FINISH(pA0, pA1, alA); SBAR();
    pv_tile<0>(o, vb0, pa0, pa1, pa2, pa3);
    if (even) { POSTQK(pB0, pB1, mnB, alB, NT - 1); __syncthreads(); RESC(alB);
        FINISH(pB0, pB1, alB); SBAR(); pv_tile<1>(o, vb0, pa0, pa1, pa2, pa3); }
    SBAR(); SEAM_K0();
    bf16* Ow = cur.O + (size_t)(wid * QBLK) * LDO;
    if (MODE != 1) {
        if (hi == 0) li_l[r32] = l_reg; asm volatile("s_waitcnt lgkmcnt(0)" ::: "memory");
        float rli[16];
#pragma unroll
        for (int r = 0; r < 16; ++r) rli[r] = __builtin_amdgcn_rcpf(li_l[crow(r, hi)]);
#pragma unroll
        for (int r = 0; r < 16; ++r) { const int orow = crow(r, hi);
#pragma unroll
            for (int d0 = 0; d0 < 4; ++d0) { const float v = o[d0][r] * rli[r];
                const float vn = __shfl_xor(v, 1);
                if (cur.O8) { const int pk = __builtin_amdgcn_cvt_pk_fp8_f32(v, vn, 0, false); const int pk2 = __shfl_xor(pk, 2);
                    if ((r32 & 3) == 0) *(unsigned*)(cur.O8 + (size_t)(wid * QBLK + orow) * (MODE == 2 ? 512 : 2048) + d0 * 32 + r32) = ((unsigned)pk & 0xFFFFu) | ((unsigned)pk2 << 16); }
                else if ((r32 & 1) == 0) *(unsigned*)(Ow + (size_t)orow * LDO + d0 * 32 + r32) = cvtpk(v, vn); } }
    } else {
        float gn[4];
#pragma unroll
        for (int d0 = 0; d0 < 4; ++d0) gn[d0] = cur.GN[d0 * 32 + r32];
        const bf16* RGw = cur.RG + (size_t)(wid * QBLK) * LDO;
#pragma unroll
        for (int r = 0; r < 16; ++r) { const int orow = crow(r, hi);
            float s = (o[0][r] + o[1][r]) + (o[2][r] + o[3][r]);
#pragma unroll
            for (int x = 1; x < 32; x <<= 1) s += __shfl_xor(s, x);
            const float mean = s * (1.f / 128.f);
            float q = 0.f;
#pragma unroll
            for (int d0 = 0; d0 < 4; ++d0) { const float dlt = o[d0][r] - mean; q += dlt * dlt; }
#pragma unroll
            for (int x = 1; x < 32; x <<= 1) q += __shfl_xor(q, x);
            const float rstd = 1.f / sqrtf(q * (1.f / 128.f) + 1e-6f);
#pragma unroll
            for (int d0 = 0; d0 < 4; ++d0) { const float g = bf2f(RGw[(size_t)orow * LDO + d0 * 32 + r32]);
                const float v = (o[d0][r] - mean) * rstd * gn[d0] * g;
                const float vn = __shfl_xor(v, 1);
                if (cur.O8) { const int pk = __builtin_amdgcn_cvt_pk_fp8_f32(v, vn, 0, false); const int pk2 = __shfl_xor(pk, 2);
                    if ((r32 & 3) == 0) *(unsigned*)(cur.O8 + (size_t)(wid * QBLK + orow) * 2048 + d0 * 32 + r32) = ((unsigned)pk & 0xFFFFu) | ((unsigned)pk2 << 16); }
                else if ((r32 & 1) == 0) *(unsigned*)(Ow + (size_t)orow * LDO + d0 * 32 + r32) = cvtpk(v, vn); } }
    }
    __syncthreads();
#undef RESC
#undef KBASE
#undef POSTQK
#undef FINISH
#undef SEAM_K0
#undef HALF_STEP
}
#undef ROWK
#undef VMW
#undef VMWN
#undef SLOAD_H
#undef SWRITE_HK
#undef SWRITE_HV
#undef SWRITE_H
#undef SBAR
#undef KSWZ
#undef ATT_PK4
}
#define GAS __attribute__((address_space(1)))
#define LAS __attribute__((address_space(3)))
typedef unsigned short bf16;
typedef unsigned v4u __attribute__((ext_vector_type(4)));
typedef float f32x4 __attribute__((ext_vector_type(4)));
typedef short bf16x8 __attribute__((ext_vector_type(8)));
typedef GAS unsigned gu32;
typedef GAS unsigned long long gu64;
#define RLX_AGENT __ATOMIC_RELAXED, __HIP_MEMORY_SCOPE_AGENT
#define LDS_WAIT() asm volatile("s_waitcnt lgkmcnt(0)" ::: "memory")
#define VM_WAIT() asm volatile("s_waitcnt vmcnt(0)" ::: "memory")
__device__ __forceinline__ unsigned long long rt() { return __builtin_amdgcn_s_memrealtime(); }
__device__ __forceinline__ unsigned f2bf(float f) { unsigned u = __builtin_bit_cast(unsigned, f); return (u + 0x7fffu + ((u >> 16) & 1u)) >> 16; }
__device__ __forceinline__ unsigned pk2(float lo, float hi) { return f2bf(lo) | (f2bf(hi) << 16); }

#define XB_TMO      128
#define XB_XCNT(j)  (256  + 64 * (j))
#define XB_XSUB(j)  (1280 + 64 * (j))
#define XB_XGEN(j)  (2304 + 64 * (j))
#define XB_TOP      3328
#define XB_TOPGEN   3392
#define XCD_BAR_WORDS 3456
#define XB_SPIN_CAP (1u << 18)

__device__ __forceinline__ unsigned xb_ld(unsigned* p)              { return __hip_atomic_load(p, __ATOMIC_RELAXED, __HIP_MEMORY_SCOPE_AGENT); }
__device__ __forceinline__ unsigned xb_add(unsigned* p, unsigned v) { return __hip_atomic_fetch_add(p, v, __ATOMIC_RELAXED, __HIP_MEMORY_SCOPE_AGENT); }
__device__ __forceinline__ unsigned xb_xcc_id() { return (unsigned)__builtin_amdgcn_s_getreg((3 << 11) | 20) & 0xFu; }
#define XB_SPIN(cond, bar) do { unsigned _sp = 0; while (cond) { __builtin_amdgcn_s_sleep(1); \
    if ((++_sp & 255u) == 0u) { if (xb_ld(&(bar)[XB_TMO])) break; if (_sp > XB_SPIN_CAP) { atomicAdd(&(bar)[XB_TMO], 1u); break; } } } } while (0)

struct XcdBarrier {
    unsigned* bar; unsigned x;
    volatile LAS unsigned* st;
};

__device__ __forceinline__ XcdBarrier xcd_barrier_post(unsigned* bar, volatile LAS unsigned* st) {
    XcdBarrier b; b.bar = bar; b.x = xb_xcc_id(); b.st = st;
    if (threadIdx.x == 0) (void)xb_add(&bar[XB_XCNT(b.x)], 1u);
    return b;
}
__device__ __forceinline__ void xcd_barrier_complete(unsigned* bar, unsigned x, unsigned& nloc, unsigned& nx) {
    const unsigned G = gridDim.x * gridDim.y * gridDim.z;
    unsigned sum, cnt, mine, sp = 0u;
    for (;;) {
        sum = 0u; cnt = 0u; mine = 0u;
#pragma unroll
        for (unsigned j = 0; j < 16; ++j) { const unsigned c = xb_ld(&bar[XB_XCNT(j)]); sum += c; cnt += (c > 0u) ? 1u : 0u; mine = (j == x) ? c : mine; }
        if (sum == G) break;
        __builtin_amdgcn_s_sleep(1);
        if ((++sp & 255u) == 0u) { if (xb_ld(&bar[XB_TMO])) break; if (sp > XB_SPIN_CAP) { atomicAdd(&bar[XB_TMO], 1u); break; } }
    }
    nloc = mine > 0u ? mine : 1u; nx = cnt > 0u ? cnt : 1u;
}

__device__ __forceinline__ void xcd_barrier(const XcdBarrier& b) {
    asm volatile("s_waitcnt vmcnt(0)" ::: "memory");
    __syncthreads();
    if (threadIdx.x == 0) {
        unsigned* bar = b.bar;
        __builtin_amdgcn_s_waitcnt(0);
        unsigned nloc = b.st[0], nx = b.st[1];
        if (nloc == 0u) { xcd_barrier_complete(bar, b.x, nloc, nx); b.st[0] = nloc; b.st[1] = nx; }
        const unsigned old = xb_add(&bar[XB_XSUB(b.x)], 1u);
        const unsigned gen = old / nloc;
        if (old + 1u == (gen + 1u) * nloc) {
            __builtin_amdgcn_fence(__ATOMIC_RELEASE, "agent");
            asm volatile("s_waitcnt vmcnt(0)" ::: "memory");
            const unsigned og = xb_add(&bar[XB_TOP], 1u);
            const unsigned tg = og / nx;
            if (og + 1u == (tg + 1u) * nx) xb_add(&bar[XB_TOPGEN], 1u);
            else XB_SPIN(xb_ld(&bar[XB_TOPGEN]) == tg, bar);
            __builtin_amdgcn_fence(__ATOMIC_ACQUIRE, "agent");
            xb_add(&bar[XB_XGEN(b.x)], 1u);
            asm volatile("s_waitcnt vmcnt(0)" ::: "memory");
        } else {
            XB_SPIN(xb_ld(&bar[XB_XGEN(b.x)]) == gen, bar);
            __builtin_amdgcn_fence(__ATOMIC_ACQUIRE, "agent");
            asm volatile("s_waitcnt vmcnt(0)" ::: "memory");
        }
    }
    __syncthreads();
}
constexpr int NWAVES = 8;
constexpr int M_TOK = 16384, DM = 2048, SEQ = 2048, NB = 8;
constexpr int PP = 11264;
constexpr int C_RQ = 0, C_RK = 1024, C_FQ = 2048, C_FK = 3072, C_FV = 4096, C_RV = 5120, C_RG = 6144, C_G0 = 7168, C_G1 = 9216;
constexpr int N_QK = 2048, N_REST = 9216;
#ifndef FP8_UP_OUT
#define FP8_UP_OUT 1
#endif
constexpr int W8_SCALE_B = 0x79797979;
constexpr int N_IN_ORIG = 11272;
constexpr float RMS_EPS = 1e-6f;
constexpr float QK_C2 = 0.08838834764831845f * 1.4426950408889634f;
constexpr size_t MiB = 1u << 20;
constexpr size_t DO_XN8 = 0, DO_OCAT8 = 32 * MiB;
constexpr size_t DO_OFOX8 = DO_OCAT8, DO_ORET8 = DO_OCAT8 + 1024;
constexpr size_t WS_CTL = 0, CTL_ZERO_BYTES = 1 * MiB;
constexpr size_t WS_ROWSS1 = 256 * 1024, WS_ROWSS2 = 512 * 1024;
constexpr size_t WS_WIN = 1 * MiB, WS_WFOX = 45 * MiB, WS_WRET = 49 * MiB, WS_WOUT = 53 * MiB, WS_WMQ = 61 * MiB, WS_WMKV = 63 * MiB, WS_WMO = 67 * MiB, WS_WPQ = 69 * MiB, WS_SUBK = 77 * MiB;
constexpr size_t WS_PSCALE = 79 * MiB;
constexpr size_t WS_LOGF = 78 * MiB, WS_CUMF = 78 * MiB + 512 * 1024;
constexpr size_t WS_XN = 80 * MiB;
constexpr size_t WS_PROJ = 144 * MiB;
constexpr size_t WS_MN = 496 * MiB, WS_KVM = 504 * MiB, WS_END = 508 * MiB;
constexpr size_t WS_XB1B = 144 * MiB;
constexpr size_t WS_XB2 = FP8_UP_OUT ? WS_XB1B : WS_XN;
constexpr size_t WS_XB1 = FP8_UP_OUT ? WS_XN   : WS_XB1B, WS_QM = 208 * MiB, WS_OMEM = 224 * MiB, WS_PU = 240 * MiB, WS_PV = 304 * MiB, WS_QP = (FP8_UP_OUT ? 368 : 144) * MiB  , WS_IDX = 208 * MiB, WS_GATE = 216 * MiB;
constexpr int CW_BAR = 4096, CW_CONV = 64;
constexpr int RING_BYTES = 131072, LDS_BYTES = 147456, LDSCTL_OFF = LDS_BYTES - 1024, MISC_OFF = LDSCTL_OFF + 320;
static_assert(att::LDS_BYTES <= LDSCTL_OFF, "attention LDS");

struct Args { const float* in[23]; float* out; unsigned char* ws; int ph_lo, ph_hi; int p0_mask, pad; };
enum { I_X = 0, I_MEM, I_LN_MIX, I_W_IN, I_B_FORGET, I_FOXQ_G, I_FOXK_G, I_RET_G, I_W_FOXUP, I_W_RETUP, I_W_OUT, I_LN_MEM, I_MEMNORM_G, I_W_MQ, I_W_MKV, I_MEMQ_G, I_MEMK_G, I_W_MO, I_LN_FFN, I_W_PQ, I_SUBK, I_PEER_U, I_PEER_V };

__device__ __forceinline__ float wave_sum(float v) {
#pragma unroll
    for (int o = 1; o < 64; o <<= 1) v += __shfl_xor(v, o);
    return v;
}
__device__ __forceinline__ void transpose_item(const float* W, int ldw, int K, int src_col0, const float* kgain, bf16* WT, int dst_row0, LAS float* scr, int kb, int nb, int lane) {
    const int k0 = 64 * kb, n0 = 32 * nb;
    f32x4 ld[8];
#pragma unroll
    for (int i = 0; i < 8; ++i) ld[i] = *(const GAS f32x4*)(W + (size_t)(k0 + 8 * i + (lane >> 3)) * ldw + src_col0 + n0 + 4 * (lane & 7));
#pragma unroll
    for (int i = 0; i < 8; ++i) { const int kk = 8 * i + (lane >> 3); f32x4 v = ld[i]; if (kgain) v = v * kgain[k0 + kk]; LAS float* d = scr + kk * 33 + 4 * (lane & 7); d[0] = v.x; d[1] = v.y; d[2] = v.z; d[3] = v.w; }
    LDS_WAIT(); asm volatile("" ::: "memory");
    const int c = lane & 7;
#pragma unroll
    for (int j = 0; j < 4; ++j) { const int n = (lane >> 3) + 8 * j; const LAS float* s = scr + (8 * c) * 33 + n;
        v4u o; o.x = pk2(s[0 * 33], s[1 * 33]); o.y = pk2(s[2 * 33], s[3 * 33]); o.z = pk2(s[4 * 33], s[5 * 33]); o.w = pk2(s[6 * 33], s[7 * 33]);
        *(GAS v4u*)(WT + (size_t)(dst_row0 + n0 + n) * K + k0 + 8 * c) = o; }
    LDS_WAIT(); asm volatile("" ::: "memory");
}
__device__ __forceinline__ void transpose_item8(const float* W, int ldw, int K  , int src_col0, unsigned char* WT8  , int kb, int nb, LAS float* scr, int lane) {
    const int k0 = 64 * kb, n0 = 32 * nb;
    f32x4 ld[8];
#pragma unroll
    for (int i = 0; i < 8; ++i) ld[i] = *(const GAS f32x4*)(W + (size_t)(k0 + 8 * i + (lane >> 3)) * ldw + src_col0 + n0 + 4 * (lane & 7));
#pragma unroll
    for (int i = 0; i < 8; ++i) { const int kk = 8 * i + (lane >> 3); const f32x4 v = ld[i] * 64.f; LAS float* d = scr + kk * 33 + 4 * (lane & 7); d[0] = v.x; d[1] = v.y; d[2] = v.z; d[3] = v.w; }
    LDS_WAIT(); asm volatile("" ::: "memory");
    const int c = lane & 7;
#pragma unroll
    for (int j = 0; j < 4; ++j) { const int n = (lane >> 3) + 8 * j; const LAS float* s = scr + (8 * c) * 33 + n;
        int p0 = 0, p1 = 0; p0 = __builtin_amdgcn_cvt_pk_fp8_f32(s[0 * 33], s[1 * 33], p0, false); p0 = __builtin_amdgcn_cvt_pk_fp8_f32(s[2 * 33], s[3 * 33], p0, true);
        p1 = __builtin_amdgcn_cvt_pk_fp8_f32(s[4 * 33], s[5 * 33], p1, false); p1 = __builtin_amdgcn_cvt_pk_fp8_f32(s[6 * 33], s[7 * 33], p1, true);
        *(GAS unsigned long long*)(WT8 + (size_t)(n0 + n) * K + k0 + 8 * c) = (unsigned long long)(unsigned)p0 | ((unsigned long long)(unsigned)p1 << 32); }
    LDS_WAIT(); asm volatile("" ::: "memory");
}
struct TJob { const float* W; int ldw, K, N; const float* gain; bf16* WT; int fp8; };

__device__ __forceinline__ void rms_row_to_bf16(const float* xrow, const float* gain, bf16* orow, int lane, f32x4 (&hv)[8], unsigned char* orow8 = nullptr) {
    const GAS f32x4* xr = (const GAS f32x4*)xrow + lane; float s = 0.f;
#pragma unroll
    for (int j = 0; j < 8; ++j) { hv[j] = xr[64 * j]; s += (hv[j].x * hv[j].x + hv[j].y * hv[j].y) + (hv[j].z * hv[j].z + hv[j].w * hv[j].w); }
    const float r = 1.f / sqrtf(wave_sum(s) * (1.f / DM) + RMS_EPS);
    GAS unsigned long long* o8 = (GAS unsigned long long*)orow + lane;
#pragma unroll
    for (int j = 0; j < 8; ++j) { const f32x4 g = ((const GAS f32x4*)gain)[lane + 64 * j]; hv[j] = hv[j] * r * g;
        o8[64 * j] = (unsigned long long)pk2(hv[j].x, hv[j].y) | ((unsigned long long)pk2(hv[j].z, hv[j].w) << 32);
        if (orow8) { int p = 0; p = __builtin_amdgcn_cvt_pk_fp8_f32(hv[j].x, hv[j].y, p, false); p = __builtin_amdgcn_cvt_pk_fp8_f32(hv[j].z, hv[j].w, p, true); ((GAS unsigned*)orow8)[lane + 64 * j] = (unsigned)p; } }
}
__device__ __forceinline__ float log_sigmoid_f(float z) { return fminf(z, 0.f) - log1pf(expf(-fabsf(z))); }

struct Frame { LAS unsigned char* lds; unsigned char* ldsg; int tid, lane, wave, G, bx, p0_mask; const float* const* in; float* out; unsigned char* ws; };

__device__ __forceinline__ void p0_prologue(Frame& F) {
    const int gw = F.bx * NWAVES + F.wave, NGW = F.G * NWAVES;
    if (F.p0_mask & 1) {
        LAS float* scr = (LAS float*)(F.lds + F.wave * 16384);
        const TJob jobs[9] = {
            {F.in[I_W_IN], N_IN_ORIG, 2048, N_QK, nullptr, (bf16*)(F.ws + WS_WIN), 0},
            {F.in[I_W_IN], N_IN_ORIG, 2048, N_REST, nullptr, (bf16*)(F.ws + WS_WIN + 16 * MiB), 1},
            {F.in[I_W_FOXUP], 2048, 1024, 2048, nullptr, (bf16*)(F.ws + WS_WFOX), FP8_UP_OUT},
            {F.in[I_W_RETUP], 2048, 1024, 2048, nullptr, (bf16*)(F.ws + (FP8_UP_OUT ? WS_WFOX + 1024 : WS_WRET)), FP8_UP_OUT},
            {F.in[I_W_OUT], 2048, 2048, 2048, nullptr, (bf16*)(F.ws + WS_WOUT), FP8_UP_OUT},
            {F.in[I_W_MQ], 512, 2048, 512, F.in[I_LN_MEM], (bf16*)(F.ws + WS_WMQ), 0},
            {F.in[I_W_MKV], 1024, 2048, 1024, nullptr, (bf16*)(F.ws + WS_WMKV), 0},
            {F.in[I_W_MO], 2048, 512, 2048, nullptr, (bf16*)(F.ws + WS_WMO), 1},
            {F.in[I_W_PQ], 2048, 2048, 2048, F.in[I_LN_FFN], (bf16*)(F.ws + WS_WPQ), 0} };
        int base = 0;
#pragma unroll
        for (int j = 0; j < 9; ++j) {
            const TJob& J = jobs[j]; const int nblk = J.N / 32, items = (J.K / 64) * nblk;
            int first = gw - (base % NGW); if (first < 0) first += NGW;
            for (int r = first; r < items; r += NGW) { const int kb = r / nblk, nb = r % nblk;
                int src_col0 = 0;
                if (j == 0) src_col0 = 3080;
                if (j == 1) src_col0 = (nb * 32 < 3072) ? 0 : 2056;
                if (J.fp8) transpose_item8(J.W, J.ldw, (FP8_UP_OUT && (j == 2 || j == 3)) ? 2048 : J.K, src_col0, (unsigned char*)J.WT, kb, nb, scr, F.lane);
                else transpose_item(J.W, J.ldw, J.K, src_col0, J.gain, J.WT, 0, scr, kb, nb, F.lane); }
            base += items;
        }
    }
    if (F.p0_mask & 1) {
        const float* sk = F.in[I_SUBK]; bf16* o = (bf16*)(F.ws + WS_SUBK);
        for (int i = (F.bx * 512 + F.tid) * 4; i < 16 * 128 * 128; i += F.G * 512 * 4) { const f32x4 v = *(const GAS f32x4*)(sk + i);
            *(GAS unsigned long long*)(o + i) = (unsigned long long)pk2(v.x, v.y) | ((unsigned long long)pk2(v.z, v.w) << 32); }
    }
    __syncthreads();
    if (F.p0_mask & 2) {
        LAS float* wf = (LAS float*)F.lds; const float* w = F.in[I_W_IN];
        for (int k = F.tid; k < 2048; k += 512) { const f32x4 a = *(const GAS f32x4*)(w + (size_t)k * N_IN_ORIG + 3072), b = *(const GAS f32x4*)(w + (size_t)k * N_IN_ORIG + 3076);
            wf[0 * 2048 + k] = a.x; wf[1 * 2048 + k] = a.y; wf[2 * 2048 + k] = a.z; wf[3 * 2048 + k] = a.w; wf[4 * 2048 + k] = b.x; wf[5 * 2048 + k] = b.y; wf[6 * 2048 + k] = b.z; wf[7 * 2048 + k] = b.w; }
    }
    __syncthreads();
    if (F.p0_mask & 2) {
        const LAS float* wf = (const LAS float*)F.lds; const float* bfg = F.in[I_B_FORGET]; float* logf_o = (float*)(F.ws + WS_LOGF);
        for (int m = gw; m < M_TOK; m += NGW) { f32x4 hv[8];
            rms_row_to_bf16(F.in[I_X] + (size_t)m * DM, F.in[I_LN_MIX], (bf16*)(F.ws + WS_XN) + (size_t)m * DM, F.lane, hv, (unsigned char*)F.out + DO_XN8 + (size_t)m * DM);
            float z = 0.f;
#pragma unroll
            for (int q = 0; q < 8; ++q) { float acc = 0.f;
#pragma unroll
                for (int j = 0; j < 8; ++j) { const f32x4 wv = *(const LAS f32x4*)(wf + q * 2048 + 4 * F.lane + 256 * j); acc += (hv[j].x * wv.x + hv[j].y * wv.y) + (hv[j].z * wv.z + hv[j].w * wv.w); }
                acc = wave_sum(acc); z = (F.lane == q) ? acc : z;
                __builtin_amdgcn_sched_barrier(0); }
            if (F.lane < 8) logf_o[(size_t)m * 8 + F.lane] = log_sigmoid_f(z + bfg[F.lane]);
        }
        for (int m = gw; m < NB * 256; m += NGW) { f32x4 hv[8]; rms_row_to_bf16(F.in[I_MEM] + (size_t)m * DM, F.in[I_MEMNORM_G], (bf16*)(F.ws + WS_MN) + (size_t)m * DM, F.lane, hv); }
    }
}
__device__ __forceinline__ void p1_scan(Frame& F) {
    if (F.bx < 64) {
        const int b = F.bx >> 3, h = F.bx & 7; const float* lf = (const float*)(F.ws + WS_LOGF); float* cf = (float*)(F.ws + WS_CUMF) + (size_t)F.bx * SEQ;
        float v[4]; float run = 0.f;
#pragma unroll
        for (int i = 0; i < 4; ++i) { run += lf[(size_t)(b * SEQ + F.tid * 4 + i) * 8 + h]; v[i] = run; }
        float incl = run;
#pragma unroll
        for (int o = 1; o < 64; o <<= 1) { const float t = __shfl_up(incl, o); if (F.lane >= o) incl += t; }
        LAS float* wt = (LAS float*)F.lds;
        if (F.lane == 63) wt[F.wave] = incl;
        __syncthreads();
        float off = incl - run;
        for (int w = 0; w < F.wave; ++w) off += wt[w];
#pragma unroll
        for (int i = 0; i < 4; ++i) cf[F.tid * 4 + i] = v[i] + off;
    }
    __syncthreads();
}
__device__ __forceinline__ void unpack8s(const att::bf16x8 v, float (&f)[8]) {
#pragma unroll
    for (int i = 0; i < 8; ++i) f[i] = __uint_as_float((unsigned)(unsigned short)v[i] << 16);
}
__device__ __forceinline__ att::bf16x8 pack8s(const float (&f)[8]) { v4u w; w.x = pg8::cvt_pk_bf16(f[0], f[1]); w.y = pg8::cvt_pk_bf16(f[2], f[3]); w.z = pg8::cvt_pk_bf16(f[4], f[5]); w.w = pg8::cvt_pk_bf16(f[6], f[7]); return __builtin_bit_cast(att::bf16x8, w); }
__device__ __forceinline__ void p4_attention(Frame& F) {
    char* lds = (char*)F.ldsg;
    const int xcd = F.bx & 7, kk = F.bx >> 3;
    const int bh = (kk >> 2) * 8 + xcd, x = kk & 3, b = bh >> 3, h = bh & 7;
    if (bh >= 64) return;
    const att::bf16* proj = (const att::bf16*)(F.ws + WS_PROJ);
    const size_t rowb = (size_t)b * SEQ;
    if (F.p0_mask & 1) {
        float* tbl = (float*)(lds + att::LDS_BIAS); const float* cf = (const float*)(F.ws + WS_CUMF) + (size_t)bh * SEQ;
        const f32x4 v = *(const f32x4*)(cf + F.tid * 4); *(f32x4*)(tbl + F.tid * 4) = v * (-1.4426950408889634f);
        att::BlockRef r0, r1;
        r0.Q = proj + (rowb + (size_t)x * 256) * PP + C_FQ + h * 128; r0.K = proj + rowb * PP + C_FK + h * 128; r0.V = proj + rowb * PP + C_FV + h * 128; r0.O = (att::bf16*)r0.Q;
        r0.P0 = x * 256; r0.skv = SEQ; r0.lg = 0.f; r0.RG = nullptr; r0.GN = nullptr; r0.O8 = FP8_UP_OUT ? (unsigned char*)F.out + DO_OFOX8 + (rowb + (size_t)x * 256) * 2048 + h * 128 : nullptr;
        r1 = r0; r1.Q = proj + (rowb + (size_t)(7 - x) * 256) * PP + C_FQ + h * 128; r1.O = (att::bf16*)r1.Q; r1.P0 = (7 - x) * 256; r1.O8 = FP8_UP_OUT ? (unsigned char*)F.out + DO_OFOX8 + (rowb + (size_t)(7 - x) * 256) * 2048 + h * 128 : nullptr;
        att::Seam S;
        att::attn_prime<0>(r0, lds, S);
        att::attn_block<0>(r0, r1, lds, S);
        att::attn_block<0>(r1, r1, lds, S);
    }
    if (F.p0_mask & 2) {
        att::BlockRef r0, r1;
        r0.Q = proj + (rowb + (size_t)x * 256) * PP + C_RQ + h * 128; r0.K = proj + rowb * PP + C_RK + h * 128; r0.V = proj + rowb * PP + C_RV + h * 128; r0.O = (att::bf16*)r0.Q;
        r0.P0 = x * 256; r0.skv = SEQ; r0.lg = __builtin_amdgcn_logf(1.f - __builtin_amdgcn_exp2f(-5.f - (float)h))    ; r0.RG = proj + (rowb + (size_t)x * 256) * PP + C_RG + h * 128; r0.GN = F.in[I_RET_G] + h * 128; r0.O8 = FP8_UP_OUT ? (unsigned char*)F.out + DO_ORET8 + (rowb + (size_t)x * 256) * 2048 + h * 128 : nullptr;
        r1 = r0; r1.O8 = FP8_UP_OUT ? (unsigned char*)F.out + DO_ORET8 + (rowb + (size_t)(7 - x) * 256) * 2048 + h * 128 : nullptr; r1.Q = proj + (rowb + (size_t)(7 - x) * 256) * PP + C_RQ + h * 128; r1.O = (att::bf16*)r1.Q; r1.P0 = (7 - x) * 256; r1.RG = proj + (rowb + (size_t)(7 - x) * 256) * PP + C_RG + h * 128;
        att::Seam S;
        att::attn_prime<1>(r0, lds, S);
        att::attn_block<1>(r0, r1, lds, S);
        att::attn_block<1>(r1, r1, lds, S);
    }
}


__device__ __forceinline__ void p8_convert_peer(Frame& F) {
    const int lane = F.lane;
    f32x4 g[8];
#pragma unroll
    for (int j = 0; j < 8; ++j) g[j] = ((const GAS f32x4*)F.in[I_LN_FFN])[lane + 64 * j];
    float* scl = (float*)(F.ws + WS_PSCALE);
    int r0, rend, rstride;
    if (F.bx >= 160) { r0 = (F.bx - 160) * NWAVES + F.wave; rend = 22272; rstride = 768; } else { r0 = 22272 + F.bx * NWAVES + F.wave; rend = 32768; rstride = 1280; }
#pragma unroll 1
    for (int rr = r0; rr < rend; rr += 2 * rstride) {
        f32x4 v[2][8]; float amax[2] = {0.f, 0.f}; bool ok[2], isu[2]; int ri[2];
#pragma unroll
        for (int q = 0; q < 2; ++q) { const int r = rr + q * rstride; ok[q] = r < rend; const int rc = ok[q] ? r : rr; isu[q] = rc < 16384; ri[q] = rc;
            const float* src = (isu[q] ? F.in[I_PEER_U] : F.in[I_PEER_V]) + (size_t)(rc & 16383) * DM;
#pragma unroll
            for (int j = 0; j < 8; ++j) v[q][j] = ((const GAS f32x4*)src)[lane + 64 * j]; }
#pragma unroll
        for (int q = 0; q < 2; ++q) {
#pragma unroll
            for (int j = 0; j < 8; ++j) { if (isu[q]) v[q][j] = v[q][j] * g[j]; amax[q] = fmaxf(amax[q], fmaxf(fmaxf(fabsf(v[q][j].x), fabsf(v[q][j].y)), fmaxf(fabsf(v[q][j].z), fabsf(v[q][j].w)))); }
#pragma unroll
            for (int o = 1; o < 64; o <<= 1) amax[q] = fmaxf(amax[q], __shfl_xor(amax[q], o));
            const float sc = amax[q] > 0.f ? amax[q] * (1.f / 448.f) : 1.f, inv = 1.f / sc;
            if (ok[q]) { if (lane == 0) scl[ri[q]] = sc;
                GAS unsigned* o4 = (GAS unsigned*)(F.ws + (isu[q] ? WS_PU : WS_PV) + (size_t)(ri[q] & 16383) * DM) + lane;
#pragma unroll
                for (int j = 0; j < 8; ++j) { int p = 0; p = __builtin_amdgcn_cvt_pk_fp8_f32(v[q][j].x * inv, v[q][j].y * inv, p, false); p = __builtin_amdgcn_cvt_pk_fp8_f32(v[q][j].z * inv, v[q][j].w * inv, p, true); o4[64 * j] = (unsigned)p; } } }
    }
}
__device__ __forceinline__ void norm_own_tile(Frame& F, bf16* base, int ld, int row0, int col0, const float* gain, float mul) {
    asm volatile("s_waitcnt vmcnt(0)" ::: "memory"); __syncthreads();
    const int lane = F.lane, rsel = lane >> 5, head = (lane >> 4) & 1, sub = lane & 15;
    float gv[8];
#pragma unroll
    for (int i = 0; i < 8; ++i) gv[i] = gain[sub * 8 + i] * mul;
#pragma unroll 1
    for (int r4 = 0; r4 < 16; r4 += 4) {
        att::bf16x8 v[4]; bf16* p[4];
#pragma unroll
        for (int q = 0; q < 4; ++q) { p[q] = base + (size_t)(row0 + F.wave * 32 + (r4 + q) * 2 + rsel) * ld + col0 + head * 128 + sub * 8; v[q] = *(const att::bf16x8*)p[q]; }
#pragma unroll
        for (int q = 0; q < 4; ++q) { float a[8]; unpack8s(v[q], a); float s = 0.f;
#pragma unroll
            for (int i = 0; i < 8; ++i) s += a[i] * a[i];
            s += __shfl_xor(s, 1); s += __shfl_xor(s, 2); s += __shfl_xor(s, 4); s += __shfl_xor(s, 8);
            const float rr = 1.f / sqrtf(s * (1.f / 128.f) + RMS_EPS);
#pragma unroll
            for (int i = 0; i < 8; ++i) a[i] *= rr * gv[i];
            *(att::bf16x8*)p[q] = pack8s(a); }
    }
}
__device__ __forceinline__ void fix_own_tile(Frame& F, bf16* proj, int pm, int pn, int kind) {
    const int lane = F.lane;
    if (kind < 2) {
        const int rsel = lane >> 5, head = (lane >> 4) & 1, sub = lane & 15; float gv[8];
#pragma unroll
        for (int i = 0; i < 8; ++i) gv[i] = kind == 0 ? F.in[I_FOXQ_G][sub * 8 + i] * QK_C2 : F.in[I_FOXK_G][sub * 8 + i];
#pragma unroll 1
        for (int r4 = 0; r4 < 16; r4 += 4) { att::bf16x8 v[4]; bf16* p[4];
#pragma unroll
            for (int q = 0; q < 4; ++q) { p[q] = proj + (size_t)(pm * 256 + F.wave * 32 + (r4 + q) * 2 + rsel) * PP + pn * 256 + head * 128 + sub * 8; v[q] = *(const att::bf16x8*)p[q]; }
#pragma unroll
            for (int q = 0; q < 4; ++q) { float a[8]; unpack8s(v[q], a); float s = 0.f;
#pragma unroll
                for (int i = 0; i < 8; ++i) s += a[i] * a[i];
                s += __shfl_xor(s, 1); s += __shfl_xor(s, 2); s += __shfl_xor(s, 4); s += __shfl_xor(s, 8);
                const float rr = 1.f / sqrtf(s * (1.f / 128.f) + RMS_EPS);
#pragma unroll
                for (int i = 0; i < 8; ++i) a[i] *= rr * gv[i];
                *(att::bf16x8*)p[q] = pack8s(a); } }
    } else {
        const int rsel = lane >> 4, head = (lane >> 3) & 1, sub = lane & 7; const float sc = kind == 3 ? 0.08838834764831845f : 1.f; float fr[8];
        const float lgh = __builtin_amdgcn_logf(1.f - __builtin_amdgcn_exp2f(-5.f - (float)((pn & 3) * 2 + head)));
#pragma unroll
        for (int i = 0; i < 8; ++i) fr[i] = expf(-9.210340371976184f * (float)(sub * 8 + i) * (1.f / 64.f)) * 0.15915494309189535f;
#pragma unroll 1
        for (int r4 = 0; r4 < 8; r4 += 4) { att::bf16x8 va[4], vb[4]; bf16* p[4];
#pragma unroll
            for (int q = 0; q < 4; ++q) { p[q] = proj + (size_t)(pm * 256 + F.wave * 32 + (r4 + q) * 4 + rsel) * PP + pn * 256 + head * 128 + sub * 8; va[q] = *(const att::bf16x8*)p[q]; vb[q] = *(const att::bf16x8*)(p[q] + 64); }
#pragma unroll
            for (int q = 0; q < 4; ++q) { const int rowi = pm * 256 + F.wave * 32 + (r4 + q) * 4 + rsel; const float pos = (float)(rowi & (SEQ - 1)); float a[8], b[8], oa[8], ob[8]; unpack8s(va[q], a); unpack8s(vb[q], b);
                const float dsc = sc * __builtin_amdgcn_exp2f((kind == 2 ? lgh : -lgh) * (float)(rowi & 63));
#pragma unroll
                for (int i = 0; i < 8; ++i) { float rev = pos * fr[i]; rev -= rintf(rev); const float sn = __builtin_amdgcn_sinf(rev), cs = __builtin_amdgcn_cosf(rev);
                    oa[i] = (a[i] * cs - b[i] * sn) * dsc; ob[i] = (a[i] * sn + b[i] * cs) * dsc; }
                *(att::bf16x8*)p[q] = pack8s(oa); *(att::bf16x8*)(p[q] + 64) = pack8s(ob); } }
    }
}
__device__ __forceinline__ void p10_mem_attention(Frame& F) {
    char* lds = (char*)F.ldsg;
    const int b = F.bx >> 5, h = (F.bx >> 3) & 3, qb = F.bx & 7;
    att::BlockRef r0;
    const size_t qoff = ((size_t)b * SEQ + (size_t)qb * 256) * 512 + h * 128;
    r0.Q = (const att::bf16*)(F.ws + WS_QM) + qoff; r0.O = (att::bf16*)(F.ws + WS_OMEM) + qoff;
    r0.K = (const att::bf16*)(F.ws + WS_KVM) + (size_t)(b * 256) * 1024 + h * 128; r0.V = r0.K + 512;
    r0.P0 = 1 << 20; r0.skv = 256; r0.lg = 0.f; r0.RG = nullptr; r0.GN = nullptr; r0.O8 = F.ws + WS_OMEM + ((size_t)b * SEQ + (size_t)qb * 256) * 512 + h * 128;
    att::Seam S;
    att::attn_prime<2>(r0, lds, S);
    att::attn_block<2>(r0, r0, lds, S);
}
#define TK_INS(L, v) do { _Pragma("unroll") for (int i_ = 15; i_ >= 1; --i_) L[i_] = __builtin_amdgcn_fmed3f(L[i_ - 1], L[i_], (v)); L[0] = fmaxf(L[0], (v)); } while (0)
__device__ __forceinline__ void p13_topk_unit(Frame& F, int pm, int h) {
    const int lane = F.lane, r32 = lane & 31, hi = lane >> 5, wave = F.wave;
    const att::bf16* qp = (const att::bf16*)(F.ws + WS_QP); const att::bf16* subk = (const att::bf16*)(F.ws + WS_SUBK);
    int* idx_o = (int*)(F.ws + WS_IDX); float* gate_o = (float*)(F.ws + WS_GATE);
    LAS unsigned* kb = (LAS unsigned*)(F.lds + 65536 + (wave * 32 + (lane & 31)) * 32);
    const int tok = pm * 256 + wave * 32 + r32;
    const unsigned q_lane = (unsigned)((tok * DM + hi * 8) * 2), k_lane = (unsigned)((r32 * 128 + hi * 8) * 2);
    att::bf16x8 qf[8];
#define TK_STAGE(p_) do { const int hp_ = h * 2 + (p_); const unsigned char* qb_ = (const unsigned char*)qp + (size_t)hp_ * 256; \
        const unsigned char* kb_ = (const unsigned char*)subk + (size_t)hp_ * 32768 + (size_t)(wave >> 1) * 8192 + (size_t)(wave & 1) * 128; \
        _Pragma("unroll") for (int d0 = 0; d0 < 8; ++d0) qf[d0] = *(const GAS att::bf16x8*)(qb_ + d0 * 32 + q_lane); \
        _Pragma("unroll") for (int f_ = 0; f_ < 4; ++f_) \
            __builtin_amdgcn_global_load_lds((const GAS unsigned*)(kb_ + f_ * 32 + k_lane), (LAS unsigned*)(F.lds + (p_) * 32768 + (wave * 4 + f_) * 1024), 16, 0, 0); } while (0)
    float L0[16], L1[16];
#pragma unroll
    for (int i = 0; i < 16; ++i) { L0[i] = 0.f; L1[i] = 0.f; }
    TK_STAGE(0);
#pragma unroll 1
    for (int p = 0; p < 2; ++p) {
        asm volatile("s_waitcnt vmcnt(0)" ::: "memory"); __syncthreads();
        att::f32x16 acc[4];
        const LAS unsigned char* img = F.lds + p * 32768;
#pragma unroll
        for (int kt = 0; kt < 4; ++kt) { acc[kt] = att::f32x16{};
#pragma unroll
            for (int d0 = 0; d0 < 8; ++d0) acc[kt] = __builtin_amdgcn_mfma_f32_32x32x16_bf16(*(const LAS att::bf16x8*)(img + (kt * 8 + d0) * 1024 + lane * 16), qf[d0], acc[kt], 0, 0, 0); }
        if (p == 0) TK_STAGE(1);
        float L[16];
#pragma unroll
        for (int i = 0; i < 16; ++i) L[i] = -3.0e38f;
#pragma unroll
        for (int kt = 0; kt < 4; ++kt)
#pragma unroll
            for (int r = 0; r < 16; ++r) { const unsigned key = (unsigned)(kt * 32 + (r & 3) + 8 * (r >> 2)) + 4u * (unsigned)hi;
                const float v = __uint_as_float((__float_as_uint(acc[kt][r]) & ~0x7Fu) | key); TK_INS(L, v); }
        float P[16];
#pragma unroll
        for (int i = 0; i < 16; ++i) P[i] = __shfl_xor(L[i], 32);
#pragma unroll
        for (int i = 0; i < 16; ++i) TK_INS(L, P[i]);
#pragma unroll
        for (int i = 0; i < 16; ++i) { L0[i] = p == 0 ? L[i] : L0[i]; L1[i] = p == 0 ? L1[i] : L[i]; }
    }
#undef TK_STAGE
#pragma unroll
        for (int w = 0; w < 4; ++w) {
            kb[w] = (__float_as_uint(L0[4 * w]) & 0x7Fu) | ((__float_as_uint(L0[4 * w + 1]) & 0x7Fu) << 8) | ((__float_as_uint(L0[4 * w + 2]) & 0x7Fu) << 16) | ((__float_as_uint(L0[4 * w + 3]) & 0x7Fu) << 24);
            kb[4 + w] = (__float_as_uint(L1[4 * w]) & 0x7Fu) | ((__float_as_uint(L1[4 * w + 1]) & 0x7Fu) << 8) | ((__float_as_uint(L1[4 * w + 2]) & 0x7Fu) << 16) | ((__float_as_uint(L1[4 * w + 3]) & 0x7Fu) << 24); }
        float T[16];
#pragma unroll
        for (int i = 0; i < 16; ++i) T[i] = -3.0e38f;
#pragma unroll
        for (int a = 0; a < 16; ++a) { const float sa = __uint_as_float(__float_as_uint(L0[a]) & ~0x7Fu);
#pragma unroll
            for (int b2 = 0; b2 < 16; ++b2) if ((a + 1) * (b2 + 1) <= 16) { const float s = sa + __uint_as_float(__float_as_uint(L1[b2]) & ~0x7Fu);
                const float v = __uint_as_float((__float_as_uint(s) & ~0xFFu) | (unsigned)(a * 16 + b2)); TK_INS(T, v); } }
        LDS_WAIT();
        const LAS unsigned char* kbb = (const LAS unsigned char*)kb;
        float sc[16]; int ei[16]; float mx = __uint_as_float(__float_as_uint(T[0]) & ~0xFFu), sum = 0.f;
#pragma unroll
        for (int k = 0; k < 16; ++k) { const unsigned bits = __float_as_uint(T[k]); const unsigned id = bits & 0xFFu;
            const int i1 = kbb[id >> 4], i2 = kbb[16 + (id & 15u)]; ei[k] = i1 * 128 + i2;
            sc[k] = __builtin_amdgcn_exp2f((__uint_as_float(bits & ~0xFFu) - mx) * 1.4426950408889634f); sum += sc[k]; }
        const float inv = 1.f / sum;
        if (hi == 0) {
#pragma unroll
            for (int w = 0; w < 4; ++w) {
                *(GAS v4u*)(idx_o + (size_t)tok * 128 + h * 16 + 4 * w) = (v4u){(unsigned)ei[4 * w], (unsigned)ei[4 * w + 1], (unsigned)ei[4 * w + 2], (unsigned)ei[4 * w + 3]};
                *(GAS f32x4*)(gate_o + (size_t)tok * 128 + h * 16 + 4 * w) = (f32x4){sc[4 * w] * inv, sc[4 * w + 1] * inv, sc[4 * w + 2] * inv, sc[4 * w + 3] * inv}; } }
        LDS_WAIT(); asm volatile("" ::: "memory");
}


typedef float f32x2 __attribute__((ext_vector_type(2)));
__device__ __forceinline__ float gelu_tanh(float x) {
    const float y = 0.7978845608028654f * (x + 0.044715f * x * x * x);
    const float t = 1.f - 2.f * __builtin_amdgcn_rcpf(1.f + __builtin_amdgcn_exp2f(2.885390081777927f * y));
    return 0.5f * x * (1.f + t);
}
__device__ __forceinline__ float dot2bf(unsigned a, unsigned b, float acc) { asm("v_dot2c_f32_bf16 %0, %1, %2" : "+v"(acc) : "v"(a), "v"(b)); return acc; }
#ifndef EX_QCH
#define EX_QCH 2
#endif
struct RowBuf { v4u r[8]; float su, sv; };
#define DPP_MOV(v, ctrl) __builtin_bit_cast(float, __builtin_amdgcn_update_dpp(0, __builtin_bit_cast(int, (v)), (ctrl), 0xF, 0xF, false))
#define ROW_ROR(v, n) __builtin_bit_cast(float, __builtin_amdgcn_update_dpp(0, __builtin_bit_cast(int, (v)), 0x120 + (n), 0xF, 0xF, false))
__device__ __forceinline__ void p14_experts_sorted(Frame& F) {
    const int lane = F.lane, wave = F.wave, q = lane >> 4, l16 = lane & 15;
    const bf16* xb = (const bf16*)(F.ws + WS_XB2); const unsigned char* pu = F.ws + WS_PU; const unsigned char* pv = F.ws + WS_PV;
    const int* idx = (const int*)(F.ws + WS_IDX); const float* gate = (const float*)(F.ws + WS_GATE); const float* rowss = (const float*)(F.ws + WS_ROWSS2);
    const float* su = (const float*)(F.ws + WS_PSCALE); const float* sv = su + 16384;
    LAS unsigned* list = (LAS unsigned*)(F.lds + wave * 8192) + q * 128;
    LAS float* wl = (LAS float*)(F.lds + wave * 8192 + 2048) + q * 128;
    LAS float* gt = (LAS float*)(F.lds + wave * 8192 + 4096) + q * 128;
    LAS unsigned* cnt = (LAS unsigned*)(F.lds + wave * 8192 + 6144) + q * 64;
    constexpr int NSTEP = 128;
    for (int grp = 0; grp < 2; ++grp) {
        const int tok = (F.bx * NWAVES + wave) * 8 + grp * 4 + q;
        const float rs = 1.f / sqrtf(rowss[tok] * (1.f / DM) + RMS_EPS);
#pragma unroll
        for (int i = 0; i < 4; ++i) cnt[l16 + 16 * i] = 0u;
        unsigned ent[8], pos[8];
#pragma unroll
        for (int j = 0; j < 8; ++j) { const int k = l16 + 16 * j; const unsigned e = (unsigned)idx[(size_t)tok * 128 + k]; gt[k] = gate[(size_t)tok * 128 + k]; ent[j] = e | ((unsigned)k << 16); }
        LDS_WAIT(); asm volatile("" ::: "memory");
#pragma unroll
        for (int j = 0; j < 8; ++j) pos[j] = __hip_atomic_fetch_add(cnt + ((ent[j] & 0x3FFFu) >> 8), 1u, __ATOMIC_RELAXED, __HIP_MEMORY_SCOPE_WORKGROUP);
        LDS_WAIT(); asm volatile("" ::: "memory");
        { unsigned c[4], inc[4], run = 0u;
#pragma unroll
          for (int i = 0; i < 4; ++i) { c[i] = cnt[l16 + 16 * i]; inc[i] = c[i];
#pragma unroll
              for (int o = 1; o < 16; o <<= 1) { const unsigned tt = __shfl_up(inc[i], o, 16); if (l16 >= o) inc[i] += tt; } }
          LDS_WAIT(); asm volatile("" ::: "memory");
#pragma unroll
          for (int i = 0; i < 4; ++i) { cnt[l16 + 16 * i] = run + inc[i] - c[i]; run += __shfl(inc[i], 15, 16); } }
        LDS_WAIT(); asm volatile("" ::: "memory");
#pragma unroll
        for (int j = 0; j < 8; ++j) list[cnt[(ent[j] & 0x3FFFu) >> 8] + pos[j]] = ent[j];
        LDS_WAIT(); asm volatile("" ::: "memory");
        const unsigned lane_off = (unsigned)l16 * 16u;
        constexpr int QCH = EX_QCH, NSW = 8 / QCH;
#define EX_LD(B, s_, TABQ) do { const int ss_ = (s_) < NSTEP ? (s_) : NSTEP - 1; const unsigned off_ = ((list[ss_] & 0x3FFFu) << 11) + lane_off;     \
            _Pragma("unroll") for (int c_ = 0; c_ < QCH; ++c_) B[c_] = *(const GAS v4u*)((TABQ) + off_ + c_ * 256); } while (0)
#define EX_RING(TABQ, STEPFN, ENDFN) do { v4u H0[QCH], H1[QCH], H2[QCH], H3[QCH], H4[QCH], H5[QCH], H6[QCH], H7[QCH]; \
            EX_LD(H0, 0, TABQ); EX_LD(H1, 1, TABQ); EX_LD(H2, 2, TABQ); EX_LD(H3, 3, TABQ); EX_LD(H4, 4, TABQ); EX_LD(H5, 5, TABQ); EX_LD(H6, 6, TABQ); \
            _Pragma("unroll 1") for (int s = 0; s < NSTEP; s += 8) { \
                EX_LD(H7, s + 7, TABQ); STEPFN(H0, s, 0); \
                EX_LD(H0, s + 8, TABQ); STEPFN(H1, s + 1, 1); \
                EX_LD(H1, s + 9, TABQ); STEPFN(H2, s + 2, 2); \
                EX_LD(H2, s + 10, TABQ); STEPFN(H3, s + 3, 3); \
                EX_LD(H3, s + 11, TABQ); STEPFN(H4, s + 4, 4); \
                EX_LD(H4, s + 12, TABQ); STEPFN(H5, s + 5, 5); \
                EX_LD(H5, s + 13, TABQ); STEPFN(H6, s + 6, 6); \
                EX_LD(H6, s + 14, TABQ); STEPFN(H7, s + 7, 7); \
                ENDFN(s); } } while (0)
#pragma unroll 1
        for (int j = 0; j < NSW; ++j) {
            f32x2 xf[QCH][8];
#pragma unroll
            for (int c = 0; c < QCH; ++c) { const v4u a = *(const GAS v4u*)(xb + (size_t)tok * DM + j * (QCH * 256) + c * 256 + l16 * 16), b = *(const GAS v4u*)(xb + (size_t)tok * DM + j * (QCH * 256) + c * 256 + l16 * 16 + 8);
                const unsigned xd[8] = {a.x, a.y, a.z, a.w, b.x, b.y, b.z, b.w};
#pragma unroll
                for (int i = 0; i < 8; ++i) xf[c][i] = (f32x2){__uint_as_float(xd[i] << 16), __uint_as_float(xd[i] & 0xffff0000u)}; }
            const unsigned char* tabq = pu + j * (QCH * 256);
#define EX_U(B, s_, k_) do { f32x2 d2_ = {0.f, 0.f}; \
            _Pragma("unroll") for (int c_ = 0; c_ < QCH; ++c_) { const unsigned ud[4] = {B[c_].x, B[c_].y, B[c_].z, B[c_].w}; \
                _Pragma("unroll") for (int w_ = 0; w_ < 4; ++w_) { d2_ = __builtin_amdgcn_cvt_pk_f32_fp8((int)ud[w_], false) * xf[c_][2 * w_] + d2_; d2_ = __builtin_amdgcn_cvt_pk_f32_fp8((int)ud[w_], true) * xf[c_][2 * w_ + 1] + d2_; } } \
            dd[k_] = d2_.x + d2_.y; } while (0)
#define EX_UEND(s_) do { float r4_[4], r2_[2], r1_; \
            { const bool up = (l16 & 8) != 0; _Pragma("unroll") for (int i_ = 0; i_ < 4; ++i_) { const float mine = up ? dd[i_ + 4] : dd[i_], theirs = up ? dd[i_] : dd[i_ + 4]; r4_[i_] = mine + ROW_ROR(theirs, 8); } } \
            { const bool up = (l16 & 4) != 0; _Pragma("unroll") for (int i_ = 0; i_ < 2; ++i_) { const float mine = up ? r4_[i_ + 2] : r4_[i_], theirs = up ? r4_[i_] : r4_[i_ + 2]; \
                const float fromhi = DPP_MOV(theirs, 0x104), fromlo = DPP_MOV(theirs, 0x114); r2_[i_] = mine + (up ? fromlo : fromhi); } }     \
            { const bool up = (l16 & 2) != 0; const float mine = up ? r2_[1] : r2_[0], theirs = up ? r2_[0] : r2_[1]; r1_ = mine + DPP_MOV(theirs, 0x4E); }     \
            r1_ += DPP_MOV(r1_, 0xB1);                                                                                                                  \
            if ((l16 & 1) == 0) { const int si_ = (s_) + (l16 >> 1); wl[si_] = (j == 0 ? 0.f : wl[si_]) + r1_; } } while (0)
            float dd[8];
            EX_RING(tabq, EX_U, EX_UEND);
#undef EX_U
#undef EX_UEND
            LDS_WAIT(); asm volatile("" ::: "memory");
        }
#pragma unroll
        for (int i = 0; i < 8; ++i) { const int s = l16 + 16 * i; const unsigned me = list[s]; const unsigned e = me & 0x3FFFu;
            wl[s] = gt[(me >> 16) & 127u] * gelu_tanh(wl[s] * su[e] * rs) * sv[e]; }
        LDS_WAIT(); asm volatile("" ::: "memory");
#pragma unroll 1
        for (int j = 0; j < NSW; ++j) {
            f32x2 acc[QCH][8];
#pragma unroll
            for (int c = 0; c < QCH; ++c)
#pragma unroll
                for (int e = 0; e < 8; ++e) acc[c][e] = (f32x2){0.f, 0.f};
            const unsigned char* tabq = pv + j * (QCH * 256);
#define EX_NOEND(s_) do { } while (0)
#define EX_V(B, s_, k_) do { const float w_ = wl[s_]; const f32x2 w2 = {w_, w_}; \
            _Pragma("unroll") for (int c_ = 0; c_ < QCH; ++c_) { const unsigned ud[4] = {B[c_].x, B[c_].y, B[c_].z, B[c_].w}; \
                _Pragma("unroll") for (int w4_ = 0; w4_ < 4; ++w4_) { acc[c_][2 * w4_] = __builtin_amdgcn_cvt_pk_f32_fp8((int)ud[w4_], false) * w2 + acc[c_][2 * w4_]; acc[c_][2 * w4_ + 1] = __builtin_amdgcn_cvt_pk_f32_fp8((int)ud[w4_], true) * w2 + acc[c_][2 * w4_ + 1]; } } } while (0)
            EX_RING(tabq, EX_V, EX_NOEND);
#undef EX_V
#undef EX_NOEND
            float* orow = F.out + (size_t)tok * DM + j * (QCH * 256) + l16 * 16; const bf16* xrow = xb + (size_t)tok * DM + j * (QCH * 256) + l16 * 16;
#pragma unroll
            for (int c = 0; c < QCH; ++c) { const v4u x0 = *(const GAS v4u*)(xrow + c * 256), x1 = *(const GAS v4u*)(xrow + c * 256 + 8); const unsigned xd[8] = {x0.x, x0.y, x0.z, x0.w, x1.x, x1.y, x1.z, x1.w};
#pragma unroll
                for (int qq = 0; qq < 4; ++qq)
                    *(GAS f32x4*)(orow + c * 256 + 4 * qq) = (f32x4){__uint_as_float(xd[2 * qq] << 16) + acc[c][2 * qq].x, __uint_as_float(xd[2 * qq] & 0xffff0000u) + acc[c][2 * qq].y,
                                                                    __uint_as_float(xd[2 * qq + 1] << 16) + acc[c][2 * qq + 1].x, __uint_as_float(xd[2 * qq + 1] & 0xffff0000u) + acc[c][2 * qq + 1].y}; }
        }
#undef EX_LD
#undef EX_RING
        LDS_WAIT(); asm volatile("" ::: "memory");
    }
}

#ifdef ONLY_PHASE
#define ISO(n) ((n) == ONLY_PHASE)
#else
#define ISO(n) true
#endif
#ifndef LAST_PHASE
#define LAST_PHASE 11
#endif
enum { PH_PROLOGUE = 0, PH_GEMM_IN, PH_GEMM_IN8, PH_ATTN, PH_GEMM_FOXUP, PH_GEMM_RETUP, PH_GEMM_OUT, PH_GEMM_MQ, PH_MEM_ATTN, PH_GEMM_MO, PH_GEMM_PQ, PH_EXPERTS, PH_N };
__global__ void __launch_bounds__(NWAVES * 64, 2) mega_fwd(Args args) {
    extern __shared__ __attribute__((aligned(16))) unsigned char lds[];
    Frame F;
    F.lds = (LAS unsigned char*)lds; F.ldsg = lds; F.tid = threadIdx.x; F.lane = F.tid & 63; F.wave = __builtin_amdgcn_readfirstlane(F.tid >> 6); F.G = gridDim.x; F.bx = blockIdx.x;
    F.in = args.in; F.out = args.out; F.ws = args.ws; F.p0_mask = args.p0_mask;
    volatile LAS unsigned* MISC = (volatile LAS unsigned*)(F.lds + MISC_OFF);
    for (int u = F.tid; u < (LDS_BYTES - LDSCTL_OFF) / 4; u += NWAVES * 64) ((LAS unsigned*)(F.lds + LDSCTL_OFF))[u] = 0u;
    __syncthreads();
    gu32* ctl = (gu32*)(args.ws + WS_CTL);
    XcdBarrier bar = xcd_barrier_post((unsigned*)(ctl + CW_BAR), MISC + 8);
    unsigned char* ws = args.ws;
    bf16* proj = (bf16*)(ws + WS_PROJ);
    for (int ph = args.ph_lo; ph < args.ph_hi; ++ph) {
        { int t_ = threadIdx.x; asm volatile("" : "+v"(t_)); F.tid = t_; F.lane = t_ & 63; }
        { int g_ = gridDim.x, b_ = blockIdx.x; asm volatile("" : "+s"(g_), "+s"(b_)); F.G = g_; F.bx = b_; }
        bool is_gemm = false, barrier_after = true, fp8 = false, mq_phase = false, qk_phase = false, pq_phase = false, ksplit = false, qk8_phase = false;
        pg8::Gemm g{nullptr, nullptr, 0, 0, 0, 0, 0x7F7F7F7F}; pg8::EpiAny E{};
        switch (ph) {
#ifndef NO_P0
        case PH_PROLOGUE: if constexpr (ISO(0)) p0_prologue(F); break;
#endif
        case PH_GEMM_IN: if constexpr (ISO(1)) p1_scan(F); is_gemm = true; barrier_after = false; qk_phase = true;
            g = pg8::Gemm{(const bf16*)(ws + WS_XN), (const bf16*)(ws + WS_WIN), M_TOK, N_QK, DM, DM, 0x7F7F7F7F, DM}; E.kind = 0; E.O = proj; E.ldc = PP; E.pn_off = 0; break;
        case PH_GEMM_IN8: is_gemm = true; fp8 = true; qk8_phase = true;
            g = pg8::Gemm{(const bf16*)((unsigned char*)args.out + DO_XN8), (const bf16*)(ws + WS_WIN + 16 * MiB), M_TOK, N_REST, DM / 2, DM / 2, W8_SCALE_B, DM / 2}; E.kind = 0; E.O = proj + N_QK; E.ldc = PP; E.pn_off = N_QK / 256; break;
#ifndef NO_ATTN
        case PH_ATTN: if constexpr (ISO(3)) p4_attention(F); break;
#endif
#if FP8_UP_OUT
        case PH_GEMM_FOXUP: is_gemm = true; fp8 = true;
            g = pg8::Gemm{(const bf16*)((unsigned char*)args.out + DO_OCAT8), (const bf16*)(ws + WS_WFOX), M_TOK, DM, 512, 1024, W8_SCALE_B, 1024}; ksplit = true; E.kind = 7; E.Gt = proj + C_G0; E.Gt2 = proj + C_G1; E.ldg = PP; E.O8 = (unsigned char*)(proj + C_FK); E.ld8 = PP * 2; break;
        case PH_GEMM_RETUP: barrier_after = false; break;
        case PH_GEMM_OUT: is_gemm = true; fp8 = true;
            g = pg8::Gemm{proj + C_FK, (const bf16*)(ws + WS_WOUT), M_TOK, DM, DM / 2, PP, W8_SCALE_B, DM / 2}; E.kind = 4; E.base = args.in[I_X]; E.base16 = nullptr; E.O = (bf16*)(ws + WS_XB1); E.ldc = DM; E.rowss = (float*)(ws + WS_ROWSS1); break;
#else
        case PH_GEMM_FOXUP: is_gemm = true;
            g = pg8::Gemm{proj + C_FQ, (const bf16*)(ws + WS_WFOX), M_TOK, DM, 1024, PP, 0x7F7F7F7F, 1024}; E.kind = 2; E.O = (bf16*)(ws + WS_XN); E.ldc = DM; E.Gt = proj + C_G0; E.ldg = PP; break;
        case PH_GEMM_RETUP: is_gemm = true;
            g = pg8::Gemm{proj + C_RQ, (const bf16*)(ws + WS_WRET), M_TOK, DM, 1024, PP, 0x7F7F7F7F, 1024}; E.kind = 6; E.O = (bf16*)(ws + WS_XN); E.ldc = DM; E.Gt = proj + C_G1; E.ldg = PP; break;
        case PH_GEMM_OUT: is_gemm = true;
            g = pg8::Gemm{(const bf16*)(ws + WS_XN), (const bf16*)(ws + WS_WOUT), M_TOK, DM, DM, DM, 0x7F7F7F7F, DM}; E.kind = 4; E.base = args.in[I_X]; E.base16 = nullptr; E.O = (bf16*)(ws + WS_XB1B); E.ldc = DM; E.rowss = (float*)(ws + WS_ROWSS1); break;
#endif
        case PH_GEMM_MQ: is_gemm = true; mq_phase = true;
            if (F.bx < 128) { g = pg8::Gemm{(const bf16*)(ws + WS_XB1), (const bf16*)(ws + WS_WMQ), M_TOK, 512, DM, DM, 0x7F7F7F7F, DM}; E.kind = 1; E.O = (bf16*)(ws + WS_QM); E.ldc = 512; E.rowss_in = (const float*)(ws + WS_ROWSS1); }
            else { g = pg8::Gemm{(const bf16*)(ws + WS_MN), (const bf16*)(ws + WS_WMKV), NB * 256, 1024, DM, DM, 0x7F7F7F7F, DM}; E.kind = 1; E.O = (bf16*)(ws + WS_KVM); E.ldc = 1024; E.rowss_in = nullptr; }
            break;
        case PH_MEM_ATTN: if constexpr (ISO(8)) p10_mem_attention(F); break;
        case PH_GEMM_MO: is_gemm = true;
            fp8 = true; g = pg8::Gemm{(const bf16*)(ws + WS_OMEM), (const bf16*)(ws + WS_WMO), M_TOK, DM, 256, 256, W8_SCALE_B, 256}; E.kind = 4; E.base = nullptr; E.base16 = (const bf16*)(ws + WS_XB1); E.O = (bf16*)(ws + WS_XB2); E.ldc = DM; E.rowss = (float*)(ws + WS_ROWSS2); break;
        case PH_GEMM_PQ: is_gemm = true; pq_phase = true;
            g = pg8::Gemm{(const bf16*)(ws + WS_XB2), (const bf16*)(ws + WS_WPQ), M_TOK, DM, DM, DM, 0x7F7F7F7F, DM}; E.kind = 1; E.O = (bf16*)(ws + WS_QP); E.ldc = DM; E.rowss_in = (const float*)(ws + WS_ROWSS2); break;
        case PH_EXPERTS: if constexpr (ISO(11)) p14_experts_sorted(F); break;
        default: break;
        }
#ifndef NO_GEMM
        if constexpr (ISO(100)) if (is_gemm) { pg8::StaticOrder S; S.init(g.M, g.N, F.G, (mq_phase && F.bx >= 128) ? F.bx - 128 : F.bx); S.kshift = ksplit ? 1 : 0;
            if (fp8) pg8::gemm_phase<pg8::EpiAny, pg8::StaticOrder, true, true, true>(F.lds, g, S, E); else pg8::gemm_phase<pg8::EpiAny, pg8::StaticOrder, true, true, false>(F.lds, g, S, E); }
        if constexpr (ISO(1)) if (qk_phase) {
            asm volatile("s_waitcnt vmcnt(0)" ::: "memory"); __syncthreads();
            pg8::StaticOrder S; pg8::Unit u; S.init(M_TOK, N_QK, F.G, F.bx);
            for (int i = 0; S.next(i, u); ++i) fix_own_tile(F, proj, u.pm, u.pn, 2 + (u.pn >> 2)); }
        if constexpr (ISO(2)) if (qk8_phase) {
            asm volatile("s_waitcnt vmcnt(0)" ::: "memory"); __syncthreads();
            pg8::StaticOrder S; pg8::Unit u; S.init(M_TOK, N_REST, F.G, F.bx);
            for (int i = 0; S.next(i, u); ++i) if (u.pn < 8) fix_own_tile(F, proj, u.pm, u.pn + 8, u.pn >> 2); }
        if constexpr (ISO(10)) if (pq_phase) {
            asm volatile("s_waitcnt vmcnt(0)" ::: "memory"); __syncthreads();
            pg8::StaticOrder S; pg8::Unit u; S.init(M_TOK, DM, F.G, F.bx);
            for (int i = 0; S.next(i, u); ++i) p13_topk_unit(F, u.pm, u.pn); }
        if constexpr (ISO(7)) if (mq_phase) {
            pg8::StaticOrder S; pg8::Unit u;
            if (F.bx < 128) { S.init(M_TOK, 512, F.G, F.bx); if (S.next(0, u)) norm_own_tile(F, (bf16*)(ws + WS_QM), 512, u.pm * 256, u.pn * 256, args.in[I_MEMQ_G], QK_C2); }
            else { S.init(NB * 256, 1024, F.G, F.bx - 128); if (S.next(0, u) && u.pn < 2) norm_own_tile(F, (bf16*)(ws + WS_KVM), 1024, u.pm * 256, u.pn * 256, args.in[I_MEMK_G], 1.f); }
            if (!(F.p0_mask & 8)) p8_convert_peer(F); }
#endif
        if (barrier_after && ph + 1 < args.ph_hi) xcd_barrier(bar);
    }
    if (xb_ld((unsigned*)(ctl + CW_BAR) + XB_TMO) != 0u) { const float q = __builtin_nanf(""); for (size_t i = (size_t)F.bx * 512 + F.tid; i < (size_t)M_TOK * DM / 4; i += (size_t)F.G * 512) ((f32x4*)args.out)[i] = (f32x4){q, q, q, q}; }
}

extern "C" void kernel_launch(void* const* d_in, const int* in_sizes, int n_in, void* d_out, int out_size, void* d_ws, size_t ws_size, hipStream_t stream) {
    static int grid = 0;
    if (grid == 0) {
        if (n_in != 23 || out_size != M_TOK * DM || ws_size < WS_END) { fprintf(stderr, "kernel_launch: unexpected shapes (n_in %d out %d ws %zu)\n", n_in, out_size, ws_size); grid = -1; return; }
        int dev = 0, cus = 0, per_cu = 0;
        if (hipGetDevice(&dev) != hipSuccess || hipDeviceGetAttribute(&cus, hipDeviceAttributeMultiprocessorCount, dev) != hipSuccess) { grid = -1; return; }
        if (hipFuncSetAttribute((const void*)mega_fwd, hipFuncAttributeMaxDynamicSharedMemorySize, LDS_BYTES) != hipSuccess) { fprintf(stderr, "hipFuncSetAttribute failed\n"); grid = -1; return; }
        if (hipOccupancyMaxActiveBlocksPerMultiprocessor(&per_cu, (const void*)mega_fwd, NWAVES * 64, LDS_BYTES) != hipSuccess || per_cu < 1) fprintf(stderr, "occupancy query reports %d\n", per_cu);
        (void)hipGetLastError();
        grid = cus;
        if (grid != 256) { fprintf(stderr, "kernel_launch: built for 256 CUs, got %d\n", cus); grid = -1; return; }
    }
    if (grid < 0) return;
    (void)hipMemsetAsync((char*)d_ws + WS_CTL, 0, CTL_ZERO_BYTES, stream);
    Args a{};
    for (int i = 0; i < 23; ++i) a.in[i] = (const float*)d_in[i];
    a.out = (float*)d_out; a.ws = (unsigned char*)d_ws;
#ifdef PROBE_PREFIX
    a.ph_lo = 0; a.ph_hi = PROBE_PREFIX;
#ifdef PROBE_P0_MASK
    a.p0_mask = PROBE_P0_MASK;
#else
    a.p0_mask = 3;
#endif
    hipLaunchKernelGGL(mega_fwd, dim3(grid), dim3(NWAVES * 64), LDS_BYTES, stream, a);
    (void)hipMemsetAsync((char*)d_ws + WS_CTL, 0, CTL_ZERO_BYTES, stream);
#endif
    a.ph_lo = 0; a.ph_hi = LAST_PHASE + 1; a.p0_mask = 3;
    hipLaunchKernelGGL(mega_fwd, dim3(grid), dim3(NWAVES * 64), LDS_BYTES, stream, a);
}
```

```cpp
#include <hip/hip_runtime.h>
#include <cstdio>
#include <cstdint>
#include <cmath>
namespace pg8 {
#define PG8_LAS __attribute__((address_space(3)))
typedef unsigned short bf16_t;
typedef short bf16x8 __attribute__((ext_vector_type(8)));
typedef float f32x4 __attribute__((ext_vector_type(4)));
typedef unsigned u32x4 __attribute__((ext_vector_type(4)));
constexpr int BM = 256, BK = 64, HALF = 128, HTB = HALF * BK * 2  , STAGE_BYTES = 8 * HTB, NXCD = 8, WGM = 8;

__host__ __device__ __forceinline__ int lds_byte(int r, int c) { const int st = (r >> 4) * 2 + (c >> 5), rr = r & 15, cc = c & 31, ob = rr * 64 + cc * 2; return st * 1024 + (ob ^ (((ob >> 9) & 1) << 5)); }
__host__ __device__ __forceinline__ void stage_rc(int b, int& R, int& C) { const int st = b / 1024, sb = b % 1024, swz = sb ^ (((sb >> 9) & 1) << 5); R = (st >> 1) * 16 + swz / 64; C = (st & 1) * 32 + (swz % 64) / 2; }
__host__ __device__ __forceinline__ int perm32(int rho) { const int n = rho >> 4, i = rho & 15; return 8 * (i >> 2) + 4 * n + (i & 3); }

struct Unit { int pm, pn, kp; };
typedef int pg8_v4i __attribute__((ext_vector_type(4)));
struct Gemm { const bf16_t* A; const bf16_t* Bt; int M, N, K, lda; int scale_b; int ldb; };

struct StaticOrder {
    int nM, nN, nwg, G, c, kshift = 0;
    __host__ __device__ __forceinline__ void init(int M, int N, int G_, int c_) { nM = M / BM; nN = N / BM; nwg = nM * nN; G = G_; c = c_; }
    __host__ __device__ __forceinline__ bool next(int i2, Unit& u) const {
        const int i = i2 >> kshift; u.kp = i2 & ((1 << kshift) - 1);
        const long L = (long)i * G + c; if (L >= nwg) return false;
        int wgid = (int)L; { const int q = nwg / NXCD, r = nwg % NXCD, xcd = wgid % NXCD, off = wgid / NXCD; wgid = (xcd < r ? xcd * (q + 1) : r * (q + 1) + (xcd - r) * q) + off; }
        const int nig = WGM * nN, gid = wgid / nig, fm = gid * WGM, gsz = (nM - fm) < WGM ? (nM - fm) : WGM;
        u.pm = fm + ((wgid % nig) % gsz); u.pn = (wgid % nig) / gsz; return true;
    }
    __device__ __forceinline__ void a_ready(const Unit&) const {}
    __device__ __forceinline__ void done(const Unit&) const {}
};

__device__ __forceinline__ unsigned cvt_pk_bf16(float lo, float hi) { unsigned r; asm volatile("v_cvt_pk_bf16_f32 %0, %1, %2" : "=v"(r) : "v"(lo), "v"(hi)); return r; }
typedef float f32x2 __attribute__((ext_vector_type(2)));
__device__ __forceinline__ f32x2 gelu_pk(f32x2 v) {
    const f32x2 av = __builtin_elementwise_abs(v), d = av * 0.2316418882f + 1.0f;
    f32x2 t; t.x = __builtin_amdgcn_rcpf(d.x); t.y = __builtin_amdgcn_rcpf(d.y);
    f32x2 q = t * 0.5307027145f + (-0.7265760135f); q = q * t + 0.7107068705f; q = q * t + (-0.142248368f); q = q * t + 0.127414796f; q = q * t;
    const f32x2 s = (v * v) * (-0.72134752044f);
    f32x2 e; e.x = __builtin_amdgcn_exp2f(s.x); e.y = __builtin_amdgcn_exp2f(s.y);
    const f32x2 m = v * (q * e), r = v - m;
    f32x2 o; o.x = v.x < 0.f ? m.x : r.x; o.y = v.y < 0.f ? m.y : r.y; return o;
}

template <int ACT  > struct EpiBf16 {
    static constexpr bool PERM = true, AFTER_DRAIN = false; static_assert(ACT == 0 || ACT == 1, "EpiBf16: ACT is 0 (none) or 1 (gelu_pk)");
    bf16_t* O; int ldc; const float* bias; int split_cols; size_t split_stride; float scale0;
    __device__ __forceinline__ void operator()(const f32x4 (&acc)[2][2][4][2], const Unit& u, int wr, int wc, int fr, int fq) const {
        const int row0 = u.pm * BM + wr * 64 + fr; int colt = u.pn * BM; bf16_t* base = O;
        float sc = 1.f; if (split_cols) { const int t = colt / split_cols; base += (size_t)t * split_stride; colt -= t * split_cols; if (t == 0) sc = scale0; }
        const int col0 = colt + wc * 32 + 8 * fq, bcol0 = u.pn * BM + wc * 32 + 8 * fq;
        f32x4 bv[2][2];
#pragma unroll
        for (int bj = 0; bj < 2; ++bj)
#pragma unroll
            for (int n = 0; n < 2; ++n) bv[bj][n] = bias ? *(const f32x4*)(bias + bcol0 + bj * HALF + 4 * n) : (f32x4){0.f, 0.f, 0.f, 0.f};
#pragma unroll
        for (int ai = 0; ai < 2; ++ai)
#pragma unroll
            for (int m = 0; m < 4; ++m) { bf16_t* rowp = base + (size_t)(row0 + ai * HALF + m * 16) * ldc + col0;
#pragma unroll
                for (int bj = 0; bj < 2; ++bj) { f32x4 v0 = acc[ai][bj][m][0] + bv[bj][0], v1 = acc[ai][bj][m][1] + bv[bj][1];
                    if (ACT == 1) { f32x2 a = gelu_pk((f32x2){v0[0], v0[1]}), b = gelu_pk((f32x2){v0[2], v0[3]}), c = gelu_pk((f32x2){v1[0], v1[1]}), d = gelu_pk((f32x2){v1[2], v1[3]});
                        v0 = (f32x4){a.x, a.y, b.x, b.y}; v1 = (f32x4){c.x, c.y, d.x, d.y}; }
                    v0 = v0 * sc; v1 = v1 * sc; u32x4 w; w.x = cvt_pk_bf16(v0[0], v0[1]); w.y = cvt_pk_bf16(v0[2], v0[3]); w.z = cvt_pk_bf16(v1[0], v1[1]); w.w = cvt_pk_bf16(v1[2], v1[3]);
                    *(u32x4*)(rowp + bj * HALF) = w; } }
    }
};

struct PanelStats {
    unsigned* xbuf;
    unsigned* cnt;
    unsigned* tmo;
    int ntn; float eps;
    unsigned code;
    __device__ __forceinline__ bool run(const f32x4 (&v)[2][2][4][2], const Unit& u, int wr, int wc, int fr, int fq, PG8_LAS unsigned char* lds, int wid, int lane) const {
        typedef float f32x2v __attribute__((ext_vector_type(2)));
        PG8_LAS f32x2v* P = (PG8_LAS f32x2v*)lds;
        PG8_LAS f32x2v* S = (PG8_LAS f32x2v*)(lds + 8192);
        PG8_LAS unsigned* flag = (PG8_LAS unsigned*)(lds + 8192 + 2048);
#pragma unroll
        for (int ai = 0; ai < 2; ++ai)
#pragma unroll
            for (int m = 0; m < 4; ++m) {
                float s = 0.f;
#pragma unroll
                for (int bj = 0; bj < 2; ++bj)
#pragma unroll
                    for (int n = 0; n < 2; ++n) { const f32x4 x = v[ai][bj][m][n]; s += (x[0] + x[1]) + (x[2] + x[3]); }
                s += __shfl_xor(s, 16); s += __shfl_xor(s, 32);
                const float mw = s * (1.0f / 64.0f); float q = 0.f;
#pragma unroll
                for (int bj = 0; bj < 2; ++bj)
#pragma unroll
                    for (int n = 0; n < 2; ++n) { const f32x4 d = v[ai][bj][m][n] - mw; q += (d[0] * d[0] + d[1] * d[1]) + (d[2] * d[2] + d[3] * d[3]); }
                q += __shfl_xor(q, 16); q += __shfl_xor(q, 32);
                if (fq == 0) P[(ai * HALF + wr * 64 + m * 16 + fr) * 4 + wc] = (f32x2v){mw, q};
            }
        asm volatile("s_waitcnt lgkmcnt(0)" ::: "memory"); __builtin_amdgcn_s_barrier(); asm volatile("" ::: "memory");
#if defined(BROKEN_EXCHANGE_NO_WAIT)
#warning BROKEN CONTROL BUILD: the row-statistics exchange does not wait; results are wrong by design
        if (blockIdx.x >= 64) { const long long t0_ = clock64(); while (clock64() - t0_ < 60000) __builtin_amdgcn_s_sleep(8); }
#endif
        const int row = wid * 32 + (lane & 31);
        if (lane < 32) {
            const f32x2v a = P[row * 4 + 0], b = P[row * 4 + 1], c = P[row * 4 + 2], d = P[row * 4 + 3];
            const float mt = (a.x + b.x + c.x + d.x) * 0.25f;
            const float da = a.x - mt, db = b.x - mt, dc = c.x - mt, dd = d.x - mt;
            const float m2 = (a.y + b.y) + (c.y + d.y) + 64.0f * ((da * da + db * db) + (dc * dc + dd * dd));
            unsigned long long* slot = (unsigned long long*)xbuf + ((size_t)(u.pm * BM + row) * 4 + u.pn);
            __hip_atomic_store(slot, ((unsigned long long)__float_as_uint(m2) << 32) | __float_as_uint(mt), __ATOMIC_RELAXED, __HIP_MEMORY_SCOPE_AGENT);
        }
        asm volatile("s_waitcnt vmcnt(0)" ::: "memory");
        if (lane == 0) __hip_atomic_fetch_add(cnt + 64 * u.pm, 1u, __ATOMIC_RELAXED, __HIP_MEMORY_SCOPE_AGENT);
        if (wid == 0) {
            bool dead = false; const unsigned long long t0 = __builtin_amdgcn_s_memrealtime(); const unsigned want = 8u * (unsigned)ntn;
            for (;;) {
#if defined(BROKEN_EXCHANGE_NO_WAIT)
                break;
#endif
                if ((unsigned)__builtin_amdgcn_readfirstlane(__hip_atomic_load(cnt + 64 * u.pm, __ATOMIC_RELAXED, __HIP_MEMORY_SCOPE_AGENT)) >= want) break;
                if (__builtin_amdgcn_s_memrealtime() - t0 > 2000000ull) {
                    if (lane == 0) { unsigned expect = 0u; __hip_atomic_compare_exchange_strong(tmo + 1, &expect, code | (unsigned)(u.pm & 0xff), __ATOMIC_RELAXED, __ATOMIC_RELAXED, __HIP_MEMORY_SCOPE_AGENT);
                                     __hip_atomic_store(tmo, 1u, __ATOMIC_RELAXED, __HIP_MEMORY_SCOPE_AGENT); }
                    dead = true; break; }
                __builtin_amdgcn_s_sleep(2);
            }
            __builtin_amdgcn_fence(__ATOMIC_ACQUIRE, "agent");
            if (lane == 0) flag[0] = dead ? 1u : 0u;
        }
        asm volatile("s_waitcnt vmcnt(0) lgkmcnt(0)" ::: "memory"); __builtin_amdgcn_s_barrier(); asm volatile("" ::: "memory");
        const bool bad = flag[0] != 0u;
        if (lane < 32) {
            const unsigned long long* slot = (const unsigned long long*)xbuf + (size_t)(u.pm * BM + row) * 4; float mt[4], m2[4]; float ms = 0.f;
#pragma unroll
            for (int t = 0; t < 4; ++t) { if (t < ntn) { const unsigned long long w = __hip_atomic_load(slot + t, __ATOMIC_RELAXED, __HIP_MEMORY_SCOPE_AGENT); mt[t] = __uint_as_float((unsigned)w); m2[t] = __uint_as_float((unsigned)(w >> 32)); } else { mt[t] = 0.f; m2[t] = 0.f; } ms += mt[t]; }
            const float mean = ms / (float)ntn; float q = 0.f;
#pragma unroll
            for (int t = 0; t < 4; ++t) if (t < ntn) { const float dm = mt[t] - mean; q += m2[t] + 256.0f * dm * dm; }
            S[row] = (f32x2v){mean, 1.0f / sqrtf(q / (256.0f * (float)ntn) + eps)};
        }
        asm volatile("s_waitcnt lgkmcnt(0)" ::: "memory"); __builtin_amdgcn_s_barrier(); asm volatile("" ::: "memory");
        return bad;
    }
};
struct EpiLnRes {
    static constexpr bool PERM = false, AFTER_DRAIN = true;
    const float* base; float* out; int ldc; const float* bias; PanelStats st; unsigned poison;
    __device__ __forceinline__ void fused(f32x4 (&acc)[2][2][4][2], const Unit& u, int wr, int wc, int fr, int fq, PG8_LAS unsigned char* lds, int wid, int lane) const {
        typedef float f32x2v __attribute__((ext_vector_type(2)));
        const PG8_LAS f32x2v* S = (const PG8_LAS f32x2v*)(lds + 8192);
        const int col0 = u.pn * BM + wc * 32 + 4 * fq;
#pragma unroll
        for (int bj = 0; bj < 2; ++bj)
#pragma unroll
            for (int n = 0; n < 2; ++n) { const f32x4 bv = bias ? *(const f32x4*)(bias + col0 + bj * HALF + n * 16) : (f32x4){0.f, 0.f, 0.f, 0.f};
#pragma unroll
                for (int ai = 0; ai < 2; ++ai)
#pragma unroll
                    for (int m = 0; m < 4; ++m) acc[ai][bj][m][n] += bv; }
        f32x4 pre[4][2][2];
#pragma unroll
        for (int m = 0; m < 4; ++m) { const size_t off = (size_t)(u.pm * BM + wr * 64 + m * 16 + fr) * ldc + col0;
#pragma unroll
            for (int bj = 0; bj < 2; ++bj)
#pragma unroll
                for (int n = 0; n < 2; ++n) pre[m][bj][n] = *(const f32x4*)(base + off + bj * HALF + n * 16); }
        const bool bad = st.run(acc, u, wr, wc, fr, fq, lds, wid, lane) || poison != 0u;
        const float qnan = __builtin_nanf("");
#pragma unroll
        for (int ai = 0; ai < 2; ++ai)
#pragma unroll
            for (int m = 0; m < 4; ++m) { const int r = ai * HALF + wr * 64 + m * 16 + fr; const f32x2v sr = S[r]; const size_t off = (size_t)(u.pm * BM + r) * ldc + col0;
#pragma unroll
                for (int bj = 0; bj < 2; ++bj)
#pragma unroll
                    for (int n = 0; n < 2; ++n) { const f32x4 bs = ai == 0 ? pre[m][bj][n] : *(const f32x4*)(base + off + bj * HALF + n * 16); f32x4 o = bs + (acc[ai][bj][m][n] - sr.x) * sr.y;
                        if (bad) o = (f32x4){qnan, qnan, qnan, qnan}; *(f32x4*)(out + off + bj * HALF + n * 16) = o; }
                if (m & 1) asm volatile("" ::: "memory"); }
    }
};
struct EpiLnResLn {
    static constexpr bool PERM = false, AFTER_DRAIN = true;
    const float* base; float* out; bf16_t* xn; int ldc; const float* bias; PanelStats st1, st2; unsigned poison;
    __device__ __forceinline__ void fused(f32x4 (&acc)[2][2][4][2], const Unit& u, int wr, int wc, int fr, int fq, PG8_LAS unsigned char* lds, int wid, int lane) const {
        typedef float f32x2v __attribute__((ext_vector_type(2))); typedef unsigned u32x2v __attribute__((ext_vector_type(2)));
        const PG8_LAS f32x2v* S = (const PG8_LAS f32x2v*)(lds + 8192);
        const int col0 = u.pn * BM + wc * 32 + 4 * fq;
#pragma unroll
        for (int bj = 0; bj < 2; ++bj)
#pragma unroll
            for (int n = 0; n < 2; ++n) { const f32x4 bv = bias ? *(const f32x4*)(bias + col0 + bj * HALF + n * 16) : (f32x4){0.f, 0.f, 0.f, 0.f};
#pragma unroll
                for (int ai = 0; ai < 2; ++ai)
#pragma unroll
                    for (int m = 0; m < 4; ++m) acc[ai][bj][m][n] += bv; }
        bool bad = st1.run(acc, u, wr, wc, fr, fq, lds, wid, lane) || poison != 0u;
        const float qnan = __builtin_nanf("");
#pragma unroll
        for (int ai = 0; ai < 2; ++ai)
#pragma unroll
            for (int m = 0; m < 4; ++m) { const int r = ai * HALF + wr * 64 + m * 16 + fr; const f32x2v sr = S[r]; const size_t off = (size_t)(u.pm * BM + r) * ldc + col0;
#pragma unroll
                for (int bj = 0; bj < 2; ++bj)
#pragma unroll
                    for (int n = 0; n < 2; ++n) { const f32x4 bs = *(const f32x4*)(base + off + bj * HALF + n * 16); acc[ai][bj][m][n] = bs + (acc[ai][bj][m][n] - sr.x) * sr.y; }
                asm volatile("" : "+v"(acc[ai][0][m][0]), "+v"(acc[ai][0][m][1]), "+v"(acc[ai][1][m][0]), "+v"(acc[ai][1][m][1]));
                if (m & 1) asm volatile("" ::: "memory"); }
        const bool bad1 = bad;
        bad = st2.run(acc, u, wr, wc, fr, fq, lds, wid, lane) || bad;
#pragma unroll
        for (int ai = 0; ai < 2; ++ai)
#pragma unroll
            for (int m = 0; m < 4; ++m) { const int r = ai * HALF + wr * 64 + m * 16 + fr; const f32x2v sr = S[r]; const size_t off = (size_t)(u.pm * BM + r) * ldc + col0;
#pragma unroll
                for (int bj = 0; bj < 2; ++bj)
#pragma unroll
                    for (int n = 0; n < 2; ++n) { const f32x4 x1 = acc[ai][bj][m][n]; *(f32x4*)(out + off + bj * HALF + n * 16) = bad1 ? (f32x4){qnan, qnan, qnan, qnan} : x1;
                        const f32x4 o = (x1 - sr.x) * sr.y; u32x2v w; w.x = cvt_pk_bf16(o[0], o[1]); w.y = cvt_pk_bf16(o[2], o[3]);
                        if (bad) { w.x = 0x7fc07fc0u; w.y = 0x7fc07fc0u; } *(u32x2v*)(xn + off + bj * HALF + n * 16) = w; }
                asm volatile("" ::: "memory"); }
    }
};

typedef int pg8_v8i __attribute__((ext_vector_type(8)));
template <bool FP8> struct Frag;
template <> struct Frag<false> { bf16x8 k[2]; };
template <> struct Frag<true> { pg8_v8i v; };
__device__ __forceinline__ void load_frag(Frag<false>& f, const PG8_LAS unsigned char* p) { f.k[0] = *(const PG8_LAS bf16x8*)p; f.k[1] = *(const PG8_LAS bf16x8*)(p + 1024); }
__device__ __forceinline__ void load_frag(Frag<true>& f, const PG8_LAS unsigned char* p) { const pg8_v4i a = *(const PG8_LAS pg8_v4i*)p, b = *(const PG8_LAS pg8_v4i*)(p + 1024); f.v = __builtin_shufflevector(a, b, 0, 1, 2, 3, 4, 5, 6, 7); }
__device__ __forceinline__ void mma_frag(f32x4& acc, const Frag<false>& b, const Frag<false>& a, int) { acc = __builtin_amdgcn_mfma_f32_16x16x32_bf16(b.k[0], a.k[0], acc, 0, 0, 0); acc = __builtin_amdgcn_mfma_f32_16x16x32_bf16(b.k[1], a.k[1], acc, 0, 0, 0); }
__device__ __forceinline__ void mma_frag(f32x4& acc, const Frag<true>& b, const Frag<true>& a, int scale_w) {
    asm volatile("v_mfma_scale_f32_16x16x128_f8f6f4 %0, %1, %2, %0, %3, %4 op_sel_hi:[0,0,0]" : "+v"(acc) : "v"(b.v), "v"(a.v), "v"(scale_w), "v"(0x7F7F7F7F)); }
template <class Epi, class Sched, bool ALIGN_EPI = false, bool SP2 = false, bool FP8 = false>
__device__ __forceinline__ void gemm_phase(PG8_LAS unsigned char* lds, const Gemm g, const Sched& S, const Epi& E) {
    int tid_ = threadIdx.x; asm volatile("" : "+v"(tid_));
    const int tid = tid_, wid = __builtin_amdgcn_readfirstlane(tid >> 6), lane = tid & 63, wr = wid >> 2, wc = wid & 3, fr = lane & 15, fq = lane >> 4;
    const int K = g.K, nt = K / BK;
    unsigned voffA[2], voffB[2];
#pragma unroll
    for (int i = 0; i < 2; ++i) { int R, C; stage_rc(tid * 16 + i * 8192, R, C); const int Rb = Epi::PERM ? ((R & ~31) + perm32(R & 31)) : R;
        voffA[i] = (unsigned)(R * g.lda + C) * 2u; voffB[i] = (unsigned)(Rb * g.ldb + C) * 2u; }
    const size_t kstep = (size_t)(BK * 2);
    const size_t hstepB = (size_t)HALF * g.ldb * 2, hstepA = (size_t)HALF * g.lda * 2;
    const size_t tstepB = 2 * hstepB, tstepA = 2 * hstepA;
    const unsigned ldsw = (unsigned)wid * 1024u;
    const int aoff = lds_byte(wr * 64 + fr, fq * 8), boff = lds_byte(wc * 32 + fr, fq * 8);
#define PG8_SA(b, h) (((b) * 2 + (h)) * HTB)
#define PG8_SB(b, h) ((4 + (b) * 2 + (h)) * HTB)
#define PG8_STAGE(bufoff, gbase, voff) do { _Pragma("unroll") for (int _i = 0; _i < 2; ++_i) \
        __builtin_amdgcn_global_load_lds((const unsigned*)((const char*)(gbase) + (voff)[_i]), (PG8_LAS unsigned*)(lds + (bufoff) + ldsw + _i * 8192), 16, 0, 0); } while (0)
#define PG8_LDA(dst, b, h) do { _Pragma("unroll") for (int m = 0; m < 4; ++m) load_frag(dst[m], lds + PG8_SA(b, h) + aoff + m * 2048); } while (0)
#define PG8_LDB(dst, b, h) do { _Pragma("unroll") for (int n = 0; n < 2; ++n) load_frag(dst[n], lds + PG8_SB(b, h) + boff + n * 2048); } while (0)
#define PG8_MMA(ai, bj, At, Bt) do { __builtin_amdgcn_s_setprio(1); _Pragma("unroll") for (int m = 0; m < 4; ++m) _Pragma("unroll") for (int n = 0; n < 2; ++n) mma_frag(acc[ai][bj][m][n], Bt[n], At[m], g.scale_b); \
        __builtin_amdgcn_s_setprio(0); } while (0)
#define PG8_WAIT_V(n) asm volatile("s_waitcnt vmcnt(" #n ")" ::: "memory")
#define PG8_WAIT_L(n) asm volatile("s_waitcnt lgkmcnt(" #n ")" ::: "memory")
#define PG8_BAR __builtin_amdgcn_s_barrier()
#define PG8_SCHED __builtin_amdgcn_sched_barrier(0)
    Unit cur, nxt; int ui = 0;
    if (!S.next(0, cur)) return;
    f32x4 acc[2][2][4][2];
#pragma unroll
    for (int a = 0; a < 2; ++a)
#pragma unroll
        for (int b = 0; b < 2; ++b)
#pragma unroll
            for (int m = 0; m < 4; ++m)
#pragma unroll
                for (int n = 0; n < 2; ++n) acc[a][b][m][n] = (f32x4){0.f, 0.f, 0.f, 0.f};
    Frag<FP8> At[4], B0[2], B1[2];
    const size_t kpart = (size_t)K * 2;
    const char* cA = (const char*)g.A + (size_t)cur.pm * tstepA + cur.kp * kpart; const char* cB = (const char*)g.Bt + (size_t)cur.pn * tstepB + cur.kp * kpart;
    S.a_ready(cur);
    if constexpr (SP2) {
        PG8_STAGE(PG8_SB(0, 0), cB, voffB); PG8_STAGE(PG8_SB(0, 1), cB + hstepB, voffB); PG8_STAGE(PG8_SA(0, 0), cA, voffA); PG8_STAGE(PG8_SA(0, 1), cA + hstepA, voffA);
        if (wr == 1) PG8_BAR;
        PG8_WAIT_V(2); PG8_BAR;
        PG8_STAGE(PG8_SB(1, 0), cB + kstep, voffB); PG8_STAGE(PG8_SA(1, 0), cA + kstep, voffA); PG8_STAGE(PG8_SB(1, 1), cB + hstepB + kstep, voffB);
        PG8_WAIT_V(6); PG8_BAR;
    } else {
        PG8_STAGE(PG8_SB(0, 0), cB, voffB); PG8_STAGE(PG8_SA(0, 0), cA, voffA); PG8_STAGE(PG8_SB(0, 1), cB + hstepB, voffB); PG8_STAGE(PG8_SA(0, 1), cA + hstepA, voffA);
        if (wr == 1) PG8_BAR;
        PG8_WAIT_V(4); PG8_BAR;
        PG8_STAGE(PG8_SB(1, 0), cB + kstep, voffB); PG8_STAGE(PG8_SA(1, 0), cA + kstep, voffA); PG8_STAGE(PG8_SB(1, 1), cB + hstepB + kstep, voffB);
        PG8_WAIT_V(6); PG8_BAR;
    }
    for (;;) {
        const bool has_next = S.next(ui + 1, nxt);
        const char* nA = has_next ? (const char*)g.A + (size_t)nxt.pm * tstepA + nxt.kp * kpart : cA; const char* nB = has_next ? (const char*)g.Bt + (size_t)nxt.pn * tstepB + nxt.kp * kpart : cB;
        for (int t = 0; t < nt; t += 2) {
            const bool last = (t == nt - 2);
            const char* a1 = cA + (size_t)(t + 1) * kstep;
            const char* a2 = last ? nA : cA + (size_t)(t + 2) * kstep; const char* b2 = last ? nB : cB + (size_t)(t + 2) * kstep;
            const char* a3 = a2 + kstep; const char* b3 = b2 + kstep;
            if (last && has_next) S.a_ready(nxt);
            if constexpr (SP2) {
            PG8_LDB(B0, 0, 0); PG8_LDB(B1, 0, 1); PG8_SCHED; PG8_LDA(At, 0, 0); PG8_STAGE(PG8_SA(1, 1), a1 + hstepA, voffA);
            PG8_WAIT_V(8); PG8_WAIT_L(0); PG8_BAR; PG8_MMA(0, 0, At, B0); PG8_MMA(0, 1, At, B1); PG8_BAR; PG8_SCHED;
            PG8_LDA(At, 0, 1); PG8_STAGE(PG8_SB(0, 0), b2, voffB); PG8_STAGE(PG8_SB(0, 1), b2 + hstepB, voffB); PG8_STAGE(PG8_SA(0, 0), a2, voffA);
            PG8_WAIT_V(8); PG8_WAIT_L(0); PG8_BAR; PG8_MMA(1, 0, At, B0); PG8_MMA(1, 1, At, B1); PG8_BAR; PG8_SCHED;
            PG8_LDB(B0, 1, 0); PG8_LDB(B1, 1, 1); PG8_SCHED; PG8_LDA(At, 1, 0); PG8_STAGE(PG8_SA(0, 1), a2 + hstepA, voffA);
            PG8_WAIT_V(8); PG8_WAIT_L(0); PG8_BAR; PG8_MMA(0, 0, At, B0); PG8_MMA(0, 1, At, B1); PG8_BAR; PG8_SCHED;
            PG8_LDA(At, 1, 1); PG8_STAGE(PG8_SB(1, 0), b3, voffB); PG8_STAGE(PG8_SB(1, 1), b3 + hstepB, voffB); PG8_STAGE(PG8_SA(1, 0), a3, voffA);
            PG8_WAIT_V(8); PG8_WAIT_L(0); PG8_BAR; PG8_MMA(1, 0, At, B0); PG8_MMA(1, 1, At, B1); PG8_BAR; PG8_SCHED;
            } else {
            PG8_LDB(B0, 0, 0); PG8_SCHED; PG8_LDA(At, 0, 0); PG8_STAGE(PG8_SA(1, 1), a1 + hstepA, voffA);
            PG8_WAIT_L(8); PG8_BAR; PG8_WAIT_L(0); PG8_MMA(0, 0, At, B0); PG8_BAR; PG8_SCHED;
            PG8_LDB(B1, 0, 1); PG8_STAGE(PG8_SB(0, 0), b2, voffB);
            PG8_BAR; PG8_WAIT_L(0); PG8_MMA(0, 1, At, B1); PG8_BAR;
            PG8_LDA(At, 0, 1); PG8_STAGE(PG8_SA(0, 0), a2, voffA);
            PG8_BAR; PG8_WAIT_L(0); PG8_MMA(1, 0, At, B0); PG8_BAR; PG8_SCHED;
            PG8_STAGE(PG8_SB(0, 1), b2 + hstepB, voffB);
            PG8_WAIT_V(6); PG8_BAR; PG8_MMA(1, 1, At, B1); PG8_BAR;
            PG8_LDB(B0, 1, 0); PG8_SCHED; PG8_LDA(At, 1, 0); PG8_STAGE(PG8_SA(0, 1), a2 + hstepA, voffA);
            PG8_WAIT_L(8); PG8_BAR; PG8_WAIT_L(0); PG8_MMA(0, 0, At, B0); PG8_BAR; PG8_SCHED;
            PG8_LDB(B1, 1, 1); PG8_STAGE(PG8_SB(1, 0), b3, voffB);
            PG8_BAR; PG8_WAIT_L(0); PG8_MMA(0, 1, At, B1); PG8_BAR;
            PG8_LDA(At, 1, 1); PG8_STAGE(PG8_SA(1, 0), a3, voffA);
            PG8_BAR; PG8_WAIT_L(0); PG8_MMA(1, 0, At, B0); PG8_BAR; PG8_SCHED;
            PG8_STAGE(PG8_SB(1, 1), b3 + hstepB, voffB);
            PG8_WAIT_V(6); PG8_BAR; PG8_MMA(1, 1, At, B1); PG8_BAR;
            }
        }
        if constexpr (ALIGN_EPI) { if (wr == 0) PG8_BAR; }
        if constexpr (FP8) { asm volatile("s_nop 15\n\ts_nop 15" ::: "memory"); }
        if constexpr (!Epi::AFTER_DRAIN) { E(acc, cur, wr, wc, fr, fq); S.done(cur); }
        if (!has_next) break;
        if (nxt.kp == 0)
#pragma unroll
        for (int a = 0; a < 2; ++a)
#pragma unroll
            for (int b = 0; b < 2; ++b)
#pragma unroll
                for (int m = 0; m < 4; ++m)
#pragma unroll
                    for (int n = 0; n < 2; ++n) acc[a][b][m][n] = (f32x4){0.f, 0.f, 0.f, 0.f};
        cur = nxt; cA = nA; cB = nB; ++ui;
        if constexpr (ALIGN_EPI) { if (wr == 1) PG8_BAR; }
    }
    PG8_WAIT_V(0);
    if constexpr (!ALIGN_EPI) { if (wr == 0) PG8_BAR; }
    PG8_BAR;
    if constexpr (Epi::AFTER_DRAIN) { E.fused(acc, cur, wr, wc, fr, fq, lds, wid, lane); S.done(cur); }
#undef PG8_SA
#undef PG8_SB
#undef PG8_STAGE
#undef PG8_LDA
#undef PG8_LDB
#undef PG8_MMA
#undef PG8_WAIT_V
#undef PG8_WAIT_L
#undef PG8_BAR
#undef PG8_SCHED
}
}

#ifndef PG8_SP2
#define PG8_SP2 true
#endif
#ifndef PG8_ALIGN
#define PG8_ALIGN true
#endif
namespace pg8 {
typedef unsigned u32x2e __attribute__((ext_vector_type(2)));
__device__ __forceinline__ float bfbits2f(unsigned b16) { return __uint_as_float(b16 << 16); }
__device__ __forceinline__ void unpack8(const u32x4 w, float (&f)[8]) {
    f[0] = __uint_as_float(w.x << 16); f[1] = __uint_as_float(w.x & 0xffff0000u); f[2] = __uint_as_float(w.y << 16); f[3] = __uint_as_float(w.y & 0xffff0000u);
    f[4] = __uint_as_float(w.z << 16); f[5] = __uint_as_float(w.z & 0xffff0000u); f[6] = __uint_as_float(w.w << 16); f[7] = __uint_as_float(w.w & 0xffff0000u);
}
__device__ __forceinline__ u32x4 pack8f(const float (&f)[8]) { u32x4 w; w.x = cvt_pk_bf16(f[0], f[1]); w.y = cvt_pk_bf16(f[2], f[3]); w.z = cvt_pk_bf16(f[4], f[5]); w.w = cvt_pk_bf16(f[6], f[7]); return w; }
__device__ __forceinline__ float sigmoid_f(float x) { return __builtin_amdgcn_rcpf(1.f + __builtin_amdgcn_exp2f(-1.4426950408889634f * x)); }

struct EpiProj {
    static constexpr bool PERM = true, AFTER_DRAIN = false;
    bf16_t* O; int ldc; int pn_off;
    __device__ __forceinline__ void operator()(const f32x4 (&acc)[2][2][4][2], const Unit& u, int wr, int wc, int fr, int fq) const {
        const int row0 = u.pm * BM + wr * 64 + fr, col0 = u.pn * BM + wc * 32 + 8 * fq;
        const int gpn = u.pn + pn_off; const int act = gpn < 24 ? 0 : (gpn < 28 ? 1 : 2);
#pragma unroll
        for (int ai = 0; ai < 2; ++ai)
#pragma unroll
            for (int m = 0; m < 4; ++m) { bf16_t* rowp = O + (size_t)(row0 + ai * HALF + m * 16) * ldc + col0;
#pragma unroll
                for (int bj = 0; bj < 2; ++bj) { float v[8];
#pragma unroll
                    for (int i = 0; i < 4; ++i) { v[i] = acc[ai][bj][m][0][i]; v[4 + i] = acc[ai][bj][m][1][i]; }
                    if (act != 0) {
#pragma unroll
                        for (int i = 0; i < 8; ++i) { const float s = sigmoid_f(v[i]); v[i] = (act == 1) ? v[i] * s : s; } }
                    *(u32x4*)(rowp + bj * HALF) = pack8f(v); } }
    }
};
struct EpiRowScale {
    static constexpr bool PERM = true, AFTER_DRAIN = false;
    bf16_t* O; int ldc; const float* rowss; float inv_n, eps;
    __device__ __forceinline__ void operator()(const f32x4 (&acc)[2][2][4][2], const Unit& u, int wr, int wc, int fr, int fq) const {
        const int row0 = u.pm * BM + wr * 64 + fr, col0 = u.pn * BM + wc * 32 + 8 * fq;
        float sc[2][4];
#pragma unroll
        for (int ai = 0; ai < 2; ++ai)
#pragma unroll
            for (int m = 0; m < 4; ++m) sc[ai][m] = rowss ? rowss[row0 + ai * HALF + m * 16] : 0.f;
#pragma unroll
        for (int ai = 0; ai < 2; ++ai)
#pragma unroll
            for (int m = 0; m < 4; ++m) { const int row = row0 + ai * HALF + m * 16; bf16_t* rowp = O + (size_t)row * ldc + col0;
                const float s = rowss ? 1.f / sqrtf(sc[ai][m] * inv_n + eps) : 1.f;
#pragma unroll
                for (int bj = 0; bj < 2; ++bj) { float v[8];
#pragma unroll
                    for (int i = 0; i < 4; ++i) { v[i] = acc[ai][bj][m][0][i] * s; v[4 + i] = acc[ai][bj][m][1][i] * s; }
                    *(u32x4*)(rowp + bj * HALF) = pack8f(v); } }
    }
};
template <bool ADD> struct EpiGate {
    static constexpr bool PERM = true, AFTER_DRAIN = false;
    bf16_t* O; int ldc; const bf16_t* Gt; int ldg; unsigned char* O8; int ld8;
    __device__ __forceinline__ void operator()(const f32x4 (&acc)[2][2][4][2], const Unit& u, int wr, int wc, int fr, int fq) const {
        const int row0 = u.pm * BM + wr * 64 + fr, col0 = u.pn * BM + wc * 32 + 8 * fq;
#pragma unroll
        for (int ai = 0; ai < 2; ++ai)
#pragma unroll
            for (int m = 0; m < 4; ++m) { const int row = row0 + ai * HALF + m * 16; bf16_t* rowp = O + (size_t)row * ldc + col0; const bf16_t* gp = Gt + (size_t)row * ldg + col0;
#pragma unroll
                for (int bj = 0; bj < 2; ++bj) { float v[8], g[8]; unpack8(*(const u32x4*)(gp + bj * HALF), g);
#pragma unroll
                    for (int i = 0; i < 4; ++i) { v[i] = acc[ai][bj][m][0][i] * g[i]; v[4 + i] = acc[ai][bj][m][1][i] * g[4 + i]; }
                    if (ADD) { float t[8]; unpack8(*(const u32x4*)(rowp + bj * HALF), t);
#pragma unroll
                        for (int i = 0; i < 8; ++i) v[i] += t[i];
                        int p0 = 0, p1 = 0; p0 = __builtin_amdgcn_cvt_pk_fp8_f32(v[0], v[1], p0, false); p0 = __builtin_amdgcn_cvt_pk_fp8_f32(v[2], v[3], p0, true);
                        p1 = __builtin_amdgcn_cvt_pk_fp8_f32(v[4], v[5], p1, false); p1 = __builtin_amdgcn_cvt_pk_fp8_f32(v[6], v[7], p1, true);
                        if (O8) *(u32x2e*)(O8 + (size_t)row * ld8 + col0 + bj * HALF) = (u32x2e){(unsigned)p0, (unsigned)p1}; else *(u32x4*)(rowp + bj * HALF) = pack8f(v); }
                    else *(u32x4*)(rowp + bj * HALF) = pack8f(v); } }
    }
};
struct EpiGate8 {
    static constexpr bool PERM = true, AFTER_DRAIN = false;
    const bf16_t* G1; int ldg; unsigned char* O8; int ld8;
    __device__ __forceinline__ void operator()(const f32x4 (&acc)[2][2][4][2], const Unit& u, int wr, int wc, int fr, int fq) const {
        const int row0 = u.pm * BM + wr * 64 + fr, col0 = u.pn * BM + wc * 32 + 8 * fq;
#pragma unroll
        for (int ai = 0; ai < 2; ++ai)
#pragma unroll
            for (int m = 0; m < 4; ++m) { const int row = row0 + ai * HALF + m * 16; const bf16_t* gp = G1 + (size_t)row * ldg + col0;
#pragma unroll
                for (int bj = 0; bj < 2; ++bj) { float v[8], g[8]; unpack8(*(const u32x4*)(gp + bj * HALF), g);
#pragma unroll
                    for (int i = 0; i < 4; ++i) { v[i] = acc[ai][bj][m][0][i] * g[i]; v[4 + i] = acc[ai][bj][m][1][i] * g[4 + i]; }
                    int p0 = 0, p1 = 0; p0 = __builtin_amdgcn_cvt_pk_fp8_f32(v[0], v[1], p0, false); p0 = __builtin_amdgcn_cvt_pk_fp8_f32(v[2], v[3], p0, true);
                    p1 = __builtin_amdgcn_cvt_pk_fp8_f32(v[4], v[5], p1, false); p1 = __builtin_amdgcn_cvt_pk_fp8_f32(v[6], v[7], p1, true);
                    *(u32x2e*)(O8 + (size_t)row * ld8 + col0 + bj * HALF) = (u32x2e){(unsigned)p0, (unsigned)p1}; } }
    }
};
struct EpiResid {
    static constexpr bool PERM = true, AFTER_DRAIN = false;
    const float* base32; const bf16_t* base16; bf16_t* XB; int ldc; float* rowss;
    __device__ __forceinline__ void operator()(const f32x4 (&acc)[2][2][4][2], const Unit& u, int wr, int wc, int fr, int fq) const {
        const int row0 = u.pm * BM + wr * 64 + fr, col0 = u.pn * BM + wc * 32 + 8 * fq;
#pragma unroll
        for (int ai = 0; ai < 2; ++ai)
#pragma unroll
            for (int m = 0; m < 4; ++m) { const int row = row0 + ai * HALF + m * 16; const size_t off = (size_t)row * ldc + col0; float ss = 0.f;
#pragma unroll
                for (int bj = 0; bj < 2; ++bj) { float b[8];
                    if (base32) { const f32x4 b0 = *(const f32x4*)(base32 + off + bj * HALF), b1 = *(const f32x4*)(base32 + off + bj * HALF + 4);
                        b[0] = b0[0]; b[1] = b0[1]; b[2] = b0[2]; b[3] = b0[3]; b[4] = b1[0]; b[5] = b1[1]; b[6] = b1[2]; b[7] = b1[3]; }
                    else unpack8(*(const u32x4*)(base16 + off + bj * HALF), b);
#pragma unroll
                    for (int i = 0; i < 4; ++i) { b[i] += acc[ai][bj][m][0][i]; b[4 + i] += acc[ai][bj][m][1][i]; }
#pragma unroll
                    for (int i = 0; i < 8; ++i) ss += b[i] * b[i];
                    *(u32x4*)(XB + off + bj * HALF) = pack8f(b); }
                ss += __shfl_xor(ss, 16); ss += __shfl_xor(ss, 32);
                if (fq == 0) atomicAdd(rowss + row, ss); }
    }
};
struct EpiAny {
    static constexpr bool PERM = true, AFTER_DRAIN = false;
    int kind; bf16_t* O; int ldc; const bf16_t* Gt; int ldg; const float* base; const bf16_t* base16; float* rowss; const float* rowss_in; int pn_off; unsigned char* O8; int ld8; const bf16_t* Gt2;
    __device__ __forceinline__ void mid(f32x4 (&acc)[2][2][4][2], const Unit& u, int wr, int wc, int fr, int fq) const {
        const int row0 = u.pm * BM + wr * 64 + fr, col0 = u.pn * BM + wc * 32 + 8 * fq;
#pragma unroll
        for (int ai = 0; ai < 2; ++ai)
#pragma unroll
            for (int m = 0; m < 4; ++m) { const int row = row0 + ai * HALF + m * 16; const bf16_t* g0p = Gt + (size_t)row * ldg + col0; const bf16_t* g1p = Gt2 + (size_t)row * ldg + col0;
#pragma unroll
                for (int bj = 0; bj < 2; ++bj) { float a[8], b[8]; unpack8(*(const u32x4*)(g0p + bj * HALF), a); unpack8(*(const u32x4*)(g1p + bj * HALF), b);
#pragma unroll
                    for (int i = 0; i < 4; ++i) { acc[ai][bj][m][0][i] *= a[i] * __builtin_amdgcn_rcpf(b[i]); acc[ai][bj][m][1][i] *= a[4 + i] * __builtin_amdgcn_rcpf(b[4 + i]); } }
                if (m & 1) asm volatile("" ::: "memory"); }
    }
    __device__ __forceinline__ void operator()(f32x4 (&acc)[2][2][4][2], const Unit& u, int wr, int wc, int fr, int fq) const {
        if (kind == 7 && u.kp == 0) { mid(acc, u, wr, wc, fr, fq); return; }
        if (kind == 0) { EpiProj e{O, ldc, pn_off}; e(acc, u, wr, wc, fr, fq); }
        else if (kind == 1) { EpiRowScale e{O, ldc, rowss_in, 1.f / 2048.f, 1e-6f}; e(acc, u, wr, wc, fr, fq); }
        else if (kind == 2) { EpiGate<false> e{O, ldc, Gt, ldg, nullptr, 0}; e(acc, u, wr, wc, fr, fq); }
        else if (kind == 3) { EpiGate<true> e{O, ldc, Gt, ldg, O8, ld8}; e(acc, u, wr, wc, fr, fq); }
        else if (kind == 6) { EpiGate<true> e{O, ldc, Gt, ldg, nullptr, 0}; e(acc, u, wr, wc, fr, fq); }
        else if (kind == 7) { EpiGate8 e{Gt2, ldg, O8, ld8}; e(acc, u, wr, wc, fr, fq); }
        else { EpiResid e{base, base16, O, ldc, rowss}; e(acc, u, wr, wc, fr, fq); }
    }
};
}
#ifndef ATT_QREG
#define ATT_QREG 1
#endif
namespace att {
using bf16 = unsigned short;
typedef short bf16x8 __attribute__((ext_vector_type(8)));
typedef short s16x4 __attribute__((ext_vector_type(4)));
typedef float f32x16 __attribute__((ext_vector_type(16)));
typedef float f32x4 __attribute__((ext_vector_type(4)));
typedef unsigned u32x4 __attribute__((ext_vector_type(4)));
constexpr int D = 128, NW = 8, QBLK = 32, KVBLK = 64, QB = NW * QBLK;
constexpr int SHM_V = KVBLK * D * 2, SHM_K = KVBLK * D * 2;
constexpr int LDS_WS = 2 * SHM_V + 2 * SHM_K;
constexpr int LDS_BIAS = LDS_WS + NW * 64 * 4;
constexpr int LDS_Q = LDS_BIAS + 2048 * 4;
constexpr int LDS_BYTES = LDS_Q + NW * 8192;
constexpr float THR = 8.f;

#define KSWZ(row, colB) ((row) * 256 + ((colB) ^ (((row) & 7) << 4)))
#define SBAR() __builtin_amdgcn_sched_barrier(0)
__device__ __forceinline__ int v_st(int k, int c) { const int kk = (k & ~0xC) | ((k & 4) << 1) | ((k & 8) >> 1); return ((kk >> 3) * 4 + (c >> 5)) * 512 + ((kk & 7) * 32 + (c & 31)) * 2; }
__device__ __forceinline__ int v_rd_base(int lane) { return ((lane & 3) << 3) | (((lane >> 2) & 3) << 6) | (((lane >> 4) & 1) << 5) | (((lane >> 5) & 1) << 8); }
constexpr int v_rd_off(int d0, int ks, int half) { return d0 * 512 + ks * 4096 + half * 2048; }
__device__ __forceinline__ int crow(int r, int hi) { return (r & 3) + 8 * (r >> 2) + 4 * hi; }
__device__ __forceinline__ unsigned cvtpk(float lo, float hi) { unsigned r; asm volatile("v_cvt_pk_bf16_f32 %0, %1, %2" : "=v"(r) : "v"(lo), "v"(hi)); return r; }
__device__ __forceinline__ bf16x8 load8(const bf16* p) { return *reinterpret_cast<const bf16x8*>(p); }
__device__ __forceinline__ float bf2f(unsigned short b) { return __uint_as_float((unsigned)b << 16); }

__device__ __forceinline__ void mask_tile(f32x16& p0, f32x16& p1, int dq) {
    const float NEG = -__builtin_inff();
#pragma unroll
    for (int r = 0; r < 16; ++r) {
        const int c = (r & 3) + 8 * (r >> 2);
        if (dq - c < 0) p0[r] = NEG;
        if (dq - c - 32 < 0) p1[r] = NEG;
    }
}
__device__ __forceinline__ void partialSM(f32x16& p0, f32x16& p1, float& m_reg, float& mn, float& alpha) {
    float pmax = p0[0]; for (int r = 1; r < 16; ++r) pmax = fmaxf(pmax, p0[r]); for (int r = 0; r < 16; ++r) pmax = fmaxf(pmax, p1[r]);
    { auto rr = __builtin_amdgcn_permlane32_swap(__float_as_uint(pmax), __float_as_uint(pmax), false, false);
      pmax = fmaxf(__uint_as_float(rr[0]), __uint_as_float(rr[1])); }
    if (__builtin_expect(__all((pmax - m_reg) <= THR), 1)) { mn = m_reg; alpha = 1.f; }
    else { mn = fmaxf(m_reg, pmax); alpha = __builtin_amdgcn_exp2f(m_reg - mn); m_reg = mn; }
    for (int r = 0; r < 16; ++r) p0[r] = p0[r] - mn; for (int r = 0; r < 16; ++r) p1[r] = p1[r] - mn;
    for (int r = 0; r < 16; ++r) p0[r] = __builtin_amdgcn_exp2f(p0[r]);
}
#define ATT_PK4(P, B_, OUT) do { unsigned a0 = cvtpk(P[B_+0], P[B_+1]), a1 = cvtpk(P[B_+2], P[B_+3]);                          \
        unsigned b0 = cvtpk(P[B_+4], P[B_+5]), b1 = cvtpk(P[B_+6], P[B_+7]);                                             \
        auto r0 = __builtin_amdgcn_permlane32_swap(a0, b0, false, false); auto r1 = __builtin_amdgcn_permlane32_swap(a1, b1, false, false); \
        u32x4 w = {r0[0], r1[0], r0[1], r1[1]}; OUT = *reinterpret_cast<bf16x8*>(&w); } while (0)
__device__ __forceinline__ void finishSM(f32x16& p0, f32x16& p1, float alpha, float& l_reg, bf16x8& pa0, bf16x8& pa1, bf16x8& pa2, bf16x8& pa3) {
    for (int r = 0; r < 16; ++r) p1[r] = __builtin_amdgcn_exp2f(p1[r]);
    float ps = 0; for (int r = 0; r < 16; ++r) ps += p0[r]; for (int r = 0; r < 16; ++r) ps += p1[r];
    { auto rr = __builtin_amdgcn_permlane32_swap(__float_as_uint(ps), __float_as_uint(ps), false, false);
      ps = __uint_as_float(rr[0]) + __uint_as_float(rr[1]); }
    l_reg = l_reg * alpha + ps;
    ATT_PK4(p0, 0, pa0); ATT_PK4(p0, 8, pa1); ATT_PK4(p1, 0, pa2); ATT_PK4(p1, 8, pa3);
}
__device__ __forceinline__ void ret_weight(f32x16& p0, f32x16& p1, int dq, float lg, int dist) {
    if (dist < 0) { p0 = f32x16{}; p1 = f32x16{}; return; }
    if (dist > 0) { const float f = __builtin_amdgcn_exp2f(lg * 64.f * (float)dist);
#pragma unroll
        for (int r = 0; r < 16; ++r) { p0[r] *= f; p1[r] *= f; }
        return; }
#pragma unroll
    for (int r = 0; r < 16; ++r) {
        const int c = (r & 3) + 8 * (r >> 2);
        const float e0 = 2.f * lg * fmaxf((float)(c - dq), 0.f), e1 = 2.f * lg * fmaxf((float)(c + 32 - dq), 0.f);
        p0[r] *= __builtin_amdgcn_exp2f(e0); p1[r] *= __builtin_amdgcn_exp2f(e1);
    }
}
__device__ __forceinline__ void ret_pack(f32x16& p0, f32x16& p1, bf16x8& pa0, bf16x8& pa1, bf16x8& pa2, bf16x8& pa3) {
    ATT_PK4(p0, 0, pa0); ATT_PK4(p0, 8, pa1); ATT_PK4(p1, 0, pa2); ATT_PK4(p1, 8, pa3);
}
template <int KB, bool BIAS>
__device__ __forceinline__ void qkt(f32x16& p0, f32x16& p1, const char* K_lds, int r32, int hi, const char* Qw  , const float* bias_tile  , const bf16x8* qr = nullptr) {
    if (BIAS) {
#pragma unroll
        for (int g = 0; g < 4; ++g) { const f32x4 b0 = *(const f32x4*)(bias_tile + 8 * g), b1 = *(const f32x4*)(bias_tile + 32 + 8 * g);
            p0[4 * g] = b0[0]; p0[4 * g + 1] = b0[1]; p0[4 * g + 2] = b0[2]; p0[4 * g + 3] = b0[3];
            p1[4 * g] = b1[0]; p1[4 * g + 1] = b1[1]; p1[4 * g + 2] = b1[2]; p1[4 * g + 3] = b1[3]; }
    } else { p0 = f32x16{}; p1 = f32x16{}; }
    int ko[4];
#pragma unroll
    for (int dd = 0; dd < 4; ++dd) ko[dd] = KSWZ(r32, (dd * 16 + hi * 8) * 2);
#pragma unroll
    for (int d0 = 0; d0 < 8; ++d0) { const char* a = K_lds + KB * SHM_K + ko[d0 & 3] + (d0 >> 2) * 128;
        bf16x8 b0 = *reinterpret_cast<const bf16x8*>(a);
        bf16x8 b1 = *reinterpret_cast<const bf16x8*>(a + 32 * 256);
#if ATT_QREG
        bf16x8 q = qr[d0];
#else
        bf16x8 q = *reinterpret_cast<const bf16x8*>(Qw + ko[d0 & 3] + (d0 >> 2) * 128);
#endif
        p0 = __builtin_amdgcn_mfma_f32_32x32x16_bf16(b0, q, p0, 0, 0, 0);
        p1 = __builtin_amdgcn_mfma_f32_32x32x16_bf16(b1, q, p1, 0, 0, 0); }
}
template <int VB>
__device__ __forceinline__ void pv_tile(f32x16* o, int vb0, bf16x8 pa0, bf16x8 pa1, bf16x8 pa2, bf16x8 pa3) {
#define TRRD(dst, off) asm volatile("ds_read_b64_tr_b16 %0, %1 offset:%2" : "=&v"(dst) : "v"(vb0), "i"(off) : "memory")
#define PV_D0(d0) do { s16x4 l0, l1, l2, l3, h0, h1, h2, h3; constexpr int b_ = VB * SHM_V + v_rd_off(d0, 0, 0); \
        TRRD(l0, b_); TRRD(h0, b_ + 2048); TRRD(l1, b_ + 4096); TRRD(h1, b_ + 6144); TRRD(l2, b_ + 8192); TRRD(h2, b_ + 10240); TRRD(l3, b_ + 12288); TRRD(h3, b_ + 14336); \
        asm volatile("s_waitcnt lgkmcnt(0)" ::: "memory"); SBAR();   \
        o[d0] = __builtin_amdgcn_mfma_f32_32x32x16_bf16(pa0, (bf16x8){l0[0], l0[1], l0[2], l0[3], h0[0], h0[1], h0[2], h0[3]}, o[d0], 0, 0, 0);   \
        o[d0] = __builtin_amdgcn_mfma_f32_32x32x16_bf16(pa1, (bf16x8){l1[0], l1[1], l1[2], l1[3], h1[0], h1[1], h1[2], h1[3]}, o[d0], 0, 0, 0);   \
        o[d0] = __builtin_amdgcn_mfma_f32_32x32x16_bf16(pa2, (bf16x8){l2[0], l2[1], l2[2], l2[3], h2[0], h2[1], h2[2], h2[3]}, o[d0], 0, 0, 0);   \
        o[d0] = __builtin_amdgcn_mfma_f32_32x32x16_bf16(pa3, (bf16x8){l3[0], l3[1], l3[2], l3[3], h3[0], h3[1], h3[2], h3[3]}, o[d0], 0, 0, 0); } while (0)
    PV_D0(0); PV_D0(1); PV_D0(2); PV_D0(3);
#undef PV_D0
#undef TRRD
}

struct BlockRef { const bf16* Q; const bf16* K; const bf16* V; bf16* O; int P0; int skv; float lg; const bf16* RG; const float* GN; unsigned char* O8;   };
struct Seam { bf16x8 qr[8]; bf16x8 st_v0, st_v1, st_k0, st_k1; };
template <int MODE> struct Pitch { static constexpr int LDQ = (MODE == 2) ? 512 : 11264, LDK = (MODE == 2) ? 1024 : 11264, LDO = LDQ; };

#define ROWK(p, k0, rr) ((p) + (size_t)((k0) + (rr)) * LDK + sc)
#define VMW() asm volatile("s_waitcnt vmcnt(0)" ::: "memory")
#define VMWN(n) asm volatile("s_waitcnt vmcnt(%0)" :: "i"(n) : "memory")
#define SLOAD_H(Kp, Vp, k0) do { S.st_v0 = load8(ROWK(Vp, k0, sr)); S.st_v1 = load8(ROWK(Vp, k0, 32 + sr));              \
                         S.st_k0 = load8(ROWK(Kp, k0, sr)); S.st_k1 = load8(ROWK(Kp, k0, 32 + sr)); } while (0)
#define SWRITE_HK(bf) do { *(bf16x8*)(K_lds + (bf) * SHM_K + kws) = S.st_k0; *(bf16x8*)(K_lds + (bf) * SHM_K + kws + 32 * 256) = S.st_k1; } while (0)
#define SWRITE_HV(bf) do { *(bf16x8*)(V_lds + (bf) * SHM_V + vst0) = S.st_v0; *(bf16x8*)(V_lds + (bf) * SHM_V + vst1) = S.st_v1; } while (0)
#define SWRITE_H(bf) do { SWRITE_HV(bf); SWRITE_HK(bf); } while (0)

template <int MODE>
__device__ __forceinline__ void attn_prime(const BlockRef& cur, char* lds, Seam& S) {
    constexpr int LDQ = Pitch<MODE>::LDQ, LDK = Pitch<MODE>::LDK;
    int tid_ = threadIdx.x; asm volatile("" : "+v"(tid_));
    const int tid = tid_, wid = __builtin_amdgcn_readfirstlane(tid >> 6), lane = tid & 63, r32 = lane & 31, hi = lane >> 5;
    const int sr = tid >> 4, sc = (tid & 15) * 8, kws = KSWZ(sr, sc * 2); char* K_lds = lds + 2 * SHM_V;
    const int kb0 = 0;
    for (int d0 = 0; d0 < 8; ++d0) S.qr[d0] = load8(cur.Q + (size_t)(wid * QBLK + r32) * LDQ + d0 * 16 + hi * 8);
    SLOAD_H(cur.K, cur.V, kb0); VMW(); SWRITE_HK(0);
    __syncthreads();
}
template <int MODE>
__device__ __forceinline__ void attn_block(const BlockRef& cur, const BlockRef& nxt, char* lds, Seam& S) {
    constexpr int LDQ = Pitch<MODE>::LDQ, LDK = Pitch<MODE>::LDK, LDO = Pitch<MODE>::LDO;
    constexpr bool BIAS = (MODE == 0), SOFTMAX = (MODE != 1);
    int tid_ = threadIdx.x; asm volatile("" : "+v"(tid_));
    const int tid = tid_, wid = __builtin_amdgcn_readfirstlane(tid >> 6), lane = tid & 63, r32 = lane & 31, hi = lane >> 5;
    const int j_lo = 0;
    int j_hi = (cur.P0 + QB - 1) / KVBLK + 1; if (j_hi > cur.skv / KVBLK) j_hi = cur.skv / KVBLK;
    const int NT = j_hi - j_lo;
    const int kbn = 0;
    const int qlo = cur.P0 + wid * QBLK, qm = qlo + r32 - 4 * hi;
    char* V_lds = lds; char* K_lds = lds + 2 * SHM_V;
    float* ws = (float*)(lds + LDS_WS) + wid * 64; float* li_l = ws, * al_l = ws + 32;
    const float* bias = (const float*)(lds + LDS_BIAS) + 4 * hi;
    float m_reg = -1e30f, l_reg = 0; f32x16 o[4] = {};
    const int sr = tid >> 4, sc = (tid & 15) * 8, vst0 = v_st(sr, sc), vst1 = v_st(32 + sr, sc), kws = KSWZ(sr, sc * 2);
    const int vb0 = (int)(uintptr_t)V_lds + v_rd_base(lane);
    const bf16* Kh = cur.K; const bf16* Vh = cur.V;
    const float lg = cur.lg; const int cq = qlo >> 6;
#define RESC(a) do { if (SOFTMAX) { if (__any((a) < 1.f)) { if (hi == 0) al_l[r32] = (a); asm volatile("s_waitcnt lgkmcnt(0)" ::: "memory");              \
                     for (int d_ = 0; d_ < 4; ++d_) for (int r = 0; r < 16; ++r) o[d_][r] *= al_l[crow(r, hi)]; } } } while (0)
#define KBASE(t) ((j_lo + (t)) * KVBLK)
#define POSTQK(P0_, P1_, mnX, alX, t) do { const int kb_ = KBASE(t); \
        if (MODE == 1) { ret_weight(P0_, P1_, qm - kb_, lg, cq - (j_lo + (t))); } \
        else { if (MODE == 0 && (kb_ + KVBLK - 1 > qlo)) mask_tile(P0_, P1_, qm - kb_); partialSM(P0_, P1_, m_reg, mnX, alX); } } while (0)
#define FINISH(P0_, P1_, alX) do { if (MODE == 1) ret_pack(P0_, P1_, pa0, pa1, pa2, pa3); else finishSM(P0_, P1_, alX, l_reg, pa0, pa1, pa2, pa3); } while (0)
    constexpr int NQL = 8;
#define SEAM_K0() do { VMWN(NQL); SWRITE_HK(0); SBAR(); } while (0)
    f32x16 pA0, pA1, pB0, pB1; float mnA = 0.f, mnB = 0.f, alA = 1.f, alB = 1.f; bf16x8 pa0, pa1, pa2, pa3;
    char* Qw = lds + LDS_Q + wid * 8192;
#if ATT_QREG
    const bf16x8* QR = S.qr;
#else
    const bf16x8* QR = nullptr;
#pragma unroll
    for (int d0 = 0; d0 < 8; ++d0) *(bf16x8*)(Qw + KSWZ(r32, (d0 * 16 + hi * 8) * 2)) = S.qr[d0];
#endif
    SWRITE_HV(0); SBAR();
    if (NT > 1) { SLOAD_H(Kh, Vh, KBASE(1)); }
    SBAR(); qkt<0, BIAS>(pA0, pA1, K_lds, r32, hi, Qw, bias + KBASE(0), QR);
    POSTQK(pA0, pA1, mnA, alA, 0);
    if (NT > 1) { VMW(); SWRITE_H(1); }
    __syncthreads();
#define HALF_STEP(PX0, PX1, mnX, alX, PY0, PY1, alY, t, KB, VB, SB) do {                                                      \
        SBAR(); qkt<KB, BIAS>(PX0, PX1, K_lds, r32, hi, Qw, bias + KBASE(t), QR);                                             \
        FINISH(PY0, PY1, alY); SBAR();                                                           \
        if ((t) + 1 < NT) { SLOAD_H(Kh, Vh, KBASE((t) + 1)); SBAR(); }                                               \
        pv_tile<VB>(o, vb0, pa0, pa1, pa2, pa3); POSTQK(PX0, PX1, mnX, alX, (t));                                        \
        __syncthreads();                                                                                                      \
        if ((t) + 1 < NT) { VMW(); SWRITE_H(SB); }                                                                          \
        RESC(alX); __syncthreads(); } while (0)
    for (int t = 1; t + 1 < NT; t += 2) {
        HALF_STEP(pB0, pB1, mnB, alB, pA0, pA1, alA, t, 1, 0, 0);
        HALF_STEP(pA0, pA1, mnA, alA, pB0, pB1, alB, t + 1, 0, 1, 1);
    }
    const bool even = (NT & 1) == 0;
    if (even) { SBAR(); qkt<1, BIAS>(pB0, pB1, K_lds, r32, hi, Qw, bias + KBASE(NT - 1), QR); SBAR(); }
    { constexpr int LDQn = LDQ; SLOAD_H(nxt.K, nxt.V, kbn); SBAR();
#pragma unroll
      for (int d0 = 0; d0 < 8; ++d0) S.qr[d0] = load8(nxt.Q + (size_t)(wid * QBLK + r32) * LDQn + d0 * 16 + hi * 8); }
    SBAR();
    FINISH(pA0, pA1, alA); SBAR();
    pv_tile<0>(o, vb0, pa0, pa1, pa2, pa3);
    if (even) { POSTQK(pB0, pB1, mnB, alB, NT - 1); __syncthreads(); RESC(alB);
        FINISH(pB0, pB1, alB); SBAR(); pv_tile<1>(o, vb0, pa0, pa1, pa2, pa3); }
    SBAR(); SEAM_K0();
    bf16* Ow = cur.O + (size_t)(wid * QBLK) * LDO;
    if (MODE != 1) {
        if (hi == 0) li_l[r32] = l_reg; asm volatile("s_waitcnt lgkmcnt(0)" ::: "memory");
        float rli[16];
#pragma unroll
        for (int r = 0; r < 16; ++r) rli[r] = __builtin_amdgcn_rcpf(li_l[crow(r, hi)]);
#pragma unroll
        for (int r = 0; r < 16; ++r) { const int orow = crow(r, hi);
#pragma unroll
            for (int d0 = 0; d0 < 4; ++d0) { const float v = o[d0][r] * rli[r];
                const float vn = __shfl_xor(v, 1);
                if (cur.O8) { const int pk = __builtin_amdgcn_cvt_pk_fp8_f32(v, vn, 0, false); const int pk2 = __shfl_xor(pk, 2);
                    if ((r32 & 3) == 0) *(unsigned*)(cur.O8 + (size_t)(wid * QBLK + orow) * (MODE == 2 ? 512 : 2048) + d0 * 32 + r32) = ((unsigned)pk & 0xFFFFu) | ((unsigned)pk2 << 16); }
                else if ((r32 & 1) == 0) *(unsigned*)(Ow + (size_t)orow * LDO + d0 * 32 + r32) = cvtpk(v, vn); } }
    } else {
        float gn[4];
#pragma unroll
        for (int d0 = 0; d0 < 4; ++d0) gn[d0] = cur.GN[d0 * 32 + r32];
        const bf16* RGw = cur.RG + (size_t)(wid * QBLK) * LDO;
#pragma unroll
        for (int r = 0; r < 16; ++r) { const int orow = crow(r, hi);
            float s = (o[0][r] + o[1][r]) + (o[2][r] + o[3][r]);
#pragma unroll
            for (int x = 1; x < 32; x <<= 1) s += __shfl_xor(s, x);
            const float mean = s * (1.f / 128.f);
            float q = 0.f;
#pragma unroll
            for (int d0 = 0; d0 < 4; ++d0) { const float dlt = o[d0][r] - mean; q += dlt * dlt; }
#pragma unroll
            for (int x = 1; x < 32; x <<= 1) q += __shfl_xor(q, x);
            const float rstd = 1.f / sqrtf(q * (1.f / 128.f) + 1e-6f);
#pragma unroll
            for (int d0 = 0; d0 < 4; ++d0) { const float g = bf2f(RGw[(size_t)orow * LDO + d0 * 32 + r32]);
                const float v = (o[d0][r] - mean) * rstd * gn[d0] * g;
                const float vn = __shfl_xor(v, 1);
                if (cur.O8) { const int pk = __builtin_amdgcn_cvt_pk_fp8_f32(v, vn, 0, false); const int pk2 = __shfl_xor(pk, 2);
                    if ((r32 & 3) == 0) *(unsigned*)(cur.O8 + (size_t)(wid * QBLK + orow) * 2048 + d0 * 32 + r32) = ((unsigned)pk & 0xFFFFu) | ((unsigned)pk2 << 16); }
                else if ((r32 & 1) == 0) *(unsigned*)(Ow + (size_t)orow * LDO + d0 * 32 + r32) = cvtpk(v, vn); } }
    }
    __syncthreads();
#undef RESC
#undef KBASE
#undef POSTQK
#undef FINISH
#undef SEAM_K0
#undef HALF_STEP
}
#undef ROWK
#undef VMW
#undef VMWN
#undef SLOAD_H
#undef SWRITE_HK
#undef SWRITE_HV
#undef SWRITE_H
#undef SBAR
#undef KSWZ
#undef ATT_PK4
}
#define GAS __attribute__((address_space(1)))
#define LAS __attribute__((address_space(3)))
typedef unsigned short bf16;
typedef unsigned v4u __attribute__((ext_vector_type(4)));
typedef float f32x4 __attribute__((ext_vector_type(4)));
typedef short bf16x8 __attribute__((ext_vector_type(8)));
typedef GAS unsigned gu32;
typedef GAS unsigned long long gu64;
#define RLX_AGENT __ATOMIC_RELAXED, __HIP_MEMORY_SCOPE_AGENT
#define LDS_WAIT() asm volatile("s_waitcnt lgkmcnt(0)" ::: "memory")
#define VM_WAIT() asm volatile("s_waitcnt vmcnt(0)" ::: "memory")
__device__ __forceinline__ unsigned long long rt() { return __builtin_amdgcn_s_memrealtime(); }
__device__ __forceinline__ unsigned f2bf(float f) { unsigned u = __builtin_bit_cast(unsigned, f); return (u + 0x7fffu + ((u >> 16) & 1u)) >> 16; }
__device__ __forceinline__ unsigned pk2(float lo, float hi) { return f2bf(lo) | (f2bf(hi) << 16); }

#define XB_TMO      128
#define XB_XCNT(j)  (256  + 64 * (j))
#define XB_XSUB(j)  (1280 + 64 * (j))
#define XB_XGEN(j)  (2304 + 64 * (j))
#define XB_TOP      3328
#define XB_TOPGEN   3392
#define XCD_BAR_WORDS 3456
#define XB_SPIN_CAP (1u << 18)

__device__ __forceinline__ unsigned xb_ld(unsigned* p)              { return __hip_atomic_load(p, __ATOMIC_RELAXED, __HIP_MEMORY_SCOPE_AGENT); }
__device__ __forceinline__ unsigned xb_add(unsigned* p, unsigned v) { return __hip_atomic_fetch_add(p, v, __ATOMIC_RELAXED, __HIP_MEMORY_SCOPE_AGENT); }
__device__ __forceinline__ unsigned xb_xcc_id() { return (unsigned)__builtin_amdgcn_s_getreg((3 << 11) | 20) & 0xFu; }
#define XB_SPIN(cond, bar) do { unsigned _sp = 0; while (cond) { __builtin_amdgcn_s_sleep(1); \
    if ((++_sp & 255u) == 0u) { if (xb_ld(&(bar)[XB_TMO])) break; if (_sp > XB_SPIN_CAP) { atomicAdd(&(bar)[XB_TMO], 1u); break; } } } } while (0)

struct XcdBarrier {
    unsigned* bar; unsigned x;
    volatile LAS unsigned* st;
};

__device__ __forceinline__ XcdBarrier xcd_barrier_post(unsigned* bar, volatile LAS unsigned* st) {
    XcdBarrier b; b.bar = bar; b.x = xb_xcc_id(); b.st = st;
    if (threadIdx.x == 0) (void)xb_add(&bar[XB_XCNT(b.x)], 1u);
    return b;
}
__device__ __forceinline__ void xcd_barrier_complete(unsigned* bar, unsigned x, unsigned& nloc, unsigned& nx) {
    const unsigned G = gridDim.x * gridDim.y * gridDim.z;
    unsigned sum, cnt, mine, sp = 0u;
    for (;;) {
        sum = 0u; cnt = 0u; mine = 0u;
#pragma unroll
        for (unsigned j = 0; j < 16; ++j) { const unsigned c = xb_ld(&bar[XB_XCNT(j)]); sum += c; cnt += (c > 0u) ? 1u : 0u; mine = (j == x) ? c : mine; }
        if (sum == G) break;
        __builtin_amdgcn_s_sleep(1);
        if ((++sp & 255u) == 0u) { if (xb_ld(&bar[XB_TMO])) break; if (sp > XB_SPIN_CAP) { atomicAdd(&bar[XB_TMO], 1u); break; } }
    }
    nloc = mine > 0u ? mine : 1u; nx = cnt > 0u ? cnt : 1u;
}

__device__ __forceinline__ void xcd_barrier(const XcdBarrier& b) {
    asm volatile("s_waitcnt vmcnt(0)" ::: "memory");
    __syncthreads();
    if (threadIdx.x == 0) {
        unsigned* bar = b.bar;
        __builtin_amdgcn_s_waitcnt(0);
        unsigned nloc = b.st[0], nx = b.st[1];
        if (nloc == 0u) { xcd_barrier_complete(bar, b.x, nloc, nx); b.st[0] = nloc; b.st[1] = nx; }
        const unsigned old = xb_add(&bar[XB_XSUB(b.x)], 1u);
        const unsigned gen = old / nloc;
        if (old + 1u == (gen + 1u) * nloc) {
            __builtin_amdgcn_fence(__ATOMIC_RELEASE, "agent");
            asm volatile("s_waitcnt vmcnt(0)" ::: "memory");
            const unsigned og = xb_add(&bar[XB_TOP], 1u);
            const unsigned tg = og / nx;
            if (og + 1u == (tg + 1u) * nx) xb_add(&bar[XB_TOPGEN], 1u);
            else XB_SPIN(xb_ld(&bar[XB_TOPGEN]) == tg, bar);
            __builtin_amdgcn_fence(__ATOMIC_ACQUIRE, "agent");
            xb_add(&bar[XB_XGEN(b.x)], 1u);
            asm volatile("s_waitcnt vmcnt(0)" ::: "memory");
        } else {
            XB_SPIN(xb_ld(&bar[XB_XGEN(b.x)]) == gen, bar);
            __builtin_amdgcn_fence(__ATOMIC_ACQUIRE, "agent");
            asm volatile("s_waitcnt vmcnt(0)" ::: "memory");
        }
    }
    __syncthreads();
}
constexpr int NWAVES = 8;
constexpr int M_TOK = 16384, DM = 2048, SEQ = 2048, NB = 8;
constexpr int PP = 11264;
constexpr int C_RQ = 0, C_RK = 1024, C_FQ = 2048, C_FK = 3072, C_FV = 4096, C_RV = 5120, C_RG = 6144, C_G0 = 7168, C_G1 = 9216;
constexpr int N_QK = 2048, N_REST = 9216;
#ifndef FP8_UP_OUT
#define FP8_UP_OUT 1
#endif
constexpr int W8_SCALE_B = 0x79797979;
constexpr int N_IN_ORIG = 11272;
constexpr float RMS_EPS = 1e-6f;
constexpr float QK_C2 = 0.08838834764831845f * 1.4426950408889634f;
constexpr size_t MiB = 1u << 20;
constexpr size_t DO_XN8 = 0, DO_OCAT8 = 32 * MiB;
constexpr size_t DO_OFOX8 = DO_OCAT8, DO_ORET8 = DO_OCAT8 + 1024;
constexpr size_t WS_CTL = 0, CTL_ZERO_BYTES = 1 * MiB;
constexpr size_t WS_ROWSS1 = 256 * 1024, WS_ROWSS2 = 512 * 1024;
constexpr size_t WS_WIN = 1 * MiB, WS_WFOX = 45 * MiB, WS_WRET = 49 * MiB, WS_WOUT = 53 * MiB, WS_WMQ = 61 * MiB, WS_WMKV = 63 * MiB, WS_WMO = 67 * MiB, WS_WPQ = 69 * MiB, WS_SUBK = 77 * MiB;
constexpr size_t WS_PSCALE = 79 * MiB;
constexpr size_t WS_LOGF = 78 * MiB, WS_CUMF = 78 * MiB + 512 * 1024;
constexpr size_t WS_XN = 80 * MiB;
constexpr size_t WS_PROJ = 144 * MiB;
constexpr size_t WS_MN = 496 * MiB, WS_KVM = 504 * MiB, WS_END = 508 * MiB;
constexpr size_t WS_XB1B = 144 * MiB;
constexpr size_t WS_XB2 = FP8_UP_OUT ? WS_XB1B : WS_XN;
constexpr size_t WS_XB1 = FP8_UP_OUT ? WS_XN   : WS_XB1B, WS_QM = 208 * MiB, WS_OMEM = 224 * MiB, WS_PU = 240 * MiB, WS_PV = 304 * MiB, WS_QP = (FP8_UP_OUT ? 368 : 144) * MiB  , WS_IDX = 208 * MiB, WS_GATE = 216 * MiB;
constexpr int CW_BAR = 4096, CW_CONV = 64;
constexpr int RING_BYTES = 131072, LDS_BYTES = 147456, LDSCTL_OFF = LDS_BYTES - 1024, MISC_OFF = LDSCTL_OFF + 320;
static_assert(att::LDS_BYTES <= LDSCTL_OFF, "attention LDS");

struct Args { const float* in[23]; float* out; unsigned char* ws; int ph_lo, ph_hi; int p0_mask, pad; };
enum { I_X = 0, I_MEM, I_LN_MIX, I_W_IN, I_B_FORGET, I_FOXQ_G, I_FOXK_G, I_RET_G, I_W_FOXUP, I_W_RETUP, I_W_OUT, I_LN_MEM, I_MEMNORM_G, I_W_MQ, I_W_MKV, I_MEMQ_G, I_MEMK_G, I_W_MO, I_LN_FFN, I_W_PQ, I_SUBK, I_PEER_U, I_PEER_V };

__device__ __forceinline__ float wave_sum(float v) {
#pragma unroll
    for (int o = 1; o < 64; o <<= 1) v += __shfl_xor(v, o);
    return v;
}
__device__ __forceinline__ void transpose_item(const float* W, int ldw, int K, int src_col0, const float* kgain, bf16* WT, int dst_row0, LAS float* scr, int kb, int nb, int lane) {
    const int k0 = 64 * kb, n0 = 32 * nb;
    f32x4 ld[8];
#pragma unroll
    for (int i = 0; i < 8; ++i) ld[i] = *(const GAS f32x4*)(W + (size_t)(k0 + 8 * i + (lane >> 3)) * ldw + src_col0 + n0 + 4 * (lane & 7));
#pragma unroll
    for (int i = 0; i < 8; ++i) { const int kk = 8 * i + (lane >> 3); f32x4 v = ld[i]; if (kgain) v = v * kgain[k0 + kk]; LAS float* d = scr + kk * 33 + 4 * (lane & 7); d[0] = v.x; d[1] = v.y; d[2] = v.z; d[3] = v.w; }
    LDS_WAIT(); asm volatile("" ::: "memory");
    const int c = lane & 7;
#pragma unroll
    for (int j = 0; j < 4; ++j) { const int n = (lane >> 3) + 8 * j; const LAS float* s = scr + (8 * c) * 33 + n;
        v4u o; o.x = pk2(s[0 * 33], s[1 * 33]); o.y = pk2(s[2 * 33], s[3 * 33]); o.z = pk2(s[4 * 33], s[5 * 33]); o.w = pk2(s[6 * 33], s[7 * 33]);
        *(GAS v4u*)(WT + (size_t)(dst_row0 + n0 + n) * K + k0 + 8 * c) = o; }
    LDS_WAIT(); asm volatile("" ::: "memory");
}
__device__ __forceinline__ void transpose_item8(const float* W, int ldw, int K  , int src_col0, unsigned char* WT8  , int kb, int nb, LAS float* scr, int lane) {
    const int k0 = 64 * kb, n0 = 32 * nb;
    f32x4 ld[8];
#pragma unroll
    for (int i = 0; i < 8; ++i) ld[i] = *(const GAS f32x4*)(W + (size_t)(k0 + 8 * i + (lane >> 3)) * ldw + src_col0 + n0 + 4 * (lane & 7));
#pragma unroll
    for (int i = 0; i < 8; ++i) { const int kk = 8 * i + (lane >> 3); const f32x4 v = ld[i] * 64.f; LAS float* d = scr + kk * 33 + 4 * (lane & 7); d[0] = v.x; d[1] = v.y; d[2] = v.z; d[3] = v.w; }
    LDS_WAIT(); asm volatile("" ::: "memory");
    const int c = lane & 7;
#pragma unroll
    for (int j = 0; j < 4; ++j) { const int n = (lane >> 3) + 8 * j; const LAS float* s = scr + (8 * c) * 33 + n;
        int p0 = 0, p1 = 0; p0 = __builtin_amdgcn_cvt_pk_fp8_f32(s[0 * 33], s[1 * 33], p0, false); p0 = __builtin_amdgcn_cvt_pk_fp8_f32(s[2 * 33], s[3 * 33], p0, true);
        p1 = __builtin_amdgcn_cvt_pk_fp8_f32(s[4 * 33], s[5 * 33], p1, false); p1 = __builtin_amdgcn_cvt_pk_fp8_f32(s[6 * 33], s[7 * 33], p1, true);
        *(GAS unsigned long long*)(WT8 + (size_t)(n0 + n) * K + k0 + 8 * c) = (unsigned long long)(unsigned)p0 | ((unsigned long long)(unsigned)p1 << 32); }
    LDS_WAIT(); asm volatile("" ::: "memory");
}
struct TJob { const float* W; int ldw, K, N; const float* gain; bf16* WT; int fp8; };

__device__ __forceinline__ void rms_row_to_bf16(const float* xrow, const float* gain, bf16* orow, int lane, f32x4 (&hv)[8], unsigned char* orow8 = nullptr) {
    const GAS f32x4* xr = (const GAS f32x4*)xrow + lane; float s = 0.f;
#pragma unroll
    for (int j = 0; j < 8; ++j) { hv[j] = xr[64 * j]; s += (hv[j].x * hv[j].x + hv[j].y * hv[j].y) + (hv[j].z * hv[j].z + hv[j].w * hv[j].w); }
    const float r = 1.f / sqrtf(wave_sum(s) * (1.f / DM) + RMS_EPS);
    GAS unsigned long long* o8 = (GAS unsigned long long*)orow + lane;
#pragma unroll
    for (int j = 0; j < 8; ++j) { const f32x4 g = ((const GAS f32x4*)gain)[lane + 64 * j]; hv[j] = hv[j] * r * g;
        o8[64 * j] = (unsigned long long)pk2(hv[j].x, hv[j].y) | ((unsigned long long)pk2(hv[j].z, hv[j].w) << 32);
        if (orow8) { int p = 0; p = __builtin_amdgcn_cvt_pk_fp8_f32(hv[j].x, hv[j].y, p, false); p = __builtin_amdgcn_cvt_pk_fp8_f32(hv[j].z, hv[j].w, p, true); ((GAS unsigned*)orow8)[lane + 64 * j] = (unsigned)p; } }
}
__device__ __forceinline__ float log_sigmoid_f(float z) { return fminf(z, 0.f) - 0.6931471805599453f * __builtin_amdgcn_logf(1.f + __builtin_amdgcn_exp2f(-1.4426950408889634f * fabsf(z))); }

struct Frame { LAS unsigned char* lds; unsigned char* ldsg; int tid, lane, wave, G, bx, p0_mask; const float* const* in; float* out; unsigned char* ws; };

__device__ __forceinline__ void p0_prologue(Frame& F) {
    const int gw = F.bx * NWAVES + F.wave, NGW = F.G * NWAVES;
    if (F.p0_mask & 1) {
        LAS float* scr = (LAS float*)(F.lds + F.wave * 16384);
        const TJob jobs[9] = {
            {F.in[I_W_IN], N_IN_ORIG, 2048, N_QK, nullptr, (bf16*)(F.ws + WS_WIN), 0},
            {F.in[I_W_IN], N_IN_ORIG, 2048, N_REST, nullptr, (bf16*)(F.ws + WS_WIN + 16 * MiB), 1},
            {F.in[I_W_FOXUP], 2048, 1024, 2048, nullptr, (bf16*)(F.ws + WS_WFOX), FP8_UP_OUT},
            {F.in[I_W_RETUP], 2048, 1024, 2048, nullptr, (bf16*)(F.ws + (FP8_UP_OUT ? WS_WFOX + 1024 : WS_WRET)), FP8_UP_OUT},
            {F.in[I_W_OUT], 2048, 2048, 2048, nullptr, (bf16*)(F.ws + WS_WOUT), FP8_UP_OUT},
            {F.in[I_W_MQ], 512, 2048, 512, F.in[I_LN_MEM], (bf16*)(F.ws + WS_WMQ), 0},
            {F.in[I_W_MKV], 1024, 2048, 1024, nullptr, (bf16*)(F.ws + WS_WMKV), 0},
            {F.in[I_W_MO], 2048, 512, 2048, nullptr, (bf16*)(F.ws + WS_WMO), 1},
            {F.in[I_W_PQ], 2048, 2048, 2048, F.in[I_LN_FFN], (bf16*)(F.ws + WS_WPQ), 0} };
        int base = 0;
#pragma unroll
        for (int j = 0; j < 9; ++j) {
            const TJob& J = jobs[j]; const int nblk = J.N / 32, items = (J.K / 64) * nblk;
            int first = gw - (base % NGW); if (first < 0) first += NGW;
            for (int r = first; r < items; r += NGW) { const int kb = r / nblk, nb = r % nblk;
                int src_col0 = 0;
                if (j == 0) src_col0 = 3080;
                if (j == 1) src_col0 = (nb * 32 < 3072) ? 0 : 2056;
                if (J.fp8) transpose_item8(J.W, J.ldw, (FP8_UP_OUT && (j == 2 || j == 3)) ? 2048 : J.K, src_col0, (unsigned char*)J.WT, kb, nb, scr, F.lane);
                else transpose_item(J.W, J.ldw, J.K, src_col0, J.gain, J.WT, 0, scr, kb, nb, F.lane); }
            base += items;
        }
    }
    if (F.p0_mask & 1) {
        const float* sk = F.in[I_SUBK]; bf16* o = (bf16*)(F.ws + WS_SUBK);
        for (int i = (F.bx * 512 + F.tid) * 4; i < 16 * 128 * 128; i += F.G * 512 * 4) { const f32x4 v = *(const GAS f32x4*)(sk + i);
            *(GAS unsigned long long*)(o + i) = (unsigned long long)pk2(v.x, v.y) | ((unsigned long long)pk2(v.z, v.w) << 32); }
    }
    __syncthreads();
    if (F.p0_mask & 2) {
        LAS float* wf = (LAS float*)F.lds; const float* w = F.in[I_W_IN];
        for (int k = F.tid; k < 2048; k += 512) { const f32x4 a = *(const GAS f32x4*)(w + (size_t)k * N_IN_ORIG + 3072), b = *(const GAS f32x4*)(w + (size_t)k * N_IN_ORIG + 3076);
            wf[0 * 2048 + k] = a.x; wf[1 * 2048 + k] = a.y; wf[2 * 2048 + k] = a.z; wf[3 * 2048 + k] = a.w; wf[4 * 2048 + k] = b.x; wf[5 * 2048 + k] = b.y; wf[6 * 2048 + k] = b.z; wf[7 * 2048 + k] = b.w; }
    }
    __syncthreads();
    if (F.p0_mask & 2) {
        const LAS float* wf = (const LAS float*)F.lds; const float* bfg = F.in[I_B_FORGET]; float* logf_o = (float*)(F.ws + WS_LOGF);
        for (int m = gw; m < M_TOK; m += NGW) { f32x4 hv[8];
            rms_row_to_bf16(F.in[I_X] + (size_t)m * DM, F.in[I_LN_MIX], (bf16*)(F.ws + WS_XN) + (size_t)m * DM, F.lane, hv, (unsigned char*)F.out + DO_XN8 + (size_t)m * DM);
            float z = 0.f;
#pragma unroll
            for (int q = 0; q < 8; ++q) { float acc = 0.f;
#pragma unroll
                for (int j = 0; j < 8; ++j) { const f32x4 wv = *(const LAS f32x4*)(wf + q * 2048 + 4 * F.lane + 256 * j); acc += (hv[j].x * wv.x + hv[j].y * wv.y) + (hv[j].z * wv.z + hv[j].w * wv.w); }
                acc = wave_sum(acc); z = (F.lane == q) ? acc : z;
                __builtin_amdgcn_sched_barrier(0); }
            if (F.lane < 8) logf_o[(size_t)m * 8 + F.lane] = log_sigmoid_f(z + bfg[F.lane]);
        }
        for (int m = gw; m < NB * 256; m += NGW) { f32x4 hv[8]; rms_row_to_bf16(F.in[I_MEM] + (size_t)m * DM, F.in[I_MEMNORM_G], (bf16*)(F.ws + WS_MN) + (size_t)m * DM, F.lane, hv); }
    }
}
__device__ __forceinline__ void p1_scan(Frame& F) {
    if (F.bx < 64) {
        const int b = F.bx >> 3, h = F.bx & 7; const float* lf = (const float*)(F.ws + WS_LOGF); float* cf = (float*)(F.ws + WS_CUMF) + (size_t)F.bx * SEQ;
        float v[4]; float run = 0.f;
#pragma unroll
        for (int i = 0; i < 4; ++i) { run += lf[(size_t)(b * SEQ + F.tid * 4 + i) * 8 + h]; v[i] = run; }
        float incl = run;
#pragma unroll
        for (int o = 1; o < 64; o <<= 1) { const float t = __shfl_up(incl, o); if (F.lane >= o) incl += t; }
        LAS float* wt = (LAS float*)F.lds;
        if (F.lane == 63) wt[F.wave] = incl;
        __syncthreads();
        float off = incl - run;
        for (int w = 0; w < F.wave; ++w) off += wt[w];
#pragma unroll
        for (int i = 0; i < 4; ++i) cf[F.tid * 4 + i] = v[i] + off;
    }
    __syncthreads();
}
__device__ __forceinline__ void unpack8s(const att::bf16x8 v, float (&f)[8]) {
#pragma unroll
    for (int i = 0; i < 8; ++i) f[i] = __uint_as_float((unsigned)(unsigned short)v[i] << 16);
}
__device__ __forceinline__ att::bf16x8 pack8s(const float (&f)[8]) { v4u w; w.x = pg8::cvt_pk_bf16(f[0], f[1]); w.y = pg8::cvt_pk_bf16(f[2], f[3]); w.z = pg8::cvt_pk_bf16(f[4], f[5]); w.w = pg8::cvt_pk_bf16(f[6], f[7]); return __builtin_bit_cast(att::bf16x8, w); }
__device__ __forceinline__ void p4_attention(Frame& F) {
    char* lds = (char*)F.ldsg;
    const int xcd = F.bx & 7, kk = F.bx >> 3;
    const int bh = (kk >> 2) * 8 + xcd, x = kk & 3, b = bh >> 3, h = bh & 7;
    if (bh >= 64) return;
    const att::bf16* proj = (const att::bf16*)(F.ws + WS_PROJ);
    const size_t rowb = (size_t)b * SEQ;
    if (F.p0_mask & 1) {
        float* tbl = (float*)(lds + att::LDS_BIAS); const float* cf = (const float*)(F.ws + WS_CUMF) + (size_t)bh * SEQ;
        const f32x4 v = *(const f32x4*)(cf + F.tid * 4); *(f32x4*)(tbl + F.tid * 4) = v * (-1.4426950408889634f);
        att::BlockRef r0, r1;
        r0.Q = proj + (rowb + (size_t)x * 256) * PP + C_FQ + h * 128; r0.K = proj + rowb * PP + C_FK + h * 128; r0.V = proj + rowb * PP + C_FV + h * 128; r0.O = (att::bf16*)r0.Q;
        r0.P0 = x * 256; r0.skv = SEQ; r0.lg = 0.f; r0.RG = nullptr; r0.GN = nullptr; r0.O8 = FP8_UP_OUT ? (unsigned char*)F.out + DO_OFOX8 + (rowb + (size_t)x * 256) * 2048 + h * 128 : nullptr;
        r1 = r0; r1.Q = proj + (rowb + (size_t)(7 - x) * 256) * PP + C_FQ + h * 128; r1.O = (att::bf16*)r1.Q; r1.P0 = (7 - x) * 256; r1.O8 = FP8_UP_OUT ? (unsigned char*)F.out + DO_OFOX8 + (rowb + (size_t)(7 - x) * 256) * 2048 + h * 128 : nullptr;
        att::Seam S;
        att::attn_prime<0>(r0, lds, S);
        att::attn_block<0>(r0, r1, lds, S);
        att::attn_block<0>(r1, r1, lds, S);
    }
    if (F.p0_mask & 2) {
        att::BlockRef r0, r1;
        r0.Q = proj + (rowb + (size_t)x * 256) * PP + C_RQ + h * 128; r0.K = proj + rowb * PP + C_RK + h * 128; r0.V = proj + rowb * PP + C_RV + h * 128; r0.O = (att::bf16*)r0.Q;
        r0.P0 = x * 256; r0.skv = SEQ; r0.lg = __builtin_amdgcn_logf(1.f - __builtin_amdgcn_exp2f(-5.f - (float)h))    ; r0.RG = proj + (rowb + (size_t)x * 256) * PP + C_RG + h * 128; r0.GN = F.in[I_RET_G] + h * 128; r0.O8 = FP8_UP_OUT ? (unsigned char*)F.out + DO_ORET8 + (rowb + (size_t)x * 256) * 2048 + h * 128 : nullptr;
        r1 = r0; r1.O8 = FP8_UP_OUT ? (unsigned char*)F.out + DO_ORET8 + (rowb + (size_t)(7 - x) * 256) * 2048 + h * 128 : nullptr; r1.Q = proj + (rowb + (size_t)(7 - x) * 256) * PP + C_RQ + h * 128; r1.O = (att::bf16*)r1.Q; r1.P0 = (7 - x) * 256; r1.RG = proj + (rowb + (size_t)(7 - x) * 256) * PP + C_RG + h * 128;
        att::Seam S;
        att::attn_prime<1>(r0, lds, S);
        att::attn_block<1>(r0, r1, lds, S);
        att::attn_block<1>(r1, r1, lds, S);
    }
}


__device__ __forceinline__ void p8_convert_peer(Frame& F) {
    const int lane = F.lane;
    f32x4 g[8];
#pragma unroll
    for (int j = 0; j < 8; ++j) g[j] = ((const GAS f32x4*)F.in[I_LN_FFN])[lane + 64 * j];
    float* scl = (float*)(F.ws + WS_PSCALE);
    int r0, rend, rstride;
    if (F.bx >= 160) { r0 = (F.bx - 160) * NWAVES + F.wave; rend = 22272; rstride = 768; } else { r0 = 22272 + F.bx * NWAVES + F.wave; rend = 32768; rstride = 1280; }
#pragma unroll 1
    for (int rr = r0; rr < rend; rr += 2 * rstride) {
        f32x4 v[2][8]; float amax[2] = {0.f, 0.f}; bool ok[2], isu[2]; int ri[2];
#pragma unroll
        for (int q = 0; q < 2; ++q) { const int r = rr + q * rstride; ok[q] = r < rend; const int rc = ok[q] ? r : rr; isu[q] = rc < 16384; ri[q] = rc;
            const float* src = (isu[q] ? F.in[I_PEER_U] : F.in[I_PEER_V]) + (size_t)(rc & 16383) * DM;
#pragma unroll
            for (int j = 0; j < 8; ++j) v[q][j] = ((const GAS f32x4*)src)[lane + 64 * j]; }
#pragma unroll
        for (int q = 0; q < 2; ++q) {
#pragma unroll
            for (int j = 0; j < 8; ++j) { if (isu[q]) v[q][j] = v[q][j] * g[j]; amax[q] = fmaxf(amax[q], fmaxf(fmaxf(fabsf(v[q][j].x), fabsf(v[q][j].y)), fmaxf(fabsf(v[q][j].z), fabsf(v[q][j].w)))); }
#pragma unroll
            for (int o = 1; o < 64; o <<= 1) amax[q] = fmaxf(amax[q], __shfl_xor(amax[q], o));
            const float sc = amax[q] > 0.f ? amax[q] * (1.f / 448.f) : 1.f, inv = 1.f / sc;
            if (ok[q]) { if (lane == 0) scl[ri[q]] = sc;
                GAS unsigned* o4 = (GAS unsigned*)(F.ws + (isu[q] ? WS_PU : WS_PV) + (size_t)(ri[q] & 16383) * DM) + lane;
#pragma unroll
                for (int j = 0; j < 8; ++j) { int p = 0; p = __builtin_amdgcn_cvt_pk_fp8_f32(v[q][j].x * inv, v[q][j].y * inv, p, false); p = __builtin_amdgcn_cvt_pk_fp8_f32(v[q][j].z * inv, v[q][j].w * inv, p, true); o4[64 * j] = (unsigned)p; } } }
    }
}
__device__ __forceinline__ void norm_own_tile(Frame& F, bf16* base, int ld, int row0, int col0, const float* gain, float mul) {
    asm volatile("s_waitcnt vmcnt(0)" ::: "memory"); __syncthreads();
    const int lane = F.lane, rsel = lane >> 5, head = (lane >> 4) & 1, sub = lane & 15;
    float gv[8];
#pragma unroll
    for (int i = 0; i < 8; ++i) gv[i] = gain[sub * 8 + i] * mul;
#pragma unroll 1
    for (int r4 = 0; r4 < 16; r4 += 4) {
        att::bf16x8 v[4]; bf16* p[4];
#pragma unroll
        for (int q = 0; q < 4; ++q) { p[q] = base + (size_t)(row0 + F.wave * 32 + (r4 + q) * 2 + rsel) * ld + col0 + head * 128 + sub * 8; v[q] = *(const att::bf16x8*)p[q]; }
#pragma unroll
        for (int q = 0; q < 4; ++q) { float a[8]; unpack8s(v[q], a); float s = 0.f;
#pragma unroll
            for (int i = 0; i < 8; ++i) s += a[i] * a[i];
            s += __shfl_xor(s, 1); s += __shfl_xor(s, 2); s += __shfl_xor(s, 4); s += __shfl_xor(s, 8);
            const float rr = 1.f / sqrtf(s * (1.f / 128.f) + RMS_EPS);
#pragma unroll
            for (int i = 0; i < 8; ++i) a[i] *= rr * gv[i];
            *(att::bf16x8*)p[q] = pack8s(a); }
    }
}
__device__ __forceinline__ void fix_own_tile(Frame& F, bf16* proj, int pm, int pn, int kind) {
    const int lane = F.lane;
    if (kind < 2) {
        const int rsel = lane >> 5, head = (lane >> 4) & 1, sub = lane & 15; float gv[8];
#pragma unroll
        for (int i = 0; i < 8; ++i) gv[i] = kind == 0 ? F.in[I_FOXQ_G][sub * 8 + i] * QK_C2 : F.in[I_FOXK_G][sub * 8 + i];
#pragma unroll 1
        for (int r4 = 0; r4 < 16; r4 += 4) { att::bf16x8 v[4]; bf16* p[4];
#pragma unroll
            for (int q = 0; q < 4; ++q) { p[q] = proj + (size_t)(pm * 256 + F.wave * 32 + (r4 + q) * 2 + rsel) * PP + pn * 256 + head * 128 + sub * 8; v[q] = *(const att::bf16x8*)p[q]; }
#pragma unroll
            for (int q = 0; q < 4; ++q) { float a[8]; unpack8s(v[q], a); float s = 0.f;
#pragma unroll
                for (int i = 0; i < 8; ++i) s += a[i] * a[i];
                s += __shfl_xor(s, 1); s += __shfl_xor(s, 2); s += __shfl_xor(s, 4); s += __shfl_xor(s, 8);
                const float rr = 1.f / sqrtf(s * (1.f / 128.f) + RMS_EPS);
#pragma unroll
                for (int i = 0; i < 8; ++i) a[i] *= rr * gv[i];
                *(att::bf16x8*)p[q] = pack8s(a); } }
    } else {
        const int rsel = lane >> 4, head = (lane >> 3) & 1, sub = lane & 7; const float sc = kind == 3 ? 0.08838834764831845f : 1.f; float fr[8];
        const float lgh = __builtin_amdgcn_logf(1.f - __builtin_amdgcn_exp2f(-5.f - (float)((pn & 3) * 2 + head)));
#pragma unroll
        for (int i = 0; i < 8; ++i) fr[i] = __builtin_amdgcn_exp2f(-13.287712379549449f * (float)(sub * 8 + i) * (1.f / 64.f)) * 0.15915494309189535f;
#pragma unroll 1
        for (int r4 = 0; r4 < 8; r4 += 4) { att::bf16x8 va[4], vb[4]; bf16* p[4];
#pragma unroll
            for (int q = 0; q < 4; ++q) { p[q] = proj + (size_t)(pm * 256 + F.wave * 32 + (r4 + q) * 4 + rsel) * PP + pn * 256 + head * 128 + sub * 8; va[q] = *(const att::bf16x8*)p[q]; vb[q] = *(const att::bf16x8*)(p[q] + 64); }
#pragma unroll
            for (int q = 0; q < 4; ++q) { const int rowi = pm * 256 + F.wave * 32 + (r4 + q) * 4 + rsel; const float pos = (float)(rowi & (SEQ - 1)); float a[8], b[8], oa[8], ob[8]; unpack8s(va[q], a); unpack8s(vb[q], b);
                const float dsc = sc * __builtin_amdgcn_exp2f((kind == 2 ? lgh : -lgh) * (float)(rowi & 63));
#pragma unroll
                for (int i = 0; i < 8; ++i) { float rev = pos * fr[i]; rev -= rintf(rev); const float sn = __builtin_amdgcn_sinf(rev), cs = __builtin_amdgcn_cosf(rev);
                    oa[i] = (a[i] * cs - b[i] * sn) * dsc; ob[i] = (a[i] * sn + b[i] * cs) * dsc; }
                *(att::bf16x8*)p[q] = pack8s(oa); *(att::bf16x8*)(p[q] + 64) = pack8s(ob); } }
    }
}
__device__ __forceinline__ void p10_mem_attention(Frame& F) {
    char* lds = (char*)F.ldsg;
    const int b = F.bx >> 5, h = (F.bx >> 3) & 3, qb = F.bx & 7;
    att::BlockRef r0;
    const size_t qoff = ((size_t)b * SEQ + (size_t)qb * 256) * 512 + h * 128;
    r0.Q = (const att::bf16*)(F.ws + WS_QM) + qoff; r0.O = (att::bf16*)(F.ws + WS_OMEM) + qoff;
    r0.K = (const att::bf16*)(F.ws + WS_KVM) + (size_t)(b * 256) * 1024 + h * 128; r0.V = r0.K + 512;
    r0.P0 = 1 << 20; r0.skv = 256; r0.lg = 0.f; r0.RG = nullptr; r0.GN = nullptr; r0.O8 = F.ws + WS_OMEM + ((size_t)b * SEQ + (size_t)qb * 256) * 512 + h * 128;
    att::Seam S;
    att::attn_prime<2>(r0, lds, S);
    att::attn_block<2>(r0, r0, lds, S);
}
#define TK_INS(L, v) do { _Pragma("unroll") for (int i_ = 15; i_ >= 1; --i_) L[i_] = __builtin_amdgcn_fmed3f(L[i_ - 1], L[i_], (v)); L[0] = fmaxf(L[0], (v)); } while (0)
__device__ __forceinline__ void p13_topk_unit(Frame& F, int pm, int h) {
    const int lane = F.lane, r32 = lane & 31, hi = lane >> 5, wave = F.wave;
    const att::bf16* qp = (const att::bf16*)(F.ws + WS_QP); const att::bf16* subk = (const att::bf16*)(F.ws + WS_SUBK);
    int* idx_o = (int*)(F.ws + WS_IDX); float* gate_o = (float*)(F.ws + WS_GATE);
    LAS unsigned* kb = (LAS unsigned*)(F.lds + 65536 + (wave * 32 + (lane & 31)) * 32);
    const int tok = pm * 256 + wave * 32 + r32;
    const unsigned q_lane = (unsigned)((tok * DM + hi * 8) * 2), k_lane = (unsigned)((r32 * 128 + hi * 8) * 2);
    att::bf16x8 qf[8];
#define TK_STAGE(p_) do { const int hp_ = h * 2 + (p_); const unsigned char* qb_ = (const unsigned char*)qp + (size_t)hp_ * 256; \
        const unsigned char* kb_ = (const unsigned char*)subk + (size_t)hp_ * 32768 + (size_t)(wave >> 1) * 8192 + (size_t)(wave & 1) * 128; \
        _Pragma("unroll") for (int d0 = 0; d0 < 8; ++d0) qf[d0] = *(const GAS att::bf16x8*)(qb_ + d0 * 32 + q_lane); \
        _Pragma("unroll") for (int f_ = 0; f_ < 4; ++f_) \
            __builtin_amdgcn_global_load_lds((const GAS unsigned*)(kb_ + f_ * 32 + k_lane), (LAS unsigned*)(F.lds + (p_) * 32768 + (wave * 4 + f_) * 1024), 16, 0, 0); } while (0)
    float L0[16], L1[16];
#pragma unroll
    for (int i = 0; i < 16; ++i) { L0[i] = 0.f; L1[i] = 0.f; }
    TK_STAGE(0);
#pragma unroll 1
    for (int p = 0; p < 2; ++p) {
        asm volatile("s_waitcnt vmcnt(0)" ::: "memory"); __syncthreads();
        att::f32x16 acc[4];
        const LAS unsigned char* img = F.lds + p * 32768;
#pragma unroll
        for (int kt = 0; kt < 4; ++kt) { acc[kt] = att::f32x16{};
#pragma unroll
            for (int d0 = 0; d0 < 8; ++d0) acc[kt] = __builtin_amdgcn_mfma_f32_32x32x16_bf16(*(const LAS att::bf16x8*)(img + (kt * 8 + d0) * 1024 + lane * 16), qf[d0], acc[kt], 0, 0, 0); }
        if (p == 0) TK_STAGE(1);
        float L[16];
#pragma unroll
        for (int i = 0; i < 16; ++i) L[i] = -3.0e38f;
#pragma unroll
        for (int kt = 0; kt < 4; ++kt)
#pragma unroll
            for (int r = 0; r < 16; ++r) { const unsigned key = (unsigned)(kt * 32 + (r & 3) + 8 * (r >> 2)) + 4u * (unsigned)hi;
                const float v = __uint_as_float((__float_as_uint(acc[kt][r]) & ~0x7Fu) | key); TK_INS(L, v); }
        float P[16];
#pragma unroll
        for (int i = 0; i < 16; ++i) P[i] = __shfl_xor(L[i], 32);
#pragma unroll
        for (int i = 0; i < 16; ++i) TK_INS(L, P[i]);
#pragma unroll
        for (int i = 0; i < 16; ++i) { L0[i] = p == 0 ? L[i] : L0[i]; L1[i] = p == 0 ? L1[i] : L[i]; }
    }
#undef TK_STAGE
#pragma unroll
        for (int w = 0; w < 4; ++w) {
            kb[w] = (__float_as_uint(L0[4 * w]) & 0x7Fu) | ((__float_as_uint(L0[4 * w + 1]) & 0x7Fu) << 8) | ((__float_as_uint(L0[4 * w + 2]) & 0x7Fu) << 16) | ((__float_as_uint(L0[4 * w + 3]) & 0x7Fu) << 24);
            kb[4 + w] = (__float_as_uint(L1[4 * w]) & 0x7Fu) | ((__float_as_uint(L1[4 * w + 1]) & 0x7Fu) << 8) | ((__float_as_uint(L1[4 * w + 2]) & 0x7Fu) << 16) | ((__float_as_uint(L1[4 * w + 3]) & 0x7Fu) << 24); }
        float T[16];
#pragma unroll
        for (int i = 0; i < 16; ++i) T[i] = -3.0e38f;
#pragma unroll
        for (int a = 0; a < 16; ++a) { const float sa = __uint_as_float(__float_as_uint(L0[a]) & ~0x7Fu);
#pragma unroll
            for (int b2 = 0; b2 < 16; ++b2) if ((a + 1) * (b2 + 1) <= 16) { const float s = sa + __uint_as_float(__float_as_uint(L1[b2]) & ~0x7Fu);
                const float v = __uint_as_float((__float_as_uint(s) & ~0xFFu) | (unsigned)(a * 16 + b2)); TK_INS(T, v); } }
        LDS_WAIT();
        const LAS unsigned char* kbb = (const LAS unsigned char*)kb;
        float sc[16]; int ei[16]; float mx = __uint_as_float(__float_as_uint(T[0]) & ~0xFFu), sum = 0.f;
#pragma unroll
        for (int k = 0; k < 16; ++k) { const unsigned bits = __float_as_uint(T[k]); const unsigned id = bits & 0xFFu;
            const int i1 = kbb[id >> 4], i2 = kbb[16 + (id & 15u)]; ei[k] = i1 * 128 + i2;
            sc[k] = __builtin_amdgcn_exp2f((__uint_as_float(bits & ~0xFFu) - mx) * 1.4426950408889634f); sum += sc[k]; }
        const float inv = 1.f / sum;
        if (hi == 0) {
#pragma unroll
            for (int w = 0; w < 4; ++w) {
                *(GAS v4u*)(idx_o + (size_t)tok * 128 + h * 16 + 4 * w) = (v4u){(unsigned)ei[4 * w], (unsigned)ei[4 * w + 1], (unsigned)ei[4 * w + 2], (unsigned)ei[4 * w + 3]};
                *(GAS f32x4*)(gate_o + (size_t)tok * 128 + h * 16 + 4 * w) = (f32x4){sc[4 * w] * inv, sc[4 * w + 1] * inv, sc[4 * w + 2] * inv, sc[4 * w + 3] * inv}; } }
        LDS_WAIT(); asm volatile("" ::: "memory");
}


typedef float f32x2 __attribute__((ext_vector_type(2)));
__device__ __forceinline__ float gelu_tanh(float x) {
    const float y = 0.7978845608028654f * (x + 0.044715f * x * x * x);
    const float t = 1.f - 2.f * __builtin_amdgcn_rcpf(1.f + __builtin_amdgcn_exp2f(2.885390081777927f * y));
    return 0.5f * x * (1.f + t);
}
__device__ __forceinline__ float dot2bf(unsigned a, unsigned b, float acc) { asm("v_dot2c_f32_bf16 %0, %1, %2" : "+v"(acc) : "v"(a), "v"(b)); return acc; }
#ifndef EX_QCH
#define EX_QCH 2
#endif
struct RowBuf { v4u r[8]; float su, sv; };
#define DPP_MOV(v, ctrl) __builtin_bit_cast(float, __builtin_amdgcn_update_dpp(0, __builtin_bit_cast(int, (v)), (ctrl), 0xF, 0xF, false))
#define ROW_ROR(v, n) __builtin_bit_cast(float, __builtin_amdgcn_update_dpp(0, __builtin_bit_cast(int, (v)), 0x120 + (n), 0xF, 0xF, false))
__device__ __forceinline__ void p14_experts_sorted(Frame& F) {
    const int lane = F.lane, wave = F.wave, q = lane >> 4, l16 = lane & 15;
    const bf16* xb = (const bf16*)(F.ws + WS_XB2); const unsigned char* pu = F.ws + WS_PU; const unsigned char* pv = F.ws + WS_PV;
    const int* idx = (const int*)(F.ws + WS_IDX); const float* gate = (const float*)(F.ws + WS_GATE); const float* rowss = (const float*)(F.ws + WS_ROWSS2);
    const float* su = (const float*)(F.ws + WS_PSCALE); const float* sv = su + 16384;
    LAS unsigned* list = (LAS unsigned*)(F.lds + wave * 8192) + q * 128;
    LAS float* wl = (LAS float*)(F.lds + wave * 8192 + 2048) + q * 128;
    LAS float* gt = (LAS float*)(F.lds + wave * 8192 + 4096) + q * 128;
    LAS unsigned* cnt = (LAS unsigned*)(F.lds + wave * 8192 + 6144) + q * 64;
    constexpr int NSTEP = 128;
    for (int grp = 0; grp < 2; ++grp) {
        const int tok = (F.bx * NWAVES + wave) * 8 + grp * 4 + q;
        const float rs = 1.f / sqrtf(rowss[tok] * (1.f / DM) + RMS_EPS);
#pragma unroll
        for (int i = 0; i < 4; ++i) cnt[l16 + 16 * i] = 0u;
        unsigned ent[8], pos[8];
#pragma unroll
        for (int j = 0; j < 8; ++j) { const int k = l16 + 16 * j; const unsigned e = (unsigned)idx[(size_t)tok * 128 + k]; gt[k] = gate[(size_t)tok * 128 + k]; ent[j] = e | ((unsigned)k << 16); }
        LDS_WAIT(); asm volatile("" ::: "memory");
#pragma unroll
        for (int j = 0; j < 8; ++j) pos[j] = __hip_atomic_fetch_add(cnt + ((ent[j] & 0x3FFFu) >> 8), 1u, __ATOMIC_RELAXED, __HIP_MEMORY_SCOPE_WORKGROUP);
        LDS_WAIT(); asm volatile("" ::: "memory");
        { unsigned c[4], inc[4], run = 0u;
#pragma unroll
          for (int i = 0; i < 4; ++i) { c[i] = cnt[l16 + 16 * i]; inc[i] = c[i];
#pragma unroll
              for (int o = 1; o < 16; o <<= 1) { const unsigned tt = __shfl_up(inc[i], o, 16); if (l16 >= o) inc[i] += tt; } }
          LDS_WAIT(); asm volatile("" ::: "memory");
#pragma unroll
          for (int i = 0; i < 4; ++i) { cnt[l16 + 16 * i] = run + inc[i] - c[i]; run += __shfl(inc[i], 15, 16); } }
        LDS_WAIT(); asm volatile("" ::: "memory");
#pragma unroll
        for (int j = 0; j < 8; ++j) list[cnt[(ent[j] & 0x3FFFu) >> 8] + pos[j]] = ent[j];
        LDS_WAIT(); asm volatile("" ::: "memory");
        const unsigned lane_off = (unsigned)l16 * 16u;
        constexpr int QCH = EX_QCH, NSW = 8 / QCH;
#define EX_LD(B, s_, TABQ) do { const int ss_ = (s_) < NSTEP ? (s_) : NSTEP - 1; const unsigned off_ = ((list[ss_] & 0x3FFFu) << 11) + lane_off;     \
            _Pragma("unroll") for (int c_ = 0; c_ < QCH; ++c_) B[c_] = *(const GAS v4u*)((TABQ) + off_ + c_ * 256); } while (0)
#ifndef EX_RINGK
#define EX_RINGK 8
#endif
#if EX_RINGK == 4
#define EX_RING(TABQ, STEPFN, ENDFN) do { v4u H0[QCH], H1[QCH], H2[QCH], H3[QCH]; \
            EX_LD(H0, 0, TABQ); EX_LD(H1, 1, TABQ); EX_LD(H2, 2, TABQ); \
            _Pragma("unroll 1") for (int s = 0; s < NSTEP; s += 8) { \
                EX_LD(H3, s + 3, TABQ); STEPFN(H0, s + 0, 0); \
                EX_LD(H0, s + 4, TABQ); STEPFN(H1, s + 1, 1); \
                EX_LD(H1, s + 5, TABQ); STEPFN(H2, s + 2, 2); \
                EX_LD(H2, s + 6, TABQ); STEPFN(H3, s + 3, 3); \
                EX_LD(H3, s + 7, TABQ); STEPFN(H0, s + 4, 4); \
                EX_LD(H0, s + 8, TABQ); STEPFN(H1, s + 5, 5); \
                EX_LD(H1, s + 9, TABQ); STEPFN(H2, s + 6, 6); \
                EX_LD(H2, s + 10, TABQ); STEPFN(H3, s + 7, 7); \
                ENDFN(s); } } while (0)
#elif EX_RINGK == 2
#define EX_RING(TABQ, STEPFN, ENDFN) do { v4u H0[QCH], H1[QCH]; \
            EX_LD(H0, 0, TABQ); \
            _Pragma("unroll 1") for (int s = 0; s < NSTEP; s += 8) { \
                EX_LD(H1, s + 1, TABQ); STEPFN(H0, s + 0, 0); \
                EX_LD(H0, s + 2, TABQ); STEPFN(H1, s + 1, 1); \
                EX_LD(H1, s + 3, TABQ); STEPFN(H0, s + 2, 2); \
                EX_LD(H0, s + 4, TABQ); STEPFN(H1, s + 3, 3); \
                EX_LD(H1, s + 5, TABQ); STEPFN(H0, s + 4, 4); \
                EX_LD(H0, s + 6, TABQ); STEPFN(H1, s + 5, 5); \
                EX_LD(H1, s + 7, TABQ); STEPFN(H0, s + 6, 6); \
                EX_LD(H0, s + 8, TABQ); STEPFN(H1, s + 7, 7); \
                ENDFN(s); } } while (0)
#else
#define EX_RING(TABQ, STEPFN, ENDFN) do { v4u H0[QCH], H1[QCH], H2[QCH], H3[QCH], H4[QCH], H5[QCH], H6[QCH], H7[QCH]; \
            EX_LD(H0, 0, TABQ); EX_LD(H1, 1, TABQ); EX_LD(H2, 2, TABQ); EX_LD(H3, 3, TABQ); EX_LD(H4, 4, TABQ); EX_LD(H5, 5, TABQ); EX_LD(H6, 6, TABQ); \
            _Pragma("unroll 1") for (int s = 0; s < NSTEP; s += 8) { \
                EX_LD(H7, s + 7, TABQ); STEPFN(H0, s + 0, 0); \
                EX_LD(H0, s + 8, TABQ); STEPFN(H1, s + 1, 1); \
                EX_LD(H1, s + 9, TABQ); STEPFN(H2, s + 2, 2); \
                EX_LD(H2, s + 10, TABQ); STEPFN(H3, s + 3, 3); \
                EX_LD(H3, s + 11, TABQ); STEPFN(H4, s + 4, 4); \
                EX_LD(H4, s + 12, TABQ); STEPFN(H5, s + 5, 5); \
                EX_LD(H5, s + 13, TABQ); STEPFN(H6, s + 6, 6); \
                EX_LD(H6, s + 14, TABQ); STEPFN(H7, s + 7, 7); \
                ENDFN(s); } } while (0)
#endif
#pragma unroll 1
        for (int j = 0; j < NSW; ++j) {
            f32x2 xf[QCH][8];
#pragma unroll
            for (int c = 0; c < QCH; ++c) { const v4u a = *(const GAS v4u*)(xb + (size_t)tok * DM + j * (QCH * 256) + c * 256 + l16 * 16), b = *(const GAS v4u*)(xb + (size_t)tok * DM + j * (QCH * 256) + c * 256 + l16 * 16 + 8);
                const unsigned xd[8] = {a.x, a.y, a.z, a.w, b.x, b.y, b.z, b.w};
#pragma unroll
                for (int i = 0; i < 8; ++i) xf[c][i] = (f32x2){__uint_as_float(xd[i] << 16), __uint_as_float(xd[i] & 0xffff0000u)}; }
            const unsigned char* tabq = pu + j * (QCH * 256);
#define EX_U(B, s_, k_) do { f32x2 d2_ = {0.f, 0.f}; \
            _Pragma("unroll") for (int c_ = 0; c_ < QCH; ++c_) { const unsigned ud[4] = {B[c_].x, B[c_].y, B[c_].z, B[c_].w}; \
                _Pragma("unroll") for (int w_ = 0; w_ < 4; ++w_) { d2_ = __builtin_amdgcn_cvt_pk_f32_fp8((int)ud[w_], false) * xf[c_][2 * w_] + d2_; d2_ = __builtin_amdgcn_cvt_pk_f32_fp8((int)ud[w_], true) * xf[c_][2 * w_ + 1] + d2_; } } \
            dd[k_] = d2_.x + d2_.y; } while (0)
#define EX_UEND(s_) do { float r4_[4], r2_[2], r1_; \
            { const bool up = (l16 & 8) != 0; _Pragma("unroll") for (int i_ = 0; i_ < 4; ++i_) { const float mine = up ? dd[i_ + 4] : dd[i_], theirs = up ? dd[i_] : dd[i_ + 4]; r4_[i_] = mine + ROW_ROR(theirs, 8); } } \
            { const bool up = (l16 & 4) != 0; _Pragma("unroll") for (int i_ = 0; i_ < 2; ++i_) { const float mine = up ? r4_[i_ + 2] : r4_[i_], theirs = up ? r4_[i_] : r4_[i_ + 2]; \
                const float fromhi = DPP_MOV(theirs, 0x104), fromlo = DPP_MOV(theirs, 0x114); r2_[i_] = mine + (up ? fromlo : fromhi); } }     \
            { const bool up = (l16 & 2) != 0; const float mine = up ? r2_[1] : r2_[0], theirs = up ? r2_[0] : r2_[1]; r1_ = mine + DPP_MOV(theirs, 0x4E); }     \
            r1_ += DPP_MOV(r1_, 0xB1);                                                                                                                  \
            if ((l16 & 1) == 0) { const int si_ = (s_) + (l16 >> 1); wl[si_] = (j == 0 ? 0.f : wl[si_]) + r1_; } } while (0)
            float dd[8];
            EX_RING(tabq, EX_U, EX_UEND);
#undef EX_U
#undef EX_UEND
            LDS_WAIT(); asm volatile("" ::: "memory");
        }
#pragma unroll
        for (int i = 0; i < 8; ++i) { const int s = l16 + 16 * i; const unsigned me = list[s]; const unsigned e = me & 0x3FFFu;
            wl[s] = gt[(me >> 16) & 127u] * gelu_tanh(wl[s] * su[e] * rs) * sv[e]; }
        LDS_WAIT(); asm volatile("" ::: "memory");
#pragma unroll 1
        for (int j = 0; j < NSW; ++j) {
            f32x2 acc[QCH][8];
#pragma unroll
            for (int c = 0; c < QCH; ++c)
#pragma unroll
                for (int e = 0; e < 8; ++e) acc[c][e] = (f32x2){0.f, 0.f};
            const unsigned char* tabq = pv + j * (QCH * 256);
#define EX_NOEND(s_) do { } while (0)
#define EX_V(B, s_, k_) do { const float w_ = wl[s_]; const f32x2 w2 = {w_, w_}; \
            _Pragma("unroll") for (int c_ = 0; c_ < QCH; ++c_) { const unsigned ud[4] = {B[c_].x, B[c_].y, B[c_].z, B[c_].w}; \
                _Pragma("unroll") for (int w4_ = 0; w4_ < 4; ++w4_) { acc[c_][2 * w4_] = __builtin_amdgcn_cvt_pk_f32_fp8((int)ud[w4_], false) * w2 + acc[c_][2 * w4_]; acc[c_][2 * w4_ + 1] = __builtin_amdgcn_cvt_pk_f32_fp8((int)ud[w4_], true) * w2 + acc[c_][2 * w4_ + 1]; } } } while (0)
            EX_RING(tabq, EX_V, EX_NOEND);
#undef EX_V
#undef EX_NOEND
            float* orow = F.out + (size_t)tok * DM + j * (QCH * 256) + l16 * 16; const bf16* xrow = xb + (size_t)tok * DM + j * (QCH * 256) + l16 * 16;
#pragma unroll
            for (int c = 0; c < QCH; ++c) { const v4u x0 = *(const GAS v4u*)(xrow + c * 256), x1 = *(const GAS v4u*)(xrow + c * 256 + 8); const unsigned xd[8] = {x0.x, x0.y, x0.z, x0.w, x1.x, x1.y, x1.z, x1.w};
#pragma unroll
                for (int qq = 0; qq < 4; ++qq)
                    *(GAS f32x4*)(orow + c * 256 + 4 * qq) = (f32x4){__uint_as_float(xd[2 * qq] << 16) + acc[c][2 * qq].x, __uint_as_float(xd[2 * qq] & 0xffff0000u) + acc[c][2 * qq].y,
                                                                    __uint_as_float(xd[2 * qq + 1] << 16) + acc[c][2 * qq + 1].x, __uint_as_float(xd[2 * qq + 1] & 0xffff0000u) + acc[c][2 * qq + 1].y}; }
        }
#undef EX_LD
#undef EX_RING
        LDS_WAIT(); asm volatile("" ::: "memory");
    }
}

#ifdef ONLY_PHASE
#define ISO(n) ((n) == ONLY_PHASE)
#else
#define ISO(n) true
#endif
#ifndef LAST_PHASE
#define LAST_PHASE 11
#endif
enum { PH_PROLOGUE = 0, PH_GEMM_IN, PH_GEMM_IN8, PH_ATTN, PH_GEMM_FOXUP, PH_GEMM_RETUP, PH_GEMM_OUT, PH_GEMM_MQ, PH_MEM_ATTN, PH_GEMM_MO, PH_GEMM_PQ, PH_EXPERTS, PH_N };
__global__ void __launch_bounds__(NWAVES * 64, 2) mega_fwd(Args args) {
    extern __shared__ __attribute__((aligned(16))) unsigned char lds[];
    Frame F;
    F.lds = (LAS unsigned char*)lds; F.ldsg = lds; F.tid = threadIdx.x; F.lane = F.tid & 63; F.wave = __builtin_amdgcn_readfirstlane(F.tid >> 6); F.G = gridDim.x; F.bx = blockIdx.x;
    F.in = args.in; F.out = args.out; F.ws = args.ws; F.p0_mask = args.p0_mask;
    volatile LAS unsigned* MISC = (volatile LAS unsigned*)(F.lds + MISC_OFF);
    for (int u = F.tid; u < (LDS_BYTES - LDSCTL_OFF) / 4; u += NWAVES * 64) ((LAS unsigned*)(F.lds + LDSCTL_OFF))[u] = 0u;
    __syncthreads();
    gu32* ctl = (gu32*)(args.ws + WS_CTL);
    XcdBarrier bar = xcd_barrier_post((unsigned*)(ctl + CW_BAR), MISC + 8);
    unsigned char* ws = args.ws;
    bf16* proj = (bf16*)(ws + WS_PROJ);
    for (int ph = args.ph_lo; ph < args.ph_hi; ++ph) {
        { int t_ = threadIdx.x; asm volatile("" : "+v"(t_)); F.tid = t_; F.lane = t_ & 63; }
        { int g_ = gridDim.x, b_ = blockIdx.x; asm volatile("" : "+s"(g_), "+s"(b_)); F.G = g_; F.bx = b_; }
        bool is_gemm = false, barrier_after = true, fp8 = false, mq_phase = false, qk_phase = false, pq_phase = false, ksplit = false, qk8_phase = false;
        pg8::Gemm g{nullptr, nullptr, 0, 0, 0, 0, 0x7F7F7F7F}; pg8::EpiAny E{};
        switch (ph) {
#ifndef NO_P0
        case PH_PROLOGUE: if constexpr (ISO(0)) p0_prologue(F); break;
#endif
        case PH_GEMM_IN: if constexpr (ISO(1)) p1_scan(F); is_gemm = true; barrier_after = false; qk_phase = true;
            g = pg8::Gemm{(const bf16*)(ws + WS_XN), (const bf16*)(ws + WS_WIN), M_TOK, N_QK, DM, DM, 0x7F7F7F7F, DM}; E.kind = 0; E.O = proj; E.ldc = PP; E.pn_off = 0; break;
        case PH_GEMM_IN8: is_gemm = true; fp8 = true; qk8_phase = true;
            g = pg8::Gemm{(const bf16*)((unsigned char*)args.out + DO_XN8), (const bf16*)(ws + WS_WIN + 16 * MiB), M_TOK, N_REST, DM / 2, DM / 2, W8_SCALE_B, DM / 2}; E.kind = 0; E.O = proj + N_QK; E.ldc = PP; E.pn_off = N_QK / 256; break;
#ifndef NO_ATTN
        case PH_ATTN: if constexpr (ISO(3)) p4_attention(F); break;
#endif
#if FP8_UP_OUT
        case PH_GEMM_FOXUP: is_gemm = true; fp8 = true;
            g = pg8::Gemm{(const bf16*)((unsigned char*)args.out + DO_OCAT8), (const bf16*)(ws + WS_WFOX), M_TOK, DM, 512, 1024, W8_SCALE_B, 1024}; ksplit = true; E.kind = 7; E.Gt = proj + C_G0; E.Gt2 = proj + C_G1; E.ldg = PP; E.O8 = (unsigned char*)(proj + C_FK); E.ld8 = PP * 2; break;
        case PH_GEMM_RETUP: barrier_after = false; break;
        case PH_GEMM_OUT: is_gemm = true; fp8 = true;
            g = pg8::Gemm{proj + C_FK, (const bf16*)(ws + WS_WOUT), M_TOK, DM, DM / 2, PP, W8_SCALE_B, DM / 2}; E.kind = 4; E.base = args.in[I_X]; E.base16 = nullptr; E.O = (bf16*)(ws + WS_XB1); E.ldc = DM; E.rowss = (float*)(ws + WS_ROWSS1); break;
#else
        case PH_GEMM_FOXUP: is_gemm = true;
            g = pg8::Gemm{proj + C_FQ, (const bf16*)(ws + WS_WFOX), M_TOK, DM, 1024, PP, 0x7F7F7F7F, 1024}; E.kind = 2; E.O = (bf16*)(ws + WS_XN); E.ldc = DM; E.Gt = proj + C_G0; E.ldg = PP; break;
        case PH_GEMM_RETUP: is_gemm = true;
            g = pg8::Gemm{proj + C_RQ, (const bf16*)(ws + WS_WRET), M_TOK, DM, 1024, PP, 0x7F7F7F7F, 1024}; E.kind = 6; E.O = (bf16*)(ws + WS_XN); E.ldc = DM; E.Gt = proj + C_G1; E.ldg = PP; break;
        case PH_GEMM_OUT: is_gemm = true;
            g = pg8::Gemm{(const bf16*)(ws + WS_XN), (const bf16*)(ws + WS_WOUT), M_TOK, DM, DM, DM, 0x7F7F7F7F, DM}; E.kind = 4; E.base = args.in[I_X]; E.base16 = nullptr; E.O = (bf16*)(ws + WS_XB1B); E.ldc = DM; E.rowss = (float*)(ws + WS_ROWSS1); break;
#endif
        case PH_GEMM_MQ: is_gemm = true; mq_phase = true;
            if (F.bx < 128) { g = pg8::Gemm{(const bf16*)(ws + WS_XB1), (const bf16*)(ws + WS_WMQ), M_TOK, 512, DM, DM, 0x7F7F7F7F, DM}; E.kind = 1; E.O = (bf16*)(ws + WS_QM); E.ldc = 512; E.rowss_in = (const float*)(ws + WS_ROWSS1); }
            else { g = pg8::Gemm{(const bf16*)(ws + WS_MN), (const bf16*)(ws + WS_WMKV), NB * 256, 1024, DM, DM, 0x7F7F7F7F, DM}; E.kind = 1; E.O = (bf16*)(ws + WS_KVM); E.ldc = 1024; E.rowss_in = nullptr; }
            break;
        case PH_MEM_ATTN: if constexpr (ISO(8)) p10_mem_attention(F); break;
        case PH_GEMM_MO: is_gemm = true;
            fp8 = true; g = pg8::Gemm{(const bf16*)(ws + WS_OMEM), (const bf16*)(ws + WS_WMO), M_TOK, DM, 256, 256, W8_SCALE_B, 256}; E.kind = 4; E.base = nullptr; E.base16 = (const bf16*)(ws + WS_XB1); E.O = (bf16*)(ws + WS_XB2); E.ldc = DM; E.rowss = (float*)(ws + WS_ROWSS2); break;
        case PH_GEMM_PQ: is_gemm = true; pq_phase = true;
            g = pg8::Gemm{(const bf16*)(ws + WS_XB2), (const bf16*)(ws + WS_WPQ), M_TOK, DM, DM, DM, 0x7F7F7F7F, DM}; E.kind = 1; E.O = (bf16*)(ws + WS_QP); E.ldc = DM; E.rowss_in = (const float*)(ws + WS_ROWSS2); break;
        case PH_EXPERTS: if constexpr (ISO(11)) p14_experts_sorted(F); break;
        default: break;
        }
#ifndef NO_GEMM
        if constexpr (ISO(100)) if (is_gemm) { pg8::StaticOrder S; S.init(g.M, g.N, F.G, (mq_phase && F.bx >= 128) ? F.bx - 128 : F.bx); S.kshift = ksplit ? 1 : 0;
            if (fp8) pg8::gemm_phase<pg8::EpiAny, pg8::StaticOrder, true, true, true>(F.lds, g, S, E); else pg8::gemm_phase<pg8::EpiAny, pg8::StaticOrder, true, true, false>(F.lds, g, S, E); }
        if constexpr (ISO(1)) if (qk_phase) {
            asm volatile("s_waitcnt vmcnt(0)" ::: "memory"); __syncthreads();
            pg8::StaticOrder S; pg8::Unit u; S.init(M_TOK, N_QK, F.G, F.bx);
            for (int i = 0; S.next(i, u); ++i) fix_own_tile(F, proj, u.pm, u.pn, 2 + (u.pn >> 2)); }
        if constexpr (ISO(2)) if (qk8_phase) {
            asm volatile("s_waitcnt vmcnt(0)" ::: "memory"); __syncthreads();
            pg8::StaticOrder S; pg8::Unit u; S.init(M_TOK, N_REST, F.G, F.bx);
            for (int i = 0; S.next(i, u); ++i) if (u.pn < 8) fix_own_tile(F, proj, u.pm, u.pn + 8, u.pn >> 2); }
        if constexpr (ISO(10)) if (pq_phase) {
            asm volatile("s_waitcnt vmcnt(0)" ::: "memory"); __syncthreads();
            pg8::StaticOrder S; pg8::Unit u; S.init(M_TOK, DM, F.G, F.bx);
            for (int i = 0; S.next(i, u); ++i) p13_topk_unit(F, u.pm, u.pn); }
        if constexpr (ISO(7)) if (mq_phase) {
            pg8::StaticOrder S; pg8::Unit u;
            if (F.bx < 128) { S.init(M_TOK, 512, F.G, F.bx); if (S.next(0, u)) norm_own_tile(F, (bf16*)(ws + WS_QM), 512, u.pm * 256, u.pn * 256, args.in[I_MEMQ_G], QK_C2); }
            else { S.init(NB * 256, 1024, F.G, F.bx - 128); if (S.next(0, u) && u.pn < 2) norm_own_tile(F, (bf16*)(ws + WS_KVM), 1024, u.pm * 256, u.pn * 256, args.in[I_MEMK_G], 1.f); }
            p8_convert_peer(F); }
#endif
        if (barrier_after && ph + 1 < args.ph_hi) xcd_barrier(bar);
    }
    if (xb_ld((unsigned*)(ctl + CW_BAR) + XB_TMO) != 0u) { const float q = __builtin_nanf(""); for (size_t i = (size_t)F.bx * 512 + F.tid; i < (size_t)M_TOK * DM / 4; i += (size_t)F.G * 512) ((f32x4*)args.out)[i] = (f32x4){q, q, q, q}; }
}

#ifdef PROBE_CVT
__global__ void __launch_bounds__(512) bench_cvt(float* sink) {
    const int lane = threadIdx.x & 63;
#if PROBE_CVT == 1
    typedef unsigned v6u_ __attribute__((ext_vector_type(6))); typedef float v32f_ __attribute__((ext_vector_type(32)));
    v6u_ src = {(unsigned)lane, 2u, 3u, 4u, 5u, 6u}; float a0 = 0.f, a1 = 0.f;
#pragma unroll 4
    for (int it = 0; it < 16384; ++it) { src[0] += 1u; const v32f_ r = __builtin_amdgcn_cvt_scalef32_pk32_f32_fp6(src, 1.0f); a0 += r[0]; a1 += r[31]; }
    if (a0 + a1 == 12345.678f) sink[0] = 0.f;
#else
    unsigned s0 = (unsigned)lane; f32x2 acc = {0.f, 0.f};
#pragma unroll 4
    for (int it = 0; it < 16384; ++it) {
#pragma unroll
        for (int w = 0; w < 8; ++w) { s0 += 1u; acc += __builtin_amdgcn_cvt_pk_f32_fp8((int)s0, false); acc += __builtin_amdgcn_cvt_pk_f32_fp8((int)s0, true); } }
    if (acc.x + acc.y == 12345.678f) sink[0] = 0.f;
#endif
}
#endif
extern "C" void kernel_launch(void* const* d_in, const int* in_sizes, int n_in, void* d_out, int out_size, void* d_ws, size_t ws_size, hipStream_t stream) {
    static int grid = 0;
    if (grid == 0) {
        if (n_in != 23 || out_size != M_TOK * DM || ws_size < WS_END) { fprintf(stderr, "kernel_launch: unexpected shapes (n_in %d out %d ws %zu)\n", n_in, out_size, ws_size); grid = -1; return; }
        int dev = 0, cus = 0, per_cu = 0;
        if (hipGetDevice(&dev) != hipSuccess || hipDeviceGetAttribute(&cus, hipDeviceAttributeMultiprocessorCount, dev) != hipSuccess) { grid = -1; return; }
        if (hipFuncSetAttribute((const void*)mega_fwd, hipFuncAttributeMaxDynamicSharedMemorySize, LDS_BYTES) != hipSuccess) { fprintf(stderr, "hipFuncSetAttribute failed\n"); grid = -1; return; }
        if (hipOccupancyMaxActiveBlocksPerMultiprocessor(&per_cu, (const void*)mega_fwd, NWAVES * 64, LDS_BYTES) != hipSuccess || per_cu < 1) fprintf(stderr, "occupancy query reports %d\n", per_cu);
        (void)hipGetLastError();
        grid = cus;
        if (grid != 256) { fprintf(stderr, "kernel_launch: built for 256 CUs, got %d\n", cus); grid = -1; return; }
    }
    if (grid < 0) return;
    (void)hipMemsetAsync((char*)d_ws + WS_CTL, 0, CTL_ZERO_BYTES, stream);
    Args a{};
    for (int i = 0; i < 23; ++i) a.in[i] = (const float*)d_in[i];
    a.out = (float*)d_out; a.ws = (unsigned char*)d_ws;
#ifdef PROBE_CVT
    hipLaunchKernelGGL(bench_cvt, dim3(256), dim3(512), 0, stream, (float*)d_ws + (4u << 20));
#endif
#ifdef PROBE_PREFIX
    a.ph_lo = 0; a.ph_hi = PROBE_PREFIX;
#ifdef PROBE_P0_MASK
    a.p0_mask = PROBE_P0_MASK;
#else
    a.p0_mask = 3;
#endif
    hipLaunchKernelGGL(mega_fwd, dim3(grid), dim3(NWAVES * 64), LDS_BYTES, stream, a);
    (void)hipMemsetAsync((char*)d_ws + WS_CTL, 0, CTL_ZERO_BYTES, stream);
#endif
    a.ph_lo = 0; a.ph_hi = LAST_PHASE + 1; a.p0_mask = 3;
    hipLaunchKernelGGL(mega_fwd, dim3(grid), dim3(NWAVES * 64), LDS_BYTES, stream, a);
}
```

```cpp
#include <hip/hip_runtime.h>
#include <cstdio>
#include <cstdint>
#include <cmath>
namespace pg8 {
#define PG8_LAS __attribute__((address_space(3)))
typedef unsigned short bf16_t;
typedef short bf16x8 __attribute__((ext_vector_type(8)));
typedef float f32x4 __attribute__((ext_vector_type(4)));
typedef unsigned u32x4 __attribute__((ext_vector_type(4)));
constexpr int BM = 256, BK = 64, HALF = 128, HTB = HALF * BK * 2  , STAGE_BYTES = 8 * HTB, NXCD = 8, WGM = 8;

__host__ __device__ __forceinline__ int lds_byte(int r, int c) { const int st = (r >> 4) * 2 + (c >> 5), rr = r & 15, cc = c & 31, ob = rr * 64 + cc * 2; return st * 1024 + (ob ^ (((ob >> 9) & 1) << 5)); }
__host__ __device__ __forceinline__ void stage_rc(int b, int& R, int& C) { const int st = b / 1024, sb = b % 1024, swz = sb ^ (((sb >> 9) & 1) << 5); R = (st >> 1) * 16 + swz / 64; C = (st & 1) * 32 + (swz % 64) / 2; }
__host__ __device__ __forceinline__ int perm32(int rho) { const int n = rho >> 4, i = rho & 15; return 8 * (i >> 2) + 4 * n + (i & 3); }

struct Unit { int pm, pn, kp; };
typedef int pg8_v4i __attribute__((ext_vector_type(4)));
struct Gemm { const bf16_t* A; const bf16_t* Bt; int M, N, K, lda; int scale_b; int ldb; };

struct StaticOrder {
    int nM, nN, nwg, G, c, kshift = 0;
    __host__ __device__ __forceinline__ void init(int M, int N, int G_, int c_) { nM = M / BM; nN = N / BM; nwg = nM * nN; G = G_; c = c_; }
    __host__ __device__ __forceinline__ bool next(int i2, Unit& u) const {
        const int i = i2 >> kshift; u.kp = i2 & ((1 << kshift) - 1);
        const long L = (long)i * G + c; if (L >= nwg) return false;
        int wgid = (int)L; { const int q = nwg / NXCD, r = nwg % NXCD, xcd = wgid % NXCD, off = wgid / NXCD; wgid = (xcd < r ? xcd * (q + 1) : r * (q + 1) + (xcd - r) * q) + off; }
        const int nig = WGM * nN, gid = wgid / nig, fm = gid * WGM, gsz = (nM - fm) < WGM ? (nM - fm) : WGM;
        u.pm = fm + ((wgid % nig) % gsz); u.pn = (wgid % nig) / gsz; return true;
    }
    __device__ __forceinline__ void a_ready(const Unit&) const {}
    __device__ __forceinline__ void done(const Unit&) const {}
};

__device__ __forceinline__ unsigned cvt_pk_bf16(float lo, float hi) { unsigned r; asm volatile("v_cvt_pk_bf16_f32 %0, %1, %2" : "=v"(r) : "v"(lo), "v"(hi)); return r; }
typedef float f32x2 __attribute__((ext_vector_type(2)));
__device__ __forceinline__ f32x2 gelu_pk(f32x2 v) {
    const f32x2 av = __builtin_elementwise_abs(v), d = av * 0.2316418882f + 1.0f;
    f32x2 t; t.x = __builtin_amdgcn_rcpf(d.x); t.y = __builtin_amdgcn_rcpf(d.y);
    f32x2 q = t * 0.5307027145f + (-0.7265760135f); q = q * t + 0.7107068705f; q = q * t + (-0.142248368f); q = q * t + 0.127414796f; q = q * t;
    const f32x2 s = (v * v) * (-0.72134752044f);
    f32x2 e; e.x = __builtin_amdgcn_exp2f(s.x); e.y = __builtin_amdgcn_exp2f(s.y);
    const f32x2 m = v * (q * e), r = v - m;
    f32x2 o; o.x = v.x < 0.f ? m.x : r.x; o.y = v.y < 0.f ? m.y : r.y; return o;
}

template <int ACT  > struct EpiBf16 {
    static constexpr bool PERM = true, AFTER_DRAIN = false; static_assert(ACT == 0 || ACT == 1, "EpiBf16: ACT is 0 (none) or 1 (gelu_pk)");
    bf16_t* O; int ldc; const float* bias; int split_cols; size_t split_stride; float scale0;
    __device__ __forceinline__ void operator()(const f32x4 (&acc)[2][2][4][2], const Unit& u, int wr, int wc, int fr, int fq) const {
        const int row0 = u.pm * BM + wr * 64 + fr; int colt = u.pn * BM; bf16_t* base = O;
        float sc = 1.f; if (split_cols) { const int t = colt / split_cols; base += (size_t)t * split_stride; colt -= t * split_cols; if (t == 0) sc = scale0; }
        const int col0 = colt + wc * 32 + 8 * fq, bcol0 = u.pn * BM + wc * 32 + 8 * fq;
        f32x4 bv[2][2];
#pragma unroll
        for (int bj = 0; bj < 2; ++bj)
#pragma unroll
            for (int n = 0; n < 2; ++n) bv[bj][n] = bias ? *(const f32x4*)(bias + bcol0 + bj * HALF + 4 * n) : (f32x4){0.f, 0.f, 0.f, 0.f};
#pragma unroll
        for (int ai = 0; ai < 2; ++ai)
#pragma unroll
            for (int m = 0; m < 4; ++m) { bf16_t* rowp = base + (size_t)(row0 + ai * HALF + m * 16) * ldc + col0;
#pragma unroll
                for (int bj = 0; bj < 2; ++bj) { f32x4 v0 = acc[ai][bj][m][0] + bv[bj][0], v1 = acc[ai][bj][m][1] + bv[bj][1];
                    if (ACT == 1) { f32x2 a = gelu_pk((f32x2){v0[0], v0[1]}), b = gelu_pk((f32x2){v0[2], v0[3]}), c = gelu_pk((f32x2){v1[0], v1[1]}), d = gelu_pk((f32x2){v1[2], v1[3]});
                        v0 = (f32x4){a.x, a.y, b.x, b.y}; v1 = (f32x4){c.x, c.y, d.x, d.y}; }
                    v0 = v0 * sc; v1 = v1 * sc; u32x4 w; w.x = cvt_pk_bf16(v0[0], v0[1]); w.y = cvt_pk_bf16(v0[2], v0[3]); w.z = cvt_pk_bf16(v1[0], v1[1]); w.w = cvt_pk_bf16(v1[2], v1[3]);
                    *(u32x4*)(rowp + bj * HALF) = w; } }
    }
};

struct PanelStats {
    unsigned* xbuf;
    unsigned* cnt;
    unsigned* tmo;
    int ntn; float eps;
    unsigned code;
    __device__ __forceinline__ bool run(const f32x4 (&v)[2][2][4][2], const Unit& u, int wr, int wc, int fr, int fq, PG8_LAS unsigned char* lds, int wid, int lane) const {
        typedef float f32x2v __attribute__((ext_vector_type(2)));
        PG8_LAS f32x2v* P = (PG8_LAS f32x2v*)lds;
        PG8_LAS f32x2v* S = (PG8_LAS f32x2v*)(lds + 8192);
        PG8_LAS unsigned* flag = (PG8_LAS unsigned*)(lds + 8192 + 2048);
#pragma unroll
        for (int ai = 0; ai < 2; ++ai)
#pragma unroll
            for (int m = 0; m < 4; ++m) {
                float s = 0.f;
#pragma unroll
                for (int bj = 0; bj < 2; ++bj)
#pragma unroll
                    for (int n = 0; n < 2; ++n) { const f32x4 x = v[ai][bj][m][n]; s += (x[0] + x[1]) + (x[2] + x[3]); }
                s += __shfl_xor(s, 16); s += __shfl_xor(s, 32);
                const float mw = s * (1.0f / 64.0f); float q = 0.f;
#pragma unroll
                for (int bj = 0; bj < 2; ++bj)
#pragma unroll
                    for (int n = 0; n < 2; ++n) { const f32x4 d = v[ai][bj][m][n] - mw; q += (d[0] * d[0] + d[1] * d[1]) + (d[2] * d[2] + d[3] * d[3]); }
                q += __shfl_xor(q, 16); q += __shfl_xor(q, 32);
                if (fq == 0) P[(ai * HALF + wr * 64 + m * 16 + fr) * 4 + wc] = (f32x2v){mw, q};
            }
        asm volatile("s_waitcnt lgkmcnt(0)" ::: "memory"); __builtin_amdgcn_s_barrier(); asm volatile("" ::: "memory");
#if defined(BROKEN_EXCHANGE_NO_WAIT)
#warning BROKEN CONTROL BUILD: the row-statistics exchange does not wait; results are wrong by design
        if (blockIdx.x >= 64) { const long long t0_ = clock64(); while (clock64() - t0_ < 60000) __builtin_amdgcn_s_sleep(8); }
#endif
        const int row = wid * 32 + (lane & 31);
        if (lane < 32) {
            const f32x2v a = P[row * 4 + 0], b = P[row * 4 + 1], c = P[row * 4 + 2], d = P[row * 4 + 3];
            const float mt = (a.x + b.x + c.x + d.x) * 0.25f;
            const float da = a.x - mt, db = b.x - mt, dc = c.x - mt, dd = d.x - mt;
            const float m2 = (a.y + b.y) + (c.y + d.y) + 64.0f * ((da * da + db * db) + (dc * dc + dd * dd));
            unsigned long long* slot = (unsigned long long*)xbuf + ((size_t)(u.pm * BM + row) * 4 + u.pn);
            __hip_atomic_store(slot, ((unsigned long long)__float_as_uint(m2) << 32) | __float_as_uint(mt), __ATOMIC_RELAXED, __HIP_MEMORY_SCOPE_AGENT);
        }
        asm volatile("s_waitcnt vmcnt(0)" ::: "memory");
        if (lane == 0) __hip_atomic_fetch_add(cnt + 64 * u.pm, 1u, __ATOMIC_RELAXED, __HIP_MEMORY_SCOPE_AGENT);
        if (wid == 0) {
            bool dead = false; const unsigned long long t0 = __builtin_amdgcn_s_memrealtime(); const unsigned want = 8u * (unsigned)ntn;
            for (;;) {
#if defined(BROKEN_EXCHANGE_NO_WAIT)
                break;
#endif
                if ((unsigned)__builtin_amdgcn_readfirstlane(__hip_atomic_load(cnt + 64 * u.pm, __ATOMIC_RELAXED, __HIP_MEMORY_SCOPE_AGENT)) >= want) break;
                if (__builtin_amdgcn_s_memrealtime() - t0 > 2000000ull) {
                    if (lane == 0) { unsigned expect = 0u; __hip_atomic_compare_exchange_strong(tmo + 1, &expect, code | (unsigned)(u.pm & 0xff), __ATOMIC_RELAXED, __ATOMIC_RELAXED, __HIP_MEMORY_SCOPE_AGENT);
                                     __hip_atomic_store(tmo, 1u, __ATOMIC_RELAXED, __HIP_MEMORY_SCOPE_AGENT); }
                    dead = true; break; }
                __builtin_amdgcn_s_sleep(2);
            }
            __builtin_amdgcn_fence(__ATOMIC_ACQUIRE, "agent");
            if (lane == 0) flag[0] = dead ? 1u : 0u;
        }
        asm volatile("s_waitcnt vmcnt(0) lgkmcnt(0)" ::: "memory"); __builtin_amdgcn_s_barrier(); asm volatile("" ::: "memory");
        const bool bad = flag[0] != 0u;
        if (lane < 32) {
            const unsigned long long* slot = (const unsigned long long*)xbuf + (size_t)(u.pm * BM + row) * 4; float mt[4], m2[4]; float ms = 0.f;
#pragma unroll
            for (int t = 0; t < 4; ++t) { if (t < ntn) { const unsigned long long w = __hip_atomic_load(slot + t, __ATOMIC_RELAXED, __HIP_MEMORY_SCOPE_AGENT); mt[t] = __uint_as_float((unsigned)w); m2[t] = __uint_as_float((unsigned)(w >> 32)); } else { mt[t] = 0.f; m2[t] = 0.f; } ms += mt[t]; }
            const float mean = ms / (float)ntn; float q = 0.f;
#pragma unroll
            for (int t = 0; t < 4; ++t) if (t < ntn) { const float dm = mt[t] - mean; q += m2[t] + 256.0f * dm * dm; }
            S[row] = (f32x2v){mean, 1.0f / sqrtf(q / (256.0f * (float)ntn) + eps)};
        }
        asm volatile("s_waitcnt lgkmcnt(0)" ::: "memory"); __builtin_amdgcn_s_barrier(); asm volatile("" ::: "memory");
        return bad;
    }
};
struct EpiLnRes {
    static constexpr bool PERM = false, AFTER_DRAIN = true;
    const float* base; float* out; int ldc; const float* bias; PanelStats st; unsigned poison;
    __device__ __forceinline__ void fused(f32x4 (&acc)[2][2][4][2], const Unit& u, int wr, int wc, int fr, int fq, PG8_LAS unsigned char* lds, int wid, int lane) const {
        typedef float f32x2v __attribute__((ext_vector_type(2)));
        const PG8_LAS f32x2v* S = (const PG8_LAS f32x2v*)(lds + 8192);
        const int col0 = u.pn * BM + wc * 32 + 4 * fq;
#pragma unroll
        for (int bj = 0; bj < 2; ++bj)
#pragma unroll
            for (int n = 0; n < 2; ++n) { const f32x4 bv = bias ? *(const f32x4*)(bias + col0 + bj * HALF + n * 16) : (f32x4){0.f, 0.f, 0.f, 0.f};
#pragma unroll
                for (int ai = 0; ai < 2; ++ai)
#pragma unroll
                    for (int m = 0; m < 4; ++m) acc[ai][bj][m][n] += bv; }
        f32x4 pre[4][2][2];
#pragma unroll
        for (int m = 0; m < 4; ++m) { const size_t off = (size_t)(u.pm * BM + wr * 64 + m * 16 + fr) * ldc + col0;
#pragma unroll
            for (int bj = 0; bj < 2; ++bj)
#pragma unroll
                for (int n = 0; n < 2; ++n) pre[m][bj][n] = *(const f32x4*)(base + off + bj * HALF + n * 16); }
        const bool bad = st.run(acc, u, wr, wc, fr, fq, lds, wid, lane) || poison != 0u;
        const float qnan = __builtin_nanf("");
#pragma unroll
        for (int ai = 0; ai < 2; ++ai)
#pragma unroll
            for (int m = 0; m < 4; ++m) { const int r = ai * HALF + wr * 64 + m * 16 + fr; const f32x2v sr = S[r]; const size_t off = (size_t)(u.pm * BM + r) * ldc + col0;
#pragma unroll
                for (int bj = 0; bj < 2; ++bj)
#pragma unroll
                    for (int n = 0; n < 2; ++n) { const f32x4 bs = ai == 0 ? pre[m][bj][n] : *(const f32x4*)(base + off + bj * HALF + n * 16); f32x4 o = bs + (acc[ai][bj][m][n] - sr.x) * sr.y;
                        if (bad) o = (f32x4){qnan, qnan, qnan, qnan}; *(f32x4*)(out + off + bj * HALF + n * 16) = o; }
                if (m & 1) asm volatile("" ::: "memory"); }
    }
};
struct EpiLnResLn {
    static constexpr bool PERM = false, AFTER_DRAIN = true;
    const float* base; float* out; bf16_t* xn; int ldc; const float* bias; PanelStats st1, st2; unsigned poison;
    __device__ __forceinline__ void fused(f32x4 (&acc)[2][2][4][2], const Unit& u, int wr, int wc, int fr, int fq, PG8_LAS unsigned char* lds, int wid, int lane) const {
        typedef float f32x2v __attribute__((ext_vector_type(2))); typedef unsigned u32x2v __attribute__((ext_vector_type(2)));
        const PG8_LAS f32x2v* S = (const PG8_LAS f32x2v*)(lds + 8192);
        const int col0 = u.pn * BM + wc * 32 + 4 * fq;
#pragma unroll
        for (int bj = 0; bj < 2; ++bj)
#pragma unroll
            for (int n = 0; n < 2; ++n) { const f32x4 bv = bias ? *(const f32x4*)(bias + col0 + bj * HALF + n * 16) : (f32x4){0.f, 0.f, 0.f, 0.f};
#pragma unroll
                for (int ai = 0; ai < 2; ++ai)
#pragma unroll
                    for (int m = 0; m < 4; ++m) acc[ai][bj][m][n] += bv; }
        bool bad = st1.run(acc, u, wr, wc, fr, fq, lds, wid, lane) || poison != 0u;
        const float qnan = __builtin_nanf("");
#pragma unroll
        for (int ai = 0; ai < 2; ++ai)
#pragma unroll
            for (int m = 0; m < 4; ++m) { const int r = ai * HALF + wr * 64 + m * 16 + fr; const f32x2v sr = S[r]; const size_t off = (size_t)(u.pm * BM + r) * ldc + col0;
#pragma unroll
                for (int bj = 0; bj < 2; ++bj)
#pragma unroll
                    for (int n = 0; n < 2; ++n) { const f32x4 bs = *(const f32x4*)(base + off + bj * HALF + n * 16); acc[ai][bj][m][n] = bs + (acc[ai][bj][m][n] - sr.x) * sr.y; }
                asm volatile("" : "+v"(acc[ai][0][m][0]), "+v"(acc[ai][0][m][1]), "+v"(acc[ai][1][m][0]), "+v"(acc[ai][1][m][1]));
                if (m & 1) asm volatile("" ::: "memory"); }
        const bool bad1 = bad;
        bad = st2.run(acc, u, wr, wc, fr, fq, lds, wid, lane) || bad;
#pragma unroll
        for (int ai = 0; ai < 2; ++ai)
#pragma unroll
            for (int m = 0; m < 4; ++m) { const int r = ai * HALF + wr * 64 + m * 16 + fr; const f32x2v sr = S[r]; const size_t off = (size_t)(u.pm * BM + r) * ldc + col0;
#pragma unroll
                for (int bj = 0; bj < 2; ++bj)
#pragma unroll
                    for (int n = 0; n < 2; ++n) { const f32x4 x1 = acc[ai][bj][m][n]; *(f32x4*)(out + off + bj * HALF + n * 16) = bad1 ? (f32x4){qnan, qnan, qnan, qnan} : x1;
                        const f32x4 o = (x1 - sr.x) * sr.y; u32x2v w; w.x = cvt_pk_bf16(o[0], o[1]); w.y = cvt_pk_bf16(o[2], o[3]);
                        if (bad) { w.x = 0x7fc07fc0u; w.y = 0x7fc07fc0u; } *(u32x2v*)(xn + off + bj * HALF + n * 16) = w; }
                asm volatile("" ::: "memory"); }
    }
};

typedef int pg8_v8i __attribute__((ext_vector_type(8)));
template <bool FP8> struct Frag;
template <> struct Frag<false> { bf16x8 k[2]; };
template <> struct Frag<true> { pg8_v8i v; };
__device__ __forceinline__ void load_frag(Frag<false>& f, const PG8_LAS unsigned char* p) { f.k[0] = *(const PG8_LAS bf16x8*)p; f.k[1] = *(const PG8_LAS bf16x8*)(p + 1024); }
__device__ __forceinline__ void load_frag(Frag<true>& f, const PG8_LAS unsigned char* p) { const pg8_v4i a = *(const PG8_LAS pg8_v4i*)p, b = *(const PG8_LAS pg8_v4i*)(p + 1024); f.v = __builtin_shufflevector(a, b, 0, 1, 2, 3, 4, 5, 6, 7); }
__device__ __forceinline__ void mma_frag(f32x4& acc, const Frag<false>& b, const Frag<false>& a, int) { acc = __builtin_amdgcn_mfma_f32_16x16x32_bf16(b.k[0], a.k[0], acc, 0, 0, 0); acc = __builtin_amdgcn_mfma_f32_16x16x32_bf16(b.k[1], a.k[1], acc, 0, 0, 0); }
__device__ __forceinline__ void mma_frag(f32x4& acc, const Frag<true>& b, const Frag<true>& a, int scale_w) {
    asm volatile("v_mfma_scale_f32_16x16x128_f8f6f4 %0, %1, %2, %0, %3, %4 op_sel_hi:[0,0,0]" : "+v"(acc) : "v"(b.v), "v"(a.v), "v"(scale_w), "v"(0x7F7F7F7F)); }
template <class Epi, class Sched, bool ALIGN_EPI = false, bool SP2 = false, bool FP8 = false>
__device__ __forceinline__ void gemm_phase(PG8_LAS unsigned char* lds, const Gemm g, const Sched& S, const Epi& E) {
    int tid_ = threadIdx.x; asm volatile("" : "+v"(tid_));
    const int tid = tid_, wid = __builtin_amdgcn_readfirstlane(tid >> 6), lane = tid & 63, wr = wid >> 2, wc = wid & 3, fr = lane & 15, fq = lane >> 4;
    const int K = g.K, nt = K / BK;
    unsigned voffA[2], voffB[2];
#pragma unroll
    for (int i = 0; i < 2; ++i) { int R, C; stage_rc(tid * 16 + i * 8192, R, C); const int Rb = Epi::PERM ? ((R & ~31) + perm32(R & 31)) : R;
        voffA[i] = (unsigned)(R * g.lda + C) * 2u; voffB[i] = (unsigned)(Rb * g.ldb + C) * 2u; }
    const size_t kstep = (size_t)(BK * 2);
    const size_t hstepB = (size_t)HALF * g.ldb * 2, hstepA = (size_t)HALF * g.lda * 2;
    const size_t tstepB = 2 * hstepB, tstepA = 2 * hstepA;
    const unsigned ldsw = (unsigned)wid * 1024u;
    const int aoff = lds_byte(wr * 64 + fr, fq * 8), boff = lds_byte(wc * 32 + fr, fq * 8);
#define PG8_SA(b, h) (((b) * 2 + (h)) * HTB)
#define PG8_SB(b, h) ((4 + (b) * 2 + (h)) * HTB)
#define PG8_STAGE(bufoff, gbase, voff) do { _Pragma("unroll") for (int _i = 0; _i < 2; ++_i) \
        __builtin_amdgcn_global_load_lds((const unsigned*)((const char*)(gbase) + (voff)[_i]), (PG8_LAS unsigned*)(lds + (bufoff) + ldsw + _i * 8192), 16, 0, 0); } while (0)
#define PG8_LDA(dst, b, h) do { _Pragma("unroll") for (int m = 0; m < 4; ++m) load_frag(dst[m], lds + PG8_SA(b, h) + aoff + m * 2048); } while (0)
#define PG8_LDB(dst, b, h) do { _Pragma("unroll") for (int n = 0; n < 2; ++n) load_frag(dst[n], lds + PG8_SB(b, h) + boff + n * 2048); } while (0)
#define PG8_MMA(ai, bj, At, Bt) do { __builtin_amdgcn_s_setprio(1); _Pragma("unroll") for (int m = 0; m < 4; ++m) _Pragma("unroll") for (int n = 0; n < 2; ++n) mma_frag(acc[ai][bj][m][n], Bt[n], At[m], g.scale_b); \
        __builtin_amdgcn_s_setprio(0); } while (0)
#define PG8_WAIT_V(n) asm volatile("s_waitcnt vmcnt(" #n ")" ::: "memory")
#define PG8_WAIT_L(n) asm volatile("s_waitcnt lgkmcnt(" #n ")" ::: "memory")
#define PG8_BAR __builtin_amdgcn_s_barrier()
#define PG8_SCHED __builtin_amdgcn_sched_barrier(0)
    Unit cur, nxt; int ui = 0;
    if (!S.next(0, cur)) return;
    f32x4 acc[2][2][4][2];
#pragma unroll
    for (int a = 0; a < 2; ++a)
#pragma unroll
        for (int b = 0; b < 2; ++b)
#pragma unroll
            for (int m = 0; m < 4; ++m)
#pragma unroll
                for (int n = 0; n < 2; ++n) acc[a][b][m][n] = (f32x4){0.f, 0.f, 0.f, 0.f};
    Frag<FP8> At[4], B0[2], B1[2];
    const size_t kpart = (size_t)K * 2;
    const char* cA = (const char*)g.A + (size_t)cur.pm * tstepA + cur.kp * kpart; const char* cB = (const char*)g.Bt + (size_t)cur.pn * tstepB + cur.kp * kpart;
    S.a_ready(cur);
    if constexpr (SP2) {
        PG8_STAGE(PG8_SB(0, 0), cB, voffB); PG8_STAGE(PG8_SB(0, 1), cB + hstepB, voffB); PG8_STAGE(PG8_SA(0, 0), cA, voffA); PG8_STAGE(PG8_SA(0, 1), cA + hstepA, voffA);
        if (wr == 1) PG8_BAR;
        PG8_WAIT_V(2); PG8_BAR;
        PG8_STAGE(PG8_SB(1, 0), cB + kstep, voffB); PG8_STAGE(PG8_SA(1, 0), cA + kstep, voffA); PG8_STAGE(PG8_SB(1, 1), cB + hstepB + kstep, voffB);
        PG8_WAIT_V(6); PG8_BAR;
    } else {
        PG8_STAGE(PG8_SB(0, 0), cB, voffB); PG8_STAGE(PG8_SA(0, 0), cA, voffA); PG8_STAGE(PG8_SB(0, 1), cB + hstepB, voffB); PG8_STAGE(PG8_SA(0, 1), cA + hstepA, voffA);
        if (wr == 1) PG8_BAR;
        PG8_WAIT_V(4); PG8_BAR;
        PG8_STAGE(PG8_SB(1, 0), cB + kstep, voffB); PG8_STAGE(PG8_SA(1, 0), cA + kstep, voffA); PG8_STAGE(PG8_SB(1, 1), cB + hstepB + kstep, voffB);
        PG8_WAIT_V(6); PG8_BAR;
    }
    for (;;) {
        const bool has_next = S.next(ui + 1, nxt);
        const char* nA = has_next ? (const char*)g.A + (size_t)nxt.pm * tstepA + nxt.kp * kpart : cA; const char* nB = has_next ? (const char*)g.Bt + (size_t)nxt.pn * tstepB + nxt.kp * kpart : cB;
        for (int t = 0; t < nt; t += 2) {
            const bool last = (t == nt - 2);
            const char* a1 = cA + (size_t)(t + 1) * kstep;
            const char* a2 = last ? nA : cA + (size_t)(t + 2) * kstep; const char* b2 = last ? nB : cB + (size_t)(t + 2) * kstep;
            const char* a3 = a2 + kstep; const char* b3 = b2 + kstep;
            if (last && has_next) S.a_ready(nxt);
            if constexpr (SP2) {
            PG8_LDB(B0, 0, 0); PG8_LDB(B1, 0, 1); PG8_SCHED; PG8_LDA(At, 0, 0); PG8_STAGE(PG8_SA(1, 1), a1 + hstepA, voffA);
            PG8_WAIT_V(8); PG8_WAIT_L(0); PG8_BAR; PG8_MMA(0, 0, At, B0); PG8_MMA(0, 1, At, B1); PG8_BAR; PG8_SCHED;
            PG8_LDA(At, 0, 1); PG8_STAGE(PG8_SB(0, 0), b2, voffB); PG8_STAGE(PG8_SB(0, 1), b2 + hstepB, voffB); PG8_STAGE(PG8_SA(0, 0), a2, voffA);
            PG8_WAIT_V(8); PG8_WAIT_L(0); PG8_BAR; PG8_MMA(1, 0, At, B0); PG8_MMA(1, 1, At, B1); PG8_BAR; PG8_SCHED;
            PG8_LDB(B0, 1, 0); PG8_LDB(B1, 1, 1); PG8_SCHED; PG8_LDA(At, 1, 0); PG8_STAGE(PG8_SA(0, 1), a2 + hstepA, voffA);
            PG8_WAIT_V(8); PG8_WAIT_L(0); PG8_BAR; PG8_MMA(0, 0, At, B0); PG8_MMA(0, 1, At, B1); PG8_BAR; PG8_SCHED;
            PG8_LDA(At, 1, 1); PG8_STAGE(PG8_SB(1, 0), b3, voffB); PG8_STAGE(PG8_SB(1, 1), b3 + hstepB, voffB); PG8_STAGE(PG8_SA(1, 0), a3, voffA);
            PG8_WAIT_V(8); PG8_WAIT_L(0); PG8_BAR; PG8_MMA(1, 0, At, B0); PG8_MMA(1, 1, At, B1); PG8_BAR; PG8_SCHED;
            } else {
            PG8_LDB(B0, 0, 0); PG8_SCHED; PG8_LDA(At, 0, 0); PG8_STAGE(PG8_SA(1, 1), a1 + hstepA, voffA);
            PG8_WAIT_L(8); PG8_BAR; PG8_WAIT_L(0); PG8_MMA(0, 0, At, B0); PG8_BAR; PG8_SCHED;
            PG8_LDB(B1, 0, 1); PG8_STAGE(PG8_SB(0, 0), b2, voffB);
            PG8_BAR; PG8_WAIT_L(0); PG8_MMA(0, 1, At, B1); PG8_BAR;
            PG8_LDA(At, 0, 1); PG8_STAGE(PG8_SA(0, 0), a2, voffA);
            PG8_BAR; PG8_WAIT_L(0); PG8_MMA(1, 0, At, B0); PG8_BAR; PG8_SCHED;
            PG8_STAGE(PG8_SB(0, 1), b2 + hstepB, voffB);
            PG8_WAIT_V(6); PG8_BAR; PG8_MMA(1, 1, At, B1); PG8_BAR;
            PG8_LDB(B0, 1, 0); PG8_SCHED; PG8_LDA(At, 1, 0); PG8_STAGE(PG8_SA(0, 1), a2 + hstepA, voffA);
            PG8_WAIT_L(8); PG8_BAR; PG8_WAIT_L(0); PG8_MMA(0, 0, At, B0); PG8_BAR; PG8_SCHED;
            PG8_LDB(B1, 1, 1); PG8_STAGE(PG8_SB(1, 0), b3, voffB);
            PG8_BAR; PG8_WAIT_L(0); PG8_MMA(0, 1, At, B1); PG8_BAR;
            PG8_LDA(At, 1, 1); PG8_STAGE(PG8_SA(1, 0), a3, voffA);
            PG8_BAR; PG8_WAIT_L(0); PG8_MMA(1, 0, At, B0); PG8_BAR; PG8_SCHED;
            PG8_STAGE(PG8_SB(1, 1), b3 + hstepB, voffB);
            PG8_WAIT_V(6); PG8_BAR; PG8_MMA(1, 1, At, B1); PG8_BAR;
            }
        }
        if constexpr (ALIGN_EPI) { if (wr == 0) PG8_BAR; }
        if constexpr (FP8) { asm volatile("s_nop 15\n\ts_nop 15" ::: "memory"); }
        if constexpr (!Epi::AFTER_DRAIN) { E(acc, cur, wr, wc, fr, fq); S.done(cur); }
        if (!has_next) break;
        if (nxt.kp == 0)
#pragma unroll
        for (int a = 0; a < 2; ++a)
#pragma unroll
            for (int b = 0; b < 2; ++b)
#pragma unroll
                for (int m = 0; m < 4; ++m)
#pragma unroll
                    for (int n = 0; n < 2; ++n) acc[a][b][m][n] = (f32x4){0.f, 0.f, 0.f, 0.f};
        cur = nxt; cA = nA; cB = nB; ++ui;
        if constexpr (ALIGN_EPI) { if (wr == 1) PG8_BAR; }
    }
    PG8_WAIT_V(0);
    if constexpr (!ALIGN_EPI) { if (wr == 0) PG8_BAR; }
    PG8_BAR;
    if constexpr (Epi::AFTER_DRAIN) { E.fused(acc, cur, wr, wc, fr, fq, lds, wid, lane); S.done(cur); }
#undef PG8_SA
#undef PG8_SB
#undef PG8_STAGE
#undef PG8_LDA
#undef PG8_LDB
#undef PG8_MMA
#undef PG8_WAIT_V
#undef PG8_WAIT_L
#undef PG8_BAR
#undef PG8_SCHED
}
}

#ifndef PG8_SP2
#define PG8_SP2 true
#endif
#ifndef PG8_ALIGN
#define PG8_ALIGN true
#endif
namespace pg8 {
typedef unsigned u32x2e __attribute__((ext_vector_type(2)));
__device__ __forceinline__ float bfbits2f(unsigned b16) { return __uint_as_float(b16 << 16); }
__device__ __forceinline__ void unpack8(const u32x4 w, float (&f)[8]) {
    f[0] = __uint_as_float(w.x << 16); f[1] = __uint_as_float(w.x & 0xffff0000u); f[2] = __uint_as_float(w.y << 16); f[3] = __uint_as_float(w.y & 0xffff0000u);
    f[4] = __uint_as_float(w.z << 16); f[5] = __uint_as_float(w.z & 0xffff0000u); f[6] = __uint_as_float(w.w << 16); f[7] = __uint_as_float(w.w & 0xffff0000u);
}
__device__ __forceinline__ u32x4 pack8f(const float (&f)[8]) { u32x4 w; w.x = cvt_pk_bf16(f[0], f[1]); w.y = cvt_pk_bf16(f[2], f[3]); w.z = cvt_pk_bf16(f[4], f[5]); w.w = cvt_pk_bf16(f[6], f[7]); return w; }
__device__ __forceinline__ float sigmoid_f(float x) { return __builtin_amdgcn_rcpf(1.f + __builtin_amdgcn_exp2f(-1.4426950408889634f * x)); }

struct EpiProj {
    static constexpr bool PERM = true, AFTER_DRAIN = false;
    bf16_t* O; int ldc; int pn_off;
    __device__ __forceinline__ void operator()(const f32x4 (&acc)[2][2][4][2], const Unit& u, int wr, int wc, int fr, int fq) const {
        const int row0 = u.pm * BM + wr * 64 + fr, col0 = u.pn * BM + wc * 32 + 8 * fq;
        const int gpn = u.pn + pn_off; const int act = gpn < 24 ? 0 : (gpn < 28 ? 1 : 2);
#pragma unroll
        for (int ai = 0; ai < 2; ++ai)
#pragma unroll
            for (int m = 0; m < 4; ++m) { bf16_t* rowp = O + (size_t)(row0 + ai * HALF + m * 16) * ldc + col0;
#pragma unroll
                for (int bj = 0; bj < 2; ++bj) { float v[8];
#pragma unroll
                    for (int i = 0; i < 4; ++i) { v[i] = acc[ai][bj][m][0][i]; v[4 + i] = acc[ai][bj][m][1][i]; }
                    if (act != 0) {
#pragma unroll
                        for (int i = 0; i < 8; ++i) { const float s = sigmoid_f(v[i]); v[i] = (act == 1) ? v[i] * s : s; } }
                    *(u32x4*)(rowp + bj * HALF) = pack8f(v); } }
    }
};
struct EpiRowScale {
    static constexpr bool PERM = true, AFTER_DRAIN = false;
    bf16_t* O; int ldc; const float* rowss; float inv_n, eps;
    __device__ __forceinline__ void operator()(const f32x4 (&acc)[2][2][4][2], const Unit& u, int wr, int wc, int fr, int fq) const {
        const int row0 = u.pm * BM + wr * 64 + fr, col0 = u.pn * BM + wc * 32 + 8 * fq;
        float sc[2][4];
#pragma unroll
        for (int ai = 0; ai < 2; ++ai)
#pragma unroll
            for (int m = 0; m < 4; ++m) sc[ai][m] = rowss ? rowss[row0 + ai * HALF + m * 16] : 0.f;
#pragma unroll
        for (int ai = 0; ai < 2; ++ai)
#pragma unroll
            for (int m = 0; m < 4; ++m) { const int row = row0 + ai * HALF + m * 16; bf16_t* rowp = O + (size_t)row * ldc + col0;
                const float s = rowss ? 1.f / sqrtf(sc[ai][m] * inv_n + eps) : 1.f;
#pragma unroll
                for (int bj = 0; bj < 2; ++bj) { float v[8];
#pragma unroll
                    for (int i = 0; i < 4; ++i) { v[i] = acc[ai][bj][m][0][i] * s; v[4 + i] = acc[ai][bj][m][1][i] * s; }
                    *(u32x4*)(rowp + bj * HALF) = pack8f(v); } }
    }
};
template <bool ADD> struct EpiGate {
    static constexpr bool PERM = true, AFTER_DRAIN = false;
    bf16_t* O; int ldc; const bf16_t* Gt; int ldg; unsigned char* O8; int ld8;
    __device__ __forceinline__ void operator()(const f32x4 (&acc)[2][2][4][2], const Unit& u, int wr, int wc, int fr, int fq) const {
        const int row0 = u.pm * BM + wr * 64 + fr, col0 = u.pn * BM + wc * 32 + 8 * fq;
#pragma unroll
        for (int ai = 0; ai < 2; ++ai)
#pragma unroll
            for (int m = 0; m < 4; ++m) { const int row = row0 + ai * HALF + m * 16; bf16_t* rowp = O + (size_t)row * ldc + col0; const bf16_t* gp = Gt + (size_t)row * ldg + col0;
#pragma unroll
                for (int bj = 0; bj < 2; ++bj) { float v[8], g[8]; unpack8(*(const u32x4*)(gp + bj * HALF), g);
#pragma unroll
                    for (int i = 0; i < 4; ++i) { v[i] = acc[ai][bj][m][0][i] * g[i]; v[4 + i] = acc[ai][bj][m][1][i] * g[4 + i]; }
                    if (ADD) { float t[8]; unpack8(*(const u32x4*)(rowp + bj * HALF), t);
#pragma unroll
                        for (int i = 0; i < 8; ++i) v[i] += t[i];
                        int p0 = 0, p1 = 0; p0 = __builtin_amdgcn_cvt_pk_fp8_f32(v[0], v[1], p0, false); p0 = __builtin_amdgcn_cvt_pk_fp8_f32(v[2], v[3], p0, true);
                        p1 = __builtin_amdgcn_cvt_pk_fp8_f32(v[4], v[5], p1, false); p1 = __builtin_amdgcn_cvt_pk_fp8_f32(v[6], v[7], p1, true);
                        if (O8) *(u32x2e*)(O8 + (size_t)row * ld8 + col0 + bj * HALF) = (u32x2e){(unsigned)p0, (unsigned)p1}; else *(u32x4*)(rowp + bj * HALF) = pack8f(v); }
                    else *(u32x4*)(rowp + bj * HALF) = pack8f(v); } }
    }
};
struct EpiGate8 {
    static constexpr bool PERM = true, AFTER_DRAIN = false;
    const bf16_t* G1; int ldg; unsigned char* O8; int ld8;
    __device__ __forceinline__ void operator()(const f32x4 (&acc)[2][2][4][2], const Unit& u, int wr, int wc, int fr, int fq) const {
        const int row0 = u.pm * BM + wr * 64 + fr, col0 = u.pn * BM + wc * 32 + 8 * fq;
#pragma unroll
        for (int ai = 0; ai < 2; ++ai)
#pragma unroll
            for (int m = 0; m < 4; ++m) { const int row = row0 + ai * HALF + m * 16; const bf16_t* gp = G1 + (size_t)row * ldg + col0;
#pragma unroll
                for (int bj = 0; bj < 2; ++bj) { float v[8], g[8]; unpack8(*(const u32x4*)(gp + bj * HALF), g);
#pragma unroll
                    for (int i = 0; i < 4; ++i) { v[i] = acc[ai][bj][m][0][i] * g[i]; v[4 + i] = acc[ai][bj][m][1][i] * g[4 + i]; }
                    int p0 = 0, p1 = 0; p0 = __builtin_amdgcn_cvt_pk_fp8_f32(v[0], v[1], p0, false); p0 = __builtin_amdgcn_cvt_pk_fp8_f32(v[2], v[3], p0, true);
                    p1 = __builtin_amdgcn_cvt_pk_fp8_f32(v[4], v[5], p1, false); p1 = __builtin_amdgcn_cvt_pk_fp8_f32(v[6], v[7], p1, true);
                    *(u32x2e*)(O8 + (size_t)row * ld8 + col0 + bj * HALF) = (u32x2e){(unsigned)p0, (unsigned)p1}; } }
    }
};
struct EpiResid {
    static constexpr bool PERM = true, AFTER_DRAIN = false;
    const float* base32; const bf16_t* base16; bf16_t* XB; int ldc; float* rowss;
    __device__ __forceinline__ void operator()(const f32x4 (&acc)[2][2][4][2], const Unit& u, int wr, int wc, int fr, int fq) const {
        const int row0 = u.pm * BM + wr * 64 + fr, col0 = u.pn * BM + wc * 32 + 8 * fq;
#pragma unroll
        for (int ai = 0; ai < 2; ++ai)
#pragma unroll
            for (int m = 0; m < 4; ++m) { const int row = row0 + ai * HALF + m * 16; const size_t off = (size_t)row * ldc + col0; float ss = 0.f;
#pragma unroll
                for (int bj = 0; bj < 2; ++bj) { float b[8];
                    if (base32) { const f32x4 b0 = *(const f32x4*)(base32 + off + bj * HALF), b1 = *(const f32x4*)(base32 + off + bj * HALF + 4);
                        b[0] = b0[0]; b[1] = b0[1]; b[2] = b0[2]; b[3] = b0[3]; b[4] = b1[0]; b[5] = b1[1]; b[6] = b1[2]; b[7] = b1[3]; }
                    else unpack8(*(const u32x4*)(base16 + off + bj * HALF), b);
#pragma unroll
                    for (int i = 0; i < 4; ++i) { b[i] += acc[ai][bj][m][0][i]; b[4 + i] += acc[ai][bj][m][1][i]; }
#pragma unroll
                    for (int i = 0; i < 8; ++i) ss += b[i] * b[i];
                    *(u32x4*)(XB + off + bj * HALF) = pack8f(b); }
                ss += __shfl_xor(ss, 16); ss += __shfl_xor(ss, 32);
                if (fq == 0) atomicAdd(rowss + row, ss); }
    }
};
struct EpiAny {
    static constexpr bool PERM = true, AFTER_DRAIN = false;
    int kind; bf16_t* O; int ldc; const bf16_t* Gt; int ldg; const float* base; const bf16_t* base16; float* rowss; const float* rowss_in; int pn_off; unsigned char* O8; int ld8; const bf16_t* Gt2;
    __device__ __forceinline__ void mid(f32x4 (&acc)[2][2][4][2], const Unit& u, int wr, int wc, int fr, int fq) const {
        const int row0 = u.pm * BM + wr * 64 + fr, col0 = u.pn * BM + wc * 32 + 8 * fq;
#pragma unroll
        for (int ai = 0; ai < 2; ++ai)
#pragma unroll
            for (int m = 0; m < 4; ++m) { const int row = row0 + ai * HALF + m * 16; const bf16_t* g0p = Gt + (size_t)row * ldg + col0; const bf16_t* g1p = Gt2 + (size_t)row * ldg + col0;
#pragma unroll
                for (int bj = 0; bj < 2; ++bj) { float a[8], b[8]; unpack8(*(const u32x4*)(g0p + bj * HALF), a); unpack8(*(const u32x4*)(g1p + bj * HALF), b);
#pragma unroll
                    for (int i = 0; i < 4; ++i) { acc[ai][bj][m][0][i] *= a[i] * __builtin_amdgcn_rcpf(b[i]); acc[ai][bj][m][1][i] *= a[4 + i] * __builtin_amdgcn_rcpf(b[4 + i]); } }
                if (m & 1) asm volatile("" ::: "memory"); }
    }
    __device__ __forceinline__ void operator()(f32x4 (&acc)[2][2][4][2], const Unit& u, int wr, int wc, int fr, int fq) const {
        if (kind == 7 && u.kp == 0) { mid(acc, u, wr, wc, fr, fq); return; }
        if (kind == 0) { EpiProj e{O, ldc, pn_off}; e(acc, u, wr, wc, fr, fq); }
        else if (kind == 1) { EpiRowScale e{O, ldc, rowss_in, 1.f / 2048.f, 1e-6f}; e(acc, u, wr, wc, fr, fq); }
        else if (kind == 2) { EpiGate<false> e{O, ldc, Gt, ldg, nullptr, 0}; e(acc, u, wr, wc, fr, fq); }
        else if (kind == 3) { EpiGate<true> e{O, ldc, Gt, ldg, O8, ld8}; e(acc, u, wr, wc, fr, fq); }
        else if (kind == 6) { EpiGate<true> e{O, ldc, Gt, ldg, nullptr, 0}; e(acc, u, wr, wc, fr, fq); }
        else if (kind == 7) { EpiGate8 e{Gt2, ldg, O8, ld8}; e(acc, u, wr, wc, fr, fq); }
        else { EpiResid e{base, base16, O, ldc, rowss}; e(acc, u, wr, wc, fr, fq); }
    }
};
}
#ifndef ATT_QREG
#define ATT_QREG 1
#endif
namespace att {
using bf16 = unsigned short;
typedef short bf16x8 __attribute__((ext_vector_type(8)));
typedef short s16x4 __attribute__((ext_vector_type(4)));
typedef float f32x16 __attribute__((ext_vector_type(16)));
typedef float f32x4 __attribute__((ext_vector_type(4)));
typedef unsigned u32x4 __attribute__((ext_vector_type(4)));
constexpr int D = 128, NW = 8, QBLK = 32, KVBLK = 64, QB = NW * QBLK;
constexpr int SHM_V = KVBLK * D * 2, SHM_K = KVBLK * D * 2;
constexpr int LDS_WS = 2 * SHM_V + 2 * SHM_K;
constexpr int LDS_BIAS = LDS_WS + NW * 64 * 4;
constexpr int LDS_Q = LDS_BIAS + 2048 * 4;
constexpr int LDS_BYTES = LDS_Q + NW * 8192;
constexpr float THR = 8.f;

#define KSWZ(row, colB) ((row) * 256 + ((colB) ^ (((row) & 7) << 4)))
#define SBAR() __builtin_amdgcn_sched_barrier(0)
__device__ __forceinline__ int v_st(int k, int c) { const int kk = (k & ~0xC) | ((k & 4) << 1) | ((k & 8) >> 1); return ((kk >> 3) * 4 + (c >> 5)) * 512 + ((kk & 7) * 32 + (c & 31)) * 2; }
__device__ __forceinline__ int v_rd_base(int lane) { return ((lane & 3) << 3) | (((lane >> 2) & 3) << 6) | (((lane >> 4) & 1) << 5) | (((lane >> 5) & 1) << 8); }
constexpr int v_rd_off(int d0, int ks, int half) { return d0 * 512 + ks * 4096 + half * 2048; }
__device__ __forceinline__ int crow(int r, int hi) { return (r & 3) + 8 * (r >> 2) + 4 * hi; }
__device__ __forceinline__ unsigned cvtpk(float lo, float hi) { unsigned r; asm volatile("v_cvt_pk_bf16_f32 %0, %1, %2" : "=v"(r) : "v"(lo), "v"(hi)); return r; }
__device__ __forceinline__ bf16x8 load8(const bf16* p) { return *reinterpret_cast<const bf16x8*>(p); }
__device__ __forceinline__ float bf2f(unsigned short b) { return __uint_as_float((unsigned)b << 16); }

__device__ __forceinline__ void mask_tile(f32x16& p0, f32x16& p1, int dq) {
    const float NEG = -__builtin_inff();
#pragma unroll
    for (int r = 0; r < 16; ++r) {
        const int c = (r & 3) + 8 * (r >> 2);
        if (dq - c < 0) p0[r] = NEG;
        if (dq - c - 32 < 0) p1[r] = NEG;
    }
}
__device__ __forceinline__ void partialSM(f32x16& p0, f32x16& p1, float& m_reg, float& mn, float& alpha) {
    float pmax = p0[0]; for (int r = 1; r < 16; ++r) pmax = fmaxf(pmax, p0[r]); for (int r = 0; r < 16; ++r) pmax = fmaxf(pmax, p1[r]);
    { auto rr = __builtin_amdgcn_permlane32_swap(__float_as_uint(pmax), __float_as_uint(pmax), false, false);
      pmax = fmaxf(__uint_as_float(rr[0]), __uint_as_float(rr[1])); }
    if (__builtin_expect(__all((pmax - m_reg) <= THR), 1)) { mn = m_reg; alpha = 1.f; }
    else { mn = fmaxf(m_reg, pmax); alpha = __builtin_amdgcn_exp2f(m_reg - mn); m_reg = mn; }
    for (int r = 0; r < 16; ++r) p0[r] = p0[r] - mn; for (int r = 0; r < 16; ++r) p1[r] = p1[r] - mn;
    for (int r = 0; r < 16; ++r) p0[r] = __builtin_amdgcn_exp2f(p0[r]);
}
#define ATT_PK4(P, B_, OUT) do { unsigned a0 = cvtpk(P[B_+0], P[B_+1]), a1 = cvtpk(P[B_+2], P[B_+3]);                          \
        unsigned b0 = cvtpk(P[B_+4], P[B_+5]), b1 = cvtpk(P[B_+6], P[B_+7]);                                             \
        auto r0 = __builtin_amdgcn_permlane32_swap(a0, b0, false, false); auto r1 = __builtin_amdgcn_permlane32_swap(a1, b1, false, false); \
        u32x4 w = {r0[0], r1[0], r0[1], r1[1]}; OUT = *reinterpret_cast<bf16x8*>(&w); } while (0)
__device__ __forceinline__ void finishSM(f32x16& p0, f32x16& p1, float alpha, float& l_reg, bf16x8& pa0, bf16x8& pa1, bf16x8& pa2, bf16x8& pa3) {
    for (int r = 0; r < 16; ++r) p1[r] = __builtin_amdgcn_exp2f(p1[r]);
    float ps = 0; for (int r = 0; r < 16; ++r) ps += p0[r]; for (int r = 0; r < 16; ++r) ps += p1[r];
    { auto rr = __builtin_amdgcn_permlane32_swap(__float_as_uint(ps), __float_as_uint(ps), false, false);
      ps = __uint_as_float(rr[0]) + __uint_as_float(rr[1]); }
    l_reg = l_reg * alpha + ps;
    ATT_PK4(p0, 0, pa0); ATT_PK4(p0, 8, pa1); ATT_PK4(p1, 0, pa2); ATT_PK4(p1, 8, pa3);
}
__device__ __forceinline__ void ret_weight(f32x16& p0, f32x16& p1, int dq, float lg, int dist) {
    if (dist < 0) { p0 = f32x16{}; p1 = f32x16{}; return; }
    if (dist > 0) { const float f = __builtin_amdgcn_exp2f(lg * 64.f * (float)dist);
#pragma unroll
        for (int r = 0; r < 16; ++r) { p0[r] *= f; p1[r] *= f; }
        return; }
#pragma unroll
    for (int r = 0; r < 16; ++r) {
        const int c = (r & 3) + 8 * (r >> 2);
        const float e0 = 2.f * lg * fmaxf((float)(c - dq), 0.f), e1 = 2.f * lg * fmaxf((float)(c + 32 - dq), 0.f);
        p0[r] *= __builtin_amdgcn_exp2f(e0); p1[r] *= __builtin_amdgcn_exp2f(e1);
    }
}
__device__ __forceinline__ void ret_pack(f32x16& p0, f32x16& p1, bf16x8& pa0, bf16x8& pa1, bf16x8& pa2, bf16x8& pa3) {
    ATT_PK4(p0, 0, pa0); ATT_PK4(p0, 8, pa1); ATT_PK4(p1, 0, pa2); ATT_PK4(p1, 8, pa3);
}
template <int KB, bool BIAS>
__device__ __forceinline__ void qkt(f32x16& p0, f32x16& p1, const char* K_lds, int r32, int hi, const char* Qw  , const float* bias_tile  , const bf16x8* qr = nullptr) {
    if (BIAS) {
#pragma unroll
        for (int g = 0; g < 4; ++g) { const f32x4 b0 = *(const f32x4*)(bias_tile + 8 * g), b1 = *(const f32x4*)(bias_tile + 32 + 8 * g);
            p0[4 * g] = b0[0]; p0[4 * g + 1] = b0[1]; p0[4 * g + 2] = b0[2]; p0[4 * g + 3] = b0[3];
            p1[4 * g] = b1[0]; p1[4 * g + 1] = b1[1]; p1[4 * g + 2] = b1[2]; p1[4 * g + 3] = b1[3]; }
    } else { p0 = f32x16{}; p1 = f32x16{}; }
    int ko[4];
#pragma unroll
    for (int dd = 0; dd < 4; ++dd) ko[dd] = KSWZ(r32, (dd * 16 + hi * 8) * 2);
#pragma unroll
    for (int d0 = 0; d0 < 8; ++d0) { const char* a = K_lds + KB * SHM_K + ko[d0 & 3] + (d0 >> 2) * 128;
        bf16x8 b0 = *reinterpret_cast<const bf16x8*>(a);
        bf16x8 b1 = *reinterpret_cast<const bf16x8*>(a + 32 * 256);
#if ATT_QREG
        bf16x8 q = qr[d0];
#else
        bf16x8 q = *reinterpret_cast<const bf16x8*>(Qw + ko[d0 & 3] + (d0 >> 2) * 128);
#endif
        p0 = __builtin_amdgcn_mfma_f32_32x32x16_bf16(b0, q, p0, 0, 0, 0);
        p1 = __builtin_amdgcn_mfma_f32_32x32x16_bf16(b1, q, p1, 0, 0, 0); }
}
template <int VB>
__device__ __forceinline__ void pv_tile(f32x16* o, int vb0, bf16x8 pa0, bf16x8 pa1, bf16x8 pa2, bf16x8 pa3) {
#define TRRD(dst, off) asm volatile("ds_read_b64_tr_b16 %0, %1 offset:%2" : "=&v"(dst) : "v"(vb0), "i"(off) : "memory")
#define PV_D0(d0) do { s16x4 l0, l1, l2, l3, h0, h1, h2, h3; constexpr int b_ = VB * SHM_V + v_rd_off(d0, 0, 0); \
        TRRD(l0, b_); TRRD(h0, b_ + 2048); TRRD(l1, b_ + 4096); TRRD(h1, b_ + 6144); TRRD(l2, b_ + 8192); TRRD(h2, b_ + 10240); TRRD(l3, b_ + 12288); TRRD(h3, b_ + 14336); \
        asm volatile("s_waitcnt lgkmcnt(0)" ::: "memory"); SBAR();   \
        o[d0] = __builtin_amdgcn_mfma_f32_32x32x16_bf16(pa0, (bf16x8){l0[0], l0[1], l0[2], l0[3], h0[0], h0[1], h0[2], h0[3]}, o[d0], 0, 0, 0);   \
        o[d0] = __builtin_amdgcn_mfma_f32_32x32x16_bf16(pa1, (bf16x8){l1[0], l1[1], l1[2], l1[3], h1[0], h1[1], h1[2], h1[3]}, o[d0], 0, 0, 0);   \
        o[d0] = __builtin_amdgcn_mfma_f32_32x32x16_bf16(pa2, (bf16x8){l2[0], l2[1], l2[2], l2[3], h2[0], h2[1], h2[2], h2[3]}, o[d0], 0, 0, 0);   \
        o[d0] = __builtin_amdgcn_mfma_f32_32x32x16_bf16(pa3, (bf16x8){l3[0], l3[1], l3[2], l3[3], h3[0], h3[1], h3[2], h3[3]}, o[d0], 0, 0, 0); } while (0)
    PV_D0(0); PV_D0(1); PV_D0(2); PV_D0(3);
#undef PV_D0
#undef TRRD
}

struct BlockRef { const bf16* Q; const bf16* K; const bf16* V; bf16* O; int P0; int skv; float lg; const bf16* RG; const float* GN; unsigned char* O8;   };
struct Seam { bf16x8 qr[8]; bf16x8 st_v0, st_v1, st_k0, st_k1; };
template <int MODE> struct Pitch { static constexpr int LDQ = (MODE == 2) ? 512 : 11264, LDK = (MODE == 2) ? 1024 : 11264, LDO = LDQ; };

#define ROWK(p, k0, rr) ((p) + (size_t)((k0) + (rr)) * LDK + sc)
#define VMW() asm volatile("s_waitcnt vmcnt(0)" ::: "memory")
#define VMWN(n) asm volatile("s_waitcnt vmcnt(%0)" :: "i"(n) : "memory")
#define SLOAD_H(Kp, Vp, k0) do { S.st_v0 = load8(ROWK(Vp, k0, sr)); S.st_v1 = load8(ROWK(Vp, k0, 32 + sr));              \
                         S.st_k0 = load8(ROWK(Kp, k0, sr)); S.st_k1 = load8(ROWK(Kp, k0, 32 + sr)); } while (0)
#define SWRITE_HK(bf) do { *(bf16x8*)(K_lds + (bf) * SHM_K + kws) = S.st_k0; *(bf16x8*)(K_lds + (bf) * SHM_K + kws + 32 * 256) = S.st_k1; } while (0)
#define SWRITE_HV(bf) do { *(bf16x8*)(V_lds + (bf) * SHM_V + vst0) = S.st_v0; *(bf16x8*)(V_lds + (bf) * SHM_V + vst1) = S.st_v1; } while (0)
#define SWRITE_H(bf) do { SWRITE_HV(bf); SWRITE_HK(bf); } while (0)

template <int MODE>
__device__ __forceinline__ void attn_prime(const BlockRef& cur, char* lds, Seam& S) {
    constexpr int LDQ = Pitch<MODE>::LDQ, LDK = Pitch<MODE>::LDK;
    int tid_ = threadIdx.x; asm volatile("" : "+v"(tid_));
    const int tid = tid_, wid = __builtin_amdgcn_readfirstlane(tid >> 6), lane = tid & 63, r32 = lane & 31, hi = lane >> 5;
    const int sr = tid >> 4, sc = (tid & 15) * 8, kws = KSWZ(sr, sc * 2); char* K_lds = lds + 2 * SHM_V;
    const int kb0 = 0;
    for (int d0 = 0; d0 < 8; ++d0) S.qr[d0] = load8(cur.Q + (size_t)(wid * QBLK + r32) * LDQ + d0 * 16 + hi * 8);
    SLOAD_H(cur.K, cur.V, kb0); VMW(); SWRITE_HK(0);
    __syncthreads();
}
template <int MODE>
__device__ __forceinline__ void attn_block(const BlockRef& cur, const BlockRef& nxt, char* lds, Seam& S) {
    constexpr int LDQ = Pitch<MODE>::LDQ, LDK = Pitch<MODE>::LDK, LDO = Pitch<MODE>::LDO;
    constexpr bool BIAS = (MODE == 0), SOFTMAX = (MODE != 1);
    int tid_ = threadIdx.x; asm volatile("" : "+v"(tid_));
    const int tid = tid_, wid = __builtin_amdgcn_readfirstlane(tid >> 6), lane = tid & 63, r32 = lane & 31, hi = lane >> 5;
    const int j_lo = 0;
    int j_hi = (cur.P0 + QB - 1) / KVBLK + 1; if (j_hi > cur.skv / KVBLK) j_hi = cur.skv / KVBLK;
    const int NT = j_hi - j_lo;
    const int kbn = 0;
    const int qlo = cur.P0 + wid * QBLK, qm = qlo + r32 - 4 * hi;
    char* V_lds = lds; char* K_lds = lds + 2 * SHM_V;
    float* ws = (float*)(lds + LDS_WS) + wid * 64; float* li_l = ws, * al_l = ws + 32;
    const float* bias = (const float*)(lds + LDS_BIAS) + 4 * hi;
    float m_reg = -1e30f, l_reg = 0; f32x16 o[4] = {};
    const int sr = tid >> 4, sc = (tid & 15) * 8, vst0 = v_st(sr, sc), vst1 = v_st(32 + sr, sc), kws = KSWZ(sr, sc * 2);
    const int vb0 = (int)(uintptr_t)V_lds + v_rd_base(lane);
    const bf16* Kh = cur.K; const bf16* Vh = cur.V;
    const float lg = cur.lg; const int cq = qlo >> 6;
#define RESC(a) do { if (SOFTMAX) { if (__any((a) < 1.f)) { if (hi == 0) al_l[r32] = (a); asm volatile("s_waitcnt lgkmcnt(0)" ::: "memory");              \
                     for (int d_ = 0; d_ < 4; ++d_) for (int r = 0; r < 16; ++r) o[d_][r] *= al_l[crow(r, hi)]; } } } while (0)
#define KBASE(t) ((j_lo + (t)) * KVBLK)
#define POSTQK(P0_, P1_, mnX, alX, t) do { const int kb_ = KBASE(t); \
        if (MODE == 1) { ret_weight(P0_, P1_, qm - kb_, lg, cq - (j_lo + (t))); } \
        else { if (MODE == 0 && (kb_ + KVBLK - 1 > qlo)) mask_tile(P0_, P1_, qm - kb_); partialSM(P0_, P1_, m_reg, mnX, alX); } } while (0)
#define FINISH(P0_, P1_, alX) do { if (MODE == 1) ret_pack(P0_, P1_, pa0, pa1, pa2, pa3); else finishSM(P0_, P1_, alX, l_reg, pa0, pa1, pa2, pa3); } while (0)
    constexpr int NQL = 8;
#define SEAM_K0() do { VMWN(NQL); SWRITE_HK(0); SBAR(); } while (0)
    f32x16 pA0, pA1, pB0, pB1; float mnA = 0.f, mnB = 0.f, alA = 1.f, alB = 1.f; bf16x8 pa0, pa1, pa2, pa3;
    char* Qw = lds + LDS_Q + wid * 8192;
#if ATT_QREG
    const bf16x8* QR = S.qr;
#else
    const bf16x8* QR = nullptr;
#pragma unroll
    for (int d0 = 0; d0 < 8; ++d0) *(bf16x8*)(Qw + KSWZ(r32, (d0 * 16 + hi * 8) * 2)) = S.qr[d0];
#endif
    SWRITE_HV(0); SBAR();
    if (NT > 1) { SLOAD_H(Kh, Vh, KBASE(1)); }
    SBAR(); qkt<0, BIAS>(pA0, pA1, K_lds, r32, hi, Qw, bias + KBASE(0), QR);
    POSTQK(pA0, pA1, mnA, alA, 0);
    if (NT > 1) { VMW(); SWRITE_H(1); }
    __syncthreads();
#define HALF_STEP(PX0, PX1, mnX, alX, PY0, PY1, alY, t, KB, VB, SB) do {                                                      \
        SBAR(); qkt<KB, BIAS>(PX0, PX1, K_lds, r32, hi, Qw, bias + KBASE(t), QR);                                             \
        FINISH(PY0, PY1, alY); SBAR();                                                           \
        if ((t) + 1 < NT) { SLOAD_H(Kh, Vh, KBASE((t) + 1)); SBAR(); }                                               \
        pv_tile<VB>(o, vb0, pa0, pa1, pa2, pa3); POSTQK(PX0, PX1, mnX, alX, (t));                                        \
        __syncthreads();                                                                                                      \
        if ((t) + 1 < NT) { VMW(); SWRITE_H(SB); }                                                                          \
        RESC(alX); __syncthreads(); } while (0)
    for (int t = 1; t + 1 < NT; t += 2) {
        HALF_STEP(pB0, pB1, mnB, alB, pA0, pA1, alA, t, 1, 0, 0);
        HALF_STEP(pA0, pA1, mnA, alA, pB0, pB1, alB, t + 1, 0, 1, 1);
    }
    const bool even = (NT & 1) == 0;
    if (even) { SBAR(); qkt<1, BIAS>(pB0, pB1, K_lds, r32, hi, Qw, bias + KBASE(NT - 1), QR); SBAR(); }
    { constexpr int LDQn = LDQ; SLOAD_H(nxt.K, nxt.V, kbn); SBAR();
#pragma unroll
      for (int d0 = 0; d0 < 8; ++d0) S.qr[d0] = load8(nxt.Q + (size_t)(wid * QBLK + r32) * LDQn + d0 * 16 + hi * 8); }
    SBAR();
    FINISH(pA0, pA1, alA); SBAR();
    pv_tile<0>(o, vb0, pa0, pa1, pa2, pa3);
    if (even) { POSTQK(pB0, pB1, mnB, alB, NT - 1); __syncthreads(); RESC(alB);
        FINISH(pB0, pB1, alB); SBAR(); pv_tile<1>(o, vb0, pa0, pa1, pa2, pa3); }
    SBAR(); SEAM_K0();
    bf16* Ow = cur.O + (size_t)(wid * QBLK) * LDO;
    if (MODE != 1) {
        if (hi == 0) li_l[r32] = l_reg; asm volatile("s_waitcnt lgkmcnt(0)" ::: "memory");
        float rli[16];
#pragma unroll
        for (int r = 0; r < 16; ++r) rli[r] = __builtin_amdgcn_rcpf(li_l[crow(r, hi)]);
#pragma unroll
        for (int r = 0; r < 16; ++r) { const int orow = crow(r, hi);
#pragma unroll
            for (int d0 = 0; d0 < 4; ++d0) { const float v = o[d0][r] * rli[r];
                const float vn = __shfl_xor(v, 1);
                if (cur.O8) { const int pk = __builtin_amdgcn_cvt_pk_fp8_f32(v, vn, 0, false); const int pk2 = __shfl_xor(pk, 2);
                    if ((r32 & 3) == 0) *(unsigned*)(cur.O8 + (size_t)(wid * QBLK + orow) * (MODE == 2 ? 512 : 2048) + d0 * 32 + r32) = ((unsigned)pk & 0xFFFFu) | ((unsigned)pk2 << 16); }
                else if ((r32 & 1) == 0) *(unsigned*)(Ow + (size_t)orow * LDO + d0 * 32 + r32) = cvtpk(v, vn); } }
    } else {
        float gn[4];
#pragma unroll
        for (int d0 = 0; d0 < 4; ++d0) gn[d0] = cur.GN[d0 * 32 + r32];
        const bf16* RGw = cur.RG + (size_t)(wid * QBLK) * LDO;
#pragma unroll
        for (int r = 0; r < 16; ++r) { const int orow = crow(r, hi);
            float s = (o[0][r] + o[1][r]) + (o[2][r] + o[3][r]);
#pragma unroll
            for (int x = 1; x < 32; x <<= 1) s += __shfl_xor(s, x);
            const float mean = s * (1.f / 128.f);
            float q = 0.f;
#pragma unroll
            for (int d0 = 0; d0 < 4; ++d0) { const float dlt = o[d0][r] - mean; q += dlt * dlt; }
#pragma unroll
            for (int x = 1; x < 32; x <<= 1) q += __shfl_xor(q, x);
            const float rstd = 1.f / sqrtf(q * (1.f / 128.f) + 1e-6f);
#pragma unroll
            for (int d0 = 0; d0 < 4; ++d0) { const float g = bf2f(RGw[(size_t)orow * LDO + d0 * 32 + r32]);
                const float v = (o[d0][r] - mean) * rstd * gn[d0] * g;
                const float vn = __shfl_xor(v, 1);
                if (cur.O8) { const int pk = __builtin_amdgcn_cvt_pk_fp8_f32(v, vn, 0, false); const int pk2 = __shfl_xor(pk, 2);
                    if ((r32 & 3) == 0) *(unsigned*)(cur.O8 + (size_t)(wid * QBLK + orow) * 2048 + d0 * 32 + r32) = ((unsigned)pk & 0xFFFFu) | ((unsigned)pk2 << 16); }
                else if ((r32 & 1) == 0) *(unsigned*)(Ow + (size_t)orow * LDO + d0 * 32 + r32) = cvtpk(v, vn); } }
    }
    __syncthreads();
#undef RESC
#undef KBASE
#undef POSTQK
#undef FINISH
#undef SEAM_K0
#undef HALF_STEP
}
#undef ROWK
#undef VMW
#undef VMWN
#undef SLOAD_H
#undef SWRITE_HK
#undef SWRITE_HV
#undef SWRITE_H
#undef SBAR
#undef KSWZ
#undef ATT_PK4
}
#define GAS __attribute__((address_space(1)))
#define LAS __attribute__((address_space(3)))
typedef unsigned short bf16;
typedef unsigned v4u __attribute__((ext_vector_type(4)));
typedef float f32x4 __attribute__((ext_vector_type(4)));
typedef short bf16x8 __attribute__((ext_vector_type(8)));
typedef GAS unsigned gu32;
typedef GAS unsigned long long gu64;
#define RLX_AGENT __ATOMIC_RELAXED, __HIP_MEMORY_SCOPE_AGENT
#define LDS_WAIT() asm volatile("s_waitcnt lgkmcnt(0)" ::: "memory")
#define VM_WAIT() asm volatile("s_waitcnt vmcnt(0)" ::: "memory")
__device__ __forceinline__ unsigned long long rt() { return __builtin_amdgcn_s_memrealtime(); }
__device__ __forceinline__ unsigned f2bf(float f) { unsigned u = __builtin_bit_cast(unsigned, f); return (u + 0x7fffu + ((u >> 16) & 1u)) >> 16; }
__device__ __forceinline__ unsigned pk2(float lo, float hi) { return f2bf(lo) | (f2bf(hi) << 16); }

#define XB_TMO      128
#define XB_XCNT(j)  (256  + 64 * (j))
#define XB_XSUB(j)  (1280 + 64 * (j))
#define XB_XGEN(j)  (2304 + 64 * (j))
#define XB_TOP      3328
#define XB_TOPGEN   3392
#define XCD_BAR_WORDS 3456
#define XB_SPIN_CAP (1u << 18)

__device__ __forceinline__ unsigned xb_ld(unsigned* p)              { return __hip_atomic_load(p, __ATOMIC_RELAXED, __HIP_MEMORY_SCOPE_AGENT); }
__device__ __forceinline__ unsigned xb_add(unsigned* p, unsigned v) { return __hip_atomic_fetch_add(p, v, __ATOMIC_RELAXED, __HIP_MEMORY_SCOPE_AGENT); }
__device__ __forceinline__ unsigned xb_xcc_id() { return (unsigned)__builtin_amdgcn_s_getreg((3 << 11) | 20) & 0xFu; }
#define XB_SPIN(cond, bar) do { unsigned _sp = 0; while (cond) { __builtin_amdgcn_s_sleep(1); \
    if ((++_sp & 255u) == 0u) { if (xb_ld(&(bar)[XB_TMO])) break; if (_sp > XB_SPIN_CAP) { atomicAdd(&(bar)[XB_TMO], 1u); break; } } } } while (0)

struct XcdBarrier {
    unsigned* bar; unsigned x;
    volatile LAS unsigned* st;
};

__device__ __forceinline__ XcdBarrier xcd_barrier_post(unsigned* bar, volatile LAS unsigned* st) {
    XcdBarrier b; b.bar = bar; b.x = xb_xcc_id(); b.st = st;
    if (threadIdx.x == 0) (void)xb_add(&bar[XB_XCNT(b.x)], 1u);
    return b;
}
__device__ __forceinline__ void xcd_barrier_complete(unsigned* bar, unsigned x, unsigned& nloc, unsigned& nx) {
    const unsigned G = gridDim.x * gridDim.y * gridDim.z;
    unsigned sum, cnt, mine, sp = 0u;
    for (;;) {
        sum = 0u; cnt = 0u; mine = 0u;
#pragma unroll
        for (unsigned j = 0; j < 16; ++j) { const unsigned c = xb_ld(&bar[XB_XCNT(j)]); sum += c; cnt += (c > 0u) ? 1u : 0u; mine = (j == x) ? c : mine; }
        if (sum == G) break;
        __builtin_amdgcn_s_sleep(1);
        if ((++sp & 255u) == 0u) { if (xb_ld(&bar[XB_TMO])) break; if (sp > XB_SPIN_CAP) { atomicAdd(&bar[XB_TMO], 1u); break; } }
    }
    nloc = mine > 0u ? mine : 1u; nx = cnt > 0u ? cnt : 1u;
}

__device__ __forceinline__ void xcd_barrier(const XcdBarrier& b) {
    asm volatile("s_waitcnt vmcnt(0)" ::: "memory");
    __syncthreads();
    if (threadIdx.x == 0) {
        unsigned* bar = b.bar;
        __builtin_amdgcn_s_waitcnt(0);
        unsigned nloc = b.st[0], nx = b.st[1];
        if (nloc == 0u) { xcd_barrier_complete(bar, b.x, nloc, nx); b.st[0] = nloc; b.st[1] = nx; }
        const unsigned old = xb_add(&bar[XB_XSUB(b.x)], 1u);
        const unsigned gen = old / nloc;
        if (old + 1u == (gen + 1u) * nloc) {
            __builtin_amdgcn_fence(__ATOMIC_RELEASE, "agent");
            asm volatile("s_waitcnt vmcnt(0)" ::: "memory");
            const unsigned og = xb_add(&bar[XB_TOP], 1u);
            const unsigned tg = og / nx;
            if (og + 1u == (tg + 1u) * nx) xb_add(&bar[XB_TOPGEN], 1u);
            else XB_SPIN(xb_ld(&bar[XB_TOPGEN]) == tg, bar);
            __builtin_amdgcn_fence(__ATOMIC_ACQUIRE, "agent");
            xb_add(&bar[XB_XGEN(b.x)], 1u);
            asm volatile("s_waitcnt vmcnt(0)" ::: "memory");
        } else {
            XB_SPIN(xb_ld(&bar[XB_XGEN(b.x)]) == gen, bar);
            __builtin_amdgcn_fence(__ATOMIC_ACQUIRE, "agent");
            asm volatile("s_waitcnt vmcnt(0)" ::: "memory");
        }
    }
    __syncthreads();
}
constexpr int NWAVES = 8;
constexpr int M_TOK = 16384, DM = 2048, SEQ = 2048, NB = 8;
constexpr int PP = 11264;
constexpr int C_RQ = 0, C_RK = 1024, C_FQ = 2048, C_FK = 3072, C_FV = 4096, C_RV = 5120, C_RG = 6144, C_G0 = 7168, C_G1 = 9216;
constexpr int N_QK = 2048, N_REST = 9216;
#ifndef FP8_UP_OUT
#define FP8_UP_OUT 1
#endif
constexpr int W8_SCALE_B = 0x79797979;
constexpr int N_IN_ORIG = 11272;
constexpr float RMS_EPS = 1e-6f;
constexpr float QK_C2 = 0.08838834764831845f * 1.4426950408889634f;
constexpr size_t MiB = 1u << 20;
constexpr size_t DO_XN8 = 0, DO_OCAT8 = 32 * MiB;
constexpr size_t DO_OFOX8 = DO_OCAT8, DO_ORET8 = DO_OCAT8 + 1024;
constexpr size_t WS_CTL = 0, CTL_ZERO_BYTES = 1 * MiB;
constexpr size_t WS_ROWSS1 = 256 * 1024, WS_ROWSS2 = 512 * 1024;
constexpr size_t WS_WIN = 1 * MiB, WS_WFOX = 45 * MiB, WS_WRET = 49 * MiB, WS_WOUT = 53 * MiB, WS_WMQ = 61 * MiB, WS_WMKV = 63 * MiB, WS_WMO = 67 * MiB, WS_WPQ = 69 * MiB, WS_SUBK = 77 * MiB;
constexpr size_t WS_PSCALE = 79 * MiB;
constexpr size_t WS_LOGF = 78 * MiB, WS_CUMF = 78 * MiB + 512 * 1024;
constexpr size_t WS_XN = 80 * MiB;
constexpr size_t WS_PROJ = 144 * MiB;
constexpr size_t WS_MN = 496 * MiB, WS_KVM = 504 * MiB, WS_END = 508 * MiB;
constexpr size_t WS_XB1B = 144 * MiB;
constexpr size_t WS_XB2 = FP8_UP_OUT ? WS_XB1B : WS_XN;
constexpr size_t WS_XB1 = FP8_UP_OUT ? WS_XN   : WS_XB1B, WS_QM = 208 * MiB, WS_OMEM = 224 * MiB, WS_PU = 240 * MiB, WS_PV = 304 * MiB, WS_QP = (FP8_UP_OUT ? 368 : 144) * MiB  , WS_IDX = 208 * MiB, WS_GATE = 216 * MiB;
constexpr int CW_BAR = 4096, CW_CONV = 64;
constexpr int RING_BYTES = 131072, LDS_BYTES = 147456, LDSCTL_OFF = LDS_BYTES - 1024, MISC_OFF = LDSCTL_OFF + 320;
static_assert(att::LDS_BYTES <= LDSCTL_OFF, "attention LDS");

struct Args { const float* in[23]; float* out; unsigned char* ws; int ph_lo, ph_hi; int p0_mask, pad; };
enum { I_X = 0, I_MEM, I_LN_MIX, I_W_IN, I_B_FORGET, I_FOXQ_G, I_FOXK_G, I_RET_G, I_W_FOXUP, I_W_RETUP, I_W_OUT, I_LN_MEM, I_MEMNORM_G, I_W_MQ, I_W_MKV, I_MEMQ_G, I_MEMK_G, I_W_MO, I_LN_FFN, I_W_PQ, I_SUBK, I_PEER_U, I_PEER_V };

__device__ __forceinline__ float wave_sum(float v) {
#pragma unroll
    for (int o = 1; o < 64; o <<= 1) v += __shfl_xor(v, o);
    return v;
}
__device__ __forceinline__ void transpose_item(const float* W, int ldw, int K, int src_col0, const float* kgain, bf16* WT, int dst_row0, LAS float* scr, int kb, int nb, int lane) {
    const int k0 = 64 * kb, n0 = 32 * nb;
    f32x4 ld[8];
#pragma unroll
    for (int i = 0; i < 8; ++i) ld[i] = *(const GAS f32x4*)(W + (size_t)(k0 + 8 * i + (lane >> 3)) * ldw + src_col0 + n0 + 4 * (lane & 7));
#pragma unroll
    for (int i = 0; i < 8; ++i) { const int kk = 8 * i + (lane >> 3); f32x4 v = ld[i]; if (kgain) v = v * kgain[k0 + kk]; LAS float* d = scr + kk * 33 + 4 * (lane & 7); d[0] = v.x; d[1] = v.y; d[2] = v.z; d[3] = v.w; }
    LDS_WAIT(); asm volatile("" ::: "memory");
    const int c = lane & 7;
#pragma unroll
    for (int j = 0; j < 4; ++j) { const int n = (lane >> 3) + 8 * j; const LAS float* s = scr + (8 * c) * 33 + n;
        v4u o; o.x = pk2(s[0 * 33], s[1 * 33]); o.y = pk2(s[2 * 33], s[3 * 33]); o.z = pk2(s[4 * 33], s[5 * 33]); o.w = pk2(s[6 * 33], s[7 * 33]);
        *(GAS v4u*)(WT + (size_t)(dst_row0 + n0 + n) * K + k0 + 8 * c) = o; }
    LDS_WAIT(); asm volatile("" ::: "memory");
}
__device__ __forceinline__ void transpose_item8(const float* W, int ldw, int K  , int src_col0, unsigned char* WT8  , int kb, int nb, LAS float* scr, int lane) {
    const int k0 = 64 * kb, n0 = 32 * nb;
    f32x4 ld[8];
#pragma unroll
    for (int i = 0; i < 8; ++i) ld[i] = *(const GAS f32x4*)(W + (size_t)(k0 + 8 * i + (lane >> 3)) * ldw + src_col0 + n0 + 4 * (lane & 7));
#pragma unroll
    for (int i = 0; i < 8; ++i) { const int kk = 8 * i + (lane >> 3); const f32x4 v = ld[i] * 64.f; LAS float* d = scr + kk * 33 + 4 * (lane & 7); d[0] = v.x; d[1] = v.y; d[2] = v.z; d[3] = v.w; }
    LDS_WAIT(); asm volatile("" ::: "memory");
    const int c = lane & 7;
#pragma unroll
    for (int j = 0; j < 4; ++j) { const int n = (lane >> 3) + 8 * j; const LAS float* s = scr + (8 * c) * 33 + n;
        int p0 = 0, p1 = 0; p0 = __builtin_amdgcn_cvt_pk_fp8_f32(s[0 * 33], s[1 * 33], p0, false); p0 = __builtin_amdgcn_cvt_pk_fp8_f32(s[2 * 33], s[3 * 33], p0, true);
        p1 = __builtin_amdgcn_cvt_pk_fp8_f32(s[4 * 33], s[5 * 33], p1, false); p1 = __builtin_amdgcn_cvt_pk_fp8_f32(s[6 * 33], s[7 * 33], p1, true);
        *(GAS unsigned long long*)(WT8 + (size_t)(n0 + n) * K + k0 + 8 * c) = (unsigned long long)(unsigned)p0 | ((unsigned long long)(unsigned)p1 << 32); }
    LDS_WAIT(); asm volatile("" ::: "memory");
}
struct TJob { const float* W; int ldw, K, N; const float* gain; bf16* WT; int fp8; };

__device__ __forceinline__ void rms_row_to_bf16(const float* xrow, const float* gain, bf16* orow, int lane, f32x4 (&hv)[8], unsigned char* orow8 = nullptr) {
    const GAS f32x4* xr = (const GAS f32x4*)xrow + lane; float s = 0.f;
#pragma unroll
    for (int j = 0; j < 8; ++j) { hv[j] = xr[64 * j]; s += (hv[j].x * hv[j].x + hv[j].y * hv[j].y) + (hv[j].z * hv[j].z + hv[j].w * hv[j].w); }
    const float r = 1.f / sqrtf(wave_sum(s) * (1.f / DM) + RMS_EPS);
    GAS unsigned long long* o8 = (GAS unsigned long long*)orow + lane;
#pragma unroll
    for (int j = 0; j < 8; ++j) { const f32x4 g = ((const GAS f32x4*)gain)[lane + 64 * j]; hv[j] = hv[j] * r * g;
        o8[64 * j] = (unsigned long long)pk2(hv[j].x, hv[j].y) | ((unsigned long long)pk2(hv[j].z, hv[j].w) << 32);
        if (orow8) { int p = 0; p = __builtin_amdgcn_cvt_pk_fp8_f32(hv[j].x, hv[j].y, p, false); p = __builtin_amdgcn_cvt_pk_fp8_f32(hv[j].z, hv[j].w, p, true); ((GAS unsigned*)orow8)[lane + 64 * j] = (unsigned)p; } }
}
__device__ __forceinline__ float log_sigmoid_f(float z) { return fminf(z, 0.f) - 0.6931471805599453f * __builtin_amdgcn_logf(1.f + __builtin_amdgcn_exp2f(-1.4426950408889634f * fabsf(z))); }

struct Frame { LAS unsigned char* lds; unsigned char* ldsg; int tid, lane, wave, G, bx, p0_mask; const float* const* in; float* out; unsigned char* ws; };

__device__ __forceinline__ void p0_prologue(Frame& F) {
    const int gw = F.bx * NWAVES + F.wave, NGW = F.G * NWAVES;
    if (F.p0_mask & 1) {
        LAS float* scr = (LAS float*)(F.lds + F.wave * 16384);
        const TJob jobs[9] = {
            {F.in[I_W_IN], N_IN_ORIG, 2048, N_QK, nullptr, (bf16*)(F.ws + WS_WIN), 0},
            {F.in[I_W_IN], N_IN_ORIG, 2048, N_REST, nullptr, (bf16*)(F.ws + WS_WIN + 16 * MiB), 1},
            {F.in[I_W_FOXUP], 2048, 1024, 2048, nullptr, (bf16*)(F.ws + WS_WFOX), FP8_UP_OUT},
            {F.in[I_W_RETUP], 2048, 1024, 2048, nullptr, (bf16*)(F.ws + (FP8_UP_OUT ? WS_WFOX + 1024 : WS_WRET)), FP8_UP_OUT},
            {F.in[I_W_OUT], 2048, 2048, 2048, nullptr, (bf16*)(F.ws + WS_WOUT), FP8_UP_OUT},
            {F.in[I_W_MQ], 512, 2048, 512, F.in[I_LN_MEM], (bf16*)(F.ws + WS_WMQ), 0},
            {F.in[I_W_MKV], 1024, 2048, 1024, nullptr, (bf16*)(F.ws + WS_WMKV), 0},
            {F.in[I_W_MO], 2048, 512, 2048, nullptr, (bf16*)(F.ws + WS_WMO), 1},
            {F.in[I_W_PQ], 2048, 2048, 2048, F.in[I_LN_FFN], (bf16*)(F.ws + WS_WPQ), 0} };
        int base = 0;
#pragma unroll
        for (int j = 0; j < 9; ++j) {
            const TJob& J = jobs[j]; const int nblk = J.N / 32, items = (J.K / 64) * nblk;
            int first = gw - (base % NGW); if (first < 0) first += NGW;
            for (int r = first; r < items; r += NGW) { const int kb = r / nblk, nb = r % nblk;
                int src_col0 = 0;
                if (j == 0) src_col0 = 3080;
                if (j == 1) src_col0 = (nb * 32 < 3072) ? 0 : 2056;
                if (J.fp8) transpose_item8(J.W, J.ldw, (FP8_UP_OUT && (j == 2 || j == 3)) ? 2048 : J.K, src_col0, (unsigned char*)J.WT, kb, nb, scr, F.lane);
                else transpose_item(J.W, J.ldw, J.K, src_col0, J.gain, J.WT, 0, scr, kb, nb, F.lane); }
            base += items;
        }
    }
    if (F.p0_mask & 1) {
        const float* sk = F.in[I_SUBK]; bf16* o = (bf16*)(F.ws + WS_SUBK);
        for (int i = (F.bx * 512 + F.tid) * 4; i < 16 * 128 * 128; i += F.G * 512 * 4) { const f32x4 v = *(const GAS f32x4*)(sk + i);
            *(GAS unsigned long long*)(o + i) = (unsigned long long)pk2(v.x, v.y) | ((unsigned long long)pk2(v.z, v.w) << 32); }
    }
    __syncthreads();
    if (F.p0_mask & 2) {
        LAS float* wf = (LAS float*)F.lds; const float* w = F.in[I_W_IN];
        for (int k = F.tid; k < 2048; k += 512) { const f32x4 a = *(const GAS f32x4*)(w + (size_t)k * N_IN_ORIG + 3072), b = *(const GAS f32x4*)(w + (size_t)k * N_IN_ORIG + 3076);
            wf[0 * 2048 + k] = a.x; wf[1 * 2048 + k] = a.y; wf[2 * 2048 + k] = a.z; wf[3 * 2048 + k] = a.w; wf[4 * 2048 + k] = b.x; wf[5 * 2048 + k] = b.y; wf[6 * 2048 + k] = b.z; wf[7 * 2048 + k] = b.w; }
    }
    __syncthreads();
    if (F.p0_mask & 2) {
        const LAS float* wf = (const LAS float*)F.lds; const float* bfg = F.in[I_B_FORGET]; float* logf_o = (float*)(F.ws + WS_LOGF);
        for (int m = gw; m < M_TOK; m += NGW) { f32x4 hv[8];
            rms_row_to_bf16(F.in[I_X] + (size_t)m * DM, F.in[I_LN_MIX], (bf16*)(F.ws + WS_XN) + (size_t)m * DM, F.lane, hv, (unsigned char*)F.out + DO_XN8 + (size_t)m * DM);
            float z = 0.f;
#pragma unroll
            for (int q = 0; q < 8; ++q) { float acc = 0.f;
#pragma unroll
                for (int j = 0; j < 8; ++j) { const f32x4 wv = *(const LAS f32x4*)(wf + q * 2048 + 4 * F.lane + 256 * j); acc += (hv[j].x * wv.x + hv[j].y * wv.y) + (hv[j].z * wv.z + hv[j].w * wv.w); }
                acc = wave_sum(acc); z = (F.lane == q) ? acc : z;
                __builtin_amdgcn_sched_barrier(0); }
            if (F.lane < 8) logf_o[(size_t)m * 8 + F.lane] = log_sigmoid_f(z + bfg[F.lane]);
        }
        for (int m = gw; m < NB * 256; m += NGW) { f32x4 hv[8]; rms_row_to_bf16(F.in[I_MEM] + (size_t)m * DM, F.in[I_MEMNORM_G], (bf16*)(F.ws + WS_MN) + (size_t)m * DM, F.lane, hv); }
    }
}
__device__ __forceinline__ void p1_scan(Frame& F) {
    if (F.bx < 64) {
        const int b = F.bx >> 3, h = F.bx & 7; const float* lf = (const float*)(F.ws + WS_LOGF); float* cf = (float*)(F.ws + WS_CUMF) + (size_t)F.bx * SEQ;
        float v[4]; float run = 0.f;
#pragma unroll
        for (int i = 0; i < 4; ++i) { run += lf[(size_t)(b * SEQ + F.tid * 4 + i) * 8 + h]; v[i] = run; }
        float incl = run;
#pragma unroll
        for (int o = 1; o < 64; o <<= 1) { const float t = __shfl_up(incl, o); if (F.lane >= o) incl += t; }
        LAS float* wt = (LAS float*)F.lds;
        if (F.lane == 63) wt[F.wave] = incl;
        __syncthreads();
        float off = incl - run;
        for (int w = 0; w < F.wave; ++w) off += wt[w];
#pragma unroll
        for (int i = 0; i < 4; ++i) cf[F.tid * 4 + i] = v[i] + off;
    }
    __syncthreads();
}
__device__ __forceinline__ void unpack8s(const att::bf16x8 v, float (&f)[8]) {
#pragma unroll
    for (int i = 0; i < 8; ++i) f[i] = __uint_as_float((unsigned)(unsigned short)v[i] << 16);
}
__device__ __forceinline__ att::bf16x8 pack8s(const float (&f)[8]) { v4u w; w.x = pg8::cvt_pk_bf16(f[0], f[1]); w.y = pg8::cvt_pk_bf16(f[2], f[3]); w.z = pg8::cvt_pk_bf16(f[4], f[5]); w.w = pg8::cvt_pk_bf16(f[6], f[7]); return __builtin_bit_cast(att::bf16x8, w); }
__device__ __forceinline__ void p4_attention(Frame& F) {
    char* lds = (char*)F.ldsg;
    const int xcd = F.bx & 7, kk = F.bx >> 3;
    const int bh = (kk >> 2) * 8 + xcd, x = kk & 3, b = bh >> 3, h = bh & 7;
    if (bh >= 64) return;
    const att::bf16* proj = (const att::bf16*)(F.ws + WS_PROJ);
    const size_t rowb = (size_t)b * SEQ;
    if (F.p0_mask & 1) {
        float* tbl = (float*)(lds + att::LDS_BIAS); const float* cf = (const float*)(F.ws + WS_CUMF) + (size_t)bh * SEQ;
        const f32x4 v = *(const f32x4*)(cf + F.tid * 4); *(f32x4*)(tbl + F.tid * 4) = v * (-1.4426950408889634f);
        att::BlockRef r0, r1;
        r0.Q = proj + (rowb + (size_t)x * 256) * PP + C_FQ + h * 128; r0.K = proj + rowb * PP + C_FK + h * 128; r0.V = proj + rowb * PP + C_FV + h * 128; r0.O = (att::bf16*)r0.Q;
        r0.P0 = x * 256; r0.skv = SEQ; r0.lg = 0.f; r0.RG = nullptr; r0.GN = nullptr; r0.O8 = FP8_UP_OUT ? (unsigned char*)F.out + DO_OFOX8 + (rowb + (size_t)x * 256) * 2048 + h * 128 : nullptr;
        r1 = r0; r1.Q = proj + (rowb + (size_t)(7 - x) * 256) * PP + C_FQ + h * 128; r1.O = (att::bf16*)r1.Q; r1.P0 = (7 - x) * 256; r1.O8 = FP8_UP_OUT ? (unsigned char*)F.out + DO_OFOX8 + (rowb + (size_t)(7 - x) * 256) * 2048 + h * 128 : nullptr;
        att::Seam S;
        att::attn_prime<0>(r0, lds, S);
        att::attn_block<0>(r0, r1, lds, S);
        att::attn_block<0>(r1, r1, lds, S);
    }
    if (F.p0_mask & 2) {
        att::BlockRef r0, r1;
        r0.Q = proj + (rowb + (size_t)x * 256) * PP + C_RQ + h * 128; r0.K = proj + rowb * PP + C_RK + h * 128; r0.V = proj + rowb * PP + C_RV + h * 128; r0.O = (att::bf16*)r0.Q;
        r0.P0 = x * 256; r0.skv = SEQ; r0.lg = __builtin_amdgcn_logf(1.f - __builtin_amdgcn_exp2f(-5.f - (float)h))    ; r0.RG = proj + (rowb + (size_t)x * 256) * PP + C_RG + h * 128; r0.GN = F.in[I_RET_G] + h * 128; r0.O8 = FP8_UP_OUT ? (unsigned char*)F.out + DO_ORET8 + (rowb + (size_t)x * 256) * 2048 + h * 128 : nullptr;
        r1 = r0; r1.O8 = FP8_UP_OUT ? (unsigned char*)F.out + DO_ORET8 + (rowb + (size_t)(7 - x) * 256) * 2048 + h * 128 : nullptr; r1.Q = proj + (rowb + (size_t)(7 - x) * 256) * PP + C_RQ + h * 128; r1.O = (att::bf16*)r1.Q; r1.P0 = (7 - x) * 256; r1.RG = proj + (rowb + (size_t)(7 - x) * 256) * PP + C_RG + h * 128;
        att::Seam S;
        att::attn_prime<1>(r0, lds, S);
        att::attn_block<1>(r0, r1, lds, S);
        att::attn_block<1>(r1, r1, lds, S);
    }
}


__device__ __forceinline__ void p8_convert_peer(Frame& F) {
    const int lane = F.lane;
    f32x4 g[8];
#pragma unroll
    for (int j = 0; j < 8; ++j) g[j] = ((const GAS f32x4*)F.in[I_LN_FFN])[lane + 64 * j];
    float* scl = (float*)(F.ws + WS_PSCALE);
    int r0, rend, rstride;
    if (F.bx >= 160) { r0 = (F.bx - 160) * NWAVES + F.wave; rend = 22272; rstride = 768; } else { r0 = 22272 + F.bx * NWAVES + F.wave; rend = 32768; rstride = 1280; }
#pragma unroll 1
    for (int rr = r0; rr < rend; rr += 2 * rstride) {
        f32x4 v[2][8]; float amax[2] = {0.f, 0.f}; bool ok[2], isu[2]; int ri[2];
#pragma unroll
        for (int q = 0; q < 2; ++q) { const int r = rr + q * rstride; ok[q] = r < rend; const int rc = ok[q] ? r : rr; isu[q] = rc < 16384; ri[q] = rc;
            const float* src = (isu[q] ? F.in[I_PEER_U] : F.in[I_PEER_V]) + (size_t)(rc & 16383) * DM;
#pragma unroll
            for (int j = 0; j < 8; ++j) v[q][j] = ((const GAS f32x4*)src)[lane + 64 * j]; }
#pragma unroll
        for (int q = 0; q < 2; ++q) {
#pragma unroll
            for (int j = 0; j < 8; ++j) { if (isu[q]) v[q][j] = v[q][j] * g[j]; amax[q] = fmaxf(amax[q], fmaxf(fmaxf(fabsf(v[q][j].x), fabsf(v[q][j].y)), fmaxf(fabsf(v[q][j].z), fabsf(v[q][j].w)))); }
#pragma unroll
            for (int o = 1; o < 64; o <<= 1) amax[q] = fmaxf(amax[q], __shfl_xor(amax[q], o));
            const float sc = amax[q] > 0.f ? amax[q] * (1.f / 448.f) : 1.f, inv = 1.f / sc;
            if (ok[q]) { if (lane == 0) scl[ri[q]] = sc;
                GAS unsigned* o4 = (GAS unsigned*)(F.ws + (isu[q] ? WS_PU : WS_PV) + (size_t)(ri[q] & 16383) * DM) + lane;
#pragma unroll
                for (int j = 0; j < 8; ++j) { int p = 0; p = __builtin_amdgcn_cvt_pk_fp8_f32(v[q][j].x * inv, v[q][j].y * inv, p, false); p = __builtin_amdgcn_cvt_pk_fp8_f32(v[q][j].z * inv, v[q][j].w * inv, p, true); o4[64 * j] = (unsigned)p; } } }
    }
}
__device__ __forceinline__ void norm_own_tile(Frame& F, bf16* base, int ld, int row0, int col0, const float* gain, float mul) {
    asm volatile("s_waitcnt vmcnt(0)" ::: "memory"); __syncthreads();
    const int lane = F.lane, rsel = lane >> 5, head = (lane >> 4) & 1, sub = lane & 15;
    float gv[8];
#pragma unroll
    for (int i = 0; i < 8; ++i) gv[i] = gain[sub * 8 + i] * mul;
#pragma unroll 1
    for (int r4 = 0; r4 < 16; r4 += 4) {
        att::bf16x8 v[4]; bf16* p[4];
#pragma unroll
        for (int q = 0; q < 4; ++q) { p[q] = base + (size_t)(row0 + F.wave * 32 + (r4 + q) * 2 + rsel) * ld + col0 + head * 128 + sub * 8; v[q] = *(const att::bf16x8*)p[q]; }
#pragma unroll
        for (int q = 0; q < 4; ++q) { float a[8]; unpack8s(v[q], a); float s = 0.f;
#pragma unroll
            for (int i = 0; i < 8; ++i) s += a[i] * a[i];
            s += __shfl_xor(s, 1); s += __shfl_xor(s, 2); s += __shfl_xor(s, 4); s += __shfl_xor(s, 8);
            const float rr = 1.f / sqrtf(s * (1.f / 128.f) + RMS_EPS);
#pragma unroll
            for (int i = 0; i < 8; ++i) a[i] *= rr * gv[i];
            *(att::bf16x8*)p[q] = pack8s(a); }
    }
}
__device__ __forceinline__ void fix_own_tile(Frame& F, bf16* proj, int pm, int pn, int kind) {
    const int lane = F.lane;
    if (kind < 2) {
        const int rsel = lane >> 5, head = (lane >> 4) & 1, sub = lane & 15; float gv[8];
#pragma unroll
        for (int i = 0; i < 8; ++i) gv[i] = kind == 0 ? F.in[I_FOXQ_G][sub * 8 + i] * QK_C2 : F.in[I_FOXK_G][sub * 8 + i];
#pragma unroll 1
        for (int r4 = 0; r4 < 16; r4 += 4) { att::bf16x8 v[4]; bf16* p[4];
#pragma unroll
            for (int q = 0; q < 4; ++q) { p[q] = proj + (size_t)(pm * 256 + F.wave * 32 + (r4 + q) * 2 + rsel) * PP + pn * 256 + head * 128 + sub * 8; v[q] = *(const att::bf16x8*)p[q]; }
#pragma unroll
            for (int q = 0; q < 4; ++q) { float a[8]; unpack8s(v[q], a); float s = 0.f;
#pragma unroll
                for (int i = 0; i < 8; ++i) s += a[i] * a[i];
                s += __shfl_xor(s, 1); s += __shfl_xor(s, 2); s += __shfl_xor(s, 4); s += __shfl_xor(s, 8);
                const float rr = 1.f / sqrtf(s * (1.f / 128.f) + RMS_EPS);
#pragma unroll
                for (int i = 0; i < 8; ++i) a[i] *= rr * gv[i];
                *(att::bf16x8*)p[q] = pack8s(a); } }
    } else {
        const int rsel = lane >> 4, head = (lane >> 3) & 1, sub = lane & 7; const float sc = kind == 3 ? 0.08838834764831845f : 1.f; float fr[8];
        const float lgh = __builtin_amdgcn_logf(1.f - __builtin_amdgcn_exp2f(-5.f - (float)((pn & 3) * 2 + head)));
#pragma unroll
        for (int i = 0; i < 8; ++i) fr[i] = __builtin_amdgcn_exp2f(-13.287712379549449f * (float)(sub * 8 + i) * (1.f / 64.f)) * 0.15915494309189535f;
#pragma unroll 1
        for (int r4 = 0; r4 < 8; r4 += 4) { att::bf16x8 va[4], vb[4]; bf16* p[4];
#pragma unroll
            for (int q = 0; q < 4; ++q) { p[q] = proj + (size_t)(pm * 256 + F.wave * 32 + (r4 + q) * 4 + rsel) * PP + pn * 256 + head * 128 + sub * 8; va[q] = *(const att::bf16x8*)p[q]; vb[q] = *(const att::bf16x8*)(p[q] + 64); }
#pragma unroll
            for (int q = 0; q < 4; ++q) { const int rowi = pm * 256 + F.wave * 32 + (r4 + q) * 4 + rsel; const float pos = (float)(rowi & (SEQ - 1)); float a[8], b[8], oa[8], ob[8]; unpack8s(va[q], a); unpack8s(vb[q], b);
                const float dsc = sc * __builtin_amdgcn_exp2f((kind == 2 ? lgh : -lgh) * (float)(rowi & 63));
#pragma unroll
                for (int i = 0; i < 8; ++i) { float rev = pos * fr[i]; rev -= rintf(rev); const float sn = __builtin_amdgcn_sinf(rev), cs = __builtin_amdgcn_cosf(rev);
                    oa[i] = (a[i] * cs - b[i] * sn) * dsc; ob[i] = (a[i] * sn + b[i] * cs) * dsc; }
                *(att::bf16x8*)p[q] = pack8s(oa); *(att::bf16x8*)(p[q] + 64) = pack8s(ob); } }
    }
}
__device__ __forceinline__ void p10_mem_attention(Frame& F) {
    char* lds = (char*)F.ldsg;
    const int b = F.bx >> 5, h = (F.bx >> 3) & 3, qb = F.bx & 7;
    att::BlockRef r0;
    const size_t qoff = ((size_t)b * SEQ + (size_t)qb * 256) * 512 + h * 128;
    r0.Q = (const att::bf16*)(F.ws + WS_QM) + qoff; r0.O = (att::bf16*)(F.ws + WS_OMEM) + qoff;
    r0.K = (const att::bf16*)(F.ws + WS_KVM) + (size_t)(b * 256) * 1024 + h * 128; r0.V = r0.K + 512;
    r0.P0 = 1 << 20; r0.skv = 256; r0.lg = 0.f; r0.RG = nullptr; r0.GN = nullptr; r0.O8 = F.ws + WS_OMEM + ((size_t)b * SEQ + (size_t)qb * 256) * 512 + h * 128;
    att::Seam S;
    att::attn_prime<2>(r0, lds, S);
    att::attn_block<2>(r0, r0, lds, S);
}
#define TK_INS(L, v) do { _Pragma("unroll") for (int i_ = 15; i_ >= 1; --i_) L[i_] = __builtin_amdgcn_fmed3f(L[i_ - 1], L[i_], (v)); L[0] = fmaxf(L[0], (v)); } while (0)
__device__ __forceinline__ void p13_topk_unit(Frame& F, int pm, int h) {
    const int lane = F.lane, r32 = lane & 31, hi = lane >> 5, wave = F.wave;
    const att::bf16* qp = (const att::bf16*)(F.ws + WS_QP); const att::bf16* subk = (const att::bf16*)(F.ws + WS_SUBK);
    int* idx_o = (int*)(F.ws + WS_IDX); float* gate_o = (float*)(F.ws + WS_GATE);
    LAS unsigned* kb = (LAS unsigned*)(F.lds + 65536 + (wave * 32 + (lane & 31)) * 32);
    const int tok = pm * 256 + wave * 32 + r32;
    const unsigned q_lane = (unsigned)((tok * DM + hi * 8) * 2), k_lane = (unsigned)((r32 * 128 + hi * 8) * 2);
    att::bf16x8 qf[8];
#define TK_STAGE(p_) do { const int hp_ = h * 2 + (p_); const unsigned char* qb_ = (const unsigned char*)qp + (size_t)hp_ * 256; \
        const unsigned char* kb_ = (const unsigned char*)subk + (size_t)hp_ * 32768 + (size_t)(wave >> 1) * 8192 + (size_t)(wave & 1) * 128; \
        _Pragma("unroll") for (int d0 = 0; d0 < 8; ++d0) qf[d0] = *(const GAS att::bf16x8*)(qb_ + d0 * 32 + q_lane); \
        _Pragma("unroll") for (int f_ = 0; f_ < 4; ++f_) \
            __builtin_amdgcn_global_load_lds((const GAS unsigned*)(kb_ + f_ * 32 + k_lane), (LAS unsigned*)(F.lds + (p_) * 32768 + (wave * 4 + f_) * 1024), 16, 0, 0); } while (0)
    float L0[16], L1[16];
#pragma unroll
    for (int i = 0; i < 16; ++i) { L0[i] = 0.f; L1[i] = 0.f; }
    TK_STAGE(0);
#pragma unroll 1
    for (int p = 0; p < 2; ++p) {
        asm volatile("s_waitcnt vmcnt(0)" ::: "memory"); __syncthreads();
        att::f32x16 acc[4];
        const LAS unsigned char* img = F.lds + p * 32768;
#pragma unroll
        for (int kt = 0; kt < 4; ++kt) { acc[kt] = att::f32x16{};
#pragma unroll
            for (int d0 = 0; d0 < 8; ++d0) acc[kt] = __builtin_amdgcn_mfma_f32_32x32x16_bf16(*(const LAS att::bf16x8*)(img + (kt * 8 + d0) * 1024 + lane * 16), qf[d0], acc[kt], 0, 0, 0); }
        if (p == 0) TK_STAGE(1);
        float L[16];
#pragma unroll
        for (int i = 0; i < 16; ++i) L[i] = -3.0e38f;
#pragma unroll
        for (int kt = 0; kt < 4; ++kt)
#pragma unroll
            for (int r = 0; r < 16; ++r) { const unsigned key = (unsigned)(kt * 32 + (r & 3) + 8 * (r >> 2)) + 4u * (unsigned)hi;
                const float v = __uint_as_float((__float_as_uint(acc[kt][r]) & ~0x7Fu) | key); TK_INS(L, v); }
        float P[16];
#pragma unroll
        for (int i = 0; i < 16; ++i) P[i] = __shfl_xor(L[i], 32);
#pragma unroll
        for (int i = 0; i < 16; ++i) TK_INS(L, P[i]);
#pragma unroll
        for (int i = 0; i < 16; ++i) { L0[i] = p == 0 ? L[i] : L0[i]; L1[i] = p == 0 ? L1[i] : L[i]; }
    }
#undef TK_STAGE
#pragma unroll
        for (int w = 0; w < 4; ++w) {
            kb[w] = (__float_as_uint(L0[4 * w]) & 0x7Fu) | ((__float_as_uint(L0[4 * w + 1]) & 0x7Fu) << 8) | ((__float_as_uint(L0[4 * w + 2]) & 0x7Fu) << 16) | ((__float_as_uint(L0[4 * w + 3]) & 0x7Fu) << 24);
            kb[4 + w] = (__float_as_uint(L1[4 * w]) & 0x7Fu) | ((__float_as_uint(L1[4 * w + 1]) & 0x7Fu) << 8) | ((__float_as_uint(L1[4 * w + 2]) & 0x7Fu) << 16) | ((__float_as_uint(L1[4 * w + 3]) & 0x7Fu) << 24); }
        float T[16];
#pragma unroll
        for (int i = 0; i < 16; ++i) T[i] = -3.0e38f;
#pragma unroll
        for (int a = 0; a < 16; ++a) { const float sa = __uint_as_float(__float_as_uint(L0[a]) & ~0x7Fu);
#pragma unroll
            for (int b2 = 0; b2 < 16; ++b2) if ((a + 1) * (b2 + 1) <= 16) { const float s = sa + __uint_as_float(__float_as_uint(L1[b2]) & ~0x7Fu);
                const float v = __uint_as_float((__float_as_uint(s) & ~0xFFu) | (unsigned)(a * 16 + b2)); TK_INS(T, v); } }
        LDS_WAIT();
        const LAS unsigned char* kbb = (const LAS unsigned char*)kb;
        float sc[16]; int ei[16]; float mx = __uint_as_float(__float_as_uint(T[0]) & ~0xFFu), sum = 0.f;
#pragma unroll
        for (int k = 0; k < 16; ++k) { const unsigned bits = __float_as_uint(T[k]); const unsigned id = bits & 0xFFu;
            const int i1 = kbb[id >> 4], i2 = kbb[16 + (id & 15u)]; ei[k] = i1 * 128 + i2;
            sc[k] = __builtin_amdgcn_exp2f((__uint_as_float(bits & ~0xFFu) - mx) * 1.4426950408889634f); sum += sc[k]; }
        const float inv = 1.f / sum;
        if (hi == 0) {
#pragma unroll
            for (int w = 0; w < 4; ++w) {
                *(GAS v4u*)(idx_o + (size_t)tok * 128 + h * 16 + 4 * w) = (v4u){(unsigned)ei[4 * w], (unsigned)ei[4 * w + 1], (unsigned)ei[4 * w + 2], (unsigned)ei[4 * w + 3]};
                *(GAS f32x4*)(gate_o + (size_t)tok * 128 + h * 16 + 4 * w) = (f32x4){sc[4 * w] * inv, sc[4 * w + 1] * inv, sc[4 * w + 2] * inv, sc[4 * w + 3] * inv}; } }
        LDS_WAIT(); asm volatile("" ::: "memory");
}


typedef float f32x2 __attribute__((ext_vector_type(2)));
__device__ __forceinline__ float gelu_tanh(float x) {
    const float y = 0.7978845608028654f * (x + 0.044715f * x * x * x);
    const float t = 1.f - 2.f * __builtin_amdgcn_rcpf(1.f + __builtin_amdgcn_exp2f(2.885390081777927f * y));
    return 0.5f * x * (1.f + t);
}
__device__ __forceinline__ float dot2bf(unsigned a, unsigned b, float acc) { asm("v_dot2c_f32_bf16 %0, %1, %2" : "+v"(acc) : "v"(a), "v"(b)); return acc; }
#ifndef EX_QCH
#define EX_QCH 2
#endif
#ifndef EX_TOK8
#define EX_TOK8 1
#endif
struct RowBuf { v4u r[8]; float su, sv; };
#define DPP_MOV(v, ctrl) __builtin_bit_cast(float, __builtin_amdgcn_update_dpp(0, __builtin_bit_cast(int, (v)), (ctrl), 0xF, 0xF, false))
#define ROW_ROR(v, n) __builtin_bit_cast(float, __builtin_amdgcn_update_dpp(0, __builtin_bit_cast(int, (v)), 0x120 + (n), 0xF, 0xF, false))
__device__ __forceinline__ void p14_experts_sorted(Frame& F) {
    const int lane = F.lane, wave = F.wave, q = lane >> 4, l16 = lane & 15;
    const bf16* xb = (const bf16*)(F.ws + WS_XB2); const unsigned char* pu = F.ws + WS_PU; const unsigned char* pv = F.ws + WS_PV;
    const int* idx = (const int*)(F.ws + WS_IDX); const float* gate = (const float*)(F.ws + WS_GATE); const float* rowss = (const float*)(F.ws + WS_ROWSS2);
    const float* su = (const float*)(F.ws + WS_PSCALE); const float* sv = su + 16384;
    LAS unsigned* list = (LAS unsigned*)(F.lds + wave * 8192) + q * 128;
    LAS float* wl = (LAS float*)(F.lds + wave * 8192 + 2048) + q * 128;
    LAS float* gt = (LAS float*)(F.lds + wave * 8192 + 4096) + q * 128;
    LAS unsigned* cnt = (LAS unsigned*)(F.lds + wave * 8192 + 6144) + q * 64;
    constexpr int NSTEP = 128;
    for (int grp = 0; grp < 2; ++grp) {
        const int tok = (F.bx * NWAVES + wave) * 8 + grp * 4 + q;
        const float rs = 1.f / sqrtf(rowss[tok] * (1.f / DM) + RMS_EPS);
#pragma unroll
        for (int i = 0; i < 4; ++i) cnt[l16 + 16 * i] = 0u;
        unsigned ent[8], pos[8];
#pragma unroll
        for (int j = 0; j < 8; ++j) { const int k = l16 + 16 * j; const unsigned e = (unsigned)idx[(size_t)tok * 128 + k]; gt[k] = gate[(size_t)tok * 128 + k]; ent[j] = e | ((unsigned)k << 16); }
        LDS_WAIT(); asm volatile("" ::: "memory");
#pragma unroll
        for (int j = 0; j < 8; ++j) pos[j] = __hip_atomic_fetch_add(cnt + ((ent[j] & 0x3FFFu) >> 8), 1u, __ATOMIC_RELAXED, __HIP_MEMORY_SCOPE_WORKGROUP);
        LDS_WAIT(); asm volatile("" ::: "memory");
        { unsigned c[4], inc[4], run = 0u;
#pragma unroll
          for (int i = 0; i < 4; ++i) { c[i] = cnt[l16 + 16 * i]; inc[i] = c[i];
#pragma unroll
              for (int o = 1; o < 16; o <<= 1) { const unsigned tt = __shfl_up(inc[i], o, 16); if (l16 >= o) inc[i] += tt; } }
          LDS_WAIT(); asm volatile("" ::: "memory");
#pragma unroll
          for (int i = 0; i < 4; ++i) { cnt[l16 + 16 * i] = run + inc[i] - c[i]; run += __shfl(inc[i], 15, 16); } }
        LDS_WAIT(); asm volatile("" ::: "memory");
#pragma unroll
        for (int j = 0; j < 8; ++j) list[cnt[(ent[j] & 0x3FFFu) >> 8] + pos[j]] = ent[j];
        LDS_WAIT(); asm volatile("" ::: "memory");
        const unsigned lane_off = (unsigned)l16 * 16u;
        constexpr int QCH = EX_QCH, NSW = 8 / QCH;
#define EX_LD(B, s_, TABQ) do { const int ss_ = (s_) < NSTEP ? (s_) : NSTEP - 1; const unsigned off_ = ((list[ss_] & 0x3FFFu) << 11) + lane_off;     \
            _Pragma("unroll") for (int c_ = 0; c_ < QCH; ++c_) B[c_] = *(const GAS v4u*)((TABQ) + off_ + c_ * 256); } while (0)
#ifndef EX_RINGK
#define EX_RINGK 8
#endif
#if EX_RINGK == 4
#define EX_RING(TABQ, STEPFN, ENDFN) do { v4u H0[QCH], H1[QCH], H2[QCH], H3[QCH]; \
            EX_LD(H0, 0, TABQ); EX_LD(H1, 1, TABQ); EX_LD(H2, 2, TABQ); \
            _Pragma("unroll 1") for (int s = 0; s < NSTEP; s += 8) { \
                EX_LD(H3, s + 3, TABQ); STEPFN(H0, s + 0, 0); \
                EX_LD(H0, s + 4, TABQ); STEPFN(H1, s + 1, 1); \
                EX_LD(H1, s + 5, TABQ); STEPFN(H2, s + 2, 2); \
                EX_LD(H2, s + 6, TABQ); STEPFN(H3, s + 3, 3); \
                EX_LD(H3, s + 7, TABQ); STEPFN(H0, s + 4, 4); \
                EX_LD(H0, s + 8, TABQ); STEPFN(H1, s + 5, 5); \
                EX_LD(H1, s + 9, TABQ); STEPFN(H2, s + 6, 6); \
                EX_LD(H2, s + 10, TABQ); STEPFN(H3, s + 7, 7); \
                ENDFN(s); } } while (0)
#elif EX_RINGK == 2
#define EX_RING(TABQ, STEPFN, ENDFN) do { v4u H0[QCH], H1[QCH]; \
            EX_LD(H0, 0, TABQ); \
            _Pragma("unroll 1") for (int s = 0; s < NSTEP; s += 8) { \
                EX_LD(H1, s + 1, TABQ); STEPFN(H0, s + 0, 0); \
                EX_LD(H0, s + 2, TABQ); STEPFN(H1, s + 1, 1); \
                EX_LD(H1, s + 3, TABQ); STEPFN(H0, s + 2, 2); \
                EX_LD(H0, s + 4, TABQ); STEPFN(H1, s + 3, 3); \
                EX_LD(H1, s + 5, TABQ); STEPFN(H0, s + 4, 4); \
                EX_LD(H0, s + 6, TABQ); STEPFN(H1, s + 5, 5); \
                EX_LD(H1, s + 7, TABQ); STEPFN(H0, s + 6, 6); \
                EX_LD(H0, s + 8, TABQ); STEPFN(H1, s + 7, 7); \
                ENDFN(s); } } while (0)
#else
#define EX_RING(TABQ, STEPFN, ENDFN) do { v4u H0[QCH], H1[QCH], H2[QCH], H3[QCH], H4[QCH], H5[QCH], H6[QCH], H7[QCH]; \
            EX_LD(H0, 0, TABQ); EX_LD(H1, 1, TABQ); EX_LD(H2, 2, TABQ); EX_LD(H3, 3, TABQ); EX_LD(H4, 4, TABQ); EX_LD(H5, 5, TABQ); EX_LD(H6, 6, TABQ); \
            _Pragma("unroll 1") for (int s = 0; s < NSTEP; s += 8) { \
                EX_LD(H7, s + 7, TABQ); STEPFN(H0, s + 0, 0); \
                EX_LD(H0, s + 8, TABQ); STEPFN(H1, s + 1, 1); \
                EX_LD(H1, s + 9, TABQ); STEPFN(H2, s + 2, 2); \
                EX_LD(H2, s + 10, TABQ); STEPFN(H3, s + 3, 3); \
                EX_LD(H3, s + 11, TABQ); STEPFN(H4, s + 4, 4); \
                EX_LD(H4, s + 12, TABQ); STEPFN(H5, s + 5, 5); \
                EX_LD(H5, s + 13, TABQ); STEPFN(H6, s + 6, 6); \
                EX_LD(H6, s + 14, TABQ); STEPFN(H7, s + 7, 7); \
                ENDFN(s); } } while (0)
#endif
#pragma unroll 1
        for (int j = 0; j < NSW; ++j) {
            f32x2 xf[QCH][8];
#pragma unroll
            for (int c = 0; c < QCH; ++c) { const v4u a = *(const GAS v4u*)(xb + (size_t)tok * DM + j * (QCH * 256) + c * 256 + l16 * 16), b = *(const GAS v4u*)(xb + (size_t)tok * DM + j * (QCH * 256) + c * 256 + l16 * 16 + 8);
                const unsigned xd[8] = {a.x, a.y, a.z, a.w, b.x, b.y, b.z, b.w};
#pragma unroll
                for (int i = 0; i < 8; ++i) xf[c][i] = (f32x2){__uint_as_float(xd[i] << 16), __uint_as_float(xd[i] & 0xffff0000u)}; }
            const unsigned char* tabq = pu + j * (QCH * 256);
#define EX_U(B, s_, k_) do { f32x2 d2_ = {0.f, 0.f}; \
            _Pragma("unroll") for (int c_ = 0; c_ < QCH; ++c_) { const unsigned ud[4] = {B[c_].x, B[c_].y, B[c_].z, B[c_].w}; \
                _Pragma("unroll") for (int w_ = 0; w_ < 4; ++w_) { d2_ = __builtin_amdgcn_cvt_pk_f32_fp8((int)ud[w_], false) * xf[c_][2 * w_] + d2_; d2_ = __builtin_amdgcn_cvt_pk_f32_fp8((int)ud[w_], true) * xf[c_][2 * w_ + 1] + d2_; } } \
            dd[k_] = d2_.x + d2_.y; } while (0)
#define EX_UEND(s_) do { float r4_[4], r2_[2], r1_; \
            { const bool up = (l16 & 8) != 0; _Pragma("unroll") for (int i_ = 0; i_ < 4; ++i_) { const float mine = up ? dd[i_ + 4] : dd[i_], theirs = up ? dd[i_] : dd[i_ + 4]; r4_[i_] = mine + ROW_ROR(theirs, 8); } } \
            { const bool up = (l16 & 4) != 0; _Pragma("unroll") for (int i_ = 0; i_ < 2; ++i_) { const float mine = up ? r4_[i_ + 2] : r4_[i_], theirs = up ? r4_[i_] : r4_[i_ + 2]; \
                const float fromhi = DPP_MOV(theirs, 0x104), fromlo = DPP_MOV(theirs, 0x114); r2_[i_] = mine + (up ? fromlo : fromhi); } }     \
            { const bool up = (l16 & 2) != 0; const float mine = up ? r2_[1] : r2_[0], theirs = up ? r2_[0] : r2_[1]; r1_ = mine + DPP_MOV(theirs, 0x4E); }     \
            r1_ += DPP_MOV(r1_, 0xB1);                                                                                                                  \
            if ((l16 & 1) == 0) { const int si_ = (s_) + (l16 >> 1); wl[si_] = (j == 0 ? 0.f : wl[si_]) + r1_; } } while (0)
            float dd[8];
            EX_RING(tabq, EX_U, EX_UEND);
#undef EX_U
#undef EX_UEND
            LDS_WAIT(); asm volatile("" ::: "memory");
        }
#pragma unroll
        for (int i = 0; i < 8; ++i) { const int s = l16 + 16 * i; const unsigned me = list[s]; const unsigned e = me & 0x3FFFu;
            wl[s] = gt[(me >> 16) & 127u] * gelu_tanh(wl[s] * su[e] * rs) * sv[e]; }
        LDS_WAIT(); asm volatile("" ::: "memory");
#pragma unroll 1
        for (int j = 0; j < NSW; ++j) {
            f32x2 acc[QCH][8];
#pragma unroll
            for (int c = 0; c < QCH; ++c)
#pragma unroll
                for (int e = 0; e < 8; ++e) acc[c][e] = (f32x2){0.f, 0.f};
            const unsigned char* tabq = pv + j * (QCH * 256);
#define EX_NOEND(s_) do { } while (0)
#define EX_V(B, s_, k_) do { const float w_ = wl[s_]; const f32x2 w2 = {w_, w_}; \
            _Pragma("unroll") for (int c_ = 0; c_ < QCH; ++c_) { const unsigned ud[4] = {B[c_].x, B[c_].y, B[c_].z, B[c_].w}; \
                _Pragma("unroll") for (int w4_ = 0; w4_ < 4; ++w4_) { acc[c_][2 * w4_] = __builtin_amdgcn_cvt_pk_f32_fp8((int)ud[w4_], false) * w2 + acc[c_][2 * w4_]; acc[c_][2 * w4_ + 1] = __builtin_amdgcn_cvt_pk_f32_fp8((int)ud[w4_], true) * w2 + acc[c_][2 * w4_ + 1]; } } } while (0)
            EX_RING(tabq, EX_V, EX_NOEND);
#undef EX_V
#undef EX_NOEND
            float* orow = F.out + (size_t)tok * DM + j * (QCH * 256) + l16 * 16; const bf16* xrow = xb + (size_t)tok * DM + j * (QCH * 256) + l16 * 16;
#pragma unroll
            for (int c = 0; c < QCH; ++c) { const v4u x0 = *(const GAS v4u*)(xrow + c * 256), x1 = *(const GAS v4u*)(xrow + c * 256 + 8); const unsigned xd[8] = {x0.x, x0.y, x0.z, x0.w, x1.x, x1.y, x1.z, x1.w};
#pragma unroll
                for (int qq = 0; qq < 4; ++qq)
                    *(GAS f32x4*)(orow + c * 256 + 4 * qq) = (f32x4){__uint_as_float(xd[2 * qq] << 16) + acc[c][2 * qq].x, __uint_as_float(xd[2 * qq] & 0xffff0000u) + acc[c][2 * qq].y,
                                                                    __uint_as_float(xd[2 * qq + 1] << 16) + acc[c][2 * qq + 1].x, __uint_as_float(xd[2 * qq + 1] & 0xffff0000u) + acc[c][2 * qq + 1].y}; }
        }
#undef EX_LD
#undef EX_RING
        LDS_WAIT(); asm volatile("" ::: "memory");
    }
}

__device__ __forceinline__ void p14_experts_8(Frame& F) {
    const int lane = F.lane, wave = F.wave, q = lane >> 3, l16 = lane & 7;
    const bf16* xb = (const bf16*)(F.ws + WS_XB2); const unsigned char* pu = F.ws + WS_PU; const unsigned char* pv = F.ws + WS_PV;
    const int* idx = (const int*)(F.ws + WS_IDX); const float* gate = (const float*)(F.ws + WS_GATE); const float* rowss = (const float*)(F.ws + WS_ROWSS2);
    const float* su = (const float*)(F.ws + WS_PSCALE); const float* sv = su + 16384;
    LAS unsigned* list = (LAS unsigned*)(F.lds + wave * 14336) + q * 128;
    LAS float* wl = (LAS float*)(F.lds + wave * 14336 + 4096) + q * 128;
    LAS float* gt = (LAS float*)(F.lds + wave * 14336 + 8192) + q * 128;
    LAS unsigned* cnt = (LAS unsigned*)(F.lds + wave * 14336 + 12288) + q * 64;
    constexpr int NSTEP = 128;
    {
        const int tok = (F.bx * NWAVES + wave) * 8 + q;
        const float rs = 1.f / sqrtf(rowss[tok] * (1.f / DM) + RMS_EPS);
#pragma unroll
        for (int i = 0; i < 8; ++i) cnt[l16 + 8 * i] = 0u;
        unsigned ent[16], pos[16];
#pragma unroll
        for (int j = 0; j < 16; ++j) { const int k = l16 + 8 * j; const unsigned e = (unsigned)idx[(size_t)tok * 128 + k]; gt[k] = gate[(size_t)tok * 128 + k]; ent[j] = e | ((unsigned)k << 16); }
        LDS_WAIT(); asm volatile("" ::: "memory");
#pragma unroll
        for (int j = 0; j < 16; ++j) pos[j] = __hip_atomic_fetch_add(cnt + ((ent[j] & 0x3FFFu) >> 8), 1u, __ATOMIC_RELAXED, __HIP_MEMORY_SCOPE_WORKGROUP);
        LDS_WAIT(); asm volatile("" ::: "memory");
        { unsigned c[8], inc[8], run = 0u;
#pragma unroll
          for (int i = 0; i < 8; ++i) { c[i] = cnt[l16 + 8 * i]; inc[i] = c[i];
#pragma unroll
              for (int o = 1; o < 8; o <<= 1) { const unsigned tt = __shfl_up(inc[i], o, 8); if (l16 >= o) inc[i] += tt; } }
          LDS_WAIT(); asm volatile("" ::: "memory");
#pragma unroll
          for (int i = 0; i < 8; ++i) { cnt[l16 + 8 * i] = run + inc[i] - c[i]; run += __shfl(inc[i], 7, 8); } }
        LDS_WAIT(); asm volatile("" ::: "memory");
#pragma unroll
        for (int j = 0; j < 16; ++j) list[cnt[(ent[j] & 0x3FFFu) >> 8] + pos[j]] = ent[j];
        LDS_WAIT(); asm volatile("" ::: "memory");
        const unsigned lane_off = (unsigned)l16 * 16u;
        constexpr int QCH = EX_QCH, NSW = 16 / QCH;
#define EX_LD(B, s_, TABQ) do { const int ss_ = (s_) < NSTEP ? (s_) : NSTEP - 1; const unsigned off_ = ((list[ss_] & 0x3FFFu) << 11) + lane_off;     \
            _Pragma("unroll") for (int c_ = 0; c_ < QCH; ++c_) B[c_] = *(const GAS v4u*)((TABQ) + off_ + c_ * 128); } while (0)
#ifndef EX_RINGK
#define EX_RINGK 8
#endif
#if EX_RINGK == 4
#define EX_RING(TABQ, STEPFN, ENDFN) do { v4u H0[QCH], H1[QCH], H2[QCH], H3[QCH]; \
            EX_LD(H0, 0, TABQ); EX_LD(H1, 1, TABQ); EX_LD(H2, 2, TABQ); \
            _Pragma("unroll 1") for (int s = 0; s < NSTEP; s += 8) { \
                EX_LD(H3, s + 3, TABQ); STEPFN(H0, s + 0, 0); \
                EX_LD(H0, s + 4, TABQ); STEPFN(H1, s + 1, 1); \
                EX_LD(H1, s + 5, TABQ); STEPFN(H2, s + 2, 2); \
                EX_LD(H2, s + 6, TABQ); STEPFN(H3, s + 3, 3); \
                EX_LD(H3, s + 7, TABQ); STEPFN(H0, s + 4, 4); \
                EX_LD(H0, s + 8, TABQ); STEPFN(H1, s + 5, 5); \
                EX_LD(H1, s + 9, TABQ); STEPFN(H2, s + 6, 6); \
                EX_LD(H2, s + 10, TABQ); STEPFN(H3, s + 7, 7); \
                ENDFN(s); } } while (0)
#elif EX_RINGK == 2
#define EX_RING(TABQ, STEPFN, ENDFN) do { v4u H0[QCH], H1[QCH]; \
            EX_LD(H0, 0, TABQ); \
            _Pragma("unroll 1") for (int s = 0; s < NSTEP; s += 8) { \
                EX_LD(H1, s + 1, TABQ); STEPFN(H0, s + 0, 0); \
                EX_LD(H0, s + 2, TABQ); STEPFN(H1, s + 1, 1); \
                EX_LD(H1, s + 3, TABQ); STEPFN(H0, s + 2, 2); \
                EX_LD(H0, s + 4, TABQ); STEPFN(H1, s + 3, 3); \
                EX_LD(H1, s + 5, TABQ); STEPFN(H0, s + 4, 4); \
                EX_LD(H0, s + 6, TABQ); STEPFN(H1, s + 5, 5); \
                EX_LD(H1, s + 7, TABQ); STEPFN(H0, s + 6, 6); \
                EX_LD(H0, s + 8, TABQ); STEPFN(H1, s + 7, 7); \
                ENDFN(s); } } while (0)
#else
#define EX_RING(TABQ, STEPFN, ENDFN) do { v4u H0[QCH], H1[QCH], H2[QCH], H3[QCH], H4[QCH], H5[QCH], H6[QCH], H7[QCH]; \
            EX_LD(H0, 0, TABQ); EX_LD(H1, 1, TABQ); EX_LD(H2, 2, TABQ); EX_LD(H3, 3, TABQ); EX_LD(H4, 4, TABQ); EX_LD(H5, 5, TABQ); EX_LD(H6, 6, TABQ); \
            _Pragma("unroll 1") for (int s = 0; s < NSTEP; s += 8) { \
                EX_LD(H7, s + 7, TABQ); STEPFN(H0, s + 0, 0); \
                EX_LD(H0, s + 8, TABQ); STEPFN(H1, s + 1, 1); \
                EX_LD(H1, s + 9, TABQ); STEPFN(H2, s + 2, 2); \
                EX_LD(H2, s + 10, TABQ); STEPFN(H3, s + 3, 3); \
                EX_LD(H3, s + 11, TABQ); STEPFN(H4, s + 4, 4); \
                EX_LD(H4, s + 12, TABQ); STEPFN(H5, s + 5, 5); \
                EX_LD(H5, s + 13, TABQ); STEPFN(H6, s + 6, 6); \
                EX_LD(H6, s + 14, TABQ); STEPFN(H7, s + 7, 7); \
                ENDFN(s); } } while (0)
#endif
#pragma unroll 1
        for (int j = 0; j < NSW; ++j) {
            f32x2 xf[QCH][8];
#pragma unroll
            for (int c = 0; c < QCH; ++c) { const v4u a = *(const GAS v4u*)(xb + (size_t)tok * DM + j * (QCH * 128) + c * 128 + l16 * 16), b = *(const GAS v4u*)(xb + (size_t)tok * DM + j * (QCH * 128) + c * 128 + l16 * 16 + 8);
                const unsigned xd[8] = {a.x, a.y, a.z, a.w, b.x, b.y, b.z, b.w};
#pragma unroll
                for (int i = 0; i < 8; ++i) xf[c][i] = (f32x2){__uint_as_float(xd[i] << 16), __uint_as_float(xd[i] & 0xffff0000u)}; }
            const unsigned char* tabq = pu + j * (QCH * 128);
#define EX_U(B, s_, k_) do { f32x2 d2_ = {0.f, 0.f}; \
            _Pragma("unroll") for (int c_ = 0; c_ < QCH; ++c_) { const unsigned ud[4] = {B[c_].x, B[c_].y, B[c_].z, B[c_].w}; \
                _Pragma("unroll") for (int w_ = 0; w_ < 4; ++w_) { d2_ = __builtin_amdgcn_cvt_pk_f32_fp8((int)ud[w_], false) * xf[c_][2 * w_] + d2_; d2_ = __builtin_amdgcn_cvt_pk_f32_fp8((int)ud[w_], true) * xf[c_][2 * w_ + 1] + d2_; } } \
            dd[k_] = d2_.x + d2_.y; } while (0)
#define EX_UEND(s_) do { float r4_[4], r2_[2], r1_; \
            { const bool up = (l16 & 4) != 0; _Pragma("unroll") for (int i_ = 0; i_ < 4; ++i_) { const float mine = up ? dd[i_ + 4] : dd[i_], theirs = up ? dd[i_] : dd[i_ + 4]; \
                const float fromhi = DPP_MOV(theirs, 0x104), fromlo = DPP_MOV(theirs, 0x114); r4_[i_] = mine + (up ? fromlo : fromhi); } }     \
            { const bool up = (l16 & 2) != 0; _Pragma("unroll") for (int i_ = 0; i_ < 2; ++i_) { const float mine = up ? r4_[i_ + 2] : r4_[i_], theirs = up ? r4_[i_] : r4_[i_ + 2]; r2_[i_] = mine + DPP_MOV(theirs, 0x4E); } }     \
            { const bool up = (l16 & 1) != 0; const float mine = up ? r2_[1] : r2_[0], theirs = up ? r2_[0] : r2_[1]; r1_ = mine + DPP_MOV(theirs, 0xB1); }     \
            { const int si_ = (s_) + l16; wl[si_] = (j == 0 ? 0.f : wl[si_]) + r1_; } } while (0)
            float dd[8];
            EX_RING(tabq, EX_U, EX_UEND);
#undef EX_U
#undef EX_UEND
            LDS_WAIT(); asm volatile("" ::: "memory");
        }
#pragma unroll
        for (int i = 0; i < 16; ++i) { const int s = l16 + 8 * i; const unsigned me = list[s]; const unsigned e = me & 0x3FFFu;
            wl[s] = gt[(me >> 16) & 127u] * gelu_tanh(wl[s] * su[e] * rs) * sv[e]; }
        LDS_WAIT(); asm volatile("" ::: "memory");
#pragma unroll 1
        for (int j = 0; j < NSW; ++j) {
            f32x2 acc[QCH][8];
#pragma unroll
            for (int c = 0; c < QCH; ++c)
#pragma unroll
                for (int e = 0; e < 8; ++e) acc[c][e] = (f32x2){0.f, 0.f};
            const unsigned char* tabq = pv + j * (QCH * 128);
#define EX_NOEND(s_) do { } while (0)
#define EX_V(B, s_, k_) do { const float w_ = wl[s_]; const f32x2 w2 = {w_, w_}; \
            _Pragma("unroll") for (int c_ = 0; c_ < QCH; ++c_) { const unsigned ud[4] = {B[c_].x, B[c_].y, B[c_].z, B[c_].w}; \
                _Pragma("unroll") for (int w4_ = 0; w4_ < 4; ++w4_) { acc[c_][2 * w4_] = __builtin_amdgcn_cvt_pk_f32_fp8((int)ud[w4_], false) * w2 + acc[c_][2 * w4_]; acc[c_][2 * w4_ + 1] = __builtin_amdgcn_cvt_pk_f32_fp8((int)ud[w4_], true) * w2 + acc[c_][2 * w4_ + 1]; } } } while (0)
            EX_RING(tabq, EX_V, EX_NOEND);
#undef EX_V
#undef EX_NOEND
            float* orow = F.out + (size_t)tok * DM + j * (QCH * 128) + l16 * 16; const bf16* xrow = xb + (size_t)tok * DM + j * (QCH * 128) + l16 * 16;
#pragma unroll
            for (int c = 0; c < QCH; ++c) { const v4u x0 = *(const GAS v4u*)(xrow + c * 128), x1 = *(const GAS v4u*)(xrow + c * 128 + 8); const unsigned xd[8] = {x0.x, x0.y, x0.z, x0.w, x1.x, x1.y, x1.z, x1.w};
#pragma unroll
                for (int qq = 0; qq < 4; ++qq)
                    *(GAS f32x4*)(orow + c * 128 + 4 * qq) = (f32x4){__uint_as_float(xd[2 * qq] << 16) + acc[c][2 * qq].x, __uint_as_float(xd[2 * qq] & 0xffff0000u) + acc[c][2 * qq].y,
                                                                    __uint_as_float(xd[2 * qq + 1] << 16) + acc[c][2 * qq + 1].x, __uint_as_float(xd[2 * qq + 1] & 0xffff0000u) + acc[c][2 * qq + 1].y}; }
        }
#undef EX_LD
#undef EX_RING
        LDS_WAIT(); asm volatile("" ::: "memory");
    }
}

#ifdef ONLY_PHASE
#define ISO(n) ((n) == ONLY_PHASE)
#else
#define ISO(n) true
#endif
#ifndef LAST_PHASE
#define LAST_PHASE 11
#endif
enum { PH_PROLOGUE = 0, PH_GEMM_IN, PH_GEMM_IN8, PH_ATTN, PH_GEMM_FOXUP, PH_GEMM_RETUP, PH_GEMM_OUT, PH_GEMM_MQ, PH_MEM_ATTN, PH_GEMM_MO, PH_GEMM_PQ, PH_EXPERTS, PH_N };
__global__ void __launch_bounds__(NWAVES * 64, 2) mega_fwd(Args args) {
    extern __shared__ __attribute__((aligned(16))) unsigned char lds[];
    Frame F;
    F.lds = (LAS unsigned char*)lds; F.ldsg = lds; F.tid = threadIdx.x; F.lane = F.tid & 63; F.wave = __builtin_amdgcn_readfirstlane(F.tid >> 6); F.G = gridDim.x; F.bx = blockIdx.x;
    F.in = args.in; F.out = args.out; F.ws = args.ws; F.p0_mask = args.p0_mask;
    volatile LAS unsigned* MISC = (volatile LAS unsigned*)(F.lds + MISC_OFF);
    for (int u = F.tid; u < (LDS_BYTES - LDSCTL_OFF) / 4; u += NWAVES * 64) ((LAS unsigned*)(F.lds + LDSCTL_OFF))[u] = 0u;
    __syncthreads();
    gu32* ctl = (gu32*)(args.ws + WS_CTL);
    XcdBarrier bar = xcd_barrier_post((unsigned*)(ctl + CW_BAR), MISC + 8);
    unsigned char* ws = args.ws;
    bf16* proj = (bf16*)(ws + WS_PROJ);
    for (int ph = args.ph_lo; ph < args.ph_hi; ++ph) {
        { int t_ = threadIdx.x; asm volatile("" : "+v"(t_)); F.tid = t_; F.lane = t_ & 63; }
        { int g_ = gridDim.x, b_ = blockIdx.x; asm volatile("" : "+s"(g_), "+s"(b_)); F.G = g_; F.bx = b_; }
        bool is_gemm = false, barrier_after = true, fp8 = false, mq_phase = false, qk_phase = false, pq_phase = false, ksplit = false, qk8_phase = false;
        pg8::Gemm g{nullptr, nullptr, 0, 0, 0, 0, 0x7F7F7F7F}; pg8::EpiAny E{};
        switch (ph) {
#ifndef NO_P0
        case PH_PROLOGUE: if constexpr (ISO(0)) p0_prologue(F); break;
#endif
        case PH_GEMM_IN: if constexpr (ISO(1)) p1_scan(F); is_gemm = true; barrier_after = false; qk_phase = true;
            g = pg8::Gemm{(const bf16*)(ws + WS_XN), (const bf16*)(ws + WS_WIN), M_TOK, N_QK, DM, DM, 0x7F7F7F7F, DM}; E.kind = 0; E.O = proj; E.ldc = PP; E.pn_off = 0; break;
        case PH_GEMM_IN8: is_gemm = true; fp8 = true; qk8_phase = true;
            g = pg8::Gemm{(const bf16*)((unsigned char*)args.out + DO_XN8), (const bf16*)(ws + WS_WIN + 16 * MiB), M_TOK, N_REST, DM / 2, DM / 2, W8_SCALE_B, DM / 2}; E.kind = 0; E.O = proj + N_QK; E.ldc = PP; E.pn_off = N_QK / 256; break;
#ifndef NO_ATTN
        case PH_ATTN: if constexpr (ISO(3)) p4_attention(F); break;
#endif
#if FP8_UP_OUT
        case PH_GEMM_FOXUP: is_gemm = true; fp8 = true;
            g = pg8::Gemm{(const bf16*)((unsigned char*)args.out + DO_OCAT8), (const bf16*)(ws + WS_WFOX), M_TOK, DM, 512, 1024, W8_SCALE_B, 1024}; ksplit = true; E.kind = 7; E.Gt = proj + C_G0; E.Gt2 = proj + C_G1; E.ldg = PP; E.O8 = (unsigned char*)(proj + C_FK); E.ld8 = PP * 2; break;
        case PH_GEMM_RETUP: barrier_after = false; break;
        case PH_GEMM_OUT: is_gemm = true; fp8 = true;
            g = pg8::Gemm{proj + C_FK, (const bf16*)(ws + WS_WOUT), M_TOK, DM, DM / 2, PP, W8_SCALE_B, DM / 2}; E.kind = 4; E.base = args.in[I_X]; E.base16 = nullptr; E.O = (bf16*)(ws + WS_XB1); E.ldc = DM; E.rowss = (float*)(ws + WS_ROWSS1); break;
#else
        case PH_GEMM_FOXUP: is_gemm = true;
            g = pg8::Gemm{proj + C_FQ, (const bf16*)(ws + WS_WFOX), M_TOK, DM, 1024, PP, 0x7F7F7F7F, 1024}; E.kind = 2; E.O = (bf16*)(ws + WS_XN); E.ldc = DM; E.Gt = proj + C_G0; E.ldg = PP; break;
        case PH_GEMM_RETUP: is_gemm = true;
            g = pg8::Gemm{proj + C_RQ, (const bf16*)(ws + WS_WRET), M_TOK, DM, 1024, PP, 0x7F7F7F7F, 1024}; E.kind = 6; E.O = (bf16*)(ws + WS_XN); E.ldc = DM; E.Gt = proj + C_G1; E.ldg = PP; break;
        case PH_GEMM_OUT: is_gemm = true;
            g = pg8::Gemm{(const bf16*)(ws + WS_XN), (const bf16*)(ws + WS_WOUT), M_TOK, DM, DM, DM, 0x7F7F7F7F, DM}; E.kind = 4; E.base = args.in[I_X]; E.base16 = nullptr; E.O = (bf16*)(ws + WS_XB1B); E.ldc = DM; E.rowss = (float*)(ws + WS_ROWSS1); break;
#endif
        case PH_GEMM_MQ: is_gemm = true; mq_phase = true;
            if (F.bx < 128) { g = pg8::Gemm{(const bf16*)(ws + WS_XB1), (const bf16*)(ws + WS_WMQ), M_TOK, 512, DM, DM, 0x7F7F7F7F, DM}; E.kind = 1; E.O = (bf16*)(ws + WS_QM); E.ldc = 512; E.rowss_in = (const float*)(ws + WS_ROWSS1); }
            else { g = pg8::Gemm{(const bf16*)(ws + WS_MN), (const bf16*)(ws + WS_WMKV), NB * 256, 1024, DM, DM, 0x7F7F7F7F, DM}; E.kind = 1; E.O = (bf16*)(ws + WS_KVM); E.ldc = 1024; E.rowss_in = nullptr; }
            break;
        case PH_MEM_ATTN: if constexpr (ISO(8)) p10_mem_attention(F); break;
        case PH_GEMM_MO: is_gemm = true;
            fp8 = true; g = pg8::Gemm{(const bf16*)(ws + WS_OMEM), (const bf16*)(ws + WS_WMO), M_TOK, DM, 256, 256, W8_SCALE_B, 256}; E.kind = 4; E.base = nullptr; E.base16 = (const bf16*)(ws + WS_XB1); E.O = (bf16*)(ws + WS_XB2); E.ldc = DM; E.rowss = (float*)(ws + WS_ROWSS2); break;
        case PH_GEMM_PQ: is_gemm = true; pq_phase = true;
            g = pg8::Gemm{(const bf16*)(ws + WS_XB2), (const bf16*)(ws + WS_WPQ), M_TOK, DM, DM, DM, 0x7F7F7F7F, DM}; E.kind = 1; E.O = (bf16*)(ws + WS_QP); E.ldc = DM; E.rowss_in = (const float*)(ws + WS_ROWSS2); break;
#if EX_TOK8
        case PH_EXPERTS: if constexpr (ISO(11)) p14_experts_8(F); break;
#else
        case PH_EXPERTS: if constexpr (ISO(11)) p14_experts_sorted(F); break;
#endif
        default: break;
        }
#ifndef NO_GEMM
        if constexpr (ISO(100)) if (is_gemm) { pg8::StaticOrder S; S.init(g.M, g.N, F.G, (mq_phase && F.bx >= 128) ? F.bx - 128 : F.bx); S.kshift = ksplit ? 1 : 0;
            if (fp8) pg8::gemm_phase<pg8::EpiAny, pg8::StaticOrder, true, true, true>(F.lds, g, S, E); else pg8::gemm_phase<pg8::EpiAny, pg8::StaticOrder, true, true, false>(F.lds, g, S, E); }
        if constexpr (ISO(1)) if (qk_phase) {
            asm volatile("s_waitcnt vmcnt(0)" ::: "memory"); __syncthreads();
            pg8::StaticOrder S; pg8::Unit u; S.init(M_TOK, N_QK, F.G, F.bx);
            for (int i = 0; S.next(i, u); ++i) fix_own_tile(F, proj, u.pm, u.pn, 2 + (u.pn >> 2)); }
        if constexpr (ISO(2)) if (qk8_phase) {
            asm volatile("s_waitcnt vmcnt(0)" ::: "memory"); __syncthreads();
            pg8::StaticOrder S; pg8::Unit u; S.init(M_TOK, N_REST, F.G, F.bx);
            for (int i = 0; S.next(i, u); ++i) if (u.pn < 8) fix_own_tile(F, proj, u.pm, u.pn + 8, u.pn >> 2); }
        if constexpr (ISO(10)) if (pq_phase) {
            asm volatile("s_waitcnt vmcnt(0)" ::: "memory"); __syncthreads();
            pg8::StaticOrder S; pg8::Unit u; S.init(M_TOK, DM, F.G, F.bx);
            for (int i = 0; S.next(i, u); ++i) p13_topk_unit(F, u.pm, u.pn); }
        if constexpr (ISO(7)) if (mq_phase) {
            pg8::StaticOrder S; pg8::Unit u;
            if (F.bx < 128) { S.init(M_TOK, 512, F.G, F.bx); if (S.next(0, u)) norm_own_tile(F, (bf16*)(ws + WS_QM), 512, u.pm * 256, u.pn * 256, args.in[I_MEMQ_G], QK_C2); }
            else { S.init(NB * 256, 1024, F.G, F.bx - 128); if (S.next(0, u) && u.pn < 2) norm_own_tile(F, (bf16*)(ws + WS_KVM), 1024, u.pm * 256, u.pn * 256, args.in[I_MEMK_G], 1.f); }
            p8_convert_peer(F); }
#endif
        if (barrier_after && ph + 1 < args.ph_hi) xcd_barrier(bar);
    }
    if (xb_ld((unsigned*)(ctl + CW_BAR) + XB_TMO) != 0u) { const float q = __builtin_nanf(""); for (size_t i = (size_t)F.bx * 512 + F.tid; i < (size_t)M_TOK * DM / 4; i += (size_t)F.G * 512) ((f32x4*)args.out)[i] = (f32x4){q, q, q, q}; }
}

#ifdef PROBE_CVT
__global__ void __launch_bounds__(512) bench_cvt(float* sink) {
    const int lane = threadIdx.x & 63;
#if PROBE_CVT == 1
    typedef unsigned v6u_ __attribute__((ext_vector_type(6))); typedef float v32f_ __attribute__((ext_vector_type(32)));
    v6u_ src = {(unsigned)lane, 2u, 3u, 4u, 5u, 6u}; float a0 = 0.f, a1 = 0.f;
#pragma unroll 4
    for (int it = 0; it < 16384; ++it) { src[0] += 1u; const v32f_ r = __builtin_amdgcn_cvt_scalef32_pk32_f32_fp6(src, 1.0f); a0 += r[0]; a1 += r[31]; }
    if (a0 + a1 == 12345.678f) sink[0] = 0.f;
#else
    unsigned s0 = (unsigned)lane; f32x2 acc = {0.f, 0.f};
#pragma unroll 4
    for (int it = 0; it < 16384; ++it) {
#pragma unroll
        for (int w = 0; w < 8; ++w) { s0 += 1u; acc += __builtin_amdgcn_cvt_pk_f32_fp8((int)s0, false); acc += __builtin_amdgcn_cvt_pk_f32_fp8((int)s0, true); } }
    if (acc.x + acc.y == 12345.678f) sink[0] = 0.f;
#endif
}
#endif
extern "C" void kernel_launch(void* const* d_in, const int* in_sizes, int n_in, void* d_out, int out_size, void* d_ws, size_t ws_size, hipStream_t stream) {
    static int grid = 0;
    if (grid == 0) {
        if (n_in != 23 || out_size != M_TOK * DM || ws_size < WS_END) { fprintf(stderr, "kernel_launch: unexpected shapes (n_in %d out %d ws %zu)\n", n_in, out_size, ws_size); grid = -1; return; }
        int dev = 0, cus = 0, per_cu = 0;
        if (hipGetDevice(&dev) != hipSuccess || hipDeviceGetAttribute(&cus, hipDeviceAttributeMultiprocessorCount, dev) != hipSuccess) { grid = -1; return; }
        if (hipFuncSetAttribute((const void*)mega_fwd, hipFuncAttributeMaxDynamicSharedMemorySize, LDS_BYTES) != hipSuccess) { fprintf(stderr, "hipFuncSetAttribute failed\n"); grid = -1; return; }
        if (hipOccupancyMaxActiveBlocksPerMultiprocessor(&per_cu, (const void*)mega_fwd, NWAVES * 64, LDS_BYTES) != hipSuccess || per_cu < 1) fprintf(stderr, "occupancy query reports %d\n", per_cu);
        (void)hipGetLastError();
        grid = cus;
        if (grid != 256) { fprintf(stderr, "kernel_launch: built for 256 CUs, got %d\n", cus); grid = -1; return; }
    }
    if (grid < 0) return;
    (void)hipMemsetAsync((char*)d_ws + WS_CTL, 0, CTL_ZERO_BYTES, stream);
    Args a{};
    for (int i = 0; i < 23; ++i) a.in[i] = (const float*)d_in[i];
    a.out = (float*)d_out; a.ws = (unsigned char*)d_ws;
#ifdef PROBE_CVT
    hipLaunchKernelGGL(bench_cvt, dim3(256), dim3(512), 0, stream, (float*)d_ws + (4u << 20));
#endif
#ifdef PROBE_PREFIX
    a.ph_lo = 0; a.ph_hi = PROBE_PREFIX;
#ifdef PROBE_P0_MASK
    a.p0_mask = PROBE_P0_MASK;
#else
    a.p0_mask = 3;
#endif
    hipLaunchKernelGGL(mega_fwd, dim3(grid), dim3(NWAVES * 64), LDS_BYTES, stream, a);
    (void)hipMemsetAsync((char*)d_ws + WS_CTL, 0, CTL_ZERO_BYTES, stream);
#endif
    a.ph_lo = 0; a.ph_hi = LAST_PHASE + 1; a.p0_mask = 3;
    hipLaunchKernelGGL(mega_fwd, dim3(grid), dim3(NWAVES * 64), LDS_BYTES, stream, a);
}
```

```cpp
#include <hip/hip_runtime.h>
#include <cstdio>
#include <cstdint>
#include <cmath>
namespace pg8 {
#define PG8_LAS __attribute__((address_space(3)))
typedef unsigned short bf16_t;
typedef short bf16x8 __attribute__((ext_vector_type(8)));
typedef float f32x4 __attribute__((ext_vector_type(4)));
typedef unsigned u32x4 __attribute__((ext_vector_type(4)));
constexpr int BM = 256, BK = 64, HALF = 128, HTB = HALF * BK * 2  , STAGE_BYTES = 8 * HTB, NXCD = 8, WGM = 8;

__host__ __device__ __forceinline__ int lds_byte(int r, int c) { const int st = (r >> 4) * 2 + (c >> 5), rr = r & 15, cc = c & 31, ob = rr * 64 + cc * 2; return st * 1024 + (ob ^ (((ob >> 9) & 1) << 5)); }
__host__ __device__ __forceinline__ void stage_rc(int b, int& R, int& C) { const int st = b / 1024, sb = b % 1024, swz = sb ^ (((sb >> 9) & 1) << 5); R = (st >> 1) * 16 + swz / 64; C = (st & 1) * 32 + (swz % 64) / 2; }
__host__ __device__ __forceinline__ int perm32(int rho) { const int n = rho >> 4, i = rho & 15; return 8 * (i >> 2) + 4 * n + (i & 3); }

struct Unit { int pm, pn, kp; };
typedef int pg8_v4i __attribute__((ext_vector_type(4)));
struct Gemm { const bf16_t* A; const bf16_t* Bt; int M, N, K, lda; int scale_b; int ldb; };

struct StaticOrder {
    int nM, nN, nwg, G, c, kshift = 0;
    __host__ __device__ __forceinline__ void init(int M, int N, int G_, int c_) { nM = M / BM; nN = N / BM; nwg = nM * nN; G = G_; c = c_; }
    __host__ __device__ __forceinline__ bool next(int i2, Unit& u) const {
        const int i = i2 >> kshift; u.kp = i2 & ((1 << kshift) - 1);
        const long L = (long)i * G + c; if (L >= nwg) return false;
        int wgid = (int)L; { const int q = nwg / NXCD, r = nwg % NXCD, xcd = wgid % NXCD, off = wgid / NXCD; wgid = (xcd < r ? xcd * (q + 1) : r * (q + 1) + (xcd - r) * q) + off; }
        const int nig = WGM * nN, gid = wgid / nig, fm = gid * WGM, gsz = (nM - fm) < WGM ? (nM - fm) : WGM;
        u.pm = fm + ((wgid % nig) % gsz); u.pn = (wgid % nig) / gsz; return true;
    }
    __device__ __forceinline__ void a_ready(const Unit&) const {}
    __device__ __forceinline__ void done(const Unit&) const {}
};

__device__ __forceinline__ unsigned cvt_pk_bf16(float lo, float hi) { unsigned r; asm volatile("v_cvt_pk_bf16_f32 %0, %1, %2" : "=v"(r) : "v"(lo), "v"(hi)); return r; }
typedef float f32x2 __attribute__((ext_vector_type(2)));
__device__ __forceinline__ f32x2 gelu_pk(f32x2 v) {
    const f32x2 av = __builtin_elementwise_abs(v), d = av * 0.2316418882f + 1.0f;
    f32x2 t; t.x = __builtin_amdgcn_rcpf(d.x); t.y = __builtin_amdgcn_rcpf(d.y);
    f32x2 q = t * 0.5307027145f + (-0.7265760135f); q = q * t + 0.7107068705f; q = q * t + (-0.142248368f); q = q * t + 0.127414796f; q = q * t;
    const f32x2 s = (v * v) * (-0.72134752044f);
    f32x2 e; e.x = __builtin_amdgcn_exp2f(s.x); e.y = __builtin_amdgcn_exp2f(s.y);
    const f32x2 m = v * (q * e), r = v - m;
    f32x2 o; o.x = v.x < 0.f ? m.x : r.x; o.y = v.y < 0.f ? m.y : r.y; return o;
}

template <int ACT  > struct EpiBf16 {
    static constexpr bool PERM = true, AFTER_DRAIN = false; static_assert(ACT == 0 || ACT == 1, "EpiBf16: ACT is 0 (none) or 1 (gelu_pk)");
    bf16_t* O; int ldc; const float* bias; int split_cols; size_t split_stride; float scale0;
    __device__ __forceinline__ void operator()(const f32x4 (&acc)[2][2][4][2], const Unit& u, int wr, int wc, int fr, int fq) const {
        const int row0 = u.pm * BM + wr * 64 + fr; int colt = u.pn * BM; bf16_t* base = O;
        float sc = 1.f; if (split_cols) { const int t = colt / split_cols; base += (size_t)t * split_stride; colt -= t * split_cols; if (t == 0) sc = scale0; }
        const int col0 = colt + wc * 32 + 8 * fq, bcol0 = u.pn * BM + wc * 32 + 8 * fq;
        f32x4 bv[2][2];
#pragma unroll
        for (int bj = 0; bj < 2; ++bj)
#pragma unroll
            for (int n = 0; n < 2; ++n) bv[bj][n] = bias ? *(const f32x4*)(bias + bcol0 + bj * HALF + 4 * n) : (f32x4){0.f, 0.f, 0.f, 0.f};
#pragma unroll
        for (int ai = 0; ai < 2; ++ai)
#pragma unroll
            for (int m = 0; m < 4; ++m) { bf16_t* rowp = base + (size_t)(row0 + ai * HALF + m * 16) * ldc + col0;
#pragma unroll
                for (int bj = 0; bj < 2; ++bj) { f32x4 v0 = acc[ai][bj][m][0] + bv[bj][0], v1 = acc[ai][bj][m][1] + bv[bj][1];
                    if (ACT == 1) { f32x2 a = gelu_pk((f32x2){v0[0], v0[1]}), b = gelu_pk((f32x2){v0[2], v0[3]}), c = gelu_pk((f32x2){v1[0], v1[1]}), d = gelu_pk((f32x2){v1[2], v1[3]});
                        v0 = (f32x4){a.x, a.y, b.x, b.y}; v1 = (f32x4){c.x, c.y, d.x, d.y}; }
                    v0 = v0 * sc; v1 = v1 * sc; u32x4 w; w.x = cvt_pk_bf16(v0[0], v0[1]); w.y = cvt_pk_bf16(v0[2], v0[3]); w.z = cvt_pk_bf16(v1[0], v1[1]); w.w = cvt_pk_bf16(v1[2], v1[3]);
                    *(u32x4*)(rowp + bj * HALF) = w; } }
    }
};

struct PanelStats {
    unsigned* xbuf;
    unsigned* cnt;
    unsigned* tmo;
    int ntn; float eps;
    unsigned code;
    __device__ __forceinline__ bool run(const f32x4 (&v)[2][2][4][2], const Unit& u, int wr, int wc, int fr, int fq, PG8_LAS unsigned char* lds, int wid, int lane) const {
        typedef float f32x2v __attribute__((ext_vector_type(2)));
        PG8_LAS f32x2v* P = (PG8_LAS f32x2v*)lds;
        PG8_LAS f32x2v* S = (PG8_LAS f32x2v*)(lds + 8192);
        PG8_LAS unsigned* flag = (PG8_LAS unsigned*)(lds + 8192 + 2048);
#pragma unroll
        for (int ai = 0; ai < 2; ++ai)
#pragma unroll
            for (int m = 0; m < 4; ++m) {
                float s = 0.f;
#pragma unroll
                for (int bj = 0; bj < 2; ++bj)
#pragma unroll
                    for (int n = 0; n < 2; ++n) { const f32x4 x = v[ai][bj][m][n]; s += (x[0] + x[1]) + (x[2] + x[3]); }
                s += __shfl_xor(s, 16); s += __shfl_xor(s, 32);
                const float mw = s * (1.0f / 64.0f); float q = 0.f;
#pragma unroll
                for (int bj = 0; bj < 2; ++bj)
#pragma unroll
                    for (int n = 0; n < 2; ++n) { const f32x4 d = v[ai][bj][m][n] - mw; q += (d[0] * d[0] + d[1] * d[1]) + (d[2] * d[2] + d[3] * d[3]); }
                q += __shfl_xor(q, 16); q += __shfl_xor(q, 32);
                if (fq == 0) P[(ai * HALF + wr * 64 + m * 16 + fr) * 4 + wc] = (f32x2v){mw, q};
            }
        asm volatile("s_waitcnt lgkmcnt(0)" ::: "memory"); __builtin_amdgcn_s_barrier(); asm volatile("" ::: "memory");
#if defined(BROKEN_EXCHANGE_NO_WAIT)
#warning BROKEN CONTROL BUILD: the row-statistics exchange does not wait; results are wrong by design
        if (blockIdx.x >= 64) { const long long t0_ = clock64(); while (clock64() - t0_ < 60000) __builtin_amdgcn_s_sleep(8); }
#endif
        const int row = wid * 32 + (lane & 31);
        if (lane < 32) {
            const f32x2v a = P[row * 4 + 0], b = P[row * 4 + 1], c = P[row * 4 + 2], d = P[row * 4 + 3];
            const float mt = (a.x + b.x + c.x + d.x) * 0.25f;
            const float da = a.x - mt, db = b.x - mt, dc = c.x - mt, dd = d.x - mt;
            const float m2 = (a.y + b.y) + (c.y + d.y) + 64.0f * ((da * da + db * db) + (dc * dc + dd * dd));
            unsigned long long* slot = (unsigned long long*)xbuf + ((size_t)(u.pm * BM + row) * 4 + u.pn);
            __hip_atomic_store(slot, ((unsigned long long)__float_as_uint(m2) << 32) | __float_as_uint(mt), __ATOMIC_RELAXED, __HIP_MEMORY_SCOPE_AGENT);
        }
        asm volatile("s_waitcnt vmcnt(0)" ::: "memory");
        if (lane == 0) __hip_atomic_fetch_add(cnt + 64 * u.pm, 1u, __ATOMIC_RELAXED, __HIP_MEMORY_SCOPE_AGENT);
        if (wid == 0) {
            bool dead = false; const unsigned long long t0 = __builtin_amdgcn_s_memrealtime(); const unsigned want = 8u * (unsigned)ntn;
            for (;;) {
#if defined(BROKEN_EXCHANGE_NO_WAIT)
                break;
#endif
                if ((unsigned)__builtin_amdgcn_readfirstlane(__hip_atomic_load(cnt + 64 * u.pm, __ATOMIC_RELAXED, __HIP_MEMORY_SCOPE_AGENT)) >= want) break;
                if (__builtin_amdgcn_s_memrealtime() - t0 > 2000000ull) {
                    if (lane == 0) { unsigned expect = 0u; __hip_atomic_compare_exchange_strong(tmo + 1, &expect, code | (unsigned)(u.pm & 0xff), __ATOMIC_RELAXED, __ATOMIC_RELAXED, __HIP_MEMORY_SCOPE_AGENT);
                                     __hip_atomic_store(tmo, 1u, __ATOMIC_RELAXED, __HIP_MEMORY_SCOPE_AGENT); }
                    dead = true; break; }
                __builtin_amdgcn_s_sleep(2);
            }
            __builtin_amdgcn_fence(__ATOMIC_ACQUIRE, "agent");
            if (lane == 0) flag[0] = dead ? 1u : 0u;
        }
        asm volatile("s_waitcnt vmcnt(0) lgkmcnt(0)" ::: "memory"); __builtin_amdgcn_s_barrier(); asm volatile("" ::: "memory");
        const bool bad = flag[0] != 0u;
        if (lane < 32) {
            const unsigned long long* slot = (const unsigned long long*)xbuf + (size_t)(u.pm * BM + row) * 4; float mt[4], m2[4]; float ms = 0.f;
#pragma unroll
            for (int t = 0; t < 4; ++t) { if (t < ntn) { const unsigned long long w = __hip_atomic_load(slot + t, __ATOMIC_RELAXED, __HIP_MEMORY_SCOPE_AGENT); mt[t] = __uint_as_float((unsigned)w); m2[t] = __uint_as_float((unsigned)(w >> 32)); } else { mt[t] = 0.f; m2[t] = 0.f; } ms += mt[t]; }
            const float mean = ms / (float)ntn; float q = 0.f;
#pragma unroll
            for (int t = 0; t < 4; ++t) if (t < ntn) { const float dm = mt[t] - mean; q += m2[t] + 256.0f * dm * dm; }
            S[row] = (f32x2v){mean, 1.0f / sqrtf(q / (256.0f * (float)ntn) + eps)};
        }
        asm volatile("s_waitcnt lgkmcnt(0)" ::: "memory"); __builtin_amdgcn_s_barrier(); asm volatile("" ::: "memory");
        return bad;
    }
};
struct EpiLnRes {
    static constexpr bool PERM = false, AFTER_DRAIN = true;
    const float* base; float* out; int ldc; const float* bias; PanelStats st; unsigned poison;
    __device__ __forceinline__ void fused(f32x4 (&acc)[2][2][4][2], const Unit& u, int wr, int wc, int fr, int fq, PG8_LAS unsigned char* lds, int wid, int lane) const {
        typedef float f32x2v __attribute__((ext_vector_type(2)));
        const PG8_LAS f32x2v* S = (const PG8_LAS f32x2v*)(lds + 8192);
        const int col0 = u.pn * BM + wc * 32 + 4 * fq;
#pragma unroll
        for (int bj = 0; bj < 2; ++bj)
#pragma unroll
            for (int n = 0; n < 2; ++n) { const f32x4 bv = bias ? *(const f32x4*)(bias + col0 + bj * HALF + n * 16) : (f32x4){0.f, 0.f, 0.f, 0.f};
#pragma unroll
                for (int ai = 0; ai < 2; ++ai)
#pragma unroll
                    for (int m = 0; m < 4; ++m) acc[ai][bj][m][n] += bv; }
        f32x4 pre[4][2][2];
#pragma unroll
        for (int m = 0; m < 4; ++m) { const size_t off = (size_t)(u.pm * BM + wr * 64 + m * 16 + fr) * ldc + col0;
#pragma unroll
            for (int bj = 0; bj < 2; ++bj)
#pragma unroll
                for (int n = 0; n < 2; ++n) pre[m][bj][n] = *(const f32x4*)(base + off + bj * HALF + n * 16); }
        const bool bad = st.run(acc, u, wr, wc, fr, fq, lds, wid, lane) || poison != 0u;
        const float qnan = __builtin_nanf("");
#pragma unroll
        for (int ai = 0; ai < 2; ++ai)
#pragma unroll
            for (int m = 0; m < 4; ++m) { const int r = ai * HALF + wr * 64 + m * 16 + fr; const f32x2v sr = S[r]; const size_t off = (size_t)(u.pm * BM + r) * ldc + col0;
#pragma unroll
                for (int bj = 0; bj < 2; ++bj)
#pragma unroll
                    for (int n = 0; n < 2; ++n) { const f32x4 bs = ai == 0 ? pre[m][bj][n] : *(const f32x4*)(base + off + bj * HALF + n * 16); f32x4 o = bs + (acc[ai][bj][m][n] - sr.x) * sr.y;
                        if (bad) o = (f32x4){qnan, qnan, qnan, qnan}; *(f32x4*)(out + off + bj * HALF + n * 16) = o; }
                if (m & 1) asm volatile("" ::: "memory"); }
    }
};
struct EpiLnResLn {
    static constexpr bool PERM = false, AFTER_DRAIN = true;
    const float* base; float* out; bf16_t* xn; int ldc; const float* bias; PanelStats st1, st2; unsigned poison;
    __device__ __forceinline__ void fused(f32x4 (&acc)[2][2][4][2], const Unit& u, int wr, int wc, int fr, int fq, PG8_LAS unsigned char* lds, int wid, int lane) const {
        typedef float f32x2v __attribute__((ext_vector_type(2))); typedef unsigned u32x2v __attribute__((ext_vector_type(2)));
        const PG8_LAS f32x2v* S = (const PG8_LAS f32x2v*)(lds + 8192);
        const int col0 = u.pn * BM + wc * 32 + 4 * fq;
#pragma unroll
        for (int bj = 0; bj < 2; ++bj)
#pragma unroll
            for (int n = 0; n < 2; ++n) { const f32x4 bv = bias ? *(const f32x4*)(bias + col0 + bj * HALF + n * 16) : (f32x4){0.f, 0.f, 0.f, 0.f};
#pragma unroll
                for (int ai = 0; ai < 2; ++ai)
#pragma unroll
                    for (int m = 0; m < 4; ++m) acc[ai][bj][m][n] += bv; }
        bool bad = st1.run(acc, u, wr, wc, fr, fq, lds, wid, lane) || poison != 0u;
        const float qnan = __builtin_nanf("");
#pragma unroll
        for (int ai = 0; ai < 2; ++ai)
#pragma unroll
            for (int m = 0; m < 4; ++m) { const int r = ai * HALF + wr * 64 + m * 16 + fr; const f32x2v sr = S[r]; const size_t off = (size_t)(u.pm * BM + r) * ldc + col0;
#pragma unroll
                for (int bj = 0; bj < 2; ++bj)
#pragma unroll
                    for (int n = 0; n < 2; ++n) { const f32x4 bs = *(const f32x4*)(base + off + bj * HALF + n * 16); acc[ai][bj][m][n] = bs + (acc[ai][bj][m][n] - sr.x) * sr.y; }
                asm volatile("" : "+v"(acc[ai][0][m][0]), "+v"(acc[ai][0][m][1]), "+v"(acc[ai][1][m][0]), "+v"(acc[ai][1][m][1]));
                if (m & 1) asm volatile("" ::: "memory"); }
        const bool bad1 = bad;
        bad = st2.run(acc, u, wr, wc, fr, fq, lds, wid, lane) || bad;
#pragma unroll
        for (int ai = 0; ai < 2; ++ai)
#pragma unroll
            for (int m = 0; m < 4; ++m) { const int r = ai * HALF + wr * 64 + m * 16 + fr; const f32x2v sr = S[r]; const size_t off = (size_t)(u.pm * BM + r) * ldc + col0;
#pragma unroll
                for (int bj = 0; bj < 2; ++bj)
#pragma unroll
                    for (int n = 0; n < 2; ++n) { const f32x4 x1 = acc[ai][bj][m][n]; *(f32x4*)(out + off + bj * HALF + n * 16) = bad1 ? (f32x4){qnan, qnan, qnan, qnan} : x1;
                        const f32x4 o = (x1 - sr.x) * sr.y; u32x2v w; w.x = cvt_pk_bf16(o[0], o[1]); w.y = cvt_pk_bf16(o[2], o[3]);
                        if (bad) { w.x = 0x7fc07fc0u; w.y = 0x7fc07fc0u; } *(u32x2v*)(xn + off + bj * HALF + n * 16) = w; }
                asm volatile("" ::: "memory"); }
    }
};

typedef int pg8_v8i __attribute__((ext_vector_type(8)));
template <bool FP8> struct Frag;
template <> struct Frag<false> { bf16x8 k[2]; };
template <> struct Frag<true> { pg8_v8i v; };
__device__ __forceinline__ void load_frag(Frag<false>& f, const PG8_LAS unsigned char* p) { f.k[0] = *(const PG8_LAS bf16x8*)p; f.k[1] = *(const PG8_LAS bf16x8*)(p + 1024); }
__device__ __forceinline__ void load_frag(Frag<true>& f, const PG8_LAS unsigned char* p) { const pg8_v4i a = *(const PG8_LAS pg8_v4i*)p, b = *(const PG8_LAS pg8_v4i*)(p + 1024); f.v = __builtin_shufflevector(a, b, 0, 1, 2, 3, 4, 5, 6, 7); }
__device__ __forceinline__ void mma_frag(f32x4& acc, const Frag<false>& b, const Frag<false>& a, int) { acc = __builtin_amdgcn_mfma_f32_16x16x32_bf16(b.k[0], a.k[0], acc, 0, 0, 0); acc = __builtin_amdgcn_mfma_f32_16x16x32_bf16(b.k[1], a.k[1], acc, 0, 0, 0); }
__device__ __forceinline__ void mma_frag(f32x4& acc, const Frag<true>& b, const Frag<true>& a, int scale_w) {
    asm volatile("v_mfma_scale_f32_16x16x128_f8f6f4 %0, %1, %2, %0, %3, %4 op_sel_hi:[0,0,0]" : "+v"(acc) : "v"(b.v), "v"(a.v), "v"(scale_w), "v"(0x7F7F7F7F)); }
template <class Epi, class Sched, bool ALIGN_EPI = false, bool SP2 = false, bool FP8 = false>
__device__ __forceinline__ void gemm_phase(PG8_LAS unsigned char* lds, const Gemm g, const Sched& S, const Epi& E) {
    int tid_ = threadIdx.x; asm volatile("" : "+v"(tid_));
    const int tid = tid_, wid = __builtin_amdgcn_readfirstlane(tid >> 6), lane = tid & 63, wr = wid >> 2, wc = wid & 3, fr = lane & 15, fq = lane >> 4;
    const int K = g.K, nt = K / BK;
    unsigned voffA[2], voffB[2];
#pragma unroll
    for (int i = 0; i < 2; ++i) { int R, C; stage_rc(tid * 16 + i * 8192, R, C); const int Rb = Epi::PERM ? ((R & ~31) + perm32(R & 31)) : R;
        voffA[i] = (unsigned)(R * g.lda + C) * 2u; voffB[i] = (unsigned)(Rb * g.ldb + C) * 2u; }
    const size_t kstep = (size_t)(BK * 2);
    const size_t hstepB = (size_t)HALF * g.ldb * 2, hstepA = (size_t)HALF * g.lda * 2;
    const size_t tstepB = 2 * hstepB, tstepA = 2 * hstepA;
    const unsigned ldsw = (unsigned)wid * 1024u;
    const int aoff = lds_byte(wr * 64 + fr, fq * 8), boff = lds_byte(wc * 32 + fr, fq * 8);
#define PG8_SA(b, h) (((b) * 2 + (h)) * HTB)
#define PG8_SB(b, h) ((4 + (b) * 2 + (h)) * HTB)
#define PG8_STAGE(bufoff, gbase, voff) do { _Pragma("unroll") for (int _i = 0; _i < 2; ++_i) \
        __builtin_amdgcn_global_load_lds((const unsigned*)((const char*)(gbase) + (voff)[_i]), (PG8_LAS unsigned*)(lds + (bufoff) + ldsw + _i * 8192), 16, 0, 0); } while (0)
#define PG8_LDA(dst, b, h) do { _Pragma("unroll") for (int m = 0; m < 4; ++m) load_frag(dst[m], lds + PG8_SA(b, h) + aoff + m * 2048); } while (0)
#define PG8_LDB(dst, b, h) do { _Pragma("unroll") for (int n = 0; n < 2; ++n) load_frag(dst[n], lds + PG8_SB(b, h) + boff + n * 2048); } while (0)
#define PG8_MMA(ai, bj, At, Bt) do { __builtin_amdgcn_s_setprio(1); _Pragma("unroll") for (int m = 0; m < 4; ++m) _Pragma("unroll") for (int n = 0; n < 2; ++n) mma_frag(acc[ai][bj][m][n], Bt[n], At[m], g.scale_b); \
        __builtin_amdgcn_s_setprio(0); } while (0)
#define PG8_WAIT_V(n) asm volatile("s_waitcnt vmcnt(" #n ")" ::: "memory")
#define PG8_WAIT_L(n) asm volatile("s_waitcnt lgkmcnt(" #n ")" ::: "memory")
#define PG8_BAR __builtin_amdgcn_s_barrier()
#define PG8_SCHED __builtin_amdgcn_sched_barrier(0)
    Unit cur, nxt; int ui = 0;
    if (!S.next(0, cur)) return;
    f32x4 acc[2][2][4][2];
#pragma unroll
    for (int a = 0; a < 2; ++a)
#pragma unroll
        for (int b = 0; b < 2; ++b)
#pragma unroll
            for (int m = 0; m < 4; ++m)
#pragma unroll
                for (int n = 0; n < 2; ++n) acc[a][b][m][n] = (f32x4){0.f, 0.f, 0.f, 0.f};
    Frag<FP8> At[4], B0[2], B1[2];
    const size_t kpart = (size_t)K * 2;
    const char* cA = (const char*)g.A + (size_t)cur.pm * tstepA + cur.kp * kpart; const char* cB = (const char*)g.Bt + (size_t)cur.pn * tstepB + cur.kp * kpart;
    S.a_ready(cur);
    if constexpr (SP2) {
        PG8_STAGE(PG8_SB(0, 0), cB, voffB); PG8_STAGE(PG8_SB(0, 1), cB + hstepB, voffB); PG8_STAGE(PG8_SA(0, 0), cA, voffA); PG8_STAGE(PG8_SA(0, 1), cA + hstepA, voffA);
        if (wr == 1) PG8_BAR;
        PG8_WAIT_V(2); PG8_BAR;
        PG8_STAGE(PG8_SB(1, 0), cB + kstep, voffB); PG8_STAGE(PG8_SA(1, 0), cA + kstep, voffA); PG8_STAGE(PG8_SB(1, 1), cB + hstepB + kstep, voffB);
        PG8_WAIT_V(6); PG8_BAR;
    } else {
        PG8_STAGE(PG8_SB(0, 0), cB, voffB); PG8_STAGE(PG8_SA(0, 0), cA, voffA); PG8_STAGE(PG8_SB(0, 1), cB + hstepB, voffB); PG8_STAGE(PG8_SA(0, 1), cA + hstepA, voffA);
        if (wr == 1) PG8_BAR;
        PG8_WAIT_V(4); PG8_BAR;
        PG8_STAGE(PG8_SB(1, 0), cB + kstep, voffB); PG8_STAGE(PG8_SA(1, 0), cA + kstep, voffA); PG8_STAGE(PG8_SB(1, 1), cB + hstepB + kstep, voffB);
        PG8_WAIT_V(6); PG8_BAR;
    }
    for (;;) {
        const bool has_next = S.next(ui + 1, nxt);
        const char* nA = has_next ? (const char*)g.A + (size_t)nxt.pm * tstepA + nxt.kp * kpart : cA; const char* nB = has_next ? (const char*)g.Bt + (size_t)nxt.pn * tstepB + nxt.kp * kpart : cB;
        for (int t = 0; t < nt; t += 2) {
            const bool last = (t == nt - 2);
            const char* a1 = cA + (size_t)(t + 1) * kstep;
            const char* a2 = last ? nA : cA + (size_t)(t + 2) * kstep; const char* b2 = last ? nB : cB + (size_t)(t + 2) * kstep;
            const char* a3 = a2 + kstep; const char* b3 = b2 + kstep;
            if (last && has_next) S.a_ready(nxt);
            if constexpr (SP2) {
            PG8_LDB(B0, 0, 0); PG8_LDB(B1, 0, 1); PG8_SCHED; PG8_LDA(At, 0, 0); PG8_STAGE(PG8_SA(1, 1), a1 + hstepA, voffA);
            PG8_WAIT_V(8); PG8_WAIT_L(0); PG8_BAR; PG8_MMA(0, 0, At, B0); PG8_MMA(0, 1, At, B1); PG8_BAR; PG8_SCHED;
            PG8_LDA(At, 0, 1); PG8_STAGE(PG8_SB(0, 0), b2, voffB); PG8_STAGE(PG8_SB(0, 1), b2 + hstepB, voffB); PG8_STAGE(PG8_SA(0, 0), a2, voffA);
            PG8_WAIT_V(8); PG8_WAIT_L(0); PG8_BAR; PG8_MMA(1, 0, At, B0); PG8_MMA(1, 1, At, B1); PG8_BAR; PG8_SCHED;
            PG8_LDB(B0, 1, 0); PG8_LDB(B1, 1, 1); PG8_SCHED; PG8_LDA(At, 1, 0); PG8_STAGE(PG8_SA(0, 1), a2 + hstepA, voffA);
            PG8_WAIT_V(8); PG8_WAIT_L(0); PG8_BAR; PG8_MMA(0, 0, At, B0); PG8_MMA(0, 1, At, B1); PG8_BAR; PG8_SCHED;
            PG8_LDA(At, 1, 1); PG8_STAGE(PG8_SB(1, 0), b3, voffB); PG8_STAGE(PG8_SB(1, 1), b3 + hstepB, voffB); PG8_STAGE(PG8_SA(1, 0), a3, voffA);
            PG8_WAIT_V(8); PG8_WAIT_L(0); PG8_BAR; PG8_MMA(1, 0, At, B0); PG8_MMA(1, 1, At, B1); PG8_BAR; PG8_SCHED;
            } else {
            PG8_LDB(B0, 0, 0); PG8_SCHED; PG8_LDA(At, 0, 0); PG8_STAGE(PG8_SA(1, 1), a1 + hstepA, voffA);
            PG8_WAIT_L(8); PG8_BAR; PG8_WAIT_L(0); PG8_MMA(0, 0, At, B0); PG8_BAR; PG8_SCHED;
            PG8_LDB(B1, 0, 1); PG8_STAGE(PG8_SB(0, 0), b2, voffB);
            PG8_BAR; PG8_WAIT_L(0); PG8_MMA(0, 1, At, B1); PG8_BAR;
            PG8_LDA(At, 0, 1); PG8_STAGE(PG8_SA(0, 0), a2, voffA);
            PG8_BAR; PG8_WAIT_L(0); PG8_MMA(1, 0, At, B0); PG8_BAR; PG8_SCHED;
            PG8_STAGE(PG8_SB(0, 1), b2 + hstepB, voffB);
            PG8_WAIT_V(6); PG8_BAR; PG8_MMA(1, 1, At, B1); PG8_BAR;
            PG8_LDB(B0, 1, 0); PG8_SCHED; PG8_LDA(At, 1, 0); PG8_STAGE(PG8_SA(0, 1), a2 + hstepA, voffA);
            PG8_WAIT_L(8); PG8_BAR; PG8_WAIT_L(0); PG8_MMA(0, 0, At, B0); PG8_BAR; PG8_SCHED;
            PG8_LDB(B1, 1, 1); PG8_STAGE(PG8_SB(1, 0), b3, voffB);
            PG8_BAR; PG8_WAIT_L(0); PG8_MMA(0, 1, At, B1); PG8_BAR;
            PG8_LDA(At, 1, 1); PG8_STAGE(PG8_SA(1, 0), a3, voffA);
            PG8_BAR; PG8_WAIT_L(0); PG8_MMA(1, 0, At, B0); PG8_BAR; PG8_SCHED;
            PG8_STAGE(PG8_SB(1, 1), b3 + hstepB, voffB);
            PG8_WAIT_V(6); PG8_BAR; PG8_MMA(1, 1, At, B1); PG8_BAR;
            }
        }
        if constexpr (ALIGN_EPI) { if (wr == 0) PG8_BAR; }
        if constexpr (FP8) { asm volatile("s_nop 15\n\ts_nop 15" ::: "memory"); }
        if constexpr (!Epi::AFTER_DRAIN) { E(acc, cur, wr, wc, fr, fq); S.done(cur); }
        if (!has_next) break;
        if (nxt.kp == 0)
#pragma unroll
        for (int a = 0; a < 2; ++a)
#pragma unroll
            for (int b = 0; b < 2; ++b)
#pragma unroll
                for (int m = 0; m < 4; ++m)
#pragma unroll
                    for (int n = 0; n < 2; ++n) acc[a][b][m][n] = (f32x4){0.f, 0.f, 0.f, 0.f};
        cur = nxt; cA = nA; cB = nB; ++ui;
        if constexpr (ALIGN_EPI) { if (wr == 1) PG8_BAR; }
    }
    PG8_WAIT_V(0);
    if constexpr (!ALIGN_EPI) { if (wr == 0) PG8_BAR; }
    PG8_BAR;
    if constexpr (Epi::AFTER_DRAIN) { E.fused(acc, cur, wr, wc, fr, fq, lds, wid, lane); S.done(cur); }
#undef PG8_SA
#undef PG8_SB
#undef PG8_STAGE
#undef PG8_LDA
#undef PG8_LDB
#undef PG8_MMA
#undef PG8_WAIT_V
#undef PG8_WAIT_L
#undef PG8_BAR
#undef PG8_SCHED
}
}

#ifndef PG8_SP2
#define PG8_SP2 true
#endif
#ifndef PG8_ALIGN
#define PG8_ALIGN true
#endif
namespace pg8 {
typedef unsigned u32x2e __attribute__((ext_vector_type(2)));
__device__ __forceinline__ float bfbits2f(unsigned b16) { return __uint_as_float(b16 << 16); }
__device__ __forceinline__ void unpack8(const u32x4 w, float (&f)[8]) {
    f[0] = __uint_as_float(w.x << 16); f[1] = __uint_as_float(w.x & 0xffff0000u); f[2] = __uint_as_float(w.y << 16); f[3] = __uint_as_float(w.y & 0xffff0000u);
    f[4] = __uint_as_float(w.z << 16); f[5] = __uint_as_float(w.z & 0xffff0000u); f[6] = __uint_as_float(w.w << 16); f[7] = __uint_as_float(w.w & 0xffff0000u);
}
__device__ __forceinline__ u32x4 pack8f(const float (&f)[8]) { u32x4 w; w.x = cvt_pk_bf16(f[0], f[1]); w.y = cvt_pk_bf16(f[2], f[3]); w.z = cvt_pk_bf16(f[4], f[5]); w.w = cvt_pk_bf16(f[6], f[7]); return w; }
__device__ __forceinline__ float sigmoid_f(float x) { return __builtin_amdgcn_rcpf(1.f + __builtin_amdgcn_exp2f(-1.4426950408889634f * x)); }

struct EpiProj {
    static constexpr bool PERM = true, AFTER_DRAIN = false;
    bf16_t* O; int ldc; int pn_off;
    __device__ __forceinline__ void operator()(const f32x4 (&acc)[2][2][4][2], const Unit& u, int wr, int wc, int fr, int fq) const {
        const int row0 = u.pm * BM + wr * 64 + fr, col0 = u.pn * BM + wc * 32 + 8 * fq;
        const int gpn = u.pn + pn_off; const int act = gpn < 24 ? 0 : (gpn < 28 ? 1 : 2);
#pragma unroll
        for (int ai = 0; ai < 2; ++ai)
#pragma unroll
            for (int m = 0; m < 4; ++m) { bf16_t* rowp = O + (size_t)(row0 + ai * HALF + m * 16) * ldc + col0;
#pragma unroll
                for (int bj = 0; bj < 2; ++bj) { float v[8];
#pragma unroll
                    for (int i = 0; i < 4; ++i) { v[i] = acc[ai][bj][m][0][i]; v[4 + i] = acc[ai][bj][m][1][i]; }
                    if (act != 0) {
#pragma unroll
                        for (int i = 0; i < 8; ++i) { const float s = sigmoid_f(v[i]); v[i] = (act == 1) ? v[i] * s : s; } }
                    *(u32x4*)(rowp + bj * HALF) = pack8f(v); } }
    }
};
struct EpiRowScale {
    static constexpr bool PERM = true, AFTER_DRAIN = false;
    bf16_t* O; int ldc; const float* rowss; float inv_n, eps;
    __device__ __forceinline__ void operator()(const f32x4 (&acc)[2][2][4][2], const Unit& u, int wr, int wc, int fr, int fq) const {
        const int row0 = u.pm * BM + wr * 64 + fr, col0 = u.pn * BM + wc * 32 + 8 * fq;
        float sc[2][4];
#pragma unroll
        for (int ai = 0; ai < 2; ++ai)
#pragma unroll
            for (int m = 0; m < 4; ++m) sc[ai][m] = rowss ? rowss[row0 + ai * HALF + m * 16] : 0.f;
#pragma unroll
        for (int ai = 0; ai < 2; ++ai)
#pragma unroll
            for (int m = 0; m < 4; ++m) { const int row = row0 + ai * HALF + m * 16; bf16_t* rowp = O + (size_t)row * ldc + col0;
                const float s = rowss ? 1.f / sqrtf(sc[ai][m] * inv_n + eps) : 1.f;
#pragma unroll
                for (int bj = 0; bj < 2; ++bj) { float v[8];
#pragma unroll
                    for (int i = 0; i < 4; ++i) { v[i] = acc[ai][bj][m][0][i] * s; v[4 + i] = acc[ai][bj][m][1][i] * s; }
                    *(u32x4*)(rowp + bj * HALF) = pack8f(v); } }
    }
};
template <bool ADD> struct EpiGate {
    static constexpr bool PERM = true, AFTER_DRAIN = false;
    bf16_t* O; int ldc; const bf16_t* Gt; int ldg; unsigned char* O8; int ld8;
    __device__ __forceinline__ void operator()(const f32x4 (&acc)[2][2][4][2], const Unit& u, int wr, int wc, int fr, int fq) const {
        const int row0 = u.pm * BM + wr * 64 + fr, col0 = u.pn * BM + wc * 32 + 8 * fq;
#pragma unroll
        for (int ai = 0; ai < 2; ++ai)
#pragma unroll
            for (int m = 0; m < 4; ++m) { const int row = row0 + ai * HALF + m * 16; bf16_t* rowp = O + (size_t)row * ldc + col0; const bf16_t* gp = Gt + (size_t)row * ldg + col0;
#pragma unroll
                for (int bj = 0; bj < 2; ++bj) { float v[8], g[8]; unpack8(*(const u32x4*)(gp + bj * HALF), g);
#pragma unroll
                    for (int i = 0; i < 4; ++i) { v[i] = acc[ai][bj][m][0][i] * g[i]; v[4 + i] = acc[ai][bj][m][1][i] * g[4 + i]; }
                    if (ADD) { float t[8]; unpack8(*(const u32x4*)(rowp + bj * HALF), t);
#pragma unroll
                        for (int i = 0; i < 8; ++i) v[i] += t[i];
                        int p0 = 0, p1 = 0; p0 = __builtin_amdgcn_cvt_pk_fp8_f32(v[0], v[1], p0, false); p0 = __builtin_amdgcn_cvt_pk_fp8_f32(v[2], v[3], p0, true);
                        p1 = __builtin_amdgcn_cvt_pk_fp8_f32(v[4], v[5], p1, false); p1 = __builtin_amdgcn_cvt_pk_fp8_f32(v[6], v[7], p1, true);
                        if (O8) *(u32x2e*)(O8 + (size_t)row * ld8 + col0 + bj * HALF) = (u32x2e){(unsigned)p0, (unsigned)p1}; else *(u32x4*)(rowp + bj * HALF) = pack8f(v); }
                    else *(u32x4*)(rowp + bj * HALF) = pack8f(v); } }
    }
};
struct EpiGate8 {
    static constexpr bool PERM = true, AFTER_DRAIN = false;
    const bf16_t* G1; int ldg; unsigned char* O8; int ld8;
    __device__ __forceinline__ void operator()(const f32x4 (&acc)[2][2][4][2], const Unit& u, int wr, int wc, int fr, int fq) const {
        const int row0 = u.pm * BM + wr * 64 + fr, col0 = u.pn * BM + wc * 32 + 8 * fq;
        u32x4 ld[2][4][2];
#pragma unroll
        for (int ai = 0; ai < 2; ++ai)
#pragma unroll
            for (int m = 0; m < 4; ++m)
#pragma unroll
                for (int bj = 0; bj < 2; ++bj) ld[ai][m][bj] = *(const u32x4*)(G1 + (size_t)(row0 + ai * HALF + m * 16) * ldg + col0 + bj * HALF);
#pragma unroll
        for (int ai = 0; ai < 2; ++ai)
#pragma unroll
            for (int m = 0; m < 4; ++m) { const int row = row0 + ai * HALF + m * 16;
#pragma unroll
                for (int bj = 0; bj < 2; ++bj) { float v[8], g[8]; unpack8(ld[ai][m][bj], g);
#pragma unroll
                    for (int i = 0; i < 4; ++i) { v[i] = acc[ai][bj][m][0][i] * g[i]; v[4 + i] = acc[ai][bj][m][1][i] * g[4 + i]; }
                    int p0 = 0, p1 = 0; p0 = __builtin_amdgcn_cvt_pk_fp8_f32(v[0], v[1], p0, false); p0 = __builtin_amdgcn_cvt_pk_fp8_f32(v[2], v[3], p0, true);
                    p1 = __builtin_amdgcn_cvt_pk_fp8_f32(v[4], v[5], p1, false); p1 = __builtin_amdgcn_cvt_pk_fp8_f32(v[6], v[7], p1, true);
                    *(u32x2e*)(O8 + (size_t)row * ld8 + col0 + bj * HALF) = (u32x2e){(unsigned)p0, (unsigned)p1}; } }
    }
};
struct EpiResid {
    static constexpr bool PERM = true, AFTER_DRAIN = false;
    const float* base32; const bf16_t* base16; bf16_t* XB; int ldc; float* rowss;
    __device__ __forceinline__ void finish_row(float (&b)[8], const f32x4& a0, const f32x4& a1, float& ss, bf16_t* dst) const {
#pragma unroll
        for (int i = 0; i < 4; ++i) { b[i] += a0[i]; b[4 + i] += a1[i]; }
#pragma unroll
        for (int i = 0; i < 8; ++i) ss += b[i] * b[i];
        *(u32x4*)dst = pack8f(b);
    }
    __device__ __forceinline__ void operator()(const f32x4 (&acc)[2][2][4][2], const Unit& u, int wr, int wc, int fr, int fq) const {
        const int row0 = u.pm * BM + wr * 64 + fr, col0 = u.pn * BM + wc * 32 + 8 * fq;
        if (base32) {
#pragma unroll
            for (int ai = 0; ai < 2; ++ai) { f32x4 ld[4][2][2];
#pragma unroll
                for (int m = 0; m < 4; ++m)
#pragma unroll
                    for (int bj = 0; bj < 2; ++bj) { const float* p = base32 + (size_t)(row0 + ai * HALF + m * 16) * ldc + col0 + bj * HALF;
                        ld[m][bj][0] = __builtin_nontemporal_load((const f32x4*)p); ld[m][bj][1] = __builtin_nontemporal_load((const f32x4*)(p + 4)); }
#pragma unroll
                for (int m = 0; m < 4; ++m) { const int row = row0 + ai * HALF + m * 16; const size_t off = (size_t)row * ldc + col0; float ss = 0.f;
#pragma unroll
                    for (int bj = 0; bj < 2; ++bj) { float b[8] = {ld[m][bj][0][0], ld[m][bj][0][1], ld[m][bj][0][2], ld[m][bj][0][3], ld[m][bj][1][0], ld[m][bj][1][1], ld[m][bj][1][2], ld[m][bj][1][3]};
                        finish_row(b, acc[ai][bj][m][0], acc[ai][bj][m][1], ss, XB + off + bj * HALF); }
                    ss += __shfl_xor(ss, 16); ss += __shfl_xor(ss, 32);
                    if (fq == 0 && rowss) atomicAdd(rowss + row, ss); }
                asm volatile("" ::: "memory"); }
        } else {
            u32x4 ld[2][4][2];
#pragma unroll
            for (int ai = 0; ai < 2; ++ai)
#pragma unroll
                for (int m = 0; m < 4; ++m)
#pragma unroll
                    for (int bj = 0; bj < 2; ++bj) ld[ai][m][bj] = *(const u32x4*)(base16 + (size_t)(row0 + ai * HALF + m * 16) * ldc + col0 + bj * HALF);
#pragma unroll
            for (int ai = 0; ai < 2; ++ai)
#pragma unroll
                for (int m = 0; m < 4; ++m) { const int row = row0 + ai * HALF + m * 16; const size_t off = (size_t)row * ldc + col0; float ss = 0.f;
#pragma unroll
                    for (int bj = 0; bj < 2; ++bj) { float b[8]; unpack8(ld[ai][m][bj], b); finish_row(b, acc[ai][bj][m][0], acc[ai][bj][m][1], ss, XB + off + bj * HALF); }
                    ss += __shfl_xor(ss, 16); ss += __shfl_xor(ss, 32);
                    if (fq == 0 && rowss) atomicAdd(rowss + row, ss); }
        }
    }
};
struct EpiAny {
    static constexpr bool PERM = true, AFTER_DRAIN = false;
    int kind; bf16_t* O; int ldc; const bf16_t* Gt; int ldg; const float* base; const bf16_t* base16; float* rowss; const float* rowss_in; int pn_off; unsigned char* O8; int ld8; const bf16_t* Gt2;
    __device__ __forceinline__ void mid(f32x4 (&acc)[2][2][4][2], const Unit& u, int wr, int wc, int fr, int fq) const {
        const int row0 = u.pm * BM + wr * 64 + fr, col0 = u.pn * BM + wc * 32 + 8 * fq;
#pragma unroll
        for (int ai = 0; ai < 2; ++ai)
#pragma unroll
            for (int m = 0; m < 4; ++m) { const int row = row0 + ai * HALF + m * 16; const bf16_t* g0p = Gt + (size_t)row * ldg + col0; const bf16_t* g1p = Gt2 + (size_t)row * ldg + col0;
#pragma unroll
                for (int bj = 0; bj < 2; ++bj) { float a[8], b[8]; unpack8(*(const u32x4*)(g0p + bj * HALF), a); unpack8(*(const u32x4*)(g1p + bj * HALF), b);
#pragma unroll
                    for (int i = 0; i < 4; ++i) { acc[ai][bj][m][0][i] *= a[i] * __builtin_amdgcn_rcpf(b[i]); acc[ai][bj][m][1][i] *= a[4 + i] * __builtin_amdgcn_rcpf(b[4 + i]); } }
                if (m & 1) asm volatile("" ::: "memory"); }
    }
    __device__ __forceinline__ void operator()(f32x4 (&acc)[2][2][4][2], const Unit& u, int wr, int wc, int fr, int fq) const {
        if (kind == 7 && u.kp == 0) { mid(acc, u, wr, wc, fr, fq); return; }
        if (kind == 0) { EpiProj e{O, ldc, pn_off}; e(acc, u, wr, wc, fr, fq); }
        else if (kind == 1) { EpiRowScale e{O, ldc, rowss_in, 1.f / 2048.f, 1e-6f}; e(acc, u, wr, wc, fr, fq); }
        else if (kind == 2) { EpiGate<false> e{O, ldc, Gt, ldg, nullptr, 0}; e(acc, u, wr, wc, fr, fq); }
        else if (kind == 3) { EpiGate<true> e{O, ldc, Gt, ldg, O8, ld8}; e(acc, u, wr, wc, fr, fq); }
        else if (kind == 6) { EpiGate<true> e{O, ldc, Gt, ldg, nullptr, 0}; e(acc, u, wr, wc, fr, fq); }
        else if (kind == 7) { EpiGate8 e{Gt2, ldg, O8, ld8}; e(acc, u, wr, wc, fr, fq); }
#ifdef PROBE_LO
        else if (kind == 99) {}
#endif
        else { EpiResid e{base, base16, O, ldc, rowss}; e(acc, u, wr, wc, fr, fq); }
    }
};
}
#ifndef ATT_QREG
#define ATT_QREG 1
#endif
namespace att {
using bf16 = unsigned short;
typedef short bf16x8 __attribute__((ext_vector_type(8)));
typedef short s16x4 __attribute__((ext_vector_type(4)));
typedef float f32x16 __attribute__((ext_vector_type(16)));
typedef float f32x4 __attribute__((ext_vector_type(4)));
typedef unsigned u32x4 __attribute__((ext_vector_type(4)));
constexpr int D = 128, NW = 8, QBLK = 32, KVBLK = 64, QB = NW * QBLK;
constexpr int SHM_V = KVBLK * D * 2, SHM_K = KVBLK * D * 2;
constexpr int LDS_WS = 2 * SHM_V + 2 * SHM_K;
constexpr int LDS_BIAS = LDS_WS + NW * 64 * 4;
constexpr int LDS_Q = LDS_BIAS + 2048 * 4;
constexpr int LDS_BYTES = LDS_Q + NW * 8192;
constexpr float THR = 8.f;

#define KSWZ(row, colB) ((row) * 256 + ((colB) ^ (((row) & 7) << 4)))
#define SBAR() __builtin_amdgcn_sched_barrier(0)
__device__ __forceinline__ int v_st(int k, int c) { const int kk = (k & ~0xC) | ((k & 4) << 1) | ((k & 8) >> 1); return ((kk >> 3) * 4 + (c >> 5)) * 512 + ((kk & 7) * 32 + (c & 31)) * 2; }
__device__ __forceinline__ int v_rd_base(int lane) { return ((lane & 3) << 3) | (((lane >> 2) & 3) << 6) | (((lane >> 4) & 1) << 5) | (((lane >> 5) & 1) << 8); }
constexpr int v_rd_off(int d0, int ks, int half) { return d0 * 512 + ks * 4096 + half * 2048; }
__device__ __forceinline__ int crow(int r, int hi) { return (r & 3) + 8 * (r >> 2) + 4 * hi; }
__device__ __forceinline__ unsigned cvtpk(float lo, float hi) { unsigned r; asm volatile("v_cvt_pk_bf16_f32 %0, %1, %2" : "=v"(r) : "v"(lo), "v"(hi)); return r; }
__device__ __forceinline__ bf16x8 load8(const bf16* p) { return *reinterpret_cast<const bf16x8*>(p); }
__device__ __forceinline__ float bf2f(unsigned short b) { return __uint_as_float((unsigned)b << 16); }

__device__ __forceinline__ void mask_tile(f32x16& p0, f32x16& p1, int dq) {
    const float NEG = -__builtin_inff();
#pragma unroll
    for (int r = 0; r < 16; ++r) {
        const int c = (r & 3) + 8 * (r >> 2);
        if (dq - c < 0) p0[r] = NEG;
        if (dq - c - 32 < 0) p1[r] = NEG;
    }
}
__device__ __forceinline__ void partialSM(f32x16& p0, f32x16& p1, float& m_reg, float& mn, float& alpha) {
    float pmax = p0[0]; for (int r = 1; r < 16; ++r) pmax = fmaxf(pmax, p0[r]); for (int r = 0; r < 16; ++r) pmax = fmaxf(pmax, p1[r]);
    { auto rr = __builtin_amdgcn_permlane32_swap(__float_as_uint(pmax), __float_as_uint(pmax), false, false);
      pmax = fmaxf(__uint_as_float(rr[0]), __uint_as_float(rr[1])); }
    if (__builtin_expect(__all((pmax - m_reg) <= THR), 1)) { mn = m_reg; alpha = 1.f; }
    else { mn = fmaxf(m_reg, pmax); alpha = __builtin_amdgcn_exp2f(m_reg - mn); m_reg = mn; }
    for (int r = 0; r < 16; ++r) p0[r] = p0[r] - mn; for (int r = 0; r < 16; ++r) p1[r] = p1[r] - mn;
    for (int r = 0; r < 16; ++r) p0[r] = __builtin_amdgcn_exp2f(p0[r]);
}
#define ATT_PK4(P, B_, OUT) do { unsigned a0 = cvtpk(P[B_+0], P[B_+1]), a1 = cvtpk(P[B_+2], P[B_+3]);                          \
        unsigned b0 = cvtpk(P[B_+4], P[B_+5]), b1 = cvtpk(P[B_+6], P[B_+7]);                                             \
        auto r0 = __builtin_amdgcn_permlane32_swap(a0, b0, false, false); auto r1 = __builtin_amdgcn_permlane32_swap(a1, b1, false, false); \
        u32x4 w = {r0[0], r1[0], r0[1], r1[1]}; OUT = *reinterpret_cast<bf16x8*>(&w); } while (0)
__device__ __forceinline__ void finishSM(f32x16& p0, f32x16& p1, float alpha, float& l_reg, bf16x8& pa0, bf16x8& pa1, bf16x8& pa2, bf16x8& pa3) {
    for (int r = 0; r < 16; ++r) p1[r] = __builtin_amdgcn_exp2f(p1[r]);
    float ps = 0; for (int r = 0; r < 16; ++r) ps += p0[r]; for (int r = 0; r < 16; ++r) ps += p1[r];
    { auto rr = __builtin_amdgcn_permlane32_swap(__float_as_uint(ps), __float_as_uint(ps), false, false);
      ps = __uint_as_float(rr[0]) + __uint_as_float(rr[1]); }
    l_reg = l_reg * alpha + ps;
    ATT_PK4(p0, 0, pa0); ATT_PK4(p0, 8, pa1); ATT_PK4(p1, 0, pa2); ATT_PK4(p1, 8, pa3);
}
__device__ __forceinline__ void ret_weight(f32x16& p0, f32x16& p1, int dq, float lg, int dist) {
    if (dist < 0) { p0 = f32x16{}; p1 = f32x16{}; return; }
    if (dist > 0) { const float f = __builtin_amdgcn_exp2f(lg * 64.f * (float)dist);
#pragma unroll
        for (int r = 0; r < 16; ++r) { p0[r] *= f; p1[r] *= f; }
        return; }
#pragma unroll
    for (int r = 0; r < 16; ++r) {
        const int c = (r & 3) + 8 * (r >> 2);
        const float e0 = 2.f * lg * fmaxf((float)(c - dq), 0.f), e1 = 2.f * lg * fmaxf((float)(c + 32 - dq), 0.f);
        p0[r] *= __builtin_amdgcn_exp2f(e0); p1[r] *= __builtin_amdgcn_exp2f(e1);
    }
}
__device__ __forceinline__ void ret_pack(f32x16& p0, f32x16& p1, bf16x8& pa0, bf16x8& pa1, bf16x8& pa2, bf16x8& pa3) {
    ATT_PK4(p0, 0, pa0); ATT_PK4(p0, 8, pa1); ATT_PK4(p1, 0, pa2); ATT_PK4(p1, 8, pa3);
}
template <int KB, bool BIAS>
__device__ __forceinline__ void qkt(f32x16& p0, f32x16& p1, const char* K_lds, int r32, int hi, const char* Qw  , const float* bias_tile  , const bf16x8* qr = nullptr) {
    if (BIAS) {
#pragma unroll
        for (int g = 0; g < 4; ++g) { const f32x4 b0 = *(const f32x4*)(bias_tile + 8 * g), b1 = *(const f32x4*)(bias_tile + 32 + 8 * g);
            p0[4 * g] = b0[0]; p0[4 * g + 1] = b0[1]; p0[4 * g + 2] = b0[2]; p0[4 * g + 3] = b0[3];
            p1[4 * g] = b1[0]; p1[4 * g + 1] = b1[1]; p1[4 * g + 2] = b1[2]; p1[4 * g + 3] = b1[3]; }
    } else { p0 = f32x16{}; p1 = f32x16{}; }
    int ko[4];
#pragma unroll
    for (int dd = 0; dd < 4; ++dd) ko[dd] = KSWZ(r32, (dd * 16 + hi * 8) * 2);
#pragma unroll
    for (int d0 = 0; d0 < 8; ++d0) { const char* a = K_lds + KB * SHM_K + ko[d0 & 3] + (d0 >> 2) * 128;
        bf16x8 b0 = *reinterpret_cast<const bf16x8*>(a);
        bf16x8 b1 = *reinterpret_cast<const bf16x8*>(a + 32 * 256);
#if ATT_QREG
        bf16x8 q = qr[d0];
#else
        bf16x8 q = *reinterpret_cast<const bf16x8*>(Qw + ko[d0 & 3] + (d0 >> 2) * 128);
#endif
        p0 = __builtin_amdgcn_mfma_f32_32x32x16_bf16(b0, q, p0, 0, 0, 0);
        p1 = __builtin_amdgcn_mfma_f32_32x32x16_bf16(b1, q, p1, 0, 0, 0); }
}
template <int VB>
__device__ __forceinline__ void pv_tile(f32x16* o, int vb0, bf16x8 pa0, bf16x8 pa1, bf16x8 pa2, bf16x8 pa3) {
#define TRRD(dst, off) asm volatile("ds_read_b64_tr_b16 %0, %1 offset:%2" : "=&v"(dst) : "v"(vb0), "i"(off) : "memory")
#define PV_D0(d0) do { s16x4 l0, l1, l2, l3, h0, h1, h2, h3; constexpr int b_ = VB * SHM_V + v_rd_off(d0, 0, 0); \
        TRRD(l0, b_); TRRD(h0, b_ + 2048); TRRD(l1, b_ + 4096); TRRD(h1, b_ + 6144); TRRD(l2, b_ + 8192); TRRD(h2, b_ + 10240); TRRD(l3, b_ + 12288); TRRD(h3, b_ + 14336); \
        asm volatile("s_waitcnt lgkmcnt(0)" ::: "memory"); SBAR();   \
        o[d0] = __builtin_amdgcn_mfma_f32_32x32x16_bf16(pa0, (bf16x8){l0[0], l0[1], l0[2], l0[3], h0[0], h0[1], h0[2], h0[3]}, o[d0], 0, 0, 0);   \
        o[d0] = __builtin_amdgcn_mfma_f32_32x32x16_bf16(pa1, (bf16x8){l1[0], l1[1], l1[2], l1[3], h1[0], h1[1], h1[2], h1[3]}, o[d0], 0, 0, 0);   \
        o[d0] = __builtin_amdgcn_mfma_f32_32x32x16_bf16(pa2, (bf16x8){l2[0], l2[1], l2[2], l2[3], h2[0], h2[1], h2[2], h2[3]}, o[d0], 0, 0, 0);   \
        o[d0] = __builtin_amdgcn_mfma_f32_32x32x16_bf16(pa3, (bf16x8){l3[0], l3[1], l3[2], l3[3], h3[0], h3[1], h3[2], h3[3]}, o[d0], 0, 0, 0); } while (0)
    PV_D0(0); PV_D0(1); PV_D0(2); PV_D0(3);
#undef PV_D0
#undef TRRD
}

struct BlockRef { const bf16* Q; const bf16* K; const bf16* V; bf16* O; int P0; int skv; float lg; const bf16* RG; const float* GN; unsigned char* O8;   };
struct Seam { bf16x8 qr[8]; bf16x8 st_v0, st_v1, st_k0, st_k1; };
template <int MODE> struct Pitch { static constexpr int LDQ = (MODE == 2) ? 512 : 11264, LDK = (MODE == 2) ? 1024 : 11264, LDO = LDQ; };

#define ROWK(p, k0, rr) ((p) + (size_t)((k0) + (rr)) * LDK + sc)
#define VMW() asm volatile("s_waitcnt vmcnt(0)" ::: "memory")
#define VMWN(n) asm volatile("s_waitcnt vmcnt(%0)" :: "i"(n) : "memory")
#define SLOAD_H(Kp, Vp, k0) do { S.st_v0 = load8(ROWK(Vp, k0, sr)); S.st_v1 = load8(ROWK(Vp, k0, 32 + sr));              \
                         S.st_k0 = load8(ROWK(Kp, k0, sr)); S.st_k1 = load8(ROWK(Kp, k0, 32 + sr)); } while (0)
#define SWRITE_HK(bf) do { *(bf16x8*)(K_lds + (bf) * SHM_K + kws) = S.st_k0; *(bf16x8*)(K_lds + (bf) * SHM_K + kws + 32 * 256) = S.st_k1; } while (0)
#define SWRITE_HV(bf) do { *(bf16x8*)(V_lds + (bf) * SHM_V + vst0) = S.st_v0; *(bf16x8*)(V_lds + (bf) * SHM_V + vst1) = S.st_v1; } while (0)
#define SWRITE_H(bf) do { SWRITE_HV(bf); SWRITE_HK(bf); } while (0)

template <int MODE>
__device__ __forceinline__ void attn_prime(const BlockRef& cur, char* lds, Seam& S) {
    constexpr int LDQ = Pitch<MODE>::LDQ, LDK = Pitch<MODE>::LDK;
    int tid_ = threadIdx.x; asm volatile("" : "+v"(tid_));
    const int tid = tid_, wid = __builtin_amdgcn_readfirstlane(tid >> 6), lane = tid & 63, r32 = lane & 31, hi = lane >> 5;
    const int sr = tid >> 4, sc = (tid & 15) * 8, kws = KSWZ(sr, sc * 2); char* K_lds = lds + 2 * SHM_V;
    const int kb0 = 0;
    for (int d0 = 0; d0 < 8; ++d0) S.qr[d0] = load8(cur.Q + (size_t)(wid * QBLK + r32) * LDQ + d0 * 16 + hi * 8);
    SLOAD_H(cur.K, cur.V, kb0); VMW(); SWRITE_HK(0);
    __syncthreads();
}
template <int MODE>
__device__ __forceinline__ void attn_block(const BlockRef& cur, const BlockRef& nxt, char* lds, Seam& S) {
    constexpr int LDQ = Pitch<MODE>::LDQ, LDK = Pitch<MODE>::LDK, LDO = Pitch<MODE>::LDO;
    constexpr bool BIAS = (MODE == 0), SOFTMAX = (MODE != 1);
    int tid_ = threadIdx.x; asm volatile("" : "+v"(tid_));
    const int tid = tid_, wid = __builtin_amdgcn_readfirstlane(tid >> 6), lane = tid & 63, r32 = lane & 31, hi = lane >> 5;
    const int j_lo = 0;
    int j_hi = (cur.P0 + QB - 1) / KVBLK + 1; if (j_hi > cur.skv / KVBLK) j_hi = cur.skv / KVBLK;
    const int NT = j_hi - j_lo;
    const int kbn = 0;
    const int qlo = cur.P0 + wid * QBLK, qm = qlo + r32 - 4 * hi;
    char* V_lds = lds; char* K_lds = lds + 2 * SHM_V;
    float* ws = (float*)(lds + LDS_WS) + wid * 64; float* li_l = ws, * al_l = ws + 32;
    const float* bias = (const float*)(lds + LDS_BIAS) + 4 * hi;
    float m_reg = -1e30f, l_reg = 0; f32x16 o[4] = {};
    const int sr = tid >> 4, sc = (tid & 15) * 8, vst0 = v_st(sr, sc), vst1 = v_st(32 + sr, sc), kws = KSWZ(sr, sc * 2);
    const int vb0 = (int)(uintptr_t)V_lds + v_rd_base(lane);
    const bf16* Kh = cur.K; const bf16* Vh = cur.V;
    const float lg = cur.lg; const int cq = qlo >> 6;
#define RESC(a) do { if (SOFTMAX) { if (__any((a) < 1.f)) { if (hi == 0) al_l[r32] = (a); asm volatile("s_waitcnt lgkmcnt(0)" ::: "memory");              \
                     for (int d_ = 0; d_ < 4; ++d_) for (int r = 0; r < 16; ++r) o[d_][r] *= al_l[crow(r, hi)]; } } } while (0)
#define KBASE(t) ((j_lo + (t)) * KVBLK)
#define POSTQK(P0_, P1_, mnX, alX, t) do { const int kb_ = KBASE(t); \
        if (MODE == 1) { ret_weight(P0_, P1_, qm - kb_, lg, cq - (j_lo + (t))); } \
        else { if (MODE == 0 && (kb_ + KVBLK - 1 > qlo)) mask_tile(P0_, P1_, qm - kb_); partialSM(P0_, P1_, m_reg, mnX, alX); } } while (0)
#define FINISH(P0_, P1_, alX) do { if (MODE == 1) ret_pack(P0_, P1_, pa0, pa1, pa2, pa3); else finishSM(P0_, P1_, alX, l_reg, pa0, pa1, pa2, pa3); } while (0)
    constexpr int NQL = 8;
#define SEAM_K0() do { VMWN(NQL); SWRITE_HK(0); SBAR(); } while (0)
    f32x16 pA0, pA1, pB0, pB1; float mnA = 0.f, mnB = 0.f, alA = 1.f, alB = 1.f; bf16x8 pa0, pa1, pa2, pa3;
    char* Qw = lds + LDS_Q + wid * 8192;
#if ATT_QREG
    const bf16x8* QR = S.qr;
#else
    const bf16x8* QR = nullptr;
#pragma unroll
    for (int d0 = 0; d0 < 8; ++d0) *(bf16x8*)(Qw + KSWZ(r32, (d0 * 16 + hi * 8) * 2)) = S.qr[d0];
#endif
    SWRITE_HV(0); SBAR();
    if (NT > 1) { SLOAD_H(Kh, Vh, KBASE(1)); }
    SBAR(); qkt<0, BIAS>(pA0, pA1, K_lds, r32, hi, Qw, bias + KBASE(0), QR);
    POSTQK(pA0, pA1, mnA, alA, 0);
    if (NT > 1) { VMW(); SWRITE_H(1); }
    __syncthreads();
#define HALF_STEP(PX0, PX1, mnX, alX, PY0, PY1, alY, t, KB, VB, SB) do {                                                      \
        SBAR(); qkt<KB, BIAS>(PX0, PX1, K_lds, r32, hi, Qw, bias + KBASE(t), QR);                                             \
        FINISH(PY0, PY1, alY); SBAR();                                                           \
        if ((t) + 1 < NT) { SLOAD_H(Kh, Vh, KBASE((t) + 1)); SBAR(); }                                               \
        pv_tile<VB>(o, vb0, pa0, pa1, pa2, pa3); POSTQK(PX0, PX1, mnX, alX, (t));                                        \
        __syncthreads();                                                                                                      \
        if ((t) + 1 < NT) { VMW(); SWRITE_H(SB); }                                                                          \
        RESC(alX); __syncthreads(); } while (0)
    for (int t = 1; t + 1 < NT; t += 2) {
        HALF_STEP(pB0, pB1, mnB, alB, pA0, pA1, alA, t, 1, 0, 0);
        HALF_STEP(pA0, pA1, mnA, alA, pB0, pB1, alB, t + 1, 0, 1, 1);
    }
    const bool even = (NT & 1) == 0;
    if (even) { SBAR(); qkt<1, BIAS>(pB0, pB1, K_lds, r32, hi, Qw, bias + KBASE(NT - 1), QR); SBAR(); }
    { constexpr int LDQn = LDQ; SLOAD_H(nxt.K, nxt.V, kbn); SBAR();
#pragma unroll
      for (int d0 = 0; d0 < 8; ++d0) S.qr[d0] = load8(nxt.Q + (size_t)(wid * QBLK + r32) * LDQn + d0 * 16 + hi * 8); }
    SBAR();
    FINISH(pA0, pA1, alA); SBAR();
    pv_tile<0>(o, vb0, pa0, pa1, pa2, pa3);
    if (even) { POSTQK(pB0, pB1, mnB, alB, NT - 1); __syncthreads(); RESC(alB);
        FINISH(pB0, pB1, alB); SBAR(); pv_tile<1>(o, vb0, pa0, pa1, pa2, pa3); }
    SBAR(); SEAM_K0();
    bf16* Ow = cur.O + (size_t)(wid * QBLK) * LDO;
    if (MODE != 1) {
        if (hi == 0) li_l[r32] = l_reg; asm volatile("s_waitcnt lgkmcnt(0)" ::: "memory");
        float rli[16];
#pragma unroll
        for (int r = 0; r < 16; ++r) rli[r] = __builtin_amdgcn_rcpf(li_l[crow(r, hi)]);
#pragma unroll
        for (int r = 0; r < 16; ++r) { const int orow = crow(r, hi);
#pragma unroll
            for (int d0 = 0; d0 < 4; ++d0) { const float v = o[d0][r] * rli[r];
                const float vn = __shfl_xor(v, 1);
                if (cur.O8) { const int pk = __builtin_amdgcn_cvt_pk_fp8_f32(v, vn, 0, false); const int pk2 = __shfl_xor(pk, 2);
                    if ((r32 & 3) == 0) *(unsigned*)(cur.O8 + (size_t)(wid * QBLK + orow) * (MODE == 2 ? 512 : 2048) + d0 * 32 + r32) = ((unsigned)pk & 0xFFFFu) | ((unsigned)pk2 << 16); }
                else if ((r32 & 1) == 0) *(unsigned*)(Ow + (size_t)orow * LDO + d0 * 32 + r32) = cvtpk(v, vn); } }
    } else {
        float gn[4];
#pragma unroll
        for (int d0 = 0; d0 < 4; ++d0) gn[d0] = cur.GN[d0 * 32 + r32];
        const bf16* RGw = cur.RG + (size_t)(wid * QBLK) * LDO;
#pragma unroll
        for (int r = 0; r < 16; ++r) { const int orow = crow(r, hi);
            float s = (o[0][r] + o[1][r]) + (o[2][r] + o[3][r]);
#pragma unroll
            for (int x = 1; x < 32; x <<= 1) s += __shfl_xor(s, x);
            const float mean = s * (1.f / 128.f);
            float q = 0.f;
#pragma unroll
            for (int d0 = 0; d0 < 4; ++d0) { const float dlt = o[d0][r] - mean; q += dlt * dlt; }
#pragma unroll
            for (int x = 1; x < 32; x <<= 1) q += __shfl_xor(q, x);
            const float rstd = 1.f / sqrtf(q * (1.f / 128.f) + 1e-6f);
#pragma unroll
            for (int d0 = 0; d0 < 4; ++d0) { const float g = bf2f(RGw[(size_t)orow * LDO + d0 * 32 + r32]);
                const float v = (o[d0][r] - mean) * rstd * gn[d0] * g;
                const float vn = __shfl_xor(v, 1);
                if (cur.O8) { const int pk = __builtin_amdgcn_cvt_pk_fp8_f32(v, vn, 0, false); const int pk2 = __shfl_xor(pk, 2);
                    if ((r32 & 3) == 0) *(unsigned*)(cur.O8 + (size_t)(wid * QBLK + orow) * 2048 + d0 * 32 + r32) = ((unsigned)pk & 0xFFFFu) | ((unsigned)pk2 << 16); }
                else if ((r32 & 1) == 0) *(unsigned*)(Ow + (size_t)orow * LDO + d0 * 32 + r32) = cvtpk(v, vn); } }
    }
    __syncthreads();
#undef RESC
#undef KBASE
#undef POSTQK
#undef FINISH
#undef SEAM_K0
#undef HALF_STEP
}
#undef ROWK
#undef VMW
#undef VMWN
#undef SLOAD_H
#undef SWRITE_HK
#undef SWRITE_HV
#undef SWRITE_H
#undef SBAR
#undef KSWZ
#undef ATT_PK4
}
#define GAS __attribute__((address_space(1)))
#define LAS __attribute__((address_space(3)))
typedef unsigned short bf16;
typedef unsigned v4u __attribute__((ext_vector_type(4)));
typedef float f32x4 __attribute__((ext_vector_type(4)));
typedef short bf16x8 __attribute__((ext_vector_type(8)));
typedef GAS unsigned gu32;
typedef GAS unsigned long long gu64;
#define RLX_AGENT __ATOMIC_RELAXED, __HIP_MEMORY_SCOPE_AGENT
#define LDS_WAIT() asm volatile("s_waitcnt lgkmcnt(0)" ::: "memory")
#define VM_WAIT() asm volatile("s_waitcnt vmcnt(0)" ::: "memory")
__device__ __forceinline__ unsigned long long rt() { return __builtin_amdgcn_s_memrealtime(); }
__device__ __forceinline__ unsigned f2bf(float f) { unsigned u = __builtin_bit_cast(unsigned, f); return (u + 0x7fffu + ((u >> 16) & 1u)) >> 16; }
__device__ __forceinline__ unsigned pk2(float lo, float hi) { return f2bf(lo) | (f2bf(hi) << 16); }

#define XB_TMO      128
#define XB_XCNT(j)  (256  + 64 * (j))
#define XB_XSUB(j)  (1280 + 64 * (j))
#define XB_XGEN(j)  (2304 + 64 * (j))
#define XB_TOP      3328
#define XB_TOPGEN   3392
#define XCD_BAR_WORDS 3456
#define XB_SPIN_CAP (1u << 18)

__device__ __forceinline__ unsigned xb_ld(unsigned* p)              { return __hip_atomic_load(p, __ATOMIC_RELAXED, __HIP_MEMORY_SCOPE_AGENT); }
__device__ __forceinline__ unsigned xb_add(unsigned* p, unsigned v) { return __hip_atomic_fetch_add(p, v, __ATOMIC_RELAXED, __HIP_MEMORY_SCOPE_AGENT); }
__device__ __forceinline__ unsigned xb_xcc_id() { return (unsigned)__builtin_amdgcn_s_getreg((3 << 11) | 20) & 0xFu; }
#define XB_SPIN(cond, bar) do { unsigned _sp = 0; while (cond) { __builtin_amdgcn_s_sleep(1); \
    if ((++_sp & 255u) == 0u) { if (xb_ld(&(bar)[XB_TMO])) break; if (_sp > XB_SPIN_CAP) { atomicAdd(&(bar)[XB_TMO], 1u); break; } } } } while (0)

struct XcdBarrier {
    unsigned* bar; unsigned x;
    volatile LAS unsigned* st;
};

__device__ __forceinline__ XcdBarrier xcd_barrier_post(unsigned* bar, volatile LAS unsigned* st) {
    XcdBarrier b; b.bar = bar; b.x = xb_xcc_id(); b.st = st;
    if (threadIdx.x == 0) (void)xb_add(&bar[XB_XCNT(b.x)], 1u);
    return b;
}
__device__ __forceinline__ void xcd_barrier_complete(unsigned* bar, unsigned x, unsigned& nloc, unsigned& nx) {
    const unsigned G = gridDim.x * gridDim.y * gridDim.z;
    unsigned sum, cnt, mine, sp = 0u;
    for (;;) {
        sum = 0u; cnt = 0u; mine = 0u;
#pragma unroll
        for (unsigned j = 0; j < 16; ++j) { const unsigned c = xb_ld(&bar[XB_XCNT(j)]); sum += c; cnt += (c > 0u) ? 1u : 0u; mine = (j == x) ? c : mine; }
        if (sum == G) break;
        __builtin_amdgcn_s_sleep(1);
        if ((++sp & 255u) == 0u) { if (xb_ld(&bar[XB_TMO])) break; if (sp > XB_SPIN_CAP) { atomicAdd(&bar[XB_TMO], 1u); break; } }
    }
    nloc = mine > 0u ? mine : 1u; nx = cnt > 0u ? cnt : 1u;
}

__device__ __forceinline__ void xcd_barrier(const XcdBarrier& b) {
    asm volatile("s_waitcnt vmcnt(0)" ::: "memory");
    __syncthreads();
    if (threadIdx.x == 0) {
        unsigned* bar = b.bar;
        __builtin_amdgcn_s_waitcnt(0);
        unsigned nloc = b.st[0], nx = b.st[1];
        if (nloc == 0u) { xcd_barrier_complete(bar, b.x, nloc, nx); b.st[0] = nloc; b.st[1] = nx; }
        const unsigned old = xb_add(&bar[XB_XSUB(b.x)], 1u);
        const unsigned gen = old / nloc;
        if (old + 1u == (gen + 1u) * nloc) {
            __builtin_amdgcn_fence(__ATOMIC_RELEASE, "agent");
            asm volatile("s_waitcnt vmcnt(0)" ::: "memory");
            const unsigned og = xb_add(&bar[XB_TOP], 1u);
            const unsigned tg = og / nx;
            if (og + 1u == (tg + 1u) * nx) xb_add(&bar[XB_TOPGEN], 1u);
            else XB_SPIN(xb_ld(&bar[XB_TOPGEN]) == tg, bar);
            __builtin_amdgcn_fence(__ATOMIC_ACQUIRE, "agent");
            xb_add(&bar[XB_XGEN(b.x)], 1u);
            asm volatile("s_waitcnt vmcnt(0)" ::: "memory");
        } else {
            XB_SPIN(xb_ld(&bar[XB_XGEN(b.x)]) == gen, bar);
            __builtin_amdgcn_fence(__ATOMIC_ACQUIRE, "agent");
            asm volatile("s_waitcnt vmcnt(0)" ::: "memory");
        }
    }
    __syncthreads();
}
constexpr int NWAVES = 8;
constexpr int M_TOK = 16384, DM = 2048, SEQ = 2048, NB = 8;
constexpr int PP = 11264;
constexpr int C_RQ = 0, C_RK = 1024, C_FQ = 2048, C_FK = 3072, C_FV = 4096, C_RV = 5120, C_RG = 6144, C_G0 = 7168, C_G1 = 9216;
constexpr int N_QK = 2048, N_REST = 9216;
#ifndef FP8_UP_OUT
#define FP8_UP_OUT 1
#endif
constexpr int W8_SCALE_B = 0x79797979;
constexpr int N_IN_ORIG = 11272;
constexpr float RMS_EPS = 1e-6f;
constexpr float QK_C2 = 0.08838834764831845f * 1.4426950408889634f;
constexpr size_t MiB = 1u << 20;
constexpr size_t DO_XN8 = 0, DO_OCAT8 = 32 * MiB;
constexpr size_t DO_OFOX8 = DO_OCAT8, DO_ORET8 = DO_OCAT8 + 1024;
constexpr size_t WS_CTL = 0, CTL_ZERO_BYTES = 1 * MiB;
constexpr size_t WS_ROWSS1 = 256 * 1024, WS_ROWSS2 = 512 * 1024;
constexpr size_t WS_WIN = 1 * MiB, WS_WFOX = 45 * MiB, WS_WRET = 49 * MiB, WS_WOUT = 53 * MiB, WS_WMQ = 61 * MiB, WS_WMKV = 63 * MiB, WS_WMO = 67 * MiB, WS_WPQ = 69 * MiB, WS_SUBK = 77 * MiB;
constexpr size_t WS_PSCALE = 79 * MiB;
constexpr size_t WS_LOGF = 78 * MiB, WS_CUMF = 78 * MiB + 512 * 1024;
constexpr size_t WS_XN = 80 * MiB;
constexpr size_t WS_PROJ = 144 * MiB;
constexpr size_t WS_MN = 496 * MiB, WS_KVM = 504 * MiB, WS_END = 508 * MiB;
constexpr size_t WS_XB1B = 144 * MiB;
constexpr size_t WS_XB2 = FP8_UP_OUT ? WS_XB1B : WS_XN;
constexpr size_t WS_XB1 = FP8_UP_OUT ? WS_XN   : WS_XB1B, WS_QM = 208 * MiB, WS_OMEM = 224 * MiB, WS_PU = 240 * MiB, WS_PV = 304 * MiB, WS_QP = (FP8_UP_OUT ? 368 : 144) * MiB  , WS_IDX = 208 * MiB, WS_GATE = 216 * MiB;
constexpr int CW_BAR = 4096, CW_CONV = 64;
constexpr int RING_BYTES = 131072, LDS_BYTES = 147456, LDSCTL_OFF = LDS_BYTES - 1024, MISC_OFF = LDSCTL_OFF + 320;
static_assert(att::LDS_BYTES <= LDSCTL_OFF, "attention LDS");

struct Args { const float* in[23]; float* out; unsigned char* ws; int ph_lo, ph_hi; int p0_mask, pad; };
enum { I_X = 0, I_MEM, I_LN_MIX, I_W_IN, I_B_FORGET, I_FOXQ_G, I_FOXK_G, I_RET_G, I_W_FOXUP, I_W_RETUP, I_W_OUT, I_LN_MEM, I_MEMNORM_G, I_W_MQ, I_W_MKV, I_MEMQ_G, I_MEMK_G, I_W_MO, I_LN_FFN, I_W_PQ, I_SUBK, I_PEER_U, I_PEER_V };

#ifdef NO_NT
#define LDNT(p) (*(p))
#else
#define LDNT(p) __builtin_nontemporal_load(p)
#endif
__device__ __forceinline__ float wave_sum(float v) {
#pragma unroll
    for (int o = 1; o < 64; o <<= 1) v += __shfl_xor(v, o);
    return v;
}
__device__ __forceinline__ void transpose_item(const float* W, int ldw, int K, int src_col0, const float* kgain, bf16* WT, int dst_row0, LAS float* scr, int kb, int nb, int lane) {
    const int k0 = 64 * kb, n0 = 32 * nb;
    f32x4 ld[8];
#pragma unroll
    for (int i = 0; i < 8; ++i) ld[i] = LDNT((const GAS f32x4*)(W + (size_t)(k0 + 8 * i + (lane >> 3)) * ldw + src_col0 + n0 + 4 * (lane & 7)));
#pragma unroll
    for (int i = 0; i < 8; ++i) { const int kk = 8 * i + (lane >> 3); f32x4 v = ld[i]; if (kgain) v = v * kgain[k0 + kk]; LAS float* d = scr + kk * 33 + 4 * (lane & 7); d[0] = v.x; d[1] = v.y; d[2] = v.z; d[3] = v.w; }
    LDS_WAIT(); asm volatile("" ::: "memory");
    const int c = lane & 7;
#pragma unroll
    for (int j = 0; j < 4; ++j) { const int n = (lane >> 3) + 8 * j; const LAS float* s = scr + (8 * c) * 33 + n;
        v4u o; o.x = pk2(s[0 * 33], s[1 * 33]); o.y = pk2(s[2 * 33], s[3 * 33]); o.z = pk2(s[4 * 33], s[5 * 33]); o.w = pk2(s[6 * 33], s[7 * 33]);
        *(GAS v4u*)(WT + (size_t)(dst_row0 + n0 + n) * K + k0 + 8 * c) = o; }
    LDS_WAIT(); asm volatile("" ::: "memory");
}
__device__ __forceinline__ void transpose_item8(const float* W, int ldw, int K  , int src_col0, unsigned char* WT8  , int kb, int nb, LAS float* scr, int lane) {
    const int k0 = 64 * kb, n0 = 32 * nb;
    f32x4 ld[8];
#pragma unroll
    for (int i = 0; i < 8; ++i) ld[i] = LDNT((const GAS f32x4*)(W + (size_t)(k0 + 8 * i + (lane >> 3)) * ldw + src_col0 + n0 + 4 * (lane & 7)));
#pragma unroll
    for (int i = 0; i < 8; ++i) { const int kk = 8 * i + (lane >> 3); const f32x4 v = ld[i] * 64.f; LAS float* d = scr + kk * 33 + 4 * (lane & 7); d[0] = v.x; d[1] = v.y; d[2] = v.z; d[3] = v.w; }
    LDS_WAIT(); asm volatile("" ::: "memory");
    const int c = lane & 7;
#pragma unroll
    for (int j = 0; j < 4; ++j) { const int n = (lane >> 3) + 8 * j; const LAS float* s = scr + (8 * c) * 33 + n;
        int p0 = 0, p1 = 0; p0 = __builtin_amdgcn_cvt_pk_fp8_f32(s[0 * 33], s[1 * 33], p0, false); p0 = __builtin_amdgcn_cvt_pk_fp8_f32(s[2 * 33], s[3 * 33], p0, true);
        p1 = __builtin_amdgcn_cvt_pk_fp8_f32(s[4 * 33], s[5 * 33], p1, false); p1 = __builtin_amdgcn_cvt_pk_fp8_f32(s[6 * 33], s[7 * 33], p1, true);
        *(GAS unsigned long long*)(WT8 + (size_t)(n0 + n) * K + k0 + 8 * c) = (unsigned long long)(unsigned)p0 | ((unsigned long long)(unsigned)p1 << 32); }
    LDS_WAIT(); asm volatile("" ::: "memory");
}
struct TJob { const float* W; int ldw, K, N; const float* gain; bf16* WT; int fp8; };

__device__ __forceinline__ void rms_row_to_bf16(const float* xrow, const float* gain, bf16* orow, int lane, f32x4 (&hv)[8], unsigned char* orow8 = nullptr) {
    const GAS f32x4* xr = (const GAS f32x4*)xrow + lane; float s = 0.f;
#pragma unroll
    for (int j = 0; j < 8; ++j) { hv[j] = LDNT(xr + 64 * j); s += (hv[j].x * hv[j].x + hv[j].y * hv[j].y) + (hv[j].z * hv[j].z + hv[j].w * hv[j].w); }
    const float r = 1.f / sqrtf(wave_sum(s) * (1.f / DM) + RMS_EPS);
    GAS unsigned long long* o8 = (GAS unsigned long long*)orow + lane;
#pragma unroll
    for (int j = 0; j < 8; ++j) { const f32x4 g = ((const GAS f32x4*)gain)[lane + 64 * j]; hv[j] = hv[j] * r * g;
        o8[64 * j] = (unsigned long long)pk2(hv[j].x, hv[j].y) | ((unsigned long long)pk2(hv[j].z, hv[j].w) << 32);
        if (orow8) { int p = 0; p = __builtin_amdgcn_cvt_pk_fp8_f32(hv[j].x, hv[j].y, p, false); p = __builtin_amdgcn_cvt_pk_fp8_f32(hv[j].z, hv[j].w, p, true); ((GAS unsigned*)orow8)[lane + 64 * j] = (unsigned)p; } }
}
__device__ __forceinline__ float log_sigmoid_f(float z) { return fminf(z, 0.f) - 0.6931471805599453f * __builtin_amdgcn_logf(1.f + __builtin_amdgcn_exp2f(-1.4426950408889634f * fabsf(z))); }

struct Frame { LAS unsigned char* lds; unsigned char* ldsg; int tid, lane, wave, G, bx, p0_mask; const float* const* in; float* out; unsigned char* ws; };

__device__ __forceinline__ void p0_prologue(Frame& F) {
    const int gw = F.bx * NWAVES + F.wave, NGW = F.G * NWAVES;
    if (F.p0_mask & 1) {
        LAS float* scr = (LAS float*)(F.lds + F.wave * 16384);
        const TJob jobs[9] = {
            {F.in[I_W_IN], N_IN_ORIG, 2048, N_QK, nullptr, (bf16*)(F.ws + WS_WIN), 0},
            {F.in[I_W_IN], N_IN_ORIG, 2048, N_REST, nullptr, (bf16*)(F.ws + WS_WIN + 16 * MiB), 1},
            {F.in[I_W_FOXUP], 2048, 1024, 2048, nullptr, (bf16*)(F.ws + WS_WFOX), FP8_UP_OUT},
            {F.in[I_W_RETUP], 2048, 1024, 2048, nullptr, (bf16*)(F.ws + (FP8_UP_OUT ? WS_WFOX + 1024 : WS_WRET)), FP8_UP_OUT},
            {F.in[I_W_OUT], 2048, 2048, 2048, nullptr, (bf16*)(F.ws + WS_WOUT), FP8_UP_OUT},
            {F.in[I_W_MQ], 512, 2048, 512, F.in[I_LN_MEM], (bf16*)(F.ws + WS_WMQ), 0},
            {F.in[I_W_MKV], 1024, 2048, 1024, nullptr, (bf16*)(F.ws + WS_WMKV), 0},
            {F.in[I_W_MO], 2048, 512, 2048, nullptr, (bf16*)(F.ws + WS_WMO), 1},
            {F.in[I_W_PQ], 2048, 2048, 2048, F.in[I_LN_FFN], (bf16*)(F.ws + WS_WPQ), 0} };
        int base = 0;
#pragma unroll
        for (int j = 0; j < 9; ++j) {
            const TJob& J = jobs[j]; const int nblk = J.N / 32, items = (J.K / 64) * nblk;
            int first = gw - (base % NGW); if (first < 0) first += NGW;
            for (int r = first; r < items; r += NGW) { const int kb = r / nblk, nb = r % nblk;
                int src_col0 = 0;
                if (j == 0) src_col0 = 3080;
                if (j == 1) src_col0 = (nb * 32 < 3072) ? 0 : 2056;
                if (J.fp8) transpose_item8(J.W, J.ldw, (FP8_UP_OUT && (j == 2 || j == 3)) ? 2048 : J.K, src_col0, (unsigned char*)J.WT, kb, nb, scr, F.lane);
                else transpose_item(J.W, J.ldw, J.K, src_col0, J.gain, J.WT, 0, scr, kb, nb, F.lane); }
            base += items;
        }
    }
    if (F.p0_mask & 1) {
        const float* sk = F.in[I_SUBK]; bf16* o = (bf16*)(F.ws + WS_SUBK);
        for (int i = (F.bx * 512 + F.tid) * 4; i < 16 * 128 * 128; i += F.G * 512 * 4) { const f32x4 v = *(const GAS f32x4*)(sk + i);
            *(GAS unsigned long long*)(o + i) = (unsigned long long)pk2(v.x, v.y) | ((unsigned long long)pk2(v.z, v.w) << 32); }
    }
    __syncthreads();
    if (F.p0_mask & 2) {
        LAS float* wf = (LAS float*)F.lds; const float* w = F.in[I_W_IN];
        for (int k = F.tid; k < 2048; k += 512) { const f32x4 a = *(const GAS f32x4*)(w + (size_t)k * N_IN_ORIG + 3072), b = *(const GAS f32x4*)(w + (size_t)k * N_IN_ORIG + 3076);
            wf[0 * 2048 + k] = a.x; wf[1 * 2048 + k] = a.y; wf[2 * 2048 + k] = a.z; wf[3 * 2048 + k] = a.w; wf[4 * 2048 + k] = b.x; wf[5 * 2048 + k] = b.y; wf[6 * 2048 + k] = b.z; wf[7 * 2048 + k] = b.w; }
    }
    __syncthreads();
    if (F.p0_mask & 2) {
        const LAS float* wf = (const LAS float*)F.lds; const float* bfg = F.in[I_B_FORGET]; float* logf_o = (float*)(F.ws + WS_LOGF);
        for (int m = gw; m < M_TOK; m += NGW) { f32x4 hv[8];
            rms_row_to_bf16(F.in[I_X] + (size_t)m * DM, F.in[I_LN_MIX], (bf16*)(F.ws + WS_XN) + (size_t)m * DM, F.lane, hv, (unsigned char*)F.out + DO_XN8 + (size_t)m * DM);
            float z = 0.f;
#pragma unroll
            for (int q = 0; q < 8; ++q) { float acc = 0.f;
#pragma unroll
                for (int j = 0; j < 8; ++j) { const f32x4 wv = *(const LAS f32x4*)(wf + q * 2048 + 4 * F.lane + 256 * j); acc += (hv[j].x * wv.x + hv[j].y * wv.y) + (hv[j].z * wv.z + hv[j].w * wv.w); }
                acc = wave_sum(acc); z = (F.lane == q) ? acc : z;
                __builtin_amdgcn_sched_barrier(0); }
            if (F.lane < 8) logf_o[(size_t)m * 8 + F.lane] = log_sigmoid_f(z + bfg[F.lane]);
        }
        for (int m = gw; m < NB * 256; m += NGW) { f32x4 hv[8]; rms_row_to_bf16(F.in[I_MEM] + (size_t)m * DM, F.in[I_MEMNORM_G], (bf16*)(F.ws + WS_MN) + (size_t)m * DM, F.lane, hv); }
    }
}
__device__ __forceinline__ void p1_scan(Frame& F) {
    if (F.bx < 64) {
        const int b = F.bx >> 3, h = F.bx & 7; const float* lf = (const float*)(F.ws + WS_LOGF); float* cf = (float*)(F.ws + WS_CUMF) + (size_t)F.bx * SEQ;
        float v[4]; float run = 0.f;
#pragma unroll
        for (int i = 0; i < 4; ++i) { run += lf[(size_t)(b * SEQ + F.tid * 4 + i) * 8 + h]; v[i] = run; }
        float incl = run;
#pragma unroll
        for (int o = 1; o < 64; o <<= 1) { const float t = __shfl_up(incl, o); if (F.lane >= o) incl += t; }
        LAS float* wt = (LAS float*)F.lds;
        if (F.lane == 63) wt[F.wave] = incl;
        __syncthreads();
        float off = incl - run;
        for (int w = 0; w < F.wave; ++w) off += wt[w];
#pragma unroll
        for (int i = 0; i < 4; ++i) cf[F.tid * 4 + i] = v[i] + off;
    }
    __syncthreads();
}
__device__ __forceinline__ void unpack8s(const att::bf16x8 v, float (&f)[8]) {
#pragma unroll
    for (int i = 0; i < 8; ++i) f[i] = __uint_as_float((unsigned)(unsigned short)v[i] << 16);
}
__device__ __forceinline__ att::bf16x8 pack8s(const float (&f)[8]) { v4u w; w.x = pg8::cvt_pk_bf16(f[0], f[1]); w.y = pg8::cvt_pk_bf16(f[2], f[3]); w.z = pg8::cvt_pk_bf16(f[4], f[5]); w.w = pg8::cvt_pk_bf16(f[6], f[7]); return __builtin_bit_cast(att::bf16x8, w); }
__device__ __forceinline__ void p4_attention(Frame& F) {
    char* lds = (char*)F.ldsg;
    const int xcd = F.bx & 7, kk = F.bx >> 3;
    const int bh = (kk >> 2) * 8 + xcd, x = kk & 3, b = bh >> 3, h = bh & 7;
    if (bh >= 64) return;
    const att::bf16* proj = (const att::bf16*)(F.ws + WS_PROJ);
    const size_t rowb = (size_t)b * SEQ;
    if (F.p0_mask & 1) {
        float* tbl = (float*)(lds + att::LDS_BIAS); const float* cf = (const float*)(F.ws + WS_CUMF) + (size_t)bh * SEQ;
        const f32x4 v = *(const f32x4*)(cf + F.tid * 4); *(f32x4*)(tbl + F.tid * 4) = v * (-1.4426950408889634f);
        att::BlockRef r0, r1;
        r0.Q = proj + (rowb + (size_t)x * 256) * PP + C_FQ + h * 128; r0.K = proj + rowb * PP + C_FK + h * 128; r0.V = proj + rowb * PP + C_FV + h * 128; r0.O = (att::bf16*)r0.Q;
        r0.P0 = x * 256; r0.skv = SEQ; r0.lg = 0.f; r0.RG = nullptr; r0.GN = nullptr; r0.O8 = FP8_UP_OUT ? (unsigned char*)F.out + DO_OFOX8 + (rowb + (size_t)x * 256) * 2048 + h * 128 : nullptr;
        r1 = r0; r1.Q = proj + (rowb + (size_t)(7 - x) * 256) * PP + C_FQ + h * 128; r1.O = (att::bf16*)r1.Q; r1.P0 = (7 - x) * 256; r1.O8 = FP8_UP_OUT ? (unsigned char*)F.out + DO_OFOX8 + (rowb + (size_t)(7 - x) * 256) * 2048 + h * 128 : nullptr;
        att::Seam S;
        att::attn_prime<0>(r0, lds, S);
        att::attn_block<0>(r0, r1, lds, S);
        att::attn_block<0>(r1, r1, lds, S);
    }
    if (F.p0_mask & 2) {
        att::BlockRef r0, r1;
        r0.Q = proj + (rowb + (size_t)x * 256) * PP + C_RQ + h * 128; r0.K = proj + rowb * PP + C_RK + h * 128; r0.V = proj + rowb * PP + C_RV + h * 128; r0.O = (att::bf16*)r0.Q;
        r0.P0 = x * 256; r0.skv = SEQ; r0.lg = __builtin_amdgcn_logf(1.f - __builtin_amdgcn_exp2f(-5.f - (float)h))    ; r0.RG = proj + (rowb + (size_t)x * 256) * PP + C_RG + h * 128; r0.GN = F.in[I_RET_G] + h * 128; r0.O8 = FP8_UP_OUT ? (unsigned char*)F.out + DO_ORET8 + (rowb + (size_t)x * 256) * 2048 + h * 128 : nullptr;
        r1 = r0; r1.O8 = FP8_UP_OUT ? (unsigned char*)F.out + DO_ORET8 + (rowb + (size_t)(7 - x) * 256) * 2048 + h * 128 : nullptr; r1.Q = proj + (rowb + (size_t)(7 - x) * 256) * PP + C_RQ + h * 128; r1.O = (att::bf16*)r1.Q; r1.P0 = (7 - x) * 256; r1.RG = proj + (rowb + (size_t)(7 - x) * 256) * PP + C_RG + h * 128;
        att::Seam S;
        att::attn_prime<1>(r0, lds, S);
        att::attn_block<1>(r0, r1, lds, S);
        att::attn_block<1>(r1, r1, lds, S);
    }
}


__device__ __forceinline__ void p8_convert_peer(Frame& F) {
    const int lane = F.lane;
    f32x4 g[8];
#pragma unroll
    for (int j = 0; j < 8; ++j) g[j] = ((const GAS f32x4*)F.in[I_LN_FFN])[lane + 64 * j];
    float* scl = (float*)(F.ws + WS_PSCALE);
    int r0, rend, rstride;
#ifndef CV_R1
#define CV_R1 22272
#endif
#ifndef CVQ
#define CVQ 2
#endif
    if (F.bx >= 160) { r0 = (F.bx - 160) * NWAVES + F.wave; rend = CV_R1; rstride = 768; } else { r0 = CV_R1 + F.bx * NWAVES + F.wave; rend = 32768; rstride = 1280; }
#pragma unroll 1
    for (int rr = r0; rr < rend; rr += CVQ * rstride) {
        f32x4 v[CVQ][8]; float amax[CVQ]; bool ok[CVQ], isu[CVQ]; int ri[CVQ];
#pragma unroll
        for (int q = 0; q < CVQ; ++q) { const int r = rr + q * rstride; ok[q] = r < rend; const int rc = ok[q] ? r : rr; isu[q] = rc < 16384; ri[q] = rc; amax[q] = 0.f;
            const float* src = (isu[q] ? F.in[I_PEER_U] : F.in[I_PEER_V]) + (size_t)(rc & 16383) * DM;
#pragma unroll
#if defined(CV_LDS)
            for (int j = 0; j < 8; ++j) __builtin_amdgcn_global_load_lds((const unsigned*)((const f32x4*)src + lane + 64 * j), (LAS unsigned*)(F.lds + F.wave * (CVQ * 8192) + q * 8192 + j * 1024), 16, 0, CV_LDS); }
        asm volatile("s_waitcnt vmcnt(0)" ::: "memory");
#pragma unroll
        for (int q = 0; q < CVQ; ++q) {
#pragma unroll
            for (int j = 0; j < 8; ++j) v[q][j] = *(const LAS f32x4*)(F.lds + F.wave * (CVQ * 8192) + q * 8192 + j * 1024 + lane * 16); }
        LDS_WAIT(); asm volatile("" ::: "memory");
#elif !defined(CV_NO_NT)
            for (int j = 0; j < 8; ++j) v[q][j] = __builtin_nontemporal_load((const GAS f32x4*)src + lane + 64 * j); }
#else
            for (int j = 0; j < 8; ++j) v[q][j] = ((const GAS f32x4*)src)[lane + 64 * j]; }
#endif
#pragma unroll
        for (int q = 0; q < CVQ; ++q) {
#pragma unroll
            for (int j = 0; j < 8; ++j) { if (isu[q]) v[q][j] = v[q][j] * g[j]; amax[q] = fmaxf(amax[q], fmaxf(fmaxf(fabsf(v[q][j].x), fabsf(v[q][j].y)), fmaxf(fabsf(v[q][j].z), fabsf(v[q][j].w)))); }
#pragma unroll
            for (int o = 1; o < 64; o <<= 1) amax[q] = fmaxf(amax[q], __shfl_xor(amax[q], o));
            const float sc = amax[q] > 0.f ? amax[q] * (1.f / 448.f) : 1.f, inv = 1.f / sc;
            if (ok[q]) { if (lane == 0) scl[ri[q]] = sc;
                GAS unsigned* o4 = (GAS unsigned*)(F.ws + (isu[q] ? WS_PU : WS_PV) + (size_t)(ri[q] & 16383) * DM) + lane;
#pragma unroll
                for (int j = 0; j < 8; ++j) { int p = 0; p = __builtin_amdgcn_cvt_pk_fp8_f32(v[q][j].x * inv, v[q][j].y * inv, p, false); p = __builtin_amdgcn_cvt_pk_fp8_f32(v[q][j].z * inv, v[q][j].w * inv, p, true); o4[64 * j] = (unsigned)p; } } }
    }
}
__device__ __forceinline__ void norm_own_tile(Frame& F, bf16* base, int ld, int row0, int col0, const float* gain, float mul) {
    asm volatile("s_waitcnt vmcnt(0)" ::: "memory"); __syncthreads();
    const int lane = F.lane, rsel = lane >> 5, head = (lane >> 4) & 1, sub = lane & 15;
    float gv[8];
#pragma unroll
    for (int i = 0; i < 8; ++i) gv[i] = gain[sub * 8 + i] * mul;
#pragma unroll 1
    for (int r4 = 0; r4 < 16; r4 += 4) {
        att::bf16x8 v[4]; bf16* p[4];
#pragma unroll
        for (int q = 0; q < 4; ++q) { p[q] = base + (size_t)(row0 + F.wave * 32 + (r4 + q) * 2 + rsel) * ld + col0 + head * 128 + sub * 8; v[q] = *(const att::bf16x8*)p[q]; }
#pragma unroll
        for (int q = 0; q < 4; ++q) { float a[8]; unpack8s(v[q], a); float s = 0.f;
#pragma unroll
            for (int i = 0; i < 8; ++i) s += a[i] * a[i];
            s += __shfl_xor(s, 1); s += __shfl_xor(s, 2); s += __shfl_xor(s, 4); s += __shfl_xor(s, 8);
            const float rr = 1.f / sqrtf(s * (1.f / 128.f) + RMS_EPS);
#pragma unroll
            for (int i = 0; i < 8; ++i) a[i] *= rr * gv[i];
            *(att::bf16x8*)p[q] = pack8s(a); }
    }
}
__device__ __forceinline__ void fix_own_tile(Frame& F, bf16* proj, int pm, int pn, int kind) {
    const int lane = F.lane;
    if (kind < 2) {
        const int rsel = lane >> 5, head = (lane >> 4) & 1, sub = lane & 15; float gv[8];
#pragma unroll
        for (int i = 0; i < 8; ++i) gv[i] = kind == 0 ? F.in[I_FOXQ_G][sub * 8 + i] * QK_C2 : F.in[I_FOXK_G][sub * 8 + i];
#pragma unroll 1
        for (int r4 = 0; r4 < 16; r4 += 4) { att::bf16x8 v[4]; bf16* p[4];
#pragma unroll
            for (int q = 0; q < 4; ++q) { p[q] = proj + (size_t)(pm * 256 + F.wave * 32 + (r4 + q) * 2 + rsel) * PP + pn * 256 + head * 128 + sub * 8; v[q] = *(const att::bf16x8*)p[q]; }
#pragma unroll
            for (int q = 0; q < 4; ++q) { float a[8]; unpack8s(v[q], a); float s = 0.f;
#pragma unroll
                for (int i = 0; i < 8; ++i) s += a[i] * a[i];
                s += __shfl_xor(s, 1); s += __shfl_xor(s, 2); s += __shfl_xor(s, 4); s += __shfl_xor(s, 8);
                const float rr = 1.f / sqrtf(s * (1.f / 128.f) + RMS_EPS);
#pragma unroll
                for (int i = 0; i < 8; ++i) a[i] *= rr * gv[i];
                *(att::bf16x8*)p[q] = pack8s(a); } }
    } else {
        const int rsel = lane >> 4, head = (lane >> 3) & 1, sub = lane & 7; const float sc = kind == 3 ? 0.08838834764831845f : 1.f; float fr[8];
        const float lgh = __builtin_amdgcn_logf(1.f - __builtin_amdgcn_exp2f(-5.f - (float)((pn & 3) * 2 + head)));
#pragma unroll
        for (int i = 0; i < 8; ++i) fr[i] = __builtin_amdgcn_exp2f(-13.287712379549449f * (float)(sub * 8 + i) * (1.f / 64.f)) * 0.15915494309189535f;
#pragma unroll 1
        for (int r4 = 0; r4 < 8; r4 += 4) { att::bf16x8 va[4], vb[4]; bf16* p[4];
#pragma unroll
            for (int q = 0; q < 4; ++q) { p[q] = proj + (size_t)(pm * 256 + F.wave * 32 + (r4 + q) * 4 + rsel) * PP + pn * 256 + head * 128 + sub * 8; va[q] = *(const att::bf16x8*)p[q]; vb[q] = *(const att::bf16x8*)(p[q] + 64); }
#pragma unroll
            for (int q = 0; q < 4; ++q) { const int rowi = pm * 256 + F.wave * 32 + (r4 + q) * 4 + rsel; const float pos = (float)(rowi & (SEQ - 1)); float a[8], b[8], oa[8], ob[8]; unpack8s(va[q], a); unpack8s(vb[q], b);
                const float dsc = sc * __builtin_amdgcn_exp2f((kind == 2 ? lgh : -lgh) * (float)(rowi & 63));
#pragma unroll
                for (int i = 0; i < 8; ++i) { float rev = pos * fr[i]; rev -= rintf(rev); const float sn = __builtin_amdgcn_sinf(rev), cs = __builtin_amdgcn_cosf(rev);
                    oa[i] = (a[i] * cs - b[i] * sn) * dsc; ob[i] = (a[i] * sn + b[i] * cs) * dsc; }
                *(att::bf16x8*)p[q] = pack8s(oa); *(att::bf16x8*)(p[q] + 64) = pack8s(ob); } }
    }
}
__device__ __forceinline__ void p10_mem_attention(Frame& F) {
    char* lds = (char*)F.ldsg;
    const int b = F.bx >> 5, h = (F.bx >> 3) & 3, qb = F.bx & 7;
    att::BlockRef r0;
    const size_t qoff = ((size_t)b * SEQ + (size_t)qb * 256) * 512 + h * 128;
    r0.Q = (const att::bf16*)(F.ws + WS_QM) + qoff; r0.O = (att::bf16*)(F.ws + WS_OMEM) + qoff;
    r0.K = (const att::bf16*)(F.ws + WS_KVM) + (size_t)(b * 256) * 1024 + h * 128; r0.V = r0.K + 512;
    r0.P0 = 1 << 20; r0.skv = 256; r0.lg = 0.f; r0.RG = nullptr; r0.GN = nullptr; r0.O8 = F.ws + WS_OMEM + ((size_t)b * SEQ + (size_t)qb * 256) * 512 + h * 128;
    att::Seam S;
    att::attn_prime<2>(r0, lds, S);
    att::attn_block<2>(r0, r0, lds, S);
}
#define TK_INS(L, v) do { _Pragma("unroll") for (int i_ = 15; i_ >= 1; --i_) L[i_] = __builtin_amdgcn_fmed3f(L[i_ - 1], L[i_], (v)); L[0] = fmaxf(L[0], (v)); } while (0)
__device__ __forceinline__ void p13_topk_unit(Frame& F, int pm, int h) {
    const int lane = F.lane, r32 = lane & 31, hi = lane >> 5, wave = F.wave;
    const att::bf16* qp = (const att::bf16*)(F.ws + WS_QP); const att::bf16* subk = (const att::bf16*)(F.ws + WS_SUBK);
    int* idx_o = (int*)(F.ws + WS_IDX); float* gate_o = (float*)(F.ws + WS_GATE);
    LAS unsigned* kb = (LAS unsigned*)(F.lds + 65536 + (wave * 32 + (lane & 31)) * 32);
    const int tok = pm * 256 + wave * 32 + r32;
    const unsigned q_lane = (unsigned)((tok * DM + hi * 8) * 2), k_lane = (unsigned)((r32 * 128 + hi * 8) * 2);
    att::bf16x8 qf[8];
#define TK_STAGE(p_) do { const int hp_ = h * 2 + (p_); const unsigned char* qb_ = (const unsigned char*)qp + (size_t)hp_ * 256; \
        const unsigned char* kb_ = (const unsigned char*)subk + (size_t)hp_ * 32768 + (size_t)(wave >> 1) * 8192 + (size_t)(wave & 1) * 128; \
        _Pragma("unroll") for (int d0 = 0; d0 < 8; ++d0) qf[d0] = *(const GAS att::bf16x8*)(qb_ + d0 * 32 + q_lane); \
        _Pragma("unroll") for (int f_ = 0; f_ < 4; ++f_) \
            __builtin_amdgcn_global_load_lds((const GAS unsigned*)(kb_ + f_ * 32 + k_lane), (LAS unsigned*)(F.lds + (p_) * 32768 + (wave * 4 + f_) * 1024), 16, 0, 0); } while (0)
    float L0[16], L1[16];
#pragma unroll
    for (int i = 0; i < 16; ++i) { L0[i] = 0.f; L1[i] = 0.f; }
    TK_STAGE(0);
#pragma unroll 1
    for (int p = 0; p < 2; ++p) {
        asm volatile("s_waitcnt vmcnt(0)" ::: "memory"); __syncthreads();
        att::f32x16 acc[4];
        const LAS unsigned char* img = F.lds + p * 32768;
#pragma unroll
        for (int kt = 0; kt < 4; ++kt) { acc[kt] = att::f32x16{};
#pragma unroll
            for (int d0 = 0; d0 < 8; ++d0) acc[kt] = __builtin_amdgcn_mfma_f32_32x32x16_bf16(*(const LAS att::bf16x8*)(img + (kt * 8 + d0) * 1024 + lane * 16), qf[d0], acc[kt], 0, 0, 0); }
        if (p == 0) TK_STAGE(1);
        float L[16];
#pragma unroll
        for (int i = 0; i < 16; ++i) L[i] = -3.0e38f;
#pragma unroll
        for (int kt = 0; kt < 4; ++kt)
#pragma unroll
            for (int r = 0; r < 16; ++r) { const unsigned key = (unsigned)(kt * 32 + (r & 3) + 8 * (r >> 2)) + 4u * (unsigned)hi;
                const float v = __uint_as_float((__float_as_uint(acc[kt][r]) & ~0x7Fu) | key); TK_INS(L, v); }
        float P[16];
#pragma unroll
        for (int i = 0; i < 16; ++i) P[i] = __shfl_xor(L[i], 32);
#pragma unroll
        for (int i = 0; i < 16; ++i) TK_INS(L, P[i]);
#pragma unroll
        for (int i = 0; i < 16; ++i) { L0[i] = p == 0 ? L[i] : L0[i]; L1[i] = p == 0 ? L1[i] : L[i]; }
    }
#undef TK_STAGE
#pragma unroll
        for (int w = 0; w < 4; ++w) {
            kb[w] = (__float_as_uint(L0[4 * w]) & 0x7Fu) | ((__float_as_uint(L0[4 * w + 1]) & 0x7Fu) << 8) | ((__float_as_uint(L0[4 * w + 2]) & 0x7Fu) << 16) | ((__float_as_uint(L0[4 * w + 3]) & 0x7Fu) << 24);
            kb[4 + w] = (__float_as_uint(L1[4 * w]) & 0x7Fu) | ((__float_as_uint(L1[4 * w + 1]) & 0x7Fu) << 8) | ((__float_as_uint(L1[4 * w + 2]) & 0x7Fu) << 16) | ((__float_as_uint(L1[4 * w + 3]) & 0x7Fu) << 24); }
        float T[16];
#pragma unroll
        for (int i = 0; i < 16; ++i) T[i] = -3.0e38f;
#pragma unroll
        for (int a = 0; a < 16; ++a) { const float sa = __uint_as_float(__float_as_uint(L0[a]) & ~0x7Fu);
#pragma unroll
            for (int b2 = 0; b2 < 16; ++b2) if ((a + 1) * (b2 + 1) <= 16) { const float s = sa + __uint_as_float(__float_as_uint(L1[b2]) & ~0x7Fu);
                const float v = __uint_as_float((__float_as_uint(s) & ~0xFFu) | (unsigned)(a * 16 + b2)); TK_INS(T, v); } }
        LDS_WAIT();
        const LAS unsigned char* kbb = (const LAS unsigned char*)kb;
        float sc[16]; int ei[16]; float mx = __uint_as_float(__float_as_uint(T[0]) & ~0xFFu), sum = 0.f;
#pragma unroll
        for (int k = 0; k < 16; ++k) { const unsigned bits = __float_as_uint(T[k]); const unsigned id = bits & 0xFFu;
            const int i1 = kbb[id >> 4], i2 = kbb[16 + (id & 15u)]; ei[k] = i1 * 128 + i2;
            sc[k] = __builtin_amdgcn_exp2f((__uint_as_float(bits & ~0xFFu) - mx) * 1.4426950408889634f); sum += sc[k]; }
        const float inv = 1.f / sum;
        if (hi == 0) {
#pragma unroll
            for (int w = 0; w < 4; ++w) {
                *(GAS v4u*)(idx_o + (size_t)tok * 128 + h * 16 + 4 * w) = (v4u){(unsigned)ei[4 * w], (unsigned)ei[4 * w + 1], (unsigned)ei[4 * w + 2], (unsigned)ei[4 * w + 3]};
                *(GAS f32x4*)(gate_o + (size_t)tok * 128 + h * 16 + 4 * w) = (f32x4){sc[4 * w] * inv, sc[4 * w + 1] * inv, sc[4 * w + 2] * inv, sc[4 * w + 3] * inv}; } }
        LDS_WAIT(); asm volatile("" ::: "memory");
}


typedef float f32x2 __attribute__((ext_vector_type(2)));
__device__ __forceinline__ float gelu_tanh(float x) {
    const float y = 0.7978845608028654f * (x + 0.044715f * x * x * x);
    const float t = 1.f - 2.f * __builtin_amdgcn_rcpf(1.f + __builtin_amdgcn_exp2f(2.885390081777927f * y));
    return 0.5f * x * (1.f + t);
}
__device__ __forceinline__ float dot2bf(unsigned a, unsigned b, float acc) { asm("v_dot2c_f32_bf16 %0, %1, %2" : "+v"(acc) : "v"(a), "v"(b)); return acc; }
#ifndef EX_QCH
#define EX_QCH 2
#endif
#ifndef EX_TOK8
#define EX_TOK8 1
#endif
struct RowBuf { v4u r[8]; float su, sv; };
#define DPP_MOV(v, ctrl) __builtin_bit_cast(float, __builtin_amdgcn_update_dpp(0, __builtin_bit_cast(int, (v)), (ctrl), 0xF, 0xF, false))
#define ROW_ROR(v, n) __builtin_bit_cast(float, __builtin_amdgcn_update_dpp(0, __builtin_bit_cast(int, (v)), 0x120 + (n), 0xF, 0xF, false))
__device__ __forceinline__ void p14_experts_sorted(Frame& F) {
    const int lane = F.lane, wave = F.wave, q = lane >> 4, l16 = lane & 15;
    const bf16* xb = (const bf16*)(F.ws + WS_XB2); const unsigned char* pu = F.ws + WS_PU; const unsigned char* pv = F.ws + WS_PV;
    const int* idx = (const int*)(F.ws + WS_IDX); const float* gate = (const float*)(F.ws + WS_GATE); const float* rowss = (const float*)(F.ws + WS_ROWSS2);
    const float* su = (const float*)(F.ws + WS_PSCALE); const float* sv = su + 16384;
    LAS unsigned* list = (LAS unsigned*)(F.lds + wave * 8192) + q * 128;
    LAS float* wl = (LAS float*)(F.lds + wave * 8192 + 2048) + q * 128;
    LAS float* gt = (LAS float*)(F.lds + wave * 8192 + 4096) + q * 128;
    LAS unsigned* cnt = (LAS unsigned*)(F.lds + wave * 8192 + 6144) + q * 64;
    constexpr int NSTEP = 128;
    for (int grp = 0; grp < 2; ++grp) {
        const int tok = (F.bx * NWAVES + wave) * 8 + grp * 4 + q;
        const float rs = 1.f / sqrtf(rowss[tok] * (1.f / DM) + RMS_EPS);
#pragma unroll
        for (int i = 0; i < 4; ++i) cnt[l16 + 16 * i] = 0u;
        unsigned ent[8], pos[8];
#pragma unroll
        for (int j = 0; j < 8; ++j) { const int k = l16 + 16 * j; const unsigned e = (unsigned)idx[(size_t)tok * 128 + k]; gt[k] = gate[(size_t)tok * 128 + k]; ent[j] = e | ((unsigned)k << 16); }
        LDS_WAIT(); asm volatile("" ::: "memory");
#pragma unroll
        for (int j = 0; j < 8; ++j) pos[j] = __hip_atomic_fetch_add(cnt + ((ent[j] & 0x3FFFu) >> 8), 1u, __ATOMIC_RELAXED, __HIP_MEMORY_SCOPE_WORKGROUP);
        LDS_WAIT(); asm volatile("" ::: "memory");
        { unsigned c[4], inc[4], run = 0u;
#pragma unroll
          for (int i = 0; i < 4; ++i) { c[i] = cnt[l16 + 16 * i]; inc[i] = c[i];
#pragma unroll
              for (int o = 1; o < 16; o <<= 1) { const unsigned tt = __shfl_up(inc[i], o, 16); if (l16 >= o) inc[i] += tt; } }
          LDS_WAIT(); asm volatile("" ::: "memory");
#pragma unroll
          for (int i = 0; i < 4; ++i) { cnt[l16 + 16 * i] = run + inc[i] - c[i]; run += __shfl(inc[i], 15, 16); } }
        LDS_WAIT(); asm volatile("" ::: "memory");
#pragma unroll
        for (int j = 0; j < 8; ++j) list[cnt[(ent[j] & 0x3FFFu) >> 8] + pos[j]] = ent[j];
        LDS_WAIT(); asm volatile("" ::: "memory");
        const unsigned lane_off = (unsigned)l16 * 16u;
        constexpr int QCH = EX_QCH, NSW = 8 / QCH;
#define EX_LD(B, s_, TABQ) do { const int ss_ = (s_) < NSTEP ? (s_) : NSTEP - 1; const unsigned off_ = ((list[ss_] & 0x3FFFu) << 11) + lane_off;     \
            _Pragma("unroll") for (int c_ = 0; c_ < QCH; ++c_) B[c_] = *(const GAS v4u*)((TABQ) + off_ + c_ * 256); } while (0)
#ifndef EX_RINGK
#define EX_RINGK 8
#endif
#if EX_RINGK == 4
#define EX_RING(TABQ, STEPFN, ENDFN) do { v4u H0[QCH], H1[QCH], H2[QCH], H3[QCH]; \
            EX_LD(H0, 0, TABQ); EX_LD(H1, 1, TABQ); EX_LD(H2, 2, TABQ); \
            _Pragma("unroll 1") for (int s = 0; s < NSTEP; s += 8) { \
                EX_LD(H3, s + 3, TABQ); STEPFN(H0, s + 0, 0); \
                EX_LD(H0, s + 4, TABQ); STEPFN(H1, s + 1, 1); \
                EX_LD(H1, s + 5, TABQ); STEPFN(H2, s + 2, 2); \
                EX_LD(H2, s + 6, TABQ); STEPFN(H3, s + 3, 3); \
                EX_LD(H3, s + 7, TABQ); STEPFN(H0, s + 4, 4); \
                EX_LD(H0, s + 8, TABQ); STEPFN(H1, s + 5, 5); \
                EX_LD(H1, s + 9, TABQ); STEPFN(H2, s + 6, 6); \
                EX_LD(H2, s + 10, TABQ); STEPFN(H3, s + 7, 7); \
                ENDFN(s); } } while (0)
#elif EX_RINGK == 2
#define EX_RING(TABQ, STEPFN, ENDFN) do { v4u H0[QCH], H1[QCH]; \
            EX_LD(H0, 0, TABQ); \
            _Pragma("unroll 1") for (int s = 0; s < NSTEP; s += 8) { \
                EX_LD(H1, s + 1, TABQ); STEPFN(H0, s + 0, 0); \
                EX_LD(H0, s + 2, TABQ); STEPFN(H1, s + 1, 1); \
                EX_LD(H1, s + 3, TABQ); STEPFN(H0, s + 2, 2); \
                EX_LD(H0, s + 4, TABQ); STEPFN(H1, s + 3, 3); \
                EX_LD(H1, s + 5, TABQ); STEPFN(H0, s + 4, 4); \
                EX_LD(H0, s + 6, TABQ); STEPFN(H1, s + 5, 5); \
                EX_LD(H1, s + 7, TABQ); STEPFN(H0, s + 6, 6); \
                EX_LD(H0, s + 8, TABQ); STEPFN(H1, s + 7, 7); \
                ENDFN(s); } } while (0)
#else
#define EX_RING(TABQ, STEPFN, ENDFN) do { v4u H0[QCH], H1[QCH], H2[QCH], H3[QCH], H4[QCH], H5[QCH], H6[QCH], H7[QCH]; \
            EX_LD(H0, 0, TABQ); EX_LD(H1, 1, TABQ); EX_LD(H2, 2, TABQ); EX_LD(H3, 3, TABQ); EX_LD(H4, 4, TABQ); EX_LD(H5, 5, TABQ); EX_LD(H6, 6, TABQ); \
            _Pragma("unroll 1") for (int s = 0; s < NSTEP; s += 8) { \
                EX_LD(H7, s + 7, TABQ); STEPFN(H0, s + 0, 0); \
                EX_LD(H0, s + 8, TABQ); STEPFN(H1, s + 1, 1); \
                EX_LD(H1, s + 9, TABQ); STEPFN(H2, s + 2, 2); \
                EX_LD(H2, s + 10, TABQ); STEPFN(H3, s + 3, 3); \
                EX_LD(H3, s + 11, TABQ); STEPFN(H4, s + 4, 4); \
                EX_LD(H4, s + 12, TABQ); STEPFN(H5, s + 5, 5); \
                EX_LD(H5, s + 13, TABQ); STEPFN(H6, s + 6, 6); \
                EX_LD(H6, s + 14, TABQ); STEPFN(H7, s + 7, 7); \
                ENDFN(s); } } while (0)
#endif
#pragma unroll 1
        for (int j = 0; j < NSW; ++j) {
            f32x2 xf[QCH][8];
#pragma unroll
            for (int c = 0; c < QCH; ++c) { const v4u a = *(const GAS v4u*)(xb + (size_t)tok * DM + j * (QCH * 256) + c * 256 + l16 * 16), b = *(const GAS v4u*)(xb + (size_t)tok * DM + j * (QCH * 256) + c * 256 + l16 * 16 + 8);
                const unsigned xd[8] = {a.x, a.y, a.z, a.w, b.x, b.y, b.z, b.w};
#pragma unroll
                for (int i = 0; i < 8; ++i) xf[c][i] = (f32x2){__uint_as_float(xd[i] << 16), __uint_as_float(xd[i] & 0xffff0000u)}; }
            const unsigned char* tabq = pu + j * (QCH * 256);
#define EX_U(B, s_, k_) do { f32x2 d2_ = {0.f, 0.f}; \
            _Pragma("unroll") for (int c_ = 0; c_ < QCH; ++c_) { const unsigned ud[4] = {B[c_].x, B[c_].y, B[c_].z, B[c_].w}; \
                _Pragma("unroll") for (int w_ = 0; w_ < 4; ++w_) { d2_ = __builtin_amdgcn_cvt_pk_f32_fp8((int)ud[w_], false) * xf[c_][2 * w_] + d2_; d2_ = __builtin_amdgcn_cvt_pk_f32_fp8((int)ud[w_], true) * xf[c_][2 * w_ + 1] + d2_; } } \
            dd[k_] = d2_.x + d2_.y; } while (0)
#define EX_UEND(s_) do { float r4_[4], r2_[2], r1_; \
            { const bool up = (l16 & 8) != 0; _Pragma("unroll") for (int i_ = 0; i_ < 4; ++i_) { const float mine = up ? dd[i_ + 4] : dd[i_], theirs = up ? dd[i_] : dd[i_ + 4]; r4_[i_] = mine + ROW_ROR(theirs, 8); } } \
            { const bool up = (l16 & 4) != 0; _Pragma("unroll") for (int i_ = 0; i_ < 2; ++i_) { const float mine = up ? r4_[i_ + 2] : r4_[i_], theirs = up ? r4_[i_] : r4_[i_ + 2]; \
                const float fromhi = DPP_MOV(theirs, 0x104), fromlo = DPP_MOV(theirs, 0x114); r2_[i_] = mine + (up ? fromlo : fromhi); } }     \
            { const bool up = (l16 & 2) != 0; const float mine = up ? r2_[1] : r2_[0], theirs = up ? r2_[0] : r2_[1]; r1_ = mine + DPP_MOV(theirs, 0x4E); }     \
            r1_ += DPP_MOV(r1_, 0xB1);                                                                                                                  \
            if ((l16 & 1) == 0) { const int si_ = (s_) + (l16 >> 1); wl[si_] = (j == 0 ? 0.f : wl[si_]) + r1_; } } while (0)
            float dd[8];
            EX_RING(tabq, EX_U, EX_UEND);
#undef EX_U
#undef EX_UEND
            LDS_WAIT(); asm volatile("" ::: "memory");
        }
#pragma unroll
        for (int i = 0; i < 8; ++i) { const int s = l16 + 16 * i; const unsigned me = list[s]; const unsigned e = me & 0x3FFFu;
            wl[s] = gt[(me >> 16) & 127u] * gelu_tanh(wl[s] * su[e] * rs) * sv[e]; }
        LDS_WAIT(); asm volatile("" ::: "memory");
#pragma unroll 1
        for (int j = 0; j < NSW; ++j) {
            f32x2 acc[QCH][8];
#pragma unroll
            for (int c = 0; c < QCH; ++c)
#pragma unroll
                for (int e = 0; e < 8; ++e) acc[c][e] = (f32x2){0.f, 0.f};
            const unsigned char* tabq = pv + j * (QCH * 256);
#define EX_NOEND(s_) do { } while (0)
#define EX_V(B, s_, k_) do { const float w_ = wl[s_]; const f32x2 w2 = {w_, w_}; \
            _Pragma("unroll") for (int c_ = 0; c_ < QCH; ++c_) { const unsigned ud[4] = {B[c_].x, B[c_].y, B[c_].z, B[c_].w}; \
                _Pragma("unroll") for (int w4_ = 0; w4_ < 4; ++w4_) { acc[c_][2 * w4_] = __builtin_amdgcn_cvt_pk_f32_fp8((int)ud[w4_], false) * w2 + acc[c_][2 * w4_]; acc[c_][2 * w4_ + 1] = __builtin_amdgcn_cvt_pk_f32_fp8((int)ud[w4_], true) * w2 + acc[c_][2 * w4_ + 1]; } } } while (0)
            EX_RING(tabq, EX_V, EX_NOEND);
#undef EX_V
#undef EX_NOEND
            float* orow = F.out + (size_t)tok * DM + j * (QCH * 256) + l16 * 16; const bf16* xrow = xb + (size_t)tok * DM + j * (QCH * 256) + l16 * 16;
#pragma unroll
            for (int c = 0; c < QCH; ++c) { const v4u x0 = *(const GAS v4u*)(xrow + c * 256), x1 = *(const GAS v4u*)(xrow + c * 256 + 8); const unsigned xd[8] = {x0.x, x0.y, x0.z, x0.w, x1.x, x1.y, x1.z, x1.w};
#pragma unroll
                for (int qq = 0; qq < 4; ++qq)
                    *(GAS f32x4*)(orow + c * 256 + 4 * qq) = (f32x4){__uint_as_float(xd[2 * qq] << 16) + acc[c][2 * qq].x, __uint_as_float(xd[2 * qq] & 0xffff0000u) + acc[c][2 * qq].y,
                                                                    __uint_as_float(xd[2 * qq + 1] << 16) + acc[c][2 * qq + 1].x, __uint_as_float(xd[2 * qq + 1] & 0xffff0000u) + acc[c][2 * qq + 1].y}; }
        }
#undef EX_LD
#undef EX_RING
        LDS_WAIT(); asm volatile("" ::: "memory");
    }
}

__device__ __forceinline__ void p14_experts_8(Frame& F) {
    const int lane = F.lane, wave = F.wave, q = lane >> 3, l16 = lane & 7;
    const bf16* xb = (const bf16*)(F.ws + WS_XB2); const unsigned char* pu = F.ws + WS_PU; const unsigned char* pv = F.ws + WS_PV;
    const int* idx = (const int*)(F.ws + WS_IDX); const float* gate = (const float*)(F.ws + WS_GATE); const float* rowss = (const float*)(F.ws + WS_ROWSS2);
    const float* su = (const float*)(F.ws + WS_PSCALE); const float* sv = su + 16384;
    LAS unsigned* list = (LAS unsigned*)(F.lds + wave * 14336) + q * 128;
    LAS float* wl = (LAS float*)(F.lds + wave * 14336 + 4096) + q * 128;
    LAS float* gt = (LAS float*)(F.lds + wave * 14336 + 8192) + q * 128;
    LAS unsigned* cnt = (LAS unsigned*)(F.lds + wave * 14336 + 12288) + q * 64;
    constexpr int NSTEP = 128;
    {
        const int tok = (F.bx * NWAVES + wave) * 8 + q;
        const float rs = 1.f / sqrtf(rowss[tok] * (1.f / DM) + RMS_EPS);
#pragma unroll
        for (int i = 0; i < 8; ++i) cnt[l16 + 8 * i] = 0u;
        unsigned ent[16], pos[16];
#pragma unroll
        for (int j = 0; j < 16; ++j) { const int k = l16 + 8 * j; const unsigned e = (unsigned)idx[(size_t)tok * 128 + k]; gt[k] = gate[(size_t)tok * 128 + k]; ent[j] = e | ((unsigned)k << 16); }
        LDS_WAIT(); asm volatile("" ::: "memory");
#pragma unroll
        for (int j = 0; j < 16; ++j) pos[j] = __hip_atomic_fetch_add(cnt + ((ent[j] & 0x3FFFu) >> 8), 1u, __ATOMIC_RELAXED, __HIP_MEMORY_SCOPE_WORKGROUP);
        LDS_WAIT(); asm volatile("" ::: "memory");
        { unsigned c[8], inc[8], run = 0u;
#pragma unroll
          for (int i = 0; i < 8; ++i) { c[i] = cnt[l16 + 8 * i]; inc[i] = c[i];
#pragma unroll
              for (int o = 1; o < 8; o <<= 1) { const unsigned tt = __shfl_up(inc[i], o, 8); if (l16 >= o) inc[i] += tt; } }
          LDS_WAIT(); asm volatile("" ::: "memory");
#pragma unroll
          for (int i = 0; i < 8; ++i) { cnt[l16 + 8 * i] = run + inc[i] - c[i]; run += __shfl(inc[i], 7, 8); } }
        LDS_WAIT(); asm volatile("" ::: "memory");
#pragma unroll
        for (int j = 0; j < 16; ++j) list[cnt[(ent[j] & 0x3FFFu) >> 8] + pos[j]] = ent[j];
        LDS_WAIT(); asm volatile("" ::: "memory");
        const unsigned lane_off = (unsigned)l16 * 16u;
        constexpr int QCH = EX_QCH, NSW = 16 / QCH;
#define EX_LD(B, s_, TABQ) do { const int ss_ = (s_) < NSTEP ? (s_) : NSTEP - 1; const unsigned off_ = ((list[ss_] & 0x3FFFu) << 11) + lane_off;     \
            _Pragma("unroll") for (int c_ = 0; c_ < QCH; ++c_) B[c_] = *(const GAS v4u*)((TABQ) + off_ + c_ * 128); } while (0)
#ifndef EX_RINGK
#define EX_RINGK 8
#endif
#if EX_RINGK == 4
#define EX_RING(TABQ, STEPFN, ENDFN) do { v4u H0[QCH], H1[QCH], H2[QCH], H3[QCH]; \
            EX_LD(H0, 0, TABQ); EX_LD(H1, 1, TABQ); EX_LD(H2, 2, TABQ); \
            _Pragma("unroll 1") for (int s = 0; s < NSTEP; s += 8) { \
                EX_LD(H3, s + 3, TABQ); STEPFN(H0, s + 0, 0); \
                EX_LD(H0, s + 4, TABQ); STEPFN(H1, s + 1, 1); \
                EX_LD(H1, s + 5, TABQ); STEPFN(H2, s + 2, 2); \
                EX_LD(H2, s + 6, TABQ); STEPFN(H3, s + 3, 3); \
                EX_LD(H3, s + 7, TABQ); STEPFN(H0, s + 4, 4); \
                EX_LD(H0, s + 8, TABQ); STEPFN(H1, s + 5, 5); \
                EX_LD(H1, s + 9, TABQ); STEPFN(H2, s + 6, 6); \
                EX_LD(H2, s + 10, TABQ); STEPFN(H3, s + 7, 7); \
                ENDFN(s); } } while (0)
#elif EX_RINGK == 2
#define EX_RING(TABQ, STEPFN, ENDFN) do { v4u H0[QCH], H1[QCH]; \
            EX_LD(H0, 0, TABQ); \
            _Pragma("unroll 1") for (int s = 0; s < NSTEP; s += 8) { \
                EX_LD(H1, s + 1, TABQ); STEPFN(H0, s + 0, 0); \
                EX_LD(H0, s + 2, TABQ); STEPFN(H1, s + 1, 1); \
                EX_LD(H1, s + 3, TABQ); STEPFN(H0, s + 2, 2); \
                EX_LD(H0, s + 4, TABQ); STEPFN(H1, s + 3, 3); \
                EX_LD(H1, s + 5, TABQ); STEPFN(H0, s + 4, 4); \
                EX_LD(H0, s + 6, TABQ); STEPFN(H1, s + 5, 5); \
                EX_LD(H1, s + 7, TABQ); STEPFN(H0, s + 6, 6); \
                EX_LD(H0, s + 8, TABQ); STEPFN(H1, s + 7, 7); \
                ENDFN(s); } } while (0)
#else
#define EX_RING(TABQ, STEPFN, ENDFN) do { v4u H0[QCH], H1[QCH], H2[QCH], H3[QCH], H4[QCH], H5[QCH], H6[QCH], H7[QCH]; \
            EX_LD(H0, 0, TABQ); EX_LD(H1, 1, TABQ); EX_LD(H2, 2, TABQ); EX_LD(H3, 3, TABQ); EX_LD(H4, 4, TABQ); EX_LD(H5, 5, TABQ); EX_LD(H6, 6, TABQ); \
            _Pragma("unroll 1") for (int s = 0; s < NSTEP; s += 8) { \
                EX_LD(H7, s + 7, TABQ); STEPFN(H0, s + 0, 0); \
                EX_LD(H0, s + 8, TABQ); STEPFN(H1, s + 1, 1); \
                EX_LD(H1, s + 9, TABQ); STEPFN(H2, s + 2, 2); \
                EX_LD(H2, s + 10, TABQ); STEPFN(H3, s + 3, 3); \
                EX_LD(H3, s + 11, TABQ); STEPFN(H4, s + 4, 4); \
                EX_LD(H4, s + 12, TABQ); STEPFN(H5, s + 5, 5); \
                EX_LD(H5, s + 13, TABQ); STEPFN(H6, s + 6, 6); \
                EX_LD(H6, s + 14, TABQ); STEPFN(H7, s + 7, 7); \
                ENDFN(s); } } while (0)
#endif
#pragma unroll 1
        for (int j = 0; j < NSW; ++j) {
            f32x2 xf[QCH][8];
#pragma unroll
            for (int c = 0; c < QCH; ++c) { const v4u a = *(const GAS v4u*)(xb + (size_t)tok * DM + j * (QCH * 128) + c * 128 + l16 * 16), b = *(const GAS v4u*)(xb + (size_t)tok * DM + j * (QCH * 128) + c * 128 + l16 * 16 + 8);
                const unsigned xd[8] = {a.x, a.y, a.z, a.w, b.x, b.y, b.z, b.w};
#pragma unroll
                for (int i = 0; i < 8; ++i) xf[c][i] = (f32x2){__uint_as_float(xd[i] << 16), __uint_as_float(xd[i] & 0xffff0000u)}; }
            const unsigned char* tabq = pu + j * (QCH * 128);
#define EX_U(B, s_, k_) do { f32x2 d2_ = {0.f, 0.f}; \
            _Pragma("unroll") for (int c_ = 0; c_ < QCH; ++c_) { const unsigned ud[4] = {B[c_].x, B[c_].y, B[c_].z, B[c_].w}; \
                _Pragma("unroll") for (int w_ = 0; w_ < 4; ++w_) { d2_ = __builtin_amdgcn_cvt_pk_f32_fp8((int)ud[w_], false) * xf[c_][2 * w_] + d2_; d2_ = __builtin_amdgcn_cvt_pk_f32_fp8((int)ud[w_], true) * xf[c_][2 * w_ + 1] + d2_; } } \
            dd[k_] = d2_.x + d2_.y; } while (0)
#define EX_UEND(s_) do { float r4_[4], r2_[2], r1_; \
            { const bool up = (l16 & 4) != 0; _Pragma("unroll") for (int i_ = 0; i_ < 4; ++i_) { const float mine = up ? dd[i_ + 4] : dd[i_], theirs = up ? dd[i_] : dd[i_ + 4]; \
                const float fromhi = DPP_MOV(theirs, 0x104), fromlo = DPP_MOV(theirs, 0x114); r4_[i_] = mine + (up ? fromlo : fromhi); } }     \
            { const bool up = (l16 & 2) != 0; _Pragma("unroll") for (int i_ = 0; i_ < 2; ++i_) { const float mine = up ? r4_[i_ + 2] : r4_[i_], theirs = up ? r4_[i_] : r4_[i_ + 2]; r2_[i_] = mine + DPP_MOV(theirs, 0x4E); } }     \
            { const bool up = (l16 & 1) != 0; const float mine = up ? r2_[1] : r2_[0], theirs = up ? r2_[0] : r2_[1]; r1_ = mine + DPP_MOV(theirs, 0xB1); }     \
            { const int si_ = (s_) + l16; wl[si_] = (j == 0 ? 0.f : wl[si_]) + r1_; } } while (0)
            float dd[8];
            EX_RING(tabq, EX_U, EX_UEND);
#undef EX_U
#undef EX_UEND
            LDS_WAIT(); asm volatile("" ::: "memory");
        }
#pragma unroll
        for (int i = 0; i < 16; ++i) { const int s = l16 + 8 * i; const unsigned me = list[s]; const unsigned e = me & 0x3FFFu;
            wl[s] = gt[(me >> 16) & 127u] * gelu_tanh(wl[s] * su[e] * rs) * sv[e]; }
        LDS_WAIT(); asm volatile("" ::: "memory");
#pragma unroll 1
        for (int j = 0; j < NSW; ++j) {
            f32x2 acc[QCH][8];
#pragma unroll
            for (int c = 0; c < QCH; ++c)
#pragma unroll
                for (int e = 0; e < 8; ++e) acc[c][e] = (f32x2){0.f, 0.f};
            const unsigned char* tabq = pv + j * (QCH * 128);
#define EX_NOEND(s_) do { } while (0)
#define EX_V(B, s_, k_) do { const float w_ = wl[s_]; const f32x2 w2 = {w_, w_}; \
            _Pragma("unroll") for (int c_ = 0; c_ < QCH; ++c_) { const unsigned ud[4] = {B[c_].x, B[c_].y, B[c_].z, B[c_].w}; \
                _Pragma("unroll") for (int w4_ = 0; w4_ < 4; ++w4_) { acc[c_][2 * w4_] = __builtin_amdgcn_cvt_pk_f32_fp8((int)ud[w4_], false) * w2 + acc[c_][2 * w4_]; acc[c_][2 * w4_ + 1] = __builtin_amdgcn_cvt_pk_f32_fp8((int)ud[w4_], true) * w2 + acc[c_][2 * w4_ + 1]; } } } while (0)
            EX_RING(tabq, EX_V, EX_NOEND);
#undef EX_V
#undef EX_NOEND
            float* orow = F.out + (size_t)tok * DM + j * (QCH * 128) + l16 * 16; const bf16* xrow = xb + (size_t)tok * DM + j * (QCH * 128) + l16 * 16;
#pragma unroll
            for (int c = 0; c < QCH; ++c) { const v4u x0 = *(const GAS v4u*)(xrow + c * 128), x1 = *(const GAS v4u*)(xrow + c * 128 + 8); const unsigned xd[8] = {x0.x, x0.y, x0.z, x0.w, x1.x, x1.y, x1.z, x1.w};
#pragma unroll
                for (int qq = 0; qq < 4; ++qq)
                    *(GAS f32x4*)(orow + c * 128 + 4 * qq) = (f32x4){__uint_as_float(xd[2 * qq] << 16) + acc[c][2 * qq].x, __uint_as_float(xd[2 * qq] & 0xffff0000u) + acc[c][2 * qq].y,
                                                                    __uint_as_float(xd[2 * qq + 1] << 16) + acc[c][2 * qq + 1].x, __uint_as_float(xd[2 * qq + 1] & 0xffff0000u) + acc[c][2 * qq + 1].y}; }
        }
#undef EX_LD
#undef EX_RING
        LDS_WAIT(); asm volatile("" ::: "memory");
    }
}

#ifdef ONLY_PHASE
#define ISO(n) ((n) == ONLY_PHASE)
#else
#define ISO(n) true
#endif
#ifndef LAST_PHASE
#define LAST_PHASE 11
#endif
enum { PH_PROLOGUE = 0, PH_GEMM_IN, PH_GEMM_IN8, PH_ATTN, PH_GEMM_FOXUP, PH_GEMM_RETUP, PH_GEMM_OUT, PH_GEMM_MQ, PH_MEM_ATTN, PH_GEMM_MO, PH_GEMM_PQ, PH_EXPERTS, PH_N };
__global__ void __launch_bounds__(NWAVES * 64, 2) mega_fwd(Args args) {
    extern __shared__ __attribute__((aligned(16))) unsigned char lds[];
    Frame F;
    F.lds = (LAS unsigned char*)lds; F.ldsg = lds; F.tid = threadIdx.x; F.lane = F.tid & 63; F.wave = __builtin_amdgcn_readfirstlane(F.tid >> 6); F.G = gridDim.x; F.bx = blockIdx.x;
    F.in = args.in; F.out = args.out; F.ws = args.ws; F.p0_mask = args.p0_mask;
    volatile LAS unsigned* MISC = (volatile LAS unsigned*)(F.lds + MISC_OFF);
    for (int u = F.tid; u < (LDS_BYTES - LDSCTL_OFF) / 4; u += NWAVES * 64) ((LAS unsigned*)(F.lds + LDSCTL_OFF))[u] = 0u;
    __syncthreads();
    gu32* ctl = (gu32*)(args.ws + WS_CTL);
    XcdBarrier bar = xcd_barrier_post((unsigned*)(ctl + CW_BAR), MISC + 8);
    unsigned char* ws = args.ws;
    bf16* proj = (bf16*)(ws + WS_PROJ);
    for (int ph = args.ph_lo; ph < args.ph_hi; ++ph) {
        { int t_ = threadIdx.x; asm volatile("" : "+v"(t_)); F.tid = t_; F.lane = t_ & 63; }
        { int g_ = gridDim.x, b_ = blockIdx.x; asm volatile("" : "+s"(g_), "+s"(b_)); F.G = g_; F.bx = b_; }
        bool is_gemm = false, barrier_after = true, fp8 = false, mq_phase = false, qk_phase = false, pq_phase = false, ksplit = false, qk8_phase = false;
        pg8::Gemm g{nullptr, nullptr, 0, 0, 0, 0, 0x7F7F7F7F}; pg8::EpiAny E{};
        switch (ph) {
#ifndef NO_P0
        case PH_PROLOGUE: if constexpr (ISO(0)) p0_prologue(F); break;
#endif
        case PH_GEMM_IN: if constexpr (ISO(1)) p1_scan(F); is_gemm = true; barrier_after = false; qk_phase = true;
            g = pg8::Gemm{(const bf16*)(ws + WS_XN), (const bf16*)(ws + WS_WIN), M_TOK, N_QK, DM, DM, 0x7F7F7F7F, DM}; E.kind = 0; E.O = proj; E.ldc = PP; E.pn_off = 0; break;
        case PH_GEMM_IN8: is_gemm = true; fp8 = true; qk8_phase = true;
            g = pg8::Gemm{(const bf16*)((unsigned char*)args.out + DO_XN8), (const bf16*)(ws + WS_WIN + 16 * MiB), M_TOK, N_REST, DM / 2, DM / 2, W8_SCALE_B, DM / 2}; E.kind = 0; E.O = proj + N_QK; E.ldc = PP; E.pn_off = N_QK / 256; break;
#ifndef NO_ATTN
        case PH_ATTN: if constexpr (ISO(3)) p4_attention(F); break;
#endif
#if FP8_UP_OUT
        case PH_GEMM_FOXUP: is_gemm = true; fp8 = true;
            g = pg8::Gemm{(const bf16*)((unsigned char*)args.out + DO_OCAT8), (const bf16*)(ws + WS_WFOX), M_TOK, DM, 512, 1024, W8_SCALE_B, 1024}; ksplit = true; E.kind = 7; E.Gt = proj + C_G0; E.Gt2 = proj + C_G1; E.ldg = PP; E.O8 = (unsigned char*)(proj + C_FK); E.ld8 = PP * 2; break;
        case PH_GEMM_RETUP: barrier_after = false; break;
        case PH_GEMM_OUT: is_gemm = true; fp8 = true;
            g = pg8::Gemm{proj + C_FK, (const bf16*)(ws + WS_WOUT), M_TOK, DM, DM / 2, PP, W8_SCALE_B, DM / 2}; E.kind = 4; E.base = args.in[I_X]; E.base16 = nullptr; E.O = (bf16*)(ws + WS_XB1); E.ldc = DM; E.rowss = (float*)(ws + WS_ROWSS1); break;
#else
        case PH_GEMM_FOXUP: is_gemm = true;
            g = pg8::Gemm{proj + C_FQ, (const bf16*)(ws + WS_WFOX), M_TOK, DM, 1024, PP, 0x7F7F7F7F, 1024}; E.kind = 2; E.O = (bf16*)(ws + WS_XN); E.ldc = DM; E.Gt = proj + C_G0; E.ldg = PP; break;
        case PH_GEMM_RETUP: is_gemm = true;
            g = pg8::Gemm{proj + C_RQ, (const bf16*)(ws + WS_WRET), M_TOK, DM, 1024, PP, 0x7F7F7F7F, 1024}; E.kind = 6; E.O = (bf16*)(ws + WS_XN); E.ldc = DM; E.Gt = proj + C_G1; E.ldg = PP; break;
        case PH_GEMM_OUT: is_gemm = true;
            g = pg8::Gemm{(const bf16*)(ws + WS_XN), (const bf16*)(ws + WS_WOUT), M_TOK, DM, DM, DM, 0x7F7F7F7F, DM}; E.kind = 4; E.base = args.in[I_X]; E.base16 = nullptr; E.O = (bf16*)(ws + WS_XB1B); E.ldc = DM; E.rowss = (float*)(ws + WS_ROWSS1); break;
#endif
        case PH_GEMM_MQ: is_gemm = true; mq_phase = true;
            if (F.bx < 128) { g = pg8::Gemm{(const bf16*)(ws + WS_XB1), (const bf16*)(ws + WS_WMQ), M_TOK, 512, DM, DM, 0x7F7F7F7F, DM}; E.kind = 1; E.O = (bf16*)(ws + WS_QM); E.ldc = 512; E.rowss_in = (const float*)(ws + WS_ROWSS1); }
            else { g = pg8::Gemm{(const bf16*)(ws + WS_MN), (const bf16*)(ws + WS_WMKV), NB * 256, 1024, DM, DM, 0x7F7F7F7F, DM}; E.kind = 1; E.O = (bf16*)(ws + WS_KVM); E.ldc = 1024; E.rowss_in = nullptr; }
            break;
        case PH_MEM_ATTN: if constexpr (ISO(8)) p10_mem_attention(F); break;
        case PH_GEMM_MO: is_gemm = true;
            fp8 = true; g = pg8::Gemm{(const bf16*)(ws + WS_OMEM), (const bf16*)(ws + WS_WMO), M_TOK, DM, 256, 256, W8_SCALE_B, 256}; E.kind = 4; E.base = nullptr; E.base16 = (const bf16*)(ws + WS_XB1); E.O = (bf16*)(ws + WS_XB2); E.ldc = DM; E.rowss = (float*)(ws + WS_ROWSS2); break;
        case PH_GEMM_PQ: is_gemm = true; pq_phase = true;
            g = pg8::Gemm{(const bf16*)(ws + WS_XB2), (const bf16*)(ws + WS_WPQ), M_TOK, DM, DM, DM, 0x7F7F7F7F, DM}; E.kind = 1; E.O = (bf16*)(ws + WS_QP); E.ldc = DM; E.rowss_in = (const float*)(ws + WS_ROWSS2); break;
#if EX_TOK8
        case PH_EXPERTS: if constexpr (ISO(11)) p14_experts_8(F); break;
#else
        case PH_EXPERTS: if constexpr (ISO(11)) p14_experts_sorted(F); break;
#endif
        default: break;
        }
#ifdef PROBE_LO
        if (is_gemm && args.pad) {
#if PROBE_FLAGS & 1
            g.K >>= 1;
#endif
#if PROBE_FLAGS & 2
            E.kind = 99;
#endif
#if PROBE_FLAGS & 4
            qk_phase = false; qk8_phase = false; pq_phase = false;
#endif
#if PROBE_FLAGS & 8
            E.pn_off = -100; E.rowss = nullptr;
#endif
#if PROBE_FLAGS & 32
            is_gemm = false;
#endif
#if PROBE_FLAGS & 64
            if ((F.bx >> 3) & 1) { const unsigned long long t0 = __builtin_amdgcn_s_memrealtime(); while (__builtin_amdgcn_s_memrealtime() - t0 < (unsigned long long)(PROBE_DLY)) __builtin_amdgcn_s_sleep(8); }
#endif
        }
#endif
#ifndef NO_GEMM
        if constexpr (ISO(100)) if (is_gemm) { pg8::StaticOrder S; S.init(g.M, g.N, F.G, (mq_phase && F.bx >= 128) ? F.bx - 128 : F.bx); S.kshift = ksplit ? 1 : 0;
            if (fp8) pg8::gemm_phase<pg8::EpiAny, pg8::StaticOrder, true, true, true>(F.lds, g, S, E); else pg8::gemm_phase<pg8::EpiAny, pg8::StaticOrder, true, true, false>(F.lds, g, S, E); }
        if constexpr (ISO(1)) if (qk_phase) {
            asm volatile("s_waitcnt vmcnt(0)" ::: "memory"); __syncthreads();
            pg8::StaticOrder S; pg8::Unit u; S.init(M_TOK, N_QK, F.G, F.bx);
            for (int i = 0; S.next(i, u); ++i) fix_own_tile(F, proj, u.pm, u.pn, 2 + (u.pn >> 2)); }
        if constexpr (ISO(2)) if (qk8_phase) {
            asm volatile("s_waitcnt vmcnt(0)" ::: "memory"); __syncthreads();
            pg8::StaticOrder S; pg8::Unit u; S.init(M_TOK, N_REST, F.G, F.bx);
            for (int i = 0; S.next(i, u); ++i) if (u.pn < 8) fix_own_tile(F, proj, u.pm, u.pn + 8, u.pn >> 2); }
        if constexpr (ISO(10)) if (pq_phase) {
            asm volatile("s_waitcnt vmcnt(0)" ::: "memory"); __syncthreads();
            pg8::StaticOrder S; pg8::Unit u; S.init(M_TOK, DM, F.G, F.bx);
            for (int i = 0; S.next(i, u); ++i) p13_topk_unit(F, u.pm, u.pn); }
        if constexpr (ISO(7)) if (mq_phase) {
            pg8::StaticOrder S; pg8::Unit u;
#if defined(PROBE_LO) && (PROBE_FLAGS & 32)
            if (args.pad) {} else
#endif
            if (F.bx < 128) { S.init(M_TOK, 512, F.G, F.bx); if (S.next(0, u)) norm_own_tile(F, (bf16*)(ws + WS_QM), 512, u.pm * 256, u.pn * 256, args.in[I_MEMQ_G], QK_C2); }
            else { S.init(NB * 256, 1024, F.G, F.bx - 128); if (S.next(0, u) && u.pn < 2) norm_own_tile(F, (bf16*)(ws + WS_KVM), 1024, u.pm * 256, u.pn * 256, args.in[I_MEMK_G], 1.f); }
#if defined(PROBE_LO) && (PROBE_FLAGS & 16)
            if (!args.pad)
#endif
            p8_convert_peer(F); }
#endif
        if (barrier_after && ph + 1 < args.ph_hi) xcd_barrier(bar);
    }
    if (xb_ld((unsigned*)(ctl + CW_BAR) + XB_TMO) != 0u) { const float q = __builtin_nanf(""); for (size_t i = (size_t)F.bx * 512 + F.tid; i < (size_t)M_TOK * DM / 4; i += (size_t)F.G * 512) ((f32x4*)args.out)[i] = (f32x4){q, q, q, q}; }
}

#ifdef PROBE_CVT
__global__ void __launch_bounds__(512) bench_cvt(float* sink) {
    const int lane = threadIdx.x & 63;
#if PROBE_CVT == 1
    typedef unsigned v6u_ __attribute__((ext_vector_type(6))); typedef float v32f_ __attribute__((ext_vector_type(32)));
    v6u_ src = {(unsigned)lane, 2u, 3u, 4u, 5u, 6u}; float a0 = 0.f, a1 = 0.f;
#pragma unroll 4
    for (int it = 0; it < 16384; ++it) { src[0] += 1u; const v32f_ r = __builtin_amdgcn_cvt_scalef32_pk32_f32_fp6(src, 1.0f); a0 += r[0]; a1 += r[31]; }
    if (a0 + a1 == 12345.678f) sink[0] = 0.f;
#else
    unsigned s0 = (unsigned)lane; f32x2 acc = {0.f, 0.f};
#pragma unroll 4
    for (int it = 0; it < 16384; ++it) {
#pragma unroll
        for (int w = 0; w < 8; ++w) { s0 += 1u; acc += __builtin_amdgcn_cvt_pk_f32_fp8((int)s0, false); acc += __builtin_amdgcn_cvt_pk_f32_fp8((int)s0, true); } }
    if (acc.x + acc.y == 12345.678f) sink[0] = 0.f;
#endif
}
#endif
#ifdef PROBE_EPI
template <int PAT> __global__ void __launch_bounds__(512) bench_epi(const float* X, unsigned short* Y) {
    const int w = threadIdx.x >> 6, lane = threadIdx.x & 63;
    for (int t = 0; t < PROBE_EPI_T; ++t) { const int L = t * 256 + blockIdx.x, pn = L & 7, pm = (L >> 3) & 63;
        if (PAT == 0) { const int wr = w >> 2, wc = w & 3, fr = lane & 15, fq = lane >> 4; const int row0 = pm * 256 + wr * 64 + fr, col0 = pn * 256 + wc * 32 + 8 * fq;
#pragma unroll
            for (int ai = 0; ai < 2; ++ai) { f32x4 ld[4][2][2];
#pragma unroll
                for (int m = 0; m < 4; ++m)
#pragma unroll
                    for (int bj = 0; bj < 2; ++bj) { const float* p = X + (size_t)(row0 + ai * 128 + m * 16) * 2048 + col0 + bj * 128; ld[m][bj][0] = __builtin_nontemporal_load((const f32x4*)p); ld[m][bj][1] = __builtin_nontemporal_load((const f32x4*)(p + 4)); }
#pragma unroll
                for (int m = 0; m < 4; ++m)
#pragma unroll
                    for (int bj = 0; bj < 2; ++bj) { v4u o; o.x = pk2(ld[m][bj][0][0], ld[m][bj][0][1]); o.y = pk2(ld[m][bj][0][2], ld[m][bj][0][3]); o.z = pk2(ld[m][bj][1][0], ld[m][bj][1][1]); o.w = pk2(ld[m][bj][1][2], ld[m][bj][1][3]);
                        *(v4u*)(Y + (size_t)(row0 + ai * 128 + m * 16) * 2048 + col0 + bj * 128) = o; }
                asm volatile("" ::: "memory"); }
        } else {
#pragma unroll
            for (int h = 0; h < 2; ++h) { f32x4 ld[16];
#pragma unroll
                for (int r = 0; r < 16; ++r) ld[r] = __builtin_nontemporal_load((const f32x4*)(X + (size_t)(pm * 256 + w * 32 + h * 16 + r) * 2048 + pn * 256) + lane);
#pragma unroll
                for (int r = 0; r < 16; ++r) { unsigned long long o = (unsigned long long)pk2(ld[r][0], ld[r][1]) | ((unsigned long long)pk2(ld[r][2], ld[r][3]) << 32);
                    *((unsigned long long*)(Y + (size_t)(pm * 256 + w * 32 + h * 16 + r) * 2048 + pn * 256) + lane) = o; }
                asm volatile("" ::: "memory"); }
        }
    }
}
#endif
extern "C" void kernel_launch(void* const* d_in, const int* in_sizes, int n_in, void* d_out, int out_size, void* d_ws, size_t ws_size, hipStream_t stream) {
    static int grid = 0;
    if (grid == 0) {
        if (n_in != 23 || out_size != M_TOK * DM || ws_size < WS_END) { fprintf(stderr, "kernel_launch: unexpected shapes (n_in %d out %d ws %zu)\n", n_in, out_size, ws_size); grid = -1; return; }
        int dev = 0, cus = 0, per_cu = 0;
        if (hipGetDevice(&dev) != hipSuccess || hipDeviceGetAttribute(&cus, hipDeviceAttributeMultiprocessorCount, dev) != hipSuccess) { grid = -1; return; }
        if (hipFuncSetAttribute((const void*)mega_fwd, hipFuncAttributeMaxDynamicSharedMemorySize, LDS_BYTES) != hipSuccess) { fprintf(stderr, "hipFuncSetAttribute failed\n"); grid = -1; return; }
        if (hipOccupancyMaxActiveBlocksPerMultiprocessor(&per_cu, (const void*)mega_fwd, NWAVES * 64, LDS_BYTES) != hipSuccess || per_cu < 1) fprintf(stderr, "occupancy query reports %d\n", per_cu);
        (void)hipGetLastError();
        grid = cus;
        if (grid != 256) { fprintf(stderr, "kernel_launch: built for 256 CUs, got %d\n", cus); grid = -1; return; }
    }
    if (grid < 0) return;
    (void)hipMemsetAsync((char*)d_ws + WS_CTL, 0, CTL_ZERO_BYTES, stream);
    Args a{};
    for (int i = 0; i < 23; ++i) a.in[i] = (const float*)d_in[i];
    a.out = (float*)d_out; a.ws = (unsigned char*)d_ws;
#ifdef PROBE_CVT
    hipLaunchKernelGGL(bench_cvt, dim3(256), dim3(512), 0, stream, (float*)d_ws + (4u << 20));
#endif
#ifdef PROBE_PREFIX
    a.ph_lo = 0; a.ph_hi = PROBE_PREFIX;
#ifdef PROBE_P0_MASK
    a.p0_mask = PROBE_P0_MASK;
#else
    a.p0_mask = 3;
#endif
    hipLaunchKernelGGL(mega_fwd, dim3(grid), dim3(NWAVES * 64), LDS_BYTES, stream, a);
    (void)hipMemsetAsync((char*)d_ws + WS_CTL, 0, CTL_ZERO_BYTES, stream);
#endif
    a.ph_lo = 0; a.ph_hi = LAST_PHASE + 1; a.p0_mask = 3;
    hipLaunchKernelGGL(mega_fwd, dim3(grid), dim3(NWAVES * 64), LDS_BYTES, stream, a);
#ifdef PROBE_EPI
    for (int r = 0; r < 4; ++r) hipLaunchKernelGGL(bench_epi<PROBE_EPI>, dim3(256), dim3(512), 0, stream, (const float*)d_in[I_X], (unsigned short*)((char*)d_ws + 144 * MiB));
#endif
#ifdef PROBE_LO
    (void)hipMemsetAsync((char*)d_ws + WS_CTL, 0, CTL_ZERO_BYTES, stream);
    a.ph_lo = PROBE_LO; a.ph_hi = PROBE_HI; a.p0_mask = 3; a.pad = PROBE_FLAGS;
    for (int r = 0; r < PROBE_REP; ++r) hipLaunchKernelGGL(mega_fwd, dim3(grid), dim3(NWAVES * 64), LDS_BYTES, stream, a);
#endif
}
```

```cpp
#include <hip/hip_runtime.h>
#include <cstdio>
#include <cstdint>
#include <cmath>
namespace pg8 {
#define PG8_LAS __attribute__((address_space(3)))
typedef unsigned short bf16_t;
typedef short bf16x8 __attribute__((ext_vector_type(8)));
typedef float f32x4 __attribute__((ext_vector_type(4)));
typedef unsigned u32x4 __attribute__((ext_vector_type(4)));
constexpr int BM = 256, BK = 64, HALF = 128, HTB = HALF * BK * 2  , STAGE_BYTES = 8 * HTB, NXCD = 8, WGM = 8;

__host__ __device__ __forceinline__ int lds_byte(int r, int c) { const int st = (r >> 4) * 2 + (c >> 5), rr = r & 15, cc = c & 31, ob = rr * 64 + cc * 2; return st * 1024 + (ob ^ (((ob >> 9) & 1) << 5)); }
__host__ __device__ __forceinline__ void stage_rc(int b, int& R, int& C) { const int st = b / 1024, sb = b % 1024, swz = sb ^ (((sb >> 9) & 1) << 5); R = (st >> 1) * 16 + swz / 64; C = (st & 1) * 32 + (swz % 64) / 2; }
__host__ __device__ __forceinline__ int perm32(int rho) { const int n = rho >> 4, i = rho & 15; return 8 * (i >> 2) + 4 * n + (i & 3); }

struct Unit { int pm, pn, kp; };
typedef int pg8_v4i __attribute__((ext_vector_type(4)));
struct Gemm { const bf16_t* A; const bf16_t* Bt; int M, N, K, lda; int scale_b; int ldb; };

struct StaticOrder {
    int nM, nN, nwg, G, c, kshift = 0;
    __host__ __device__ __forceinline__ void init(int M, int N, int G_, int c_) { nM = M / BM; nN = N / BM; nwg = nM * nN; G = G_; c = c_; }
    __host__ __device__ __forceinline__ bool next(int i2, Unit& u) const {
        const int i = i2 >> kshift; u.kp = i2 & ((1 << kshift) - 1);
        const long L = (long)i * G + c; if (L >= nwg) return false;
        int wgid = (int)L; { const int q = nwg / NXCD, r = nwg % NXCD, xcd = wgid % NXCD, off = wgid / NXCD; wgid = (xcd < r ? xcd * (q + 1) : r * (q + 1) + (xcd - r) * q) + off; }
        const int nig = WGM * nN, gid = wgid / nig, fm = gid * WGM, gsz = (nM - fm) < WGM ? (nM - fm) : WGM;
        u.pm = fm + ((wgid % nig) % gsz); u.pn = (wgid % nig) / gsz; return true;
    }
    __device__ __forceinline__ void a_ready(const Unit&) const {}
    __device__ __forceinline__ void done(const Unit&) const {}
};

__device__ __forceinline__ unsigned cvt_pk_bf16(float lo, float hi) { unsigned r; asm volatile("v_cvt_pk_bf16_f32 %0, %1, %2" : "=v"(r) : "v"(lo), "v"(hi)); return r; }
typedef float f32x2 __attribute__((ext_vector_type(2)));
__device__ __forceinline__ f32x2 gelu_pk(f32x2 v) {
    const f32x2 av = __builtin_elementwise_abs(v), d = av * 0.2316418882f + 1.0f;
    f32x2 t; t.x = __builtin_amdgcn_rcpf(d.x); t.y = __builtin_amdgcn_rcpf(d.y);
    f32x2 q = t * 0.5307027145f + (-0.7265760135f); q = q * t + 0.7107068705f; q = q * t + (-0.142248368f); q = q * t + 0.127414796f; q = q * t;
    const f32x2 s = (v * v) * (-0.72134752044f);
    f32x2 e; e.x = __builtin_amdgcn_exp2f(s.x); e.y = __builtin_amdgcn_exp2f(s.y);
    const f32x2 m = v * (q * e), r = v - m;
    f32x2 o; o.x = v.x < 0.f ? m.x : r.x; o.y = v.y < 0.f ? m.y : r.y; return o;
}

template <int ACT  > struct EpiBf16 {
    static constexpr bool PERM = true, AFTER_DRAIN = false; static_assert(ACT == 0 || ACT == 1, "EpiBf16: ACT is 0 (none) or 1 (gelu_pk)");
    bf16_t* O; int ldc; const float* bias; int split_cols; size_t split_stride; float scale0;
    __device__ __forceinline__ void operator()(const f32x4 (&acc)[2][2][4][2], const Unit& u, int wr, int wc, int fr, int fq) const {
        const int row0 = u.pm * BM + wr * 64 + fr; int colt = u.pn * BM; bf16_t* base = O;
        float sc = 1.f; if (split_cols) { const int t = colt / split_cols; base += (size_t)t * split_stride; colt -= t * split_cols; if (t == 0) sc = scale0; }
        const int col0 = colt + wc * 32 + 8 * fq, bcol0 = u.pn * BM + wc * 32 + 8 * fq;
        f32x4 bv[2][2];
#pragma unroll
        for (int bj = 0; bj < 2; ++bj)
#pragma unroll
            for (int n = 0; n < 2; ++n) bv[bj][n] = bias ? *(const f32x4*)(bias + bcol0 + bj * HALF + 4 * n) : (f32x4){0.f, 0.f, 0.f, 0.f};
#pragma unroll
        for (int ai = 0; ai < 2; ++ai)
#pragma unroll
            for (int m = 0; m < 4; ++m) { bf16_t* rowp = base + (size_t)(row0 + ai * HALF + m * 16) * ldc + col0;
#pragma unroll
                for (int bj = 0; bj < 2; ++bj) { f32x4 v0 = acc[ai][bj][m][0] + bv[bj][0], v1 = acc[ai][bj][m][1] + bv[bj][1];
                    if (ACT == 1) { f32x2 a = gelu_pk((f32x2){v0[0], v0[1]}), b = gelu_pk((f32x2){v0[2], v0[3]}), c = gelu_pk((f32x2){v1[0], v1[1]}), d = gelu_pk((f32x2){v1[2], v1[3]});
                        v0 = (f32x4){a.x, a.y, b.x, b.y}; v1 = (f32x4){c.x, c.y, d.x, d.y}; }
                    v0 = v0 * sc; v1 = v1 * sc; u32x4 w; w.x = cvt_pk_bf16(v0[0], v0[1]); w.y = cvt_pk_bf16(v0[2], v0[3]); w.z = cvt_pk_bf16(v1[0], v1[1]); w.w = cvt_pk_bf16(v1[2], v1[3]);
                    *(u32x4*)(rowp + bj * HALF) = w; } }
    }
};

struct PanelStats {
    unsigned* xbuf;
    unsigned* cnt;
    unsigned* tmo;
    int ntn; float eps;
    unsigned code;
    __device__ __forceinline__ bool run(const f32x4 (&v)[2][2][4][2], const Unit& u, int wr, int wc, int fr, int fq, PG8_LAS unsigned char* lds, int wid, int lane) const {
        typedef float f32x2v __attribute__((ext_vector_type(2)));
        PG8_LAS f32x2v* P = (PG8_LAS f32x2v*)lds;
        PG8_LAS f32x2v* S = (PG8_LAS f32x2v*)(lds + 8192);
        PG8_LAS unsigned* flag = (PG8_LAS unsigned*)(lds + 8192 + 2048);
#pragma unroll
        for (int ai = 0; ai < 2; ++ai)
#pragma unroll
            for (int m = 0; m < 4; ++m) {
                float s = 0.f;
#pragma unroll
                for (int bj = 0; bj < 2; ++bj)
#pragma unroll
                    for (int n = 0; n < 2; ++n) { const f32x4 x = v[ai][bj][m][n]; s += (x[0] + x[1]) + (x[2] + x[3]); }
                s += __shfl_xor(s, 16); s += __shfl_xor(s, 32);
                const float mw = s * (1.0f / 64.0f); float q = 0.f;
#pragma unroll
                for (int bj = 0; bj < 2; ++bj)
#pragma unroll
                    for (int n = 0; n < 2; ++n) { const f32x4 d = v[ai][bj][m][n] - mw; q += (d[0] * d[0] + d[1] * d[1]) + (d[2] * d[2] + d[3] * d[3]); }
                q += __shfl_xor(q, 16); q += __shfl_xor(q, 32);
                if (fq == 0) P[(ai * HALF + wr * 64 + m * 16 + fr) * 4 + wc] = (f32x2v){mw, q};
            }
        asm volatile("s_waitcnt lgkmcnt(0)" ::: "memory"); __builtin_amdgcn_s_barrier(); asm volatile("" ::: "memory");
#if defined(BROKEN_EXCHANGE_NO_WAIT)
#warning BROKEN CONTROL BUILD: the row-statistics exchange does not wait; results are wrong by design
        if (blockIdx.x >= 64) { const long long t0_ = clock64(); while (clock64() - t0_ < 60000) __builtin_amdgcn_s_sleep(8); }
#endif
        const int row = wid * 32 + (lane & 31);
        if (lane < 32) {
            const f32x2v a = P[row * 4 + 0], b = P[row * 4 + 1], c = P[row * 4 + 2], d = P[row * 4 + 3];
            const float mt = (a.x + b.x + c.x + d.x) * 0.25f;
            const float da = a.x - mt, db = b.x - mt, dc = c.x - mt, dd = d.x - mt;
            const float m2 = (a.y + b.y) + (c.y + d.y) + 64.0f * ((da * da + db * db) + (dc * dc + dd * dd));
            unsigned long long* slot = (unsigned long long*)xbuf + ((size_t)(u.pm * BM + row) * 4 + u.pn);
            __hip_atomic_store(slot, ((unsigned long long)__float_as_uint(m2) << 32) | __float_as_uint(mt), __ATOMIC_RELAXED, __HIP_MEMORY_SCOPE_AGENT);
        }
        asm volatile("s_waitcnt vmcnt(0)" ::: "memory");
        if (lane == 0) __hip_atomic_fetch_add(cnt + 64 * u.pm, 1u, __ATOMIC_RELAXED, __HIP_MEMORY_SCOPE_AGENT);
        if (wid == 0) {
            bool dead = false; const unsigned long long t0 = __builtin_amdgcn_s_memrealtime(); const unsigned want = 8u * (unsigned)ntn;
            for (;;) {
#if defined(BROKEN_EXCHANGE_NO_WAIT)
                break;
#endif
                if ((unsigned)__builtin_amdgcn_readfirstlane(__hip_atomic_load(cnt + 64 * u.pm, __ATOMIC_RELAXED, __HIP_MEMORY_SCOPE_AGENT)) >= want) break;
                if (__builtin_amdgcn_s_memrealtime() - t0 > 2000000ull) {
                    if (lane == 0) { unsigned expect = 0u; __hip_atomic_compare_exchange_strong(tmo + 1, &expect, code | (unsigned)(u.pm & 0xff), __ATOMIC_RELAXED, __ATOMIC_RELAXED, __HIP_MEMORY_SCOPE_AGENT);
                                     __hip_atomic_store(tmo, 1u, __ATOMIC_RELAXED, __HIP_MEMORY_SCOPE_AGENT); }
                    dead = true; break; }
                __builtin_amdgcn_s_sleep(2);
            }
            __builtin_amdgcn_fence(__ATOMIC_ACQUIRE, "agent");
            if (lane == 0) flag[0] = dead ? 1u : 0u;
        }
        asm volatile("s_waitcnt vmcnt(0) lgkmcnt(0)" ::: "memory"); __builtin_amdgcn_s_barrier(); asm volatile("" ::: "memory");
        const bool bad = flag[0] != 0u;
        if (lane < 32) {
            const unsigned long long* slot = (const unsigned long long*)xbuf + (size_t)(u.pm * BM + row) * 4; float mt[4], m2[4]; float ms = 0.f;
#pragma unroll
            for (int t = 0; t < 4; ++t) { if (t < ntn) { const unsigned long long w = __hip_atomic_load(slot + t, __ATOMIC_RELAXED, __HIP_MEMORY_SCOPE_AGENT); mt[t] = __uint_as_float((unsigned)w); m2[t] = __uint_as_float((unsigned)(w >> 32)); } else { mt[t] = 0.f; m2[t] = 0.f; } ms += mt[t]; }
            const float mean = ms / (float)ntn; float q = 0.f;
#pragma unroll
            for (int t = 0; t < 4; ++t) if (t < ntn) { const float dm = mt[t] - mean; q += m2[t] + 256.0f * dm * dm; }
            S[row] = (f32x2v){mean, 1.0f / sqrtf(q / (256.0f * (float)ntn) + eps)};
        }
        asm volatile("s_waitcnt lgkmcnt(0)" ::: "memory"); __builtin_amdgcn_s_barrier(); asm volatile("" ::: "memory");
        return bad;
    }
};
struct EpiLnRes {
    static constexpr bool PERM = false, AFTER_DRAIN = true;
    const float* base; float* out; int ldc; const float* bias; PanelStats st; unsigned poison;
    __device__ __forceinline__ void fused(f32x4 (&acc)[2][2][4][2], const Unit& u, int wr, int wc, int fr, int fq, PG8_LAS unsigned char* lds, int wid, int lane) const {
        typedef float f32x2v __attribute__((ext_vector_type(2)));
        const PG8_LAS f32x2v* S = (const PG8_LAS f32x2v*)(lds + 8192);
        const int col0 = u.pn * BM + wc * 32 + 4 * fq;
#pragma unroll
        for (int bj = 0; bj < 2; ++bj)
#pragma unroll
            for (int n = 0; n < 2; ++n) { const f32x4 bv = bias ? *(const f32x4*)(bias + col0 + bj * HALF + n * 16) : (f32x4){0.f, 0.f, 0.f, 0.f};
#pragma unroll
                for (int ai = 0; ai < 2; ++ai)
#pragma unroll
                    for (int m = 0; m < 4; ++m) acc[ai][bj][m][n] += bv; }
        f32x4 pre[4][2][2];
#pragma unroll
        for (int m = 0; m < 4; ++m) { const size_t off = (size_t)(u.pm * BM + wr * 64 + m * 16 + fr) * ldc + col0;
#pragma unroll
            for (int bj = 0; bj < 2; ++bj)
#pragma unroll
                for (int n = 0; n < 2; ++n) pre[m][bj][n] = *(const f32x4*)(base + off + bj * HALF + n * 16); }
        const bool bad = st.run(acc, u, wr, wc, fr, fq, lds, wid, lane) || poison != 0u;
        const float qnan = __builtin_nanf("");
#pragma unroll
        for (int ai = 0; ai < 2; ++ai)
#pragma unroll
            for (int m = 0; m < 4; ++m) { const int r = ai * HALF + wr * 64 + m * 16 + fr; const f32x2v sr = S[r]; const size_t off = (size_t)(u.pm * BM + r) * ldc + col0;
#pragma unroll
                for (int bj = 0; bj < 2; ++bj)
#pragma unroll
                    for (int n = 0; n < 2; ++n) { const f32x4 bs = ai == 0 ? pre[m][bj][n] : *(const f32x4*)(base + off + bj * HALF + n * 16); f32x4 o = bs + (acc[ai][bj][m][n] - sr.x) * sr.y;
                        if (bad) o = (f32x4){qnan, qnan, qnan, qnan}; *(f32x4*)(out + off + bj * HALF + n * 16) = o; }
                if (m & 1) asm volatile("" ::: "memory"); }
    }
};
struct EpiLnResLn {
    static constexpr bool PERM = false, AFTER_DRAIN = true;
    const float* base; float* out; bf16_t* xn; int ldc; const float* bias; PanelStats st1, st2; unsigned poison;
    __device__ __forceinline__ void fused(f32x4 (&acc)[2][2][4][2], const Unit& u, int wr, int wc, int fr, int fq, PG8_LAS unsigned char* lds, int wid, int lane) const {
        typedef float f32x2v __attribute__((ext_vector_type(2))); typedef unsigned u32x2v __attribute__((ext_vector_type(2)));
        const PG8_LAS f32x2v* S = (const PG8_LAS f32x2v*)(lds + 8192);
        const int col0 = u.pn * BM + wc * 32 + 4 * fq;
#pragma unroll
        for (int bj = 0; bj < 2; ++bj)
#pragma unroll
            for (int n = 0; n < 2; ++n) { const f32x4 bv = bias ? *(const f32x4*)(bias + col0 + bj * HALF + n * 16) : (f32x4){0.f, 0.f, 0.f, 0.f};
#pragma unroll
                for (int ai = 0; ai < 2; ++ai)
#pragma unroll
                    for (int m = 0; m < 4; ++m) acc[ai][bj][m][n] += bv; }
        bool bad = st1.run(acc, u, wr, wc, fr, fq, lds, wid, lane) || poison != 0u;
        const float qnan = __builtin_nanf("");
#pragma unroll
        for (int ai = 0; ai < 2; ++ai)
#pragma unroll
            for (int m = 0; m < 4; ++m) { const int r = ai * HALF + wr * 64 + m * 16 + fr; const f32x2v sr = S[r]; const size_t off = (size_t)(u.pm * BM + r) * ldc + col0;
#pragma unroll
                for (int bj = 0; bj < 2; ++bj)
#pragma unroll
                    for (int n = 0; n < 2; ++n) { const f32x4 bs = *(const f32x4*)(base + off + bj * HALF + n * 16); acc[ai][bj][m][n] = bs + (acc[ai][bj][m][n] - sr.x) * sr.y; }
                asm volatile("" : "+v"(acc[ai][0][m][0]), "+v"(acc[ai][0][m][1]), "+v"(acc[ai][1][m][0]), "+v"(acc[ai][1][m][1]));
                if (m & 1) asm volatile("" ::: "memory"); }
        const bool bad1 = bad;
        bad = st2.run(acc, u, wr, wc, fr, fq, lds, wid, lane) || bad;
#pragma unroll
        for (int ai = 0; ai < 2; ++ai)
#pragma unroll
            for (int m = 0; m < 4; ++m) { const int r = ai * HALF + wr * 64 + m * 16 + fr; const f32x2v sr = S[r]; const size_t off = (size_t)(u.pm * BM + r) * ldc + col0;
#pragma unroll
                for (int bj = 0; bj < 2; ++bj)
#pragma unroll
                    for (int n = 0; n < 2; ++n) { const f32x4 x1 = acc[ai][bj][m][n]; *(f32x4*)(out + off + bj * HALF + n * 16) = bad1 ? (f32x4){qnan, qnan, qnan, qnan} : x1;
                        const f32x4 o = (x1 - sr.x) * sr.y; u32x2v w; w.x = cvt_pk_bf16(o[0], o[1]); w.y = cvt_pk_bf16(o[2], o[3]);
                        if (bad) { w.x = 0x7fc07fc0u; w.y = 0x7fc07fc0u; } *(u32x2v*)(xn + off + bj * HALF + n * 16) = w; }
                asm volatile("" ::: "memory"); }
    }
};

typedef int pg8_v8i __attribute__((ext_vector_type(8)));
template <bool FP8> struct Frag;
template <> struct Frag<false> { bf16x8 k[2]; };
template <> struct Frag<true> { pg8_v8i v; };
__device__ __forceinline__ void load_frag(Frag<false>& f, const PG8_LAS unsigned char* p) { f.k[0] = *(const PG8_LAS bf16x8*)p; f.k[1] = *(const PG8_LAS bf16x8*)(p + 1024); }
__device__ __forceinline__ void load_frag(Frag<true>& f, const PG8_LAS unsigned char* p) { const pg8_v4i a = *(const PG8_LAS pg8_v4i*)p, b = *(const PG8_LAS pg8_v4i*)(p + 1024); f.v = __builtin_shufflevector(a, b, 0, 1, 2, 3, 4, 5, 6, 7); }
__device__ __forceinline__ void mma_frag(f32x4& acc, const Frag<false>& b, const Frag<false>& a, int) { acc = __builtin_amdgcn_mfma_f32_16x16x32_bf16(b.k[0], a.k[0], acc, 0, 0, 0); acc = __builtin_amdgcn_mfma_f32_16x16x32_bf16(b.k[1], a.k[1], acc, 0, 0, 0); }
__device__ __forceinline__ void mma_frag(f32x4& acc, const Frag<true>& b, const Frag<true>& a, int scale_w) {
    asm volatile("v_mfma_scale_f32_16x16x128_f8f6f4 %0, %1, %2, %0, %3, %4 op_sel_hi:[0,0,0]" : "+v"(acc) : "v"(b.v), "v"(a.v), "v"(scale_w), "v"(0x7F7F7F7F)); }
template <class Epi, class Sched, bool ALIGN_EPI = false, bool SP2 = false, bool FP8 = false>
__device__ __forceinline__ void gemm_phase(PG8_LAS unsigned char* lds, const Gemm g, const Sched& S, const Epi& E) {
    int tid_ = threadIdx.x; asm volatile("" : "+v"(tid_));
    const int tid = tid_, wid = __builtin_amdgcn_readfirstlane(tid >> 6), lane = tid & 63, wr = wid >> 2, wc = wid & 3, fr = lane & 15, fq = lane >> 4;
    const int K = g.K, nt = K / BK;
    unsigned voffA[2], voffB[2];
#pragma unroll
    for (int i = 0; i < 2; ++i) { int R, C; stage_rc(tid * 16 + i * 8192, R, C); const int Rb = Epi::PERM ? ((R & ~31) + perm32(R & 31)) : R;
        voffA[i] = (unsigned)(R * g.lda + C) * 2u; voffB[i] = (unsigned)(Rb * g.ldb + C) * 2u; }
    const size_t kstep = (size_t)(BK * 2);
    const size_t hstepB = (size_t)HALF * g.ldb * 2, hstepA = (size_t)HALF * g.lda * 2;
    const size_t tstepB = 2 * hstepB, tstepA = 2 * hstepA;
    const unsigned ldsw = (unsigned)wid * 1024u;
    const int aoff = lds_byte(wr * 64 + fr, fq * 8), boff = lds_byte(wc * 32 + fr, fq * 8);
#define PG8_SA(b, h) (((b) * 2 + (h)) * HTB)
#define PG8_SB(b, h) ((4 + (b) * 2 + (h)) * HTB)
#define PG8_STAGE(bufoff, gbase, voff) do { _Pragma("unroll") for (int _i = 0; _i < 2; ++_i) \
        __builtin_amdgcn_global_load_lds((const unsigned*)((const char*)(gbase) + (voff)[_i]), (PG8_LAS unsigned*)(lds + (bufoff) + ldsw + _i * 8192), 16, 0, 0); } while (0)
#define PG8_LDA(dst, b, h) do { _Pragma("unroll") for (int m = 0; m < 4; ++m) load_frag(dst[m], lds + PG8_SA(b, h) + aoff + m * 2048); } while (0)
#define PG8_LDB(dst, b, h) do { _Pragma("unroll") for (int n = 0; n < 2; ++n) load_frag(dst[n], lds + PG8_SB(b, h) + boff + n * 2048); } while (0)
#define PG8_MMA(ai, bj, At, Bt) do { __builtin_amdgcn_s_setprio(1); _Pragma("unroll") for (int m = 0; m < 4; ++m) _Pragma("unroll") for (int n = 0; n < 2; ++n) mma_frag(acc[ai][bj][m][n], Bt[n], At[m], g.scale_b); \
        __builtin_amdgcn_s_setprio(0); } while (0)
#define PG8_WAIT_V(n) asm volatile("s_waitcnt vmcnt(" #n ")" ::: "memory")
#define PG8_WAIT_L(n) asm volatile("s_waitcnt lgkmcnt(" #n ")" ::: "memory")
#define PG8_BAR __builtin_amdgcn_s_barrier()
#define PG8_SCHED __builtin_amdgcn_sched_barrier(0)
    Unit cur, nxt; int ui = 0;
    if (!S.next(0, cur)) return;
    f32x4 acc[2][2][4][2];
#pragma unroll
    for (int a = 0; a < 2; ++a)
#pragma unroll
        for (int b = 0; b < 2; ++b)
#pragma unroll
            for (int m = 0; m < 4; ++m)
#pragma unroll
                for (int n = 0; n < 2; ++n) acc[a][b][m][n] = (f32x4){0.f, 0.f, 0.f, 0.f};
    Frag<FP8> At[4], B0[2], B1[2];
    const size_t kpart = (size_t)K * 2;
    const char* cA = (const char*)g.A + (size_t)cur.pm * tstepA + cur.kp * kpart; const char* cB = (const char*)g.Bt + (size_t)cur.pn * tstepB + cur.kp * kpart;
    S.a_ready(cur);
    if constexpr (SP2) {
        PG8_STAGE(PG8_SB(0, 0), cB, voffB); PG8_STAGE(PG8_SB(0, 1), cB + hstepB, voffB); PG8_STAGE(PG8_SA(0, 0), cA, voffA); PG8_STAGE(PG8_SA(0, 1), cA + hstepA, voffA);
        if (wr == 1) PG8_BAR;
        PG8_WAIT_V(2); PG8_BAR;
        PG8_STAGE(PG8_SB(1, 0), cB + kstep, voffB); PG8_STAGE(PG8_SA(1, 0), cA + kstep, voffA); PG8_STAGE(PG8_SB(1, 1), cB + hstepB + kstep, voffB);
        PG8_WAIT_V(6); PG8_BAR;
    } else {
        PG8_STAGE(PG8_SB(0, 0), cB, voffB); PG8_STAGE(PG8_SA(0, 0), cA, voffA); PG8_STAGE(PG8_SB(0, 1), cB + hstepB, voffB); PG8_STAGE(PG8_SA(0, 1), cA + hstepA, voffA);
        if (wr == 1) PG8_BAR;
        PG8_WAIT_V(4); PG8_BAR;
        PG8_STAGE(PG8_SB(1, 0), cB + kstep, voffB); PG8_STAGE(PG8_SA(1, 0), cA + kstep, voffA); PG8_STAGE(PG8_SB(1, 1), cB + hstepB + kstep, voffB);
        PG8_WAIT_V(6); PG8_BAR;
    }
    for (;;) {
        const bool has_next = S.next(ui + 1, nxt);
        const char* nA = has_next ? (const char*)g.A + (size_t)nxt.pm * tstepA + nxt.kp * kpart : cA; const char* nB = has_next ? (const char*)g.Bt + (size_t)nxt.pn * tstepB + nxt.kp * kpart : cB;
        for (int t = 0; t < nt; t += 2) {
            const bool last = (t == nt - 2);
            const char* a1 = cA + (size_t)(t + 1) * kstep;
            const char* a2 = last ? nA : cA + (size_t)(t + 2) * kstep; const char* b2 = last ? nB : cB + (size_t)(t + 2) * kstep;
            const char* a3 = a2 + kstep; const char* b3 = b2 + kstep;
            if (last && has_next) S.a_ready(nxt);
            if constexpr (SP2) {
            PG8_LDB(B0, 0, 0); PG8_LDB(B1, 0, 1); PG8_SCHED; PG8_LDA(At, 0, 0); PG8_STAGE(PG8_SA(1, 1), a1 + hstepA, voffA);
            PG8_WAIT_V(8); PG8_WAIT_L(0); PG8_BAR; PG8_MMA(0, 0, At, B0); PG8_MMA(0, 1, At, B1); PG8_BAR; PG8_SCHED;
            PG8_LDA(At, 0, 1); PG8_STAGE(PG8_SB(0, 0), b2, voffB); PG8_STAGE(PG8_SB(0, 1), b2 + hstepB, voffB); PG8_STAGE(PG8_SA(0, 0), a2, voffA);
            PG8_WAIT_V(8); PG8_WAIT_L(0); PG8_BAR; PG8_MMA(1, 0, At, B0); PG8_MMA(1, 1, At, B1); PG8_BAR; PG8_SCHED;
            PG8_LDB(B0, 1, 0); PG8_LDB(B1, 1, 1); PG8_SCHED; PG8_LDA(At, 1, 0); PG8_STAGE(PG8_SA(0, 1), a2 + hstepA, voffA);
            PG8_WAIT_V(8); PG8_WAIT_L(0); PG8_BAR; PG8_MMA(0, 0, At, B0); PG8_MMA(0, 1, At, B1); PG8_BAR; PG8_SCHED;
            PG8_LDA(At, 1, 1); PG8_STAGE(PG8_SB(1, 0), b3, voffB); PG8_STAGE(PG8_SB(1, 1), b3 + hstepB, voffB); PG8_STAGE(PG8_SA(1, 0), a3, voffA);
            PG8_WAIT_V(8); PG8_WAIT_L(0); PG8_BAR; PG8_MMA(1, 0, At, B0); PG8_MMA(1, 1, At, B1); PG8_BAR; PG8_SCHED;
            } else {
            PG8_LDB(B0, 0, 0); PG8_SCHED; PG8_LDA(At, 0, 0); PG8_STAGE(PG8_SA(1, 1), a1 + hstepA, voffA);
            PG8_WAIT_L(8); PG8_BAR; PG8_WAIT_L(0); PG8_MMA(0, 0, At, B0); PG8_BAR; PG8_SCHED;
            PG8_LDB(B1, 0, 1); PG8_STAGE(PG8_SB(0, 0), b2, voffB);
            PG8_BAR; PG8_WAIT_L(0); PG8_MMA(0, 1, At, B1); PG8_BAR;
            PG8_LDA(At, 0, 1); PG8_STAGE(PG8_SA(0, 0), a2, voffA);
            PG8_BAR; PG8_WAIT_L(0); PG8_MMA(1, 0, At, B0); PG8_BAR; PG8_SCHED;
            PG8_STAGE(PG8_SB(0, 1), b2 + hstepB, voffB);
            PG8_WAIT_V(6); PG8_BAR; PG8_MMA(1, 1, At, B1); PG8_BAR;
            PG8_LDB(B0, 1, 0); PG8_SCHED; PG8_LDA(At, 1, 0); PG8_STAGE(PG8_SA(0, 1), a2 + hstepA, voffA);
            PG8_WAIT_L(8); PG8_BAR; PG8_WAIT_L(0); PG8_MMA(0, 0, At, B0); PG8_BAR; PG8_SCHED;
            PG8_LDB(B1, 1, 1); PG8_STAGE(PG8_SB(1, 0), b3, voffB);
            PG8_BAR; PG8_WAIT_L(0); PG8_MMA(0, 1, At, B1); PG8_BAR;
            PG8_LDA(At, 1, 1); PG8_STAGE(PG8_SA(1, 0), a3, voffA);
            PG8_BAR; PG8_WAIT_L(0); PG8_MMA(1, 0, At, B0); PG8_BAR; PG8_SCHED;
            PG8_STAGE(PG8_SB(1, 1), b3 + hstepB, voffB);
            PG8_WAIT_V(6); PG8_BAR; PG8_MMA(1, 1, At, B1); PG8_BAR;
            }
        }
        if constexpr (ALIGN_EPI) { if (wr == 0) PG8_BAR; }
        if constexpr (FP8) { asm volatile("s_nop 15\n\ts_nop 15" ::: "memory"); }
        if constexpr (!Epi::AFTER_DRAIN) { E(acc, cur, wr, wc, fr, fq); S.done(cur); }
        if (!has_next) break;
        if (nxt.kp == 0)
#pragma unroll
        for (int a = 0; a < 2; ++a)
#pragma unroll
            for (int b = 0; b < 2; ++b)
#pragma unroll
                for (int m = 0; m < 4; ++m)
#pragma unroll
                    for (int n = 0; n < 2; ++n) acc[a][b][m][n] = (f32x4){0.f, 0.f, 0.f, 0.f};
        cur = nxt; cA = nA; cB = nB; ++ui;
        if constexpr (ALIGN_EPI) { if (wr == 1) PG8_BAR; }
    }
    PG8_WAIT_V(0);
    if constexpr (!ALIGN_EPI) { if (wr == 0) PG8_BAR; }
    PG8_BAR;
    if constexpr (Epi::AFTER_DRAIN) { E.fused(acc, cur, wr, wc, fr, fq, lds, wid, lane); S.done(cur); }
#undef PG8_SA
#undef PG8_SB
#undef PG8_STAGE
#undef PG8_LDA
#undef PG8_LDB
#undef PG8_MMA
#undef PG8_WAIT_V
#undef PG8_WAIT_L
#undef PG8_BAR
#undef PG8_SCHED
}
}

#ifndef PG8_SP2
#define PG8_SP2 true
#endif
#ifndef PG8_ALIGN
#define PG8_ALIGN true
#endif
#ifndef GATE_U8
#define GATE_U8 1
#endif
#define GATE_PN0 28
#define GATE_PN1 36
namespace pg8 {
typedef unsigned u32x2e __attribute__((ext_vector_type(2)));
__device__ __forceinline__ float bfbits2f(unsigned b16) { return __uint_as_float(b16 << 16); }
__device__ __forceinline__ void unpack8(const u32x4 w, float (&f)[8]) {
    f[0] = __uint_as_float(w.x << 16); f[1] = __uint_as_float(w.x & 0xffff0000u); f[2] = __uint_as_float(w.y << 16); f[3] = __uint_as_float(w.y & 0xffff0000u);
    f[4] = __uint_as_float(w.z << 16); f[5] = __uint_as_float(w.z & 0xffff0000u); f[6] = __uint_as_float(w.w << 16); f[7] = __uint_as_float(w.w & 0xffff0000u);
}
__device__ __forceinline__ u32x4 pack8f(const float (&f)[8]) { u32x4 w; w.x = cvt_pk_bf16(f[0], f[1]); w.y = cvt_pk_bf16(f[2], f[3]); w.z = cvt_pk_bf16(f[4], f[5]); w.w = cvt_pk_bf16(f[6], f[7]); return w; }
__device__ __forceinline__ void unpack8u(const u32x2e w, float (&f)[8]) {
    f[0] = (float)(w.x & 0xffu); f[1] = (float)((w.x >> 8) & 0xffu); f[2] = (float)((w.x >> 16) & 0xffu); f[3] = (float)(w.x >> 24);
    f[4] = (float)(w.y & 0xffu); f[5] = (float)((w.y >> 8) & 0xffu); f[6] = (float)((w.y >> 16) & 0xffu); f[7] = (float)(w.y >> 24);
}
__device__ __forceinline__ float sigmoid_f(float x) { return __builtin_amdgcn_rcpf(1.f + __builtin_amdgcn_exp2f(-1.4426950408889634f * x)); }

struct EpiProj {
    static constexpr bool PERM = true, AFTER_DRAIN = false;
    bf16_t* O; int ldc; int pn_off;
    __device__ __forceinline__ void operator()(const f32x4 (&acc)[2][2][4][2], const Unit& u, int wr, int wc, int fr, int fq) const {
        const int row0 = u.pm * BM + wr * 64 + fr, col0 = u.pn * BM + wc * 32 + 8 * fq;
        const int gpn = u.pn + pn_off; const int act = gpn < 24 ? 0 : (gpn < 28 ? 1 : 2);
#pragma unroll
        for (int ai = 0; ai < 2; ++ai)
#pragma unroll
            for (int m = 0; m < 4; ++m) { bf16_t* rowp = O + (size_t)(row0 + ai * HALF + m * 16) * ldc + col0;
#pragma unroll
                for (int bj = 0; bj < 2; ++bj) { float v[8];
#pragma unroll
                    for (int i = 0; i < 4; ++i) { v[i] = acc[ai][bj][m][0][i]; v[4 + i] = acc[ai][bj][m][1][i]; }
                    if (act != 0) {
#pragma unroll
                        for (int i = 0; i < 8; ++i) { const float s = sigmoid_f(v[i]); v[i] = (act == 1) ? v[i] * s : s; } }
#if GATE_U8
                    if (act == 2) {
                        const int cb = gpn >= GATE_PN1 ? GATE_PN1 * 256 : GATE_PN0 * 256;
                        unsigned char* gb = (unsigned char*)(O - pn_off * 256 + (size_t)(row0 + ai * HALF + m * 16) * ldc + cb) + (gpn * 256 - cb) + wc * 32 + 8 * fq + bj * HALF;
                        unsigned p0 = 0u, p1 = 0u;
#pragma unroll
                        for (int i = 0; i < 4; ++i) { p0 = __builtin_amdgcn_cvt_pk_u8_f32(fmaxf(floorf(v[i] * 255.f + 0.5f), 1.f), i, p0); p1 = __builtin_amdgcn_cvt_pk_u8_f32(fmaxf(floorf(v[4 + i] * 255.f + 0.5f), 1.f), i, p1); }
                        *(u32x2e*)gb = (u32x2e){p0, p1};
                    } else
#endif
#ifdef PROJ_NT
                    __builtin_nontemporal_store(pack8f(v), (u32x4*)(rowp + bj * HALF)); } }
#else
                    *(u32x4*)(rowp + bj * HALF) = pack8f(v); } }
#endif
    }
};
struct EpiRowScale {
    static constexpr bool PERM = true, AFTER_DRAIN = false;
    bf16_t* O; int ldc; const float* rowss; float inv_n, eps;
    __device__ __forceinline__ void operator()(const f32x4 (&acc)[2][2][4][2], const Unit& u, int wr, int wc, int fr, int fq) const {
        const int row0 = u.pm * BM + wr * 64 + fr, col0 = u.pn * BM + wc * 32 + 8 * fq;
        float sc[2][4];
#pragma unroll
        for (int ai = 0; ai < 2; ++ai)
#pragma unroll
            for (int m = 0; m < 4; ++m) sc[ai][m] = rowss ? rowss[row0 + ai * HALF + m * 16] : 0.f;
#pragma unroll
        for (int ai = 0; ai < 2; ++ai)
#pragma unroll
            for (int m = 0; m < 4; ++m) { const int row = row0 + ai * HALF + m * 16; bf16_t* rowp = O + (size_t)row * ldc + col0;
                const float s = rowss ? 1.f / sqrtf(sc[ai][m] * inv_n + eps) : 1.f;
#pragma unroll
                for (int bj = 0; bj < 2; ++bj) { float v[8];
#pragma unroll
                    for (int i = 0; i < 4; ++i) { v[i] = acc[ai][bj][m][0][i] * s; v[4 + i] = acc[ai][bj][m][1][i] * s; }
                    *(u32x4*)(rowp + bj * HALF) = pack8f(v); } }
    }
};
template <bool ADD> struct EpiGate {
    static constexpr bool PERM = true, AFTER_DRAIN = false;
    bf16_t* O; int ldc; const bf16_t* Gt; int ldg; unsigned char* O8; int ld8;
    __device__ __forceinline__ void operator()(const f32x4 (&acc)[2][2][4][2], const Unit& u, int wr, int wc, int fr, int fq) const {
        const int row0 = u.pm * BM + wr * 64 + fr, col0 = u.pn * BM + wc * 32 + 8 * fq;
#pragma unroll
        for (int ai = 0; ai < 2; ++ai)
#pragma unroll
            for (int m = 0; m < 4; ++m) { const int row = row0 + ai * HALF + m * 16; bf16_t* rowp = O + (size_t)row * ldc + col0; const bf16_t* gp = Gt + (size_t)row * ldg + col0;
#pragma unroll
                for (int bj = 0; bj < 2; ++bj) { float v[8], g[8]; unpack8(*(const u32x4*)(gp + bj * HALF), g);
#pragma unroll
                    for (int i = 0; i < 4; ++i) { v[i] = acc[ai][bj][m][0][i] * g[i]; v[4 + i] = acc[ai][bj][m][1][i] * g[4 + i]; }
                    if (ADD) { float t[8]; unpack8(*(const u32x4*)(rowp + bj * HALF), t);
#pragma unroll
                        for (int i = 0; i < 8; ++i) v[i] += t[i];
                        int p0 = 0, p1 = 0; p0 = __builtin_amdgcn_cvt_pk_fp8_f32(v[0], v[1], p0, false); p0 = __builtin_amdgcn_cvt_pk_fp8_f32(v[2], v[3], p0, true);
                        p1 = __builtin_amdgcn_cvt_pk_fp8_f32(v[4], v[5], p1, false); p1 = __builtin_amdgcn_cvt_pk_fp8_f32(v[6], v[7], p1, true);
                        if (O8) *(u32x2e*)(O8 + (size_t)row * ld8 + col0 + bj * HALF) = (u32x2e){(unsigned)p0, (unsigned)p1}; else *(u32x4*)(rowp + bj * HALF) = pack8f(v); }
                    else *(u32x4*)(rowp + bj * HALF) = pack8f(v); } }
    }
};
struct EpiGate8 {
    static constexpr bool PERM = true, AFTER_DRAIN = false;
    const bf16_t* G1; int ldg; unsigned char* O8; int ld8;
    __device__ __forceinline__ void operator()(const f32x4 (&acc)[2][2][4][2], const Unit& u, int wr, int wc, int fr, int fq) const {
        const int row0 = u.pm * BM + wr * 64 + fr, col0 = u.pn * BM + wc * 32 + 8 * fq;
#if GATE_U8
        u32x2e ld[2][4][2];
#pragma unroll
        for (int ai = 0; ai < 2; ++ai)
#pragma unroll
            for (int m = 0; m < 4; ++m)
#pragma unroll
                for (int bj = 0; bj < 2; ++bj) ld[ai][m][bj] = *(const u32x2e*)((const unsigned char*)(G1 + (size_t)(row0 + ai * HALF + m * 16) * ldg) + col0 + bj * HALF);
#else
        u32x4 ld[2][4][2];
#pragma unroll
        for (int ai = 0; ai < 2; ++ai)
#pragma unroll
            for (int m = 0; m < 4; ++m)
#pragma unroll
                for (int bj = 0; bj < 2; ++bj) ld[ai][m][bj] = *(const u32x4*)(G1 + (size_t)(row0 + ai * HALF + m * 16) * ldg + col0 + bj * HALF);
#endif
#pragma unroll
        for (int ai = 0; ai < 2; ++ai)
#pragma unroll
            for (int m = 0; m < 4; ++m) { const int row = row0 + ai * HALF + m * 16;
#pragma unroll
                for (int bj = 0; bj < 2; ++bj) { float v[8], g[8];
#if GATE_U8
                    unpack8u(ld[ai][m][bj], g);
#pragma unroll
                    for (int i = 0; i < 8; ++i) g[i] *= (1.f / 255.f);
#else
                    unpack8(ld[ai][m][bj], g);
#endif
#pragma unroll
                    for (int i = 0; i < 4; ++i) { v[i] = acc[ai][bj][m][0][i] * g[i]; v[4 + i] = acc[ai][bj][m][1][i] * g[4 + i]; }
                    int p0 = 0, p1 = 0; p0 = __builtin_amdgcn_cvt_pk_fp8_f32(v[0], v[1], p0, false); p0 = __builtin_amdgcn_cvt_pk_fp8_f32(v[2], v[3], p0, true);
                    p1 = __builtin_amdgcn_cvt_pk_fp8_f32(v[4], v[5], p1, false); p1 = __builtin_amdgcn_cvt_pk_fp8_f32(v[6], v[7], p1, true);
                    *(u32x2e*)(O8 + (size_t)row * ld8 + col0 + bj * HALF) = (u32x2e){(unsigned)p0, (unsigned)p1}; } }
    }
};
struct EpiResid {
    static constexpr bool PERM = true, AFTER_DRAIN = false;
    const float* base32; const bf16_t* base16; bf16_t* XB; int ldc; float* rowss;
    __device__ __forceinline__ void finish_row(float (&b)[8], const f32x4& a0, const f32x4& a1, float& ss, bf16_t* dst) const {
#pragma unroll
        for (int i = 0; i < 4; ++i) { b[i] += a0[i]; b[4 + i] += a1[i]; }
#pragma unroll
        for (int i = 0; i < 8; ++i) ss += b[i] * b[i];
        *(u32x4*)dst = pack8f(b);
    }
    __device__ __forceinline__ void operator()(const f32x4 (&acc)[2][2][4][2], const Unit& u, int wr, int wc, int fr, int fq) const {
        const int row0 = u.pm * BM + wr * 64 + fr, col0 = u.pn * BM + wc * 32 + 8 * fq;
        if (base32) {
#pragma unroll
            for (int ai = 0; ai < 2; ++ai) { f32x4 ld[4][2][2];
#pragma unroll
                for (int m = 0; m < 4; ++m)
#pragma unroll
                    for (int bj = 0; bj < 2; ++bj) { const float* p = base32 + (size_t)(row0 + ai * HALF + m * 16) * ldc + col0 + bj * HALF;
                        ld[m][bj][0] = __builtin_nontemporal_load((const f32x4*)p); ld[m][bj][1] = __builtin_nontemporal_load((const f32x4*)(p + 4)); }
#pragma unroll
                for (int m = 0; m < 4; ++m) { const int row = row0 + ai * HALF + m * 16; const size_t off = (size_t)row * ldc + col0; float ss = 0.f;
#pragma unroll
                    for (int bj = 0; bj < 2; ++bj) { float b[8] = {ld[m][bj][0][0], ld[m][bj][0][1], ld[m][bj][0][2], ld[m][bj][0][3], ld[m][bj][1][0], ld[m][bj][1][1], ld[m][bj][1][2], ld[m][bj][1][3]};
                        finish_row(b, acc[ai][bj][m][0], acc[ai][bj][m][1], ss, XB + off + bj * HALF); }
                    ss += __shfl_xor(ss, 16); ss += __shfl_xor(ss, 32);
                    if (fq == 0 && rowss) atomicAdd(rowss + row, ss); }
                asm volatile("" ::: "memory"); }
        } else {
            u32x4 ld[2][4][2];
#pragma unroll
            for (int ai = 0; ai < 2; ++ai)
#pragma unroll
                for (int m = 0; m < 4; ++m)
#pragma unroll
                    for (int bj = 0; bj < 2; ++bj) ld[ai][m][bj] = *(const u32x4*)(base16 + (size_t)(row0 + ai * HALF + m * 16) * ldc + col0 + bj * HALF);
#pragma unroll
            for (int ai = 0; ai < 2; ++ai)
#pragma unroll
                for (int m = 0; m < 4; ++m) { const int row = row0 + ai * HALF + m * 16; const size_t off = (size_t)row * ldc + col0; float ss = 0.f;
#pragma unroll
                    for (int bj = 0; bj < 2; ++bj) { float b[8]; unpack8(ld[ai][m][bj], b); finish_row(b, acc[ai][bj][m][0], acc[ai][bj][m][1], ss, XB + off + bj * HALF); }
                    ss += __shfl_xor(ss, 16); ss += __shfl_xor(ss, 32);
                    if (fq == 0 && rowss) atomicAdd(rowss + row, ss); }
        }
    }
};
struct EpiAny {
    static constexpr bool PERM = true, AFTER_DRAIN = false;
    int kind; bf16_t* O; int ldc; const bf16_t* Gt; int ldg; const float* base; const bf16_t* base16; float* rowss; const float* rowss_in; int pn_off; unsigned char* O8; int ld8; const bf16_t* Gt2;
    __device__ __forceinline__ void mid(f32x4 (&acc)[2][2][4][2], const Unit& u, int wr, int wc, int fr, int fq) const {
        const int row0 = u.pm * BM + wr * 64 + fr, col0 = u.pn * BM + wc * 32 + 8 * fq;
#pragma unroll
        for (int ai = 0; ai < 2; ++ai)
#pragma unroll
            for (int m = 0; m < 4; ++m) { const int row = row0 + ai * HALF + m * 16; const bf16_t* g0p = Gt + (size_t)row * ldg + col0; const bf16_t* g1p = Gt2 + (size_t)row * ldg + col0;
#pragma unroll
                for (int bj = 0; bj < 2; ++bj) { float a[8], b[8];
#if GATE_U8
                    unpack8u(*(const u32x2e*)((const unsigned char*)(Gt + (size_t)row * ldg) + col0 + bj * HALF), a); unpack8u(*(const u32x2e*)((const unsigned char*)(Gt2 + (size_t)row * ldg) + col0 + bj * HALF), b);
#else
                    unpack8(*(const u32x4*)(g0p + bj * HALF), a); unpack8(*(const u32x4*)(g1p + bj * HALF), b);
#endif
#pragma unroll
                    for (int i = 0; i < 4; ++i) { acc[ai][bj][m][0][i] *= a[i] * __builtin_amdgcn_rcpf(b[i]); acc[ai][bj][m][1][i] *= a[4 + i] * __builtin_amdgcn_rcpf(b[4 + i]); } }
                if (m & 1) asm volatile("" ::: "memory"); }
    }
    __device__ __forceinline__ void operator()(f32x4 (&acc)[2][2][4][2], const Unit& u, int wr, int wc, int fr, int fq) const {
        if (kind == 7 && u.kp == 0) { mid(acc, u, wr, wc, fr, fq); return; }
        if (kind == 0) { EpiProj e{O, ldc, pn_off}; e(acc, u, wr, wc, fr, fq); }
        else if (kind == 1) { EpiRowScale e{O, ldc, rowss_in, 1.f / 2048.f, 1e-6f}; e(acc, u, wr, wc, fr, fq); }
        else if (kind == 2) { EpiGate<false> e{O, ldc, Gt, ldg, nullptr, 0}; e(acc, u, wr, wc, fr, fq); }
        else if (kind == 3) { EpiGate<true> e{O, ldc, Gt, ldg, O8, ld8}; e(acc, u, wr, wc, fr, fq); }
        else if (kind == 6) { EpiGate<true> e{O, ldc, Gt, ldg, nullptr, 0}; e(acc, u, wr, wc, fr, fq); }
        else if (kind == 7) { EpiGate8 e{Gt2, ldg, O8, ld8}; e(acc, u, wr, wc, fr, fq); }
#ifdef PROBE_LO
        else if (kind == 99) {}
#endif
        else { EpiResid e{base, base16, O, ldc, rowss}; e(acc, u, wr, wc, fr, fq); }
    }
};
}
#ifndef ATT_QREG
#define ATT_QREG 1
#endif
namespace att {
using bf16 = unsigned short;
typedef short bf16x8 __attribute__((ext_vector_type(8)));
typedef short s16x4 __attribute__((ext_vector_type(4)));
typedef float f32x16 __attribute__((ext_vector_type(16)));
typedef float f32x4 __attribute__((ext_vector_type(4)));
typedef unsigned u32x4 __attribute__((ext_vector_type(4)));
constexpr int D = 128, NW = 8, QBLK = 32, KVBLK = 64, QB = NW * QBLK;
constexpr int SHM_V = KVBLK * D * 2, SHM_K = KVBLK * D * 2;
constexpr int LDS_WS = 2 * SHM_V + 2 * SHM_K;
constexpr int LDS_BIAS = LDS_WS + NW * 64 * 4;
constexpr int LDS_Q = LDS_BIAS + 2048 * 4;
constexpr int LDS_BYTES = LDS_Q + NW * 8192;
constexpr float THR = 8.f;

#define KSWZ(row, colB) ((row) * 256 + ((colB) ^ (((row) & 7) << 4)))
#define SBAR() __builtin_amdgcn_sched_barrier(0)
__device__ __forceinline__ int v_st(int k, int c) { const int kk = (k & ~0xC) | ((k & 4) << 1) | ((k & 8) >> 1); return ((kk >> 3) * 4 + (c >> 5)) * 512 + ((kk & 7) * 32 + (c & 31)) * 2; }
__device__ __forceinline__ int v_rd_base(int lane) { return ((lane & 3) << 3) | (((lane >> 2) & 3) << 6) | (((lane >> 4) & 1) << 5) | (((lane >> 5) & 1) << 8); }
constexpr int v_rd_off(int d0, int ks, int half) { return d0 * 512 + ks * 4096 + half * 2048; }
__device__ __forceinline__ int crow(int r, int hi) { return (r & 3) + 8 * (r >> 2) + 4 * hi; }
__device__ __forceinline__ unsigned cvtpk(float lo, float hi) { unsigned r; asm volatile("v_cvt_pk_bf16_f32 %0, %1, %2" : "=v"(r) : "v"(lo), "v"(hi)); return r; }
__device__ __forceinline__ bf16x8 load8(const bf16* p) { return *reinterpret_cast<const bf16x8*>(p); }
__device__ __forceinline__ float bf2f(unsigned short b) { return __uint_as_float((unsigned)b << 16); }

__device__ __forceinline__ void mask_tile(f32x16& p0, f32x16& p1, int dq) {
    const float NEG = -__builtin_inff();
#pragma unroll
    for (int r = 0; r < 16; ++r) {
        const int c = (r & 3) + 8 * (r >> 2);
        if (dq - c < 0) p0[r] = NEG;
        if (dq - c - 32 < 0) p1[r] = NEG;
    }
}
__device__ __forceinline__ void partialSM(f32x16& p0, f32x16& p1, float& m_reg, float& mn, float& alpha) {
    float pmax = p0[0]; for (int r = 1; r < 16; ++r) pmax = fmaxf(pmax, p0[r]); for (int r = 0; r < 16; ++r) pmax = fmaxf(pmax, p1[r]);
    { auto rr = __builtin_amdgcn_permlane32_swap(__float_as_uint(pmax), __float_as_uint(pmax), false, false);
      pmax = fmaxf(__uint_as_float(rr[0]), __uint_as_float(rr[1])); }
    if (__builtin_expect(__all((pmax - m_reg) <= THR), 1)) { mn = m_reg; alpha = 1.f; }
    else { mn = fmaxf(m_reg, pmax); alpha = __builtin_amdgcn_exp2f(m_reg - mn); m_reg = mn; }
    for (int r = 0; r < 16; ++r) p0[r] = p0[r] - mn; for (int r = 0; r < 16; ++r) p1[r] = p1[r] - mn;
    for (int r = 0; r < 16; ++r) p0[r] = __builtin_amdgcn_exp2f(p0[r]);
}
#define ATT_PK4(P, B_, OUT) do { unsigned a0 = cvtpk(P[B_+0], P[B_+1]), a1 = cvtpk(P[B_+2], P[B_+3]);                          \
        unsigned b0 = cvtpk(P[B_+4], P[B_+5]), b1 = cvtpk(P[B_+6], P[B_+7]);                                             \
        auto r0 = __builtin_amdgcn_permlane32_swap(a0, b0, false, false); auto r1 = __builtin_amdgcn_permlane32_swap(a1, b1, false, false); \
        u32x4 w = {r0[0], r1[0], r0[1], r1[1]}; OUT = *reinterpret_cast<bf16x8*>(&w); } while (0)
__device__ __forceinline__ void finishSM(f32x16& p0, f32x16& p1, float alpha, float& l_reg, bf16x8& pa0, bf16x8& pa1, bf16x8& pa2, bf16x8& pa3) {
    for (int r = 0; r < 16; ++r) p1[r] = __builtin_amdgcn_exp2f(p1[r]);
    float ps = 0; for (int r = 0; r < 16; ++r) ps += p0[r]; for (int r = 0; r < 16; ++r) ps += p1[r];
    { auto rr = __builtin_amdgcn_permlane32_swap(__float_as_uint(ps), __float_as_uint(ps), false, false);
      ps = __uint_as_float(rr[0]) + __uint_as_float(rr[1]); }
    l_reg = l_reg * alpha + ps;
    ATT_PK4(p0, 0, pa0); ATT_PK4(p0, 8, pa1); ATT_PK4(p1, 0, pa2); ATT_PK4(p1, 8, pa3);
}
__device__ __forceinline__ void ret_weight(f32x16& p0, f32x16& p1, int dq, float lg, int dist) {
    if (dist < 0) { p0 = f32x16{}; p1 = f32x16{}; return; }
    if (dist > 0) { const float f = __builtin_amdgcn_exp2f(lg * 64.f * (float)dist);
#pragma unroll
        for (int r = 0; r < 16; ++r) { p0[r] *= f; p1[r] *= f; }
        return; }
#pragma unroll
    for (int r = 0; r < 16; ++r) {
        const int c = (r & 3) + 8 * (r >> 2);
        const float e0 = 2.f * lg * fmaxf((float)(c - dq), 0.f), e1 = 2.f * lg * fmaxf((float)(c + 32 - dq), 0.f);
        p0[r] *= __builtin_amdgcn_exp2f(e0); p1[r] *= __builtin_amdgcn_exp2f(e1);
    }
}
__device__ __forceinline__ void ret_pack(f32x16& p0, f32x16& p1, bf16x8& pa0, bf16x8& pa1, bf16x8& pa2, bf16x8& pa3) {
    ATT_PK4(p0, 0, pa0); ATT_PK4(p0, 8, pa1); ATT_PK4(p1, 0, pa2); ATT_PK4(p1, 8, pa3);
}
template <int KB, bool BIAS>
__device__ __forceinline__ void qkt(f32x16& p0, f32x16& p1, const char* K_lds, int r32, int hi, const char* Qw  , const float* bias_tile  , const bf16x8* qr = nullptr) {
    if (BIAS) {
#pragma unroll
        for (int g = 0; g < 4; ++g) { const f32x4 b0 = *(const f32x4*)(bias_tile + 8 * g), b1 = *(const f32x4*)(bias_tile + 32 + 8 * g);
            p0[4 * g] = b0[0]; p0[4 * g + 1] = b0[1]; p0[4 * g + 2] = b0[2]; p0[4 * g + 3] = b0[3];
            p1[4 * g] = b1[0]; p1[4 * g + 1] = b1[1]; p1[4 * g + 2] = b1[2]; p1[4 * g + 3] = b1[3]; }
    } else { p0 = f32x16{}; p1 = f32x16{}; }
    int ko[4];
#pragma unroll
    for (int dd = 0; dd < 4; ++dd) ko[dd] = KSWZ(r32, (dd * 16 + hi * 8) * 2);
#pragma unroll
    for (int d0 = 0; d0 < 8; ++d0) { const char* a = K_lds + KB * SHM_K + ko[d0 & 3] + (d0 >> 2) * 128;
        bf16x8 b0 = *reinterpret_cast<const bf16x8*>(a);
        bf16x8 b1 = *reinterpret_cast<const bf16x8*>(a + 32 * 256);
#if ATT_QREG
        bf16x8 q = qr[d0];
#else
        bf16x8 q = *reinterpret_cast<const bf16x8*>(Qw + ko[d0 & 3] + (d0 >> 2) * 128);
#endif
        p0 = __builtin_amdgcn_mfma_f32_32x32x16_bf16(b0, q, p0, 0, 0, 0);
        p1 = __builtin_amdgcn_mfma_f32_32x32x16_bf16(b1, q, p1, 0, 0, 0); }
}
template <int VB>
__device__ __forceinline__ void pv_tile(f32x16* o, int vb0, bf16x8 pa0, bf16x8 pa1, bf16x8 pa2, bf16x8 pa3) {
#define TRRD(dst, off) asm volatile("ds_read_b64_tr_b16 %0, %1 offset:%2" : "=&v"(dst) : "v"(vb0), "i"(off) : "memory")
#define PV_D0(d0) do { s16x4 l0, l1, l2, l3, h0, h1, h2, h3; constexpr int b_ = VB * SHM_V + v_rd_off(d0, 0, 0); \
        TRRD(l0, b_); TRRD(h0, b_ + 2048); TRRD(l1, b_ + 4096); TRRD(h1, b_ + 6144); TRRD(l2, b_ + 8192); TRRD(h2, b_ + 10240); TRRD(l3, b_ + 12288); TRRD(h3, b_ + 14336); \
        asm volatile("s_waitcnt lgkmcnt(0)" ::: "memory"); SBAR();   \
        o[d0] = __builtin_amdgcn_mfma_f32_32x32x16_bf16(pa0, (bf16x8){l0[0], l0[1], l0[2], l0[3], h0[0], h0[1], h0[2], h0[3]}, o[d0], 0, 0, 0);   \
        o[d0] = __builtin_amdgcn_mfma_f32_32x32x16_bf16(pa1, (bf16x8){l1[0], l1[1], l1[2], l1[3], h1[0], h1[1], h1[2], h1[3]}, o[d0], 0, 0, 0);   \
        o[d0] = __builtin_amdgcn_mfma_f32_32x32x16_bf16(pa2, (bf16x8){l2[0], l2[1], l2[2], l2[3], h2[0], h2[1], h2[2], h2[3]}, o[d0], 0, 0, 0);   \
        o[d0] = __builtin_amdgcn_mfma_f32_32x32x16_bf16(pa3, (bf16x8){l3[0], l3[1], l3[2], l3[3], h3[0], h3[1], h3[2], h3[3]}, o[d0], 0, 0, 0); } while (0)
    PV_D0(0); PV_D0(1); PV_D0(2); PV_D0(3);
#undef PV_D0
#undef TRRD
}

struct BlockRef { const bf16* Q; const bf16* K; const bf16* V; bf16* O; int P0; int skv; float lg; const bf16* RG; const float* GN; unsigned char* O8;   };
struct Seam { bf16x8 qr[8]; bf16x8 st_v0, st_v1, st_k0, st_k1; };
template <int MODE> struct Pitch { static constexpr int LDQ = (MODE == 2) ? 512 : 11264, LDK = (MODE == 2) ? 1024 : 11264, LDO = LDQ; };

#define ROWK(p, k0, rr) ((p) + (size_t)((k0) + (rr)) * LDK + sc)
#define VMW() asm volatile("s_waitcnt vmcnt(0)" ::: "memory")
#define VMWN(n) asm volatile("s_waitcnt vmcnt(%0)" :: "i"(n) : "memory")
#define SLOAD_H(Kp, Vp, k0) do { S.st_v0 = load8(ROWK(Vp, k0, sr)); S.st_v1 = load8(ROWK(Vp, k0, 32 + sr));              \
                         S.st_k0 = load8(ROWK(Kp, k0, sr)); S.st_k1 = load8(ROWK(Kp, k0, 32 + sr)); } while (0)
#define SWRITE_HK(bf) do { *(bf16x8*)(K_lds + (bf) * SHM_K + kws) = S.st_k0; *(bf16x8*)(K_lds + (bf) * SHM_K + kws + 32 * 256) = S.st_k1; } while (0)
#define SWRITE_HV(bf) do { *(bf16x8*)(V_lds + (bf) * SHM_V + vst0) = S.st_v0; *(bf16x8*)(V_lds + (bf) * SHM_V + vst1) = S.st_v1; } while (0)
#define SWRITE_H(bf) do { SWRITE_HV(bf); SWRITE_HK(bf); } while (0)

template <int MODE>
__device__ __forceinline__ void attn_prime(const BlockRef& cur, char* lds, Seam& S) {
    constexpr int LDQ = Pitch<MODE>::LDQ, LDK = Pitch<MODE>::LDK;
    int tid_ = threadIdx.x; asm volatile("" : "+v"(tid_));
    const int tid = tid_, wid = __builtin_amdgcn_readfirstlane(tid >> 6), lane = tid & 63, r32 = lane & 31, hi = lane >> 5;
    const int sr = tid >> 4, sc = (tid & 15) * 8, kws = KSWZ(sr, sc * 2); char* K_lds = lds + 2 * SHM_V;
    const int kb0 = 0;
    for (int d0 = 0; d0 < 8; ++d0) S.qr[d0] = load8(cur.Q + (size_t)(wid * QBLK + r32) * LDQ + d0 * 16 + hi * 8);
    SLOAD_H(cur.K, cur.V, kb0); VMW(); SWRITE_HK(0);
    __syncthreads();
}
template <int MODE>
__device__ __forceinline__ void attn_block(const BlockRef& cur, const BlockRef& nxt, char* lds, Seam& S) {
    constexpr int LDQ = Pitch<MODE>::LDQ, LDK = Pitch<MODE>::LDK, LDO = Pitch<MODE>::LDO;
    constexpr bool BIAS = (MODE == 0), SOFTMAX = (MODE != 1);
    int tid_ = threadIdx.x; asm volatile("" : "+v"(tid_));
    const int tid = tid_, wid = __builtin_amdgcn_readfirstlane(tid >> 6), lane = tid & 63, r32 = lane & 31, hi = lane >> 5;
    const int j_lo = 0;
    int j_hi = (cur.P0 + QB - 1) / KVBLK + 1; if (j_hi > cur.skv / KVBLK) j_hi = cur.skv / KVBLK;
    const int NT = j_hi - j_lo;
    const int kbn = 0;
    const int qlo = cur.P0 + wid * QBLK, qm = qlo + r32 - 4 * hi;
    char* V_lds = lds; char* K_lds = lds + 2 * SHM_V;
    float* ws = (float*)(lds + LDS_WS) + wid * 64; float* li_l = ws, * al_l = ws + 32;
    const float* bias = (const float*)(lds + LDS_BIAS) + 4 * hi;
    float m_reg = -1e30f, l_reg = 0; f32x16 o[4] = {};
    const int sr = tid >> 4, sc = (tid & 15) * 8, vst0 = v_st(sr, sc), vst1 = v_st(32 + sr, sc), kws = KSWZ(sr, sc * 2);
    const int vb0 = (int)(uintptr_t)V_lds + v_rd_base(lane);
    const bf16* Kh = cur.K; const bf16* Vh = cur.V;
    const float lg = cur.lg; const int cq = qlo >> 6;
#define RESC(a) do { if (SOFTMAX) { if (__any((a) < 1.f)) { if (hi == 0) al_l[r32] = (a); asm volatile("s_waitcnt lgkmcnt(0)" ::: "memory");              \
                     for (int d_ = 0; d_ < 4; ++d_) for (int r = 0; r < 16; ++r) o[d_][r] *= al_l[crow(r, hi)]; } } } while (0)
#define KBASE(t) ((j_lo + (t)) * KVBLK)
#define POSTQK(P0_, P1_, mnX, alX, t) do { const int kb_ = KBASE(t); \
        if (MODE == 1) { ret_weight(P0_, P1_, qm - kb_, lg, cq - (j_lo + (t))); } \
        else { if (MODE == 0 && (kb_ + KVBLK - 1 > qlo)) mask_tile(P0_, P1_, qm - kb_); partialSM(P0_, P1_, m_reg, mnX, alX); } } while (0)
#define FINISH(P0_, P1_, alX) do { if (MODE == 1) ret_pack(P0_, P1_, pa0, pa1, pa2, pa3); else finishSM(P0_, P1_, alX, l_reg, pa0, pa1, pa2, pa3); } while (0)
    constexpr int NQL = 8;
#define SEAM_K0() do { VMWN(NQL); SWRITE_HK(0); SBAR(); } while (0)
    f32x16 pA0, pA1, pB0, pB1; float mnA = 0.f, mnB = 0.f, alA = 1.f, alB = 1.f; bf16x8 pa0, pa1, pa2, pa3;
    char* Qw = lds + LDS_Q + wid * 8192;
#if ATT_QREG
    const bf16x8* QR = S.qr;
#else
    const bf16x8* QR = nullptr;
#pragma unroll
    for (int d0 = 0; d0 < 8; ++d0) *(bf16x8*)(Qw + KSWZ(r32, (d0 * 16 + hi * 8) * 2)) = S.qr[d0];
#endif
    SWRITE_HV(0); SBAR();
    if (NT > 1) { SLOAD_H(Kh, Vh, KBASE(1)); }
    SBAR(); qkt<0, BIAS>(pA0, pA1, K_lds, r32, hi, Qw, bias + KBASE(0), QR);
    POSTQK(pA0, pA1, mnA, alA, 0);
    if (NT > 1) { VMW(); SWRITE_H(1); }
    __syncthreads();
#define HALF_STEP(PX0, PX1, mnX, alX, PY0, PY1, alY, t, KB, VB, SB) do {                                                      \
        SBAR(); qkt<KB, BIAS>(PX0, PX1, K_lds, r32, hi, Qw, bias + KBASE(t), QR);                                             \
        FINISH(PY0, PY1, alY); SBAR();                                                           \
        if ((t) + 1 < NT) { SLOAD_H(Kh, Vh, KBASE((t) + 1)); SBAR(); }                                               \
        pv_tile<VB>(o, vb0, pa0, pa1, pa2, pa3); POSTQK(PX0, PX1, mnX, alX, (t));                                        \
        __syncthreads();                                                                                                      \
        if ((t) + 1 < NT) { VMW(); SWRITE_H(SB); }                                                                          \
        RESC(alX); __syncthreads(); } while (0)
    for (int t = 1; t + 1 < NT; t += 2) {
        HALF_STEP(pB0, pB1, mnB, alB, pA0, pA1, alA, t, 1, 0, 0);
        HALF_STEP(pA0, pA1, mnA, alA, pB0, pB1, alB, t + 1, 0, 1, 1);
    }
    const bool even = (NT & 1) == 0;
    if (even) { SBAR(); qkt<1, BIAS>(pB0, pB1, K_lds, r32, hi, Qw, bias + KBASE(NT - 1), QR); SBAR(); }
    { constexpr int LDQn = LDQ; SLOAD_H(nxt.K, nxt.V, kbn); SBAR();
#pragma unroll
      for (int d0 = 0; d0 < 8; ++d0) S.qr[d0] = load8(nxt.Q + (size_t)(wid * QBLK + r32) * LDQn + d0 * 16 + hi * 8); }
    SBAR();
    FINISH(pA0, pA1, alA); SBAR();
    pv_tile<0>(o, vb0, pa0, pa1, pa2, pa3);
    if (even) { POSTQK(pB0, pB1, mnB, alB, NT - 1); __syncthreads(); RESC(alB);
        FINISH(pB0, pB1, alB); SBAR(); pv_tile<1>(o, vb0, pa0, pa1, pa2, pa3); }
    SBAR(); SEAM_K0();
    bf16* Ow = cur.O + (size_t)(wid * QBLK) * LDO;
    if (MODE != 1) {
        if (hi == 0) li_l[r32] = l_reg; asm volatile("s_waitcnt lgkmcnt(0)" ::: "memory");
        float rli[16];
#pragma unroll
        for (int r = 0; r < 16; ++r) rli[r] = __builtin_amdgcn_rcpf(li_l[crow(r, hi)]);
#pragma unroll
        for (int r = 0; r < 16; ++r) { const int orow = crow(r, hi);
#pragma unroll
            for (int d0 = 0; d0 < 4; ++d0) { const float v = o[d0][r] * rli[r];
                const float vn = __shfl_xor(v, 1);
                if (cur.O8) { const int pk = __builtin_amdgcn_cvt_pk_fp8_f32(v, vn, 0, false); const int pk2 = __shfl_xor(pk, 2);
                    if ((r32 & 3) == 0) *(unsigned*)(cur.O8 + (size_t)(wid * QBLK + orow) * (MODE == 2 ? 512 : 2048) + d0 * 32 + r32) = ((unsigned)pk & 0xFFFFu) | ((unsigned)pk2 << 16); }
                else if ((r32 & 1) == 0) *(unsigned*)(Ow + (size_t)orow * LDO + d0 * 32 + r32) = cvtpk(v, vn); } }
    } else {
        float gn[4];
#pragma unroll
        for (int d0 = 0; d0 < 4; ++d0) gn[d0] = cur.GN[d0 * 32 + r32];
        const bf16* RGw = cur.RG + (size_t)(wid * QBLK) * LDO;
#pragma unroll
        for (int r = 0; r < 16; ++r) { const int orow = crow(r, hi);
            float s = (o[0][r] + o[1][r]) + (o[2][r] + o[3][r]);
#pragma unroll
            for (int x = 1; x < 32; x <<= 1) s += __shfl_xor(s, x);
            const float mean = s * (1.f / 128.f);
            float q = 0.f;
#pragma unroll
            for (int d0 = 0; d0 < 4; ++d0) { const float dlt = o[d0][r] - mean; q += dlt * dlt; }
#pragma unroll
            for (int x = 1; x < 32; x <<= 1) q += __shfl_xor(q, x);
            const float rstd = 1.f / sqrtf(q * (1.f / 128.f) + 1e-6f);
#pragma unroll
            for (int d0 = 0; d0 < 4; ++d0) { const float g = bf2f(RGw[(size_t)orow * LDO + d0 * 32 + r32]);
                const float v = (o[d0][r] - mean) * rstd * gn[d0] * g;
                const float vn = __shfl_xor(v, 1);
                if (cur.O8) { const int pk = __builtin_amdgcn_cvt_pk_fp8_f32(v, vn, 0, false); const int pk2 = __shfl_xor(pk, 2);
                    if ((r32 & 3) == 0) *(unsigned*)(cur.O8 + (size_t)(wid * QBLK + orow) * 2048 + d0 * 32 + r32) = ((unsigned)pk & 0xFFFFu) | ((unsigned)pk2 << 16); }
                else if ((r32 & 1) == 0) *(unsigned*)(Ow + (size_t)orow * LDO + d0 * 32 + r32) = cvtpk(v, vn); } }
    }
    __syncthreads();
#undef RESC
#undef KBASE
#undef POSTQK
#undef FINISH
#undef SEAM_K0
#undef HALF_STEP
}
#undef ROWK
#undef VMW
#undef VMWN
#undef SLOAD_H
#undef SWRITE_HK
#undef SWRITE_HV
#undef SWRITE_H
#undef SBAR
#undef KSWZ
#undef ATT_PK4
}
#define GAS __attribute__((address_space(1)))
#define LAS __attribute__((address_space(3)))
typedef unsigned short bf16;
typedef unsigned v4u __attribute__((ext_vector_type(4)));
typedef float f32x4 __attribute__((ext_vector_type(4)));
typedef short bf16x8 __attribute__((ext_vector_type(8)));
typedef GAS unsigned gu32;
typedef GAS unsigned long long gu64;
#define RLX_AGENT __ATOMIC_RELAXED, __HIP_MEMORY_SCOPE_AGENT
#define LDS_WAIT() asm volatile("s_waitcnt lgkmcnt(0)" ::: "memory")
#define VM_WAIT() asm volatile("s_waitcnt vmcnt(0)" ::: "memory")
__device__ __forceinline__ unsigned long long rt() { return __builtin_amdgcn_s_memrealtime(); }
__device__ __forceinline__ unsigned f2bf(float f) { unsigned u = __builtin_bit_cast(unsigned, f); return (u + 0x7fffu + ((u >> 16) & 1u)) >> 16; }
__device__ __forceinline__ unsigned pk2(float lo, float hi) { return f2bf(lo) | (f2bf(hi) << 16); }

#define XB_TMO      128
#define XB_XCNT(j)  (256  + 64 * (j))
#define XB_XSUB(j)  (1280 + 64 * (j))
#define XB_XGEN(j)  (2304 + 64 * (j))
#define XB_TOP      3328
#define XB_TOPGEN   3392
#define XCD_BAR_WORDS 3456
#define XB_SPIN_CAP (1u << 18)

__device__ __forceinline__ unsigned xb_ld(unsigned* p)              { return __hip_atomic_load(p, __ATOMIC_RELAXED, __HIP_MEMORY_SCOPE_AGENT); }
__device__ __forceinline__ unsigned xb_add(unsigned* p, unsigned v) { return __hip_atomic_fetch_add(p, v, __ATOMIC_RELAXED, __HIP_MEMORY_SCOPE_AGENT); }
__device__ __forceinline__ unsigned xb_xcc_id() { return (unsigned)__builtin_amdgcn_s_getreg((3 << 11) | 20) & 0xFu; }
#define XB_SPIN(cond, bar) do { unsigned _sp = 0; while (cond) { __builtin_amdgcn_s_sleep(1); \
    if ((++_sp & 255u) == 0u) { if (xb_ld(&(bar)[XB_TMO])) break; if (_sp > XB_SPIN_CAP) { atomicAdd(&(bar)[XB_TMO], 1u); break; } } } } while (0)

struct XcdBarrier {
    unsigned* bar; unsigned x;
    volatile LAS unsigned* st;
};

__device__ __forceinline__ XcdBarrier xcd_barrier_post(unsigned* bar, volatile LAS unsigned* st) {
    XcdBarrier b; b.bar = bar; b.x = xb_xcc_id(); b.st = st;
    if (threadIdx.x == 0) (void)xb_add(&bar[XB_XCNT(b.x)], 1u);
    return b;
}
__device__ __forceinline__ void xcd_barrier_complete(unsigned* bar, unsigned x, unsigned& nloc, unsigned& nx) {
    const unsigned G = gridDim.x * gridDim.y * gridDim.z;
    unsigned sum, cnt, mine, sp = 0u;
    for (;;) {
        sum = 0u; cnt = 0u; mine = 0u;
#pragma unroll
        for (unsigned j = 0; j < 16; ++j) { const unsigned c = xb_ld(&bar[XB_XCNT(j)]); sum += c; cnt += (c > 0u) ? 1u : 0u; mine = (j == x) ? c : mine; }
        if (sum == G) break;
        __builtin_amdgcn_s_sleep(1);
        if ((++sp & 255u) == 0u) { if (xb_ld(&bar[XB_TMO])) break; if (sp > XB_SPIN_CAP) { atomicAdd(&bar[XB_TMO], 1u); break; } }
    }
    nloc = mine > 0u ? mine : 1u; nx = cnt > 0u ? cnt : 1u;
}

__device__ __forceinline__ void xcd_barrier(const XcdBarrier& b) {
    asm volatile("s_waitcnt vmcnt(0)" ::: "memory");
    __syncthreads();
    if (threadIdx.x == 0) {
        unsigned* bar = b.bar;
        __builtin_amdgcn_s_waitcnt(0);
        unsigned nloc = b.st[0], nx = b.st[1];
        if (nloc == 0u) { xcd_barrier_complete(bar, b.x, nloc, nx); b.st[0] = nloc; b.st[1] = nx; }
        const unsigned old = xb_add(&bar[XB_XSUB(b.x)], 1u);
        const unsigned gen = old / nloc;
        if (old + 1u == (gen + 1u) * nloc) {
            __builtin_amdgcn_fence(__ATOMIC_RELEASE, "agent");
            asm volatile("s_waitcnt vmcnt(0)" ::: "memory");
            const unsigned og = xb_add(&bar[XB_TOP], 1u);
            const unsigned tg = og / nx;
            if (og + 1u == (tg + 1u) * nx) xb_add(&bar[XB_TOPGEN], 1u);
            else XB_SPIN(xb_ld(&bar[XB_TOPGEN]) == tg, bar);
            __builtin_amdgcn_fence(__ATOMIC_ACQUIRE, "agent");
            xb_add(&bar[XB_XGEN(b.x)], 1u);
            asm volatile("s_waitcnt vmcnt(0)" ::: "memory");
        } else {
            XB_SPIN(xb_ld(&bar[XB_XGEN(b.x)]) == gen, bar);
            __builtin_amdgcn_fence(__ATOMIC_ACQUIRE, "agent");
            asm volatile("s_waitcnt vmcnt(0)" ::: "memory");
        }
    }
    __syncthreads();
}
constexpr int NWAVES = 8;
constexpr int M_TOK = 16384, DM = 2048, SEQ = 2048, NB = 8;
constexpr int PP = 11264;
constexpr int C_RQ = 0, C_RK = 1024, C_FQ = 2048, C_FK = 3072, C_FV = 4096, C_RV = 5120, C_RG = 6144, C_G0 = 7168, C_G1 = 9216;
constexpr int N_QK = 2048, N_REST = 9216;
#ifndef FP8_UP_OUT
#define FP8_UP_OUT 1
#endif
constexpr int W8_SCALE_B = 0x79797979;
constexpr int N_IN_ORIG = 11272;
constexpr float RMS_EPS = 1e-6f;
constexpr float QK_C2 = 0.08838834764831845f * 1.4426950408889634f;
constexpr size_t MiB = 1u << 20;
constexpr size_t DO_XN8 = 0, DO_OCAT8 = 32 * MiB;
constexpr size_t DO_OFOX8 = DO_OCAT8, DO_ORET8 = DO_OCAT8 + 1024;
constexpr size_t WS_CTL = 0, CTL_ZERO_BYTES = 1 * MiB;
constexpr size_t WS_ROWSS1 = 256 * 1024, WS_ROWSS2 = 512 * 1024;
constexpr size_t WS_WIN = 1 * MiB, WS_WFOX = 45 * MiB, WS_WRET = 49 * MiB, WS_WOUT = 53 * MiB, WS_WMQ = 61 * MiB, WS_WMKV = 63 * MiB, WS_WMO = 67 * MiB, WS_WPQ = 69 * MiB, WS_SUBK = 77 * MiB;
constexpr size_t WS_PSCALE = 79 * MiB;
constexpr size_t WS_LOGF = 78 * MiB, WS_CUMF = 78 * MiB + 512 * 1024;
constexpr size_t WS_XN = 80 * MiB;
constexpr size_t WS_PROJ = 144 * MiB;
constexpr size_t WS_MN = 496 * MiB, WS_KVM = 504 * MiB, WS_END = 508 * MiB;
constexpr size_t WS_XB1B = 144 * MiB;
constexpr size_t WS_XB2 = FP8_UP_OUT ? WS_XB1B : WS_XN;
constexpr size_t WS_XB1 = FP8_UP_OUT ? WS_XN   : WS_XB1B, WS_QM = 208 * MiB, WS_OMEM = 224 * MiB, WS_PU = 240 * MiB, WS_PV = 304 * MiB, WS_QP = (FP8_UP_OUT ? 368 : 144) * MiB  , WS_IDX = 208 * MiB, WS_GATE = 216 * MiB;
constexpr int CW_BAR = 4096, CW_CONV = 64;
constexpr int RING_BYTES = 131072, LDS_BYTES = 147456, LDSCTL_OFF = LDS_BYTES - 1024, MISC_OFF = LDSCTL_OFF + 320;
static_assert(att::LDS_BYTES <= LDSCTL_OFF, "attention LDS");

struct Args { const float* in[23]; float* out; unsigned char* ws; int ph_lo, ph_hi; int p0_mask, pad; };
enum { I_X = 0, I_MEM, I_LN_MIX, I_W_IN, I_B_FORGET, I_FOXQ_G, I_FOXK_G, I_RET_G, I_W_FOXUP, I_W_RETUP, I_W_OUT, I_LN_MEM, I_MEMNORM_G, I_W_MQ, I_W_MKV, I_MEMQ_G, I_MEMK_G, I_W_MO, I_LN_FFN, I_W_PQ, I_SUBK, I_PEER_U, I_PEER_V };

#ifdef NO_NT
#define LDNT(p) (*(p))
#define STNT(v, p) (*(p) = (v))
#else
#define STNT(v, p) (*(p) = (v))
#define LDNT(p) __builtin_nontemporal_load(p)
#endif
__device__ __forceinline__ float wave_sum(float v) {
#pragma unroll
    for (int o = 1; o < 64; o <<= 1) v += __shfl_xor(v, o);
    return v;
}
__device__ __forceinline__ void transpose_item(const float* W, int ldw, int K, int src_col0, const float* kgain, bf16* WT, int dst_row0, LAS float* scr, int kb, int nb, int lane) {
    const int k0 = 64 * kb, n0 = 32 * nb;
    f32x4 ld[8];
#pragma unroll
    for (int i = 0; i < 8; ++i) ld[i] = LDNT((const GAS f32x4*)(W + (size_t)(k0 + 8 * i + (lane >> 3)) * ldw + src_col0 + n0 + 4 * (lane & 7)));
#pragma unroll
    for (int i = 0; i < 8; ++i) { const int kk = 8 * i + (lane >> 3); f32x4 v = ld[i]; if (kgain) v = v * kgain[k0 + kk]; LAS float* d = scr + kk * 33 + 4 * (lane & 7); d[0] = v.x; d[1] = v.y; d[2] = v.z; d[3] = v.w; }
    LDS_WAIT(); asm volatile("" ::: "memory");
    const int c = lane & 7;
#pragma unroll
    for (int j = 0; j < 4; ++j) { const int n = (lane >> 3) + 8 * j; const LAS float* s = scr + (8 * c) * 33 + n;
        v4u o; o.x = pk2(s[0 * 33], s[1 * 33]); o.y = pk2(s[2 * 33], s[3 * 33]); o.z = pk2(s[4 * 33], s[5 * 33]); o.w = pk2(s[6 * 33], s[7 * 33]);
        *(GAS v4u*)(WT + (size_t)(dst_row0 + n0 + n) * K + k0 + 8 * c) = o; }
    LDS_WAIT(); asm volatile("" ::: "memory");
}
__device__ __forceinline__ void transpose_item8(const float* W, int ldw, int K  , int src_col0, unsigned char* WT8  , int kb, int nb, LAS float* scr, int lane) {
    const int k0 = 64 * kb, n0 = 32 * nb;
    f32x4 ld[8];
#pragma unroll
    for (int i = 0; i < 8; ++i) ld[i] = LDNT((const GAS f32x4*)(W + (size_t)(k0 + 8 * i + (lane >> 3)) * ldw + src_col0 + n0 + 4 * (lane & 7)));
#pragma unroll
    for (int i = 0; i < 8; ++i) { const int kk = 8 * i + (lane >> 3); const f32x4 v = ld[i] * 64.f; LAS float* d = scr + kk * 33 + 4 * (lane & 7); d[0] = v.x; d[1] = v.y; d[2] = v.z; d[3] = v.w; }
    LDS_WAIT(); asm volatile("" ::: "memory");
    const int c = lane & 7;
#pragma unroll
    for (int j = 0; j < 4; ++j) { const int n = (lane >> 3) + 8 * j; const LAS float* s = scr + (8 * c) * 33 + n;
        int p0 = 0, p1 = 0; p0 = __builtin_amdgcn_cvt_pk_fp8_f32(s[0 * 33], s[1 * 33], p0, false); p0 = __builtin_amdgcn_cvt_pk_fp8_f32(s[2 * 33], s[3 * 33], p0, true);
        p1 = __builtin_amdgcn_cvt_pk_fp8_f32(s[4 * 33], s[5 * 33], p1, false); p1 = __builtin_amdgcn_cvt_pk_fp8_f32(s[6 * 33], s[7 * 33], p1, true);
        *(GAS unsigned long long*)(WT8 + (size_t)(n0 + n) * K + k0 + 8 * c) = (unsigned long long)(unsigned)p0 | ((unsigned long long)(unsigned)p1 << 32); }
    LDS_WAIT(); asm volatile("" ::: "memory");
}
struct TJob { const float* W; int ldw, K, N; const float* gain; bf16* WT; int fp8; };

__device__ __forceinline__ void rms_row_to_bf16(const float* xrow, const float* gain, bf16* orow, int lane, f32x4 (&hv)[8], unsigned char* orow8 = nullptr) {
    const GAS f32x4* xr = (const GAS f32x4*)xrow + lane; float s = 0.f;
#pragma unroll
    for (int j = 0; j < 8; ++j) { hv[j] = LDNT(xr + 64 * j); s += (hv[j].x * hv[j].x + hv[j].y * hv[j].y) + (hv[j].z * hv[j].z + hv[j].w * hv[j].w); }
    const float r = 1.f / sqrtf(wave_sum(s) * (1.f / DM) + RMS_EPS);
    GAS unsigned long long* o8 = (GAS unsigned long long*)orow + lane;
#pragma unroll
    for (int j = 0; j < 8; ++j) { const f32x4 g = ((const GAS f32x4*)gain)[lane + 64 * j]; hv[j] = hv[j] * r * g;
        o8[64 * j] = (unsigned long long)pk2(hv[j].x, hv[j].y) | ((unsigned long long)pk2(hv[j].z, hv[j].w) << 32);
        if (orow8) { int p = 0; p = __builtin_amdgcn_cvt_pk_fp8_f32(hv[j].x, hv[j].y, p, false); p = __builtin_amdgcn_cvt_pk_fp8_f32(hv[j].z, hv[j].w, p, true); ((GAS unsigned*)orow8)[lane + 64 * j] = (unsigned)p; } }
}
__device__ __forceinline__ float log_sigmoid_f(float z) { return fminf(z, 0.f) - 0.6931471805599453f * __builtin_amdgcn_logf(1.f + __builtin_amdgcn_exp2f(-1.4426950408889634f * fabsf(z))); }

struct Frame { LAS unsigned char* lds; unsigned char* ldsg; int tid, lane, wave, G, bx, p0_mask; const float* const* in; float* out; unsigned char* ws; };

__device__ __forceinline__ void p0_prologue(Frame& F) {
    const int gw = F.bx * NWAVES + F.wave, NGW = F.G * NWAVES;
    if (F.p0_mask & 1) {
        LAS float* scr = (LAS float*)(F.lds + F.wave * 16384);
        const TJob jobs[9] = {
            {F.in[I_W_IN], N_IN_ORIG, 2048, N_QK, nullptr, (bf16*)(F.ws + WS_WIN), 0},
            {F.in[I_W_IN], N_IN_ORIG, 2048, N_REST, nullptr, (bf16*)(F.ws + WS_WIN + 16 * MiB), 1},
            {F.in[I_W_FOXUP], 2048, 1024, 2048, nullptr, (bf16*)(F.ws + WS_WFOX), FP8_UP_OUT},
            {F.in[I_W_RETUP], 2048, 1024, 2048, nullptr, (bf16*)(F.ws + (FP8_UP_OUT ? WS_WFOX + 1024 : WS_WRET)), FP8_UP_OUT},
            {F.in[I_W_OUT], 2048, 2048, 2048, nullptr, (bf16*)(F.ws + WS_WOUT), FP8_UP_OUT},
            {F.in[I_W_MQ], 512, 2048, 512, F.in[I_LN_MEM], (bf16*)(F.ws + WS_WMQ), 0},
            {F.in[I_W_MKV], 1024, 2048, 1024, nullptr, (bf16*)(F.ws + WS_WMKV), 0},
            {F.in[I_W_MO], 2048, 512, 2048, nullptr, (bf16*)(F.ws + WS_WMO), 1},
            {F.in[I_W_PQ], 2048, 2048, 2048, F.in[I_LN_FFN], (bf16*)(F.ws + WS_WPQ), 0} };
        int base = 0;
#pragma unroll
        for (int j = 0; j < 9; ++j) {
            const TJob& J = jobs[j]; const int nblk = J.N / 32, items = (J.K / 64) * nblk;
            int first = gw - (base % NGW); if (first < 0) first += NGW;
            for (int r = first; r < items; r += NGW) { const int kb = r / nblk, nb = r % nblk;
                int src_col0 = 0;
                if (j == 0) src_col0 = 3080;
                if (j == 1) src_col0 = (nb * 32 < 3072) ? 0 : 2056;
                if (J.fp8) transpose_item8(J.W, J.ldw, (FP8_UP_OUT && (j == 2 || j == 3)) ? 2048 : J.K, src_col0, (unsigned char*)J.WT, kb, nb, scr, F.lane);
                else transpose_item(J.W, J.ldw, J.K, src_col0, J.gain, J.WT, 0, scr, kb, nb, F.lane); }
            base += items;
        }
    }
    if (F.p0_mask & 1) {
        const float* sk = F.in[I_SUBK]; bf16* o = (bf16*)(F.ws + WS_SUBK);
        for (int i = (F.bx * 512 + F.tid) * 4; i < 16 * 128 * 128; i += F.G * 512 * 4) { const f32x4 v = *(const GAS f32x4*)(sk + i);
            *(GAS unsigned long long*)(o + i) = (unsigned long long)pk2(v.x, v.y) | ((unsigned long long)pk2(v.z, v.w) << 32); }
    }
    __syncthreads();
    if (F.p0_mask & 2) {
        LAS float* wf = (LAS float*)F.lds; const float* w = F.in[I_W_IN];
        for (int k = F.tid; k < 2048; k += 512) { const f32x4 a = *(const GAS f32x4*)(w + (size_t)k * N_IN_ORIG + 3072), b = *(const GAS f32x4*)(w + (size_t)k * N_IN_ORIG + 3076);
            wf[0 * 2048 + k] = a.x; wf[1 * 2048 + k] = a.y; wf[2 * 2048 + k] = a.z; wf[3 * 2048 + k] = a.w; wf[4 * 2048 + k] = b.x; wf[5 * 2048 + k] = b.y; wf[6 * 2048 + k] = b.z; wf[7 * 2048 + k] = b.w; }
    }
    __syncthreads();
    if (F.p0_mask & 2) {
        const LAS float* wf = (const LAS float*)F.lds; const float* bfg = F.in[I_B_FORGET]; float* logf_o = (float*)(F.ws + WS_LOGF);
        for (int m = gw; m < M_TOK; m += NGW) { f32x4 hv[8];
            rms_row_to_bf16(F.in[I_X] + (size_t)m * DM, F.in[I_LN_MIX], (bf16*)(F.ws + WS_XN) + (size_t)m * DM, F.lane, hv, (unsigned char*)F.out + DO_XN8 + (size_t)m * DM);
            float z = 0.f;
#pragma unroll
            for (int q = 0; q < 8; ++q) { float acc = 0.f;
#pragma unroll
                for (int j = 0; j < 8; ++j) { const f32x4 wv = *(const LAS f32x4*)(wf + q * 2048 + 4 * F.lane + 256 * j); acc += (hv[j].x * wv.x + hv[j].y * wv.y) + (hv[j].z * wv.z + hv[j].w * wv.w); }
                acc = wave_sum(acc); z = (F.lane == q) ? acc : z;
                __builtin_amdgcn_sched_barrier(0); }
            if (F.lane < 8) logf_o[(size_t)m * 8 + F.lane] = log_sigmoid_f(z + bfg[F.lane]);
        }
        for (int m = gw; m < NB * 256; m += NGW) { f32x4 hv[8]; rms_row_to_bf16(F.in[I_MEM] + (size_t)m * DM, F.in[I_MEMNORM_G], (bf16*)(F.ws + WS_MN) + (size_t)m * DM, F.lane, hv); }
    }
}
__device__ __forceinline__ void p1_scan(Frame& F) {
    if (F.bx < 64) {
        const int b = F.bx >> 3, h = F.bx & 7; const float* lf = (const float*)(F.ws + WS_LOGF); float* cf = (float*)(F.ws + WS_CUMF) + (size_t)F.bx * SEQ;
        float v[4]; float run = 0.f;
#pragma unroll
        for (int i = 0; i < 4; ++i) { run += lf[(size_t)(b * SEQ + F.tid * 4 + i) * 8 + h]; v[i] = run; }
        float incl = run;
#pragma unroll
        for (int o = 1; o < 64; o <<= 1) { const float t = __shfl_up(incl, o); if (F.lane >= o) incl += t; }
        LAS float* wt = (LAS float*)F.lds;
        if (F.lane == 63) wt[F.wave] = incl;
        __syncthreads();
        float off = incl - run;
        for (int w = 0; w < F.wave; ++w) off += wt[w];
#pragma unroll
        for (int i = 0; i < 4; ++i) cf[F.tid * 4 + i] = v[i] + off;
    }
    __syncthreads();
}
__device__ __forceinline__ void unpack8s(const att::bf16x8 v, float (&f)[8]) {
#pragma unroll
    for (int i = 0; i < 8; ++i) f[i] = __uint_as_float((unsigned)(unsigned short)v[i] << 16);
}
__device__ __forceinline__ att::bf16x8 pack8s(const float (&f)[8]) { v4u w; w.x = pg8::cvt_pk_bf16(f[0], f[1]); w.y = pg8::cvt_pk_bf16(f[2], f[3]); w.z = pg8::cvt_pk_bf16(f[4], f[5]); w.w = pg8::cvt_pk_bf16(f[6], f[7]); return __builtin_bit_cast(att::bf16x8, w); }
__device__ __forceinline__ void p4_attention(Frame& F) {
    char* lds = (char*)F.ldsg;
    const int xcd = F.bx & 7, kk = F.bx >> 3;
    const int bh = (kk >> 2) * 8 + xcd, x = kk & 3, b = bh >> 3, h = bh & 7;
    if (bh >= 64) return;
    const att::bf16* proj = (const att::bf16*)(F.ws + WS_PROJ);
    const size_t rowb = (size_t)b * SEQ;
    if (F.p0_mask & 1) {
        float* tbl = (float*)(lds + att::LDS_BIAS); const float* cf = (const float*)(F.ws + WS_CUMF) + (size_t)bh * SEQ;
        const f32x4 v = *(const f32x4*)(cf + F.tid * 4); *(f32x4*)(tbl + F.tid * 4) = v * (-1.4426950408889634f);
        att::BlockRef r0, r1;
        r0.Q = proj + (rowb + (size_t)x * 256) * PP + C_FQ + h * 128; r0.K = proj + rowb * PP + C_FK + h * 128; r0.V = proj + rowb * PP + C_FV + h * 128; r0.O = (att::bf16*)r0.Q;
        r0.P0 = x * 256; r0.skv = SEQ; r0.lg = 0.f; r0.RG = nullptr; r0.GN = nullptr; r0.O8 = FP8_UP_OUT ? (unsigned char*)F.out + DO_OFOX8 + (rowb + (size_t)x * 256) * 2048 + h * 128 : nullptr;
        r1 = r0; r1.Q = proj + (rowb + (size_t)(7 - x) * 256) * PP + C_FQ + h * 128; r1.O = (att::bf16*)r1.Q; r1.P0 = (7 - x) * 256; r1.O8 = FP8_UP_OUT ? (unsigned char*)F.out + DO_OFOX8 + (rowb + (size_t)(7 - x) * 256) * 2048 + h * 128 : nullptr;
        att::Seam S;
        att::attn_prime<0>(r0, lds, S);
        att::attn_block<0>(r0, r1, lds, S);
        att::attn_block<0>(r1, r1, lds, S);
    }
    if (F.p0_mask & 2) {
        att::BlockRef r0, r1;
        r0.Q = proj + (rowb + (size_t)x * 256) * PP + C_RQ + h * 128; r0.K = proj + rowb * PP + C_RK + h * 128; r0.V = proj + rowb * PP + C_RV + h * 128; r0.O = (att::bf16*)r0.Q;
        r0.P0 = x * 256; r0.skv = SEQ; r0.lg = __builtin_amdgcn_logf(1.f - __builtin_amdgcn_exp2f(-5.f - (float)h))    ; r0.RG = proj + (rowb + (size_t)x * 256) * PP + C_RG + h * 128; r0.GN = F.in[I_RET_G] + h * 128; r0.O8 = FP8_UP_OUT ? (unsigned char*)F.out + DO_ORET8 + (rowb + (size_t)x * 256) * 2048 + h * 128 : nullptr;
        r1 = r0; r1.O8 = FP8_UP_OUT ? (unsigned char*)F.out + DO_ORET8 + (rowb + (size_t)(7 - x) * 256) * 2048 + h * 128 : nullptr; r1.Q = proj + (rowb + (size_t)(7 - x) * 256) * PP + C_RQ + h * 128; r1.O = (att::bf16*)r1.Q; r1.P0 = (7 - x) * 256; r1.RG = proj + (rowb + (size_t)(7 - x) * 256) * PP + C_RG + h * 128;
        att::Seam S;
        att::attn_prime<1>(r0, lds, S);
        att::attn_block<1>(r0, r1, lds, S);
        att::attn_block<1>(r1, r1, lds, S);
    }
}


__device__ __forceinline__ void p8_convert_peer(Frame& F) {
    const int lane = F.lane;
    f32x4 g[8];
#pragma unroll
    for (int j = 0; j < 8; ++j) g[j] = ((const GAS f32x4*)F.in[I_LN_FFN])[lane + 64 * j];
    float* scl = (float*)(F.ws + WS_PSCALE);
    int r0, rend, rstride;
#ifndef CV_R1
#define CV_R1 22272
#endif
#ifndef CVQ
#define CVQ 2
#endif
    if (F.bx >= 160) { r0 = (F.bx - 160) * NWAVES + F.wave; rend = CV_R1; rstride = 768; } else { r0 = CV_R1 + F.bx * NWAVES + F.wave; rend = 32768; rstride = 1280; }
#pragma unroll 1
    for (int rr = r0; rr < rend; rr += CVQ * rstride) {
        f32x4 v[CVQ][8]; float amax[CVQ]; bool ok[CVQ], isu[CVQ]; int ri[CVQ];
#pragma unroll
        for (int q = 0; q < CVQ; ++q) { const int r = rr + q * rstride; ok[q] = r < rend; const int rc = ok[q] ? r : rr; isu[q] = rc < 16384; ri[q] = rc; amax[q] = 0.f;
            const float* src = (isu[q] ? F.in[I_PEER_U] : F.in[I_PEER_V]) + (size_t)(rc & 16383) * DM;
#pragma unroll
#if defined(CV_LDS)
            for (int j = 0; j < 8; ++j) __builtin_amdgcn_global_load_lds((const unsigned*)((const f32x4*)src + lane + 64 * j), (LAS unsigned*)(F.lds + F.wave * (CVQ * 8192) + q * 8192 + j * 1024), 16, 0, CV_LDS); }
        asm volatile("s_waitcnt vmcnt(0)" ::: "memory");
#pragma unroll
        for (int q = 0; q < CVQ; ++q) {
#pragma unroll
            for (int j = 0; j < 8; ++j) v[q][j] = *(const LAS f32x4*)(F.lds + F.wave * (CVQ * 8192) + q * 8192 + j * 1024 + lane * 16); }
        LDS_WAIT(); asm volatile("" ::: "memory");
#elif !defined(CV_NO_NT)
            for (int j = 0; j < 8; ++j) v[q][j] = __builtin_nontemporal_load((const GAS f32x4*)src + lane + 64 * j); }
#else
            for (int j = 0; j < 8; ++j) v[q][j] = ((const GAS f32x4*)src)[lane + 64 * j]; }
#endif
#pragma unroll
        for (int q = 0; q < CVQ; ++q) {
#pragma unroll
            for (int j = 0; j < 8; ++j) { if (isu[q]) v[q][j] = v[q][j] * g[j]; amax[q] = fmaxf(amax[q], fmaxf(fmaxf(fabsf(v[q][j].x), fabsf(v[q][j].y)), fmaxf(fabsf(v[q][j].z), fabsf(v[q][j].w)))); }
#pragma unroll
            for (int o = 1; o < 64; o <<= 1) amax[q] = fmaxf(amax[q], __shfl_xor(amax[q], o));
            const float sc = amax[q] > 0.f ? amax[q] * (1.f / 448.f) : 1.f, inv = 1.f / sc;
            if (ok[q]) { if (lane == 0) scl[ri[q]] = sc;
                GAS unsigned* o4 = (GAS unsigned*)(F.ws + (isu[q] ? WS_PU : WS_PV) + (size_t)(ri[q] & 16383) * DM) + lane;
#pragma unroll
                for (int j = 0; j < 8; ++j) { int p = 0; p = __builtin_amdgcn_cvt_pk_fp8_f32(v[q][j].x * inv, v[q][j].y * inv, p, false); p = __builtin_amdgcn_cvt_pk_fp8_f32(v[q][j].z * inv, v[q][j].w * inv, p, true); o4[64 * j] = (unsigned)p; } } }
    }
}
__device__ __forceinline__ void norm_own_tile(Frame& F, bf16* base, int ld, int row0, int col0, const float* gain, float mul) {
    asm volatile("s_waitcnt vmcnt(0)" ::: "memory"); __syncthreads();
    const int lane = F.lane, rsel = lane >> 5, head = (lane >> 4) & 1, sub = lane & 15;
    float gv[8];
#pragma unroll
    for (int i = 0; i < 8; ++i) gv[i] = gain[sub * 8 + i] * mul;
#pragma unroll 1
    for (int r4 = 0; r4 < 16; r4 += 4) {
        att::bf16x8 v[4]; bf16* p[4];
#pragma unroll
        for (int q = 0; q < 4; ++q) { p[q] = base + (size_t)(row0 + F.wave * 32 + (r4 + q) * 2 + rsel) * ld + col0 + head * 128 + sub * 8; v[q] = *(const att::bf16x8*)p[q]; }
#pragma unroll
        for (int q = 0; q < 4; ++q) { float a[8]; unpack8s(v[q], a); float s = 0.f;
#pragma unroll
            for (int i = 0; i < 8; ++i) s += a[i] * a[i];
            s += __shfl_xor(s, 1); s += __shfl_xor(s, 2); s += __shfl_xor(s, 4); s += __shfl_xor(s, 8);
            const float rr = 1.f / sqrtf(s * (1.f / 128.f) + RMS_EPS);
#pragma unroll
            for (int i = 0; i < 8; ++i) a[i] *= rr * gv[i];
            *(att::bf16x8*)p[q] = pack8s(a); }
    }
}
__device__ __forceinline__ void fix_own_tile(Frame& F, bf16* proj, int pm, int pn, int kind) {
    const int lane = F.lane;
    if (kind < 2) {
        const int rsel = lane >> 5, head = (lane >> 4) & 1, sub = lane & 15; float gv[8];
#pragma unroll
        for (int i = 0; i < 8; ++i) gv[i] = kind == 0 ? F.in[I_FOXQ_G][sub * 8 + i] * QK_C2 : F.in[I_FOXK_G][sub * 8 + i];
#pragma unroll 1
        for (int r4 = 0; r4 < 16; r4 += 4) { att::bf16x8 v[4]; bf16* p[4];
#pragma unroll
            for (int q = 0; q < 4; ++q) { p[q] = proj + (size_t)(pm * 256 + F.wave * 32 + (r4 + q) * 2 + rsel) * PP + pn * 256 + head * 128 + sub * 8; v[q] = *(const att::bf16x8*)p[q]; }
#pragma unroll
            for (int q = 0; q < 4; ++q) { float a[8]; unpack8s(v[q], a); float s = 0.f;
#pragma unroll
                for (int i = 0; i < 8; ++i) s += a[i] * a[i];
                s += __shfl_xor(s, 1); s += __shfl_xor(s, 2); s += __shfl_xor(s, 4); s += __shfl_xor(s, 8);
                const float rr = 1.f / sqrtf(s * (1.f / 128.f) + RMS_EPS);
#pragma unroll
                for (int i = 0; i < 8; ++i) a[i] *= rr * gv[i];
                *(att::bf16x8*)p[q] = pack8s(a); } }
    } else {
        const int rsel = lane >> 4, head = (lane >> 3) & 1, sub = lane & 7; const float sc = kind == 3 ? 0.08838834764831845f : 1.f; float fr[8];
        const float lgh = __builtin_amdgcn_logf(1.f - __builtin_amdgcn_exp2f(-5.f - (float)((pn & 3) * 2 + head)));
#pragma unroll
        for (int i = 0; i < 8; ++i) fr[i] = __builtin_amdgcn_exp2f(-13.287712379549449f * (float)(sub * 8 + i) * (1.f / 64.f)) * 0.15915494309189535f;
#pragma unroll 1
        for (int r4 = 0; r4 < 8; r4 += 4) { att::bf16x8 va[4], vb[4]; bf16* p[4];
#pragma unroll
            for (int q = 0; q < 4; ++q) { p[q] = proj + (size_t)(pm * 256 + F.wave * 32 + (r4 + q) * 4 + rsel) * PP + pn * 256 + head * 128 + sub * 8; va[q] = *(const att::bf16x8*)p[q]; vb[q] = *(const att::bf16x8*)(p[q] + 64); }
#pragma unroll
            for (int q = 0; q < 4; ++q) { const int rowi = pm * 256 + F.wave * 32 + (r4 + q) * 4 + rsel; const float pos = (float)(rowi & (SEQ - 1)); float a[8], b[8], oa[8], ob[8]; unpack8s(va[q], a); unpack8s(vb[q], b);
                const float dsc = sc * __builtin_amdgcn_exp2f((kind == 2 ? lgh : -lgh) * (float)(rowi & 63));
#pragma unroll
                for (int i = 0; i < 8; ++i) { float rev = pos * fr[i]; rev -= rintf(rev); const float sn = __builtin_amdgcn_sinf(rev), cs = __builtin_amdgcn_cosf(rev);
                    oa[i] = (a[i] * cs - b[i] * sn) * dsc; ob[i] = (a[i] * sn + b[i] * cs) * dsc; }
                *(att::bf16x8*)p[q] = pack8s(oa); *(att::bf16x8*)(p[q] + 64) = pack8s(ob); } }
    }
}
__device__ __forceinline__ void p10_mem_attention(Frame& F) {
    char* lds = (char*)F.ldsg;
    const int b = F.bx >> 5, h = (F.bx >> 3) & 3, qb = F.bx & 7;
    att::BlockRef r0;
    const size_t qoff = ((size_t)b * SEQ + (size_t)qb * 256) * 512 + h * 128;
    r0.Q = (const att::bf16*)(F.ws + WS_QM) + qoff; r0.O = (att::bf16*)(F.ws + WS_OMEM) + qoff;
    r0.K = (const att::bf16*)(F.ws + WS_KVM) + (size_t)(b * 256) * 1024 + h * 128; r0.V = r0.K + 512;
    r0.P0 = 1 << 20; r0.skv = 256; r0.lg = 0.f; r0.RG = nullptr; r0.GN = nullptr; r0.O8 = F.ws + WS_OMEM + ((size_t)b * SEQ + (size_t)qb * 256) * 512 + h * 128;
    att::Seam S;
    att::attn_prime<2>(r0, lds, S);
    att::attn_block<2>(r0, r0, lds, S);
}
#define TK_INS(L, v) do { _Pragma("unroll") for (int i_ = 15; i_ >= 1; --i_) L[i_] = __builtin_amdgcn_fmed3f(L[i_ - 1], L[i_], (v)); L[0] = fmaxf(L[0], (v)); } while (0)
__device__ __forceinline__ void p13_topk_unit(Frame& F, int pm, int h) {
    const int lane = F.lane, r32 = lane & 31, hi = lane >> 5, wave = F.wave;
    const att::bf16* qp = (const att::bf16*)(F.ws + WS_QP); const att::bf16* subk = (const att::bf16*)(F.ws + WS_SUBK);
    int* idx_o = (int*)(F.ws + WS_IDX); float* gate_o = (float*)(F.ws + WS_GATE);
    LAS unsigned* kb = (LAS unsigned*)(F.lds + 65536 + (wave * 32 + (lane & 31)) * 32);
    const int tok = pm * 256 + wave * 32 + r32;
    const unsigned q_lane = (unsigned)((tok * DM + hi * 8) * 2), k_lane = (unsigned)((r32 * 128 + hi * 8) * 2);
    att::bf16x8 qf[8];
#define TK_STAGE(p_) do { const int hp_ = h * 2 + (p_); const unsigned char* qb_ = (const unsigned char*)qp + (size_t)hp_ * 256; \
        const unsigned char* kb_ = (const unsigned char*)subk + (size_t)hp_ * 32768 + (size_t)(wave >> 1) * 8192 + (size_t)(wave & 1) * 128; \
        _Pragma("unroll") for (int d0 = 0; d0 < 8; ++d0) qf[d0] = *(const GAS att::bf16x8*)(qb_ + d0 * 32 + q_lane); \
        _Pragma("unroll") for (int f_ = 0; f_ < 4; ++f_) \
            __builtin_amdgcn_global_load_lds((const GAS unsigned*)(kb_ + f_ * 32 + k_lane), (LAS unsigned*)(F.lds + (p_) * 32768 + (wave * 4 + f_) * 1024), 16, 0, 0); } while (0)
    float L0[16], L1[16];
#pragma unroll
    for (int i = 0; i < 16; ++i) { L0[i] = 0.f; L1[i] = 0.f; }
    TK_STAGE(0);
#pragma unroll 1
    for (int p = 0; p < 2; ++p) {
        asm volatile("s_waitcnt vmcnt(0)" ::: "memory"); __syncthreads();
        att::f32x16 acc[4];
        const LAS unsigned char* img = F.lds + p * 32768;
#pragma unroll
        for (int kt = 0; kt < 4; ++kt) { acc[kt] = att::f32x16{};
#pragma unroll
            for (int d0 = 0; d0 < 8; ++d0) acc[kt] = __builtin_amdgcn_mfma_f32_32x32x16_bf16(*(const LAS att::bf16x8*)(img + (kt * 8 + d0) * 1024 + lane * 16), qf[d0], acc[kt], 0, 0, 0); }
        if (p == 0) TK_STAGE(1);
        float L[16];
#pragma unroll
        for (int i = 0; i < 16; ++i) L[i] = -3.0e38f;
#pragma unroll
        for (int kt = 0; kt < 4; ++kt)
#pragma unroll
            for (int r = 0; r < 16; ++r) { const unsigned key = (unsigned)(kt * 32 + (r & 3) + 8 * (r >> 2)) + 4u * (unsigned)hi;
                const float v = __uint_as_float((__float_as_uint(acc[kt][r]) & ~0x7Fu) | key); TK_INS(L, v); }
        float P[16];
#pragma unroll
        for (int i = 0; i < 16; ++i) P[i] = __shfl_xor(L[i], 32);
#pragma unroll
        for (int i = 0; i < 16; ++i) TK_INS(L, P[i]);
#pragma unroll
        for (int i = 0; i < 16; ++i) { L0[i] = p == 0 ? L[i] : L0[i]; L1[i] = p == 0 ? L1[i] : L[i]; }
    }
#undef TK_STAGE
#pragma unroll
        for (int w = 0; w < 4; ++w) {
            kb[w] = (__float_as_uint(L0[4 * w]) & 0x7Fu) | ((__float_as_uint(L0[4 * w + 1]) & 0x7Fu) << 8) | ((__float_as_uint(L0[4 * w + 2]) & 0x7Fu) << 16) | ((__float_as_uint(L0[4 * w + 3]) & 0x7Fu) << 24);
            kb[4 + w] = (__float_as_uint(L1[4 * w]) & 0x7Fu) | ((__float_as_uint(L1[4 * w + 1]) & 0x7Fu) << 8) | ((__float_as_uint(L1[4 * w + 2]) & 0x7Fu) << 16) | ((__float_as_uint(L1[4 * w + 3]) & 0x7Fu) << 24); }
        float T[16];
#pragma unroll
        for (int i = 0; i < 16; ++i) T[i] = -3.0e38f;
#pragma unroll
        for (int a = 0; a < 16; ++a) { const float sa = __uint_as_float(__float_as_uint(L0[a]) & ~0x7Fu);
#pragma unroll
            for (int b2 = 0; b2 < 16; ++b2) if ((a + 1) * (b2 + 1) <= 16) { const float s = sa + __uint_as_float(__float_as_uint(L1[b2]) & ~0x7Fu);
                const float v = __uint_as_float((__float_as_uint(s) & ~0xFFu) | (unsigned)(a * 16 + b2)); TK_INS(T, v); } }
        LDS_WAIT();
        const LAS unsigned char* kbb = (const LAS unsigned char*)kb;
        float sc[16]; int ei[16]; float mx = __uint_as_float(__float_as_uint(T[0]) & ~0xFFu), sum = 0.f;
#pragma unroll
        for (int k = 0; k < 16; ++k) { const unsigned bits = __float_as_uint(T[k]); const unsigned id = bits & 0xFFu;
            const int i1 = kbb[id >> 4], i2 = kbb[16 + (id & 15u)]; ei[k] = i1 * 128 + i2;
            sc[k] = __builtin_amdgcn_exp2f((__uint_as_float(bits & ~0xFFu) - mx) * 1.4426950408889634f); sum += sc[k]; }
        const float inv = 1.f / sum;
        if (hi == 0) {
#pragma unroll
            for (int w = 0; w < 4; ++w) {
                *(GAS v4u*)(idx_o + (size_t)tok * 128 + h * 16 + 4 * w) = (v4u){(unsigned)ei[4 * w], (unsigned)ei[4 * w + 1], (unsigned)ei[4 * w + 2], (unsigned)ei[4 * w + 3]};
                *(GAS f32x4*)(gate_o + (size_t)tok * 128 + h * 16 + 4 * w) = (f32x4){sc[4 * w] * inv, sc[4 * w + 1] * inv, sc[4 * w + 2] * inv, sc[4 * w + 3] * inv}; } }
        LDS_WAIT(); asm volatile("" ::: "memory");
}


typedef float f32x2 __attribute__((ext_vector_type(2)));
__device__ __forceinline__ float gelu_tanh(float x) {
    const float y = 0.7978845608028654f * (x + 0.044715f * x * x * x);
    const float t = 1.f - 2.f * __builtin_amdgcn_rcpf(1.f + __builtin_amdgcn_exp2f(2.885390081777927f * y));
    return 0.5f * x * (1.f + t);
}
__device__ __forceinline__ float dot2bf(unsigned a, unsigned b, float acc) { asm("v_dot2c_f32_bf16 %0, %1, %2" : "+v"(acc) : "v"(a), "v"(b)); return acc; }
#ifndef EX_QCH
#define EX_QCH 2
#endif
#ifndef EX_TOK8
#define EX_TOK8 1
#endif
struct RowBuf { v4u r[8]; float su, sv; };
#define DPP_MOV(v, ctrl) __builtin_bit_cast(float, __builtin_amdgcn_update_dpp(0, __builtin_bit_cast(int, (v)), (ctrl), 0xF, 0xF, false))
#define ROW_ROR(v, n) __builtin_bit_cast(float, __builtin_amdgcn_update_dpp(0, __builtin_bit_cast(int, (v)), 0x120 + (n), 0xF, 0xF, false))
__device__ __forceinline__ void p14_experts_sorted(Frame& F) {
    const int lane = F.lane, wave = F.wave, q = lane >> 4, l16 = lane & 15;
    const bf16* xb = (const bf16*)(F.ws + WS_XB2); const unsigned char* pu = F.ws + WS_PU; const unsigned char* pv = F.ws + WS_PV;
    const int* idx = (const int*)(F.ws + WS_IDX); const float* gate = (const float*)(F.ws + WS_GATE); const float* rowss = (const float*)(F.ws + WS_ROWSS2);
    const float* su = (const float*)(F.ws + WS_PSCALE); const float* sv = su + 16384;
    LAS unsigned* list = (LAS unsigned*)(F.lds + wave * 8192) + q * 128;
    LAS float* wl = (LAS float*)(F.lds + wave * 8192 + 2048) + q * 128;
    LAS float* gt = (LAS float*)(F.lds + wave * 8192 + 4096) + q * 128;
    LAS unsigned* cnt = (LAS unsigned*)(F.lds + wave * 8192 + 6144) + q * 64;
    constexpr int NSTEP = 128;
    for (int grp = 0; grp < 2; ++grp) {
        const int tok = (F.bx * NWAVES + wave) * 8 + grp * 4 + q;
        const float rs = 1.f / sqrtf(rowss[tok] * (1.f / DM) + RMS_EPS);
#pragma unroll
        for (int i = 0; i < 4; ++i) cnt[l16 + 16 * i] = 0u;
        unsigned ent[8], pos[8];
#pragma unroll
        for (int j = 0; j < 8; ++j) { const int k = l16 + 16 * j; const unsigned e = (unsigned)idx[(size_t)tok * 128 + k]; gt[k] = gate[(size_t)tok * 128 + k]; ent[j] = e | ((unsigned)k << 16); }
        LDS_WAIT(); asm volatile("" ::: "memory");
#pragma unroll
        for (int j = 0; j < 8; ++j) pos[j] = __hip_atomic_fetch_add(cnt + ((ent[j] & 0x3FFFu) >> 8), 1u, __ATOMIC_RELAXED, __HIP_MEMORY_SCOPE_WORKGROUP);
        LDS_WAIT(); asm volatile("" ::: "memory");
        { unsigned c[4], inc[4], run = 0u;
#pragma unroll
          for (int i = 0; i < 4; ++i) { c[i] = cnt[l16 + 16 * i]; inc[i] = c[i];
#pragma unroll
              for (int o = 1; o < 16; o <<= 1) { const unsigned tt = __shfl_up(inc[i], o, 16); if (l16 >= o) inc[i] += tt; } }
          LDS_WAIT(); asm volatile("" ::: "memory");
#pragma unroll
          for (int i = 0; i < 4; ++i) { cnt[l16 + 16 * i] = run + inc[i] - c[i]; run += __shfl(inc[i], 15, 16); } }
        LDS_WAIT(); asm volatile("" ::: "memory");
#pragma unroll
        for (int j = 0; j < 8; ++j) list[cnt[(ent[j] & 0x3FFFu) >> 8] + pos[j]] = ent[j];
        LDS_WAIT(); asm volatile("" ::: "memory");
        const unsigned lane_off = (unsigned)l16 * 16u;
        constexpr int QCH = EX_QCH, NSW = 8 / QCH;
#define EX_LD(B, s_, TABQ) do { const int ss_ = (s_) < NSTEP ? (s_) : NSTEP - 1; const unsigned off_ = ((list[ss_] & 0x3FFFu) << 11) + lane_off;     \
            _Pragma("unroll") for (int c_ = 0; c_ < QCH; ++c_) B[c_] = *(const GAS v4u*)((TABQ) + off_ + c_ * 256); } while (0)
#ifndef EX_RINGK
#define EX_RINGK 8
#endif
#if EX_RINGK == 4
#define EX_RING(TABQ, STEPFN, ENDFN) do { v4u H0[QCH], H1[QCH], H2[QCH], H3[QCH]; \
            EX_LD(H0, 0, TABQ); EX_LD(H1, 1, TABQ); EX_LD(H2, 2, TABQ); \
            _Pragma("unroll 1") for (int s = 0; s < NSTEP; s += 8) { \
                EX_LD(H3, s + 3, TABQ); STEPFN(H0, s + 0, 0); \
                EX_LD(H0, s + 4, TABQ); STEPFN(H1, s + 1, 1); \
                EX_LD(H1, s + 5, TABQ); STEPFN(H2, s + 2, 2); \
                EX_LD(H2, s + 6, TABQ); STEPFN(H3, s + 3, 3); \
                EX_LD(H3, s + 7, TABQ); STEPFN(H0, s + 4, 4); \
                EX_LD(H0, s + 8, TABQ); STEPFN(H1, s + 5, 5); \
                EX_LD(H1, s + 9, TABQ); STEPFN(H2, s + 6, 6); \
                EX_LD(H2, s + 10, TABQ); STEPFN(H3, s + 7, 7); \
                ENDFN(s); } } while (0)
#elif EX_RINGK == 2
#define EX_RING(TABQ, STEPFN, ENDFN) do { v4u H0[QCH], H1[QCH]; \
            EX_LD(H0, 0, TABQ); \
            _Pragma("unroll 1") for (int s = 0; s < NSTEP; s += 8) { \
                EX_LD(H1, s + 1, TABQ); STEPFN(H0, s + 0, 0); \
                EX_LD(H0, s + 2, TABQ); STEPFN(H1, s + 1, 1); \
                EX_LD(H1, s + 3, TABQ); STEPFN(H0, s + 2, 2); \
                EX_LD(H0, s + 4, TABQ); STEPFN(H1, s + 3, 3); \
                EX_LD(H1, s + 5, TABQ); STEPFN(H0, s + 4, 4); \
                EX_LD(H0, s + 6, TABQ); STEPFN(H1, s + 5, 5); \
                EX_LD(H1, s + 7, TABQ); STEPFN(H0, s + 6, 6); \
                EX_LD(H0, s + 8, TABQ); STEPFN(H1, s + 7, 7); \
                ENDFN(s); } } while (0)
#else
#define EX_RING(TABQ, STEPFN, ENDFN) do { v4u H0[QCH], H1[QCH], H2[QCH], H3[QCH], H4[QCH], H5[QCH], H6[QCH], H7[QCH]; \
            EX_LD(H0, 0, TABQ); EX_LD(H1, 1, TABQ); EX_LD(H2, 2, TABQ); EX_LD(H3, 3, TABQ); EX_LD(H4, 4, TABQ); EX_LD(H5, 5, TABQ); EX_LD(H6, 6, TABQ); \
            _Pragma("unroll 1") for (int s = 0; s < NSTEP; s += 8) { \
                EX_LD(H7, s + 7, TABQ); STEPFN(H0, s + 0, 0); \
                EX_LD(H0, s + 8, TABQ); STEPFN(H1, s + 1, 1); \
                EX_LD(H1, s + 9, TABQ); STEPFN(H2, s + 2, 2); \
                EX_LD(H2, s + 10, TABQ); STEPFN(H3, s + 3, 3); \
                EX_LD(H3, s + 11, TABQ); STEPFN(H4, s + 4, 4); \
                EX_LD(H4, s + 12, TABQ); STEPFN(H5, s + 5, 5); \
                EX_LD(H5, s + 13, TABQ); STEPFN(H6, s + 6, 6); \
                EX_LD(H6, s + 14, TABQ); STEPFN(H7, s + 7, 7); \
                ENDFN(s); } } while (0)
#endif
#pragma unroll 1
        for (int j = 0; j < NSW; ++j) {
            f32x2 xf[QCH][8];
#pragma unroll
            for (int c = 0; c < QCH; ++c) { const v4u a = *(const GAS v4u*)(xb + (size_t)tok * DM + j * (QCH * 256) + c * 256 + l16 * 16), b = *(const GAS v4u*)(xb + (size_t)tok * DM + j * (QCH * 256) + c * 256 + l16 * 16 + 8);
                const unsigned xd[8] = {a.x, a.y, a.z, a.w, b.x, b.y, b.z, b.w};
#pragma unroll
                for (int i = 0; i < 8; ++i) xf[c][i] = (f32x2){__uint_as_float(xd[i] << 16), __uint_as_float(xd[i] & 0xffff0000u)}; }
            const unsigned char* tabq = pu + j * (QCH * 256);
#define EX_U(B, s_, k_) do { f32x2 d2_ = {0.f, 0.f}; \
            _Pragma("unroll") for (int c_ = 0; c_ < QCH; ++c_) { const unsigned ud[4] = {B[c_].x, B[c_].y, B[c_].z, B[c_].w}; \
                _Pragma("unroll") for (int w_ = 0; w_ < 4; ++w_) { d2_ = __builtin_amdgcn_cvt_pk_f32_fp8((int)ud[w_], false) * xf[c_][2 * w_] + d2_; d2_ = __builtin_amdgcn_cvt_pk_f32_fp8((int)ud[w_], true) * xf[c_][2 * w_ + 1] + d2_; } } \
            dd[k_] = d2_.x + d2_.y; } while (0)
#define EX_UEND(s_) do { float r4_[4], r2_[2], r1_; \
            { const bool up = (l16 & 8) != 0; _Pragma("unroll") for (int i_ = 0; i_ < 4; ++i_) { const float mine = up ? dd[i_ + 4] : dd[i_], theirs = up ? dd[i_] : dd[i_ + 4]; r4_[i_] = mine + ROW_ROR(theirs, 8); } } \
            { const bool up = (l16 & 4) != 0; _Pragma("unroll") for (int i_ = 0; i_ < 2; ++i_) { const float mine = up ? r4_[i_ + 2] : r4_[i_], theirs = up ? r4_[i_] : r4_[i_ + 2]; \
                const float fromhi = DPP_MOV(theirs, 0x104), fromlo = DPP_MOV(theirs, 0x114); r2_[i_] = mine + (up ? fromlo : fromhi); } }     \
            { const bool up = (l16 & 2) != 0; const float mine = up ? r2_[1] : r2_[0], theirs = up ? r2_[0] : r2_[1]; r1_ = mine + DPP_MOV(theirs, 0x4E); }     \
            r1_ += DPP_MOV(r1_, 0xB1);                                                                                                                  \
            if ((l16 & 1) == 0) { const int si_ = (s_) + (l16 >> 1); wl[si_] = (j == 0 ? 0.f : wl[si_]) + r1_; } } while (0)
            float dd[8];
            EX_RING(tabq, EX_U, EX_UEND);
#undef EX_U
#undef EX_UEND
            LDS_WAIT(); asm volatile("" ::: "memory");
        }
#pragma unroll
        for (int i = 0; i < 8; ++i) { const int s = l16 + 16 * i; const unsigned me = list[s]; const unsigned e = me & 0x3FFFu;
            wl[s] = gt[(me >> 16) & 127u] * gelu_tanh(wl[s] * su[e] * rs) * sv[e]; }
        LDS_WAIT(); asm volatile("" ::: "memory");
#pragma unroll 1
        for (int j = 0; j < NSW; ++j) {
            f32x2 acc[QCH][8];
#pragma unroll
            for (int c = 0; c < QCH; ++c)
#pragma unroll
                for (int e = 0; e < 8; ++e) acc[c][e] = (f32x2){0.f, 0.f};
            const unsigned char* tabq = pv + j * (QCH * 256);
#define EX_NOEND(s_) do { } while (0)
#define EX_V(B, s_, k_) do { const float w_ = wl[s_]; const f32x2 w2 = {w_, w_}; \
            _Pragma("unroll") for (int c_ = 0; c_ < QCH; ++c_) { const unsigned ud[4] = {B[c_].x, B[c_].y, B[c_].z, B[c_].w}; \
                _Pragma("unroll") for (int w4_ = 0; w4_ < 4; ++w4_) { acc[c_][2 * w4_] = __builtin_amdgcn_cvt_pk_f32_fp8((int)ud[w4_], false) * w2 + acc[c_][2 * w4_]; acc[c_][2 * w4_ + 1] = __builtin_amdgcn_cvt_pk_f32_fp8((int)ud[w4_], true) * w2 + acc[c_][2 * w4_ + 1]; } } } while (0)
            EX_RING(tabq, EX_V, EX_NOEND);
#undef EX_V
#undef EX_NOEND
            float* orow = F.out + (size_t)tok * DM + j * (QCH * 256) + l16 * 16; const bf16* xrow = xb + (size_t)tok * DM + j * (QCH * 256) + l16 * 16;
#pragma unroll
            for (int c = 0; c < QCH; ++c) { const v4u x0 = *(const GAS v4u*)(xrow + c * 256), x1 = *(const GAS v4u*)(xrow + c * 256 + 8); const unsigned xd[8] = {x0.x, x0.y, x0.z, x0.w, x1.x, x1.y, x1.z, x1.w};
#pragma unroll
                for (int qq = 0; qq < 4; ++qq)
                    *(GAS f32x4*)(orow + c * 256 + 4 * qq) = (f32x4){__uint_as_float(xd[2 * qq] << 16) + acc[c][2 * qq].x, __uint_as_float(xd[2 * qq] & 0xffff0000u) + acc[c][2 * qq].y,
                                                                    __uint_as_float(xd[2 * qq + 1] << 16) + acc[c][2 * qq + 1].x, __uint_as_float(xd[2 * qq + 1] & 0xffff0000u) + acc[c][2 * qq + 1].y}; }
        }
#undef EX_LD
#undef EX_RING
        LDS_WAIT(); asm volatile("" ::: "memory");
    }
}

__device__ __forceinline__ void p14_experts_8(Frame& F) {
    const int lane = F.lane, wave = F.wave, q = lane >> 3, l16 = lane & 7;
    const bf16* xb = (const bf16*)(F.ws + WS_XB2); const unsigned char* pu = F.ws + WS_PU; const unsigned char* pv = F.ws + WS_PV;
    const int* idx = (const int*)(F.ws + WS_IDX); const float* gate = (const float*)(F.ws + WS_GATE); const float* rowss = (const float*)(F.ws + WS_ROWSS2);
    const float* su = (const float*)(F.ws + WS_PSCALE); const float* sv = su + 16384;
    LAS unsigned* list = (LAS unsigned*)(F.lds + wave * 14336) + q * 128;
    LAS float* wl = (LAS float*)(F.lds + wave * 14336 + 4096) + q * 128;
    LAS float* gt = (LAS float*)(F.lds + wave * 14336 + 8192) + q * 128;
    LAS unsigned* cnt = (LAS unsigned*)(F.lds + wave * 14336 + 12288) + q * 64;
    constexpr int NSTEP = 128;
    {
        const int tok = (F.bx * NWAVES + wave) * 8 + q;
        const float rs = 1.f / sqrtf(rowss[tok] * (1.f / DM) + RMS_EPS);
#pragma unroll
        for (int i = 0; i < 8; ++i) cnt[l16 + 8 * i] = 0u;
        unsigned ent[16], pos[16];
#pragma unroll
        for (int j = 0; j < 16; ++j) { const int k = l16 + 8 * j; const unsigned e = (unsigned)idx[(size_t)tok * 128 + k]; gt[k] = gate[(size_t)tok * 128 + k]; ent[j] = e | ((unsigned)k << 16); }
        LDS_WAIT(); asm volatile("" ::: "memory");
#pragma unroll
        for (int j = 0; j < 16; ++j) pos[j] = __hip_atomic_fetch_add(cnt + ((ent[j] & 0x3FFFu) >> 8), 1u, __ATOMIC_RELAXED, __HIP_MEMORY_SCOPE_WORKGROUP);
        LDS_WAIT(); asm volatile("" ::: "memory");
        { unsigned c[8], inc[8], run = 0u;
#pragma unroll
          for (int i = 0; i < 8; ++i) { c[i] = cnt[l16 + 8 * i]; inc[i] = c[i];
#pragma unroll
              for (int o = 1; o < 8; o <<= 1) { const unsigned tt = __shfl_up(inc[i], o, 8); if (l16 >= o) inc[i] += tt; } }
          LDS_WAIT(); asm volatile("" ::: "memory");
#pragma unroll
          for (int i = 0; i < 8; ++i) { cnt[l16 + 8 * i] = run + inc[i] - c[i]; run += __shfl(inc[i], 7, 8); } }
        LDS_WAIT(); asm volatile("" ::: "memory");
#pragma unroll
        for (int j = 0; j < 16; ++j) list[cnt[(ent[j] & 0x3FFFu) >> 8] + pos[j]] = ent[j];
        LDS_WAIT(); asm volatile("" ::: "memory");
        const unsigned lane_off = (unsigned)l16 * 16u;
        constexpr int QCH = EX_QCH, NSW = 16 / QCH;
#define EX_LD(B, s_, TABQ) do { const int ss_ = (s_) < NSTEP ? (s_) : NSTEP - 1; const unsigned off_ = ((list[ss_] & 0x3FFFu) << 11) + lane_off;     \
            _Pragma("unroll") for (int c_ = 0; c_ < QCH; ++c_) B[c_] = *(const GAS v4u*)((TABQ) + off_ + c_ * 128); } while (0)
#ifndef EX_RINGK
#define EX_RINGK 8
#endif
#if EX_RINGK == 4
#define EX_RING(TABQ, STEPFN, ENDFN) do { v4u H0[QCH], H1[QCH], H2[QCH], H3[QCH]; \
            EX_LD(H0, 0, TABQ); EX_LD(H1, 1, TABQ); EX_LD(H2, 2, TABQ); \
            _Pragma("unroll 1") for (int s = 0; s < NSTEP; s += 8) { \
                EX_LD(H3, s + 3, TABQ); STEPFN(H0, s + 0, 0); \
                EX_LD(H0, s + 4, TABQ); STEPFN(H1, s + 1, 1); \
                EX_LD(H1, s + 5, TABQ); STEPFN(H2, s + 2, 2); \
                EX_LD(H2, s + 6, TABQ); STEPFN(H3, s + 3, 3); \
                EX_LD(H3, s + 7, TABQ); STEPFN(H0, s + 4, 4); \
                EX_LD(H0, s + 8, TABQ); STEPFN(H1, s + 5, 5); \
                EX_LD(H1, s + 9, TABQ); STEPFN(H2, s + 6, 6); \
                EX_LD(H2, s + 10, TABQ); STEPFN(H3, s + 7, 7); \
                ENDFN(s); } } while (0)
#elif EX_RINGK == 2
#define EX_RING(TABQ, STEPFN, ENDFN) do { v4u H0[QCH], H1[QCH]; \
            EX_LD(H0, 0, TABQ); \
            _Pragma("unroll 1") for (int s = 0; s < NSTEP; s += 8) { \
                EX_LD(H1, s + 1, TABQ); STEPFN(H0, s + 0, 0); \
                EX_LD(H0, s + 2, TABQ); STEPFN(H1, s + 1, 1); \
                EX_LD(H1, s + 3, TABQ); STEPFN(H0, s + 2, 2); \
                EX_LD(H0, s + 4, TABQ); STEPFN(H1, s + 3, 3); \
                EX_LD(H1, s + 5, TABQ); STEPFN(H0, s + 4, 4); \
                EX_LD(H0, s + 6, TABQ); STEPFN(H1, s + 5, 5); \
                EX_LD(H1, s + 7, TABQ); STEPFN(H0, s + 6, 6); \
                EX_LD(H0, s + 8, TABQ); STEPFN(H1, s + 7, 7); \
                ENDFN(s); } } while (0)
#else
#define EX_RING(TABQ, STEPFN, ENDFN) do { v4u H0[QCH], H1[QCH], H2[QCH], H3[QCH], H4[QCH], H5[QCH], H6[QCH], H7[QCH]; \
            EX_LD(H0, 0, TABQ); EX_LD(H1, 1, TABQ); EX_LD(H2, 2, TABQ); EX_LD(H3, 3, TABQ); EX_LD(H4, 4, TABQ); EX_LD(H5, 5, TABQ); EX_LD(H6, 6, TABQ); \
            _Pragma("unroll 1") for (int s = 0; s < NSTEP; s += 8) { \
                EX_LD(H7, s + 7, TABQ); STEPFN(H0, s + 0, 0); \
                EX_LD(H0, s + 8, TABQ); STEPFN(H1, s + 1, 1); \
                EX_LD(H1, s + 9, TABQ); STEPFN(H2, s + 2, 2); \
                EX_LD(H2, s + 10, TABQ); STEPFN(H3, s + 3, 3); \
                EX_LD(H3, s + 11, TABQ); STEPFN(H4, s + 4, 4); \
                EX_LD(H4, s + 12, TABQ); STEPFN(H5, s + 5, 5); \
                EX_LD(H5, s + 13, TABQ); STEPFN(H6, s + 6, 6); \
                EX_LD(H6, s + 14, TABQ); STEPFN(H7, s + 7, 7); \
                ENDFN(s); } } while (0)
#endif
#pragma unroll 1
        for (int j = 0; j < NSW; ++j) {
            f32x2 xf[QCH][8];
#pragma unroll
            for (int c = 0; c < QCH; ++c) { const v4u a = *(const GAS v4u*)(xb + (size_t)tok * DM + j * (QCH * 128) + c * 128 + l16 * 16), b = *(const GAS v4u*)(xb + (size_t)tok * DM + j * (QCH * 128) + c * 128 + l16 * 16 + 8);
                const unsigned xd[8] = {a.x, a.y, a.z, a.w, b.x, b.y, b.z, b.w};
#pragma unroll
                for (int i = 0; i < 8; ++i) xf[c][i] = (f32x2){__uint_as_float(xd[i] << 16), __uint_as_float(xd[i] & 0xffff0000u)}; }
            const unsigned char* tabq = pu + j * (QCH * 128);
#define EX_U(B, s_, k_) do { f32x2 d2_ = {0.f, 0.f}; \
            _Pragma("unroll") for (int c_ = 0; c_ < QCH; ++c_) { const unsigned ud[4] = {B[c_].x, B[c_].y, B[c_].z, B[c_].w}; \
                _Pragma("unroll") for (int w_ = 0; w_ < 4; ++w_) { d2_ = __builtin_amdgcn_cvt_pk_f32_fp8((int)ud[w_], false) * xf[c_][2 * w_] + d2_; d2_ = __builtin_amdgcn_cvt_pk_f32_fp8((int)ud[w_], true) * xf[c_][2 * w_ + 1] + d2_; } } \
            dd[k_] = d2_.x + d2_.y; } while (0)
#define EX_UEND(s_) do { float r4_[4], r2_[2], r1_; \
            { const bool up = (l16 & 4) != 0; _Pragma("unroll") for (int i_ = 0; i_ < 4; ++i_) { const float mine = up ? dd[i_ + 4] : dd[i_], theirs = up ? dd[i_] : dd[i_ + 4]; \
                const float fromhi = DPP_MOV(theirs, 0x104), fromlo = DPP_MOV(theirs, 0x114); r4_[i_] = mine + (up ? fromlo : fromhi); } }     \
            { const bool up = (l16 & 2) != 0; _Pragma("unroll") for (int i_ = 0; i_ < 2; ++i_) { const float mine = up ? r4_[i_ + 2] : r4_[i_], theirs = up ? r4_[i_] : r4_[i_ + 2]; r2_[i_] = mine + DPP_MOV(theirs, 0x4E); } }     \
            { const bool up = (l16 & 1) != 0; const float mine = up ? r2_[1] : r2_[0], theirs = up ? r2_[0] : r2_[1]; r1_ = mine + DPP_MOV(theirs, 0xB1); }     \
            { const int si_ = (s_) + l16; wl[si_] = (j == 0 ? 0.f : wl[si_]) + r1_; } } while (0)
            float dd[8];
            EX_RING(tabq, EX_U, EX_UEND);
#undef EX_U
#undef EX_UEND
            LDS_WAIT(); asm volatile("" ::: "memory");
        }
#pragma unroll
        for (int i = 0; i < 16; ++i) { const int s = l16 + 8 * i; const unsigned me = list[s]; const unsigned e = me & 0x3FFFu;
            wl[s] = gt[(me >> 16) & 127u] * gelu_tanh(wl[s] * su[e] * rs) * sv[e]; }
        LDS_WAIT(); asm volatile("" ::: "memory");
#pragma unroll 1
        for (int j = 0; j < NSW; ++j) {
            f32x2 acc[QCH][8];
#pragma unroll
            for (int c = 0; c < QCH; ++c)
#pragma unroll
                for (int e = 0; e < 8; ++e) acc[c][e] = (f32x2){0.f, 0.f};
            const unsigned char* tabq = pv + j * (QCH * 128);
#define EX_NOEND(s_) do { } while (0)
#define EX_V(B, s_, k_) do { const float w_ = wl[s_]; const f32x2 w2 = {w_, w_}; \
            _Pragma("unroll") for (int c_ = 0; c_ < QCH; ++c_) { const unsigned ud[4] = {B[c_].x, B[c_].y, B[c_].z, B[c_].w}; \
                _Pragma("unroll") for (int w4_ = 0; w4_ < 4; ++w4_) { acc[c_][2 * w4_] = __builtin_amdgcn_cvt_pk_f32_fp8((int)ud[w4_], false) * w2 + acc[c_][2 * w4_]; acc[c_][2 * w4_ + 1] = __builtin_amdgcn_cvt_pk_f32_fp8((int)ud[w4_], true) * w2 + acc[c_][2 * w4_ + 1]; } } } while (0)
            EX_RING(tabq, EX_V, EX_NOEND);
#undef EX_V
#undef EX_NOEND
            float* orow = F.out + (size_t)tok * DM + j * (QCH * 128) + l16 * 16; const bf16* xrow = xb + (size_t)tok * DM + j * (QCH * 128) + l16 * 16;
#pragma unroll
            for (int c = 0; c < QCH; ++c) { const v4u x0 = *(const GAS v4u*)(xrow + c * 128), x1 = *(const GAS v4u*)(xrow + c * 128 + 8); const unsigned xd[8] = {x0.x, x0.y, x0.z, x0.w, x1.x, x1.y, x1.z, x1.w};
#pragma unroll
                for (int qq = 0; qq < 4; ++qq)
                    STNT(((f32x4){__uint_as_float(xd[2 * qq] << 16) + acc[c][2 * qq].x, __uint_as_float(xd[2 * qq] & 0xffff0000u) + acc[c][2 * qq].y,
                                  __uint_as_float(xd[2 * qq + 1] << 16) + acc[c][2 * qq + 1].x, __uint_as_float(xd[2 * qq + 1] & 0xffff0000u) + acc[c][2 * qq + 1].y}), (GAS f32x4*)(orow + c * 128 + 4 * qq)); }
        }
#undef EX_LD
#undef EX_RING
        LDS_WAIT(); asm volatile("" ::: "memory");
    }
}

#ifdef ONLY_PHASE
#define ISO(n) ((n) == ONLY_PHASE)
#else
#define ISO(n) true
#endif
#ifndef LAST_PHASE
#define LAST_PHASE 11
#endif
enum { PH_PROLOGUE = 0, PH_GEMM_IN, PH_GEMM_IN8, PH_ATTN, PH_GEMM_FOXUP, PH_GEMM_RETUP, PH_GEMM_OUT, PH_GEMM_MQ, PH_MEM_ATTN, PH_GEMM_MO, PH_GEMM_PQ, PH_EXPERTS, PH_N };
__global__ void __launch_bounds__(NWAVES * 64, 2) mega_fwd(Args args) {
    extern __shared__ __attribute__((aligned(16))) unsigned char lds[];
    Frame F;
    F.lds = (LAS unsigned char*)lds; F.ldsg = lds; F.tid = threadIdx.x; F.lane = F.tid & 63; F.wave = __builtin_amdgcn_readfirstlane(F.tid >> 6); F.G = gridDim.x; F.bx = blockIdx.x;
    F.in = args.in; F.out = args.out; F.ws = args.ws; F.p0_mask = args.p0_mask;
    volatile LAS unsigned* MISC = (volatile LAS unsigned*)(F.lds + MISC_OFF);
    for (int u = F.tid; u < (LDS_BYTES - LDSCTL_OFF) / 4; u += NWAVES * 64) ((LAS unsigned*)(F.lds + LDSCTL_OFF))[u] = 0u;
    __syncthreads();
    gu32* ctl = (gu32*)(args.ws + WS_CTL);
    XcdBarrier bar = xcd_barrier_post((unsigned*)(ctl + CW_BAR), MISC + 8);
    unsigned char* ws = args.ws;
    bf16* proj = (bf16*)(ws + WS_PROJ);
    for (int ph = args.ph_lo; ph < args.ph_hi; ++ph) {
        { int t_ = threadIdx.x; asm volatile("" : "+v"(t_)); F.tid = t_; F.lane = t_ & 63; }
        { int g_ = gridDim.x, b_ = blockIdx.x; asm volatile("" : "+s"(g_), "+s"(b_)); F.G = g_; F.bx = b_; }
        bool is_gemm = false, barrier_after = true, fp8 = false, mq_phase = false, qk_phase = false, pq_phase = false, ksplit = false, qk8_phase = false;
        pg8::Gemm g{nullptr, nullptr, 0, 0, 0, 0, 0x7F7F7F7F}; pg8::EpiAny E{};
        switch (ph) {
#ifndef NO_P0
        case PH_PROLOGUE: if constexpr (ISO(0)) p0_prologue(F); break;
#endif
        case PH_GEMM_IN: if constexpr (ISO(1)) p1_scan(F); is_gemm = true; barrier_after = false; qk_phase = true;
            g = pg8::Gemm{(const bf16*)(ws + WS_XN), (const bf16*)(ws + WS_WIN), M_TOK, N_QK, DM, DM, 0x7F7F7F7F, DM}; E.kind = 0; E.O = proj; E.ldc = PP; E.pn_off = 0; break;
        case PH_GEMM_IN8: is_gemm = true; fp8 = true; qk8_phase = true;
            g = pg8::Gemm{(const bf16*)((unsigned char*)args.out + DO_XN8), (const bf16*)(ws + WS_WIN + 16 * MiB), M_TOK, N_REST, DM / 2, DM / 2, W8_SCALE_B, DM / 2}; E.kind = 0; E.O = proj + N_QK; E.ldc = PP; E.pn_off = N_QK / 256; break;
#ifndef NO_ATTN
        case PH_ATTN: if constexpr (ISO(3)) p4_attention(F); break;
#endif
#if FP8_UP_OUT
        case PH_GEMM_FOXUP: is_gemm = true; fp8 = true;
            g = pg8::Gemm{(const bf16*)((unsigned char*)args.out + DO_OCAT8), (const bf16*)(ws + WS_WFOX), M_TOK, DM, 512, 1024, W8_SCALE_B, 1024}; ksplit = true; E.kind = 7; E.Gt = proj + C_G0; E.Gt2 = proj + C_G1; E.ldg = PP; E.O8 = (unsigned char*)(proj + C_FK); E.ld8 = PP * 2; break;
        case PH_GEMM_RETUP: barrier_after = false; break;
        case PH_GEMM_OUT: is_gemm = true; fp8 = true;
            g = pg8::Gemm{proj + C_FK, (const bf16*)(ws + WS_WOUT), M_TOK, DM, DM / 2, PP, W8_SCALE_B, DM / 2}; E.kind = 4; E.base = args.in[I_X]; E.base16 = nullptr; E.O = (bf16*)(ws + WS_XB1); E.ldc = DM; E.rowss = (float*)(ws + WS_ROWSS1); break;
#else
        case PH_GEMM_FOXUP: is_gemm = true;
            g = pg8::Gemm{proj + C_FQ, (const bf16*)(ws + WS_WFOX), M_TOK, DM, 1024, PP, 0x7F7F7F7F, 1024}; E.kind = 2; E.O = (bf16*)(ws + WS_XN); E.ldc = DM; E.Gt = proj + C_G0; E.ldg = PP; break;
        case PH_GEMM_RETUP: is_gemm = true;
            g = pg8::Gemm{proj + C_RQ, (const bf16*)(ws + WS_WRET), M_TOK, DM, 1024, PP, 0x7F7F7F7F, 1024}; E.kind = 6; E.O = (bf16*)(ws + WS_XN); E.ldc = DM; E.Gt = proj + C_G1; E.ldg = PP; break;
        case PH_GEMM_OUT: is_gemm = true;
            g = pg8::Gemm{(const bf16*)(ws + WS_XN), (const bf16*)(ws + WS_WOUT), M_TOK, DM, DM, DM, 0x7F7F7F7F, DM}; E.kind = 4; E.base = args.in[I_X]; E.base16 = nullptr; E.O = (bf16*)(ws + WS_XB1B); E.ldc = DM; E.rowss = (float*)(ws + WS_ROWSS1); break;
#endif
        case PH_GEMM_MQ: is_gemm = true; mq_phase = true;
            if (F.bx < 128) { g = pg8::Gemm{(const bf16*)(ws + WS_XB1), (const bf16*)(ws + WS_WMQ), M_TOK, 512, DM, DM, 0x7F7F7F7F, DM}; E.kind = 1; E.O = (bf16*)(ws + WS_QM); E.ldc = 512; E.rowss_in = (const float*)(ws + WS_ROWSS1); }
            else { g = pg8::Gemm{(const bf16*)(ws + WS_MN), (const bf16*)(ws + WS_WMKV), NB * 256, 1024, DM, DM, 0x7F7F7F7F, DM}; E.kind = 1; E.O = (bf16*)(ws + WS_KVM); E.ldc = 1024; E.rowss_in = nullptr; }
            break;
        case PH_MEM_ATTN: if constexpr (ISO(8)) p10_mem_attention(F); break;
        case PH_GEMM_MO: is_gemm = true;
            fp8 = true; g = pg8::Gemm{(const bf16*)(ws + WS_OMEM), (const bf16*)(ws + WS_WMO), M_TOK, DM, 256, 256, W8_SCALE_B, 256}; E.kind = 4; E.base = nullptr; E.base16 = (const bf16*)(ws + WS_XB1); E.O = (bf16*)(ws + WS_XB2); E.ldc = DM; E.rowss = (float*)(ws + WS_ROWSS2); break;
        case PH_GEMM_PQ: is_gemm = true; pq_phase = true;
            g = pg8::Gemm{(const bf16*)(ws + WS_XB2), (const bf16*)(ws + WS_WPQ), M_TOK, DM, DM, DM, 0x7F7F7F7F, DM}; E.kind = 1; E.O = (bf16*)(ws + WS_QP); E.ldc = DM; E.rowss_in = (const float*)(ws + WS_ROWSS2); break;
#if EX_TOK8
        case PH_EXPERTS: if constexpr (ISO(11)) p14_experts_8(F); break;
#else
        case PH_EXPERTS: if constexpr (ISO(11)) p14_experts_sorted(F); break;
#endif
        default: break;
        }
#ifdef PROBE_LO
        if (is_gemm && args.pad) {
#if PROBE_FLAGS & 1
            g.K >>= 1;
#endif
#if PROBE_FLAGS & 2
            E.kind = 99;
#endif
#if PROBE_FLAGS & 4
            qk_phase = false; qk8_phase = false; pq_phase = false;
#endif
#if PROBE_FLAGS & 8
            E.pn_off = -100; E.rowss = nullptr;
#endif
#if PROBE_FLAGS & 32
            is_gemm = false;
#endif
#if PROBE_FLAGS & 64
            if ((F.bx >> 3) & 1) { const unsigned long long t0 = __builtin_amdgcn_s_memrealtime(); while (__builtin_amdgcn_s_memrealtime() - t0 < (unsigned long long)(PROBE_DLY)) __builtin_amdgcn_s_sleep(8); }
#endif
        }
#endif
#ifndef NO_GEMM
        if constexpr (ISO(100)) if (is_gemm) { pg8::StaticOrder S; S.init(g.M, g.N, F.G, (mq_phase && F.bx >= 128) ? F.bx - 128 : F.bx); S.kshift = ksplit ? 1 : 0;
            if (fp8) pg8::gemm_phase<pg8::EpiAny, pg8::StaticOrder, true, true, true>(F.lds, g, S, E); else pg8::gemm_phase<pg8::EpiAny, pg8::StaticOrder, true, true, false>(F.lds, g, S, E); }
        if constexpr (ISO(1)) if (qk_phase) {
            asm volatile("s_waitcnt vmcnt(0)" ::: "memory"); __syncthreads();
            pg8::StaticOrder S; pg8::Unit u; S.init(M_TOK, N_QK, F.G, F.bx);
            for (int i = 0; S.next(i, u); ++i) fix_own_tile(F, proj, u.pm, u.pn, 2 + (u.pn >> 2)); }
        if constexpr (ISO(2)) if (qk8_phase) {
            asm volatile("s_waitcnt vmcnt(0)" ::: "memory"); __syncthreads();
            pg8::StaticOrder S; pg8::Unit u; S.init(M_TOK, N_REST, F.G, F.bx);
            for (int i = 0; S.next(i, u); ++i) if (u.pn < 8) fix_own_tile(F, proj, u.pm, u.pn + 8, u.pn >> 2); }
        if constexpr (ISO(10)) if (pq_phase) {
            asm volatile("s_waitcnt vmcnt(0)" ::: "memory"); __syncthreads();
            pg8::StaticOrder S; pg8::Unit u; S.init(M_TOK, DM, F.G, F.bx);
            for (int i = 0; S.next(i, u); ++i) p13_topk_unit(F, u.pm, u.pn); }
        if constexpr (ISO(7)) if (mq_phase) {
            pg8::StaticOrder S; pg8::Unit u;
#if defined(PROBE_LO) && (PROBE_FLAGS & 32)
            if (args.pad) {} else
#endif
            if (F.bx < 128) { S.init(M_TOK, 512, F.G, F.bx); if (S.next(0, u)) norm_own_tile(F, (bf16*)(ws + WS_QM), 512, u.pm * 256, u.pn * 256, args.in[I_MEMQ_G], QK_C2); }
            else { S.init(NB * 256, 1024, F.G, F.bx - 128); if (S.next(0, u) && u.pn < 2) norm_own_tile(F, (bf16*)(ws + WS_KVM), 1024, u.pm * 256, u.pn * 256, args.in[I_MEMK_G], 1.f); }
#if defined(PROBE_LO) && (PROBE_FLAGS & 16)
            if (!args.pad)
#endif
            p8_convert_peer(F); }
#endif
        if (barrier_after && ph + 1 < args.ph_hi) xcd_barrier(bar);
    }
    if (xb_ld((unsigned*)(ctl + CW_BAR) + XB_TMO) != 0u) { const float q = __builtin_nanf(""); for (size_t i = (size_t)F.bx * 512 + F.tid; i < (size_t)M_TOK * DM / 4; i += (size_t)F.G * 512) ((f32x4*)args.out)[i] = (f32x4){q, q, q, q}; }
}

#ifdef PROBE_CVT
__global__ void __launch_bounds__(512) bench_cvt(float* sink) {
    const int lane = threadIdx.x & 63;
#if PROBE_CVT == 1
    typedef unsigned v6u_ __attribute__((ext_vector_type(6))); typedef float v32f_ __attribute__((ext_vector_type(32)));
    v6u_ src = {(unsigned)lane, 2u, 3u, 4u, 5u, 6u}; float a0 = 0.f, a1 = 0.f;
#pragma unroll 4
    for (int it = 0; it < 16384; ++it) { src[0] += 1u; const v32f_ r = __builtin_amdgcn_cvt_scalef32_pk32_f32_fp6(src, 1.0f); a0 += r[0]; a1 += r[31]; }
    if (a0 + a1 == 12345.678f) sink[0] = 0.f;
#else
    unsigned s0 = (unsigned)lane; f32x2 acc = {0.f, 0.f};
#pragma unroll 4
    for (int it = 0; it < 16384; ++it) {
#pragma unroll
        for (int w = 0; w < 8; ++w) { s0 += 1u; acc += __builtin_amdgcn_cvt_pk_f32_fp8((int)s0, false); acc += __builtin_amdgcn_cvt_pk_f32_fp8((int)s0, true); } }
    if (acc.x + acc.y == 12345.678f) sink[0] = 0.f;
#endif
}
#endif
#ifdef PROBE_EPI
template <int PAT> __global__ void __launch_bounds__(512) bench_epi(const float* X, unsigned short* Y) {
    const int w = threadIdx.x >> 6, lane = threadIdx.x & 63;
    for (int t = 0; t < PROBE_EPI_T; ++t) { const int L = t * 256 + blockIdx.x, pn = L & 7, pm = (L >> 3) & 63;
        if (PAT == 0) { const int wr = w >> 2, wc = w & 3, fr = lane & 15, fq = lane >> 4; const int row0 = pm * 256 + wr * 64 + fr, col0 = pn * 256 + wc * 32 + 8 * fq;
#pragma unroll
            for (int ai = 0; ai < 2; ++ai) { f32x4 ld[4][2][2];
#pragma unroll
                for (int m = 0; m < 4; ++m)
#pragma unroll
                    for (int bj = 0; bj < 2; ++bj) { const float* p = X + (size_t)(row0 + ai * 128 + m * 16) * 2048 + col0 + bj * 128; ld[m][bj][0] = __builtin_nontemporal_load((const f32x4*)p); ld[m][bj][1] = __builtin_nontemporal_load((const f32x4*)(p + 4)); }
#pragma unroll
                for (int m = 0; m < 4; ++m)
#pragma unroll
                    for (int bj = 0; bj < 2; ++bj) { v4u o; o.x = pk2(ld[m][bj][0][0], ld[m][bj][0][1]); o.y = pk2(ld[m][bj][0][2], ld[m][bj][0][3]); o.z = pk2(ld[m][bj][1][0], ld[m][bj][1][1]); o.w = pk2(ld[m][bj][1][2], ld[m][bj][1][3]);
                        *(v4u*)(Y + (size_t)(row0 + ai * 128 + m * 16) * 2048 + col0 + bj * 128) = o; }
                asm volatile("" ::: "memory"); }
        } else {
#pragma unroll
            for (int h = 0; h < 2; ++h) { f32x4 ld[16];
#pragma unroll
                for (int r = 0; r < 16; ++r) ld[r] = __builtin_nontemporal_load((const f32x4*)(X + (size_t)(pm * 256 + w * 32 + h * 16 + r) * 2048 + pn * 256) + lane);
#pragma unroll
                for (int r = 0; r < 16; ++r) { unsigned long long o = (unsigned long long)pk2(ld[r][0], ld[r][1]) | ((unsigned long long)pk2(ld[r][2], ld[r][3]) << 32);
                    *((unsigned long long*)(Y + (size_t)(pm * 256 + w * 32 + h * 16 + r) * 2048 + pn * 256) + lane) = o; }
                asm volatile("" ::: "memory"); }
        }
    }
}
#endif
extern "C" void kernel_launch(void* const* d_in, const int* in_sizes, int n_in, void* d_out, int out_size, void* d_ws, size_t ws_size, hipStream_t stream) {
    static int grid = 0;
    if (grid == 0) {
        if (n_in != 23 || out_size != M_TOK * DM || ws_size < WS_END) { fprintf(stderr, "kernel_launch: unexpected shapes (n_in %d out %d ws %zu)\n", n_in, out_size, ws_size); grid = -1; return; }
        int dev = 0, cus = 0, per_cu = 0;
        if (hipGetDevice(&dev) != hipSuccess || hipDeviceGetAttribute(&cus, hipDeviceAttributeMultiprocessorCount, dev) != hipSuccess) { grid = -1; return; }
        if (hipFuncSetAttribute((const void*)mega_fwd, hipFuncAttributeMaxDynamicSharedMemorySize, LDS_BYTES) != hipSuccess) { fprintf(stderr, "hipFuncSetAttribute failed\n"); grid = -1; return; }
        if (hipOccupancyMaxActiveBlocksPerMultiprocessor(&per_cu, (const void*)mega_fwd, NWAVES * 64, LDS_BYTES) != hipSuccess || per_cu < 1) fprintf(stderr, "occupancy query reports %d\n", per_cu);
        (void)hipGetLastError();
        grid = cus;
        if (grid != 256) { fprintf(stderr, "kernel_launch: built for 256 CUs, got %d\n", cus); grid = -1; return; }
    }
    if (grid < 0) return;
    (void)hipMemsetAsync((char*)d_ws + WS_CTL, 0, CTL_ZERO_BYTES, stream);
    Args a{};
    for (int i = 0; i < 23; ++i) a.in[i] = (const float*)d_in[i];
    a.out = (float*)d_out; a.ws = (unsigned char*)d_ws;
#ifdef PROBE_CVT
    hipLaunchKernelGGL(bench_cvt, dim3(256), dim3(512), 0, stream, (float*)d_ws + (4u << 20));
#endif
#ifdef PROBE_PREFIX
    a.ph_lo = 0; a.ph_hi = PROBE_PREFIX;
#ifdef PROBE_P0_MASK
    a.p0_mask = PROBE_P0_MASK;
#else
    a.p0_mask = 3;
#endif
    hipLaunchKernelGGL(mega_fwd, dim3(grid), dim3(NWAVES * 64), LDS_BYTES, stream, a);
    (void)hipMemsetAsync((char*)d_ws + WS_CTL, 0, CTL_ZERO_BYTES, stream);
#endif
    a.ph_lo = 0; a.ph_hi = LAST_PHASE + 1; a.p0_mask = 3;
    hipLaunchKernelGGL(mega_fwd, dim3(grid), dim3(NWAVES * 64), LDS_BYTES, stream, a);
#ifdef PROBE_EPI
    for (int r = 0; r < 4; ++r) hipLaunchKernelGGL(bench_epi<PROBE_EPI>, dim3(256), dim3(512), 0, stream, (const float*)d_in[I_X], (unsigned short*)((char*)d_ws + 144 * MiB));
#endif
#ifdef PROBE_LO
    (void)hipMemsetAsync((char*)d_ws + WS_CTL, 0, CTL_ZERO_BYTES, stream);
    a.ph_lo = PROBE_LO; a.ph_hi = PROBE_HI; a.p0_mask = 3; a.pad = PROBE_FLAGS;
    for (int r = 0; r < PROBE_REP; ++r) hipLaunchKernelGGL(mega_fwd, dim3(grid), dim3(NWAVES * 64), LDS_BYTES, stream, a);
#endif
}
```

```cpp
#include <hip/hip_runtime.h>
#include <cstdio>
#include <cstdint>
#include <cmath>
__device__ __forceinline__ int lane_now() { int l; asm volatile("v_mbcnt_lo_u32_b32 %0, -1, 0\n\tv_mbcnt_hi_u32_b32 %0, -1, %0" : "=v"(l)); return l; }
namespace pg8 {
#define PG8_LAS __attribute__((address_space(3)))
typedef unsigned short bf16_t;
typedef short bf16x8 __attribute__((ext_vector_type(8)));
typedef float f32x4 __attribute__((ext_vector_type(4)));
typedef unsigned u32x4 __attribute__((ext_vector_type(4)));
constexpr int BM = 256, BK = 64, HALF = 128, HTB = HALF * BK * 2  , STAGE_BYTES = 8 * HTB, NXCD = 8, WGM = 8;

__host__ __device__ __forceinline__ int lds_byte(int r, int c) { const int st = (r >> 4) * 2 + (c >> 5), rr = r & 15, cc = c & 31, ob = rr * 64 + cc * 2; return st * 1024 + (ob ^ (((ob >> 9) & 1) << 5)); }
__host__ __device__ __forceinline__ void stage_rc(int b, int& R, int& C) { const int st = b / 1024, sb = b % 1024, swz = sb ^ (((sb >> 9) & 1) << 5); R = (st >> 1) * 16 + swz / 64; C = (st & 1) * 32 + (swz % 64) / 2; }
__host__ __device__ __forceinline__ int perm32(int rho) { const int n = rho >> 4, i = rho & 15; return 8 * (i >> 2) + 4 * n + (i & 3); }

struct Unit { int pm, pn, kp; };
typedef int pg8_v4i __attribute__((ext_vector_type(4)));
struct Gemm { const bf16_t* A; const bf16_t* Bt; int M, N, K, lda; int scale_b; int ldb; };

struct StaticOrder {
    int nM, nN, nwg, G, c, kshift = 0;
    __host__ __device__ __forceinline__ void init(int M, int N, int G_, int c_) { nM = M / BM; nN = N / BM; nwg = nM * nN; G = G_; c = c_; }
    __host__ __device__ __forceinline__ bool next(int i2, Unit& u) const {
        const int i = i2 >> kshift; u.kp = i2 & ((1 << kshift) - 1);
        const long L = (long)i * G + c; if (L >= nwg) return false;
        int wgid = (int)L; { const int q = nwg / NXCD, r = nwg % NXCD, xcd = wgid % NXCD, off = wgid / NXCD; wgid = (xcd < r ? xcd * (q + 1) : r * (q + 1) + (xcd - r) * q) + off; }
        const int nig = WGM * nN, gid = wgid / nig, fm = gid * WGM, gsz = (nM - fm) < WGM ? (nM - fm) : WGM;
        u.pm = fm + ((wgid % nig) % gsz); u.pn = (wgid % nig) / gsz; return true;
    }
    __device__ __forceinline__ void a_ready(const Unit&) const {}
    __device__ __forceinline__ void done(const Unit&) const {}
};

__device__ __forceinline__ unsigned cvt_pk_bf16(float lo, float hi) { unsigned r; asm volatile("v_cvt_pk_bf16_f32 %0, %1, %2" : "=v"(r) : "v"(lo), "v"(hi)); return r; }
typedef float f32x2 __attribute__((ext_vector_type(2)));
__device__ __forceinline__ f32x2 gelu_pk(f32x2 v) {
    const f32x2 av = __builtin_elementwise_abs(v), d = av * 0.2316418882f + 1.0f;
    f32x2 t; t.x = __builtin_amdgcn_rcpf(d.x); t.y = __builtin_amdgcn_rcpf(d.y);
    f32x2 q = t * 0.5307027145f + (-0.7265760135f); q = q * t + 0.7107068705f; q = q * t + (-0.142248368f); q = q * t + 0.127414796f; q = q * t;
    const f32x2 s = (v * v) * (-0.72134752044f);
    f32x2 e; e.x = __builtin_amdgcn_exp2f(s.x); e.y = __builtin_amdgcn_exp2f(s.y);
    const f32x2 m = v * (q * e), r = v - m;
    f32x2 o; o.x = v.x < 0.f ? m.x : r.x; o.y = v.y < 0.f ? m.y : r.y; return o;
}

template <int ACT  > struct EpiBf16 {
    static constexpr bool PERM = true, AFTER_DRAIN = false; static_assert(ACT == 0 || ACT == 1, "EpiBf16: ACT is 0 (none) or 1 (gelu_pk)");
    bf16_t* O; int ldc; const float* bias; int split_cols; size_t split_stride; float scale0;
    __device__ __forceinline__ void operator()(const f32x4 (&acc)[2][2][4][2], const Unit& u, int wr, int wc, int fr, int fq) const {
        const int row0 = u.pm * BM + wr * 64 + fr; int colt = u.pn * BM; bf16_t* base = O;
        float sc = 1.f; if (split_cols) { const int t = colt / split_cols; base += (size_t)t * split_stride; colt -= t * split_cols; if (t == 0) sc = scale0; }
        const int col0 = colt + wc * 32 + 8 * fq, bcol0 = u.pn * BM + wc * 32 + 8 * fq;
        f32x4 bv[2][2];
#pragma unroll
        for (int bj = 0; bj < 2; ++bj)
#pragma unroll
            for (int n = 0; n < 2; ++n) bv[bj][n] = bias ? *(const f32x4*)(bias + bcol0 + bj * HALF + 4 * n) : (f32x4){0.f, 0.f, 0.f, 0.f};
#pragma unroll
        for (int ai = 0; ai < 2; ++ai)
#pragma unroll
            for (int m = 0; m < 4; ++m) { bf16_t* rowp = base + (size_t)(row0 + ai * HALF + m * 16) * ldc + col0;
#pragma unroll
                for (int bj = 0; bj < 2; ++bj) { f32x4 v0 = acc[ai][bj][m][0] + bv[bj][0], v1 = acc[ai][bj][m][1] + bv[bj][1];
                    if (ACT == 1) { f32x2 a = gelu_pk((f32x2){v0[0], v0[1]}), b = gelu_pk((f32x2){v0[2], v0[3]}), c = gelu_pk((f32x2){v1[0], v1[1]}), d = gelu_pk((f32x2){v1[2], v1[3]});
                        v0 = (f32x4){a.x, a.y, b.x, b.y}; v1 = (f32x4){c.x, c.y, d.x, d.y}; }
                    v0 = v0 * sc; v1 = v1 * sc; u32x4 w; w.x = cvt_pk_bf16(v0[0], v0[1]); w.y = cvt_pk_bf16(v0[2], v0[3]); w.z = cvt_pk_bf16(v1[0], v1[1]); w.w = cvt_pk_bf16(v1[2], v1[3]);
                    *(u32x4*)(rowp + bj * HALF) = w; } }
    }
};

struct PanelStats {
    unsigned* xbuf;
    unsigned* cnt;
    unsigned* tmo;
    int ntn; float eps;
    unsigned code;
    __device__ __forceinline__ bool run(const f32x4 (&v)[2][2][4][2], const Unit& u, int wr, int wc, int fr, int fq, PG8_LAS unsigned char* lds, int wid, int lane) const {
        typedef float f32x2v __attribute__((ext_vector_type(2)));
        PG8_LAS f32x2v* P = (PG8_LAS f32x2v*)lds;
        PG8_LAS f32x2v* S = (PG8_LAS f32x2v*)(lds + 8192);
        PG8_LAS unsigned* flag = (PG8_LAS unsigned*)(lds + 8192 + 2048);
#pragma unroll
        for (int ai = 0; ai < 2; ++ai)
#pragma unroll
            for (int m = 0; m < 4; ++m) {
                float s = 0.f;
#pragma unroll
                for (int bj = 0; bj < 2; ++bj)
#pragma unroll
                    for (int n = 0; n < 2; ++n) { const f32x4 x = v[ai][bj][m][n]; s += (x[0] + x[1]) + (x[2] + x[3]); }
                s += __shfl_xor(s, 16); s += __shfl_xor(s, 32);
                const float mw = s * (1.0f / 64.0f); float q = 0.f;
#pragma unroll
                for (int bj = 0; bj < 2; ++bj)
#pragma unroll
                    for (int n = 0; n < 2; ++n) { const f32x4 d = v[ai][bj][m][n] - mw; q += (d[0] * d[0] + d[1] * d[1]) + (d[2] * d[2] + d[3] * d[3]); }
                q += __shfl_xor(q, 16); q += __shfl_xor(q, 32);
                if (fq == 0) P[(ai * HALF + wr * 64 + m * 16 + fr) * 4 + wc] = (f32x2v){mw, q};
            }
        asm volatile("s_waitcnt lgkmcnt(0)" ::: "memory"); __builtin_amdgcn_s_barrier(); asm volatile("" ::: "memory");
#if defined(BROKEN_EXCHANGE_NO_WAIT)
#warning BROKEN CONTROL BUILD: the row-statistics exchange does not wait; results are wrong by design
        if (blockIdx.x >= 64) { const long long t0_ = clock64(); while (clock64() - t0_ < 60000) __builtin_amdgcn_s_sleep(8); }
#endif
        const int row = wid * 32 + (lane & 31);
        if (lane < 32) {
            const f32x2v a = P[row * 4 + 0], b = P[row * 4 + 1], c = P[row * 4 + 2], d = P[row * 4 + 3];
            const float mt = (a.x + b.x + c.x + d.x) * 0.25f;
            const float da = a.x - mt, db = b.x - mt, dc = c.x - mt, dd = d.x - mt;
            const float m2 = (a.y + b.y) + (c.y + d.y) + 64.0f * ((da * da + db * db) + (dc * dc + dd * dd));
            unsigned long long* slot = (unsigned long long*)xbuf + ((size_t)(u.pm * BM + row) * 4 + u.pn);
            __hip_atomic_store(slot, ((unsigned long long)__float_as_uint(m2) << 32) | __float_as_uint(mt), __ATOMIC_RELAXED, __HIP_MEMORY_SCOPE_AGENT);
        }
        asm volatile("s_waitcnt vmcnt(0)" ::: "memory");
        if (lane == 0) __hip_atomic_fetch_add(cnt + 64 * u.pm, 1u, __ATOMIC_RELAXED, __HIP_MEMORY_SCOPE_AGENT);
        if (wid == 0) {
            bool dead = false; const unsigned long long t0 = __builtin_amdgcn_s_memrealtime(); const unsigned want = 8u * (unsigned)ntn;
            for (;;) {
#if defined(BROKEN_EXCHANGE_NO_WAIT)
                break;
#endif
                if ((unsigned)__builtin_amdgcn_readfirstlane(__hip_atomic_load(cnt + 64 * u.pm, __ATOMIC_RELAXED, __HIP_MEMORY_SCOPE_AGENT)) >= want) break;
                if (__builtin_amdgcn_s_memrealtime() - t0 > 2000000ull) {
                    if (lane == 0) { unsigned expect = 0u; __hip_atomic_compare_exchange_strong(tmo + 1, &expect, code | (unsigned)(u.pm & 0xff), __ATOMIC_RELAXED, __ATOMIC_RELAXED, __HIP_MEMORY_SCOPE_AGENT);
                                     __hip_atomic_store(tmo, 1u, __ATOMIC_RELAXED, __HIP_MEMORY_SCOPE_AGENT); }
                    dead = true; break; }
                __builtin_amdgcn_s_sleep(2);
            }
            __builtin_amdgcn_fence(__ATOMIC_ACQUIRE, "agent");
            if (lane == 0) flag[0] = dead ? 1u : 0u;
        }
        asm volatile("s_waitcnt vmcnt(0) lgkmcnt(0)" ::: "memory"); __builtin_amdgcn_s_barrier(); asm volatile("" ::: "memory");
        const bool bad = flag[0] != 0u;
        if (lane < 32) {
            const unsigned long long* slot = (const unsigned long long*)xbuf + (size_t)(u.pm * BM + row) * 4; float mt[4], m2[4]; float ms = 0.f;
#pragma unroll
            for (int t = 0; t < 4; ++t) { if (t < ntn) { const unsigned long long w = __hip_atomic_load(slot + t, __ATOMIC_RELAXED, __HIP_MEMORY_SCOPE_AGENT); mt[t] = __uint_as_float((unsigned)w); m2[t] = __uint_as_float((unsigned)(w >> 32)); } else { mt[t] = 0.f; m2[t] = 0.f; } ms += mt[t]; }
            const float mean = ms / (float)ntn; float q = 0.f;
#pragma unroll
            for (int t = 0; t < 4; ++t) if (t < ntn) { const float dm = mt[t] - mean; q += m2[t] + 256.0f * dm * dm; }
            S[row] = (f32x2v){mean, 1.0f / sqrtf(q / (256.0f * (float)ntn) + eps)};
        }
        asm volatile("s_waitcnt lgkmcnt(0)" ::: "memory"); __builtin_amdgcn_s_barrier(); asm volatile("" ::: "memory");
        return bad;
    }
};
struct EpiLnRes {
    static constexpr bool PERM = false, AFTER_DRAIN = true;
    const float* base; float* out; int ldc; const float* bias; PanelStats st; unsigned poison;
    __device__ __forceinline__ void fused(f32x4 (&acc)[2][2][4][2], const Unit& u, int wr, int wc, int fr, int fq, PG8_LAS unsigned char* lds, int wid, int lane) const {
        typedef float f32x2v __attribute__((ext_vector_type(2)));
        const PG8_LAS f32x2v* S = (const PG8_LAS f32x2v*)(lds + 8192);
        const int col0 = u.pn * BM + wc * 32 + 4 * fq;
#pragma unroll
        for (int bj = 0; bj < 2; ++bj)
#pragma unroll
            for (int n = 0; n < 2; ++n) { const f32x4 bv = bias ? *(const f32x4*)(bias + col0 + bj * HALF + n * 16) : (f32x4){0.f, 0.f, 0.f, 0.f};
#pragma unroll
                for (int ai = 0; ai < 2; ++ai)
#pragma unroll
                    for (int m = 0; m < 4; ++m) acc[ai][bj][m][n] += bv; }
        f32x4 pre[4][2][2];
#pragma unroll
        for (int m = 0; m < 4; ++m) { const size_t off = (size_t)(u.pm * BM + wr * 64 + m * 16 + fr) * ldc + col0;
#pragma unroll
            for (int bj = 0; bj < 2; ++bj)
#pragma unroll
                for (int n = 0; n < 2; ++n) pre[m][bj][n] = *(const f32x4*)(base + off + bj * HALF + n * 16); }
        const bool bad = st.run(acc, u, wr, wc, fr, fq, lds, wid, lane) || poison != 0u;
        const float qnan = __builtin_nanf("");
#pragma unroll
        for (int ai = 0; ai < 2; ++ai)
#pragma unroll
            for (int m = 0; m < 4; ++m) { const int r = ai * HALF + wr * 64 + m * 16 + fr; const f32x2v sr = S[r]; const size_t off = (size_t)(u.pm * BM + r) * ldc + col0;
#pragma unroll
                for (int bj = 0; bj < 2; ++bj)
#pragma unroll
                    for (int n = 0; n < 2; ++n) { const f32x4 bs = ai == 0 ? pre[m][bj][n] : *(const f32x4*)(base + off + bj * HALF + n * 16); f32x4 o = bs + (acc[ai][bj][m][n] - sr.x) * sr.y;
                        if (bad) o = (f32x4){qnan, qnan, qnan, qnan}; *(f32x4*)(out + off + bj * HALF + n * 16) = o; }
                if (m & 1) asm volatile("" ::: "memory"); }
    }
};
struct EpiLnResLn {
    static constexpr bool PERM = false, AFTER_DRAIN = true;
    const float* base; float* out; bf16_t* xn; int ldc; const float* bias; PanelStats st1, st2; unsigned poison;
    __device__ __forceinline__ void fused(f32x4 (&acc)[2][2][4][2], const Unit& u, int wr, int wc, int fr, int fq, PG8_LAS unsigned char* lds, int wid, int lane) const {
        typedef float f32x2v __attribute__((ext_vector_type(2))); typedef unsigned u32x2v __attribute__((ext_vector_type(2)));
        const PG8_LAS f32x2v* S = (const PG8_LAS f32x2v*)(lds + 8192);
        const int col0 = u.pn * BM + wc * 32 + 4 * fq;
#pragma unroll
        for (int bj = 0; bj < 2; ++bj)
#pragma unroll
            for (int n = 0; n < 2; ++n) { const f32x4 bv = bias ? *(const f32x4*)(bias + col0 + bj * HALF + n * 16) : (f32x4){0.f, 0.f, 0.f, 0.f};
#pragma unroll
                for (int ai = 0; ai < 2; ++ai)
#pragma unroll
                    for (int m = 0; m < 4; ++m) acc[ai][bj][m][n] += bv; }
        bool bad = st1.run(acc, u, wr, wc, fr, fq, lds, wid, lane) || poison != 0u;
        const float qnan = __builtin_nanf("");
#pragma unroll
        for (int ai = 0; ai < 2; ++ai)
#pragma unroll
            for (int m = 0; m < 4; ++m) { const int r = ai * HALF + wr * 64 + m * 16 + fr; const f32x2v sr = S[r]; const size_t off = (size_t)(u.pm * BM + r) * ldc + col0;
#pragma unroll
                for (int bj = 0; bj < 2; ++bj)
#pragma unroll
                    for (int n = 0; n < 2; ++n) { const f32x4 bs = *(const f32x4*)(base + off + bj * HALF + n * 16); acc[ai][bj][m][n] = bs + (acc[ai][bj][m][n] - sr.x) * sr.y; }
                asm volatile("" : "+v"(acc[ai][0][m][0]), "+v"(acc[ai][0][m][1]), "+v"(acc[ai][1][m][0]), "+v"(acc[ai][1][m][1]));
                if (m & 1) asm volatile("" ::: "memory"); }
        const bool bad1 = bad;
        bad = st2.run(acc, u, wr, wc, fr, fq, lds, wid, lane) || bad;
#pragma unroll
        for (int ai = 0; ai < 2; ++ai)
#pragma unroll
            for (int m = 0; m < 4; ++m) { const int r = ai * HALF + wr * 64 + m * 16 + fr; const f32x2v sr = S[r]; const size_t off = (size_t)(u.pm * BM + r) * ldc + col0;
#pragma unroll
                for (int bj = 0; bj < 2; ++bj)
#pragma unroll
                    for (int n = 0; n < 2; ++n) { const f32x4 x1 = acc[ai][bj][m][n]; *(f32x4*)(out + off + bj * HALF + n * 16) = bad1 ? (f32x4){qnan, qnan, qnan, qnan} : x1;
                        const f32x4 o = (x1 - sr.x) * sr.y; u32x2v w; w.x = cvt_pk_bf16(o[0], o[1]); w.y = cvt_pk_bf16(o[2], o[3]);
                        if (bad) { w.x = 0x7fc07fc0u; w.y = 0x7fc07fc0u; } *(u32x2v*)(xn + off + bj * HALF + n * 16) = w; }
                asm volatile("" ::: "memory"); }
    }
};

typedef int pg8_v8i __attribute__((ext_vector_type(8)));
template <bool FP8> struct Frag;
template <> struct Frag<false> { bf16x8 k[2]; };
template <> struct Frag<true> { pg8_v8i v; };
__device__ __forceinline__ void load_frag(Frag<false>& f, const PG8_LAS unsigned char* p) { f.k[0] = *(const PG8_LAS bf16x8*)p; f.k[1] = *(const PG8_LAS bf16x8*)(p + 1024); }
__device__ __forceinline__ void load_frag(Frag<true>& f, const PG8_LAS unsigned char* p) { const pg8_v4i a = *(const PG8_LAS pg8_v4i*)p, b = *(const PG8_LAS pg8_v4i*)(p + 1024); f.v = __builtin_shufflevector(a, b, 0, 1, 2, 3, 4, 5, 6, 7); }
__device__ __forceinline__ void mma_frag(f32x4& acc, const Frag<false>& b, const Frag<false>& a, int) { acc = __builtin_amdgcn_mfma_f32_16x16x32_bf16(b.k[0], a.k[0], acc, 0, 0, 0); acc = __builtin_amdgcn_mfma_f32_16x16x32_bf16(b.k[1], a.k[1], acc, 0, 0, 0); }
__device__ __forceinline__ void mma_frag(f32x4& acc, const Frag<true>& b, const Frag<true>& a, int scale_w) {
    asm volatile("v_mfma_scale_f32_16x16x128_f8f6f4 %0, %1, %2, %0, %3, %4 op_sel_hi:[0,0,0]" : "+v"(acc) : "v"(b.v), "v"(a.v), "v"(scale_w), "v"(0x7F7F7F7F)); }
template <class Epi, class Sched, bool ALIGN_EPI = false, bool SP2 = false, bool FP8 = false>
__device__ __forceinline__ void gemm_phase(PG8_LAS unsigned char* lds, const Gemm g, const Sched& S, const Epi& E, int wave_s) {
    int tid_ = wave_s * 64 + lane_now();
    const int tid = tid_, wid = __builtin_amdgcn_readfirstlane(tid >> 6), lane = tid & 63, wr = wid >> 2, wc = wid & 3, fr = lane & 15, fq = lane >> 4;
    const int K = g.K, nt = K / BK;
    unsigned voffA[2], voffB[2];
#pragma unroll
    for (int i = 0; i < 2; ++i) { int R, C; stage_rc(tid * 16 + i * 8192, R, C); const int Rb = Epi::PERM ? ((R & ~31) + perm32(R & 31)) : R;
        voffA[i] = (unsigned)(R * g.lda + C) * 2u; voffB[i] = (unsigned)(Rb * g.ldb + C) * 2u; }
    const size_t kstep = (size_t)(BK * 2);
    const size_t hstepB = (size_t)HALF * g.ldb * 2, hstepA = (size_t)HALF * g.lda * 2;
    const size_t tstepB = 2 * hstepB, tstepA = 2 * hstepA;
    const unsigned ldsw = (unsigned)wid * 1024u;
    const int aoff = lds_byte(wr * 64 + fr, fq * 8), boff = lds_byte(wc * 32 + fr, fq * 8);
#define PG8_SA(b, h) (((b) * 2 + (h)) * HTB)
#define PG8_SB(b, h) ((4 + (b) * 2 + (h)) * HTB)
#define PG8_STAGE(bufoff, gbase, voff) do { _Pragma("unroll") for (int _i = 0; _i < 2; ++_i) \
        __builtin_amdgcn_global_load_lds((const unsigned*)((const char*)(gbase) + (voff)[_i]), (PG8_LAS unsigned*)(lds + (bufoff) + ldsw + _i * 8192), 16, 0, 0); } while (0)
#define PG8_LDA(dst, b, h) do { _Pragma("unroll") for (int m = 0; m < 4; ++m) load_frag(dst[m], lds + PG8_SA(b, h) + aoff + m * 2048); } while (0)
#define PG8_LDB(dst, b, h) do { _Pragma("unroll") for (int n = 0; n < 2; ++n) load_frag(dst[n], lds + PG8_SB(b, h) + boff + n * 2048); } while (0)
#define PG8_MMA(ai, bj, At, Bt) do { __builtin_amdgcn_s_setprio(1); _Pragma("unroll") for (int m = 0; m < 4; ++m) _Pragma("unroll") for (int n = 0; n < 2; ++n) mma_frag(acc[ai][bj][m][n], Bt[n], At[m], g.scale_b); \
        __builtin_amdgcn_s_setprio(0); } while (0)
#define PG8_WAIT_V(n) asm volatile("s_waitcnt vmcnt(" #n ")" ::: "memory")
#define PG8_WAIT_L(n) asm volatile("s_waitcnt lgkmcnt(" #n ")" ::: "memory")
#define PG8_BAR __builtin_amdgcn_s_barrier()
#define PG8_SCHED __builtin_amdgcn_sched_barrier(0)
    Unit cur, nxt; int ui = 0;
    if (!S.next(0, cur)) return;
    f32x4 acc[2][2][4][2];
#pragma unroll
    for (int a = 0; a < 2; ++a)
#pragma unroll
        for (int b = 0; b < 2; ++b)
#pragma unroll
            for (int m = 0; m < 4; ++m)
#pragma unroll
                for (int n = 0; n < 2; ++n) acc[a][b][m][n] = (f32x4){0.f, 0.f, 0.f, 0.f};
    Frag<FP8> At[4], B0[2], B1[2];
    const size_t kpart = (size_t)K * 2;
    const char* cA = (const char*)g.A + (size_t)cur.pm * tstepA + cur.kp * kpart; const char* cB = (const char*)g.Bt + (size_t)cur.pn * tstepB + cur.kp * kpart;
    S.a_ready(cur);
    if constexpr (SP2) {
        PG8_STAGE(PG8_SB(0, 0), cB, voffB); PG8_STAGE(PG8_SB(0, 1), cB + hstepB, voffB); PG8_STAGE(PG8_SA(0, 0), cA, voffA); PG8_STAGE(PG8_SA(0, 1), cA + hstepA, voffA);
        if (wr == 1) PG8_BAR;
        PG8_WAIT_V(2); PG8_BAR;
        PG8_STAGE(PG8_SB(1, 0), cB + kstep, voffB); PG8_STAGE(PG8_SA(1, 0), cA + kstep, voffA); PG8_STAGE(PG8_SB(1, 1), cB + hstepB + kstep, voffB);
        PG8_WAIT_V(6); PG8_BAR;
    } else {
        PG8_STAGE(PG8_SB(0, 0), cB, voffB); PG8_STAGE(PG8_SA(0, 0), cA, voffA); PG8_STAGE(PG8_SB(0, 1), cB + hstepB, voffB); PG8_STAGE(PG8_SA(0, 1), cA + hstepA, voffA);
        if (wr == 1) PG8_BAR;
        PG8_WAIT_V(4); PG8_BAR;
        PG8_STAGE(PG8_SB(1, 0), cB + kstep, voffB); PG8_STAGE(PG8_SA(1, 0), cA + kstep, voffA); PG8_STAGE(PG8_SB(1, 1), cB + hstepB + kstep, voffB);
        PG8_WAIT_V(6); PG8_BAR;
    }
    for (;;) {
        const bool has_next = S.next(ui + 1, nxt);
        const char* nA = has_next ? (const char*)g.A + (size_t)nxt.pm * tstepA + nxt.kp * kpart : cA; const char* nB = has_next ? (const char*)g.Bt + (size_t)nxt.pn * tstepB + nxt.kp * kpart : cB;
        for (int t = 0; t < nt; t += 2) {
            const bool last = (t == nt - 2);
            const char* a1 = cA + (size_t)(t + 1) * kstep;
            const char* a2 = last ? nA : cA + (size_t)(t + 2) * kstep; const char* b2 = last ? nB : cB + (size_t)(t + 2) * kstep;
            const char* a3 = a2 + kstep; const char* b3 = b2 + kstep;
            if (last && has_next) S.a_ready(nxt);
            if constexpr (SP2) {
            PG8_LDB(B0, 0, 0); PG8_LDB(B1, 0, 1); PG8_SCHED; PG8_LDA(At, 0, 0); PG8_STAGE(PG8_SA(1, 1), a1 + hstepA, voffA);
            PG8_WAIT_V(8); PG8_WAIT_L(0); PG8_BAR; PG8_MMA(0, 0, At, B0); PG8_MMA(0, 1, At, B1); PG8_BAR; PG8_SCHED;
            PG8_LDA(At, 0, 1); PG8_STAGE(PG8_SB(0, 0), b2, voffB); PG8_STAGE(PG8_SB(0, 1), b2 + hstepB, voffB); PG8_STAGE(PG8_SA(0, 0), a2, voffA);
            PG8_WAIT_V(8); PG8_WAIT_L(0); PG8_BAR; PG8_MMA(1, 0, At, B0); PG8_MMA(1, 1, At, B1); PG8_BAR; PG8_SCHED;
            PG8_LDB(B0, 1, 0); PG8_LDB(B1, 1, 1); PG8_SCHED; PG8_LDA(At, 1, 0); PG8_STAGE(PG8_SA(0, 1), a2 + hstepA, voffA);
            PG8_WAIT_V(8); PG8_WAIT_L(0); PG8_BAR; PG8_MMA(0, 0, At, B0); PG8_MMA(0, 1, At, B1); PG8_BAR; PG8_SCHED;
            PG8_LDA(At, 1, 1); PG8_STAGE(PG8_SB(1, 0), b3, voffB); PG8_STAGE(PG8_SB(1, 1), b3 + hstepB, voffB); PG8_STAGE(PG8_SA(1, 0), a3, voffA);
            PG8_WAIT_V(8); PG8_WAIT_L(0); PG8_BAR; PG8_MMA(1, 0, At, B0); PG8_MMA(1, 1, At, B1); PG8_BAR; PG8_SCHED;
            } else {
            PG8_LDB(B0, 0, 0); PG8_SCHED; PG8_LDA(At, 0, 0); PG8_STAGE(PG8_SA(1, 1), a1 + hstepA, voffA);
            PG8_WAIT_L(8); PG8_BAR; PG8_WAIT_L(0); PG8_MMA(0, 0, At, B0); PG8_BAR; PG8_SCHED;
            PG8_LDB(B1, 0, 1); PG8_STAGE(PG8_SB(0, 0), b2, voffB);
            PG8_BAR; PG8_WAIT_L(0); PG8_MMA(0, 1, At, B1); PG8_BAR;
            PG8_LDA(At, 0, 1); PG8_STAGE(PG8_SA(0, 0), a2, voffA);
            PG8_BAR; PG8_WAIT_L(0); PG8_MMA(1, 0, At, B0); PG8_BAR; PG8_SCHED;
            PG8_STAGE(PG8_SB(0, 1), b2 + hstepB, voffB);
            PG8_WAIT_V(6); PG8_BAR; PG8_MMA(1, 1, At, B1); PG8_BAR;
            PG8_LDB(B0, 1, 0); PG8_SCHED; PG8_LDA(At, 1, 0); PG8_STAGE(PG8_SA(0, 1), a2 + hstepA, voffA);
            PG8_WAIT_L(8); PG8_BAR; PG8_WAIT_L(0); PG8_MMA(0, 0, At, B0); PG8_BAR; PG8_SCHED;
            PG8_LDB(B1, 1, 1); PG8_STAGE(PG8_SB(1, 0), b3, voffB);
            PG8_BAR; PG8_WAIT_L(0); PG8_MMA(0, 1, At, B1); PG8_BAR;
            PG8_LDA(At, 1, 1); PG8_STAGE(PG8_SA(1, 0), a3, voffA);
            PG8_BAR; PG8_WAIT_L(0); PG8_MMA(1, 0, At, B0); PG8_BAR; PG8_SCHED;
            PG8_STAGE(PG8_SB(1, 1), b3 + hstepB, voffB);
            PG8_WAIT_V(6); PG8_BAR; PG8_MMA(1, 1, At, B1); PG8_BAR;
            }
        }
        if constexpr (ALIGN_EPI) { if (wr == 0) PG8_BAR; }
        if constexpr (FP8) { asm volatile("s_nop 15\n\ts_nop 15" ::: "memory"); }
        if constexpr (!Epi::AFTER_DRAIN) { E.template run<FP8>(acc, cur, wr, wc, fr, fq); S.done(cur); }
        if (!has_next) break;
        if (nxt.kp == 0)
#pragma unroll
        for (int a = 0; a < 2; ++a)
#pragma unroll
            for (int b = 0; b < 2; ++b)
#pragma unroll
                for (int m = 0; m < 4; ++m)
#pragma unroll
                    for (int n = 0; n < 2; ++n) acc[a][b][m][n] = (f32x4){0.f, 0.f, 0.f, 0.f};
        cur = nxt; cA = nA; cB = nB; ++ui;
        if constexpr (ALIGN_EPI) { if (wr == 1) PG8_BAR; }
    }
    PG8_WAIT_V(0);
    if constexpr (!ALIGN_EPI) { if (wr == 0) PG8_BAR; }
    PG8_BAR;
    if constexpr (Epi::AFTER_DRAIN) { E.fused(acc, cur, wr, wc, fr, fq, lds, wid, lane); S.done(cur); }
#undef PG8_SA
#undef PG8_SB
#undef PG8_STAGE
#undef PG8_LDA
#undef PG8_LDB
#undef PG8_MMA
#undef PG8_WAIT_V
#undef PG8_WAIT_L
#undef PG8_BAR
#undef PG8_SCHED
}
}

#ifndef PG8_SP2
#define PG8_SP2 true
#endif
#ifndef PG8_ALIGN
#define PG8_ALIGN true
#endif
#ifndef QKNORM_FUSED
#define QKNORM_FUSED 1
#endif
#ifndef ROPE_FUSED
#define ROPE_FUSED 1
#endif
#ifndef GATE_U8
#define GATE_U8 1
#endif
#define GATE_PN0 28
#define GATE_PN1 36
namespace pg8 {
typedef unsigned u32x2e __attribute__((ext_vector_type(2)));
__device__ __forceinline__ float bfbits2f(unsigned b16) { return __uint_as_float(b16 << 16); }
__device__ __forceinline__ void unpack8(const u32x4 w, float (&f)[8]) {
    f[0] = __uint_as_float(w.x << 16); f[1] = __uint_as_float(w.x & 0xffff0000u); f[2] = __uint_as_float(w.y << 16); f[3] = __uint_as_float(w.y & 0xffff0000u);
    f[4] = __uint_as_float(w.z << 16); f[5] = __uint_as_float(w.z & 0xffff0000u); f[6] = __uint_as_float(w.w << 16); f[7] = __uint_as_float(w.w & 0xffff0000u);
}
__device__ __forceinline__ u32x4 pack8f(const float (&f)[8]) { u32x4 w; w.x = cvt_pk_bf16(f[0], f[1]); w.y = cvt_pk_bf16(f[2], f[3]); w.z = cvt_pk_bf16(f[4], f[5]); w.w = cvt_pk_bf16(f[6], f[7]); return w; }
__device__ __forceinline__ void unpack8u(const u32x2e w, float (&f)[8]) {
    f[0] = (float)(w.x & 0xffu); f[1] = (float)((w.x >> 8) & 0xffu); f[2] = (float)((w.x >> 16) & 0xffu); f[3] = (float)(w.x >> 24);
    f[4] = (float)(w.y & 0xffu); f[5] = (float)((w.y >> 8) & 0xffu); f[6] = (float)((w.y >> 16) & 0xffu); f[7] = (float)(w.y >> 24);
}
__device__ __forceinline__ float sigmoid_f(float x) { return __builtin_amdgcn_rcpf(1.f + __builtin_amdgcn_exp2f(-1.4426950408889634f * x)); }

#if ROPE_FUSED
struct EpiRope {
    static constexpr bool PERM = true, AFTER_DRAIN = false;
    bf16_t* O; int ldc;
    __device__ __forceinline__ void operator()(const f32x4 (&acc)[2][2][4][2], const Unit& u, int wr, int wc, int fr, int fq) const {
        const int row0 = u.pm * BM + wr * 64 + fr, col0 = u.pn * BM + wc * 32 + 8 * fq; const bool isk = u.pn >= 4;
        int hq = (u.pn & 3) * 2;
#pragma unroll
        for (int ai = 0; ai < 2; ++ai)
#pragma unroll
            for (int m = 0; m < 4; ++m) { const int rowi = row0 + ai * HALF + m * 16; bf16_t* rowp = O + (size_t)rowi * ldc + col0; const float pos = (float)(rowi & 2047), n64 = (float)(rowi & 63);
#pragma unroll
                for (int bj = 0; bj < 2; ++bj) { int fql = fq; asm volatile("" : "+s"(hq), "+v"(fql)); const int d0 = 4 * (4 * wc + fql);
                    float lgh = __builtin_amdgcn_logf(1.f - __builtin_amdgcn_exp2f(-5.f - (float)(hq + bj))); if (isk) lgh = -lgh;
                    const float dsc = (isk ? 0.08838834764831845f : 1.f) * __builtin_amdgcn_exp2f(lgh * n64); float v[8];
#pragma unroll
                    for (int i = 0; i < 4; ++i) { float rev = pos * (__builtin_amdgcn_exp2f(-0.20762050593046014f * (float)(d0 + i)) * 0.15915494309189535f); rev -= rintf(rev);
                        const float sn = __builtin_amdgcn_sinf(rev) * dsc, cs = __builtin_amdgcn_cosf(rev) * dsc, a = acc[ai][bj][m][0][i], b = acc[ai][bj][m][1][i]; v[i] = a * cs - b * sn; v[4 + i] = a * sn + b * cs; }
                    *(u32x4*)(rowp + bj * HALF) = pack8f(v);
                    __builtin_amdgcn_sched_barrier(0); }
                __builtin_amdgcn_sched_barrier(0); }
    }
};
#endif
#if QKNORM_FUSED
struct EpiQKNorm {
    static constexpr bool PERM = true, AFTER_DRAIN = false;
    bf16_t* O; int ldc; const float* gain; float mul; PG8_LAS float* P;
    __device__ __forceinline__ void operator()(const f32x4 (&acc)[2][2][4][2], const Unit& u, int wr, int wc, int fr, int fq) const {
        const int row0 = u.pm * BM + wr * 64 + fr, col0 = u.pn * BM + wc * 32 + 8 * fq;
#pragma unroll
        for (int ai = 0; ai < 2; ++ai)
#pragma unroll
            for (int m = 0; m < 4; ++m)
#pragma unroll
                for (int bj = 0; bj < 2; ++bj) { const f32x4 a = acc[ai][bj][m][0], b = acc[ai][bj][m][1];
                    float ss = (a[0] * a[0] + a[1] * a[1]) + (a[2] * a[2] + a[3] * a[3]) + (b[0] * b[0] + b[1] * b[1]) + (b[2] * b[2] + b[3] * b[3]);
                    ss += __shfl_xor(ss, 16); ss += __shfl_xor(ss, 32);
                    if (fq == 0) P[((ai * HALF + wr * 64 + m * 16 + fr) * 2 + bj) * 4 + wc] = ss; }
        asm volatile("s_waitcnt lgkmcnt(0)" ::: "memory"); __builtin_amdgcn_s_barrier(); asm volatile("" ::: "memory");
        float g[8];
#pragma unroll
        for (int i = 0; i < 8; ++i) g[i] = gain[wc * 32 + 8 * fq + i] * mul;
#pragma unroll
        for (int ai = 0; ai < 2; ++ai)
#pragma unroll
            for (int m = 0; m < 4; ++m) { bf16_t* rowp = O + (size_t)(row0 + ai * HALF + m * 16) * ldc + col0;
#pragma unroll
                for (int bj = 0; bj < 2; ++bj) { const f32x4 p = *(const PG8_LAS f32x4*)(P + ((ai * HALF + wr * 64 + m * 16 + fr) * 2 + bj) * 4);
                    const float rr = __builtin_amdgcn_rsqf(((p[0] + p[1]) + (p[2] + p[3])) * (1.f / 128.f) + 1e-6f); float v[8];
#pragma unroll
                    for (int i = 0; i < 4; ++i) { v[i] = acc[ai][bj][m][0][i] * rr * g[i]; v[4 + i] = acc[ai][bj][m][1][i] * rr * g[4 + i]; }
                    *(u32x4*)(rowp + bj * HALF) = pack8f(v); } }
    }
};
#endif
template <bool ROPE> struct EpiProjT {
    static constexpr bool PERM = true, AFTER_DRAIN = false;
    bf16_t* O; int ldc; int pn_off;
    __device__ __forceinline__ void operator()(const f32x4 (&acc)[2][2][4][2], const Unit& u, int wr, int wc, int fr, int fq) const {
        const int row0 = u.pm * BM + wr * 64 + fr, col0 = u.pn * BM + wc * 32 + 8 * fq;
        const int gpn = u.pn + pn_off; const int act = gpn < 24 ? 0 : (gpn < 28 ? 1 : 2);
#pragma unroll
        for (int ai = 0; ai < 2; ++ai)
#pragma unroll
            for (int m = 0; m < 4; ++m) { bf16_t* rowp = O + (size_t)(row0 + ai * HALF + m * 16) * ldc + col0;
#pragma unroll
                for (int bj = 0; bj < 2; ++bj) { float v[8];
#pragma unroll
                    for (int i = 0; i < 4; ++i) { v[i] = acc[ai][bj][m][0][i]; v[4 + i] = acc[ai][bj][m][1][i]; }
                    if (act != 0) {
#pragma unroll
                        for (int i = 0; i < 8; ++i) { const float s = sigmoid_f(v[i]); v[i] = (act == 1) ? v[i] * s : s; } }
#if GATE_U8
                    if (act == 2) {
                        const int cb = gpn >= GATE_PN1 ? GATE_PN1 * 256 : GATE_PN0 * 256;
                        unsigned char* gb = (unsigned char*)(O - pn_off * 256 + (size_t)(row0 + ai * HALF + m * 16) * ldc + cb) + (gpn * 256 - cb) + wc * 32 + 8 * fq + bj * HALF;
                        unsigned p0 = 0u, p1 = 0u;
#pragma unroll
                        for (int i = 0; i < 4; ++i) { p0 = __builtin_amdgcn_cvt_pk_u8_f32(fmaxf(floorf(v[i] * 255.f + 0.5f), 1.f), i, p0); p1 = __builtin_amdgcn_cvt_pk_u8_f32(fmaxf(floorf(v[4 + i] * 255.f + 0.5f), 1.f), i, p1); }
                        *(u32x2e*)gb = (u32x2e){p0, p1};
                    } else
#endif
#ifdef PROJ_NT
                    __builtin_nontemporal_store(pack8f(v), (u32x4*)(rowp + bj * HALF)); } }
#else
                    *(u32x4*)(rowp + bj * HALF) = pack8f(v); } }
#endif
    }
};
struct EpiRowScale {
    static constexpr bool PERM = true, AFTER_DRAIN = false;
    bf16_t* O; int ldc; const float* rowss; float inv_n, eps;
    __device__ __forceinline__ void operator()(const f32x4 (&acc)[2][2][4][2], const Unit& u, int wr, int wc, int fr, int fq) const {
        const int row0 = u.pm * BM + wr * 64 + fr, col0 = u.pn * BM + wc * 32 + 8 * fq;
        const float* rp = rowss ? rowss + row0 : (const float*)O;
        const int rstep = rowss ? 16 : 0;
#pragma unroll
        for (int ai = 0; ai < 2; ++ai) { float sc[4];
#pragma unroll
            for (int m = 0; m < 4; ++m) sc[m] = rp[(ai * 8 + m) * rstep];
            asm volatile("" : "+v"(sc[0]), "+v"(sc[1]), "+v"(sc[2]), "+v"(sc[3]));
#pragma unroll
            for (int m = 0; m < 4; ++m) { const int row = row0 + ai * HALF + m * 16; bf16_t* rowp = O + (size_t)row * ldc + col0;
                const float s = rowss ? __builtin_amdgcn_rsqf(sc[m] * inv_n + eps) : 1.f;
#pragma unroll
                for (int bj = 0; bj < 2; ++bj) { float v[8];
#pragma unroll
                    for (int i = 0; i < 4; ++i) { v[i] = acc[ai][bj][m][0][i] * s; v[4 + i] = acc[ai][bj][m][1][i] * s; }
                    *(u32x4*)(rowp + bj * HALF) = pack8f(v); } } }
    }
};
template <bool ADD> struct EpiGate {
    static constexpr bool PERM = true, AFTER_DRAIN = false;
    bf16_t* O; int ldc; const bf16_t* Gt; int ldg; unsigned char* O8; int ld8;
    __device__ __forceinline__ void operator()(const f32x4 (&acc)[2][2][4][2], const Unit& u, int wr, int wc, int fr, int fq) const {
        const int row0 = u.pm * BM + wr * 64 + fr, col0 = u.pn * BM + wc * 32 + 8 * fq;
#pragma unroll
        for (int ai = 0; ai < 2; ++ai)
#pragma unroll
            for (int m = 0; m < 4; ++m) { const int row = row0 + ai * HALF + m * 16; bf16_t* rowp = O + (size_t)row * ldc + col0; const bf16_t* gp = Gt + (size_t)row * ldg + col0;
#pragma unroll
                for (int bj = 0; bj < 2; ++bj) { float v[8], g[8]; unpack8(*(const u32x4*)(gp + bj * HALF), g);
#pragma unroll
                    for (int i = 0; i < 4; ++i) { v[i] = acc[ai][bj][m][0][i] * g[i]; v[4 + i] = acc[ai][bj][m][1][i] * g[4 + i]; }
                    if (ADD) { float t[8]; unpack8(*(const u32x4*)(rowp + bj * HALF), t);
#pragma unroll
                        for (int i = 0; i < 8; ++i) v[i] += t[i];
                        int p0 = 0, p1 = 0; p0 = __builtin_amdgcn_cvt_pk_fp8_f32(v[0], v[1], p0, false); p0 = __builtin_amdgcn_cvt_pk_fp8_f32(v[2], v[3], p0, true);
                        p1 = __builtin_amdgcn_cvt_pk_fp8_f32(v[4], v[5], p1, false); p1 = __builtin_amdgcn_cvt_pk_fp8_f32(v[6], v[7], p1, true);
                        if (O8) *(u32x2e*)(O8 + (size_t)row * ld8 + col0 + bj * HALF) = (u32x2e){(unsigned)p0, (unsigned)p1}; else *(u32x4*)(rowp + bj * HALF) = pack8f(v); }
                    else *(u32x4*)(rowp + bj * HALF) = pack8f(v); } }
    }
};
struct EpiGate8 {
    static constexpr bool PERM = true, AFTER_DRAIN = false;
    const bf16_t* G1; int ldg; unsigned char* O8; int ld8;
    __device__ __forceinline__ void operator()(const f32x4 (&acc)[2][2][4][2], const Unit& u, int wr, int wc, int fr, int fq) const {
        const int row0 = u.pm * BM + wr * 64 + fr, col0 = u.pn * BM + wc * 32 + 8 * fq;
#if GATE_U8
        u32x2e ld[2][4][2];
#pragma unroll
        for (int ai = 0; ai < 2; ++ai)
#pragma unroll
            for (int m = 0; m < 4; ++m)
#pragma unroll
                for (int bj = 0; bj < 2; ++bj) ld[ai][m][bj] = *(const u32x2e*)((const unsigned char*)(G1 + (size_t)(row0 + ai * HALF + m * 16) * ldg) + col0 + bj * HALF);
#else
        u32x4 ld[2][4][2];
#pragma unroll
        for (int ai = 0; ai < 2; ++ai)
#pragma unroll
            for (int m = 0; m < 4; ++m)
#pragma unroll
                for (int bj = 0; bj < 2; ++bj) ld[ai][m][bj] = *(const u32x4*)(G1 + (size_t)(row0 + ai * HALF + m * 16) * ldg + col0 + bj * HALF);
#endif
#pragma unroll
        for (int ai = 0; ai < 2; ++ai)
#pragma unroll
            for (int m = 0; m < 4; ++m) { const int row = row0 + ai * HALF + m * 16;
#pragma unroll
                for (int bj = 0; bj < 2; ++bj) { float v[8], g[8];
#if GATE_U8
                    unpack8u(ld[ai][m][bj], g);
#pragma unroll
                    for (int i = 0; i < 8; ++i) g[i] *= (1.f / 255.f);
#else
                    unpack8(ld[ai][m][bj], g);
#endif
#pragma unroll
                    for (int i = 0; i < 4; ++i) { v[i] = acc[ai][bj][m][0][i] * g[i]; v[4 + i] = acc[ai][bj][m][1][i] * g[4 + i]; }
                    int p0 = 0, p1 = 0; p0 = __builtin_amdgcn_cvt_pk_fp8_f32(v[0], v[1], p0, false); p0 = __builtin_amdgcn_cvt_pk_fp8_f32(v[2], v[3], p0, true);
                    p1 = __builtin_amdgcn_cvt_pk_fp8_f32(v[4], v[5], p1, false); p1 = __builtin_amdgcn_cvt_pk_fp8_f32(v[6], v[7], p1, true);
                    *(u32x2e*)(O8 + (size_t)row * ld8 + col0 + bj * HALF) = (u32x2e){(unsigned)p0, (unsigned)p1}; } }
    }
};
struct EpiResid {
    static constexpr bool PERM = true, AFTER_DRAIN = false;
    const float* base32; const bf16_t* base16; bf16_t* XB; int ldc; float* rowss;
    __device__ __forceinline__ void finish_row(float (&b)[8], const f32x4& a0, const f32x4& a1, float& ss, bf16_t* dst) const {
#pragma unroll
        for (int i = 0; i < 4; ++i) { b[i] += a0[i]; b[4 + i] += a1[i]; }
#pragma unroll
        for (int i = 0; i < 8; ++i) ss += b[i] * b[i];
        *(u32x4*)dst = pack8f(b);
    }
    __device__ __forceinline__ void operator()(const f32x4 (&acc)[2][2][4][2], const Unit& u, int wr, int wc, int fr, int fq) const {
        const int row0 = u.pm * BM + wr * 64 + fr, col0 = u.pn * BM + wc * 32 + 8 * fq;
        if (base32) {
#pragma unroll
            for (int ai = 0; ai < 2; ++ai) { f32x4 ld[4][2][2];
#pragma unroll
                for (int m = 0; m < 4; ++m)
#pragma unroll
                    for (int bj = 0; bj < 2; ++bj) { const float* p = base32 + (size_t)(row0 + ai * HALF + m * 16) * ldc + col0 + bj * HALF;
                        ld[m][bj][0] = __builtin_nontemporal_load((const f32x4*)p); ld[m][bj][1] = __builtin_nontemporal_load((const f32x4*)(p + 4)); }
                float ssm[4];
#pragma unroll
                for (int m = 0; m < 4; ++m) { const int row = row0 + ai * HALF + m * 16; const size_t off = (size_t)row * ldc + col0; float ss = 0.f;
#pragma unroll
                    for (int bj = 0; bj < 2; ++bj) { float b[8] = {ld[m][bj][0][0], ld[m][bj][0][1], ld[m][bj][0][2], ld[m][bj][0][3], ld[m][bj][1][0], ld[m][bj][1][1], ld[m][bj][1][2], ld[m][bj][1][3]};
                        finish_row(b, acc[ai][bj][m][0], acc[ai][bj][m][1], ss, XB + off + bj * HALF); }
                    ss += __shfl_xor(ss, 16); ss += __shfl_xor(ss, 32); ssm[m] = ss; }
                if (rowss) atomicAdd(rowss + row0 + ai * HALF + fq * 16, fq == 0 ? ssm[0] : fq == 1 ? ssm[1] : fq == 2 ? ssm[2] : ssm[3]);
                asm volatile("" ::: "memory"); }
        } else {
            u32x4 ld[2][4][2];
#pragma unroll
            for (int ai = 0; ai < 2; ++ai)
#pragma unroll
                for (int m = 0; m < 4; ++m)
#pragma unroll
                    for (int bj = 0; bj < 2; ++bj) ld[ai][m][bj] = *(const u32x4*)(base16 + (size_t)(row0 + ai * HALF + m * 16) * ldc + col0 + bj * HALF);
#pragma unroll
            for (int ai = 0; ai < 2; ++ai)
              { float ssm[4];
#pragma unroll
                for (int m = 0; m < 4; ++m) { const int row = row0 + ai * HALF + m * 16; const size_t off = (size_t)row * ldc + col0; float ss = 0.f;
#pragma unroll
                    for (int bj = 0; bj < 2; ++bj) { float b[8]; unpack8(ld[ai][m][bj], b); finish_row(b, acc[ai][bj][m][0], acc[ai][bj][m][1], ss, XB + off + bj * HALF); }
                    ss += __shfl_xor(ss, 16); ss += __shfl_xor(ss, 32); ssm[m] = ss; }
                if (rowss) atomicAdd(rowss + row0 + ai * HALF + fq * 16, fq == 0 ? ssm[0] : fq == 1 ? ssm[1] : fq == 2 ? ssm[2] : ssm[3]); }
        }
    }
};
struct EpiAny {
    static constexpr bool PERM = true, AFTER_DRAIN = false;
    int kind; bf16_t* O; int ldc; const bf16_t* Gt; int ldg; const float* base; const bf16_t* base16; float* rowss; const float* rowss_in; int pn_off; unsigned char* O8; int ld8; const bf16_t* Gt2; const float* gq; const float* gk; float qmul; PG8_LAS float* P;
    __device__ __forceinline__ void mid(f32x4 (&acc)[2][2][4][2], const Unit& u, int wr, int wc, int fr, int fq) const {
        const int row0 = u.pm * BM + wr * 64 + fr, col0 = u.pn * BM + wc * 32 + 8 * fq;
#pragma unroll
        for (int ai = 0; ai < 2; ++ai)
#pragma unroll
            for (int m = 0; m < 4; ++m) { const int row = row0 + ai * HALF + m * 16; const bf16_t* g0p = Gt + (size_t)row * ldg + col0; const bf16_t* g1p = Gt2 + (size_t)row * ldg + col0;
#pragma unroll
                for (int bj = 0; bj < 2; ++bj) { float a[8], b[8];
#if GATE_U8
                    unpack8u(*(const u32x2e*)((const unsigned char*)(Gt + (size_t)row * ldg) + col0 + bj * HALF), a); unpack8u(*(const u32x2e*)((const unsigned char*)(Gt2 + (size_t)row * ldg) + col0 + bj * HALF), b);
#else
                    unpack8(*(const u32x4*)(g0p + bj * HALF), a); unpack8(*(const u32x4*)(g1p + bj * HALF), b);
#endif
#pragma unroll
                    for (int i = 0; i < 4; ++i) { acc[ai][bj][m][0][i] *= a[i] * __builtin_amdgcn_rcpf(b[i]); acc[ai][bj][m][1][i] *= a[4 + i] * __builtin_amdgcn_rcpf(b[4 + i]); } }
                if (m & 1) asm volatile("" ::: "memory"); }
    }
    __device__ __forceinline__ void operator()(f32x4 (&acc)[2][2][4][2], const Unit& u, int wr, int wc, int fr, int fq) const { run<false>(acc, u, wr, wc, fr, fq); }
    template <bool FP8> __device__ __forceinline__ void run(f32x4 (&acc)[2][2][4][2], const Unit& u, int wr, int wc, int fr, int fq) const {
        if (kind == 7 && u.kp == 0) { mid(acc, u, wr, wc, fr, fq); return; }
#if QKNORM_FUSED
        if constexpr (FP8) { const int gp = u.pn + pn_off; if (kind == 0 && gp >= 8 && gp < 16) { EpiQKNorm e{O, ldc, gp < 12 ? gq : gk, gp < 12 ? qmul : 1.f, P}; e(acc, u, wr, wc, fr, fq); return; } }
#endif
#if ROPE_FUSED
        if constexpr (!FP8) { if (kind == 8) { EpiRope e{O, ldc}; e(acc, u, wr, wc, fr, fq); return; } }
#endif
        if (kind == 0) { EpiProjT<false> e{O, ldc, pn_off}; e(acc, u, wr, wc, fr, fq); }
        else if (kind == 1) { EpiRowScale e{O, ldc, rowss_in, 1.f / 2048.f, 1e-6f}; e(acc, u, wr, wc, fr, fq); }
        else if (kind == 2) { EpiGate<false> e{O, ldc, Gt, ldg, nullptr, 0}; e(acc, u, wr, wc, fr, fq); }
        else if (kind == 3) { EpiGate<true> e{O, ldc, Gt, ldg, O8, ld8}; e(acc, u, wr, wc, fr, fq); }
        else if (kind == 6) { EpiGate<true> e{O, ldc, Gt, ldg, nullptr, 0}; e(acc, u, wr, wc, fr, fq); }
        else if (kind == 7) { EpiGate8 e{Gt2, ldg, O8, ld8}; e(acc, u, wr, wc, fr, fq); }
#ifdef PROBE_LO
        else if (kind == 99) {}
#endif
        else { EpiResid e{base, base16, O, ldc, rowss}; e(acc, u, wr, wc, fr, fq); }
    }
};
}
#ifndef ATT_QREG
#define ATT_QREG 1
#endif
namespace att {
using bf16 = unsigned short;
typedef short bf16x8 __attribute__((ext_vector_type(8)));
typedef short s16x4 __attribute__((ext_vector_type(4)));
typedef float f32x16 __attribute__((ext_vector_type(16)));
typedef float f32x4 __attribute__((ext_vector_type(4)));
typedef unsigned u32x4 __attribute__((ext_vector_type(4)));
constexpr int D = 128, NW = 8, QBLK = 32, KVBLK = 64, QB = NW * QBLK;
constexpr int SHM_V = KVBLK * D * 2, SHM_K = KVBLK * D * 2;
constexpr int LDS_WS = 2 * SHM_V + 2 * SHM_K;
constexpr int LDS_BIAS = LDS_WS + NW * 64 * 4;
constexpr int LDS_Q = LDS_BIAS + 2048 * 4;
constexpr int LDS_BYTES = LDS_Q + NW * 8192;
constexpr float THR = 8.f;

#define KSWZ(row, colB) ((row) * 256 + ((colB) ^ (((row) & 7) << 4)))
#define SBAR() __builtin_amdgcn_sched_barrier(0)
__device__ __forceinline__ int v_st(int k, int c) { const int kk = (k & ~0xC) | ((k & 4) << 1) | ((k & 8) >> 1); return ((kk >> 3) * 4 + (c >> 5)) * 512 + ((kk & 7) * 32 + (c & 31)) * 2; }
__device__ __forceinline__ int v_rd_base(int lane) { return ((lane & 3) << 3) | (((lane >> 2) & 3) << 6) | (((lane >> 4) & 1) << 5) | (((lane >> 5) & 1) << 8); }
constexpr int v_rd_off(int d0, int ks, int half) { return d0 * 512 + ks * 4096 + half * 2048; }
__device__ __forceinline__ int crow(int r, int hi) { return (r & 3) + 8 * (r >> 2) + 4 * hi; }
__device__ __forceinline__ unsigned cvtpk(float lo, float hi) { unsigned r; asm volatile("v_cvt_pk_bf16_f32 %0, %1, %2" : "=v"(r) : "v"(lo), "v"(hi)); return r; }
__device__ __forceinline__ bf16x8 load8(const bf16* p) { return *reinterpret_cast<const bf16x8*>(p); }
#define ATT_DPPI(v, ctrl) __builtin_amdgcn_update_dpp(0, (v), (ctrl), 0xF, 0xF, false)
#define ATT_DPPF(v, ctrl) __builtin_bit_cast(float, __builtin_amdgcn_update_dpp(0, __builtin_bit_cast(int, (v)), (ctrl), 0xF, 0xF, false))
__device__ __forceinline__ float bf2f(unsigned short b) { return __uint_as_float((unsigned)b << 16); }

__device__ __forceinline__ void mask_tile(f32x16& p0, f32x16& p1, int dq) {
    const float NEG = -__builtin_inff();
#pragma unroll
    for (int r = 0; r < 16; ++r) {
        const int c = (r & 3) + 8 * (r >> 2);
        if (dq - c < 0) p0[r] = NEG;
        if (dq - c - 32 < 0) p1[r] = NEG;
    }
}
__device__ __forceinline__ void partialSM(f32x16& p0, f32x16& p1, float& m_reg, float& mn, float& alpha) {
    float pmax = p0[0]; for (int r = 1; r < 16; ++r) pmax = fmaxf(pmax, p0[r]); for (int r = 0; r < 16; ++r) pmax = fmaxf(pmax, p1[r]);
    { auto rr = __builtin_amdgcn_permlane32_swap(__float_as_uint(pmax), __float_as_uint(pmax), false, false);
      pmax = fmaxf(__uint_as_float(rr[0]), __uint_as_float(rr[1])); }
    if (__builtin_expect(__all((pmax - m_reg) <= THR), 1)) { mn = m_reg; alpha = 1.f; }
    else { mn = fmaxf(m_reg, pmax); alpha = __builtin_amdgcn_exp2f(m_reg - mn); m_reg = mn; }
    for (int r = 0; r < 16; ++r) p0[r] = p0[r] - mn; for (int r = 0; r < 16; ++r) p1[r] = p1[r] - mn;
    for (int r = 0; r < 16; ++r) p0[r] = __builtin_amdgcn_exp2f(p0[r]);
}
#define ATT_PK4(P, B_, OUT) do { unsigned a0 = cvtpk(P[B_+0], P[B_+1]), a1 = cvtpk(P[B_+2], P[B_+3]);                          \
        unsigned b0 = cvtpk(P[B_+4], P[B_+5]), b1 = cvtpk(P[B_+6], P[B_+7]);                                             \
        auto r0 = __builtin_amdgcn_permlane32_swap(a0, b0, false, false); auto r1 = __builtin_amdgcn_permlane32_swap(a1, b1, false, false); \
        u32x4 w = {r0[0], r1[0], r0[1], r1[1]}; OUT = *reinterpret_cast<bf16x8*>(&w); } while (0)
__device__ __forceinline__ void finishSM(f32x16& p0, f32x16& p1, float alpha, float& l_reg, bf16x8& pa0, bf16x8& pa1, bf16x8& pa2, bf16x8& pa3) {
    for (int r = 0; r < 16; ++r) p1[r] = __builtin_amdgcn_exp2f(p1[r]);
    float ps = 0; for (int r = 0; r < 16; ++r) ps += p0[r]; for (int r = 0; r < 16; ++r) ps += p1[r];
    { auto rr = __builtin_amdgcn_permlane32_swap(__float_as_uint(ps), __float_as_uint(ps), false, false);
      ps = __uint_as_float(rr[0]) + __uint_as_float(rr[1]); }
    l_reg = l_reg * alpha + ps;
    ATT_PK4(p0, 0, pa0); ATT_PK4(p0, 8, pa1); ATT_PK4(p1, 0, pa2); ATT_PK4(p1, 8, pa3);
}
__device__ __forceinline__ void ret_weight(f32x16& p0, f32x16& p1, int dq, float lg, int dist) {
    if (dist < 0) { p0 = f32x16{}; p1 = f32x16{}; return; }
    if (dist > 0) { const float f = __builtin_amdgcn_exp2f(lg * 64.f * (float)dist);
#pragma unroll
        for (int r = 0; r < 16; ++r) { p0[r] *= f; p1[r] *= f; }
        return; }
#pragma unroll
    for (int r = 0; r < 16; ++r) {
        const int c = (r & 3) + 8 * (r >> 2);
        const float e0 = 2.f * lg * fmaxf((float)(c - dq), 0.f), e1 = 2.f * lg * fmaxf((float)(c + 32 - dq), 0.f);
        p0[r] *= __builtin_amdgcn_exp2f(e0); p1[r] *= __builtin_amdgcn_exp2f(e1);
    }
}
__device__ __forceinline__ void ret_pack(f32x16& p0, f32x16& p1, bf16x8& pa0, bf16x8& pa1, bf16x8& pa2, bf16x8& pa3) {
    ATT_PK4(p0, 0, pa0); ATT_PK4(p0, 8, pa1); ATT_PK4(p1, 0, pa2); ATT_PK4(p1, 8, pa3);
}
template <int KB, bool BIAS>
__device__ __forceinline__ void qkt(f32x16& p0, f32x16& p1, const char* K_lds, int r32, int hi, const char* Qw  , const float* bias_tile  , const bf16x8* qr = nullptr) {
    if (BIAS) {
#pragma unroll
        for (int g = 0; g < 4; ++g) { const f32x4 b0 = *(const f32x4*)(bias_tile + 8 * g), b1 = *(const f32x4*)(bias_tile + 32 + 8 * g);
            p0[4 * g] = b0[0]; p0[4 * g + 1] = b0[1]; p0[4 * g + 2] = b0[2]; p0[4 * g + 3] = b0[3];
            p1[4 * g] = b1[0]; p1[4 * g + 1] = b1[1]; p1[4 * g + 2] = b1[2]; p1[4 * g + 3] = b1[3]; }
    } else { p0 = f32x16{}; p1 = f32x16{}; }
    int ko[4];
#pragma unroll
    for (int dd = 0; dd < 4; ++dd) ko[dd] = KSWZ(r32, (dd * 16 + hi * 8) * 2);
#pragma unroll
    for (int d0 = 0; d0 < 8; ++d0) { const char* a = K_lds + KB * SHM_K + ko[d0 & 3] + (d0 >> 2) * 128;
        bf16x8 b0 = *reinterpret_cast<const bf16x8*>(a);
        bf16x8 b1 = *reinterpret_cast<const bf16x8*>(a + 32 * 256);
#if ATT_QREG
        bf16x8 q = qr[d0];
#else
        bf16x8 q = *reinterpret_cast<const bf16x8*>(Qw + ko[d0 & 3] + (d0 >> 2) * 128);
#endif
        p0 = __builtin_amdgcn_mfma_f32_32x32x16_bf16(b0, q, p0, 0, 0, 0);
        p1 = __builtin_amdgcn_mfma_f32_32x32x16_bf16(b1, q, p1, 0, 0, 0); }
}
template <int VB>
__device__ __forceinline__ void pv_tile(f32x16* o, int vb0, bf16x8 pa0, bf16x8 pa1, bf16x8 pa2, bf16x8 pa3) {
#define TRRD(dst, off) asm volatile("ds_read_b64_tr_b16 %0, %1 offset:%2" : "=&v"(dst) : "v"(vb0), "i"(off) : "memory")
#define PV_D0(d0) do { s16x4 l0, l1, l2, l3, h0, h1, h2, h3; constexpr int b_ = VB * SHM_V + v_rd_off(d0, 0, 0); \
        TRRD(l0, b_); TRRD(h0, b_ + 2048); TRRD(l1, b_ + 4096); TRRD(h1, b_ + 6144); TRRD(l2, b_ + 8192); TRRD(h2, b_ + 10240); TRRD(l3, b_ + 12288); TRRD(h3, b_ + 14336); \
        asm volatile("s_waitcnt lgkmcnt(0)" ::: "memory"); SBAR();   \
        o[d0] = __builtin_amdgcn_mfma_f32_32x32x16_bf16(pa0, (bf16x8){l0[0], l0[1], l0[2], l0[3], h0[0], h0[1], h0[2], h0[3]}, o[d0], 0, 0, 0);   \
        o[d0] = __builtin_amdgcn_mfma_f32_32x32x16_bf16(pa1, (bf16x8){l1[0], l1[1], l1[2], l1[3], h1[0], h1[1], h1[2], h1[3]}, o[d0], 0, 0, 0);   \
        o[d0] = __builtin_amdgcn_mfma_f32_32x32x16_bf16(pa2, (bf16x8){l2[0], l2[1], l2[2], l2[3], h2[0], h2[1], h2[2], h2[3]}, o[d0], 0, 0, 0);   \
        o[d0] = __builtin_amdgcn_mfma_f32_32x32x16_bf16(pa3, (bf16x8){l3[0], l3[1], l3[2], l3[3], h3[0], h3[1], h3[2], h3[3]}, o[d0], 0, 0, 0); } while (0)
    PV_D0(0); PV_D0(1); PV_D0(2); PV_D0(3);
#undef PV_D0
#undef TRRD
}

struct BlockRef { const bf16* Q; const bf16* K; const bf16* V; bf16* O; int P0; int skv; float lg; const bf16* RG; const float* GN; unsigned char* O8; int wave;     };
struct Seam { bf16x8 qr[8]; bf16x8 st_v0, st_v1, st_k0, st_k1; };
template <int MODE> struct Pitch { static constexpr int LDQ = (MODE == 2) ? 512 : 11264, LDK = (MODE == 2) ? 1024 : 11264, LDO = LDQ; };

#define ROWK(p, k0, rr) ((p) + (size_t)((k0) + (rr)) * LDK + sc)
#define VMW() asm volatile("s_waitcnt vmcnt(0)" ::: "memory")
#define VMWN(n) asm volatile("s_waitcnt vmcnt(%0)" :: "i"(n) : "memory")
#define SLOAD_H(Kp, Vp, k0) do { S.st_v0 = load8(ROWK(Vp, k0, sr)); S.st_v1 = load8(ROWK(Vp, k0, 32 + sr));              \
                         S.st_k0 = load8(ROWK(Kp, k0, sr)); S.st_k1 = load8(ROWK(Kp, k0, 32 + sr)); } while (0)
#define SWRITE_HK(bf) do { *(bf16x8*)(K_lds + (bf) * SHM_K + kws) = S.st_k0; *(bf16x8*)(K_lds + (bf) * SHM_K + kws + 32 * 256) = S.st_k1; } while (0)
#define SWRITE_HV(bf) do { *(bf16x8*)(V_lds + (bf) * SHM_V + vst0) = S.st_v0; *(bf16x8*)(V_lds + (bf) * SHM_V + vst1) = S.st_v1; } while (0)
#define SWRITE_H(bf) do { SWRITE_HV(bf); SWRITE_HK(bf); } while (0)

template <int MODE>
__device__ __forceinline__ void attn_prime(const BlockRef& cur, char* lds, Seam& S) {
    constexpr int LDQ = Pitch<MODE>::LDQ, LDK = Pitch<MODE>::LDK;
    int tid_ = cur.wave * 64 + lane_now();
    const int tid = tid_, wid = __builtin_amdgcn_readfirstlane(tid >> 6), lane = tid & 63, r32 = lane & 31, hi = lane >> 5;
    const int sr = tid >> 4, sc = (tid & 15) * 8, kws = KSWZ(sr, sc * 2); char* K_lds = lds + 2 * SHM_V;
    const int kb0 = 0;
    for (int d0 = 0; d0 < 8; ++d0) S.qr[d0] = load8(cur.Q + (size_t)(wid * QBLK + r32) * LDQ + d0 * 16 + hi * 8);
    SLOAD_H(cur.K, cur.V, kb0); VMW(); SWRITE_HK(0);
    __syncthreads();
}
template <int MODE>
__device__ __forceinline__ void attn_block(const BlockRef& cur, const BlockRef& nxt, char* lds, Seam& S) {
    constexpr int LDQ = Pitch<MODE>::LDQ, LDK = Pitch<MODE>::LDK, LDO = Pitch<MODE>::LDO;
    constexpr bool BIAS = (MODE == 0), SOFTMAX = (MODE != 1);
    int tid_ = cur.wave * 64 + lane_now();
    const int tid = tid_, wid = __builtin_amdgcn_readfirstlane(tid >> 6), lane = tid & 63, r32 = lane & 31, hi = lane >> 5;
    const int j_lo = 0;
    int j_hi = (cur.P0 + QB - 1) / KVBLK + 1; if (j_hi > cur.skv / KVBLK) j_hi = cur.skv / KVBLK;
    const int NT = j_hi - j_lo;
    const int kbn = 0;
    const int qlo = cur.P0 + wid * QBLK, qm = qlo + r32 - 4 * hi;
    char* V_lds = lds; char* K_lds = lds + 2 * SHM_V;
    float* ws = (float*)(lds + LDS_WS) + wid * 64; float* li_l = ws, * al_l = ws + 32;
    const float* bias = (const float*)(lds + LDS_BIAS) + 4 * hi;
    float m_reg = -1e30f, l_reg = 0; f32x16 o[4] = {};
    const int sr = tid >> 4, sc = (tid & 15) * 8, vst0 = v_st(sr, sc), vst1 = v_st(32 + sr, sc), kws = KSWZ(sr, sc * 2);
    const int vb0 = (int)(uintptr_t)V_lds + v_rd_base(lane);
    const bf16* Kh = cur.K; const bf16* Vh = cur.V;
    const float lg = cur.lg; const int cq = qlo >> 6;
#define RESC(a) do { if (SOFTMAX) { if (__any((a) < 1.f)) { if (hi == 0) al_l[r32] = (a); asm volatile("s_waitcnt lgkmcnt(0)" ::: "memory");              \
                     for (int d_ = 0; d_ < 4; ++d_) for (int r = 0; r < 16; ++r) o[d_][r] *= al_l[crow(r, hi)]; } } } while (0)
#define KBASE(t) ((j_lo + (t)) * KVBLK)
#define POSTQK(P0_, P1_, mnX, alX, t) do { const int kb_ = KBASE(t); \
        if (MODE == 1) { ret_weight(P0_, P1_, qm - kb_, lg, cq - (j_lo + (t))); } \
        else { if (MODE == 0 && (kb_ + KVBLK - 1 > qlo)) mask_tile(P0_, P1_, qm - kb_); partialSM(P0_, P1_, m_reg, mnX, alX); } } while (0)
#define FINISH(P0_, P1_, alX) do { if (MODE == 1) ret_pack(P0_, P1_, pa0, pa1, pa2, pa3); else finishSM(P0_, P1_, alX, l_reg, pa0, pa1, pa2, pa3); } while (0)
    constexpr int NQL = 8;
#define SEAM_K0() do { VMWN(NQL); SWRITE_HK(0); SBAR(); } while (0)
    f32x16 pA0, pA1, pB0, pB1; float mnA = 0.f, mnB = 0.f, alA = 1.f, alB = 1.f; bf16x8 pa0, pa1, pa2, pa3;
    char* Qw = lds + LDS_Q + wid * 8192;
#if ATT_QREG
    const bf16x8* QR = S.qr;
#else
    const bf16x8* QR = nullptr;
#pragma unroll
    for (int d0 = 0; d0 < 8; ++d0) *(bf16x8*)(Qw + KSWZ(r32, (d0 * 16 + hi * 8) * 2)) = S.qr[d0];
#endif
    SWRITE_HV(0); SBAR();
    if (NT > 1) { SLOAD_H(Kh, Vh, KBASE(1)); }
    SBAR(); qkt<0, BIAS>(pA0, pA1, K_lds, r32, hi, Qw, bias + KBASE(0), QR);
    POSTQK(pA0, pA1, mnA, alA, 0);
    if (NT > 1) { VMW(); SWRITE_H(1); }
    __syncthreads();
#define HALF_STEP(PX0, PX1, mnX, alX, PY0, PY1, alY, t, KB, VB, SB) do {                                                      \
        SBAR(); qkt<KB, BIAS>(PX0, PX1, K_lds, r32, hi, Qw, bias + KBASE(t), QR);                                             \
        FINISH(PY0, PY1, alY); SBAR();                                                           \
        if ((t) + 1 < NT) { SLOAD_H(Kh, Vh, KBASE((t) + 1)); SBAR(); }                                               \
        pv_tile<VB>(o, vb0, pa0, pa1, pa2, pa3); POSTQK(PX0, PX1, mnX, alX, (t));                                        \
        __syncthreads();                                                                                                      \
        if ((t) + 1 < NT) { VMW(); SWRITE_H(SB); }                                                                          \
        RESC(alX); __syncthreads(); } while (0)
    for (int t = 1; t + 1 < NT; t += 2) {
        HALF_STEP(pB0, pB1, mnB, alB, pA0, pA1, alA, t, 1, 0, 0);
        HALF_STEP(pA0, pA1, mnA, alA, pB0, pB1, alB, t + 1, 0, 1, 1);
    }
    const bool even = (NT & 1) == 0;
    if (even) { SBAR(); qkt<1, BIAS>(pB0, pB1, K_lds, r32, hi, Qw, bias + KBASE(NT - 1), QR); SBAR(); }
    { constexpr int LDQn = LDQ; SLOAD_H(nxt.K, nxt.V, kbn); SBAR();
#pragma unroll
      for (int d0 = 0; d0 < 8; ++d0) S.qr[d0] = load8(nxt.Q + (size_t)(wid * QBLK + r32) * LDQn + d0 * 16 + hi * 8); }
    SBAR();
    FINISH(pA0, pA1, alA); SBAR();
    pv_tile<0>(o, vb0, pa0, pa1, pa2, pa3);
    if (even) { POSTQK(pB0, pB1, mnB, alB, NT - 1); __syncthreads(); RESC(alB);
        FINISH(pB0, pB1, alB); SBAR(); pv_tile<1>(o, vb0, pa0, pa1, pa2, pa3); }
    SBAR(); SEAM_K0();
    bf16* Ow = cur.O + (size_t)(wid * QBLK) * LDO;
    if (MODE != 1) {
        if (hi == 0) li_l[r32] = l_reg; asm volatile("s_waitcnt lgkmcnt(0)" ::: "memory");
        float rli[16];
#pragma unroll
        for (int r = 0; r < 16; ++r) rli[r] = __builtin_amdgcn_rcpf(li_l[crow(r, hi)]);
#pragma unroll
        for (int r = 0; r < 16; ++r) { const int orow = crow(r, hi);
#pragma unroll
            for (int d0 = 0; d0 < 4; ++d0) { const float v = o[d0][r] * rli[r];
                const float vn = ATT_DPPF(v, 0xB1);
                if (cur.O8) { const int pk = __builtin_amdgcn_cvt_pk_fp8_f32(v, vn, 0, false); const int pk2 = ATT_DPPI(pk, 0x4E);
                    if ((r32 & 3) == 0) *(unsigned*)(cur.O8 + (size_t)(wid * QBLK + orow) * (MODE == 2 ? 512 : 2048) + d0 * 32 + r32) = ((unsigned)pk & 0xFFFFu) | ((unsigned)pk2 << 16); }
                else if ((r32 & 1) == 0) *(unsigned*)(Ow + (size_t)orow * LDO + d0 * 32 + r32) = cvtpk(v, vn); } }
    } else {
        float gn[4];
#pragma unroll
        for (int d0 = 0; d0 < 4; ++d0) gn[d0] = cur.GN[d0 * 32 + r32];
        const bf16* RGw = cur.RG + (size_t)(wid * QBLK) * LDO;
        unsigned short rgv[16][4];
#pragma unroll
        for (int r = 0; r < 16; ++r)
#pragma unroll
            for (int d0 = 0; d0 < 4; ++d0) rgv[r][d0] = RGw[(size_t)crow(r, hi) * LDO + d0 * 32 + r32];
#pragma unroll
        for (int r = 0; r < 16; ++r) { const int orow = crow(r, hi);
            float s = (o[0][r] + o[1][r]) + (o[2][r] + o[3][r]);
            s += ATT_DPPF(s, 0xB1); s += ATT_DPPF(s, 0x4E);
#pragma unroll
            for (int x = 4; x < 32; x <<= 1) s += __shfl_xor(s, x);
            const float mean = s * (1.f / 128.f);
            float q = 0.f;
#pragma unroll
            for (int d0 = 0; d0 < 4; ++d0) { const float dlt = o[d0][r] - mean; q += dlt * dlt; }
            q += ATT_DPPF(q, 0xB1); q += ATT_DPPF(q, 0x4E);
#pragma unroll
            for (int x = 4; x < 32; x <<= 1) q += __shfl_xor(q, x);
            const float rstd = 1.f / sqrtf(q * (1.f / 128.f) + 1e-6f);
#pragma unroll
            for (int d0 = 0; d0 < 4; ++d0) { const float g = bf2f(rgv[r][d0]);
                const float v = (o[d0][r] - mean) * rstd * gn[d0] * g;
                const float vn = ATT_DPPF(v, 0xB1);
                if (cur.O8) { const int pk = __builtin_amdgcn_cvt_pk_fp8_f32(v, vn, 0, false); const int pk2 = ATT_DPPI(pk, 0x4E);
                    if ((r32 & 3) == 0) *(unsigned*)(cur.O8 + (size_t)(wid * QBLK + orow) * 2048 + d0 * 32 + r32) = ((unsigned)pk & 0xFFFFu) | ((unsigned)pk2 << 16); }
                else if ((r32 & 1) == 0) *(unsigned*)(Ow + (size_t)orow * LDO + d0 * 32 + r32) = cvtpk(v, vn); } }
    }
    asm volatile("s_waitcnt lgkmcnt(0)" ::: "memory"); __builtin_amdgcn_s_barrier(); asm volatile("" ::: "memory");
#undef RESC
#undef KBASE
#undef POSTQK
#undef FINISH
#undef SEAM_K0
#undef HALF_STEP
}
#undef ROWK
#undef VMW
#undef VMWN
#undef SLOAD_H
#undef SWRITE_HK
#undef SWRITE_HV
#undef SWRITE_H
#undef SBAR
#undef KSWZ
#undef ATT_PK4
}
#define GAS __attribute__((address_space(1)))
#define LAS __attribute__((address_space(3)))
typedef unsigned short bf16;
typedef unsigned v4u __attribute__((ext_vector_type(4)));
typedef float f32x4 __attribute__((ext_vector_type(4)));
typedef short bf16x8 __attribute__((ext_vector_type(8)));
typedef GAS unsigned gu32;
typedef GAS unsigned long long gu64;
#define RLX_AGENT __ATOMIC_RELAXED, __HIP_MEMORY_SCOPE_AGENT
#define LDS_WAIT() asm volatile("s_waitcnt lgkmcnt(0)" ::: "memory")
#define VM_WAIT() asm volatile("s_waitcnt vmcnt(0)" ::: "memory")
__device__ __forceinline__ unsigned long long rt() { return __builtin_amdgcn_s_memrealtime(); }
__device__ __forceinline__ unsigned f2bf(float f) { unsigned u = __builtin_bit_cast(unsigned, f); return (u + 0x7fffu + ((u >> 16) & 1u)) >> 16; }
__device__ __forceinline__ unsigned pk2(float lo, float hi) { return f2bf(lo) | (f2bf(hi) << 16); }

#define XB_TMO      128
#define XB_XCNT(j)  (256  + 64 * (j))
#define XB_XSUB(j)  (1280 + 64 * (j))
#define XB_XGEN(j)  (2304 + 64 * (j))
#define XB_TOP      3328
#define XB_TOPGEN   3392
#define XCD_BAR_WORDS 3456
#define XB_SPIN_CAP (1u << 18)

__device__ __forceinline__ unsigned xb_ld(unsigned* p)              { return __hip_atomic_load(p, __ATOMIC_RELAXED, __HIP_MEMORY_SCOPE_AGENT); }
__device__ __forceinline__ unsigned xb_add(unsigned* p, unsigned v) { return __hip_atomic_fetch_add(p, v, __ATOMIC_RELAXED, __HIP_MEMORY_SCOPE_AGENT); }
__device__ __forceinline__ unsigned xb_xcc_id() { return (unsigned)__builtin_amdgcn_s_getreg((3 << 11) | 20) & 0xFu; }
#define XB_SPIN(cond, bar) do { unsigned _sp = 0; while (cond) { __builtin_amdgcn_s_sleep(1); \
    if ((++_sp & 255u) == 0u) { if (xb_ld(&(bar)[XB_TMO])) break; if (_sp > XB_SPIN_CAP) { atomicAdd(&(bar)[XB_TMO], 1u); break; } } } } while (0)

struct XcdBarrier {
    unsigned* bar; unsigned x;
    unsigned wave;
    volatile LAS unsigned* st;
};

__device__ __forceinline__ XcdBarrier xcd_barrier_post(unsigned* bar, volatile LAS unsigned* st, unsigned wave) {
    XcdBarrier b; b.bar = bar; b.x = xb_xcc_id(); b.st = st; b.wave = wave;
    if (wave == 0u && lane_now() == 0) (void)xb_add(&bar[XB_XCNT(b.x)], 1u);
    return b;
}
__device__ __forceinline__ void xcd_barrier_complete(unsigned* bar, unsigned x, unsigned& nloc, unsigned& nx) {
    const unsigned G = gridDim.x * gridDim.y * gridDim.z;
    unsigned sum, cnt, mine, sp = 0u;
    for (;;) {
        sum = 0u; cnt = 0u; mine = 0u;
#pragma unroll
        for (unsigned j = 0; j < 16; ++j) { const unsigned c = xb_ld(&bar[XB_XCNT(j)]); sum += c; cnt += (c > 0u) ? 1u : 0u; mine = (j == x) ? c : mine; }
        if (sum == G) break;
        __builtin_amdgcn_s_sleep(1);
        if ((++sp & 255u) == 0u) { if (xb_ld(&bar[XB_TMO])) break; if (sp > XB_SPIN_CAP) { atomicAdd(&bar[XB_TMO], 1u); break; } }
    }
    nloc = mine > 0u ? mine : 1u; nx = cnt > 0u ? cnt : 1u;
}

__device__ __forceinline__ void xcd_barrier(const XcdBarrier& b) {
    asm volatile("s_waitcnt vmcnt(0)" ::: "memory");
    __syncthreads();
    if (b.wave == 0u && lane_now() == 0) {
        unsigned* bar = b.bar;
        __builtin_amdgcn_s_waitcnt(0);
        unsigned nloc = b.st[0], nx = b.st[1];
        if (nloc == 0u) { xcd_barrier_complete(bar, b.x, nloc, nx); b.st[0] = nloc; b.st[1] = nx; }
        const unsigned old = xb_add(&bar[XB_XSUB(b.x)], 1u);
        const unsigned gen = old / nloc;
        if (old + 1u == (gen + 1u) * nloc) {
            __builtin_amdgcn_fence(__ATOMIC_RELEASE, "agent");
            asm volatile("s_waitcnt vmcnt(0)" ::: "memory");
            const unsigned og = xb_add(&bar[XB_TOP], 1u);
            const unsigned tg = og / nx;
            if (og + 1u == (tg + 1u) * nx) xb_add(&bar[XB_TOPGEN], 1u);
            else XB_SPIN(xb_ld(&bar[XB_TOPGEN]) == tg, bar);
            __builtin_amdgcn_fence(__ATOMIC_ACQUIRE, "agent");
            xb_add(&bar[XB_XGEN(b.x)], 1u);
            asm volatile("s_waitcnt vmcnt(0)" ::: "memory");
        } else {
            XB_SPIN(xb_ld(&bar[XB_XGEN(b.x)]) == gen, bar);
            __builtin_amdgcn_fence(__ATOMIC_ACQUIRE, "agent");
            asm volatile("s_waitcnt vmcnt(0)" ::: "memory");
        }
    }
    __syncthreads();
}
constexpr int NWAVES = 8;
constexpr int M_TOK = 16384, DM = 2048, SEQ = 2048, NB = 8;
constexpr int PP = 11264;
constexpr int C_RQ = 0, C_RK = 1024, C_FQ = 2048, C_FK = 3072, C_FV = 4096, C_RV = 5120, C_RG = 6144, C_G0 = 7168, C_G1 = 9216;
constexpr int N_QK = 2048, N_REST = 9216;
#ifndef TK_NET
#define TK_NET 1
#endif
#ifndef EX_SLICEMAJOR
#define EX_SLICEMAJOR 1
#endif
#ifndef EX_FP6
#define EX_FP6 1
#endif
#ifndef EX_W512
#define EX_W512 1
#endif
#ifndef EX_FP6_HWPACK
#define EX_FP6_HWPACK 2
#endif
#ifndef EX_PFLIST
#define EX_PFLIST 1
#endif
typedef unsigned u32x2m __attribute__((ext_vector_type(2)));
typedef unsigned v6u_t __attribute__((ext_vector_type(6))); typedef float v32f_t __attribute__((ext_vector_type(32)));
#ifndef FP8_UP_OUT
#define FP8_UP_OUT 1
#endif
constexpr int W8_SCALE_B = 0x79797979;
constexpr int N_IN_ORIG = 11272;
constexpr float RMS_EPS = 1e-6f;
constexpr float QK_C2 = 0.08838834764831845f * 1.4426950408889634f;
constexpr size_t MiB = 1u << 20;
constexpr size_t DO_XN8 = 0, DO_OCAT8 = 32 * MiB;
constexpr size_t DO_OFOX8 = DO_OCAT8, DO_ORET8 = DO_OCAT8 + 1024;
constexpr size_t WS_CTL = 0, CTL_ZERO_BYTES = 1 * MiB;
constexpr size_t WS_ROWSS1 = 256 * 1024, WS_ROWSS2 = 512 * 1024;
constexpr size_t WS_WIN = 1 * MiB, WS_WFOX = 45 * MiB, WS_WRET = 49 * MiB, WS_WOUT = 53 * MiB, WS_WMQ = 61 * MiB, WS_WMKV = 63 * MiB, WS_WMO = 67 * MiB, WS_WPQ = 69 * MiB, WS_SUBK = 77 * MiB;
constexpr size_t WS_PSCALE = 79 * MiB;
constexpr size_t WS_LOGF = 78 * MiB, WS_CUMF = 78 * MiB + 512 * 1024;
constexpr size_t WS_XN = 80 * MiB;
constexpr size_t WS_PROJ = 144 * MiB;
constexpr size_t WS_MN = 496 * MiB, WS_KVM = 504 * MiB, WS_END = 508 * MiB;
constexpr size_t WS_XB1B = 144 * MiB;
constexpr size_t WS_XB2 = FP8_UP_OUT ? WS_XB1B : WS_XN;
constexpr size_t WS_XB1 = FP8_UP_OUT ? WS_XN   : WS_XB1B, WS_QM = 208 * MiB, WS_OMEM = 224 * MiB, WS_PU = 240 * MiB, WS_PV = 304 * MiB, WS_QP = (FP8_UP_OUT ? 368 : 144) * MiB  , WS_IDX = 208 * MiB, WS_GATE = 216 * MiB;
constexpr int CW_BAR = 4096, CW_CONV = 64;
constexpr int RING_BYTES = 131072, LDS_BYTES = 147456, LDSCTL_OFF = LDS_BYTES - 1024, MISC_OFF = LDSCTL_OFF + 320;
static_assert(att::LDS_BYTES <= LDSCTL_OFF, "attention LDS");

struct Args { const float* in[23]; float* out; unsigned char* ws; int ph_lo, ph_hi; int p0_mask, pad; };
enum { I_X = 0, I_MEM, I_LN_MIX, I_W_IN, I_B_FORGET, I_FOXQ_G, I_FOXK_G, I_RET_G, I_W_FOXUP, I_W_RETUP, I_W_OUT, I_LN_MEM, I_MEMNORM_G, I_W_MQ, I_W_MKV, I_MEMQ_G, I_MEMK_G, I_W_MO, I_LN_FFN, I_W_PQ, I_SUBK, I_PEER_U, I_PEER_V };

#ifdef NO_NT
#define LDNT(p) (*(p))
#define STNT(v, p) (*(p) = (v))
#else
#define STNT(v, p) (*(p) = (v))
#define LDNT(p) __builtin_nontemporal_load(p)
#endif
#define ROW16_DPP(v, ctrl) __builtin_bit_cast(float, __builtin_amdgcn_update_dpp(0, __builtin_bit_cast(int, (v)), (ctrl), 0xF, 0xF, false))
__device__ __forceinline__ float wave_sum(float v) {
    v += __builtin_bit_cast(float, __builtin_amdgcn_update_dpp(0, __builtin_bit_cast(int, v), 0xB1, 0xF, 0xF, false));
    v += __builtin_bit_cast(float, __builtin_amdgcn_update_dpp(0, __builtin_bit_cast(int, v), 0x4E, 0xF, 0xF, false));
    v += __builtin_bit_cast(float, __builtin_amdgcn_update_dpp(0, __builtin_bit_cast(int, v), 0x124, 0xF, 0xF, false));
    v += __builtin_bit_cast(float, __builtin_amdgcn_update_dpp(0, __builtin_bit_cast(int, v), 0x128, 0xF, 0xF, false));
    v += __shfl_xor(v, 16); v += __shfl_xor(v, 32);
    return v;
}
__device__ __forceinline__ void transpose_item(const float* W, int ldw, int K, int src_col0, const float* kgain, bf16* WT, int dst_row0, LAS float* scr, int kb, int nb, int lane) {
    const int k0 = 64 * kb, n0 = 32 * nb;
    f32x4 ld[8];
#pragma unroll
    for (int i = 0; i < 8; ++i) ld[i] = LDNT((const GAS f32x4*)(W + (size_t)(k0 + 8 * i + (lane >> 3)) * ldw + src_col0 + n0 + 4 * (lane & 7)));
#pragma unroll
    for (int i = 0; i < 8; ++i) { const int kk = 8 * i + (lane >> 3); f32x4 v = ld[i]; if (kgain) v = v * kgain[k0 + kk]; LAS float* d = scr + kk * 33 + 4 * (lane & 7); d[0] = v.x; d[1] = v.y; d[2] = v.z; d[3] = v.w; }
    LDS_WAIT(); asm volatile("" ::: "memory");
    const int c = lane & 7;
#pragma unroll
    for (int j = 0; j < 4; ++j) { const int n = (lane >> 3) + 8 * j; const LAS float* s = scr + (8 * c) * 33 + n;
        v4u o; o.x = pk2(s[0 * 33], s[1 * 33]); o.y = pk2(s[2 * 33], s[3 * 33]); o.z = pk2(s[4 * 33], s[5 * 33]); o.w = pk2(s[6 * 33], s[7 * 33]);
        int nn = n0 + n;
#if ROPE_FUSED
        if (dst_row0 < 0) { const int d = nn & 127, dd = d & 63; nn = (nn & ~127) | (8 * (dd >> 2) + (d >> 6) * 4 + (dd & 3)); }
#endif
        *(GAS v4u*)(WT + (size_t)((dst_row0 < 0 ? 0 : dst_row0) + nn) * K + k0 + 8 * c) = o; }
    LDS_WAIT(); asm volatile("" ::: "memory");
}
__device__ __forceinline__ void transpose_item8(const float* W, int ldw, int K  , int src_col0, unsigned char* WT8  , int kb, int nb, LAS float* scr, int lane) {
    const int k0 = 64 * kb, n0 = 32 * nb;
    f32x4 ld[8];
#pragma unroll
    for (int i = 0; i < 8; ++i) ld[i] = LDNT((const GAS f32x4*)(W + (size_t)(k0 + 8 * i + (lane >> 3)) * ldw + src_col0 + n0 + 4 * (lane & 7)));
#pragma unroll
    for (int i = 0; i < 8; ++i) { const int kk = 8 * i + (lane >> 3); const f32x4 v = ld[i] * 64.f; LAS float* d = scr + kk * 33 + 4 * (lane & 7); d[0] = v.x; d[1] = v.y; d[2] = v.z; d[3] = v.w; }
    LDS_WAIT(); asm volatile("" ::: "memory");
    const int c = lane & 7;
#pragma unroll
    for (int j = 0; j < 4; ++j) { const int n = (lane >> 3) + 8 * j; const LAS float* s = scr + (8 * c) * 33 + n;
        int p0 = 0, p1 = 0; p0 = __builtin_amdgcn_cvt_pk_fp8_f32(s[0 * 33], s[1 * 33], p0, false); p0 = __builtin_amdgcn_cvt_pk_fp8_f32(s[2 * 33], s[3 * 33], p0, true);
        p1 = __builtin_amdgcn_cvt_pk_fp8_f32(s[4 * 33], s[5 * 33], p1, false); p1 = __builtin_amdgcn_cvt_pk_fp8_f32(s[6 * 33], s[7 * 33], p1, true);
        *(GAS unsigned long long*)(WT8 + (size_t)(n0 + n) * K + k0 + 8 * c) = (unsigned long long)(unsigned)p0 | ((unsigned long long)(unsigned)p1 << 32); }
    LDS_WAIT(); asm volatile("" ::: "memory");
}
struct TJob { const float* W; int ldw, K, N; const float* gain; bf16* WT; int fp8; };

__device__ __forceinline__ void rms_row_to_bf16(const float* xrow, const float* gain, bf16* orow, int lane, f32x4 (&hv)[8], unsigned char* orow8 = nullptr) {
    const GAS f32x4* xr = (const GAS f32x4*)xrow + lane; float s = 0.f;
#pragma unroll
    for (int j = 0; j < 8; ++j) { hv[j] = LDNT(xr + 64 * j); s += (hv[j].x * hv[j].x + hv[j].y * hv[j].y) + (hv[j].z * hv[j].z + hv[j].w * hv[j].w); }
    const float r = 1.f / sqrtf(wave_sum(s) * (1.f / DM) + RMS_EPS);
    GAS unsigned long long* o8 = (GAS unsigned long long*)orow + lane;
    f32x4 gv[8];
#pragma unroll
    for (int j = 0; j < 8; ++j) gv[j] = ((const GAS f32x4*)gain)[lane + 64 * j];
#pragma unroll
    for (int j = 0; j < 8; ++j) { const f32x4 g = gv[j]; hv[j] = hv[j] * r * g;
        o8[64 * j] = (unsigned long long)pk2(hv[j].x, hv[j].y) | ((unsigned long long)pk2(hv[j].z, hv[j].w) << 32);
        if (orow8) { int p = 0; p = __builtin_amdgcn_cvt_pk_fp8_f32(hv[j].x, hv[j].y, p, false); p = __builtin_amdgcn_cvt_pk_fp8_f32(hv[j].z, hv[j].w, p, true); ((GAS unsigned*)orow8)[lane + 64 * j] = (unsigned)p; } }
}
__device__ __forceinline__ float log_sigmoid_f(float z) { return fminf(z, 0.f) - 0.6931471805599453f * __builtin_amdgcn_logf(1.f + __builtin_amdgcn_exp2f(-1.4426950408889634f * fabsf(z))); }

struct Frame { LAS unsigned char* lds; unsigned char* ldsg; int tid, lane, wave, G, bx, p0_mask; const float* const* in; float* out; unsigned char* ws; };

__device__ __forceinline__ void p0_prologue(Frame& F) {
    const int gw = F.bx * NWAVES + F.wave, NGW = F.G * NWAVES;
    if (F.p0_mask & 1) {
        LAS float* scr = (LAS float*)(F.lds + F.wave * 16384);
        const TJob jobs[9] = {
            {F.in[I_W_IN], N_IN_ORIG, 2048, N_QK, nullptr, (bf16*)(F.ws + WS_WIN), 0},
            {F.in[I_W_IN], N_IN_ORIG, 2048, N_REST, nullptr, (bf16*)(F.ws + WS_WIN + 16 * MiB), 1},
            {F.in[I_W_FOXUP], 2048, 1024, 2048, nullptr, (bf16*)(F.ws + WS_WFOX), FP8_UP_OUT},
            {F.in[I_W_RETUP], 2048, 1024, 2048, nullptr, (bf16*)(F.ws + (FP8_UP_OUT ? WS_WFOX + 1024 : WS_WRET)), FP8_UP_OUT},
            {F.in[I_W_OUT], 2048, 2048, 2048, nullptr, (bf16*)(F.ws + WS_WOUT), FP8_UP_OUT},
            {F.in[I_W_MQ], 512, 2048, 512, F.in[I_LN_MEM], (bf16*)(F.ws + WS_WMQ), 0},
            {F.in[I_W_MKV], 1024, 2048, 1024, nullptr, (bf16*)(F.ws + WS_WMKV), 0},
            {F.in[I_W_MO], 2048, 512, 2048, nullptr, (bf16*)(F.ws + WS_WMO), 1},
            {F.in[I_W_PQ], 2048, 2048, 2048, F.in[I_LN_FFN], (bf16*)(F.ws + WS_WPQ), 0} };
        int base = 0;
#pragma unroll
        for (int j = 0; j < 9; ++j) {
            const TJob& J = jobs[j]; const int nblk = J.N / 32, items = (J.K / 64) * nblk;
            int first = gw - (base % NGW); if (first < 0) first += NGW;
            for (int r = first; r < items; r += NGW) { const int kb = r / nblk, nb = r % nblk;
                int src_col0 = 0;
                if (j == 0) src_col0 = 3080;
                if (j == 1) src_col0 = (nb * 32 < 3072) ? 0 : 2056;
                if (J.fp8) transpose_item8(J.W, J.ldw, (FP8_UP_OUT && (j == 2 || j == 3)) ? 2048 : J.K, src_col0, (unsigned char*)J.WT, kb, nb, scr, F.lane);
                else transpose_item(J.W, J.ldw, J.K, src_col0, J.gain, J.WT, (ROPE_FUSED && j == 0) ? -1 : 0, scr, kb, nb, F.lane); }
            base += items;
        }
    }
    if (F.p0_mask & 1) {
        const float* sk = F.in[I_SUBK]; bf16* o = (bf16*)(F.ws + WS_SUBK);
        for (int i = (F.bx * 512 + F.tid) * 4; i < 16 * 128 * 128; i += F.G * 512 * 4) { const f32x4 v = *(const GAS f32x4*)(sk + i);
            *(GAS unsigned long long*)(o + i) = (unsigned long long)pk2(v.x, v.y) | ((unsigned long long)pk2(v.z, v.w) << 32); }
    }
    __syncthreads();
    if (F.p0_mask & 2) {
        LAS float* wf = (LAS float*)F.lds; const float* w = F.in[I_W_IN];
        f32x4 a[4], b[4];
#pragma unroll
        for (int i = 0; i < 4; ++i) { const int k = F.tid + 512 * i; a[i] = *(const GAS f32x4*)(w + (size_t)k * N_IN_ORIG + 3072); b[i] = *(const GAS f32x4*)(w + (size_t)k * N_IN_ORIG + 3076); }
#pragma unroll
        for (int i = 0; i < 4; ++i) { const int k = F.tid + 512 * i;
            wf[0 * 2048 + k] = a[i].x; wf[1 * 2048 + k] = a[i].y; wf[2 * 2048 + k] = a[i].z; wf[3 * 2048 + k] = a[i].w; wf[4 * 2048 + k] = b[i].x; wf[5 * 2048 + k] = b[i].y; wf[6 * 2048 + k] = b[i].z; wf[7 * 2048 + k] = b[i].w; }
    }
    __syncthreads();
    if (F.p0_mask & 2) {
        const LAS float* wf = (const LAS float*)F.lds; const float* bfg = F.in[I_B_FORGET]; float* logf_o = (float*)(F.ws + WS_LOGF);
        for (int m = gw; m < M_TOK; m += NGW) { f32x4 hv[8];
            rms_row_to_bf16(F.in[I_X] + (size_t)m * DM, F.in[I_LN_MIX], (bf16*)(F.ws + WS_XN) + (size_t)m * DM, F.lane, hv, (unsigned char*)F.out + DO_XN8 + (size_t)m * DM);
            float z = 0.f;
#pragma unroll
            for (int q = 0; q < 8; ++q) { float acc = 0.f;
#pragma unroll
                for (int j = 0; j < 8; ++j) { const f32x4 wv = *(const LAS f32x4*)(wf + q * 2048 + 4 * F.lane + 256 * j); acc += (hv[j].x * wv.x + hv[j].y * wv.y) + (hv[j].z * wv.z + hv[j].w * wv.w); }
                acc = wave_sum(acc); z = (F.lane == q) ? acc : z;
                __builtin_amdgcn_sched_barrier(0); }
            if (F.lane < 8) logf_o[(size_t)m * 8 + F.lane] = log_sigmoid_f(z + bfg[F.lane]);
        }
        for (int m = gw; m < NB * 256; m += NGW) { f32x4 hv[8]; rms_row_to_bf16(F.in[I_MEM] + (size_t)m * DM, F.in[I_MEMNORM_G], (bf16*)(F.ws + WS_MN) + (size_t)m * DM, F.lane, hv); }
    }
}
__device__ __forceinline__ void p1_scan(Frame& F) {
    if (F.bx < 64) {
        const int b = F.bx >> 3, h = F.bx & 7; const float* lf = (const float*)(F.ws + WS_LOGF); float* cf = (float*)(F.ws + WS_CUMF) + (size_t)F.bx * SEQ;
        float v[4]; float run = 0.f;
#pragma unroll
        for (int i = 0; i < 4; ++i) { run += lf[(size_t)(b * SEQ + F.tid * 4 + i) * 8 + h]; v[i] = run; }
        float incl = run;
#pragma unroll
        for (int o = 1; o < 64; o <<= 1) { const float t = __shfl_up(incl, o); if (F.lane >= o) incl += t; }
        LAS float* wt = (LAS float*)F.lds;
        if (F.lane == 63) wt[F.wave] = incl;
        __syncthreads();
        float off = incl - run;
        for (int w = 0; w < F.wave; ++w) off += wt[w];
#pragma unroll
        for (int i = 0; i < 4; ++i) cf[F.tid * 4 + i] = v[i] + off;
    }
    __syncthreads();
}
__device__ __forceinline__ void unpack8s(const att::bf16x8 v, float (&f)[8]) {
#pragma unroll
    for (int i = 0; i < 8; ++i) f[i] = __uint_as_float((unsigned)(unsigned short)v[i] << 16);
}
__device__ __forceinline__ att::bf16x8 pack8s(const float (&f)[8]) { v4u w; w.x = pg8::cvt_pk_bf16(f[0], f[1]); w.y = pg8::cvt_pk_bf16(f[2], f[3]); w.z = pg8::cvt_pk_bf16(f[4], f[5]); w.w = pg8::cvt_pk_bf16(f[6], f[7]); return __builtin_bit_cast(att::bf16x8, w); }
__device__ __forceinline__ void p4_attention(Frame& F) {
    char* lds = (char*)F.ldsg;
    const int xcd = F.bx & 7, kk = F.bx >> 3;
    const int bh = (kk >> 2) * 8 + xcd, x = kk & 3, b = bh >> 3, h = bh & 7;
    if (bh >= 64) return;
    const att::bf16* proj = (const att::bf16*)(F.ws + WS_PROJ);
    const size_t rowb = (size_t)b * SEQ;
    if (F.p0_mask & 1) {
        float* tbl = (float*)(lds + att::LDS_BIAS); const float* cf = (const float*)(F.ws + WS_CUMF) + (size_t)bh * SEQ;
        const f32x4 v = *(const f32x4*)(cf + F.tid * 4); *(f32x4*)(tbl + F.tid * 4) = v * (-1.4426950408889634f);
        att::BlockRef r0, r1; r0.wave = F.wave;
        r0.Q = proj + (rowb + (size_t)x * 256) * PP + C_FQ + h * 128; r0.K = proj + rowb * PP + C_FK + h * 128; r0.V = proj + rowb * PP + C_FV + h * 128; r0.O = (att::bf16*)r0.Q;
        r0.P0 = x * 256; r0.skv = SEQ; r0.lg = 0.f; r0.RG = nullptr; r0.GN = nullptr; r0.O8 = FP8_UP_OUT ? (unsigned char*)F.out + DO_OFOX8 + (rowb + (size_t)x * 256) * 2048 + h * 128 : nullptr;
        r1 = r0; r1.Q = proj + (rowb + (size_t)(7 - x) * 256) * PP + C_FQ + h * 128; r1.O = (att::bf16*)r1.Q; r1.P0 = (7 - x) * 256; r1.O8 = FP8_UP_OUT ? (unsigned char*)F.out + DO_OFOX8 + (rowb + (size_t)(7 - x) * 256) * 2048 + h * 128 : nullptr;
        att::Seam S;
        att::attn_prime<0>(r0, lds, S);
        att::attn_block<0>(r0, r1, lds, S);
        att::attn_block<0>(r1, r1, lds, S);
    }
    if (F.p0_mask & 2) {
        att::BlockRef r0, r1; r0.wave = F.wave;
        r0.Q = proj + (rowb + (size_t)x * 256) * PP + C_RQ + h * 128; r0.K = proj + rowb * PP + C_RK + h * 128; r0.V = proj + rowb * PP + C_RV + h * 128; r0.O = (att::bf16*)r0.Q;
        r0.P0 = x * 256; r0.skv = SEQ; r0.lg = __builtin_amdgcn_logf(1.f - __builtin_amdgcn_exp2f(-5.f - (float)h))    ; r0.RG = proj + (rowb + (size_t)x * 256) * PP + C_RG + h * 128; r0.GN = F.in[I_RET_G] + h * 128; r0.O8 = FP8_UP_OUT ? (unsigned char*)F.out + DO_ORET8 + (rowb + (size_t)x * 256) * 2048 + h * 128 : nullptr;
        r1 = r0; r1.O8 = FP8_UP_OUT ? (unsigned char*)F.out + DO_ORET8 + (rowb + (size_t)(7 - x) * 256) * 2048 + h * 128 : nullptr; r1.Q = proj + (rowb + (size_t)(7 - x) * 256) * PP + C_RQ + h * 128; r1.O = (att::bf16*)r1.Q; r1.P0 = (7 - x) * 256; r1.RG = proj + (rowb + (size_t)(7 - x) * 256) * PP + C_RG + h * 128;
        att::Seam S;
        att::attn_prime<1>(r0, lds, S);
        att::attn_block<1>(r0, r1, lds, S);
        att::attn_block<1>(r1, r1, lds, S);
    }
}


__device__ __forceinline__ void p8_convert_peer(Frame& F) {
    const int lane = F.lane;
    f32x4 g[8];
#pragma unroll
    for (int j = 0; j < 8; ++j) g[j] = ((const GAS f32x4*)F.in[I_LN_FFN])[lane + 64 * j];
    float* scl = (float*)(F.ws + WS_PSCALE);
    int r0, rend, rstride;
#ifndef CV_R1
#define CV_R1 22272
#endif
#ifndef CVQ
#define CVQ 2
#endif
    if (F.bx >= 160) { r0 = (F.bx - 160) * NWAVES + F.wave; rend = CV_R1; rstride = 768; } else { r0 = CV_R1 + F.bx * NWAVES + F.wave; rend = 32768; rstride = 1280; }
#pragma unroll 1
    for (int rr = r0; rr < rend; rr += CVQ * rstride) {
        f32x4 v[CVQ][8]; float amax[CVQ]; bool ok[CVQ], isu[CVQ]; int ri[CVQ];
#pragma unroll
        for (int q = 0; q < CVQ; ++q) { const int r = rr + q * rstride; ok[q] = r < rend; const int rc = ok[q] ? r : rr; isu[q] = rc < 16384; ri[q] = rc; amax[q] = 0.f;
            const float* src = (isu[q] ? F.in[I_PEER_U] : F.in[I_PEER_V]) + (size_t)(rc & 16383) * DM;
#pragma unroll
#if defined(CV_LDS)
            for (int j = 0; j < 8; ++j) __builtin_amdgcn_global_load_lds((const unsigned*)((const f32x4*)src + lane + 64 * j), (LAS unsigned*)(F.lds + F.wave * (CVQ * 8192) + q * 8192 + j * 1024), 16, 0, CV_LDS); }
        asm volatile("s_waitcnt vmcnt(0)" ::: "memory");
#pragma unroll
        for (int q = 0; q < CVQ; ++q) {
#pragma unroll
            for (int j = 0; j < 8; ++j) v[q][j] = *(const LAS f32x4*)(F.lds + F.wave * (CVQ * 8192) + q * 8192 + j * 1024 + lane * 16); }
        LDS_WAIT(); asm volatile("" ::: "memory");
#elif !defined(CV_NO_NT)
            for (int j = 0; j < 8; ++j) v[q][j] = __builtin_nontemporal_load((const GAS f32x4*)src + lane + 64 * j); }
#else
            for (int j = 0; j < 8; ++j) v[q][j] = ((const GAS f32x4*)src)[lane + 64 * j]; }
#endif
#pragma unroll
        for (int q = 0; q < CVQ; ++q) {
#pragma unroll
            for (int j = 0; j < 8; ++j) { if (isu[q]) v[q][j] = v[q][j] * g[j]; amax[q] = fmaxf(amax[q], fmaxf(fmaxf(fabsf(v[q][j].x), fabsf(v[q][j].y)), fmaxf(fabsf(v[q][j].z), fabsf(v[q][j].w)))); }
#pragma unroll
            for (int o = 16; o < 64; o <<= 1) amax[q] = fmaxf(amax[q], __shfl_xor(amax[q], o));
            amax[q] = fmaxf(amax[q], ROW16_DPP(amax[q], 0xB1)); amax[q] = fmaxf(amax[q], ROW16_DPP(amax[q], 0x4E)); amax[q] = fmaxf(amax[q], ROW16_DPP(amax[q], 0x124)); amax[q] = fmaxf(amax[q], ROW16_DPP(amax[q], 0x128));
            const float sc = amax[q] > 0.f ? amax[q] * (EX_FP6 ? (1.f / 7.5f) : (1.f / 448.f)) : 1.f, inv = 1.f / sc;
            if (ok[q]) { if (lane == 0) scl[ri[q]] = sc;
#if EX_FP6
                { unsigned cw[6];
#if EX_FP6_HWPACK
                  { typedef float v16f_t __attribute__((ext_vector_type(16))); v16f_t pa, pb;
#pragma unroll
                    for (int j = 0; j < 4; ++j) { pa[4 * j] = v[q][j].x * inv; pa[4 * j + 1] = v[q][j].y * inv; pa[4 * j + 2] = v[q][j].z * inv; pa[4 * j + 3] = v[q][j].w * inv;
                        pb[4 * j] = v[q][j + 4].x * inv; pb[4 * j + 1] = v[q][j + 4].y * inv; pb[4 * j + 2] = v[q][j + 4].z * inv; pb[4 * j + 3] = v[q][j + 4].w * inv; }
#if EX_FP6_HWPACK == 2
                    { v16f_t ea, eb;
#pragma unroll
                      for (int i = 0; i < 8; ++i) { ea[i] = pa[2 * i]; eb[i] = pa[2 * i + 1]; ea[8 + i] = pb[2 * i]; eb[8 + i] = pb[2 * i + 1]; }
                      pa = ea; pb = eb; }
#endif
                    const v6u_t r6 = __builtin_amdgcn_cvt_scalef32_2xpk16_fp6_f32(pa, pb, 1.0f);
#pragma unroll
                    for (int d = 0; d < 6; ++d) cw[d] = r6[d]; }
#else
#pragma unroll
                  for (int d = 0; d < 6; ++d) cw[d] = 0u;
#pragma unroll
                  for (int j = 0; j < 8; ++j) { const float y4[4] = {v[q][j].x * inv, v[q][j].y * inv, v[q][j].z * inv, v[q][j].w * inv};
#pragma unroll
                      for (int k = 0; k < 4; ++k) { const float y = y4[k], ay = fabsf(y);
                          const float qf = ay < 2.f ? rintf(ay * 8.f) : (ay < 4.f ? rintf(ay * 4.f) + 8.f : fminf(rintf(ay * 2.f) + 16.f, 31.f));
                          const unsigned code = (unsigned)qf | (y < 0.f ? 32u : 0u);
                          const int bp = 6 * (4 * j + k), d = bp >> 5, sh = bp & 31;
                          cw[d] |= code << sh; if (sh > 26) cw[d + 1] |= code >> (32 - sh); } }
#endif
#if EX_W512
                  GAS unsigned* o6 = (GAS unsigned*)(F.ws + (isu[q] ? WS_PU : WS_PV) + (size_t)(lane >> 4) * ((size_t)16384 * 384) + (size_t)(ri[q] & 16383) * 384 + (lane & 15) * 24);
#else
                  GAS unsigned* o6 = (GAS unsigned*)(F.ws + (isu[q] ? WS_PU : WS_PV) + (size_t)(lane >> 3) * ((size_t)16384 * 192) + (size_t)(ri[q] & 16383) * 192 + (lane & 7) * 24);
#endif
                  *(GAS u32x2m*)o6 = (u32x2m){cw[0], cw[1]}; *(GAS u32x2m*)(o6 + 2) = (u32x2m){cw[2], cw[3]}; *(GAS u32x2m*)(o6 + 4) = (u32x2m){cw[4], cw[5]}; } } }
#elif EX_SLICEMAJOR
                GAS unsigned* o4 = (GAS unsigned*)(F.ws + (isu[q] ? WS_PU : WS_PV) + (size_t)(ri[q] & 16383) * 256) + lane;
#pragma unroll
                for (int j = 0; j < 8; ++j) { int p = 0; p = __builtin_amdgcn_cvt_pk_fp8_f32(v[q][j].x * inv, v[q][j].y * inv, p, false); p = __builtin_amdgcn_cvt_pk_fp8_f32(v[q][j].z * inv, v[q][j].w * inv, p, true); o4[(size_t)j * (16384 * 64)] = (unsigned)p; } } }
#else
                GAS unsigned* o4 = (GAS unsigned*)(F.ws + (isu[q] ? WS_PU : WS_PV) + (size_t)(ri[q] & 16383) * DM) + lane;
#pragma unroll
                for (int j = 0; j < 8; ++j) { int p = 0; p = __builtin_amdgcn_cvt_pk_fp8_f32(v[q][j].x * inv, v[q][j].y * inv, p, false); p = __builtin_amdgcn_cvt_pk_fp8_f32(v[q][j].z * inv, v[q][j].w * inv, p, true); o4[64 * j] = (unsigned)p; } } }
#endif
    }
}
__device__ __forceinline__ void norm_own_tile(Frame& F, bf16* base, int ld, int row0, int col0, const float* gain, float mul) {
    asm volatile("s_waitcnt vmcnt(0)" ::: "memory"); __syncthreads();
    const int lane = F.lane, rsel = lane >> 5, head = (lane >> 4) & 1, sub = lane & 15;
    float gv[8];
#pragma unroll
    for (int i = 0; i < 8; ++i) gv[i] = gain[sub * 8 + i] * mul;
    att::bf16x8 v[16];
#pragma unroll
    for (int q = 0; q < 16; ++q) v[q] = *(const att::bf16x8*)(base + (size_t)(row0 + F.wave * 32 + q * 2 + rsel) * ld + col0 + head * 128 + sub * 8);
#pragma unroll
    for (int q = 0; q < 16; ++q) { float a[8]; unpack8s(v[q], a); float s = 0.f;
#pragma unroll
        for (int i = 0; i < 8; ++i) s += a[i] * a[i];
        s += ROW16_DPP(s, 0xB1); s += ROW16_DPP(s, 0x4E); s += ROW16_DPP(s, 0x124); s += ROW16_DPP(s, 0x128);
        const float rr = 1.f / sqrtf(s * (1.f / 128.f) + RMS_EPS);
#pragma unroll
        for (int i = 0; i < 8; ++i) a[i] *= rr * gv[i];
        *(att::bf16x8*)(base + (size_t)(row0 + F.wave * 32 + q * 2 + rsel) * ld + col0 + head * 128 + sub * 8) = pack8s(a); }
}
__device__ __forceinline__ void fix_own_tile(Frame& F, bf16* proj, int pm, int pn, int kind) {
    const int lane = F.lane;
    if (kind < 2) {
        const int rsel = lane >> 5, head = (lane >> 4) & 1, sub = lane & 15; float gv[8];
#pragma unroll
        for (int i = 0; i < 8; ++i) gv[i] = kind == 0 ? F.in[I_FOXQ_G][sub * 8 + i] * QK_C2 : F.in[I_FOXK_G][sub * 8 + i];
#pragma unroll 1
        for (int r4 = 0; r4 < 16; r4 += 4) { att::bf16x8 v[4]; bf16* p[4];
#pragma unroll
            for (int q = 0; q < 4; ++q) { p[q] = proj + (size_t)(pm * 256 + F.wave * 32 + (r4 + q) * 2 + rsel) * PP + pn * 256 + head * 128 + sub * 8; v[q] = *(const att::bf16x8*)p[q]; }
#pragma unroll
            for (int q = 0; q < 4; ++q) { float a[8]; unpack8s(v[q], a); float s = 0.f;
#pragma unroll
                for (int i = 0; i < 8; ++i) s += a[i] * a[i];
                s += __shfl_xor(s, 1); s += __shfl_xor(s, 2); s += __shfl_xor(s, 4); s += __shfl_xor(s, 8);
                const float rr = 1.f / sqrtf(s * (1.f / 128.f) + RMS_EPS);
#pragma unroll
                for (int i = 0; i < 8; ++i) a[i] *= rr * gv[i];
                *(att::bf16x8*)p[q] = pack8s(a); } }
    } else {
        const int rsel = lane >> 4, head = (lane >> 3) & 1, sub = lane & 7; const float sc = kind == 3 ? 0.08838834764831845f : 1.f; float fr[8];
        const float lgh = __builtin_amdgcn_logf(1.f - __builtin_amdgcn_exp2f(-5.f - (float)((pn & 3) * 2 + head)));
#pragma unroll
        for (int i = 0; i < 8; ++i) fr[i] = __builtin_amdgcn_exp2f(-13.287712379549449f * (float)(sub * 8 + i) * (1.f / 64.f)) * 0.15915494309189535f;
#pragma unroll 1
        for (int r4 = 0; r4 < 8; r4 += 4) { att::bf16x8 va[4], vb[4]; bf16* p[4];
#pragma unroll
            for (int q = 0; q < 4; ++q) { p[q] = proj + (size_t)(pm * 256 + F.wave * 32 + (r4 + q) * 4 + rsel) * PP + pn * 256 + head * 128 + sub * 8; va[q] = *(const att::bf16x8*)p[q]; vb[q] = *(const att::bf16x8*)(p[q] + 64); }
#pragma unroll
            for (int q = 0; q < 4; ++q) { const int rowi = pm * 256 + F.wave * 32 + (r4 + q) * 4 + rsel; const float pos = (float)(rowi & (SEQ - 1)); float a[8], b[8], oa[8], ob[8]; unpack8s(va[q], a); unpack8s(vb[q], b);
                const float dsc = sc * __builtin_amdgcn_exp2f((kind == 2 ? lgh : -lgh) * (float)(rowi & 63));
#pragma unroll
                for (int i = 0; i < 8; ++i) { float rev = pos * fr[i]; rev -= rintf(rev); const float sn = __builtin_amdgcn_sinf(rev), cs = __builtin_amdgcn_cosf(rev);
                    oa[i] = (a[i] * cs - b[i] * sn) * dsc; ob[i] = (a[i] * sn + b[i] * cs) * dsc; }
                *(att::bf16x8*)p[q] = pack8s(oa); *(att::bf16x8*)(p[q] + 64) = pack8s(ob); } }
    }
}
__device__ __forceinline__ void p10_mem_attention(Frame& F) {
    char* lds = (char*)F.ldsg;
    const int b = F.bx >> 5, h = (F.bx >> 3) & 3, qb = F.bx & 7;
    att::BlockRef r0; r0.wave = F.wave;
    const size_t qoff = ((size_t)b * SEQ + (size_t)qb * 256) * 512 + h * 128;
    r0.Q = (const att::bf16*)(F.ws + WS_QM) + qoff; r0.O = (att::bf16*)(F.ws + WS_OMEM) + qoff;
    r0.K = (const att::bf16*)(F.ws + WS_KVM) + (size_t)(b * 256) * 1024 + h * 128; r0.V = r0.K + 512;
    r0.P0 = 1 << 20; r0.skv = 256; r0.lg = 0.f; r0.RG = nullptr; r0.GN = nullptr; r0.O8 = F.ws + WS_OMEM + ((size_t)b * SEQ + (size_t)qb * 256) * 512 + h * 128;
    att::Seam S;
    att::attn_prime<2>(r0, lds, S);
    att::attn_block<2>(r0, r0, lds, S);
}
#define TK_CE(a_, b_) do { const float hi_ = fmaxf((a_), (b_)), lo_ = fminf((a_), (b_)); (a_) = hi_; (b_) = lo_; } while (0)
__device__ __forceinline__ void tk_sort16(float (&v)[16]) {
#pragma unroll
    for (int p = 1; p < 16; p *= 2)
#pragma unroll
        for (int k = p; k >= 1; k /= 2)
#pragma unroll
            for (int j = k % p; j <= 15 - k; j += 2 * k)
#pragma unroll
                for (int i = 0; i < k; ++i) if (i + j + k <= 15 && (i + j) / (2 * p) == (i + j + k) / (2 * p)) TK_CE(v[i + j], v[i + j + k]);
}
__device__ __forceinline__ void tk_merge16(float (&a)[16], const float (&b)[16]) {
#pragma unroll
    for (int i = 0; i < 16; ++i) a[i] = fmaxf(a[i], b[15 - i]);
#pragma unroll
    for (int k = 8; k >= 1; k /= 2)
#pragma unroll
        for (int i = 0; i < 16; ++i) if ((i & k) == 0) TK_CE(a[i], a[i + k]);
}
#define TK_INS(L, v) do { _Pragma("unroll") for (int i_ = 15; i_ >= 1; --i_) L[i_] = __builtin_amdgcn_fmed3f(L[i_ - 1], L[i_], (v)); L[0] = fmaxf(L[0], (v)); } while (0)
__device__ __forceinline__ void p13_topk_unit(Frame& F, int pm, int h) {
    const int lane = F.lane, r32 = lane & 31, hi = lane >> 5, wave = F.wave;
    const att::bf16* qp = (const att::bf16*)(F.ws + WS_QP); const att::bf16* subk = (const att::bf16*)(F.ws + WS_SUBK);
    int* idx_o = (int*)(F.ws + WS_IDX); float* gate_o = (float*)(F.ws + WS_GATE);
    LAS unsigned* kb = (LAS unsigned*)(F.lds + 65536 + (wave * 32 + (lane & 31)) * 32);
    const int tok = pm * 256 + wave * 32 + r32;
    const unsigned q_lane = (unsigned)((tok * DM + hi * 8) * 2), k_lane = (unsigned)((r32 * 128 + hi * 8) * 2);
    att::bf16x8 qf[8];
#define TK_STAGE(p_) do { const int hp_ = h * 2 + (p_); const unsigned char* qb_ = (const unsigned char*)qp + (size_t)hp_ * 256; \
        const unsigned char* kb_ = (const unsigned char*)subk + (size_t)hp_ * 32768 + (size_t)(wave >> 1) * 8192 + (size_t)(wave & 1) * 128; \
        _Pragma("unroll") for (int d0 = 0; d0 < 8; ++d0) qf[d0] = *(const GAS att::bf16x8*)(qb_ + d0 * 32 + q_lane); \
        _Pragma("unroll") for (int f_ = 0; f_ < 4; ++f_) \
            __builtin_amdgcn_global_load_lds((const GAS unsigned*)(kb_ + f_ * 32 + k_lane), (LAS unsigned*)(F.lds + (p_) * 32768 + (wave * 4 + f_) * 1024), 16, 0, 0); } while (0)
    float L0[16], L1[16];
#pragma unroll
    for (int i = 0; i < 16; ++i) { L0[i] = 0.f; L1[i] = 0.f; }
    TK_STAGE(0);
#pragma unroll 1
    for (int p = 0; p < 2; ++p) {
        asm volatile("s_waitcnt vmcnt(0)" ::: "memory"); __syncthreads();
        att::f32x16 acc[4];
        const LAS unsigned char* img = F.lds + p * 32768;
#pragma unroll
        for (int kt = 0; kt < 4; ++kt) { acc[kt] = att::f32x16{};
#pragma unroll
            for (int d0 = 0; d0 < 8; ++d0) acc[kt] = __builtin_amdgcn_mfma_f32_32x32x16_bf16(*(const LAS att::bf16x8*)(img + (kt * 8 + d0) * 1024 + lane * 16), qf[d0], acc[kt], 0, 0, 0); }
        if (p == 0) TK_STAGE(1);
#if TK_NET
        float L[16], M[16];
#pragma unroll
        for (int kt = 0; kt < 4; ++kt) { float (&D)[16] = (kt == 0) ? L : M;
#pragma unroll
            for (int r = 0; r < 16; ++r) { const unsigned key = (unsigned)(kt * 32 + (r & 3) + 8 * (r >> 2)) + 4u * (unsigned)hi;
                D[r] = __uint_as_float((__float_as_uint(acc[kt][r]) & ~0x7Fu) | key); }
            tk_sort16(D); if (kt > 0) tk_merge16(L, M); }
        float P[16];
#pragma unroll
        for (int i = 0; i < 16; ++i) P[i] = __shfl_xor(L[i], 32);
        tk_merge16(L, P);
#else
        float L[16];
#pragma unroll
        for (int i = 0; i < 16; ++i) L[i] = -3.0e38f;
#pragma unroll
        for (int kt = 0; kt < 4; ++kt)
#pragma unroll
            for (int r = 0; r < 16; ++r) { const unsigned key = (unsigned)(kt * 32 + (r & 3) + 8 * (r >> 2)) + 4u * (unsigned)hi;
                const float v = __uint_as_float((__float_as_uint(acc[kt][r]) & ~0x7Fu) | key); TK_INS(L, v); }
        float P[16];
#pragma unroll
        for (int i = 0; i < 16; ++i) P[i] = __shfl_xor(L[i], 32);
#pragma unroll
        for (int i = 0; i < 16; ++i) TK_INS(L, P[i]);
#endif
#pragma unroll
        for (int i = 0; i < 16; ++i) { L0[i] = p == 0 ? L[i] : L0[i]; L1[i] = p == 0 ? L1[i] : L[i]; }
    }
#undef TK_STAGE
#pragma unroll
        for (int w = 0; w < 4; ++w) {
            kb[w] = (__float_as_uint(L0[4 * w]) & 0x7Fu) | ((__float_as_uint(L0[4 * w + 1]) & 0x7Fu) << 8) | ((__float_as_uint(L0[4 * w + 2]) & 0x7Fu) << 16) | ((__float_as_uint(L0[4 * w + 3]) & 0x7Fu) << 24);
            kb[4 + w] = (__float_as_uint(L1[4 * w]) & 0x7Fu) | ((__float_as_uint(L1[4 * w + 1]) & 0x7Fu) << 8) | ((__float_as_uint(L1[4 * w + 2]) & 0x7Fu) << 16) | ((__float_as_uint(L1[4 * w + 3]) & 0x7Fu) << 24); }
        float T[16];
#if TK_NET
        {
            float Y[16]; const float sa0 = __uint_as_float(__float_as_uint(L0[0]) & ~0x7Fu), sb0 = __uint_as_float(__float_as_uint(L1[0]) & ~0x7Fu);
#pragma unroll
            for (int b2 = 0; b2 < 16; ++b2) { const float s = sa0 + __uint_as_float(__float_as_uint(L1[b2]) & ~0x7Fu); T[b2] = __uint_as_float((__float_as_uint(s) & ~0xFFu) | (unsigned)(255 - b2)); }
#pragma unroll
            for (int a = 1; a < 16; ++a) { const float s = __uint_as_float(__float_as_uint(L0[a]) & ~0x7Fu) + sb0; Y[a - 1] = __uint_as_float((__float_as_uint(s) & ~0xFFu) | (unsigned)(255 - a * 16)); }
            Y[15] = -3.0e38f;
            tk_merge16(T, Y);
#pragma unroll
            for (int a = 1; a < 8; ++a) { const float sa = __uint_as_float(__float_as_uint(L0[a]) & ~0x7Fu);
#pragma unroll
                for (int b2 = 1; b2 < 8; ++b2) if ((a + 1) * (b2 + 1) <= 16) { const float s = sa + __uint_as_float(__float_as_uint(L1[b2]) & ~0x7Fu);
                    const float v = __uint_as_float((__float_as_uint(s) & ~0xFFu) | (unsigned)(255 - (a * 16 + b2))); TK_INS(T, v); } }
        }
#else
#pragma unroll
        for (int i = 0; i < 16; ++i) T[i] = -3.0e38f;
#pragma unroll
        for (int a = 0; a < 16; ++a) { const float sa = __uint_as_float(__float_as_uint(L0[a]) & ~0x7Fu);
#pragma unroll
            for (int b2 = 0; b2 < 16; ++b2) if ((a + 1) * (b2 + 1) <= 16) { const float s = sa + __uint_as_float(__float_as_uint(L1[b2]) & ~0x7Fu);
                const float v = __uint_as_float((__float_as_uint(s) & ~0xFFu) | (unsigned)(a * 16 + b2)); TK_INS(T, v); } }
#endif
        LDS_WAIT();
        const LAS unsigned char* kbb = (const LAS unsigned char*)kb;
        float sc[16]; int ei[16]; float mx = __uint_as_float(__float_as_uint(T[0]) & ~0xFFu), sum = 0.f;
#pragma unroll
        for (int k = 0; k < 16; ++k) { const unsigned bits = __float_as_uint(T[k]); const unsigned id = TK_NET ? 255u - (bits & 0xFFu) : (bits & 0xFFu);
            const int i1 = kbb[id >> 4], i2 = kbb[16 + (id & 15u)]; ei[k] = i1 * 128 + i2;
            sc[k] = __builtin_amdgcn_exp2f((__uint_as_float(bits & ~0xFFu) - mx) * 1.4426950408889634f); sum += sc[k]; }
        const float inv = 1.f / sum;
        if (hi == 0) {
#pragma unroll
            for (int w = 0; w < 4; ++w) {
                *(GAS v4u*)(idx_o + (size_t)tok * 128 + h * 16 + 4 * w) = (v4u){(unsigned)ei[4 * w], (unsigned)ei[4 * w + 1], (unsigned)ei[4 * w + 2], (unsigned)ei[4 * w + 3]};
                *(GAS f32x4*)(gate_o + (size_t)tok * 128 + h * 16 + 4 * w) = (f32x4){sc[4 * w] * inv, sc[4 * w + 1] * inv, sc[4 * w + 2] * inv, sc[4 * w + 3] * inv}; } }
        LDS_WAIT(); asm volatile("" ::: "memory");
}


typedef float f32x2 __attribute__((ext_vector_type(2)));
__device__ __forceinline__ float gelu_tanh(float x) {
    const float y = 0.7978845608028654f * (x + 0.044715f * x * x * x);
    const float t = 1.f - 2.f * __builtin_amdgcn_rcpf(1.f + __builtin_amdgcn_exp2f(2.885390081777927f * y));
    return 0.5f * x * (1.f + t);
}
__device__ __forceinline__ float dot2bf(unsigned a, unsigned b, float acc) { asm("v_dot2c_f32_bf16 %0, %1, %2" : "+v"(acc) : "v"(a), "v"(b)); return acc; }
#ifndef EX_QCH
#define EX_QCH 2
#endif
#ifdef EX_GATHER_NT
#define EX_GLD(p) __builtin_nontemporal_load(p)
#else
#define EX_GLD(p) (*(p))
#endif
#ifndef EX_TOK8
#define EX_TOK8 1
#endif
struct RowBuf { v4u r[8]; float su, sv; };
#define DPP_MOV(v, ctrl) __builtin_bit_cast(float, __builtin_amdgcn_update_dpp(0, __builtin_bit_cast(int, (v)), (ctrl), 0xF, 0xF, false))
#define ROW_ROR(v, n) __builtin_bit_cast(float, __builtin_amdgcn_update_dpp(0, __builtin_bit_cast(int, (v)), 0x120 + (n), 0xF, 0xF, false))
__device__ __forceinline__ void p14_experts_sorted(Frame& F) {
    const int lane = F.lane, wave = F.wave, q = lane >> 4, l16 = lane & 15;
    const bf16* xb = (const bf16*)(F.ws + WS_XB2); const unsigned char* pu = F.ws + WS_PU; const unsigned char* pv = F.ws + WS_PV;
    const int* idx = (const int*)(F.ws + WS_IDX); const float* gate = (const float*)(F.ws + WS_GATE); const float* rowss = (const float*)(F.ws + WS_ROWSS2);
    const float* su = (const float*)(F.ws + WS_PSCALE); const float* sv = su + 16384;
    LAS unsigned* list = (LAS unsigned*)(F.lds + wave * 8192) + q * 128;
    LAS float* wl = (LAS float*)(F.lds + wave * 8192 + 2048) + q * 128;
    LAS float* gt = (LAS float*)(F.lds + wave * 8192 + 4096) + q * 128;
    LAS unsigned* cnt = (LAS unsigned*)(F.lds + wave * 8192 + 6144) + q * 64;
    constexpr int NSTEP = 128;
    for (int grp = 0; grp < 2; ++grp) {
        const int tok = (F.bx * NWAVES + wave) * 8 + grp * 4 + q;
        const float rs = 1.f / sqrtf(rowss[tok] * (1.f / DM) + RMS_EPS);
#pragma unroll
        for (int i = 0; i < 4; ++i) cnt[l16 + 16 * i] = 0u;
        unsigned ent[8], pos[8];
#pragma unroll
        for (int j = 0; j < 8; ++j) { const int k = l16 + 16 * j; const unsigned e = (unsigned)idx[(size_t)tok * 128 + k]; gt[k] = gate[(size_t)tok * 128 + k]; ent[j] = e | ((unsigned)k << 16); }
        LDS_WAIT(); asm volatile("" ::: "memory");
#pragma unroll
        for (int j = 0; j < 8; ++j) pos[j] = __hip_atomic_fetch_add(cnt + ((ent[j] & 0x3FFFu) >> 8), 1u, __ATOMIC_RELAXED, __HIP_MEMORY_SCOPE_WORKGROUP);
        LDS_WAIT(); asm volatile("" ::: "memory");
        { unsigned c[4], inc[4], run = 0u;
#pragma unroll
          for (int i = 0; i < 4; ++i) { c[i] = cnt[l16 + 16 * i]; inc[i] = c[i];
#pragma unroll
              for (int o = 1; o < 16; o <<= 1) { const unsigned tt = __shfl_up(inc[i], o, 16); if (l16 >= o) inc[i] += tt; } }
          LDS_WAIT(); asm volatile("" ::: "memory");
#pragma unroll
          for (int i = 0; i < 4; ++i) { cnt[l16 + 16 * i] = run + inc[i] - c[i]; run += __shfl(inc[i], 15, 16); } }
        LDS_WAIT(); asm volatile("" ::: "memory");
#pragma unroll
        for (int j = 0; j < 8; ++j) list[cnt[(ent[j] & 0x3FFFu) >> 8] + pos[j]] = ent[j];
        LDS_WAIT(); asm volatile("" ::: "memory");
        const unsigned lane_off = (unsigned)l16 * 16u;
        constexpr int QCH = EX_QCH, NSW = 8 / QCH;
#define EX_LD(B, s_, TABQ) do { const int ss_ = (s_) < NSTEP ? (s_) : NSTEP - 1; const unsigned off_ = ((list[ss_] & 0x3FFFu) << 11) + lane_off;     \
            _Pragma("unroll") for (int c_ = 0; c_ < QCH; ++c_) B[c_] = *(const GAS v4u*)((TABQ) + off_ + c_ * 256); } while (0)
#ifndef EX_RINGK
#define EX_RINGK 8
#endif
#ifndef EX_UCHAIN
#define EX_UCHAIN 1
#endif
#ifndef EX_CONT
#define EX_CONT 1
#endif
#define EX_SLICE_STEP (EX_W512 ? (size_t)16384 * 384 : EX_FP6 ? (size_t)16384 * 192 : EX_SLICEMAJOR ? (size_t)16384 * 256 : (size_t)256)
#if EX_RINGK == 4
#define EX_RING(TABQ, STEPFN, ENDFN) do { v4u H0[QCH], H1[QCH], H2[QCH], H3[QCH]; \
            EX_LD(H0, 0, TABQ); EX_LD(H1, 1, TABQ); EX_LD(H2, 2, TABQ); \
            _Pragma("unroll 1") for (int s = 0; s < NSTEP; s += 8) { \
                EX_LD(H3, s + 3, TABQ); STEPFN(H0, s + 0, 0); \
                EX_LD(H0, s + 4, TABQ); STEPFN(H1, s + 1, 1); \
                EX_LD(H1, s + 5, TABQ); STEPFN(H2, s + 2, 2); \
                EX_LD(H2, s + 6, TABQ); STEPFN(H3, s + 3, 3); \
                EX_LD(H3, s + 7, TABQ); STEPFN(H0, s + 4, 4); \
                EX_LD(H0, s + 8, TABQ); STEPFN(H1, s + 5, 5); \
                EX_LD(H1, s + 9, TABQ); STEPFN(H2, s + 6, 6); \
                EX_LD(H2, s + 10, TABQ); STEPFN(H3, s + 7, 7); \
                ENDFN(s); } } while (0)
#elif EX_RINGK == 2
#define EX_RING(TABQ, STEPFN, ENDFN) do { v4u H0[QCH], H1[QCH]; \
            EX_LD(H0, 0, TABQ); \
            _Pragma("unroll 1") for (int s = 0; s < NSTEP; s += 8) { \
                EX_LD(H1, s + 1, TABQ); STEPFN(H0, s + 0, 0); \
                EX_LD(H0, s + 2, TABQ); STEPFN(H1, s + 1, 1); \
                EX_LD(H1, s + 3, TABQ); STEPFN(H0, s + 2, 2); \
                EX_LD(H0, s + 4, TABQ); STEPFN(H1, s + 3, 3); \
                EX_LD(H1, s + 5, TABQ); STEPFN(H0, s + 4, 4); \
                EX_LD(H0, s + 6, TABQ); STEPFN(H1, s + 5, 5); \
                EX_LD(H1, s + 7, TABQ); STEPFN(H0, s + 6, 6); \
                EX_LD(H0, s + 8, TABQ); STEPFN(H1, s + 7, 7); \
                ENDFN(s); } } while (0)
#else
#define EX_RING(TABQ, STEPFN, ENDFN) do { v4u H0[QCH], H1[QCH], H2[QCH], H3[QCH], H4[QCH], H5[QCH], H6[QCH], H7[QCH]; \
            EX_LD(H0, 0, TABQ); EX_LD(H1, 1, TABQ); EX_LD(H2, 2, TABQ); EX_LD(H3, 3, TABQ); EX_LD(H4, 4, TABQ); EX_LD(H5, 5, TABQ); EX_LD(H6, 6, TABQ); \
            _Pragma("unroll 1") for (int s = 0; s < NSTEP; s += 8) { \
                EX_LD(H7, s + 7, TABQ); STEPFN(H0, s + 0, 0); \
                EX_LD(H0, s + 8, TABQ); STEPFN(H1, s + 1, 1); \
                EX_LD(H1, s + 9, TABQ); STEPFN(H2, s + 2, 2); \
                EX_LD(H2, s + 10, TABQ); STEPFN(H3, s + 3, 3); \
                EX_LD(H3, s + 11, TABQ); STEPFN(H4, s + 4, 4); \
                EX_LD(H4, s + 12, TABQ); STEPFN(H5, s + 5, 5); \
                EX_LD(H5, s + 13, TABQ); STEPFN(H6, s + 6, 6); \
                EX_LD(H6, s + 14, TABQ); STEPFN(H7, s + 7, 7); \
                ENDFN(s); } } while (0)
#endif
#pragma unroll 1
        for (int j = 0; j < NSW; ++j) {
            f32x2 xf[QCH][8];
#pragma unroll
            for (int c = 0; c < QCH; ++c) { const v4u a = *(const GAS v4u*)(xb + (size_t)tok * DM + j * (QCH * 256) + c * 256 + l16 * 16), b = *(const GAS v4u*)(xb + (size_t)tok * DM + j * (QCH * 256) + c * 256 + l16 * 16 + 8);
                const unsigned xd[8] = {a.x, a.y, a.z, a.w, b.x, b.y, b.z, b.w};
#pragma unroll
                for (int i = 0; i < 8; ++i) xf[c][i] = (f32x2){__uint_as_float(xd[i] << 16), __uint_as_float(xd[i] & 0xffff0000u)}; }
            const unsigned char* tabq = pu + j * (QCH * 256);
#if EX_UCHAIN == 2
#define EX_U(B, s_, k_) do { f32x2 d2_[QCH]; \
            _Pragma("unroll") for (int c_ = 0; c_ < QCH; ++c_) { const unsigned ud[4] = {B[c_].x, B[c_].y, B[c_].z, B[c_].w}; d2_[c_] = __builtin_amdgcn_cvt_pk_f32_fp8((int)ud[0], false) * xf[c_][0]; \
                d2_[c_] = __builtin_amdgcn_cvt_pk_f32_fp8((int)ud[0], true) * xf[c_][1] + d2_[c_]; \
                _Pragma("unroll") for (int w_ = 1; w_ < 4; ++w_) { d2_[c_] = __builtin_amdgcn_cvt_pk_f32_fp8((int)ud[w_], false) * xf[c_][2 * w_] + d2_[c_]; d2_[c_] = __builtin_amdgcn_cvt_pk_f32_fp8((int)ud[w_], true) * xf[c_][2 * w_ + 1] + d2_[c_]; } } \
            f32x2 dsum_ = d2_[0]; _Pragma("unroll") for (int c_ = 1; c_ < QCH; ++c_) dsum_ += d2_[c_]; \
            dd[k_] = dsum_.x + dsum_.y; } while (0)
#else
#define EX_U(B, s_, k_) do { f32x2 d2_ = {0.f, 0.f}; \
            _Pragma("unroll") for (int c_ = 0; c_ < QCH; ++c_) { const unsigned ud[4] = {B[c_].x, B[c_].y, B[c_].z, B[c_].w}; \
                _Pragma("unroll") for (int w_ = 0; w_ < 4; ++w_) { d2_ = __builtin_amdgcn_cvt_pk_f32_fp8((int)ud[w_], false) * xf[c_][2 * w_] + d2_; d2_ = __builtin_amdgcn_cvt_pk_f32_fp8((int)ud[w_], true) * xf[c_][2 * w_ + 1] + d2_; } } \
            dd[k_] = d2_.x + d2_.y; } while (0)
#endif
#define EX_UEND(s_) do { float r4_[4], r2_[2], r1_; \
            { const bool up = (l16 & 8) != 0; _Pragma("unroll") for (int i_ = 0; i_ < 4; ++i_) { const float mine = up ? dd[i_ + 4] : dd[i_], theirs = up ? dd[i_] : dd[i_ + 4]; r4_[i_] = mine + ROW_ROR(theirs, 8); } } \
            { const bool up = (l16 & 4) != 0; _Pragma("unroll") for (int i_ = 0; i_ < 2; ++i_) { const float mine = up ? r4_[i_ + 2] : r4_[i_], theirs = up ? r4_[i_] : r4_[i_ + 2]; \
                const float fromhi = DPP_MOV(theirs, 0x104), fromlo = DPP_MOV(theirs, 0x114); r2_[i_] = mine + (up ? fromlo : fromhi); } }     \
            { const bool up = (l16 & 2) != 0; const float mine = up ? r2_[1] : r2_[0], theirs = up ? r2_[0] : r2_[1]; r1_ = mine + DPP_MOV(theirs, 0x4E); }     \
            r1_ += DPP_MOV(r1_, 0xB1);                                                                                                                  \
            if ((l16 & 1) == 0) { const int si_ = (s_) + (l16 >> 1); wl[si_] = (j == 0 ? 0.f : wl[si_]) + r1_; } } while (0)
            float dd[8];
            EX_RING(tabq, EX_U, EX_UEND);
#undef EX_U
#undef EX_UEND
            LDS_WAIT(); asm volatile("" ::: "memory");
        }
#pragma unroll
        for (int i = 0; i < 8; ++i) { const int s = l16 + 16 * i; const unsigned me = list[s]; const unsigned e = me & 0x3FFFu;
            wl[s] = gt[(me >> 16) & 127u] * gelu_tanh(wl[s] * su[e] * rs) * sv[e]; }
        LDS_WAIT(); asm volatile("" ::: "memory");
#pragma unroll 1
        for (int j = 0; j < NSW; ++j) {
            f32x2 acc[QCH][8];
#pragma unroll
            for (int c = 0; c < QCH; ++c)
#pragma unroll
                for (int e = 0; e < 8; ++e) acc[c][e] = (f32x2){0.f, 0.f};
            const unsigned char* tabq = pv + j * (QCH * 256);
#define EX_NOEND(s_) do { } while (0)
#define EX_V(B, s_, k_) do { const float w_ = wl[s_]; const f32x2 w2 = {w_, w_}; \
            _Pragma("unroll") for (int c_ = 0; c_ < QCH; ++c_) { const unsigned ud[4] = {B[c_].x, B[c_].y, B[c_].z, B[c_].w}; \
                _Pragma("unroll") for (int w4_ = 0; w4_ < 4; ++w4_) { acc[c_][2 * w4_] = __builtin_amdgcn_cvt_pk_f32_fp8((int)ud[w4_], false) * w2 + acc[c_][2 * w4_]; acc[c_][2 * w4_ + 1] = __builtin_amdgcn_cvt_pk_f32_fp8((int)ud[w4_], true) * w2 + acc[c_][2 * w4_ + 1]; } } } while (0)
            EX_RING(tabq, EX_V, EX_NOEND);
#undef EX_V
#undef EX_NOEND
            float* orow = F.out + (size_t)tok * DM + j * (QCH * 256) + l16 * 16; const bf16* xrow = xb + (size_t)tok * DM + j * (QCH * 256) + l16 * 16;
#pragma unroll
            for (int c = 0; c < QCH; ++c) { const v4u x0 = *(const GAS v4u*)(xrow + c * 256), x1 = *(const GAS v4u*)(xrow + c * 256 + 8); const unsigned xd[8] = {x0.x, x0.y, x0.z, x0.w, x1.x, x1.y, x1.z, x1.w};
#pragma unroll
                for (int qq = 0; qq < 4; ++qq)
                    *(GAS f32x4*)(orow + c * 256 + 4 * qq) = (f32x4){__uint_as_float(xd[2 * qq] << 16) + acc[c][2 * qq].x, __uint_as_float(xd[2 * qq] & 0xffff0000u) + acc[c][2 * qq].y,
                                                                    __uint_as_float(xd[2 * qq + 1] << 16) + acc[c][2 * qq + 1].x, __uint_as_float(xd[2 * qq + 1] & 0xffff0000u) + acc[c][2 * qq + 1].y}; }
        }
#undef EX_LD
#undef EX_RING
        LDS_WAIT(); asm volatile("" ::: "memory");
    }
}

__device__ __forceinline__ void p14_experts_8(Frame& F) {
    const int lane = F.lane, wave = F.wave, q = lane >> 3, l16 = lane & 7;
    const bf16* xb = (const bf16*)(F.ws + WS_XB2); const unsigned char* pu = F.ws + WS_PU; const unsigned char* pv = F.ws + WS_PV;
    const int* idx = (const int*)(F.ws + WS_IDX); const float* gate = (const float*)(F.ws + WS_GATE); const float* rowss = (const float*)(F.ws + WS_ROWSS2);
    const float* su = (const float*)(F.ws + WS_PSCALE); const float* sv = su + 16384;
    LAS unsigned* list = (LAS unsigned*)(F.lds + wave * 14336) + q * 128;
    LAS float* wl = (LAS float*)(F.lds + wave * 14336 + 4096) + q * 128;
    LAS float* gt = (LAS float*)(F.lds + wave * 14336 + 8192) + q * 128;
    LAS unsigned* cnt = (LAS unsigned*)(F.lds + wave * 14336 + 12288) + q * 64;
    constexpr int NSTEP = 128;
    {
        const int tok = (F.bx * NWAVES + wave) * 8 + q;
        const float rs = 1.f / sqrtf(rowss[tok] * (1.f / DM) + RMS_EPS);
#pragma unroll
        for (int i = 0; i < 8; ++i) cnt[l16 + 8 * i] = 0u;
        unsigned ent[16], pos[16];
#pragma unroll
        for (int j = 0; j < 16; ++j) { const int k = l16 + 8 * j; ent[j] = (unsigned)((const GAS int*)idx)[(size_t)tok * 128 + k]; pos[j] = __float_as_uint(((const GAS float*)gate)[(size_t)tok * 128 + k]); }
#pragma unroll
        for (int j = 0; j < 16; ++j) { const int k = l16 + 8 * j; gt[k] = __uint_as_float(pos[j]); ent[j] |= (unsigned)k << 16; }
        LDS_WAIT(); asm volatile("" ::: "memory");
#pragma unroll
        for (int j = 0; j < 16; ++j) pos[j] = __hip_atomic_fetch_add(cnt + ((ent[j] & 0x3FFFu) >> 8), 1u, __ATOMIC_RELAXED, __HIP_MEMORY_SCOPE_WORKGROUP);
        LDS_WAIT(); asm volatile("" ::: "memory");
        { unsigned c[8], inc[8], run = 0u;
#pragma unroll
          for (int i = 0; i < 8; ++i) { c[i] = cnt[l16 + 8 * i]; inc[i] = c[i];
              { const unsigned t1 = (unsigned)__builtin_amdgcn_update_dpp(0, (int)inc[i], 0x111, 0xF, 0xF, false); if (l16 >= 1) inc[i] += t1;
                const unsigned t2 = (unsigned)__builtin_amdgcn_update_dpp(0, (int)inc[i], 0x112, 0xF, 0xF, false); if (l16 >= 2) inc[i] += t2;
                const unsigned t4 = (unsigned)__builtin_amdgcn_update_dpp(0, (int)inc[i], 0x114, 0xF, 0xF, false); if (l16 >= 4) inc[i] += t4; } }
          LDS_WAIT(); asm volatile("" ::: "memory");
#pragma unroll
          for (int i = 0; i < 8; ++i) { cnt[l16 + 8 * i] = run + inc[i] - c[i]; run += __shfl(inc[i], 7, 8); } }
        LDS_WAIT(); asm volatile("" ::: "memory");
#pragma unroll
        for (int j = 0; j < 16; ++j) list[cnt[(ent[j] & 0x3FFFu) >> 8] + pos[j]] = ent[j];
        LDS_WAIT(); asm volatile("" ::: "memory");
        const unsigned lane_off = (unsigned)l16 * (EX_W512 ? 48u : EX_FP6 ? 24u : 16u);
        constexpr int QCH = EX_QCH, NSW = EX_W512 ? 4 : 16 / QCH, HB = EX_W512 ? 3 : QCH;
#if EX_CONT
#if EX_W512
#define EX_LD(B, s_, TABQ) do { const int s2_ = (s_); const bool nx_ = s2_ >= NSTEP; const int ss_ = nx_ ? s2_ - NSTEP : s2_; const unsigned e_ = list[ss_] & 0x3FFFu; const unsigned off_ = (((e_ << 1) + e_) << 7) + lane_off;     \
            const unsigned char* tb_ = nx_ ? nxtq : (TABQ); \
            B[0] = *(const GAS v4u*)(tb_ + off_); B[1] = *(const GAS v4u*)(tb_ + off_ + 16); B[2] = *(const GAS v4u*)(tb_ + off_ + 32); } while (0)
#elif EX_FP6
#define EX_LD(B, s_, TABQ) do { const int s2_ = (s_); const bool nx_ = s2_ >= NSTEP; const int ss_ = nx_ ? s2_ - NSTEP : s2_; const unsigned off_ = (list[ss_] & 0x3FFFu) * 192u + lane_off; \
            const unsigned char* tb_ = nx_ ? nxtq : (TABQ); \
            B[0] = *(const GAS v4u*)(tb_ + off_); { const u32x2m h_ = *(const GAS u32x2m*)(tb_ + off_ + 16); B[1].x = h_.x; B[1].y = h_.y; } } while (0)
#else
#define EX_LD(B, s_, TABQ) do { const int s2_ = (s_); const bool nx_ = s2_ >= NSTEP; const int ss_ = nx_ ? s2_ - NSTEP : s2_; const unsigned off_ = ((list[ss_] & 0x3FFFu) << (EX_SLICEMAJOR ? 8 : 11)) + lane_off; \
            const unsigned char* tb_ = nx_ ? nxtq : (TABQ); \
            _Pragma("unroll") for (int c_ = 0; c_ < QCH; ++c_) B[c_] = EX_GLD((const GAS v4u*)(tb_ + off_ + c_ * 128)); } while (0)
#endif
#else
#define EX_LD(B, s_, TABQ) do { const int ss_ = (s_) < NSTEP ? (s_) : NSTEP - 1; const unsigned off_ = ((list[ss_] & 0x3FFFu) << 11) + lane_off;     \
            _Pragma("unroll") for (int c_ = 0; c_ < QCH; ++c_) B[c_] = EX_GLD((const GAS v4u*)((TABQ) + off_ + c_ * 128)); } while (0)
#endif
#ifndef EX_RINGK
#define EX_RINGK 8
#endif
#if EX_RINGK == 4
#define EX_RING(TABQ, STEPFN, ENDFN) do { v4u H0[QCH], H1[QCH], H2[QCH], H3[QCH]; \
            EX_LD(H0, 0, TABQ); EX_LD(H1, 1, TABQ); EX_LD(H2, 2, TABQ); \
            _Pragma("unroll 1") for (int s = 0; s < NSTEP; s += 8) { \
                EX_LD(H3, s + 3, TABQ); STEPFN(H0, s + 0, 0); \
                EX_LD(H0, s + 4, TABQ); STEPFN(H1, s + 1, 1); \
                EX_LD(H1, s + 5, TABQ); STEPFN(H2, s + 2, 2); \
                EX_LD(H2, s + 6, TABQ); STEPFN(H3, s + 3, 3); \
                EX_LD(H3, s + 7, TABQ); STEPFN(H0, s + 4, 4); \
                EX_LD(H0, s + 8, TABQ); STEPFN(H1, s + 5, 5); \
                EX_LD(H1, s + 9, TABQ); STEPFN(H2, s + 6, 6); \
                EX_LD(H2, s + 10, TABQ); STEPFN(H3, s + 7, 7); \
                ENDFN(s); } } while (0)
#elif EX_RINGK == 2
#define EX_RING(TABQ, STEPFN, ENDFN) do { v4u H0[QCH], H1[QCH]; \
            EX_LD(H0, 0, TABQ); \
            _Pragma("unroll 1") for (int s = 0; s < NSTEP; s += 8) { \
                EX_LD(H1, s + 1, TABQ); STEPFN(H0, s + 0, 0); \
                EX_LD(H0, s + 2, TABQ); STEPFN(H1, s + 1, 1); \
                EX_LD(H1, s + 3, TABQ); STEPFN(H0, s + 2, 2); \
                EX_LD(H0, s + 4, TABQ); STEPFN(H1, s + 3, 3); \
                EX_LD(H1, s + 5, TABQ); STEPFN(H0, s + 4, 4); \
                EX_LD(H0, s + 6, TABQ); STEPFN(H1, s + 5, 5); \
                EX_LD(H1, s + 7, TABQ); STEPFN(H0, s + 6, 6); \
                EX_LD(H0, s + 8, TABQ); STEPFN(H1, s + 7, 7); \
                ENDFN(s); } } while (0)
#else
#if EX_CONT && EX_W512 && EX_PFLIST
#define EX_LDE(B, ent_, tb_) do { const unsigned e_ = (ent_) & 0x3FFFu; const unsigned off_ = (((e_ << 1) + e_) << 7) + lane_off; \
            B[0] = *(const GAS v4u*)((tb_) + off_); B[1] = *(const GAS v4u*)((tb_) + off_ + 16); B[2] = *(const GAS v4u*)((tb_) + off_ + 32); } while (0)
#define EX_RING(TABQ, STEPFN, ENDFN) do { \
            if (!primed) { EX_LD(H0, 0, TABQ); EX_LD(H1, 1, TABQ); EX_LD(H2, 2, TABQ); EX_LD(H3, 3, TABQ); EX_LD(H4, 4, TABQ); EX_LD(H5, 5, TABQ); EX_LD(H6, 6, TABQ); EX_LD(H7, 7, TABQ); primed = true; } \
            _Pragma("unroll 1") for (int s = 0; s < NSTEP; s += 8) { \
                const bool nxg_ = s + 8 >= NSTEP; const unsigned char* tbn_ = nxg_ ? nxtq : (TABQ); const int sb_ = nxg_ ? 0 : s + 8; \
                const v4u ea_ = *(const LAS v4u*)(list + sb_), eb_ = *(const LAS v4u*)(list + sb_ + 4); \
                STEPFN(H0, s + 0, 0); EX_LDE(H0, ea_.x, tbn_); \
                STEPFN(H1, s + 1, 1); EX_LDE(H1, ea_.y, tbn_); \
                STEPFN(H2, s + 2, 2); EX_LDE(H2, ea_.z, tbn_); \
                STEPFN(H3, s + 3, 3); EX_LDE(H3, ea_.w, tbn_); \
                STEPFN(H4, s + 4, 4); EX_LDE(H4, eb_.x, tbn_); \
                STEPFN(H5, s + 5, 5); EX_LDE(H5, eb_.y, tbn_); \
                STEPFN(H6, s + 6, 6); EX_LDE(H6, eb_.z, tbn_); \
                STEPFN(H7, s + 7, 7); EX_LDE(H7, eb_.w, tbn_); \
                ENDFN(s); } } while (0)
#elif EX_CONT
#define EX_RING(TABQ, STEPFN, ENDFN) do { \
            if (!primed) { EX_LD(H0, 0, TABQ); EX_LD(H1, 1, TABQ); EX_LD(H2, 2, TABQ); EX_LD(H3, 3, TABQ); EX_LD(H4, 4, TABQ); EX_LD(H5, 5, TABQ); EX_LD(H6, 6, TABQ); primed = true; } \
            _Pragma("unroll 1") for (int s = 0; s < NSTEP; s += 8) { \
                EX_LD(H7, s + 7, TABQ); STEPFN(H0, s + 0, 0); \
                EX_LD(H0, s + 8, TABQ); STEPFN(H1, s + 1, 1); \
                EX_LD(H1, s + 9, TABQ); STEPFN(H2, s + 2, 2); \
                EX_LD(H2, s + 10, TABQ); STEPFN(H3, s + 3, 3); \
                EX_LD(H3, s + 11, TABQ); STEPFN(H4, s + 4, 4); \
                EX_LD(H4, s + 12, TABQ); STEPFN(H5, s + 5, 5); \
                EX_LD(H5, s + 13, TABQ); STEPFN(H6, s + 6, 6); \
                EX_LD(H6, s + 14, TABQ); STEPFN(H7, s + 7, 7); \
                ENDFN(s); } } while (0)
#else
#define EX_RING(TABQ, STEPFN, ENDFN) do { v4u H0[QCH], H1[QCH], H2[QCH], H3[QCH], H4[QCH], H5[QCH], H6[QCH], H7[QCH]; \
            EX_LD(H0, 0, TABQ); EX_LD(H1, 1, TABQ); EX_LD(H2, 2, TABQ); EX_LD(H3, 3, TABQ); EX_LD(H4, 4, TABQ); EX_LD(H5, 5, TABQ); EX_LD(H6, 6, TABQ); \
            _Pragma("unroll 1") for (int s = 0; s < NSTEP; s += 8) { \
                EX_LD(H7, s + 7, TABQ); STEPFN(H0, s + 0, 0); \
                EX_LD(H0, s + 8, TABQ); STEPFN(H1, s + 1, 1); \
                EX_LD(H1, s + 9, TABQ); STEPFN(H2, s + 2, 2); \
                EX_LD(H2, s + 10, TABQ); STEPFN(H3, s + 3, 3); \
                EX_LD(H3, s + 11, TABQ); STEPFN(H4, s + 4, 4); \
                EX_LD(H4, s + 12, TABQ); STEPFN(H5, s + 5, 5); \
                EX_LD(H5, s + 13, TABQ); STEPFN(H6, s + 6, 6); \
                EX_LD(H6, s + 14, TABQ); STEPFN(H7, s + 7, 7); \
                ENDFN(s); } } while (0)
#endif
#endif
#if EX_CONT
        v4u H0[HB], H1[HB], H2[HB], H3[HB], H4[HB], H5[HB], H6[HB], H7[HB]; bool primed = false; const unsigned char* nxtq;
#endif
#pragma unroll 1
        for (int j = 0; j < NSW; ++j) {
#if EX_W512
            f32x2 xfg[2][16];
#pragma unroll
            for (int jj = 0; jj < 8; ++jj) { const v4u xw = *(const GAS v4u*)(xb + (size_t)tok * DM + 64 * j + 8 * l16 + 256 * jj);
                xfg[0][2 * jj] = (f32x2){__uint_as_float(xw.x << 16), __uint_as_float(xw.x & 0xffff0000u)}; xfg[0][2 * jj + 1] = (f32x2){__uint_as_float(xw.y << 16), __uint_as_float(xw.y & 0xffff0000u)};
                xfg[1][2 * jj] = (f32x2){__uint_as_float(xw.z << 16), __uint_as_float(xw.z & 0xffff0000u)}; xfg[1][2 * jj + 1] = (f32x2){__uint_as_float(xw.w << 16), __uint_as_float(xw.w & 0xffff0000u)}; }
#elif EX_FP6
            f32x2 xf6[16];
#pragma unroll
            for (int jj = 0; jj < 8; ++jj) { const u32x2m xw = *(const GAS u32x2m*)(xb + (size_t)tok * DM + 32 * j + 4 * l16 + 256 * jj);
                xf6[2 * jj] = (f32x2){__uint_as_float(xw.x << 16), __uint_as_float(xw.x & 0xffff0000u)}; xf6[2 * jj + 1] = (f32x2){__uint_as_float(xw.y << 16), __uint_as_float(xw.y & 0xffff0000u)}; }
#else
            f32x2 xf[QCH][8];
#pragma unroll
            for (int c = 0; c < QCH; ++c) { const v4u a = *(const GAS v4u*)(xb + (size_t)tok * DM + j * (QCH * 128) + c * 128 + l16 * 16), b = *(const GAS v4u*)(xb + (size_t)tok * DM + j * (QCH * 128) + c * 128 + l16 * 16 + 8);
                const unsigned xd[8] = {a.x, a.y, a.z, a.w, b.x, b.y, b.z, b.w};
#pragma unroll
                for (int i = 0; i < 8; ++i) xf[c][i] = (f32x2){__uint_as_float(xd[i] << 16), __uint_as_float(xd[i] & 0xffff0000u)}; }
#endif
            const unsigned char* tabq = pu + (size_t)j * EX_SLICE_STEP;
#if EX_CONT
            nxtq = (j + 1 < NSW) ? pu + (size_t)(j + 1) * EX_SLICE_STEP : pv;
#endif
#if EX_W512
#define EX_U(B, s_, k_) do { f32x2 d2_, d3_;     \
            { const v6u_t s6_ = {B[0].x, B[0].y, B[0].z, B[0].w, B[1].x, B[1].y}; const v32f_t c_ = __builtin_amdgcn_cvt_scalef32_pk32_f32_fp6(s6_, 1.0f); \
              d2_ = (f32x2){c_[0], c_[1]} * xfg[0][0]; d3_ = (f32x2){c_[2], c_[3]} * xfg[0][1]; \
              _Pragma("unroll") for (int p_ = 2; p_ < 16; p_ += 2) { d2_ = (f32x2){c_[2 * p_], c_[2 * p_ + 1]} * xfg[0][p_] + d2_; d3_ = (f32x2){c_[2 * p_ + 2], c_[2 * p_ + 3]} * xfg[0][p_ + 1] + d3_; } } \
            { const v6u_t s6_ = {B[1].z, B[1].w, B[2].x, B[2].y, B[2].z, B[2].w}; const v32f_t c_ = __builtin_amdgcn_cvt_scalef32_pk32_f32_fp6(s6_, 1.0f); \
              _Pragma("unroll") for (int p_ = 0; p_ < 16; p_ += 2) { d2_ = (f32x2){c_[2 * p_], c_[2 * p_ + 1]} * xfg[1][p_] + d2_; d3_ = (f32x2){c_[2 * p_ + 2], c_[2 * p_ + 3]} * xfg[1][p_ + 1] + d3_; } } \
            d2_ += d3_; dd[k_] = d2_.x + d2_.y; } while (0)
#elif EX_FP6
#define EX_U(B, s_, k_) do { f32x2 d2_ = {0.f, 0.f}; const v6u_t s6_ = {B[0].x, B[0].y, B[0].z, B[0].w, B[1].x, B[1].y}; const v32f_t c_ = __builtin_amdgcn_cvt_scalef32_pk32_f32_fp6(s6_, 1.0f); \
            _Pragma("unroll") for (int p_ = 0; p_ < 16; ++p_) d2_ = (f32x2){c_[2 * p_], c_[2 * p_ + 1]} * xf6[p_] + d2_; \
            dd[k_] = d2_.x + d2_.y; } while (0)
#else
#define EX_U(B, s_, k_) do { f32x2 d2_ = {0.f, 0.f}; \
            _Pragma("unroll") for (int c_ = 0; c_ < QCH; ++c_) { const unsigned ud[4] = {B[c_].x, B[c_].y, B[c_].z, B[c_].w}; \
                _Pragma("unroll") for (int w_ = 0; w_ < 4; ++w_) { d2_ = __builtin_amdgcn_cvt_pk_f32_fp8((int)ud[w_], false) * xf[c_][2 * w_] + d2_; d2_ = __builtin_amdgcn_cvt_pk_f32_fp8((int)ud[w_], true) * xf[c_][2 * w_ + 1] + d2_; } } \
            dd[k_] = d2_.x + d2_.y; } while (0)
#endif
#define EX_UEND(s_) do { float r4_[4], r2_[2], r1_; \
            { const bool up = (l16 & 4) != 0; _Pragma("unroll") for (int i_ = 0; i_ < 4; ++i_) { const float mine = up ? dd[i_ + 4] : dd[i_], theirs = up ? dd[i_] : dd[i_ + 4]; \
                const float fromhi = DPP_MOV(theirs, 0x104), fromlo = DPP_MOV(theirs, 0x114); r4_[i_] = mine + (up ? fromlo : fromhi); } }     \
            { const bool up = (l16 & 2) != 0; _Pragma("unroll") for (int i_ = 0; i_ < 2; ++i_) { const float mine = up ? r4_[i_ + 2] : r4_[i_], theirs = up ? r4_[i_] : r4_[i_ + 2]; r2_[i_] = mine + DPP_MOV(theirs, 0x4E); } }     \
            { const bool up = (l16 & 1) != 0; const float mine = up ? r2_[1] : r2_[0], theirs = up ? r2_[0] : r2_[1]; r1_ = mine + DPP_MOV(theirs, 0xB1); }     \
            { const int si_ = (s_) + l16; wl[si_] = (j == 0 ? 0.f : wl[si_]) + r1_; } } while (0)
            float dd[8];
#if EX_SWSYNC
            __syncthreads();
#endif
            EX_RING(tabq, EX_U, EX_UEND);
#undef EX_U
#undef EX_UEND
            LDS_WAIT(); asm volatile("" ::: "memory");
        }
        { float suv[16], svv[16]; unsigned mev[16];
#pragma unroll
          for (int i = 0; i < 16; ++i) { mev[i] = list[l16 + 8 * i]; const unsigned e = mev[i] & 0x3FFFu; suv[i] = ((const GAS float*)su)[e]; svv[i] = ((const GAS float*)sv)[e]; }
#pragma unroll
          for (int i = 0; i < 16; ++i) { const int s = l16 + 8 * i;
            wl[s] = gt[(mev[i] >> 16) & 127u] * gelu_tanh(wl[s] * suv[i] * rs) * svv[i]; } }
        LDS_WAIT(); asm volatile("" ::: "memory");
#if EX_W512
        f32x4 wq0 = *(const LAS f32x4*)wl, wq1 = *(const LAS f32x4*)(wl + 4);
#endif
#pragma unroll 1
        for (int j = 0; j < NSW; ++j) {
#if EX_W512
            f32x2 accg[2][16];
#pragma unroll
            for (int e = 0; e < 16; ++e) { accg[0][e] = (f32x2){0.f, 0.f}; accg[1][e] = (f32x2){0.f, 0.f}; }
#elif EX_FP6
            f32x2 acc6[16];
#pragma unroll
            for (int e = 0; e < 16; ++e) acc6[e] = (f32x2){0.f, 0.f};
#else
            f32x2 acc[QCH][8];
#pragma unroll
            for (int c = 0; c < QCH; ++c)
#pragma unroll
                for (int e = 0; e < 8; ++e) acc[c][e] = (f32x2){0.f, 0.f};
#endif
            const unsigned char* tabq = pv + (size_t)j * EX_SLICE_STEP;
#if EX_CONT
            nxtq = (j + 1 < NSW) ? pv + (size_t)(j + 1) * EX_SLICE_STEP : pv + (size_t)j * EX_SLICE_STEP;
#endif
#define EX_NOEND(s_) do { } while (0)
#if EX_W512
#define EX_VEND(s_) do { const int sn_ = ((s_) + 8) & (NSTEP - 1); wq0 = *(const LAS f32x4*)(wl + sn_); wq1 = *(const LAS f32x4*)(wl + sn_ + 4); } while (0)
#endif
#if EX_W512
#define EX_V(B, s_, k_) do { const float w_ = (k_) < 4 ? wq0[(k_) & 3] : wq1[(k_) & 3]; const f32x2 w2 = {w_, w_};     \
            { const v6u_t s6_ = {B[0].x, B[0].y, B[0].z, B[0].w, B[1].x, B[1].y}; const v32f_t c_ = __builtin_amdgcn_cvt_scalef32_pk32_f32_fp6(s6_, 1.0f); \
              _Pragma("unroll") for (int p_ = 0; p_ < 16; ++p_) accg[0][p_] = (f32x2){c_[2 * p_], c_[2 * p_ + 1]} * w2 + accg[0][p_]; } \
            { const v6u_t s6_ = {B[1].z, B[1].w, B[2].x, B[2].y, B[2].z, B[2].w}; const v32f_t c_ = __builtin_amdgcn_cvt_scalef32_pk32_f32_fp6(s6_, 1.0f); \
              _Pragma("unroll") for (int p_ = 0; p_ < 16; ++p_) accg[1][p_] = (f32x2){c_[2 * p_], c_[2 * p_ + 1]} * w2 + accg[1][p_]; } } while (0)
#elif EX_FP6
#define EX_V(B, s_, k_) do { const float w_ = wl[s_]; const f32x2 w2 = {w_, w_}; const v6u_t s6_ = {B[0].x, B[0].y, B[0].z, B[0].w, B[1].x, B[1].y}; const v32f_t c_ = __builtin_amdgcn_cvt_scalef32_pk32_f32_fp6(s6_, 1.0f); \
            _Pragma("unroll") for (int p_ = 0; p_ < 16; ++p_) acc6[p_] = (f32x2){c_[2 * p_], c_[2 * p_ + 1]} * w2 + acc6[p_]; } while (0)
#else
#define EX_V(B, s_, k_) do { const float w_ = wl[s_]; const f32x2 w2 = {w_, w_}; \
            _Pragma("unroll") for (int c_ = 0; c_ < QCH; ++c_) { const unsigned ud[4] = {B[c_].x, B[c_].y, B[c_].z, B[c_].w}; \
                _Pragma("unroll") for (int w4_ = 0; w4_ < 4; ++w4_) { acc[c_][2 * w4_] = __builtin_amdgcn_cvt_pk_f32_fp8((int)ud[w4_], false) * w2 + acc[c_][2 * w4_]; acc[c_][2 * w4_ + 1] = __builtin_amdgcn_cvt_pk_f32_fp8((int)ud[w4_], true) * w2 + acc[c_][2 * w4_ + 1]; } } } while (0)
#endif
#if EX_SWSYNC
            __syncthreads();
#endif
#if EX_W512
            EX_RING(tabq, EX_V, EX_VEND);
#else
            EX_RING(tabq, EX_V, EX_NOEND);
#endif
#undef EX_V
#undef EX_NOEND
#if EX_W512
            { v4u xr8[8];
#pragma unroll
              for (int jj = 0; jj < 8; ++jj) xr8[jj] = *(const GAS v4u*)(xb + (size_t)tok * DM + 64 * j + 8 * l16 + 256 * jj);
#pragma unroll
              for (int jj = 0; jj < 8; ++jj) { float* op = F.out + (size_t)tok * DM + 64 * j + 8 * l16 + 256 * jj;
                  *(GAS f32x4*)op = (f32x4){__uint_as_float(xr8[jj].x << 16) + accg[0][2 * jj].x, __uint_as_float(xr8[jj].x & 0xffff0000u) + accg[0][2 * jj].y, __uint_as_float(xr8[jj].y << 16) + accg[0][2 * jj + 1].x, __uint_as_float(xr8[jj].y & 0xffff0000u) + accg[0][2 * jj + 1].y};
                  *(GAS f32x4*)(op + 4) = (f32x4){__uint_as_float(xr8[jj].z << 16) + accg[1][2 * jj].x, __uint_as_float(xr8[jj].z & 0xffff0000u) + accg[1][2 * jj].y, __uint_as_float(xr8[jj].w << 16) + accg[1][2 * jj + 1].x, __uint_as_float(xr8[jj].w & 0xffff0000u) + accg[1][2 * jj + 1].y}; } }
#elif EX_FP6
            { u32x2m xr6[8];
#pragma unroll
              for (int jj = 0; jj < 8; ++jj) xr6[jj] = *(const GAS u32x2m*)(xb + (size_t)tok * DM + 32 * j + 4 * l16 + 256 * jj);
#pragma unroll
              for (int jj = 0; jj < 8; ++jj)
                  *(GAS f32x4*)(F.out + (size_t)tok * DM + 32 * j + 4 * l16 + 256 * jj) = (f32x4){__uint_as_float(xr6[jj].x << 16) + acc6[2 * jj].x, __uint_as_float(xr6[jj].x & 0xffff0000u) + acc6[2 * jj].y,
                                                                                         __uint_as_float(xr6[jj].y << 16) + acc6[2 * jj + 1].x, __uint_as_float(xr6[jj].y & 0xffff0000u) + acc6[2 * jj + 1].y}; }
#else
            float* orow = F.out + (size_t)tok * DM + j * (QCH * 128) + l16 * 16; const bf16* xrow = xb + (size_t)tok * DM + j * (QCH * 128) + l16 * 16;
            v4u xr[QCH][2];
#pragma unroll
            for (int c = 0; c < QCH; ++c) { xr[c][0] = *(const GAS v4u*)(xrow + c * 128); xr[c][1] = *(const GAS v4u*)(xrow + c * 128 + 8); }
#pragma unroll
            for (int c = 0; c < QCH; ++c) { const v4u x0 = xr[c][0], x1 = xr[c][1]; const unsigned xd[8] = {x0.x, x0.y, x0.z, x0.w, x1.x, x1.y, x1.z, x1.w};
#pragma unroll
                for (int qq = 0; qq < 4; ++qq)
                    STNT(((f32x4){__uint_as_float(xd[2 * qq] << 16) + acc[c][2 * qq].x, __uint_as_float(xd[2 * qq] & 0xffff0000u) + acc[c][2 * qq].y,
                                  __uint_as_float(xd[2 * qq + 1] << 16) + acc[c][2 * qq + 1].x, __uint_as_float(xd[2 * qq + 1] & 0xffff0000u) + acc[c][2 * qq + 1].y}), (GAS f32x4*)(orow + c * 128 + 4 * qq)); }
#endif
        }
#undef EX_LD
#undef EX_RING
        LDS_WAIT(); asm volatile("" ::: "memory");
    }
}

#ifndef EX_LC
#define EX_LC 0
#endif
#ifndef EX_SWSYNC
#define EX_SWSYNC 0
#endif
#ifndef EX_LC_INFL
#define EX_LC_INFL 4
#endif
#ifndef EX_LC_SPLIT
#define EX_LC_SPLIT 0
#endif
#ifndef EX_LC_R
#define EX_LC_R 16
#endif
__device__ __forceinline__ unsigned lc_lds_addr(const volatile LAS void* p) { return (unsigned)(size_t)p; }
__device__ __forceinline__ void lc_st_u32(unsigned addr, unsigned v) { asm volatile("ds_write_b32 %0, %1" : : "v"(addr), "v"(v) : "memory"); }
__device__ __forceinline__ unsigned lc_ld_u32(unsigned addr) { unsigned v; asm volatile("ds_read_b32 %0, %1\n\ts_waitcnt lgkmcnt(0)" : "=v"(v) : "v"(addr) : "memory"); return v; }
__device__ __forceinline__ void lc_glds16(const void* gsrc, unsigned lds_dst) {
    unsigned keep;
    asm volatile("s_mov_b32 %0, m0\n\ts_mov_b32 m0, %2\n\ts_nop 0\n\tglobal_load_lds_dwordx4 %1, off\n\ts_mov_b32 m0, %0" : "=&s"(keep) : "v"(gsrc), "s"(lds_dst) : "memory");
}
#if defined(PROBE_LO) && (PROBE_FLAGS & 512)
#define LC_SKIPMATH(B) if (pflags) { asm volatile("" :: "v"(B[0]), "v"(B[1])); } else
#else
#define LC_SKIPMATH(B)
#endif
constexpr int LC_NSLOT = 8, LC_SLOT = 2048, LC_RING0 = 65536, LC_INFL = EX_LC_INFL;
__device__ __forceinline__ void p14_experts_lc(Frame& F, unsigned* tmo_word, int pflags) {
    const int lane = F.lane, wave = F.wave, q = lane >> 3, l16 = lane & 7;
    const bf16* xb = (const bf16*)(F.ws + WS_XB2); const unsigned char* pu = F.ws + WS_PU; const unsigned char* pv = F.ws + WS_PV;
    const int* idx = (const int*)(F.ws + WS_IDX); const float* gate = (const float*)(F.ws + WS_GATE); const float* rowss = (const float*)(F.ws + WS_ROWSS2);
    const float* su = (const float*)(F.ws + WS_PSCALE); const float* sv = su + 16384;
    constexpr int NSTEP = 128, QCH = 2, NSW = 8;
    {
        LAS unsigned* list = (LAS unsigned*)(F.lds + wave * 8192) + q * 128;
        LAS unsigned* cnt = (LAS unsigned*)(F.lds + LC_RING0 + wave * 2048) + q * 64;
        const int tok = (F.bx * NWAVES + wave) * 8 + q;
#pragma unroll
        for (int i = 0; i < 8; ++i) cnt[l16 + 8 * i] = 0u;
        unsigned ent[16], pos[16];
#pragma unroll
        for (int j = 0; j < 16; ++j) { const int k = l16 + 8 * j; const unsigned e = (unsigned)idx[(size_t)tok * 128 + k]; const unsigned gb = (__float_as_uint(gate[(size_t)tok * 128 + k]) + 0x8000u) & 0xffff0000u; ent[j] = e | gb; }
        LDS_WAIT(); asm volatile("" ::: "memory");
#pragma unroll
        for (int j = 0; j < 16; ++j) pos[j] = __hip_atomic_fetch_add(cnt + ((ent[j] & 0x3FFFu) >> 8), 1u, __ATOMIC_RELAXED, __HIP_MEMORY_SCOPE_WORKGROUP);
        LDS_WAIT(); asm volatile("" ::: "memory");
        { unsigned c[8], inc[8], run = 0u;
#pragma unroll
          for (int i = 0; i < 8; ++i) { c[i] = cnt[l16 + 8 * i]; inc[i] = c[i];
#pragma unroll
              for (int o = 1; o < 8; o <<= 1) { const unsigned tt = __shfl_up(inc[i], o, 8); if (l16 >= o) inc[i] += tt; } }
          LDS_WAIT(); asm volatile("" ::: "memory");
#pragma unroll
          for (int i = 0; i < 8; ++i) { cnt[l16 + 8 * i] = run + inc[i] - c[i]; run += __shfl(inc[i], 7, 8); } }
        LDS_WAIT(); asm volatile("" ::: "memory");
#pragma unroll
        for (int j = 0; j < 16; ++j) list[cnt[(ent[j] & 0x3FFFu) >> 8] + pos[j]] = ent[j];
        if (F.tid < 16) ((LAS unsigned*)(F.lds + LDSCTL_OFF))[F.tid] = 0u;
        LDS_WAIT(); asm volatile("" ::: "memory");
    }
    __syncthreads();
#if EX_LC_SPLIT == 1
    const int c = wave >> 1, regA = c * 2, regB = c * 2 + 1; const bool is_loader = (wave & 1) != 0;
#else
    const int c = wave & 3, regA = c, regB = c + 4; const bool is_loader = wave >= 4;
#endif
    const unsigned ring = lc_lds_addr(F.lds + LC_RING0 + c * (LC_NSLOT * LC_SLOT));
    const unsigned fullw = lc_lds_addr(F.lds + LDSCTL_OFF + c * 8), freew = fullw + 4;
    if (is_loader) {
        constexpr int LC_R = EX_LC_R, NTOT = 2 * 2 * NSW * NSTEP;
        unsigned known_free = 0; bool dead = false;
        volatile LAS unsigned* fullp = (volatile LAS unsigned*)(F.lds + LDSCTL_OFF + c * 8); volatile LAS unsigned* freep = fullp + 1;
        LAS unsigned char* ringl = F.lds + LC_RING0 + c * (LC_NSLOT * LC_SLOT) + lane * 16;
        v4u H[LC_R][2];
#define LC_ENT(n0_) do { const int nn_ = (n0_); const int ps_ = nn_ >> 11, tj_ = (nn_ >> 7) & 15, s_ = nn_ & 127; \
            const LAS v4u* lp_ = (const LAS v4u*)((const LAS unsigned*)(F.lds + (ps_ ? regB : regA) * 8192) + q * 128 + s_); \
            _Pragma("unroll") for (int i_ = 0; i_ < LC_R / 4; ++i_) { const v4u t_ = lp_[i_]; E[4 * i_] = t_.x; E[4 * i_ + 1] = t_.y; E[4 * i_ + 2] = t_.z; E[4 * i_ + 3] = t_.w; } \
            tb = (tj_ < NSW ? pu : pv) + (tj_ & (NSW - 1)) * (QCH * 128) + l16 * 16; } while (0)
#if defined(PROBE_LO) && (PROBE_FLAGS & 256)
#define LC_LOAD(k_) do { const unsigned char* src_ = tb + ((size_t)(E[k_] & 0x3FFFu) << 11); if (pflags) { H[k_][0] = (v4u){E[k_], 1u, 2u, 3u}; H[k_][1] = H[k_][0]; } else { H[k_][0] = *(const GAS v4u*)src_; H[k_][1] = *(const GAS v4u*)(src_ + 128); } } while (0)
#else
#define LC_LOAD(k_) do { const unsigned char* src_ = tb + ((size_t)(E[k_] & 0x3FFFu) << 11); H[k_][0] = *(const GAS v4u*)src_; H[k_][1] = *(const GAS v4u*)(src_ + 128); } while (0)
#endif
        unsigned E[LC_R]; const unsigned char* tb;
        LC_ENT(0);
#pragma unroll
        for (int k = 0; k < LC_R; ++k) LC_LOAD(k);
        LC_ENT(LC_R);
#pragma unroll 1
        for (int n0 = 0; n0 < NTOT; n0 += LC_R) {
#pragma unroll
            for (int k = 0; k < LC_R; ++k) { const unsigned n = (unsigned)(n0 + k);
                if (n >= known_free + (unsigned)LC_NSLOT && !dead) { unsigned sp = 0;
                    for (;;) { known_free = *freep; if (n < known_free + (unsigned)LC_NSLOT) break; __builtin_amdgcn_s_sleep(1);
                        if (++sp > (1u << 22)) { dead = true; if (lane == 0) atomicAdd(tmo_word, 1u); break; } } }
                LAS unsigned char* sl = ringl + (n & (LC_NSLOT - 1)) * LC_SLOT;
                *(LAS v4u*)sl = H[k][0]; *(LAS v4u*)(sl + 1024) = H[k][1];
                asm volatile("" ::: "memory");
                *fullp = n + 1u;
                if (n0 + LC_R < NTOT) LC_LOAD(k);
            }
            if (n0 + 2 * LC_R < NTOT) LC_ENT(n0 + 2 * LC_R);
        }
#undef LC_LOAD
#undef LC_ENT
    } else {
        volatile LAS unsigned* fullp = (volatile LAS unsigned*)(F.lds + LDSCTL_OFF + c * 8);
        unsigned qn = 0, known_full = 0; bool dead = false;
        const LAS unsigned char* ringp = F.lds + LC_RING0 + c * (LC_NSLOT * LC_SLOT) + lane * 16;
#define LC_GET(B) do { if (qn >= known_full && !dead) { unsigned sp_ = 0; for (;;) { known_full = *fullp; if (qn < known_full) break; __builtin_amdgcn_s_sleep(1); \
                if (++sp_ > (1u << 22)) { dead = true; if (lane == 0) atomicAdd(tmo_word, 1u); break; } } } \
            const LAS unsigned char* sl_ = ringp + (qn & (LC_NSLOT - 1)) * LC_SLOT; B[0] = *(const LAS v4u*)sl_; B[1] = *(const LAS v4u*)(sl_ + 1024); } while (0)
#define LC_REL() do { LDS_WAIT(); asm volatile("" ::: "memory"); ++qn; lc_st_u32(freew, qn); } while (0)
#pragma unroll 1
        for (int pass = 0; pass < 2; ++pass) {
            const int reg = pass ? regB : regA;
            const LAS unsigned* list = (const LAS unsigned*)(F.lds + reg * 8192) + q * 128;
            LAS float* wl = (LAS float*)(F.lds + reg * 8192 + 4096) + q * 128;
            const int tok = (F.bx * NWAVES + reg) * 8 + q;
            const float rs = 1.f / sqrtf(rowss[tok] * (1.f / DM) + RMS_EPS);
#pragma unroll 1
            for (int j = 0; j < NSW; ++j) {
                f32x2 xf[QCH][8];
#pragma unroll
                for (int cc = 0; cc < QCH; ++cc) { const v4u a = *(const GAS v4u*)(xb + (size_t)tok * DM + j * (QCH * 128) + cc * 128 + l16 * 16), b = *(const GAS v4u*)(xb + (size_t)tok * DM + j * (QCH * 128) + cc * 128 + l16 * 16 + 8);
                    const unsigned xd[8] = {a.x, a.y, a.z, a.w, b.x, b.y, b.z, b.w};
#pragma unroll
                    for (int i = 0; i < 8; ++i) xf[cc][i] = (f32x2){__uint_as_float(xd[i] << 16), __uint_as_float(xd[i] & 0xffff0000u)}; }
#define LC_U(B, k_) do { f32x2 d2_[2 * QCH]; LC_SKIPMATH(B) { \
                _Pragma("unroll") for (int c_ = 0; c_ < QCH; ++c_) { const unsigned ud[4] = {B[c_].x, B[c_].y, B[c_].z, B[c_].w}; \
                    d2_[2 * c_] = __builtin_amdgcn_cvt_pk_f32_fp8((int)ud[0], false) * xf[c_][0]; d2_[2 * c_ + 1] = __builtin_amdgcn_cvt_pk_f32_fp8((int)ud[0], true) * xf[c_][1]; \
                    _Pragma("unroll") for (int w_ = 1; w_ < 4; ++w_) { d2_[2 * c_] = __builtin_amdgcn_cvt_pk_f32_fp8((int)ud[w_], false) * xf[c_][2 * w_] + d2_[2 * c_]; d2_[2 * c_ + 1] = __builtin_amdgcn_cvt_pk_f32_fp8((int)ud[w_], true) * xf[c_][2 * w_ + 1] + d2_[2 * c_ + 1]; } } \
                const f32x2 t_ = (d2_[0] + d2_[1]) + (d2_[2] + d2_[3]); dd[k_] = t_.x + t_.y; } } while (0)
                float dd[8]; v4u B0[QCH], B1[QCH];
                LC_GET(B0);
#pragma unroll 1
                for (int s = 0; s < NSTEP; s += 8) {
                    LC_REL(); LC_GET(B1); LC_U(B0, 0);  LC_REL(); LC_GET(B0); LC_U(B1, 1);
                    LC_REL(); LC_GET(B1); LC_U(B0, 2);  LC_REL(); LC_GET(B0); LC_U(B1, 3);
                    LC_REL(); LC_GET(B1); LC_U(B0, 4);  LC_REL(); LC_GET(B0); LC_U(B1, 5);
                    LC_REL(); LC_GET(B1); LC_U(B0, 6);  LC_REL();
                    if (s + 8 < NSTEP) LC_GET(B0);
                    LC_U(B1, 7);
                    { float r4_[4], r2_[2], r1_;
                      { const bool up = (l16 & 4) != 0;
#pragma unroll
                        for (int i_ = 0; i_ < 4; ++i_) { const float mine = up ? dd[i_ + 4] : dd[i_], theirs = up ? dd[i_] : dd[i_ + 4]; const float fromhi = DPP_MOV(theirs, 0x104), fromlo = DPP_MOV(theirs, 0x114); r4_[i_] = mine + (up ? fromlo : fromhi); } }
                      { const bool up = (l16 & 2) != 0;
#pragma unroll
                        for (int i_ = 0; i_ < 2; ++i_) { const float mine = up ? r4_[i_ + 2] : r4_[i_], theirs = up ? r4_[i_] : r4_[i_ + 2]; r2_[i_] = mine + DPP_MOV(theirs, 0x4E); } }
                      { const bool up = (l16 & 1) != 0; const float mine = up ? r2_[1] : r2_[0], theirs = up ? r2_[0] : r2_[1]; r1_ = mine + DPP_MOV(theirs, 0xB1); }
                      { const int si_ = s + l16; wl[si_] = (j == 0 ? 0.f : wl[si_]) + r1_; } }
                }
#undef LC_U
                LDS_WAIT(); asm volatile("" ::: "memory");
            }
#pragma unroll
            for (int i = 0; i < 16; ++i) { const int s = l16 + 8 * i; const unsigned me = list[s]; const unsigned e = me & 0x3FFFu;
                wl[s] = __uint_as_float(me & 0xffff0000u) * gelu_tanh(wl[s] * su[e] * rs) * sv[e]; }
            LDS_WAIT(); asm volatile("" ::: "memory");
#pragma unroll 1
            for (int j = 0; j < NSW; ++j) {
                f32x2 acc[QCH][8];
#pragma unroll
                for (int cc = 0; cc < QCH; ++cc)
#pragma unroll
                    for (int e = 0; e < 8; ++e) acc[cc][e] = (f32x2){0.f, 0.f};
#define LC_V(B, W) do { const f32x2 w2 = {W, W}; LC_SKIPMATH(B) \
                _Pragma("unroll") for (int c_ = 0; c_ < QCH; ++c_) { const unsigned ud[4] = {B[c_].x, B[c_].y, B[c_].z, B[c_].w}; \
                    _Pragma("unroll") for (int w4_ = 0; w4_ < 4; ++w4_) { acc[c_][2 * w4_] = __builtin_amdgcn_cvt_pk_f32_fp8((int)ud[w4_], false) * w2 + acc[c_][2 * w4_]; acc[c_][2 * w4_ + 1] = __builtin_amdgcn_cvt_pk_f32_fp8((int)ud[w4_], true) * w2 + acc[c_][2 * w4_ + 1]; } } } while (0)
                v4u B0[QCH], B1[QCH]; float W0, W1;
                W0 = wl[0]; LC_GET(B0);
#pragma unroll 1
                for (int s = 0; s < NSTEP; s += 2) {
                    LC_REL(); W1 = wl[s + 1]; LC_GET(B1); LC_V(B0, W0);
                    LC_REL(); if (s + 2 < NSTEP) { W0 = wl[s + 2]; LC_GET(B0); } LC_V(B1, W1);
                }
#undef LC_V
                float* orow = F.out + (size_t)tok * DM + j * (QCH * 128) + l16 * 16; const bf16* xrow = xb + (size_t)tok * DM + j * (QCH * 128) + l16 * 16;
#pragma unroll
                for (int cc = 0; cc < QCH; ++cc) { const v4u x0 = *(const GAS v4u*)(xrow + cc * 128), x1 = *(const GAS v4u*)(xrow + cc * 128 + 8); const unsigned xd[8] = {x0.x, x0.y, x0.z, x0.w, x1.x, x1.y, x1.z, x1.w};
#pragma unroll
                    for (int qq = 0; qq < 4; ++qq)
#ifdef PROBE_LO
                        if (!pflags)
#endif
                        *(GAS f32x4*)(orow + cc * 128 + 4 * qq) = (f32x4){__uint_as_float(xd[2 * qq] << 16) + acc[cc][2 * qq].x, __uint_as_float(xd[2 * qq] & 0xffff0000u) + acc[cc][2 * qq].y,
                                                                        __uint_as_float(xd[2 * qq + 1] << 16) + acc[cc][2 * qq + 1].x, __uint_as_float(xd[2 * qq + 1] & 0xffff0000u) + acc[cc][2 * qq + 1].y}; }
            }
        }
#undef LC_GET
#undef LC_REL
    }
    asm volatile("s_waitcnt vmcnt(0) lgkmcnt(0)" ::: "memory");
    __syncthreads();
}

#ifdef ONLY_PHASE
#define ISO(n) ((n) == ONLY_PHASE)
#else
#define ISO(n) true
#endif
#ifndef LAST_PHASE
#define LAST_PHASE 11
#endif
enum { PH_PROLOGUE = 0, PH_GEMM_IN, PH_GEMM_IN8, PH_ATTN, PH_GEMM_FOXUP, PH_GEMM_RETUP, PH_GEMM_OUT, PH_GEMM_MQ, PH_MEM_ATTN, PH_GEMM_MO, PH_GEMM_PQ, PH_EXPERTS, PH_N };
__global__ void __launch_bounds__(NWAVES * 64, 2) mega_fwd(Args args) {
    extern __shared__ __attribute__((aligned(16))) unsigned char lds[];
    Frame F;
    F.lds = (LAS unsigned char*)lds; F.ldsg = lds; F.tid = threadIdx.x; F.lane = F.tid & 63; F.wave = __builtin_amdgcn_readfirstlane(F.tid >> 6); F.G = gridDim.x; F.bx = blockIdx.x;
    F.in = args.in; F.out = args.out; F.ws = args.ws; F.p0_mask = args.p0_mask;
    volatile LAS unsigned* MISC = (volatile LAS unsigned*)(F.lds + MISC_OFF);
    for (int u = F.tid; u < (LDS_BYTES - LDSCTL_OFF) / 4; u += NWAVES * 64) ((LAS unsigned*)(F.lds + LDSCTL_OFF))[u] = 0u;
    __syncthreads();
    gu32* ctl = (gu32*)(args.ws + WS_CTL);
    XcdBarrier bar = xcd_barrier_post((unsigned*)(ctl + CW_BAR), MISC + 8, (unsigned)F.wave);
    unsigned char* ws = args.ws;
    bf16* proj = (bf16*)(ws + WS_PROJ);
    for (int ph = args.ph_lo; ph < args.ph_hi; ++ph) {
        { int w_ = F.wave; asm volatile("" : "+s"(w_)); F.wave = w_; F.lane = lane_now(); F.tid = w_ * 64 + F.lane; }
        { int g_ = gridDim.x, b_ = blockIdx.x; asm volatile("" : "+s"(g_), "+s"(b_)); F.G = g_; F.bx = b_; }
        bool is_gemm = false, barrier_after = true, fp8 = false, mq_phase = false, qk_phase = false, pq_phase = false, ksplit = false, qk8_phase = false;
        pg8::Gemm g{nullptr, nullptr, 0, 0, 0, 0, 0x7F7F7F7F}; pg8::EpiAny E{};
#ifdef PROBE_EX2
        switch (ph > LAST_PHASE ? LAST_PHASE : ph) {
#else
        switch (ph) {
#endif
#ifndef NO_P0
        case PH_PROLOGUE: if constexpr (ISO(0)) p0_prologue(F); break;
#endif
        case PH_GEMM_IN: if constexpr (ISO(1)) p1_scan(F); is_gemm = true; barrier_after = false; qk_phase = true;
            g = pg8::Gemm{(const bf16*)(ws + WS_XN), (const bf16*)(ws + WS_WIN), M_TOK, N_QK, DM, DM, 0x7F7F7F7F, DM}; E.kind = ROPE_FUSED ? 8 : 0; E.O = proj; E.ldc = PP; E.pn_off = 0; break;
        case PH_GEMM_IN8: is_gemm = true; fp8 = true; qk8_phase = true;
            g = pg8::Gemm{(const bf16*)((unsigned char*)args.out + DO_XN8), (const bf16*)(ws + WS_WIN + 16 * MiB), M_TOK, N_REST, DM / 2, DM / 2, W8_SCALE_B, DM / 2}; E.kind = 0; E.O = proj + N_QK; E.ldc = PP; E.pn_off = N_QK / 256; E.gq = args.in[I_FOXQ_G]; E.gk = args.in[I_FOXK_G]; E.qmul = QK_C2; E.P = (LAS float*)(F.lds + RING_BYTES); break;
#ifndef NO_ATTN
        case PH_ATTN: if constexpr (ISO(3)) p4_attention(F); break;
#endif
#if FP8_UP_OUT
        case PH_GEMM_FOXUP: is_gemm = true; fp8 = true;
            g = pg8::Gemm{(const bf16*)((unsigned char*)args.out + DO_OCAT8), (const bf16*)(ws + WS_WFOX), M_TOK, DM, 512, 1024, W8_SCALE_B, 1024}; ksplit = true; E.kind = 7; E.Gt = proj + C_G0; E.Gt2 = proj + C_G1; E.ldg = PP; E.O8 = (unsigned char*)(proj + C_FK); E.ld8 = PP * 2; break;
        case PH_GEMM_RETUP: barrier_after = false; break;
        case PH_GEMM_OUT: is_gemm = true; fp8 = true;
            g = pg8::Gemm{proj + C_FK, (const bf16*)(ws + WS_WOUT), M_TOK, DM, DM / 2, PP, W8_SCALE_B, DM / 2}; E.kind = 4; E.base = args.in[I_X]; E.base16 = nullptr; E.O = (bf16*)(ws + WS_XB1); E.ldc = DM; E.rowss = (float*)(ws + WS_ROWSS1); break;
#else
        case PH_GEMM_FOXUP: is_gemm = true;
            g = pg8::Gemm{proj + C_FQ, (const bf16*)(ws + WS_WFOX), M_TOK, DM, 1024, PP, 0x7F7F7F7F, 1024}; E.kind = 2; E.O = (bf16*)(ws + WS_XN); E.ldc = DM; E.Gt = proj + C_G0; E.ldg = PP; break;
        case PH_GEMM_RETUP: is_gemm = true;
            g = pg8::Gemm{proj + C_RQ, (const bf16*)(ws + WS_WRET), M_TOK, DM, 1024, PP, 0x7F7F7F7F, 1024}; E.kind = 6; E.O = (bf16*)(ws + WS_XN); E.ldc = DM; E.Gt = proj + C_G1; E.ldg = PP; break;
        case PH_GEMM_OUT: is_gemm = true;
            g = pg8::Gemm{(const bf16*)(ws + WS_XN), (const bf16*)(ws + WS_WOUT), M_TOK, DM, DM, DM, 0x7F7F7F7F, DM}; E.kind = 4; E.base = args.in[I_X]; E.base16 = nullptr; E.O = (bf16*)(ws + WS_XB1B); E.ldc = DM; E.rowss = (float*)(ws + WS_ROWSS1); break;
#endif
        case PH_GEMM_MQ: is_gemm = true; mq_phase = true;
            if (F.bx < 128) { g = pg8::Gemm{(const bf16*)(ws + WS_XB1), (const bf16*)(ws + WS_WMQ), M_TOK, 512, DM, DM, 0x7F7F7F7F, DM}; E.kind = 1; E.O = (bf16*)(ws + WS_QM); E.ldc = 512; E.rowss_in = (const float*)(ws + WS_ROWSS1); }
            else { g = pg8::Gemm{(const bf16*)(ws + WS_MN), (const bf16*)(ws + WS_WMKV), NB * 256, 1024, DM, DM, 0x7F7F7F7F, DM}; E.kind = 1; E.O = (bf16*)(ws + WS_KVM); E.ldc = 1024; E.rowss_in = nullptr; }
            break;
        case PH_MEM_ATTN: if constexpr (ISO(8)) p10_mem_attention(F); break;
        case PH_GEMM_MO: is_gemm = true;
            fp8 = true; g = pg8::Gemm{(const bf16*)(ws + WS_OMEM), (const bf16*)(ws + WS_WMO), M_TOK, DM, 256, 256, W8_SCALE_B, 256}; E.kind = 4; E.base = nullptr; E.base16 = (const bf16*)(ws + WS_XB1); E.O = (bf16*)(ws + WS_XB2); E.ldc = DM; E.rowss = (float*)(ws + WS_ROWSS2); break;
        case PH_GEMM_PQ: is_gemm = true; pq_phase = true;
            g = pg8::Gemm{(const bf16*)(ws + WS_XB2), (const bf16*)(ws + WS_WPQ), M_TOK, DM, DM, DM, 0x7F7F7F7F, DM}; E.kind = 1; E.O = (bf16*)(ws + WS_QP); E.ldc = DM; E.rowss_in = (const float*)(ws + WS_ROWSS2); break;
#if EX_TOK8
#if EX_LC
        case PH_EXPERTS: if constexpr (ISO(11)) p14_experts_lc(F, (unsigned*)(ctl + CW_BAR) + XB_TMO, args.pad); break;
#else
        case PH_EXPERTS: if constexpr (ISO(11)) p14_experts_8(F); break;
#endif
#else
        case PH_EXPERTS: if constexpr (ISO(11)) p14_experts_sorted(F); break;
#endif
        default: break;
        }
#ifdef PROBE_LO
        if (is_gemm && args.pad) {
#if PROBE_FLAGS & 1
            g.K >>= 1;
#endif
#if PROBE_FLAGS & 2
            E.kind = 99;
#endif
#if PROBE_FLAGS & 4
            qk_phase = false; qk8_phase = false; pq_phase = false;
#endif
#if PROBE_FLAGS & 8
            E.pn_off = -100; E.rowss = nullptr;
#endif
#if PROBE_FLAGS & 32
            is_gemm = false;
#endif
#if PROBE_FLAGS & 128
            g.lda = 0; g.ldb = 0;
#endif
#if PROBE_FLAGS & 64
            if ((F.bx >> 3) & 1) { const unsigned long long t0 = __builtin_amdgcn_s_memrealtime(); while (__builtin_amdgcn_s_memrealtime() - t0 < (unsigned long long)(PROBE_DLY)) __builtin_amdgcn_s_sleep(8); }
#endif
        }
#endif
#ifndef NO_GEMM
        if constexpr (ISO(100)) if (is_gemm) { pg8::StaticOrder S; S.init(g.M, g.N, F.G, (mq_phase && F.bx >= 128) ? F.bx - 128 : F.bx); S.kshift = ksplit ? 1 : 0;
            if (fp8) pg8::gemm_phase<pg8::EpiAny, pg8::StaticOrder, true, true, true>(F.lds, g, S, E, F.wave); else pg8::gemm_phase<pg8::EpiAny, pg8::StaticOrder, true, true, false>(F.lds, g, S, E, F.wave); }
        if constexpr (ISO(1)) if (qk_phase) {
            asm volatile("s_waitcnt vmcnt(0)" ::: "memory"); __syncthreads();
            pg8::StaticOrder S; pg8::Unit u; S.init(M_TOK, N_QK, F.G, F.bx);
            for (int i = 0; S.next(i, u); ++i) if (!ROPE_FUSED) fix_own_tile(F, proj, u.pm, u.pn, 2 + (u.pn >> 2)); }
        if constexpr (ISO(2)) if (qk8_phase) {
            asm volatile("s_waitcnt vmcnt(0)" ::: "memory"); __syncthreads();
            pg8::StaticOrder S; pg8::Unit u; S.init(M_TOK, N_REST, F.G, F.bx);
            for (int i = 0; S.next(i, u); ++i) if (!QKNORM_FUSED && u.pn < 8) fix_own_tile(F, proj, u.pm, u.pn + 8, u.pn >> 2); }
        if constexpr (ISO(10)) if (pq_phase) {
            asm volatile("s_waitcnt vmcnt(0)" ::: "memory"); __syncthreads();
            pg8::StaticOrder S; pg8::Unit u; S.init(M_TOK, DM, F.G, F.bx);
            for (int i = 0; S.next(i, u); ++i) p13_topk_unit(F, u.pm, u.pn); }
        if constexpr (ISO(7)) if (mq_phase) {
            pg8::StaticOrder S; pg8::Unit u;
#if defined(PROBE_LO) && (PROBE_FLAGS & 32)
            if (args.pad) {} else
#endif
            if (F.bx < 128) { S.init(M_TOK, 512, F.G, F.bx); if (S.next(0, u)) norm_own_tile(F, (bf16*)(ws + WS_QM), 512, u.pm * 256, u.pn * 256, args.in[I_MEMQ_G], QK_C2); }
            else { S.init(NB * 256, 1024, F.G, F.bx - 128); if (S.next(0, u) && u.pn < 2) norm_own_tile(F, (bf16*)(ws + WS_KVM), 1024, u.pm * 256, u.pn * 256, args.in[I_MEMK_G], 1.f); }
#if defined(PROBE_LO) && (PROBE_FLAGS & 16)
            if (!args.pad)
#endif
            p8_convert_peer(F); }
#endif
        if (barrier_after && ph + 1 < args.ph_hi) xcd_barrier(bar);
    }
    if (xb_ld((unsigned*)(ctl + CW_BAR) + XB_TMO) != 0u) { const float q = __builtin_nanf(""); for (size_t i = (size_t)F.bx * 512 + F.tid; i < (size_t)M_TOK * DM / 4; i += (size_t)F.G * 512) ((f32x4*)args.out)[i] = (f32x4){q, q, q, q}; }
}

#ifdef PROBE_CVT
__global__ void __launch_bounds__(512) bench_cvt(float* sink) {
    const int lane = threadIdx.x & 63;
#if PROBE_CVT == 1
    typedef unsigned v6u_ __attribute__((ext_vector_type(6))); typedef float v32f_ __attribute__((ext_vector_type(32)));
    v6u_ src = {(unsigned)lane, 2u, 3u, 4u, 5u, 6u}; float a0 = 0.f, a1 = 0.f;
#pragma unroll 4
    for (int it = 0; it < 16384; ++it) { src[0] += 1u; const v32f_ r = __builtin_amdgcn_cvt_scalef32_pk32_f32_fp6(src, 1.0f); a0 += r[0]; a1 += r[31]; }
    if (a0 + a1 == 12345.678f) sink[0] = 0.f;
#else
    unsigned s0 = (unsigned)lane; f32x2 acc = {0.f, 0.f};
#pragma unroll 4
    for (int it = 0; it < 16384; ++it) {
#pragma unroll
        for (int w = 0; w < 8; ++w) { s0 += 1u; acc += __builtin_amdgcn_cvt_pk_f32_fp8((int)s0, false); acc += __builtin_amdgcn_cvt_pk_f32_fp8((int)s0, true); } }
    if (acc.x + acc.y == 12345.678f) sink[0] = 0.f;
#endif
}
#endif
#ifdef PROBE_EPI
template <int PAT> __global__ void __launch_bounds__(512) bench_epi(const float* X, unsigned short* Y) {
    const int w = threadIdx.x >> 6, lane = threadIdx.x & 63;
    for (int t = 0; t < PROBE_EPI_T; ++t) { const int L = t * 256 + blockIdx.x, pn = L & 7, pm = (L >> 3) & 63;
        if (PAT == 0) { const int wr = w >> 2, wc = w & 3, fr = lane & 15, fq = lane >> 4; const int row0 = pm * 256 + wr * 64 + fr, col0 = pn * 256 + wc * 32 + 8 * fq;
#pragma unroll
            for (int ai = 0; ai < 2; ++ai) { f32x4 ld[4][2][2];
#pragma unroll
                for (int m = 0; m < 4; ++m)
#pragma unroll
                    for (int bj = 0; bj < 2; ++bj) { const float* p = X + (size_t)(row0 + ai * 128 + m * 16) * 2048 + col0 + bj * 128; ld[m][bj][0] = __builtin_nontemporal_load((const f32x4*)p); ld[m][bj][1] = __builtin_nontemporal_load((const f32x4*)(p + 4)); }
#pragma unroll
                for (int m = 0; m < 4; ++m)
#pragma unroll
                    for (int bj = 0; bj < 2; ++bj) { v4u o; o.x = pk2(ld[m][bj][0][0], ld[m][bj][0][1]); o.y = pk2(ld[m][bj][0][2], ld[m][bj][0][3]); o.z = pk2(ld[m][bj][1][0], ld[m][bj][1][1]); o.w = pk2(ld[m][bj][1][2], ld[m][bj][1][3]);
                        *(v4u*)(Y + (size_t)(row0 + ai * 128 + m * 16) * 2048 + col0 + bj * 128) = o; }
                asm volatile("" ::: "memory"); }
        } else {
#pragma unroll
            for (int h = 0; h < 2; ++h) { f32x4 ld[16];
#pragma unroll
                for (int r = 0; r < 16; ++r) ld[r] = __builtin_nontemporal_load((const f32x4*)(X + (size_t)(pm * 256 + w * 32 + h * 16 + r) * 2048 + pn * 256) + lane);
#pragma unroll
                for (int r = 0; r < 16; ++r) { unsigned long long o = (unsigned long long)pk2(ld[r][0], ld[r][1]) | ((unsigned long long)pk2(ld[r][2], ld[r][3]) << 32);
                    *((unsigned long long*)(Y + (size_t)(pm * 256 + w * 32 + h * 16 + r) * 2048 + pn * 256) + lane) = o; }
                asm volatile("" ::: "memory"); }
        }
    }
}
#endif
extern "C" void kernel_launch(void* const* d_in, const int* in_sizes, int n_in, void* d_out, int out_size, void* d_ws, size_t ws_size, hipStream_t stream) {
    static int grid = 0;
    if (grid == 0) {
        if (n_in != 23 || out_size != M_TOK * DM || ws_size < WS_END) { fprintf(stderr, "kernel_launch: unexpected shapes (n_in %d out %d ws %zu)\n", n_in, out_size, ws_size); grid = -1; return; }
        int dev = 0, cus = 0, per_cu = 0;
        if (hipGetDevice(&dev) != hipSuccess || hipDeviceGetAttribute(&cus, hipDeviceAttributeMultiprocessorCount, dev) != hipSuccess) { grid = -1; return; }
        if (hipFuncSetAttribute((const void*)mega_fwd, hipFuncAttributeMaxDynamicSharedMemorySize, LDS_BYTES) != hipSuccess) { fprintf(stderr, "hipFuncSetAttribute failed\n"); grid = -1; return; }
        if (hipOccupancyMaxActiveBlocksPerMultiprocessor(&per_cu, (const void*)mega_fwd, NWAVES * 64, LDS_BYTES) != hipSuccess || per_cu < 1) fprintf(stderr, "occupancy query reports %d\n", per_cu);
        (void)hipGetLastError();
        grid = cus;
        if (grid != 256) { fprintf(stderr, "kernel_launch: built for 256 CUs, got %d\n", cus); grid = -1; return; }
    }
    if (grid < 0) return;
    (void)hipMemsetAsync((char*)d_ws + WS_CTL, 0, CTL_ZERO_BYTES, stream);
    Args a{};
    for (int i = 0; i < 23; ++i) a.in[i] = (const float*)d_in[i];
    a.out = (float*)d_out; a.ws = (unsigned char*)d_ws;
#ifdef PROBE_CVT
    hipLaunchKernelGGL(bench_cvt, dim3(256), dim3(512), 0, stream, (float*)d_ws + (4u << 20));
#endif
#ifdef PROBE_PREFIX
    a.ph_lo = 0; a.ph_hi = PROBE_PREFIX;
#ifdef PROBE_P0_MASK
    a.p0_mask = PROBE_P0_MASK;
#else
    a.p0_mask = 3;
#endif
    hipLaunchKernelGGL(mega_fwd, dim3(grid), dim3(NWAVES * 64), LDS_BYTES, stream, a);
    (void)hipMemsetAsync((char*)d_ws + WS_CTL, 0, CTL_ZERO_BYTES, stream);
#endif
#ifdef PROBE_EX2
    a.ph_lo = 0; a.ph_hi = LAST_PHASE + PROBE_EX2; a.p0_mask = 3;
#else
    a.ph_lo = 0; a.ph_hi = LAST_PHASE + 1; a.p0_mask = 3;
#endif
    hipLaunchKernelGGL(mega_fwd, dim3(grid), dim3(NWAVES * 64), LDS_BYTES, stream, a);
#ifdef PROBE_EPI
    for (int r = 0; r < 4; ++r) hipLaunchKernelGGL(bench_epi<PROBE_EPI>, dim3(256), dim3(512), 0, stream, (const float*)d_in[I_X], (unsigned short*)((char*)d_ws + 144 * MiB));
#endif
#ifdef PROBE_LO
    (void)hipMemsetAsync((char*)d_ws + WS_CTL, 0, PROBE_LO == 11 ? 256 * 1024 : CTL_ZERO_BYTES, stream);
    a.ph_lo = PROBE_LO; a.ph_hi = PROBE_HI; a.p0_mask = 3; a.pad = PROBE_FLAGS;
    for (int r = 0; r < PROBE_REP; ++r) hipLaunchKernelGGL(mega_fwd, dim3(grid), dim3(NWAVES * 64), LDS_BYTES, stream, a);
#endif
}
```
